# Optimizing an MI355X kernel written in HIP

```python
import jax
import jax.numpy as jnp
from jax import lax
import numpy as np

D_MODEL = 1024
BATCH = 1
SEQ = 16384
DEPTH = 4

GRID_W = 64
CTX_LEN = 256
N_MIXERS = 3
RMS_EPS = 1e-6
ROPE_THETA = 10000.0

NA_HEADS = 16
NA_HEAD_DIM = D_MODEL // NA_HEADS
NA_WIN_ROWS = 8
NA_WIN_COLS = 16

SWA_Q_HEADS = 16
SWA_KV_HEADS = 4
SWA_HEAD_DIM = D_MODEL // SWA_Q_HEADS
SWA_GROUP = SWA_Q_HEADS // SWA_KV_HEADS
SWA_WINDOW = 128
SWA_BLOCK = 128

MLA_HEADS = 16
MLA_Q_RANK = D_MODEL // 2
MLA_KV_RANK = D_MODEL // 4
MLA_NOPE_DIM = 64
MLA_ROPE_DIM = 32
MLA_V_DIM = 64
MLA_QK_DIM = MLA_NOPE_DIM + MLA_ROPE_DIM
MLA_Q_BLOCK = 128

N_EXPERTS = 16
EXPERT_FF = 2 * D_MODEL
EC_CAPACITY_FACTOR = 2

kernel_name = 'hybrid_na_swa_mla_ecmoe_dit'


def rmsnorm(x, g):
    xf = x.astype(jnp.float32)
    y = xf * lax.rsqrt(jnp.mean(xf * xf, axis=-1, keepdims=True) + RMS_EPS)
    return (y * g.astype(jnp.float32)).astype(x.dtype)


def modulate(h, shift, scale):
    return h * (1 + scale) + shift


def axial_rope_angles(n_tokens, rot_dim):
    quarter = rot_dim // 4
    inv_freq = ROPE_THETA ** (-jnp.arange(quarter, dtype=jnp.float32) / quarter)
    t = jnp.arange(n_tokens)
    row = (t // GRID_W).astype(jnp.float32)
    col = (t % GRID_W).astype(jnp.float32)
    return row[:, None] * inv_freq, col[:, None] * inv_freq


def _rotate(x, ang):
    m = ang.shape[-1]
    bshape = (ang.shape[0],) + (1,) * (x.ndim - 3) + (m,)
    cos = jnp.cos(ang).reshape(bshape).astype(x.dtype)
    sin = jnp.sin(ang).reshape(bshape).astype(x.dtype)
    x1, x2 = x[..., :m], x[..., m:]
    return jnp.concatenate([x1 * cos - x2 * sin, x1 * sin + x2 * cos], axis=-1)


def apply_axial_rope(x, ang_row, ang_col):
    half = x.shape[-1] // 2
    return jnp.concatenate([_rotate(x[..., :half], ang_row), _rotate(x[..., half:], ang_col)], axis=-1)


def dense_attend(q, k, v, scale, sink=None):
    s = jnp.einsum('bqkgd,bskd->bkgqs', q, k).astype(jnp.float32) * scale
    if sink is None:
        p = jax.nn.softmax(s, axis=-1)
    else:
        s_sink = jnp.broadcast_to(sink.astype(jnp.float32)[None, :, :, None, None], s.shape[:-1] + (1,))
        p = jax.nn.softmax(jnp.concatenate([s_sink, s], axis=-1), axis=-1)[..., 1:]
    return jnp.einsum('bkgqs,bskd->bqkgd', p.astype(v.dtype), v)


def neighborhood_attention(hc, hl, w_qkv, w_o, rpb, need_ctx):
    B, L, _ = hl.shape
    rows = L // GRID_W
    kr, kc = min(NA_WIN_ROWS, rows), NA_WIN_COLS
    scale = NA_HEAD_DIM ** -0.5
    q, k, v = jnp.moveaxis((hl @ w_qkv).reshape(B, L, 3, NA_HEADS, NA_HEAD_DIM), 2, 0)
    qc, k_ctx, v_ctx = jnp.moveaxis((hc @ w_qkv).reshape(B, -1, 3, NA_HEADS, NA_HEAD_DIM), 2, 0)
    qg = q.reshape(B, rows, GRID_W, NA_HEADS, NA_HEAD_DIM)
    kg = k.reshape(B, rows, GRID_W, NA_HEADS, NA_HEAD_DIM)
    vg = v.reshape(B, rows, GRID_W, NA_HEADS, NA_HEAD_DIM)
    col = jnp.arange(GRID_W)
    col_idx = jnp.clip(col - kc // 2, 0, GRID_W - kc)[:, None] + jnp.arange(kc)
    dc = col_idx - col[:, None] + (NA_WIN_COLS - 1)
    row_start = jnp.clip(jnp.arange(rows) - kr // 2, 0, rows - kr)

    def one_row(r):
        rs = row_start[r]
        k_nb = lax.dynamic_slice_in_dim(kg, rs, kr, axis=1)[:, :, col_idx]
        v_nb = lax.dynamic_slice_in_dim(vg, rs, kr, axis=1)[:, :, col_idx]
        q_r = lax.dynamic_index_in_dim(qg, r, axis=1, keepdims=False)
        dr = rs + jnp.arange(kr) - r + (NA_WIN_ROWS - 1)
        bias = rpb[:, dr[None, :, None], dc[:, None, :]]
        s_nb = jnp.einsum('bqhd,bpqkhd->bhqpk', q_r, k_nb).astype(jnp.float32) * scale + bias.astype(jnp.float32)
        s_ctx = jnp.einsum('bqhd,bchd->bhqc', q_r, k_ctx).astype(jnp.float32) * scale
        p = jax.nn.softmax(jnp.concatenate([s_nb.reshape(B, NA_HEADS, GRID_W, kr * kc), s_ctx], axis=-1), axis=-1)
        p = p.astype(v.dtype)
        p_nb = p[..., :kr * kc].reshape(B, NA_HEADS, GRID_W, kr, kc)
        p_ctx = p[..., kr * kc:]
        return jnp.einsum('bhqpk,bpqkhd->bqhd', p_nb, v_nb) + jnp.einsum('bhqc,bchd->bqhd', p_ctx, v_ctx)

    o = lax.map(one_row, jnp.arange(rows))
    yl = jnp.moveaxis(o, 0, 1).reshape(B, L, -1) @ w_o
    yc = None
    if need_ctx:
        oc = dense_attend(qc[:, :, :, None], k_ctx, v_ctx, scale)
        yc = oc.reshape(B, hc.shape[1], -1) @ w_o
    return yc, yl


def sliding_window_gqa(hc, hl, w_qkv, w_o, sink, need_ctx):
    B, L, _ = hl.shape
    nq, nkv = SWA_Q_HEADS * SWA_HEAD_DIM, SWA_KV_HEADS * SWA_HEAD_DIM
    scale = SWA_HEAD_DIM ** -0.5
    sink_logits = sink.reshape(SWA_KV_HEADS, SWA_GROUP)

    def split(h):
        n = h.shape[1]
        qkv = h @ w_qkv
        q = qkv[..., :nq].reshape(B, n, SWA_KV_HEADS, SWA_GROUP, SWA_HEAD_DIM)
        k = qkv[..., nq:nq + nkv].reshape(B, n, SWA_KV_HEADS, SWA_HEAD_DIM)
        v = qkv[..., nq + nkv:].reshape(B, n, SWA_KV_HEADS, SWA_HEAD_DIM)
        return q, k, v

    q_l, k_l, v_l = split(hl)
    q_c, k_c, v_c = split(hc)
    ang_row, ang_col = axial_rope_angles(L, SWA_HEAD_DIM)
    q_l = apply_axial_rope(q_l, ang_row, ang_col)
    k_l = apply_axial_rope(k_l, ang_row, ang_col)
    pad = ((0, 0), (SWA_WINDOW, SWA_WINDOW), (0, 0), (0, 0))
    kp, vp = jnp.pad(k_l, pad), jnp.pad(v_l, pad)
    band = SWA_BLOCK + 2 * SWA_WINDOW
    n_blocks = L // SWA_BLOCK

    def one_block(n):
        start = n * SWA_BLOCK
        qb = lax.dynamic_slice_in_dim(q_l, start, SWA_BLOCK, axis=1)
        kb = lax.dynamic_slice_in_dim(kp, start, band, axis=1)
        vb = lax.dynamic_slice_in_dim(vp, start, band, axis=1)
        qpos = start + jnp.arange(SWA_BLOCK)
        kpos = start - SWA_WINDOW + jnp.arange(band)
        valid = (jnp.abs(kpos[None, :] - qpos[:, None]) <= SWA_WINDOW) & (kpos >= 0)[None, :] & (kpos < L)[None, :]
        s_band = jnp.einsum('bqkgd,bskd->bkgqs', qb, kb).astype(jnp.float32) * scale
        s_band = jnp.where(valid, s_band, -jnp.inf)
        s_ctx = jnp.einsum('bqkgd,bskd->bkgqs', qb, k_c).astype(jnp.float32) * scale
        s_sink = jnp.broadcast_to(sink_logits.astype(jnp.float32)[None, :, :, None, None], s_ctx.shape[:-1] + (1,))
        p = jax.nn.softmax(jnp.concatenate([s_sink, s_band, s_ctx], axis=-1), axis=-1).astype(v_l.dtype)
        p_band, p_ctx = p[..., 1:1 + band], p[..., 1 + band:]
        return jnp.einsum('bkgqs,bskd->bqkgd', p_band, vb) + jnp.einsum('bkgqs,bskd->bqkgd', p_ctx, v_c)

    o = lax.map(one_block, jnp.arange(n_blocks))
    yl = jnp.moveaxis(o, 0, 1).reshape(B, L, nq) @ w_o
    yc = None
    if need_ctx:
        oc = dense_attend(q_c, k_c, v_c, scale, sink_logits)
        yc = oc.reshape(B, hc.shape[1], nq) @ w_o
    return yc, yl


def latent_attention(hc, hl, w_dq, q_norm, w_uq, w_dkv, kv_norm, w_ukv, w_o, need_ctx):
    B, L, _ = hl.shape
    scale = MLA_QK_DIM ** -0.5

    def project(h):
        n = h.shape[1]
        q = (rmsnorm(h @ w_dq, q_norm) @ w_uq).reshape(B, n, MLA_HEADS, MLA_QK_DIM)
        ckv = h @ w_dkv
        kv = (rmsnorm(ckv[..., :MLA_KV_RANK], kv_norm) @ w_ukv).reshape(B, n, MLA_HEADS, MLA_NOPE_DIM + MLA_V_DIM)
        k_rope = ckv[..., MLA_KV_RANK:][:, :, None, :]
        return q, kv[..., :MLA_NOPE_DIM], k_rope, kv[..., MLA_NOPE_DIM:]

    def join_key(k_nope, k_rope):
        return jnp.concatenate([k_nope, jnp.broadcast_to(k_rope, k_nope.shape[:-1] + (MLA_ROPE_DIM,))], axis=-1)

    ang_row, ang_col = axial_rope_angles(L, MLA_ROPE_DIM)
    q_l, kn_l, kr_l, v_l = project(hl)
    q_l = jnp.concatenate([q_l[..., :MLA_NOPE_DIM], apply_axial_rope(q_l[..., MLA_NOPE_DIM:], ang_row, ang_col)], axis=-1)
    k_l = join_key(kn_l, apply_axial_rope(kr_l, ang_row, ang_col))
    q_c, kn_c, kr_c, v_c = project(hc)
    k_c = join_key(kn_c, kr_c)
    k_all = jnp.concatenate([k_l, k_c], axis=1)
    v_all = jnp.concatenate([v_l, v_c], axis=1)
    n_blocks = L // MLA_Q_BLOCK
    q_blocks = jnp.moveaxis(q_l.reshape(B, n_blocks, MLA_Q_BLOCK, MLA_HEADS, 1, MLA_QK_DIM), 1, 0)
    o = lax.map(lambda qb: dense_attend(qb, k_all, v_all, scale), q_blocks)
    yl = jnp.moveaxis(o, 0, 1).reshape(B, L, MLA_HEADS * MLA_V_DIM) @ w_o
    yc = None
    if need_ctx:
        oc = dense_attend(q_c[:, :, :, None], k_c, v_c, scale)
        yc = oc.reshape(B, hc.shape[1], MLA_HEADS * MLA_V_DIM) @ w_o
    return yc, yl


def expert_choice_ffn(h, router, w_gate, w_up, w_down):
    B, N, D = h.shape
    cap = EC_CAPACITY_FACTOR * N // N_EXPERTS
    aff = jax.nn.softmax(h.astype(jnp.float32) @ router.astype(jnp.float32), axis=-1)
    gate, idx = lax.top_k(jnp.swapaxes(aff, 1, 2), cap)
    b_idx = jnp.arange(B)[:, None]
    x_in = h[b_idx, idx.reshape(B, -1)].reshape(B, N_EXPERTS, cap, D)
    a = jnp.einsum('becd,edf->becf', x_in, w_gate)
    u = jnp.einsum('becd,edf->becf', x_in, w_up)
    y = jnp.einsum('becf,efd->becd', jax.nn.silu(a) * u, w_down) * gate[..., None].astype(h.dtype)
    return jnp.zeros_like(h).at[b_idx[:, :, None], idx].add(y)


def setup_inputs(seed: int = 0) -> dict:
    key = jax.random.key(seed)
    ks = iter(jax.random.split(key, 40))

    def nrm(shape, std):
        return std * jax.random.normal(next(ks), shape, jnp.float32)

    D = D_MODEL
    n_na = len(range(0, DEPTH, N_MIXERS))
    n_swa = len(range(1, DEPTH, N_MIXERS))
    n_mla = len(range(2, DEPTH, N_MIXERS))
    swa_cols = (SWA_Q_HEADS + 2 * SWA_KV_HEADS) * SWA_HEAD_DIM
    return {
        'x': nrm((BATCH, SEQ, D), 1.0),
        'c': nrm((BATCH, D), 1.0),
        'ctx': nrm((BATCH, CTX_LEN, D), 1.0),
        'c_ctx': nrm((D,), 1.0),
        'ada_w': nrm((DEPTH, D, 6 * D), 0.5 * D ** -0.5),
        'ada_b': nrm((DEPTH, 6 * D), 0.02),
        'norm_mix': 1.0 + nrm((DEPTH, D), 0.1),
        'norm_ffn': 1.0 + nrm((DEPTH, D), 0.1),
        'na_w_qkv': nrm((n_na, D, 3 * NA_HEADS * NA_HEAD_DIM), D ** -0.5),
        'na_w_o': nrm((n_na, NA_HEADS * NA_HEAD_DIM, D), (NA_HEADS * NA_HEAD_DIM) ** -0.5),
        'na_rpb': nrm((n_na, NA_HEADS, 2 * NA_WIN_ROWS - 1, 2 * NA_WIN_COLS - 1), 0.1),
        'swa_w_qkv': nrm((n_swa, D, swa_cols), D ** -0.5),
        'swa_w_o': nrm((n_swa, SWA_Q_HEADS * SWA_HEAD_DIM, D), (SWA_Q_HEADS * SWA_HEAD_DIM) ** -0.5),
        'swa_sink': nrm((n_swa, SWA_Q_HEADS), 0.5),
        'mla_w_dq': nrm((n_mla, D, MLA_Q_RANK), D ** -0.5),
        'mla_q_norm': 1.0 + nrm((n_mla, MLA_Q_RANK), 0.1),
        'mla_w_uq': nrm((n_mla, MLA_Q_RANK, MLA_HEADS * MLA_QK_DIM), MLA_Q_RANK ** -0.5),
        'mla_w_dkv': nrm((n_mla, D, MLA_KV_RANK + MLA_ROPE_DIM), D ** -0.5),
        'mla_kv_norm': 1.0 + nrm((n_mla, MLA_KV_RANK), 0.1),
        'mla_w_ukv': nrm((n_mla, MLA_KV_RANK, MLA_HEADS * (MLA_NOPE_DIM + MLA_V_DIM)), MLA_KV_RANK ** -0.5),
        'mla_w_o': nrm((n_mla, MLA_HEADS * MLA_V_DIM, D), (MLA_HEADS * MLA_V_DIM) ** -0.5),
        'moe_router': nrm((DEPTH, D, N_EXPERTS), D ** -0.5),
        'moe_w_gate': nrm((DEPTH, N_EXPERTS, D, EXPERT_FF), D ** -0.5),
        'moe_w_up': nrm((DEPTH, N_EXPERTS, D, EXPERT_FF), D ** -0.5),
        'moe_w_down': nrm((DEPTH, N_EXPERTS, EXPERT_FF, D), EXPERT_FF ** -0.5),
        'final_norm': 1.0 + nrm((D,), 0.1),
    }


def reference(x, c, ctx, c_ctx, ada_w, ada_b, norm_mix, norm_ffn, na_w_qkv, na_w_o, na_rpb, swa_w_qkv, swa_w_o, swa_sink, mla_w_dq, mla_q_norm, mla_w_uq, mla_w_dkv, mla_kv_norm, mla_w_ukv, mla_w_o, moe_router, moe_w_gate, moe_w_up, moe_w_down, final_norm):
    B = x.shape[0]
    xl, xc = x, ctx
    for i in range(DEPTH):
        need_ctx = i < DEPTH - 1
        ml = (jax.nn.silu(c) @ ada_w[i] + ada_b[i]).reshape(B, 6, 1, D_MODEL)
        mc = (jax.nn.silu(c_ctx) @ ada_w[i] + ada_b[i]).reshape(6, D_MODEL)
        hl = modulate(rmsnorm(xl, norm_mix[i]), ml[:, 0], ml[:, 1])
        hc = modulate(rmsnorm(xc, norm_mix[i]), mc[0], mc[1])
        kind, slot = i % N_MIXERS, i // N_MIXERS
        if kind == 0:
            yc, yl = neighborhood_attention(hc, hl, na_w_qkv[slot], na_w_o[slot], na_rpb[slot], need_ctx)
        elif kind == 1:
            yc, yl = sliding_window_gqa(hc, hl, swa_w_qkv[slot], swa_w_o[slot], swa_sink[slot], need_ctx)
        else:
            yc, yl = latent_attention(hc, hl, mla_w_dq[slot], mla_q_norm[slot], mla_w_uq[slot], mla_w_dkv[slot], mla_kv_norm[slot], mla_w_ukv[slot], mla_w_o[slot], need_ctx)
        xl = xl + ml[:, 2] * yl
        hl = modulate(rmsnorm(xl, norm_ffn[i]), ml[:, 3], ml[:, 4])
        xl = xl + ml[:, 5] * expert_choice_ffn(hl, moe_router[i], moe_w_gate[i], moe_w_up[i], moe_w_down[i])
        if need_ctx:
            xc = xc + mc[2] * yc
            hc = modulate(rmsnorm(xc, norm_ffn[i]), mc[3], mc[4])
            xc = xc + mc[5] * expert_choice_ffn(hc, moe_router[i], moe_w_gate[i], moe_w_up[i], moe_w_down[i])
    return rmsnorm(xl, final_norm)
```

```cpp
#include <hip/hip_runtime.h>
#include <cstdio>
#include <cstdint>

#ifndef MK_N_LAUNCHES
#define MK_N_LAUNCHES 1
#endif

#define GAS __attribute__((address_space(1)))
#define LAS __attribute__((address_space(3)))
typedef unsigned short bf16;
typedef float f32x4 __attribute__((ext_vector_type(4)));
typedef unsigned u32x4 __attribute__((ext_vector_type(4)));
typedef unsigned u32x2 __attribute__((ext_vector_type(2)));

constexpr int D = 1024, SEQ = 16384, NCTX = 256, R = SEQ + NCTX, NE = 16, FF = 2048;
constexpr int CAP_L = 2048, CAP_C = 32, EROWS = 2304, XROWS = NE * EROWS;
constexpr float RMS_EPS = 1e-6f;
constexpr int NPH = 1 + 9 + 10 + 12 + 9 + 1;

constexpr size_t MiB = 1u << 20;
constexpr size_t WS_CTL = 0, CTL_ZERO_BYTES = 1 * MiB;
constexpr size_t WS_MOD = 1 * MiB;
constexpr size_t WS_W_NAQKV = 2 * MiB;
constexpr size_t WS_W_NAO = 14 * MiB;
constexpr size_t WS_W_SWAQKV = 18 * MiB;
constexpr size_t WS_W_SWAO = 21 * MiB;
constexpr size_t WS_W_MLAD = 23 * MiB;
constexpr size_t WS_W_MLAUQ = 25 * MiB;
constexpr size_t WS_W_MLAUKV = 27 * MiB;
constexpr size_t WS_W_MLAO = 28 * MiB;
constexpr size_t WS_W_GU = 32 * MiB;
constexpr size_t WS_W_DN = WS_W_GU + 512 * MiB;
constexpr size_t WS_X = WS_W_DN + 256 * MiB;
constexpr size_t WS_H = WS_X + 65 * MiB;
constexpr size_t WS_QKV = WS_H + 33 * MiB;
constexpr size_t WS_CQ = WS_QKV + 98 * MiB;
constexpr size_t WS_Q = WS_CQ + 65 * MiB;
constexpr size_t WS_KV = WS_Q + 49 * MiB;
constexpr size_t WS_CQN = WS_KV + 65 * MiB;
constexpr size_t WS_CKVN = WS_CQN + 17 * MiB;
constexpr size_t WS_KROPE = WS_CKVN + 9 * MiB;
constexpr size_t WS_O = WS_KROPE + 2 * MiB;
constexpr size_t WS_AFF = WS_O + 33 * MiB;
constexpr size_t WS_ROWL = WS_AFF + 2 * MiB;
constexpr size_t WS_GATEL = WS_ROWL + 1 * MiB;
constexpr size_t WS_INV = WS_GATEL + 1 * MiB;
constexpr size_t WS_XG = WS_INV + 2 * MiB;
constexpr size_t WS_ACT = WS_XG + 72 * MiB;
constexpr size_t WS_YB = WS_ACT + 144 * MiB;
constexpr size_t WS_END = WS_YB + 72 * MiB;
static_assert(WS_END <= 2048 * MiB, "d_ws map");
constexpr int CW_BAR = 4096;

constexpr int LDS_BYTES = 147456;
constexpr int MISC_OFF = 131072 + 320;

__device__ __forceinline__ float bf2f(unsigned b) { return __uint_as_float(b << 16); }
__device__ __forceinline__ unsigned f2bf(float f) { unsigned u = __float_as_uint(f); return (u + 0x7fffu + ((u >> 16) & 1u)) >> 16; }
__device__ __forceinline__ unsigned pk2(float lo, float hi) { return f2bf(lo) | (f2bf(hi) << 16); }
__device__ __forceinline__ float wave_sum(float v) {
#pragma unroll
    for (int o = 1; o < 64; o <<= 1) v += __shfl_xor(v, o);
    return v;
}
__device__ __forceinline__ int wave_sum_i(int v) {
#pragma unroll
    for (int o = 1; o < 64; o <<= 1) v += __shfl_xor(v, o);
    return v;
}

#define XB_TMO      128
#define XB_XCNT(j)  (256  + 64 * (j))
#define XB_XSUB(j)  (1280 + 64 * (j))
#define XB_XGEN(j)  (2304 + 64 * (j))
#define XB_TOP      3328
#define XB_TOPGEN   3392
#define XCD_BAR_WORDS 3456
#define XB_SPIN_CAP (1u << 18)
__device__ __forceinline__ unsigned xb_ld(unsigned* p)              { return __hip_atomic_load(p, __ATOMIC_RELAXED, __HIP_MEMORY_SCOPE_AGENT); }
__device__ __forceinline__ unsigned xb_add(unsigned* p, unsigned v) { return __hip_atomic_fetch_add(p, v, __ATOMIC_RELAXED, __HIP_MEMORY_SCOPE_AGENT); }
__device__ __forceinline__ unsigned xb_xcc_id() { return (unsigned)__builtin_amdgcn_s_getreg((3 << 11) | 20) & 0xFu; }
#define XB_SPIN(cond, bar) do { unsigned _sp = 0; while (cond) { __builtin_amdgcn_s_sleep(1); \
    if ((++_sp & 255u) == 0u) { if (xb_ld(&(bar)[XB_TMO])) break; if (_sp > XB_SPIN_CAP) { atomicAdd(&(bar)[XB_TMO], 1u); break; } } } } while (0)
struct XcdBarrier { unsigned* bar; unsigned x; volatile LAS unsigned* st; };
__device__ __forceinline__ XcdBarrier xcd_barrier_post(unsigned* bar, volatile LAS unsigned* st) {
    XcdBarrier b; b.bar = bar; b.x = xb_xcc_id(); b.st = st;
    if (threadIdx.x == 0) (void)xb_add(&bar[XB_XCNT(b.x)], 1u);
    return b;
}
__device__ __forceinline__ void xcd_barrier_complete(unsigned* bar, unsigned x, unsigned& nloc, unsigned& nx) {
    const unsigned G = gridDim.x * gridDim.y * gridDim.z;
    unsigned sum, cnt, mine, sp = 0u;
    for (;;) {
        sum = 0u; cnt = 0u; mine = 0u;
#pragma unroll
        for (unsigned j = 0; j < 16; ++j) { const unsigned c = xb_ld(&bar[XB_XCNT(j)]); sum += c; cnt += (c > 0u) ? 1u : 0u; mine = (j == x) ? c : mine; }
        if (sum == G) break;
        __builtin_amdgcn_s_sleep(1);
        if ((++sp & 255u) == 0u) { if (xb_ld(&bar[XB_TMO])) break; if (sp > XB_SPIN_CAP) { atomicAdd(&bar[XB_TMO], 1u); break; } }
    }
    nloc = mine > 0u ? mine : 1u; nx = cnt > 0u ? cnt : 1u;
}
__device__ __forceinline__ void xcd_barrier(const XcdBarrier& b) {
    asm volatile("s_waitcnt vmcnt(0)" ::: "memory");
    __syncthreads();
    if (threadIdx.x == 0) {
        unsigned* bar = b.bar;
        __builtin_amdgcn_s_waitcnt(0);
        unsigned nloc = b.st[0], nx = b.st[1];
        if (nloc == 0u) { xcd_barrier_complete(bar, b.x, nloc, nx); b.st[0] = nloc; b.st[1] = nx; }
        const unsigned old = xb_add(&bar[XB_XSUB(b.x)], 1u);
        const unsigned gen = old / nloc;
        if (old + 1u == (gen + 1u) * nloc) {
            __builtin_amdgcn_fence(__ATOMIC_RELEASE, "agent");
            asm volatile("s_waitcnt vmcnt(0)" ::: "memory");
            const unsigned og = xb_add(&bar[XB_TOP], 1u);
            const unsigned tg = og / nx;
            if (og + 1u == (tg + 1u) * nx) xb_add(&bar[XB_TOPGEN], 1u);
            else XB_SPIN(xb_ld(&bar[XB_TOPGEN]) == tg, bar);
            __builtin_amdgcn_fence(__ATOMIC_ACQUIRE, "agent");
            xb_add(&bar[XB_XGEN(b.x)], 1u);
            asm volatile("s_waitcnt vmcnt(0)" ::: "memory");
        } else {
            XB_SPIN(xb_ld(&bar[XB_XGEN(b.x)]) == gen, bar);
            __builtin_amdgcn_fence(__ATOMIC_ACQUIRE, "agent");
            asm volatile("s_waitcnt vmcnt(0)" ::: "memory");
        }
    }
    __syncthreads();
}

struct Args { const float* in[26]; float* out; unsigned char* ws; int ph_lo, ph_hi, li, pad; };
struct Ctx {
    const float* in[26]; float* out; unsigned char* ws;
    LAS unsigned char* lds;
    int tid, lane, wave, blk, G;
};
#define WSP(T, off) ((T*)(C.ws + (off)))
__device__ __forceinline__ const float* modp(const Ctx& C, int l, int set, int j) { return (const float*)(C.ws + WS_MOD) + ((l * 2 + set) * 6 + j) * D; }

__device__ __forceinline__ void p0_transpose_item(const float* W, int K, int N, bf16* WT, int k0, int n0, int drow0, LAS float* scr, int lane) {
#pragma unroll 8
    for (int i = 0; i < 32; ++i) { const int kk = 2 * i + (lane >> 5); scr[kk * 33 + (lane & 31)] = W[(size_t)(k0 + kk) * N + n0 + (lane & 31)]; }
    asm volatile("s_waitcnt lgkmcnt(0)" ::: "memory");
    const int c = lane & 7;
#pragma unroll
    for (int j = 0; j < 4; ++j) { const int n = (lane >> 3) + 8 * j; const LAS float* s = scr + (8 * c) * 33 + n;
        u32x4 o; o.x = pk2(s[0 * 33], s[1 * 33]); o.y = pk2(s[2 * 33], s[3 * 33]); o.z = pk2(s[4 * 33], s[5 * 33]); o.w = pk2(s[6 * 33], s[7 * 33]);
        *(u32x4*)(WT + (size_t)(drow0 + n) * K + k0 + 8 * c) = o; }
    asm volatile("s_waitcnt lgkmcnt(0)" ::: "memory");
}
__device__ __forceinline__ bool p0_plain(int& r, const float* W, int K, int N, bf16* WT, int row_off, LAS float* scr, int lane) {
    const int nblk = N / 32, cnt = (K / 64) * nblk;
    if (r >= cnt) { r -= cnt; return false; }
    const int kb = r / nblk, nb = r % nblk;
    p0_transpose_item(W, K, N, WT, kb * 64, nb * 32, row_off + nb * 32, scr, lane);
    return true;
}
__device__ __forceinline__ void ph_prologue(const Ctx& C) {
    LAS float* scr = (LAS float*)(C.lds + C.wave * 16384);
    const int gw = C.blk * 8 + C.wave, NGW = C.G * 8;
    constexpr int MOE_ITEMS = 4 * 16 * 3072;
    constexpr int SMALL_ITEMS = 2 * 1536 + 2 * 512 + 768 + 512 + 256 + 144 + 384 + 256 + 512;
    for (int it = gw; it < MOE_ITEMS + SMALL_ITEMS; it += NGW) {
        if (it < MOE_ITEMS) {
            const int le = it / 3072, r2 = it % 3072, which = r2 / 1024, item = r2 % 1024, l = le / 16, e = le % 16;
            if (which < 2) {
                const float* W = (which ? C.in[23] : C.in[22]) + (size_t)le * 1024 * 2048;
                bf16* WT = WSP(bf16, WS_W_GU) + ((size_t)l * 16 + e) * 4096 * 1024;
                const int kb = item / 64, nb = item % 64, n0 = nb * 32;
                p0_transpose_item(W, 1024, 2048, WT, kb * 64, n0, (n0 >> 7) * 256 + (n0 & 127) + which * 128, scr, C.lane);
            } else {
                const float* W = C.in[24] + (size_t)le * 2048 * 1024;
                bf16* WT = WSP(bf16, WS_W_DN) + ((size_t)l * 16 + e) * 1024 * 2048;
                const int kb = item / 32, nb = item % 32;
                p0_transpose_item(W, 2048, 1024, WT, kb * 64, nb * 32, nb * 32, scr, C.lane);
            }
            continue;
        }
        int r = it - MOE_ITEMS;
        if (p0_plain(r, C.in[8], 1024, 3072, WSP(bf16, WS_W_NAQKV), 0, scr, C.lane)) continue;
        if (p0_plain(r, C.in[8] + (size_t)1024 * 3072, 1024, 3072, WSP(bf16, WS_W_NAQKV) + (size_t)3072 * 1024, 0, scr, C.lane)) continue;
        if (p0_plain(r, C.in[9], 1024, 1024, WSP(bf16, WS_W_NAO), 0, scr, C.lane)) continue;
        if (p0_plain(r, C.in[9] + (size_t)1024 * 1024, 1024, 1024, WSP(bf16, WS_W_NAO) + (size_t)1024 * 1024, 0, scr, C.lane)) continue;
        if (p0_plain(r, C.in[11], 1024, 1536, WSP(bf16, WS_W_SWAQKV), 0, scr, C.lane)) continue;
        if (p0_plain(r, C.in[12], 1024, 1024, WSP(bf16, WS_W_SWAO), 0, scr, C.lane)) continue;
        if (p0_plain(r, C.in[14], 1024, 512, WSP(bf16, WS_W_MLAD), 0, scr, C.lane)) continue;
        if (p0_plain(r, C.in[17], 1024, 288, WSP(bf16, WS_W_MLAD), 512, scr, C.lane)) continue;
        if (p0_plain(r, C.in[16], 512, 1536, WSP(bf16, WS_W_MLAUQ), 0, scr, C.lane)) continue;
        if (p0_plain(r, C.in[19], 256, 2048, WSP(bf16, WS_W_MLAUKV), 0, scr, C.lane)) continue;
        p0_plain(r, C.in[20], 1024, 1024, WSP(bf16, WS_W_MLAO), 0, scr, C.lane);
    }
    { u32x4* z = (u32x4*)(WSP(bf16, WS_W_MLAD) + (size_t)800 * 1024); const int n16 = 224 * 1024 * 2 / 16;
      for (int i = C.blk * 512 + C.tid; i < n16; i += C.G * 512) z[i] = (u32x4){0u, 0u, 0u, 0u}; }
    __syncthreads();
    LAS float* sc = (LAS float*)C.lds;
    LAS float* red = sc + 2048;
    for (int i = C.tid; i < 2048; i += 512) { const float v = (i < 1024) ? C.in[1][i] : C.in[3][i - 1024]; sc[i] = v / (1.f + __expf(-v)); }
    __syncthreads();
    for (int u = C.blk; u < 4 * 96; u += C.G) {
        const int l = u / 96, j0 = (u % 96) * 64, kq = C.tid >> 6, jj = C.tid & 63;
        const float* W = C.in[4] + (size_t)l * 1024 * 6144 + j0 + jj;
        float a0 = 0.f, a1 = 0.f;
#pragma unroll 8
        for (int k = kq * 128; k < kq * 128 + 128; ++k) { const float w = W[(size_t)k * 6144]; a0 += sc[k] * w; a1 += sc[1024 + k] * w; }
        red[kq * 64 + jj] = a0; red[512 + kq * 64 + jj] = a1;
        __syncthreads();
        if (C.tid < 128) { const int set = C.tid >> 6, j = C.tid & 63; float s = 0.f;
#pragma unroll
            for (int q = 0; q < 8; ++q) s += red[set * 512 + q * 64 + j];
            const int col = j0 + j;
            ((float*)(C.ws + WS_MOD))[((l * 2 + set) * 6) * D + col] = s + C.in[5][l * 6144 + col]; }
        __syncthreads();
    }
}

template <int MODE>
__device__ __forceinline__ void ph_rowA(const Ctx& C, int l) {
    float* X = WSP(float, WS_X); bf16* H = WSP(bf16, WS_H); const int* INV = WSP(int, WS_INV); const bf16* YB = WSP(bf16, WS_YB);
    const int nrows = MODE == 1 ? SEQ : R;
    for (int t = C.blk * 8 + C.wave; t < nrows; t += C.G * 8) {
        const int set = t >= SEQ ? 1 : 0;
        const float* src = (MODE == 0 && l == 0) ? (set ? C.in[2] + (size_t)(t - SEQ) * D : C.in[0] + (size_t)t * D) : X + (size_t)t * D;
        f32x4 v[4];
#pragma unroll
        for (int j = 0; j < 4; ++j) v[j] = ((const f32x4*)src)[C.lane + 64 * j];
        if (MODE == 1 || l > 0) {
            const int lp = MODE == 1 ? 3 : l - 1;
            const int myinv = C.lane < 16 ? INV[(size_t)t * 16 + C.lane] : -1;
            f32x4 a[4];
#pragma unroll
            for (int j = 0; j < 4; ++j) a[j] = (f32x4){0.f, 0.f, 0.f, 0.f};
            for (int e = 0; e < 16; ++e) {
                const int s = __shfl(myinv, e);
                if (s >= 0) {
                    const u32x2* yr = (const u32x2*)(YB + ((size_t)e * EROWS + s) * D);
#pragma unroll
                    for (int j = 0; j < 4; ++j) { const u32x2 w = yr[C.lane + 64 * j];
                        a[j] += (f32x4){bf2f(w.x & 0xffffu), bf2f(w.x >> 16), bf2f(w.y & 0xffffu), bf2f(w.y >> 16)}; }
                }
            }
            const f32x4* g = (const f32x4*)modp(C, lp, set, 5);
#pragma unroll
            for (int j = 0; j < 4; ++j) v[j] += g[C.lane + 64 * j] * a[j];
        }
        if (MODE == 0) {
#pragma unroll
            for (int j = 0; j < 4; ++j) ((f32x4*)(X + (size_t)t * D))[C.lane + 64 * j] = v[j];
        }
        float ss = 0.f;
#pragma unroll
        for (int j = 0; j < 4; ++j) ss += (v[j].x * v[j].x + v[j].y * v[j].y) + (v[j].z * v[j].z + v[j].w * v[j].w);
        const float rstd = rsqrtf(wave_sum(ss) * (1.f / D) + RMS_EPS);
        if (MODE == 0) {
            const f32x4* w = (const f32x4*)(C.in[6] + (size_t)l * D); const f32x4* sh = (const f32x4*)modp(C, l, set, 0); const f32x4* scl = (const f32x4*)modp(C, l, set, 1);
#pragma unroll
            for (int j = 0; j < 4; ++j) { const int i = C.lane + 64 * j; const f32x4 y = v[j] * rstd * w[i] * (scl[i] + 1.f) + sh[i];
                u32x2 o; o.x = pk2(y.x, y.y); o.y = pk2(y.z, y.w); ((u32x2*)(H + (size_t)t * D))[i] = o; }
        } else {
            const f32x4* w = (const f32x4*)C.in[25];
#pragma unroll
            for (int j = 0; j < 4; ++j) { const int i = C.lane + 64 * j; ((f32x4*)(C.out + (size_t)t * D))[i] = v[j] * rstd * w[i]; }
        }
    }
}
__device__ __forceinline__ void ph_norm2(const Ctx& C, int l) {
    const float* X = WSP(float, WS_X); bf16* H = WSP(bf16, WS_H); float* AFF = WSP(float, WS_AFF);
    LAS float* Rs = (LAS float*)C.lds;
    const float* rt = C.in[21] + (size_t)l * D * NE;
    for (int i = C.tid; i < D * NE; i += 512) { const int c = i >> 4, e = i & 15; Rs[e * D + c] = rt[i]; }
    __syncthreads();
    for (int t = C.blk * 8 + C.wave; t < R; t += C.G * 8) {
        asm volatile("" ::: "memory");
        const int set = t >= SEQ ? 1 : 0;
        f32x4 v[4];
#pragma unroll
        for (int j = 0; j < 4; ++j) v[j] = ((const f32x4*)(X + (size_t)t * D))[C.lane + 64 * j];
        float ss = 0.f;
#pragma unroll
        for (int j = 0; j < 4; ++j) ss += (v[j].x * v[j].x + v[j].y * v[j].y) + (v[j].z * v[j].z + v[j].w * v[j].w);
        const float rstd = rsqrtf(wave_sum(ss) * (1.f / D) + RMS_EPS);
        const f32x4* w = (const f32x4*)(C.in[7] + (size_t)l * D); const f32x4* sh = (const f32x4*)modp(C, l, set, 3); const f32x4* scl = (const f32x4*)modp(C, l, set, 4);
#pragma unroll
        for (int j = 0; j < 4; ++j) { const int i = C.lane + 64 * j; v[j] = v[j] * rstd * w[i] * (scl[i] + 1.f) + sh[i];
            u32x2 o; o.x = pk2(v[j].x, v[j].y); o.y = pk2(v[j].z, v[j].w); ((u32x2*)(H + (size_t)t * D))[i] = o; }
        float lg[16];
#pragma unroll
        for (int e = 0; e < 16; ++e) { float s = 0.f;
#pragma unroll
            for (int j = 0; j < 4; ++j) { const f32x4 r = *(const LAS f32x4*)(Rs + e * D + 4 * (C.lane + 64 * j)); s += (v[j].x * r.x + v[j].y * r.y) + (v[j].z * r.z + v[j].w * r.w); }
            lg[e] = wave_sum(s); }
        float mx = lg[0];
#pragma unroll
        for (int e = 1; e < 16; ++e) mx = fmaxf(mx, lg[e]);
        float sum = 0.f;
#pragma unroll
        for (int e = 0; e < 16; ++e) { lg[e] = __expf(lg[e] - mx); sum += lg[e]; }
        const float inv = 1.f / sum; float mine = 0.f;
#pragma unroll
        for (int e = 0; e < 16; ++e) mine = (C.lane == e) ? lg[e] * inv : mine;
        if (C.lane < 16) AFF[(size_t)C.lane * R + t] = mine;
    }
}

__device__ __forceinline__ int block_sum_i(int v, LAS int* scr, int wave, int lane) {
    v = wave_sum_i(v);
    if (lane == 0) scr[wave] = v;
    __syncthreads();
    int t = 0;
#pragma unroll
    for (int w = 0; w < 8; ++w) t += scr[w];
    __syncthreads();
    return t;
}
__device__ __forceinline__ int block_excl_scan(int v, LAS int* scr, int wave, int lane) {
    int inc = v;
#pragma unroll
    for (int o = 1; o < 64; o <<= 1) { const int n = __shfl_up(inc, o); if (lane >= o) inc += n; }
    if (lane == 63) scr[wave] = inc;
    __syncthreads();
    int off = 0;
#pragma unroll
    for (int w = 0; w < 8; ++w) off += (w < wave) ? scr[w] : 0;
    __syncthreads();
    return off + inc - v;
}
template <int KPT>
__device__ __forceinline__ void topk_unit(const Ctx& C, int e, int base, int n, int cap, int slot0) {
    const float* aff = WSP(float, WS_AFF) + (size_t)e * R + base;
    int* rowl = WSP(int, WS_ROWL) + e * EROWS; float* gatel = WSP(float, WS_GATEL) + e * EROWS; int* INV = WSP(int, WS_INV);
    LAS int* scr = (LAS int*)C.lds;
    unsigned key[KPT];
#pragma unroll
    for (int j = 0; j < KPT; ++j) { const int t = C.tid * KPT + j; key[j] = t < n ? __float_as_uint(aff[t]) : 0u; }
    unsigned prefix = 0u;
    for (int bit = 30; bit >= 0; --bit) {
        const unsigned cand = prefix | (1u << bit); int c = 0;
#pragma unroll
        for (int j = 0; j < KPT; ++j) c += key[j] >= cand ? 1 : 0;
        if (block_sum_i(c, scr, C.wave, C.lane) >= cap) prefix = cand;
    }
    int cg = 0, ce = 0;
#pragma unroll
    for (int j = 0; j < KPT; ++j) { cg += key[j] > prefix ? 1 : 0; ce += key[j] == prefix ? 1 : 0; }
    const int need_eq = cap - block_sum_i(cg, scr, C.wave, C.lane);
    int eqr = block_excl_scan(ce, scr, C.wave, C.lane);
    int nsel = 0; unsigned selmask = 0u;
#pragma unroll
    for (int j = 0; j < KPT; ++j) { bool s = key[j] > prefix; if (key[j] == prefix) { s = eqr < need_eq; ++eqr; } if (s) { ++nsel; selmask |= 1u << j; } }
    int slot = block_excl_scan(nsel, scr, C.wave, C.lane);
#pragma unroll
    for (int j = 0; j < KPT; ++j) { const int t = C.tid * KPT + j;
        if (t < n) {
            if ((selmask >> j) & 1u) { rowl[slot0 + slot] = base + t; gatel[slot0 + slot] = __uint_as_float(key[j]); INV[(size_t)(base + t) * 16 + e] = slot0 + slot; ++slot; }
            else INV[(size_t)(base + t) * 16 + e] = -1;
        } }
}
__device__ __forceinline__ void ph_topk(const Ctx& C) {
    for (int u = C.blk; u < 32; u += C.G) {
        const int e = u & 15;
        if (u < 16) { topk_unit<32>(C, e, 0, SEQ, CAP_L, 0);
            int* rowl = WSP(int, WS_ROWL) + e * EROWS; float* gatel = WSP(float, WS_GATEL) + e * EROWS;
            for (int i = CAP_L + CAP_C + C.tid; i < EROWS; i += 512) { rowl[i] = -1; gatel[i] = 0.f; } }
        else topk_unit<1>(C, e, SEQ, NCTX, CAP_C, CAP_L);
        __syncthreads();
    }
}
__device__ __forceinline__ void ph_gather(const Ctx& C) {
    const int* rowl = WSP(int, WS_ROWL); const bf16* H = WSP(bf16, WS_H); bf16* XG = WSP(bf16, WS_XG);
    for (int r = C.blk * 8 + C.wave; r < XROWS; r += C.G * 8) {
        const int src = rowl[r];
        u32x4* d = (u32x4*)(XG + (size_t)r * D);
        if (src >= 0) { const u32x4* s = (const u32x4*)(H + (size_t)src * D); d[C.lane] = s[C.lane]; d[C.lane + 64] = s[C.lane + 64]; }
        else { d[C.lane] = (u32x4){0u, 0u, 0u, 0u}; d[C.lane + 64] = (u32x4){0u, 0u, 0u, 0u}; }
    }
}
__device__ __forceinline__ void rot_angles(int t, int half, int d, int quarter, float& cs, float& sn) {
    const float invf = exp2f(-(float)d * (13.287712379549449f / (float)quarter));
    const float pos = half ? (float)(t & 63) : (float)(t >> 6);
    const float ang = pos * invf;
    const double rev = (double)ang * 0.15915494309189535; const float fr = (float)(rev - __builtin_rint(rev));
    cs = __builtin_amdgcn_cosf(fr); sn = __builtin_amdgcn_sinf(fr);
}
__device__ __forceinline__ void ph_rope(const Ctx& C, bf16* buf, int pitch, int nheads, int head_stride, int off, int quarter) {
    const int per_tok = nheads * 2 * quarter; const long total = (long)SEQ * per_tok;
    for (long i = (long)C.blk * 512 + C.tid; i < total; i += (long)C.G * 512) {
        const int t = (int)(i / per_tok), r = (int)(i % per_tok), h = r / (2 * quarter), p = r % (2 * quarter), half = p / quarter, d = p % quarter;
        float cs, sn; rot_angles(t, half, d, quarter, cs, sn);
        bf16* b = buf + (size_t)t * pitch + h * head_stride + off + half * 2 * quarter + d;
        const float x1 = bf2f(b[0]), x2 = bf2f(b[quarter]);
        b[0] = (bf16)f2bf(x1 * cs - x2 * sn); b[quarter] = (bf16)f2bf(x1 * sn + x2 * cs);
    }
}
__device__ __forceinline__ void ph_mlanorm(const Ctx& C) {
    const float* CQ = WSP(float, WS_CQ); bf16* CQN = WSP(bf16, WS_CQN); bf16* CKVN = WSP(bf16, WS_CKVN); bf16* KR = WSP(bf16, WS_KROPE);
    for (int t = C.blk * 8 + C.wave; t < R; t += C.G * 8) {
        const float* row = CQ + (size_t)t * D;
        const f32x4 a0 = ((const f32x4*)row)[C.lane], a1 = ((const f32x4*)row)[C.lane + 64], b0 = ((const f32x4*)(row + 512))[C.lane];
        const float sa = wave_sum((a0.x * a0.x + a0.y * a0.y) + (a0.z * a0.z + a0.w * a0.w) + (a1.x * a1.x + a1.y * a1.y) + (a1.z * a1.z + a1.w * a1.w));
        const float sb = wave_sum((b0.x * b0.x + b0.y * b0.y) + (b0.z * b0.z + b0.w * b0.w));
        const float ra = rsqrtf(sa * (1.f / 512.f) + RMS_EPS), rb = rsqrtf(sb * (1.f / 256.f) + RMS_EPS);
        const f32x4* gq = (const f32x4*)C.in[15]; const f32x4* gk = (const f32x4*)C.in[18];
        { const f32x4 y0 = a0 * ra * gq[C.lane], y1 = a1 * ra * gq[C.lane + 64], z = b0 * rb * gk[C.lane];
          u32x2 o; o.x = pk2(y0.x, y0.y); o.y = pk2(y0.z, y0.w); ((u32x2*)(CQN + (size_t)t * 512))[C.lane] = o;
          o.x = pk2(y1.x, y1.y); o.y = pk2(y1.z, y1.w); ((u32x2*)(CQN + (size_t)t * 512))[C.lane + 64] = o;
          o.x = pk2(z.x, z.y); o.y = pk2(z.z, z.w); ((u32x2*)(CKVN + (size_t)t * 256))[C.lane] = o; }
        const float x = row[768 + (C.lane & 31)];
        const float xp = __shfl_xor(x, 8);
        float y = x;
        if (t < SEQ) { float cs, sn; rot_angles(t, (C.lane >> 4) & 1, C.lane & 7, 8, cs, sn);
            y = ((C.lane >> 3) & 1) ? (xp * sn + x * cs) : (x * cs - xp * sn); }
        if (C.lane < 32) KR[(size_t)t * 32 + C.lane] = (bf16)f2bf(y);
    }
}

struct EpiStoreBf16 { static constexpr bool DUAL = false; bf16* O; int ldc;
    __device__ __forceinline__ void elem(int row, int col, float v, float) const { O[(size_t)row * ldc + col] = (bf16)f2bf(v); } };
struct EpiStoreF32 { static constexpr bool DUAL = false; float* O; int ldc;
    __device__ __forceinline__ void elem(int row, int col, float v, float) const { O[(size_t)row * ldc + col] = v; } };
struct EpiResid { static constexpr bool DUAL = false; float* X; const float* g_lat; const float* g_ctx;
    __device__ __forceinline__ void elem(int row, int col, float v, float) const { const float g = row >= SEQ ? g_ctx[col] : g_lat[col]; X[(size_t)row * D + col] += g * v; } };
struct EpiSwiglu { static constexpr bool DUAL = true; bf16* ACT;
    __device__ __forceinline__ void elem(int row, int col, float g, float u) const { ACT[(size_t)row * FF + col] = (bf16)f2bf(g / (1.f + __expf(-g)) * u); } };
struct EpiMoeOut { static constexpr bool DUAL = false; bf16* YB; const float* gatel;
    __device__ __forceinline__ void elem(int row, int col, float v, float) const { YB[(size_t)row * D + col] = (bf16)f2bf(v * gatel[row]); } };

template <class Epi>
__device__ __forceinline__ void naive_gemm(const Ctx& C, const bf16* A, const bf16* Bt, int M, int N, int K, int pm_per_grp, size_t grp_stride, const Epi& E) {
    LAS float* As = (LAS float*)C.lds;
    LAS float* Bs = As + 16 * 132;
    LAS float* Bs2 = Bs + 16 * 68;
    const int NO = Epi::DUAL ? N / 2 : N, tn_cnt = NO / 64, nun = (M / 128) * tn_cnt;
    const int ty = C.tid >> 4, tx = C.tid & 15;
    for (int u = C.blk; u < nun; u += C.G) {
        const int tm = u / tn_cnt, tn = u % tn_cnt, row0 = tm * 128, oc0 = tn * 64;
        const bf16* Bg = Bt + (pm_per_grp ? (size_t)((row0 / 256) / pm_per_grp) * grp_stride : (size_t)0);
        const int brow0 = Epi::DUAL ? ((oc0 >> 7) * 256 + (oc0 & 127)) : oc0;
        float acc[4][4], acc2[4][4];
#pragma unroll
        for (int i = 0; i < 4; ++i)
#pragma unroll
            for (int j = 0; j < 4; ++j) { acc[i][j] = 0.f; acc2[i][j] = 0.f; }
        for (int k0 = 0; k0 < K; k0 += 16) {
            __syncthreads();
            { const int r = C.tid >> 2, kc = (C.tid & 3) * 4;
              const u32x2 w = *(const u32x2*)(A + (size_t)(row0 + r) * K + k0 + kc);
              As[(kc + 0) * 132 + r] = bf2f(w.x & 0xffffu); As[(kc + 1) * 132 + r] = bf2f(w.x >> 16); As[(kc + 2) * 132 + r] = bf2f(w.y & 0xffffu); As[(kc + 3) * 132 + r] = bf2f(w.y >> 16); }
            if (C.tid < 256) { const int r = C.tid >> 2, kc = (C.tid & 3) * 4;
              const u32x2 w = *(const u32x2*)(Bg + (size_t)(brow0 + r) * K + k0 + kc);
              Bs[(kc + 0) * 68 + r] = bf2f(w.x & 0xffffu); Bs[(kc + 1) * 68 + r] = bf2f(w.x >> 16); Bs[(kc + 2) * 68 + r] = bf2f(w.y & 0xffffu); Bs[(kc + 3) * 68 + r] = bf2f(w.y >> 16);
              if (Epi::DUAL) { const u32x2 w2 = *(const u32x2*)(Bg + (size_t)(brow0 + 128 + r) * K + k0 + kc);
                Bs2[(kc + 0) * 68 + r] = bf2f(w2.x & 0xffffu); Bs2[(kc + 1) * 68 + r] = bf2f(w2.x >> 16); Bs2[(kc + 2) * 68 + r] = bf2f(w2.y & 0xffffu); Bs2[(kc + 3) * 68 + r] = bf2f(w2.y >> 16); } }
            __syncthreads();
#pragma unroll
            for (int kk = 0; kk < 16; ++kk) {
                const f32x4 a = *(const LAS f32x4*)(As + kk * 132 + ty * 4), b = *(const LAS f32x4*)(Bs + kk * 68 + tx * 4);
#pragma unroll
                for (int i = 0; i < 4; ++i)
#pragma unroll
                    for (int j = 0; j < 4; ++j) acc[i][j] += a[i] * b[j];
                if (Epi::DUAL) { const f32x4 b2 = *(const LAS f32x4*)(Bs2 + kk * 68 + tx * 4);
#pragma unroll
                    for (int i = 0; i < 4; ++i)
#pragma unroll
                        for (int j = 0; j < 4; ++j) acc2[i][j] += a[i] * b2[j]; }
            }
        }
#pragma unroll
        for (int i = 0; i < 4; ++i)
#pragma unroll
            for (int j = 0; j < 4; ++j) E.elem(row0 + ty * 4 + i, oc0 + tx * 4 + j, acc[i][j], acc2[i][j]);
    }
    __syncthreads();
}

template <int KIND>
__device__ __forceinline__ void ph_attn_naive(const Ctx& C, int slot) {
    constexpr int DQK = KIND == 2 ? 96 : 64, DH = DQK / 2;
    LAS float* Ks = (LAS float*)C.lds;
    LAS float* Vs = Ks + 32 * DQK;
    LAS float* Bsm = Vs + 32 * 64;
    const bf16 *Qb, *Kb, *Vb, *KRb = nullptr; int qp, kp, vp, qhs, khs, vhs, kgrp = 1; float scale;
    if (KIND == 0) { Qb = WSP(bf16, WS_QKV); Kb = Qb + 1024; Vb = Qb + 2048; qp = kp = vp = 3072; qhs = khs = vhs = 64; scale = 0.125f; }
    else if (KIND == 1) { Qb = WSP(bf16, WS_QKV); Kb = Qb + 1024; Vb = Qb + 1280; qp = kp = vp = 1536; qhs = khs = vhs = 64; kgrp = 4; scale = 0.125f; }
    else { Qb = WSP(bf16, WS_Q); Kb = WSP(bf16, WS_KV); Vb = Kb + 64; KRb = WSP(bf16, WS_KROPE); qp = 1536; kp = vp = 2048; qhs = 96; khs = vhs = 128; scale = 0.10206207261596575f; }
    bf16* Ob = WSP(bf16, WS_O);
    const int half = C.tid & 1, qi = C.tid >> 1;
    for (int u = C.blk; u < 1040; u += C.G) {
        const bool isctx = u >= 1024;
        const int h = isctx ? (u - 1024) : (u & 15), q0 = isctx ? SEQ : (u >> 4) * 256, kh = h / kgrp;
        const int t = q0 + qi;
        float q[DH], o[32];
        { const bf16* qr = Qb + (size_t)t * qp + h * qhs + half * DH;
#pragma unroll
          for (int d = 0; d < DH; d += 8) { const u32x4 w = *(const u32x4*)(qr + d);
              q[d + 0] = bf2f(w.x & 0xffffu); q[d + 1] = bf2f(w.x >> 16); q[d + 2] = bf2f(w.y & 0xffffu); q[d + 3] = bf2f(w.y >> 16);
              q[d + 4] = bf2f(w.z & 0xffffu); q[d + 5] = bf2f(w.z >> 16); q[d + 6] = bf2f(w.w & 0xffffu); q[d + 7] = bf2f(w.w >> 16); } }
#pragma unroll
        for (int d = 0; d < 32; ++d) o[d] = 0.f;
        float m = -INFINITY, l = 0.f;
        if (KIND == 1) { m = C.in[13][h]; l = 1.f; }
        int klo = 0, khi = 0;
        if (!isctx) {
            if (KIND == 0) { const int r0 = q0 >> 6; const int ra = r0 - 4 < 0 ? 0 : r0 - 4, rb = r0 + 7 > 255 ? 255 : r0 + 7; klo = ra * 64; khi = (rb + 1) * 64; }
            else if (KIND == 1) { klo = q0 - 128 < 0 ? 0 : q0 - 128; khi = q0 + 384 > SEQ ? SEQ : q0 + 384; }
            else { klo = 0; khi = SEQ; }
        }
        if (KIND == 0) { __syncthreads(); const float* rp = C.in[10] + ((size_t)slot * 16 + h) * 465; for (int i = C.tid; i < 465; i += 512) Bsm[i] = rp[i]; }
        const int qr_ = t >> 6, qc_ = t & 63;
        int rs = qr_ - 4; rs = rs < 0 ? 0 : (rs > 248 ? 248 : rs);
        int cs0 = qc_ - 8; cs0 = cs0 < 0 ? 0 : (cs0 > 48 ? 48 : cs0);
        for (int seg = 0; seg < 2; ++seg) {
            const int kb = seg == 0 ? klo : SEQ, ke = seg == 0 ? khi : R;
            for (int k0 = kb; k0 < ke; k0 += 32) {
                __syncthreads();
                for (int i = C.tid; i < 32 * DQK; i += 512) { const int j = i / DQK, d = i % DQK; const int row = k0 + j;
                    unsigned b;
                    if (KIND == 2 && d >= 64) b = KRb[(size_t)row * 32 + (d - 64)]; else b = Kb[(size_t)row * kp + kh * khs + d];
                    Ks[i] = bf2f(b); }
                for (int i = C.tid; i < 32 * 64; i += 512) { const int j = i >> 6, d = i & 63; Vs[i] = bf2f(Vb[(size_t)(k0 + j) * vp + kh * vhs + d]); }
                __syncthreads();
#pragma unroll 1
                for (int j = 0; j < 32; ++j) {
                    const int kt = k0 + j; bool valid = true; float bias = 0.f;
                    if (seg == 0) {
                        if (KIND == 0) { const int kr = kt >> 6, kc = kt & 63; valid = kr >= rs && kr < rs + 8 && kc >= cs0 && kc < cs0 + 16;
                            if (valid) bias = Bsm[(kr - qr_ + 7) * 31 + (kc - qc_ + 15)]; }
                        else if (KIND == 1) { const int dd = kt - t; valid = dd <= 128 && dd >= -128; }
                    }
                    float s0 = 0.f, s1 = 0.f;
#pragma unroll
                    for (int d = 0; d < DH; d += 4) { const f32x4 kv = *(const LAS f32x4*)(Ks + j * DQK + half * DH + d); s0 += q[d] * kv.x + q[d + 2] * kv.z; s1 += q[d + 1] * kv.y + q[d + 3] * kv.w; }
                    float sp = s0 + s1; sp += __shfl_xor(sp, 1);
                    if (valid) {
                        const float s = sp * scale + bias;
                        if (s > m) { const float a = __expf(m - s); l *= a;
#pragma unroll
                            for (int d = 0; d < 32; ++d) o[d] *= a;
                            m = s; }
                        const float p = __expf(s - m); l += p;
#pragma unroll
                        for (int d = 0; d < 32; d += 4) { const f32x4 vv = *(const LAS f32x4*)(Vs + j * 64 + half * 32 + d); o[d] += p * vv.x; o[d + 1] += p * vv.y; o[d + 2] += p * vv.z; o[d + 3] += p * vv.w; }
                    }
                }
            }
        }
        { const float il = 1.f / l; bf16* orow = Ob + (size_t)t * D + h * 64 + half * 32;
#pragma unroll
            for (int d = 0; d < 32; d += 8) { u32x4 w; w.x = pk2(o[d] * il, o[d + 1] * il); w.y = pk2(o[d + 2] * il, o[d + 3] * il); w.z = pk2(o[d + 4] * il, o[d + 5] * il); w.w = pk2(o[d + 6] * il, o[d + 7] * il);
                *(u32x4*)(orow + d) = w; } }
    }
    __syncthreads();
}

#define PH_BEGIN if (lo <= ph && ph < hi) {
#define PH_END   if (ph + 1 < hi) xcd_barrier(bar); } ++ph;
template <int L>
__device__ __forceinline__ void layer_phases(const Ctx& C, const XcdBarrier& bar, int lo, int hi, int& ph) {
    constexpr int l = L, kind = L % 3, slot = L / 3;
    PH_BEGIN ph_rowA<0>(C, l); PH_END
    if constexpr (kind == 0) {
        PH_BEGIN naive_gemm(C, WSP(bf16, WS_H), WSP(bf16, WS_W_NAQKV) + (size_t)slot * 3072 * 1024, R, 3072, 1024, 0, 0, EpiStoreBf16{WSP(bf16, WS_QKV), 3072}); PH_END
        PH_BEGIN ph_attn_naive<0>(C, slot); PH_END
    } else if constexpr (kind == 1) {
        PH_BEGIN naive_gemm(C, WSP(bf16, WS_H), WSP(bf16, WS_W_SWAQKV), R, 1536, 1024, 0, 0, EpiStoreBf16{WSP(bf16, WS_QKV), 1536}); PH_END
        PH_BEGIN ph_rope(C, WSP(bf16, WS_QKV), 1536, 20, 64, 0, 16); PH_END
        PH_BEGIN ph_attn_naive<1>(C, slot); PH_END
    } else {
        PH_BEGIN naive_gemm(C, WSP(bf16, WS_H), WSP(bf16, WS_W_MLAD), R, 1024, 1024, 0, 0, EpiStoreF32{WSP(float, WS_CQ), 1024}); PH_END
        PH_BEGIN ph_mlanorm(C); PH_END
        PH_BEGIN naive_gemm(C, WSP(bf16, WS_CQN), WSP(bf16, WS_W_MLAUQ), R, 1536, 512, 0, 0, EpiStoreBf16{WSP(bf16, WS_Q), 1536});
                 naive_gemm(C, WSP(bf16, WS_CKVN), WSP(bf16, WS_W_MLAUKV), R, 2048, 256, 0, 0, EpiStoreBf16{WSP(bf16, WS_KV), 2048}); PH_END
        PH_BEGIN ph_rope(C, WSP(bf16, WS_Q), 1536, 16, 96, 64, 8); PH_END
        PH_BEGIN ph_attn_naive<2>(C, slot); PH_END
    }
    const bf16* wo = kind == 0 ? WSP(bf16, WS_W_NAO) + (size_t)slot * 1024 * 1024 : (kind == 1 ? WSP(bf16, WS_W_SWAO) : WSP(bf16, WS_W_MLAO));
    PH_BEGIN naive_gemm(C, WSP(bf16, WS_O), wo, R, 1024, 1024, 0, 0, EpiResid{WSP(float, WS_X), modp(C, l, 0, 2), modp(C, l, 1, 2)}); PH_END
    PH_BEGIN ph_norm2(C, l); PH_END
    PH_BEGIN ph_topk(C); PH_END
    PH_BEGIN ph_gather(C); PH_END
    PH_BEGIN naive_gemm(C, WSP(bf16, WS_XG), WSP(bf16, WS_W_GU) + (size_t)l * 16 * 4096 * 1024, XROWS, 4096, 1024, 9, (size_t)4096 * 1024, EpiSwiglu{WSP(bf16, WS_ACT)}); PH_END
    PH_BEGIN naive_gemm(C, WSP(bf16, WS_ACT), WSP(bf16, WS_W_DN) + (size_t)l * 16 * 1024 * 2048, XROWS, 1024, 2048, 9, (size_t)1024 * 2048, EpiMoeOut{WSP(bf16, WS_YB), WSP(float, WS_GATEL)}); PH_END
}
__global__ void __launch_bounds__(512, 2) fwd_kernel(Args args) {
    extern __shared__ __attribute__((aligned(16))) unsigned char lds_raw[];
    Ctx C;
#pragma unroll
    for (int i = 0; i < 26; ++i) C.in[i] = args.in[i];
    C.out = args.out; C.ws = args.ws; C.lds = (LAS unsigned char*)lds_raw;
    C.tid = threadIdx.x; C.lane = C.tid & 63; C.wave = __builtin_amdgcn_readfirstlane(C.tid >> 6); C.blk = blockIdx.x; C.G = gridDim.x;
    volatile LAS unsigned* MISC = (volatile LAS unsigned*)(C.lds + MISC_OFF);
    if (C.tid < 32) MISC[C.tid] = 0u;
    __syncthreads();
    const int lo = args.ph_lo, hi = args.ph_hi;
    XcdBarrier bar; bar.bar = (unsigned*)(C.ws + WS_CTL) + CW_BAR; bar.x = 0; bar.st = nullptr;
    if (hi - lo > 1) bar = xcd_barrier_post((unsigned*)(C.ws + WS_CTL) + CW_BAR, MISC + 8);
    int ph = 0;
    PH_BEGIN ph_prologue(C); PH_END
    layer_phases<0>(C, bar, lo, hi, ph);
    layer_phases<1>(C, bar, lo, hi, ph);
    layer_phases<2>(C, bar, lo, hi, ph);
    layer_phases<3>(C, bar, lo, hi, ph);
    PH_BEGIN ph_rowA<1>(C, 4); PH_END
}
#undef PH_BEGIN
#undef PH_END

extern "C" void kernel_launch(void* const* d_in, const int* in_sizes, int n_in, void* d_out, int out_size, void* d_ws, size_t ws_size, hipStream_t stream) {
    static int grid = 0;
    if (grid == 0) {
        if (n_in != 26 || out_size != SEQ * D || ws_size < WS_END) { fprintf(stderr, "kernel_launch: unexpected shapes (n_in %d out %d ws %zu)\n", n_in, out_size, ws_size); grid = -1; return; }
        int dev = 0, cus = 0, per_cu = 0;
        if (hipGetDevice(&dev) != hipSuccess || hipDeviceGetAttribute(&cus, hipDeviceAttributeMultiprocessorCount, dev) != hipSuccess) { grid = -1; return; }
        if (hipFuncSetAttribute((const void*)fwd_kernel, hipFuncAttributeMaxDynamicSharedMemorySize, LDS_BYTES) != hipSuccess) { fprintf(stderr, "kernel_launch: hipFuncSetAttribute failed\n"); grid = -1; return; }
        if (hipOccupancyMaxActiveBlocksPerMultiprocessor(&per_cu, (const void*)fwd_kernel, 512, LDS_BYTES) != hipSuccess || per_cu < 1) fprintf(stderr, "kernel_launch: occupancy query says %d\n", per_cu);
        (void)hipGetLastError();
        grid = cus;
    }
    if (grid < 0) return;
    if (hipMemsetAsync((char*)d_ws + WS_CTL, 0, CTL_ZERO_BYTES, stream) != hipSuccess) return;
    Args a{};
    for (int i = 0; i < 26; ++i) a.in[i] = (const float*)d_in[i];
    a.out = (float*)d_out; a.ws = (unsigned char*)d_ws; a.pad = 0;
#if MK_N_LAUNCHES == 1
    a.ph_lo = 0; a.ph_hi = NPH; a.li = 0;
    hipLaunchKernelGGL(fwd_kernel, dim3(grid), dim3(512), LDS_BYTES, stream, a);
#else
    for (int li = 0; li < NPH; ++li) { a.ph_lo = li; a.ph_hi = li + 1; a.li = li;
        hipLaunchKernelGGL(fwd_kernel, dim3(grid), dim3(512), LDS_BYTES, stream, a); }
#endif
}
```

```cpp
#include <hip/hip_runtime.h>
#include <cstdio>
#include <cstdint>

#ifndef MK_N_LAUNCHES
#define MK_N_LAUNCHES 1
#endif

#define GAS __attribute__((address_space(1)))
#define LAS __attribute__((address_space(3)))
typedef unsigned short bf16;
typedef float f32x4 __attribute__((ext_vector_type(4)));
typedef unsigned u32x4 __attribute__((ext_vector_type(4)));
typedef unsigned u32x2 __attribute__((ext_vector_type(2)));

constexpr int D = 1024, SEQ = 16384, NCTX = 256, R = SEQ + NCTX, NE = 16, FF = 2048;
constexpr int CAP_L = 2048, CAP_C = 32, EROWS = 2304, XROWS = NE * EROWS;
constexpr float RMS_EPS = 1e-6f;
constexpr int NPH = 1 + 9 + 10 + 12 + 9 + 1;

constexpr size_t MiB = 1u << 20;
constexpr size_t WS_CTL = 0, CTL_ZERO_BYTES = 1 * MiB;
constexpr size_t WS_MOD = 1 * MiB;
constexpr size_t WS_W_NAQKV = 2 * MiB;
constexpr size_t WS_W_NAO = 14 * MiB;
constexpr size_t WS_W_SWAQKV = 18 * MiB;
constexpr size_t WS_W_SWAO = 21 * MiB;
constexpr size_t WS_W_MLAD = 23 * MiB;
constexpr size_t WS_W_MLAUQ = 25 * MiB;
constexpr size_t WS_W_MLAUKV = 27 * MiB;
constexpr size_t WS_W_MLAO = 28 * MiB;
constexpr size_t WS_W_GU = 32 * MiB;
constexpr size_t WS_W_DN = WS_W_GU + 512 * MiB;
constexpr size_t WS_X = WS_W_DN + 256 * MiB;
constexpr size_t WS_H = WS_X + 65 * MiB;
constexpr size_t WS_QKV = WS_H + 33 * MiB;
constexpr size_t WS_CQ = WS_QKV + 98 * MiB;
constexpr size_t WS_Q = WS_CQ + 65 * MiB;
constexpr size_t WS_KV = WS_Q + 49 * MiB;
constexpr size_t WS_CQN = WS_KV + 65 * MiB;
constexpr size_t WS_CKVN = WS_CQN + 17 * MiB;
constexpr size_t WS_KROPE = WS_CKVN + 9 * MiB;
constexpr size_t WS_O = WS_KROPE + 2 * MiB;
constexpr size_t WS_AFF = WS_O + 33 * MiB;
constexpr size_t WS_ROWL = WS_AFF + 2 * MiB;
constexpr size_t WS_GATEL = WS_ROWL + 1 * MiB;
constexpr size_t WS_INV = WS_GATEL + 1 * MiB;
constexpr size_t WS_XG = WS_INV + 2 * MiB;
constexpr size_t WS_ACT = WS_XG + 72 * MiB;
constexpr size_t WS_YB = WS_ACT + 144 * MiB;
constexpr size_t WS_END = WS_YB + 72 * MiB;
static_assert(WS_END <= 2048 * MiB, "d_ws map");
constexpr int CW_BAR = 4096;

constexpr int LDS_BYTES = 147456;
constexpr int MISC_OFF = 131072 + 320;

__device__ __forceinline__ float bf2f(unsigned b) { return __uint_as_float(b << 16); }
__device__ __forceinline__ unsigned f2bf(float f) { unsigned u = __float_as_uint(f); return (u + 0x7fffu + ((u >> 16) & 1u)) >> 16; }
__device__ __forceinline__ unsigned pk2(float lo, float hi) { return f2bf(lo) | (f2bf(hi) << 16); }
__device__ __forceinline__ float wave_sum(float v) {
#pragma unroll
    for (int o = 1; o < 64; o <<= 1) v += __shfl_xor(v, o);
    return v;
}
__device__ __forceinline__ int wave_sum_i(int v) {
#pragma unroll
    for (int o = 1; o < 64; o <<= 1) v += __shfl_xor(v, o);
    return v;
}

#define XB_TMO      128
#define XB_XCNT(j)  (256  + 64 * (j))
#define XB_XSUB(j)  (1280 + 64 * (j))
#define XB_XGEN(j)  (2304 + 64 * (j))
#define XB_TOP      3328
#define XB_TOPGEN   3392
#define XCD_BAR_WORDS 3456
#define XB_SPIN_CAP (1u << 18)
__device__ __forceinline__ unsigned xb_ld(unsigned* p)              { return __hip_atomic_load(p, __ATOMIC_RELAXED, __HIP_MEMORY_SCOPE_AGENT); }
__device__ __forceinline__ unsigned xb_add(unsigned* p, unsigned v) { return __hip_atomic_fetch_add(p, v, __ATOMIC_RELAXED, __HIP_MEMORY_SCOPE_AGENT); }
__device__ __forceinline__ unsigned xb_xcc_id() { return (unsigned)__builtin_amdgcn_s_getreg((3 << 11) | 20) & 0xFu; }
#define XB_SPIN(cond, bar) do { unsigned _sp = 0; while (cond) { __builtin_amdgcn_s_sleep(1); \
    if ((++_sp & 255u) == 0u) { if (xb_ld(&(bar)[XB_TMO])) break; if (_sp > XB_SPIN_CAP) { atomicAdd(&(bar)[XB_TMO], 1u); break; } } } } while (0)
struct XcdBarrier { unsigned* bar; unsigned x; volatile LAS unsigned* st; };
__device__ __forceinline__ XcdBarrier xcd_barrier_post(unsigned* bar, volatile LAS unsigned* st) {
    XcdBarrier b; b.bar = bar; b.x = xb_xcc_id(); b.st = st;
    if (threadIdx.x == 0) (void)xb_add(&bar[XB_XCNT(b.x)], 1u);
    return b;
}
__device__ __forceinline__ void xcd_barrier_complete(unsigned* bar, unsigned x, unsigned& nloc, unsigned& nx) {
    const unsigned G = gridDim.x * gridDim.y * gridDim.z;
    unsigned sum, cnt, mine, sp = 0u;
    for (;;) {
        sum = 0u; cnt = 0u; mine = 0u;
#pragma unroll
        for (unsigned j = 0; j < 16; ++j) { const unsigned c = xb_ld(&bar[XB_XCNT(j)]); sum += c; cnt += (c > 0u) ? 1u : 0u; mine = (j == x) ? c : mine; }
        if (sum == G) break;
        __builtin_amdgcn_s_sleep(1);
        if ((++sp & 255u) == 0u) { if (xb_ld(&bar[XB_TMO])) break; if (sp > XB_SPIN_CAP) { atomicAdd(&bar[XB_TMO], 1u); break; } }
    }
    nloc = mine > 0u ? mine : 1u; nx = cnt > 0u ? cnt : 1u;
}
__device__ __forceinline__ void xcd_barrier(const XcdBarrier& b) {
    asm volatile("s_waitcnt vmcnt(0)" ::: "memory");
    __syncthreads();
    if (threadIdx.x == 0) {
        unsigned* bar = b.bar;
        __builtin_amdgcn_s_waitcnt(0);
        unsigned nloc = b.st[0], nx = b.st[1];
        if (nloc == 0u) { xcd_barrier_complete(bar, b.x, nloc, nx); b.st[0] = nloc; b.st[1] = nx; }
        const unsigned old = xb_add(&bar[XB_XSUB(b.x)], 1u);
        const unsigned gen = old / nloc;
        if (old + 1u == (gen + 1u) * nloc) {
            __builtin_amdgcn_fence(__ATOMIC_RELEASE, "agent");
            asm volatile("s_waitcnt vmcnt(0)" ::: "memory");
            const unsigned og = xb_add(&bar[XB_TOP], 1u);
            const unsigned tg = og / nx;
            if (og + 1u == (tg + 1u) * nx) xb_add(&bar[XB_TOPGEN], 1u);
            else XB_SPIN(xb_ld(&bar[XB_TOPGEN]) == tg, bar);
            __builtin_amdgcn_fence(__ATOMIC_ACQUIRE, "agent");
            xb_add(&bar[XB_XGEN(b.x)], 1u);
            asm volatile("s_waitcnt vmcnt(0)" ::: "memory");
        } else {
            XB_SPIN(xb_ld(&bar[XB_XGEN(b.x)]) == gen, bar);
            __builtin_amdgcn_fence(__ATOMIC_ACQUIRE, "agent");
            asm volatile("s_waitcnt vmcnt(0)" ::: "memory");
        }
    }
    __syncthreads();
}

struct Args { const float* in[26]; float* out; unsigned char* ws; int ph_lo, ph_hi, li, pad; };
struct Ctx {
    const float* in[26]; float* out; unsigned char* ws;
    LAS unsigned char* lds;
    int tid, lane, wave, blk, G;
};
#define WSP(T, off) ((T*)(C.ws + (off)))
__device__ __forceinline__ const float* modp(const Ctx& C, int l, int set, int j) { return (const float*)(C.ws + WS_MOD) + ((l * 2 + set) * 6 + j) * D; }

__device__ __forceinline__ void p0_transpose_item(const float* W, int K, int N, bf16* WT, int k0, int n0, int drow0, LAS float* scr, int lane) {
#pragma unroll 8
    for (int i = 0; i < 32; ++i) { const int kk = 2 * i + (lane >> 5); scr[kk * 33 + (lane & 31)] = W[(size_t)(k0 + kk) * N + n0 + (lane & 31)]; }
    asm volatile("s_waitcnt lgkmcnt(0)" ::: "memory");
    const int c = lane & 7;
#pragma unroll
    for (int j = 0; j < 4; ++j) { const int n = (lane >> 3) + 8 * j; const LAS float* s = scr + (8 * c) * 33 + n;
        u32x4 o; o.x = pk2(s[0 * 33], s[1 * 33]); o.y = pk2(s[2 * 33], s[3 * 33]); o.z = pk2(s[4 * 33], s[5 * 33]); o.w = pk2(s[6 * 33], s[7 * 33]);
        *(u32x4*)(WT + (size_t)(drow0 + n) * K + k0 + 8 * c) = o; }
    asm volatile("s_waitcnt lgkmcnt(0)" ::: "memory");
}
__device__ __forceinline__ bool p0_plain(int& r, const float* W, int K, int N, bf16* WT, int row_off, LAS float* scr, int lane) {
    const int nblk = N / 32, cnt = (K / 64) * nblk;
    if (r >= cnt) { r -= cnt; return false; }
    const int kb = r / nblk, nb = r % nblk;
    p0_transpose_item(W, K, N, WT, kb * 64, nb * 32, row_off + nb * 32, scr, lane);
    return true;
}
__device__ __forceinline__ void ph_prologue(const Ctx& C) {
    LAS float* scr = (LAS float*)(C.lds + C.wave * 16384);
    const int gw = C.blk * 8 + C.wave, NGW = C.G * 8;
    constexpr int MOE_ITEMS = 4 * 16 * 3072;
    constexpr int SMALL_ITEMS = 2 * 1536 + 2 * 512 + 768 + 512 + 256 + 144 + 384 + 256 + 512;
    for (int it = gw; it < MOE_ITEMS + SMALL_ITEMS; it += NGW) {
        if (it < MOE_ITEMS) {
            const int le = it / 3072, r2 = it % 3072, which = r2 / 1024, item = r2 % 1024, l = le / 16, e = le % 16;
            if (which < 2) {
                const float* W = (which ? C.in[23] : C.in[22]) + (size_t)le * 1024 * 2048;
                bf16* WT = WSP(bf16, WS_W_GU) + ((size_t)l * 16 + e) * 4096 * 1024;
                const int kb = item / 64, nb = item % 64, n0 = nb * 32;
                p0_transpose_item(W, 1024, 2048, WT, kb * 64, n0, (n0 >> 7) * 256 + (n0 & 127) + which * 128, scr, C.lane);
            } else {
                const float* W = C.in[24] + (size_t)le * 2048 * 1024;
                bf16* WT = WSP(bf16, WS_W_DN) + ((size_t)l * 16 + e) * 1024 * 2048;
                const int kb = item / 32, nb = item % 32;
                p0_transpose_item(W, 2048, 1024, WT, kb * 64, nb * 32, nb * 32, scr, C.lane);
            }
            continue;
        }
        int r = it - MOE_ITEMS;
        if (p0_plain(r, C.in[8], 1024, 3072, WSP(bf16, WS_W_NAQKV), 0, scr, C.lane)) continue;
        if (p0_plain(r, C.in[8] + (size_t)1024 * 3072, 1024, 3072, WSP(bf16, WS_W_NAQKV) + (size_t)3072 * 1024, 0, scr, C.lane)) continue;
        if (p0_plain(r, C.in[9], 1024, 1024, WSP(bf16, WS_W_NAO), 0, scr, C.lane)) continue;
        if (p0_plain(r, C.in[9] + (size_t)1024 * 1024, 1024, 1024, WSP(bf16, WS_W_NAO) + (size_t)1024 * 1024, 0, scr, C.lane)) continue;
        if (p0_plain(r, C.in[11], 1024, 1536, WSP(bf16, WS_W_SWAQKV), 0, scr, C.lane)) continue;
        if (p0_plain(r, C.in[12], 1024, 1024, WSP(bf16, WS_W_SWAO), 0, scr, C.lane)) continue;
        if (p0_plain(r, C.in[14], 1024, 512, WSP(bf16, WS_W_MLAD), 0, scr, C.lane)) continue;
        if (p0_plain(r, C.in[17], 1024, 288, WSP(bf16, WS_W_MLAD), 512, scr, C.lane)) continue;
        if (p0_plain(r, C.in[16], 512, 1536, WSP(bf16, WS_W_MLAUQ), 0, scr, C.lane)) continue;
        if (p0_plain(r, C.in[19], 256, 2048, WSP(bf16, WS_W_MLAUKV), 0, scr, C.lane)) continue;
        p0_plain(r, C.in[20], 1024, 1024, WSP(bf16, WS_W_MLAO), 0, scr, C.lane);
    }
    { u32x4* z = (u32x4*)(WSP(bf16, WS_W_MLAD) + (size_t)800 * 1024); const int n16 = 224 * 1024 * 2 / 16;
      for (int i = C.blk * 512 + C.tid; i < n16; i += C.G * 512) z[i] = (u32x4){0u, 0u, 0u, 0u}; }
    __syncthreads();
    LAS float* sc = (LAS float*)C.lds;
    LAS float* red = sc + 2048;
    for (int i = C.tid; i < 2048; i += 512) { const float v = (i < 1024) ? C.in[1][i] : C.in[3][i - 1024]; sc[i] = v / (1.f + __expf(-v)); }
    __syncthreads();
    for (int u = C.blk; u < 4 * 96; u += C.G) {
        const int l = u / 96, j0 = (u % 96) * 64, kq = C.tid >> 6, jj = C.tid & 63;
        const float* W = C.in[4] + (size_t)l * 1024 * 6144 + j0 + jj;
        float a0 = 0.f, a1 = 0.f;
#pragma unroll 8
        for (int k = kq * 128; k < kq * 128 + 128; ++k) { const float w = W[(size_t)k * 6144]; a0 += sc[k] * w; a1 += sc[1024 + k] * w; }
        red[kq * 64 + jj] = a0; red[512 + kq * 64 + jj] = a1;
        __syncthreads();
        if (C.tid < 128) { const int set = C.tid >> 6, j = C.tid & 63; float s = 0.f;
#pragma unroll
            for (int q = 0; q < 8; ++q) s += red[set * 512 + q * 64 + j];
            const int col = j0 + j;
            ((float*)(C.ws + WS_MOD))[((l * 2 + set) * 6) * D + col] = s + C.in[5][l * 6144 + col]; }
        __syncthreads();
    }
}

template <int MODE>
__device__ __forceinline__ void ph_rowA(const Ctx& C, int l) {
    float* X = WSP(float, WS_X); bf16* H = WSP(bf16, WS_H); const int* INV = WSP(int, WS_INV); const bf16* YB = WSP(bf16, WS_YB);
    const int nrows = MODE == 1 ? SEQ : R;
    for (int t = C.blk * 8 + C.wave; t < nrows; t += C.G * 8) {
        const int set = t >= SEQ ? 1 : 0;
        const float* src = (MODE == 0 && l == 0) ? (set ? C.in[2] + (size_t)(t - SEQ) * D : C.in[0] + (size_t)t * D) : X + (size_t)t * D;
        f32x4 v[4];
#pragma unroll
        for (int j = 0; j < 4; ++j) v[j] = ((const f32x4*)src)[C.lane + 64 * j];
        if (MODE == 1 || l > 0) {
            const int lp = MODE == 1 ? 3 : l - 1;
            const int myinv = C.lane < 16 ? INV[(size_t)t * 16 + C.lane] : -1;
            f32x4 a[4];
#pragma unroll
            for (int j = 0; j < 4; ++j) a[j] = (f32x4){0.f, 0.f, 0.f, 0.f};
            for (int e = 0; e < 16; ++e) {
                const int s = __shfl(myinv, e);
                if (s >= 0) {
                    const u32x2* yr = (const u32x2*)(YB + ((size_t)e * EROWS + s) * D);
#pragma unroll
                    for (int j = 0; j < 4; ++j) { const u32x2 w = yr[C.lane + 64 * j];
                        a[j] += (f32x4){bf2f(w.x & 0xffffu), bf2f(w.x >> 16), bf2f(w.y & 0xffffu), bf2f(w.y >> 16)}; }
                }
            }
            const f32x4* g = (const f32x4*)modp(C, lp, set, 5);
#pragma unroll
            for (int j = 0; j < 4; ++j) v[j] += g[C.lane + 64 * j] * a[j];
        }
        if (MODE == 0) {
#pragma unroll
            for (int j = 0; j < 4; ++j) ((f32x4*)(X + (size_t)t * D))[C.lane + 64 * j] = v[j];
        }
        float ss = 0.f;
#pragma unroll
        for (int j = 0; j < 4; ++j) ss += (v[j].x * v[j].x + v[j].y * v[j].y) + (v[j].z * v[j].z + v[j].w * v[j].w);
        const float rstd = rsqrtf(wave_sum(ss) * (1.f / D) + RMS_EPS);
        if (MODE == 0) {
            const f32x4* w = (const f32x4*)(C.in[6] + (size_t)l * D); const f32x4* sh = (const f32x4*)modp(C, l, set, 0); const f32x4* scl = (const f32x4*)modp(C, l, set, 1);
#pragma unroll
            for (int j = 0; j < 4; ++j) { const int i = C.lane + 64 * j; const f32x4 y = v[j] * rstd * w[i] * (scl[i] + 1.f) + sh[i];
                u32x2 o; o.x = pk2(y.x, y.y); o.y = pk2(y.z, y.w); ((u32x2*)(H + (size_t)t * D))[i] = o; }
        } else {
            const f32x4* w = (const f32x4*)C.in[25];
#pragma unroll
            for (int j = 0; j < 4; ++j) { const int i = C.lane + 64 * j; ((f32x4*)(C.out + (size_t)t * D))[i] = v[j] * rstd * w[i]; }
        }
    }
}
__device__ __forceinline__ void ph_norm2(const Ctx& C, int l) {
    const float* X = WSP(float, WS_X); bf16* H = WSP(bf16, WS_H); float* AFF = WSP(float, WS_AFF);
    LAS float* Rs = (LAS float*)C.lds;
    const float* rt = C.in[21] + (size_t)l * D * NE;
    for (int i = C.tid; i < D * NE; i += 512) { const int c = i >> 4, e = i & 15; Rs[e * D + c] = rt[i]; }
    __syncthreads();
    for (int t = C.blk * 8 + C.wave; t < R; t += C.G * 8) {
        asm volatile("" ::: "memory");
        const int set = t >= SEQ ? 1 : 0;
        f32x4 v[4];
#pragma unroll
        for (int j = 0; j < 4; ++j) v[j] = ((const f32x4*)(X + (size_t)t * D))[C.lane + 64 * j];
        float ss = 0.f;
#pragma unroll
        for (int j = 0; j < 4; ++j) ss += (v[j].x * v[j].x + v[j].y * v[j].y) + (v[j].z * v[j].z + v[j].w * v[j].w);
        const float rstd = rsqrtf(wave_sum(ss) * (1.f / D) + RMS_EPS);
        const f32x4* w = (const f32x4*)(C.in[7] + (size_t)l * D); const f32x4* sh = (const f32x4*)modp(C, l, set, 3); const f32x4* scl = (const f32x4*)modp(C, l, set, 4);
#pragma unroll
        for (int j = 0; j < 4; ++j) { const int i = C.lane + 64 * j; v[j] = v[j] * rstd * w[i] * (scl[i] + 1.f) + sh[i];
            u32x2 o; o.x = pk2(v[j].x, v[j].y); o.y = pk2(v[j].z, v[j].w); ((u32x2*)(H + (size_t)t * D))[i] = o; }
        float lg[16];
#pragma unroll
        for (int e = 0; e < 16; ++e) { float s = 0.f;
#pragma unroll
            for (int j = 0; j < 4; ++j) { const f32x4 r = *(const LAS f32x4*)(Rs + e * D + 4 * (C.lane + 64 * j)); s += (v[j].x * r.x + v[j].y * r.y) + (v[j].z * r.z + v[j].w * r.w); }
            lg[e] = wave_sum(s); }
        float mx = lg[0];
#pragma unroll
        for (int e = 1; e < 16; ++e) mx = fmaxf(mx, lg[e]);
        float sum = 0.f;
#pragma unroll
        for (int e = 0; e < 16; ++e) { lg[e] = __expf(lg[e] - mx); sum += lg[e]; }
        const float inv = 1.f / sum; float mine = 0.f;
#pragma unroll
        for (int e = 0; e < 16; ++e) mine = (C.lane == e) ? lg[e] * inv : mine;
        if (C.lane < 16) AFF[(size_t)C.lane * R + t] = mine;
    }
}

__device__ __forceinline__ int block_sum_i(int v, LAS int* scr, int wave, int lane) {
    v = wave_sum_i(v);
    if (lane == 0) scr[wave] = v;
    __syncthreads();
    int t = 0;
#pragma unroll
    for (int w = 0; w < 8; ++w) t += scr[w];
    __syncthreads();
    return t;
}
__device__ __forceinline__ int block_excl_scan(int v, LAS int* scr, int wave, int lane) {
    int inc = v;
#pragma unroll
    for (int o = 1; o < 64; o <<= 1) { const int n = __shfl_up(inc, o); if (lane >= o) inc += n; }
    if (lane == 63) scr[wave] = inc;
    __syncthreads();
    int off = 0;
#pragma unroll
    for (int w = 0; w < 8; ++w) off += (w < wave) ? scr[w] : 0;
    __syncthreads();
    return off + inc - v;
}
template <int KPT>
__device__ __forceinline__ void topk_unit(const Ctx& C, int e, int base, int n, int cap, int slot0) {
    const float* aff = WSP(float, WS_AFF) + (size_t)e * R + base;
    int* rowl = WSP(int, WS_ROWL) + e * EROWS; float* gatel = WSP(float, WS_GATEL) + e * EROWS; int* INV = WSP(int, WS_INV);
    LAS int* scr = (LAS int*)C.lds;
    unsigned key[KPT];
#pragma unroll
    for (int j = 0; j < KPT; ++j) { const int t = C.tid * KPT + j; key[j] = t < n ? __float_as_uint(aff[t]) : 0u; }
    unsigned prefix = 0u;
    for (int bit = 30; bit >= 0; --bit) {
        const unsigned cand = prefix | (1u << bit); int c = 0;
#pragma unroll
        for (int j = 0; j < KPT; ++j) c += key[j] >= cand ? 1 : 0;
        if (block_sum_i(c, scr, C.wave, C.lane) >= cap) prefix = cand;
    }
    int cg = 0, ce = 0;
#pragma unroll
    for (int j = 0; j < KPT; ++j) { cg += key[j] > prefix ? 1 : 0; ce += key[j] == prefix ? 1 : 0; }
    const int need_eq = cap - block_sum_i(cg, scr, C.wave, C.lane);
    int eqr = block_excl_scan(ce, scr, C.wave, C.lane);
    int nsel = 0; unsigned selmask = 0u;
#pragma unroll
    for (int j = 0; j < KPT; ++j) { bool s = key[j] > prefix; if (key[j] == prefix) { s = eqr < need_eq; ++eqr; } if (s) { ++nsel; selmask |= 1u << j; } }
    int slot = block_excl_scan(nsel, scr, C.wave, C.lane);
#pragma unroll
    for (int j = 0; j < KPT; ++j) { const int t = C.tid * KPT + j;
        if (t < n) {
            if ((selmask >> j) & 1u) { rowl[slot0 + slot] = base + t; gatel[slot0 + slot] = __uint_as_float(key[j]); INV[(size_t)(base + t) * 16 + e] = slot0 + slot; ++slot; }
            else INV[(size_t)(base + t) * 16 + e] = -1;
        } }
}
__device__ __forceinline__ void ph_topk(const Ctx& C) {
    for (int u = C.blk; u < 32; u += C.G) {
        const int e = u & 15;
        if (u < 16) { topk_unit<32>(C, e, 0, SEQ, CAP_L, 0);
            int* rowl = WSP(int, WS_ROWL) + e * EROWS; float* gatel = WSP(float, WS_GATEL) + e * EROWS;
            for (int i = CAP_L + CAP_C + C.tid; i < EROWS; i += 512) { rowl[i] = -1; gatel[i] = 0.f; } }
        else topk_unit<1>(C, e, SEQ, NCTX, CAP_C, CAP_L);
        __syncthreads();
    }
}
__device__ __forceinline__ void ph_gather(const Ctx& C) {
    const int* rowl = WSP(int, WS_ROWL); const bf16* H = WSP(bf16, WS_H); bf16* XG = WSP(bf16, WS_XG);
    for (int r = C.blk * 8 + C.wave; r < XROWS; r += C.G * 8) {
        const int src = rowl[r];
        u32x4* d = (u32x4*)(XG + (size_t)r * D);
        if (src >= 0) { const u32x4* s = (const u32x4*)(H + (size_t)src * D); d[C.lane] = s[C.lane]; d[C.lane + 64] = s[C.lane + 64]; }
        else { d[C.lane] = (u32x4){0u, 0u, 0u, 0u}; d[C.lane + 64] = (u32x4){0u, 0u, 0u, 0u}; }
    }
}
__device__ __forceinline__ void rot_angles(int t, int half, int d, int quarter, float& cs, float& sn) {
    const float invf = exp2f(-(float)d * (13.287712379549449f / (float)quarter));
    const float pos = half ? (float)(t & 63) : (float)(t >> 6);
    const float ang = pos * invf;
    const double rev = (double)ang * 0.15915494309189535; const float fr = (float)(rev - __builtin_rint(rev));
    cs = __builtin_amdgcn_cosf(fr); sn = __builtin_amdgcn_sinf(fr);
}
__device__ __forceinline__ void ph_rope(const Ctx& C, bf16* buf, int pitch, int nheads, int head_stride, int off, int quarter) {
    const int per_tok = nheads * 2 * quarter; const long total = (long)SEQ * per_tok;
    for (long i = (long)C.blk * 512 + C.tid; i < total; i += (long)C.G * 512) {
        const int t = (int)(i / per_tok), r = (int)(i % per_tok), h = r / (2 * quarter), p = r % (2 * quarter), half = p / quarter, d = p % quarter;
        float cs, sn; rot_angles(t, half, d, quarter, cs, sn);
        bf16* b = buf + (size_t)t * pitch + h * head_stride + off + half * 2 * quarter + d;
        const float x1 = bf2f(b[0]), x2 = bf2f(b[quarter]);
        b[0] = (bf16)f2bf(x1 * cs - x2 * sn); b[quarter] = (bf16)f2bf(x1 * sn + x2 * cs);
    }
}
__device__ __forceinline__ void ph_mlanorm(const Ctx& C) {
    const float* CQ = WSP(float, WS_CQ); bf16* CQN = WSP(bf16, WS_CQN); bf16* CKVN = WSP(bf16, WS_CKVN); bf16* KR = WSP(bf16, WS_KROPE);
    for (int t = C.blk * 8 + C.wave; t < R; t += C.G * 8) {
        const float* row = CQ + (size_t)t * D;
        const f32x4 a0 = ((const f32x4*)row)[C.lane], a1 = ((const f32x4*)row)[C.lane + 64], b0 = ((const f32x4*)(row + 512))[C.lane];
        const float sa = wave_sum((a0.x * a0.x + a0.y * a0.y) + (a0.z * a0.z + a0.w * a0.w) + (a1.x * a1.x + a1.y * a1.y) + (a1.z * a1.z + a1.w * a1.w));
        const float sb = wave_sum((b0.x * b0.x + b0.y * b0.y) + (b0.z * b0.z + b0.w * b0.w));
        const float ra = rsqrtf(sa * (1.f / 512.f) + RMS_EPS), rb = rsqrtf(sb * (1.f / 256.f) + RMS_EPS);
        const f32x4* gq = (const f32x4*)C.in[15]; const f32x4* gk = (const f32x4*)C.in[18];
        { const f32x4 y0 = a0 * ra * gq[C.lane], y1 = a1 * ra * gq[C.lane + 64], z = b0 * rb * gk[C.lane];
          u32x2 o; o.x = pk2(y0.x, y0.y); o.y = pk2(y0.z, y0.w); ((u32x2*)(CQN + (size_t)t * 512))[C.lane] = o;
          o.x = pk2(y1.x, y1.y); o.y = pk2(y1.z, y1.w); ((u32x2*)(CQN + (size_t)t * 512))[C.lane + 64] = o;
          o.x = pk2(z.x, z.y); o.y = pk2(z.z, z.w); ((u32x2*)(CKVN + (size_t)t * 256))[C.lane] = o; }
        const float x = row[768 + (C.lane & 31)];
        const float xp = __shfl_xor(x, 8);
        float y = x;
        if (t < SEQ) { float cs, sn; rot_angles(t, (C.lane >> 4) & 1, C.lane & 7, 8, cs, sn);
            y = ((C.lane >> 3) & 1) ? (xp * sn + x * cs) : (x * cs - xp * sn); }
        if (C.lane < 32) KR[(size_t)t * 32 + C.lane] = (bf16)f2bf(y);
    }
}

namespace pg8 {
#define PG8_LAS __attribute__((address_space(3)))
typedef unsigned short bf16_t;
typedef short bf16x8 __attribute__((ext_vector_type(8)));
typedef float f32x4 __attribute__((ext_vector_type(4)));
typedef unsigned u32x4 __attribute__((ext_vector_type(4)));
constexpr int BM = 256, BK = 64, HALF = 128, HTB = HALF * BK * 2  , STAGE_BYTES = 8 * HTB, NXCD = 8, WGM = 8;

__host__ __device__ __forceinline__ int lds_byte(int r, int c) { const int st = (r >> 4) * 2 + (c >> 5), rr = r & 15, cc = c & 31, ob = rr * 64 + cc * 2; return st * 1024 + (ob ^ (((ob >> 9) & 1) << 5)); }
__host__ __device__ __forceinline__ void stage_rc(int b, int& R, int& C) { const int st = b / 1024, sb = b % 1024, swz = sb ^ (((sb >> 9) & 1) << 5); R = (st >> 1) * 16 + swz / 64; C = (st & 1) * 32 + (swz % 64) / 2; }
__host__ __device__ __forceinline__ int perm32(int rho) { const int n = rho >> 4, i = rho & 15; return 8 * (i >> 2) + 4 * n + (i & 3); }

struct Unit { int pm, pn; };
struct Gemm { const bf16_t* A; const bf16_t* Bt; int M, N, K; int pm_per_grp; size_t grp_stride; };

struct StaticOrder {
    int nM, nN, nwg, G, c;
    __host__ __device__ void init(int M, int N, int G_, int c_) { nM = M / BM; nN = N / BM; nwg = nM * nN; G = G_; c = c_; }
    __host__ __device__ bool next(int i, Unit& u) const {
        const long L = (long)i * G + c; if (L >= nwg) return false;
        int wgid = (int)L; { const int q = nwg / NXCD, r = nwg % NXCD, xcd = wgid % NXCD, off = wgid / NXCD; wgid = (xcd < r ? xcd * (q + 1) : r * (q + 1) + (xcd - r) * q) + off; }
        const int nig = WGM * nN, gid = wgid / nig, fm = gid * WGM, gsz = (nM - fm) < WGM ? (nM - fm) : WGM;
        u.pm = fm + ((wgid % nig) % gsz); u.pn = (wgid % nig) / gsz; return true;
    }
    __device__ __forceinline__ void a_ready(const Unit&) const {}
    __device__ __forceinline__ void done(const Unit&) const {}
};

template <class Epi, class Sched, bool ALIGN_EPI = false, bool SP2 = false>
__device__ __forceinline__ void gemm_phase(PG8_LAS unsigned char* lds, const Gemm g, const Sched& S, const Epi& E) {
    const int tid = threadIdx.x, wid = __builtin_amdgcn_readfirstlane(tid >> 6), lane = tid & 63, wr = wid >> 2, wc = wid & 3, fr = lane & 15, fq = lane >> 4;
    const int K = g.K, nt = K / BK;
    unsigned voffA[2], voffB[2];
#pragma unroll
    for (int i = 0; i < 2; ++i) { int R, C; stage_rc(tid * 16 + i * 8192, R, C); const int Rb = Epi::PERM ? ((R & ~31) + perm32(R & 31)) : R;
        voffA[i] = (unsigned)(R * K + C) * 2u; voffB[i] = (unsigned)(Rb * K + C) * 2u; }
    const size_t kstep = (size_t)(BK * 2);
    const size_t hstep = (size_t)HALF * K * 2;
    const size_t tstep = 2 * hstep;
    const unsigned ldsw = (unsigned)wid * 1024u;
    const int aoff = lds_byte(wr * 64 + fr, fq * 8), boff = lds_byte(wc * 32 + fr, fq * 8);
#define PG8_SA(b, h) (((b) * 2 + (h)) * HTB)
#define PG8_SB(b, h) ((4 + (b) * 2 + (h)) * HTB)
#define PG8_STAGE(bufoff, gbase, voff) do { _Pragma("unroll") for (int _i = 0; _i < 2; ++_i) \
        __builtin_amdgcn_global_load_lds((const unsigned*)((const char*)(gbase) + (voff)[_i]), (PG8_LAS unsigned*)(lds + (bufoff) + ldsw + _i * 8192), 16, 0, 0); } while (0)
#define PG8_LDA(dst, b, h) do { _Pragma("unroll") for (int m = 0; m < 4; ++m) _Pragma("unroll") for (int k = 0; k < 2; ++k) dst[m][k] = *(const PG8_LAS bf16x8*)(lds + PG8_SA(b, h) + aoff + m * 2048 + k * 1024); } while (0)
#define PG8_LDB(dst, b, h) do { _Pragma("unroll") for (int n = 0; n < 2; ++n) _Pragma("unroll") for (int k = 0; k < 2; ++k) dst[n][k] = *(const PG8_LAS bf16x8*)(lds + PG8_SB(b, h) + boff + n * 2048 + k * 1024); } while (0)
#define PG8_MMA(ai, bj, At, Bt) do { __builtin_amdgcn_s_setprio(1); _Pragma("unroll") for (int m = 0; m < 4; ++m) _Pragma("unroll") for (int n = 0; n < 2; ++n) _Pragma("unroll") for (int k = 0; k < 2; ++k) \
        acc[ai][bj][m][n] = __builtin_amdgcn_mfma_f32_16x16x32_bf16(Bt[n][k], At[m][k], acc[ai][bj][m][n], 0, 0, 0); __builtin_amdgcn_s_setprio(0); } while (0)
#define PG8_WAIT_V(n) asm volatile("s_waitcnt vmcnt(" #n ")" ::: "memory")
#define PG8_WAIT_L(n) asm volatile("s_waitcnt lgkmcnt(" #n ")" ::: "memory")
#define PG8_BAR __builtin_amdgcn_s_barrier()
#define PG8_SCHED __builtin_amdgcn_sched_barrier(0)
    Unit cur, nxt; int ui = 0;
    if (!S.next(0, cur)) return;
    f32x4 acc[2][2][4][2];
#pragma unroll
    for (int a = 0; a < 2; ++a)
#pragma unroll
        for (int b = 0; b < 2; ++b)
#pragma unroll
            for (int m = 0; m < 4; ++m)
#pragma unroll
                for (int n = 0; n < 2; ++n) acc[a][b][m][n] = (f32x4){0.f, 0.f, 0.f, 0.f};
    bf16x8 At[4][2], B0[2][2], B1[2][2];
    const char* cA = (const char*)g.A + (size_t)cur.pm * tstep; const char* cB = (const char*)g.Bt + (g.pm_per_grp ? (size_t)(cur.pm / g.pm_per_grp) * g.grp_stride * 2 : (size_t)0) + (size_t)cur.pn * tstep;
    S.a_ready(cur);
    if constexpr (SP2) {
        PG8_STAGE(PG8_SB(0, 0), cB, voffB); PG8_STAGE(PG8_SB(0, 1), cB + hstep, voffB); PG8_STAGE(PG8_SA(0, 0), cA, voffA); PG8_STAGE(PG8_SA(0, 1), cA + hstep, voffA);
        if (wr == 1) PG8_BAR;
        PG8_WAIT_V(2); PG8_BAR;
        PG8_STAGE(PG8_SB(1, 0), cB + kstep, voffB); PG8_STAGE(PG8_SA(1, 0), cA + kstep, voffA); PG8_STAGE(PG8_SB(1, 1), cB + hstep + kstep, voffB);
        PG8_WAIT_V(6); PG8_BAR;
    } else {
        PG8_STAGE(PG8_SB(0, 0), cB, voffB); PG8_STAGE(PG8_SA(0, 0), cA, voffA); PG8_STAGE(PG8_SB(0, 1), cB + hstep, voffB); PG8_STAGE(PG8_SA(0, 1), cA + hstep, voffA);
        if (wr == 1) PG8_BAR;
        PG8_WAIT_V(4); PG8_BAR;
        PG8_STAGE(PG8_SB(1, 0), cB + kstep, voffB); PG8_STAGE(PG8_SA(1, 0), cA + kstep, voffA); PG8_STAGE(PG8_SB(1, 1), cB + hstep + kstep, voffB);
        PG8_WAIT_V(6); PG8_BAR;
    }
    for (;;) {
        const bool has_next = S.next(ui + 1, nxt);
        const char* nA = has_next ? (const char*)g.A + (size_t)nxt.pm * tstep : cA; const char* nB = has_next ? (const char*)g.Bt + (g.pm_per_grp ? (size_t)(nxt.pm / g.pm_per_grp) * g.grp_stride * 2 : (size_t)0) + (size_t)nxt.pn * tstep : cB;
        for (int t = 0; t < nt; t += 2) {
            const bool last = (t == nt - 2);
            const char* a1 = cA + (size_t)(t + 1) * kstep;
            const char* a2 = last ? nA : cA + (size_t)(t + 2) * kstep; const char* b2 = last ? nB : cB + (size_t)(t + 2) * kstep;
            const char* a3 = a2 + kstep; const char* b3 = b2 + kstep;
            if (last && has_next) S.a_ready(nxt);
            if constexpr (SP2) {
            PG8_LDB(B0, 0, 0); PG8_LDB(B1, 0, 1); PG8_SCHED; PG8_LDA(At, 0, 0); PG8_STAGE(PG8_SA(1, 1), a1 + hstep, voffA);
            PG8_WAIT_V(8); PG8_WAIT_L(0); PG8_BAR; PG8_MMA(0, 0, At, B0); PG8_MMA(0, 1, At, B1); PG8_BAR; PG8_SCHED;
            PG8_LDA(At, 0, 1); PG8_STAGE(PG8_SB(0, 0), b2, voffB); PG8_STAGE(PG8_SB(0, 1), b2 + hstep, voffB); PG8_STAGE(PG8_SA(0, 0), a2, voffA);
            PG8_WAIT_V(8); PG8_WAIT_L(0); PG8_BAR; PG8_MMA(1, 0, At, B0); PG8_MMA(1, 1, At, B1); PG8_BAR; PG8_SCHED;
            PG8_LDB(B0, 1, 0); PG8_LDB(B1, 1, 1); PG8_SCHED; PG8_LDA(At, 1, 0); PG8_STAGE(PG8_SA(0, 1), a2 + hstep, voffA);
            PG8_WAIT_V(8); PG8_WAIT_L(0); PG8_BAR; PG8_MMA(0, 0, At, B0); PG8_MMA(0, 1, At, B1); PG8_BAR; PG8_SCHED;
            PG8_LDA(At, 1, 1); PG8_STAGE(PG8_SB(1, 0), b3, voffB); PG8_STAGE(PG8_SB(1, 1), b3 + hstep, voffB); PG8_STAGE(PG8_SA(1, 0), a3, voffA);
            PG8_WAIT_V(8); PG8_WAIT_L(0); PG8_BAR; PG8_MMA(1, 0, At, B0); PG8_MMA(1, 1, At, B1); PG8_BAR; PG8_SCHED;
            } else {
            PG8_LDB(B0, 0, 0); PG8_SCHED; PG8_LDA(At, 0, 0); PG8_STAGE(PG8_SA(1, 1), a1 + hstep, voffA);
            PG8_WAIT_L(8); PG8_BAR; PG8_WAIT_L(0); PG8_MMA(0, 0, At, B0); PG8_BAR; PG8_SCHED;
            PG8_LDB(B1, 0, 1); PG8_STAGE(PG8_SB(0, 0), b2, voffB);
            PG8_BAR; PG8_WAIT_L(0); PG8_MMA(0, 1, At, B1); PG8_BAR;
            PG8_LDA(At, 0, 1); PG8_STAGE(PG8_SA(0, 0), a2, voffA);
            PG8_BAR; PG8_WAIT_L(0); PG8_MMA(1, 0, At, B0); PG8_BAR; PG8_SCHED;
            PG8_STAGE(PG8_SB(0, 1), b2 + hstep, voffB);
            PG8_WAIT_V(6); PG8_BAR; PG8_MMA(1, 1, At, B1); PG8_BAR;
            PG8_LDB(B0, 1, 0); PG8_SCHED; PG8_LDA(At, 1, 0); PG8_STAGE(PG8_SA(0, 1), a2 + hstep, voffA);
            PG8_WAIT_L(8); PG8_BAR; PG8_WAIT_L(0); PG8_MMA(0, 0, At, B0); PG8_BAR; PG8_SCHED;
            PG8_LDB(B1, 1, 1); PG8_STAGE(PG8_SB(1, 0), b3, voffB);
            PG8_BAR; PG8_WAIT_L(0); PG8_MMA(0, 1, At, B1); PG8_BAR;
            PG8_LDA(At, 1, 1); PG8_STAGE(PG8_SA(1, 0), a3, voffA);
            PG8_BAR; PG8_WAIT_L(0); PG8_MMA(1, 0, At, B0); PG8_BAR; PG8_SCHED;
            PG8_STAGE(PG8_SB(1, 1), b3 + hstep, voffB);
            PG8_WAIT_V(6); PG8_BAR; PG8_MMA(1, 1, At, B1); PG8_BAR;
            }
        }
        if constexpr (ALIGN_EPI) { if (wr == 0) PG8_BAR; }
        if constexpr (!Epi::AFTER_DRAIN) { E(acc, cur, wr, wc, fr, fq); S.done(cur); }
        if (!has_next) break;
#pragma unroll
        for (int a = 0; a < 2; ++a)
#pragma unroll
            for (int b = 0; b < 2; ++b)
#pragma unroll
                for (int m = 0; m < 4; ++m)
#pragma unroll
                    for (int n = 0; n < 2; ++n) acc[a][b][m][n] = (f32x4){0.f, 0.f, 0.f, 0.f};
        cur = nxt; cA = nA; cB = nB; ++ui;
        if constexpr (ALIGN_EPI) { if (wr == 1) PG8_BAR; }
    }
    PG8_WAIT_V(0);
    if constexpr (!ALIGN_EPI) { if (wr == 0) PG8_BAR; }
    PG8_BAR;
    if constexpr (Epi::AFTER_DRAIN) { E.fused(acc, cur, wr, wc, fr, fq, lds, wid, lane); S.done(cur); }
#undef PG8_SA
#undef PG8_SB
#undef PG8_STAGE
#undef PG8_LDA
#undef PG8_LDB
#undef PG8_MMA
#undef PG8_WAIT_V
#undef PG8_WAIT_L
#undef PG8_BAR
#undef PG8_SCHED
}
}
#ifndef USE_PG8
#define USE_PG8 1
#endif
__device__ __forceinline__ unsigned cvt_pk_bf16(float lo, float hi) { unsigned r; asm volatile("v_cvt_pk_bf16_f32 %0, %1, %2" : "=v"(r) : "v"(lo), "v"(hi)); return r; }
typedef const f32x4 (&AccRef)[2][2][4][2];
struct EpiStoreBf16 { static constexpr bool DUAL = false, PERM = true, AFTER_DRAIN = false; bf16* O; int ldc;
    __device__ __forceinline__ void elem(int row, int col, float v, float) const { O[(size_t)row * ldc + col] = (bf16)f2bf(v); }
    __device__ __forceinline__ void operator()(AccRef acc, const pg8::Unit& u, int wr, int wc, int fr, int fq) const {
        const int row0 = u.pm * 256 + wr * 64 + fr, col0 = u.pn * 256 + wc * 32 + 8 * fq;
#pragma unroll
        for (int ai = 0; ai < 2; ++ai)
#pragma unroll
            for (int m = 0; m < 4; ++m) { bf16* rowp = O + (size_t)(row0 + ai * 128 + m * 16) * ldc + col0;
#pragma unroll
                for (int bj = 0; bj < 2; ++bj) { const f32x4 v0 = acc[ai][bj][m][0], v1 = acc[ai][bj][m][1];
                    u32x4 w; w.x = cvt_pk_bf16(v0[0], v0[1]); w.y = cvt_pk_bf16(v0[2], v0[3]); w.z = cvt_pk_bf16(v1[0], v1[1]); w.w = cvt_pk_bf16(v1[2], v1[3]);
                    *(u32x4*)(rowp + bj * 128) = w; } }
    } };
struct EpiStoreF32 { static constexpr bool DUAL = false, PERM = false, AFTER_DRAIN = false; float* O; int ldc;
    __device__ __forceinline__ void elem(int row, int col, float v, float) const { O[(size_t)row * ldc + col] = v; }
    __device__ __forceinline__ void operator()(AccRef acc, const pg8::Unit& u, int wr, int wc, int fr, int fq) const {
        const int row0 = u.pm * 256 + wr * 64 + fr, col0 = u.pn * 256 + wc * 32 + 4 * fq;
#pragma unroll
        for (int ai = 0; ai < 2; ++ai)
#pragma unroll
            for (int m = 0; m < 4; ++m) { float* rowp = O + (size_t)(row0 + ai * 128 + m * 16) * ldc + col0;
#pragma unroll
                for (int bj = 0; bj < 2; ++bj)
#pragma unroll
                    for (int n = 0; n < 2; ++n) *(f32x4*)(rowp + bj * 128 + n * 16) = acc[ai][bj][m][n]; }
    } };
struct EpiResid { static constexpr bool DUAL = false, PERM = false, AFTER_DRAIN = false; float* X; const float* g_lat; const float* g_ctx;
    __device__ __forceinline__ void elem(int row, int col, float v, float) const { const float g = row >= SEQ ? g_ctx[col] : g_lat[col]; X[(size_t)row * D + col] += g * v; }
    __device__ __forceinline__ void operator()(AccRef acc, const pg8::Unit& u, int wr, int wc, int fr, int fq) const {
        const int row0 = u.pm * 256 + wr * 64 + fr, col0 = u.pn * 256 + wc * 32 + 4 * fq;
        const float* g = (u.pm * 256 >= SEQ) ? g_ctx : g_lat;
        f32x4 gv[2][2];
#pragma unroll
        for (int bj = 0; bj < 2; ++bj)
#pragma unroll
            for (int n = 0; n < 2; ++n) gv[bj][n] = *(const f32x4*)(g + col0 + bj * 128 + n * 16);
#pragma unroll
        for (int ai = 0; ai < 2; ++ai)
#pragma unroll
            for (int m = 0; m < 4; ++m) { float* rowp = X + (size_t)(row0 + ai * 128 + m * 16) * D + col0;
#pragma unroll
                for (int bj = 0; bj < 2; ++bj)
#pragma unroll
                    for (int n = 0; n < 2; ++n) { f32x4* p = (f32x4*)(rowp + bj * 128 + n * 16); *p = *p + gv[bj][n] * acc[ai][bj][m][n]; } }
    } };
__device__ __forceinline__ float silu_mul(float g, float u) { return g * __builtin_amdgcn_rcpf(1.f + __expf(-g)) * u; }
struct EpiSwiglu { static constexpr bool DUAL = true, PERM = true, AFTER_DRAIN = false; bf16* ACT;
    __device__ __forceinline__ void elem(int row, int col, float g, float u) const { ACT[(size_t)row * FF + col] = (bf16)f2bf(g / (1.f + __expf(-g)) * u); }
    __device__ __forceinline__ void operator()(AccRef acc, const pg8::Unit& u, int wr, int wc, int fr, int fq) const {
        const int row0 = u.pm * 256 + wr * 64 + fr, col0 = u.pn * 128 + wc * 32 + 8 * fq;
#pragma unroll
        for (int ai = 0; ai < 2; ++ai)
#pragma unroll
            for (int m = 0; m < 4; ++m) { bf16* rowp = ACT + (size_t)(row0 + ai * 128 + m * 16) * FF + col0;
                const f32x4 g0 = acc[ai][0][m][0], g1 = acc[ai][0][m][1], u0 = acc[ai][1][m][0], u1 = acc[ai][1][m][1];
                u32x4 w; w.x = cvt_pk_bf16(silu_mul(g0[0], u0[0]), silu_mul(g0[1], u0[1])); w.y = cvt_pk_bf16(silu_mul(g0[2], u0[2]), silu_mul(g0[3], u0[3]));
                w.z = cvt_pk_bf16(silu_mul(g1[0], u1[0]), silu_mul(g1[1], u1[1])); w.w = cvt_pk_bf16(silu_mul(g1[2], u1[2]), silu_mul(g1[3], u1[3]));
                *(u32x4*)rowp = w; }
    } };
struct EpiMoeOut { static constexpr bool DUAL = false, PERM = true, AFTER_DRAIN = false; bf16* YB; const float* gatel;
    __device__ __forceinline__ void elem(int row, int col, float v, float) const { YB[(size_t)row * D + col] = (bf16)f2bf(v * gatel[row]); }
    __device__ __forceinline__ void operator()(AccRef acc, const pg8::Unit& u, int wr, int wc, int fr, int fq) const {
        const int row0 = u.pm * 256 + wr * 64 + fr, col0 = u.pn * 256 + wc * 32 + 8 * fq;
#pragma unroll
        for (int ai = 0; ai < 2; ++ai)
#pragma unroll
            for (int m = 0; m < 4; ++m) { const int row = row0 + ai * 128 + m * 16; const float gt = gatel[row]; bf16* rowp = YB + (size_t)row * D + col0;
#pragma unroll
                for (int bj = 0; bj < 2; ++bj) { const f32x4 v0 = acc[ai][bj][m][0] * gt, v1 = acc[ai][bj][m][1] * gt;
                    u32x4 w; w.x = cvt_pk_bf16(v0[0], v0[1]); w.y = cvt_pk_bf16(v0[2], v0[3]); w.z = cvt_pk_bf16(v1[0], v1[1]); w.w = cvt_pk_bf16(v1[2], v1[3]);
                    *(u32x4*)(rowp + bj * 128) = w; } }
    } };

template <class Epi>
__device__ __forceinline__ void naive_gemm(const Ctx& C, const bf16* A, const bf16* Bt, int M, int N, int K, int pm_per_grp, size_t grp_stride, const Epi& E) {
    LAS float* As = (LAS float*)C.lds;
    LAS float* Bs = As + 16 * 132;
    LAS float* Bs2 = Bs + 16 * 68;
    const int NO = Epi::DUAL ? N / 2 : N, tn_cnt = NO / 64, nun = (M / 128) * tn_cnt;
    const int ty = C.tid >> 4, tx = C.tid & 15;
    for (int u = C.blk; u < nun; u += C.G) {
        const int tm = u / tn_cnt, tn = u % tn_cnt, row0 = tm * 128, oc0 = tn * 64;
        const bf16* Bg = Bt + (pm_per_grp ? (size_t)((row0 / 256) / pm_per_grp) * grp_stride : (size_t)0);
        const int brow0 = Epi::DUAL ? ((oc0 >> 7) * 256 + (oc0 & 127)) : oc0;
        float acc[4][4], acc2[4][4];
#pragma unroll
        for (int i = 0; i < 4; ++i)
#pragma unroll
            for (int j = 0; j < 4; ++j) { acc[i][j] = 0.f; acc2[i][j] = 0.f; }
        for (int k0 = 0; k0 < K; k0 += 16) {
            __syncthreads();
            { const int r = C.tid >> 2, kc = (C.tid & 3) * 4;
              const u32x2 w = *(const u32x2*)(A + (size_t)(row0 + r) * K + k0 + kc);
              As[(kc + 0) * 132 + r] = bf2f(w.x & 0xffffu); As[(kc + 1) * 132 + r] = bf2f(w.x >> 16); As[(kc + 2) * 132 + r] = bf2f(w.y & 0xffffu); As[(kc + 3) * 132 + r] = bf2f(w.y >> 16); }
            if (C.tid < 256) { const int r = C.tid >> 2, kc = (C.tid & 3) * 4;
              const u32x2 w = *(const u32x2*)(Bg + (size_t)(brow0 + r) * K + k0 + kc);
              Bs[(kc + 0) * 68 + r] = bf2f(w.x & 0xffffu); Bs[(kc + 1) * 68 + r] = bf2f(w.x >> 16); Bs[(kc + 2) * 68 + r] = bf2f(w.y & 0xffffu); Bs[(kc + 3) * 68 + r] = bf2f(w.y >> 16);
              if (Epi::DUAL) { const u32x2 w2 = *(const u32x2*)(Bg + (size_t)(brow0 + 128 + r) * K + k0 + kc);
                Bs2[(kc + 0) * 68 + r] = bf2f(w2.x & 0xffffu); Bs2[(kc + 1) * 68 + r] = bf2f(w2.x >> 16); Bs2[(kc + 2) * 68 + r] = bf2f(w2.y & 0xffffu); Bs2[(kc + 3) * 68 + r] = bf2f(w2.y >> 16); } }
            __syncthreads();
#pragma unroll
            for (int kk = 0; kk < 16; ++kk) {
                const f32x4 a = *(const LAS f32x4*)(As + kk * 132 + ty * 4), b = *(const LAS f32x4*)(Bs + kk * 68 + tx * 4);
#pragma unroll
                for (int i = 0; i < 4; ++i)
#pragma unroll
                    for (int j = 0; j < 4; ++j) acc[i][j] += a[i] * b[j];
                if (Epi::DUAL) { const f32x4 b2 = *(const LAS f32x4*)(Bs2 + kk * 68 + tx * 4);
#pragma unroll
                    for (int i = 0; i < 4; ++i)
#pragma unroll
                        for (int j = 0; j < 4; ++j) acc2[i][j] += a[i] * b2[j]; }
            }
        }
#pragma unroll
        for (int i = 0; i < 4; ++i)
#pragma unroll
            for (int j = 0; j < 4; ++j) E.elem(row0 + ty * 4 + i, oc0 + tx * 4 + j, acc[i][j], acc2[i][j]);
    }
    __syncthreads();
}

template <class Epi>
__device__ __forceinline__ void gemm(const Ctx& C, const bf16* A, const bf16* Bt, int M, int N, int K, int pm_per_grp, size_t grp_stride, const Epi& E) {
#if USE_PG8
    pg8::Gemm g{A, Bt, M, N, K, pm_per_grp, grp_stride}; pg8::StaticOrder S; S.init(M, N, C.G, C.blk);
    pg8::gemm_phase<Epi, pg8::StaticOrder, true, true>(C.lds, g, S, E);
#else
    naive_gemm(C, A, Bt, M, N, K, pm_per_grp, grp_stride, E);
#endif
}

template <int KIND>
__device__ __forceinline__ void ph_attn_naive(const Ctx& C, int slot) {
    constexpr int DQK = KIND == 2 ? 96 : 64, DH = DQK / 2;
    LAS float* Ks = (LAS float*)C.lds;
    LAS float* Vs = Ks + 32 * DQK;
    LAS float* Bsm = Vs + 32 * 64;
    const bf16 *Qb, *Kb, *Vb, *KRb = nullptr; int qp, kp, vp, qhs, khs, vhs, kgrp = 1; float scale;
    if (KIND == 0) { Qb = WSP(bf16, WS_QKV); Kb = Qb + 1024; Vb = Qb + 2048; qp = kp = vp = 3072; qhs = khs = vhs = 64; scale = 0.125f; }
    else if (KIND == 1) { Qb = WSP(bf16, WS_QKV); Kb = Qb + 1024; Vb = Qb + 1280; qp = kp = vp = 1536; qhs = khs = vhs = 64; kgrp = 4; scale = 0.125f; }
    else { Qb = WSP(bf16, WS_Q); Kb = WSP(bf16, WS_KV); Vb = Kb + 64; KRb = WSP(bf16, WS_KROPE); qp = 1536; kp = vp = 2048; qhs = 96; khs = vhs = 128; scale = 0.10206207261596575f; }
    bf16* Ob = WSP(bf16, WS_O);
    const int half = C.tid & 1, qi = C.tid >> 1;
    for (int u = C.blk; u < 1040; u += C.G) {
        const bool isctx = u >= 1024;
        const int h = isctx ? (u - 1024) : (u & 15), q0 = isctx ? SEQ : (u >> 4) * 256, kh = h / kgrp;
        const int t = q0 + qi;
        float q[DH], o[32];
        { const bf16* qr = Qb + (size_t)t * qp + h * qhs + half * DH;
#pragma unroll
          for (int d = 0; d < DH; d += 8) { const u32x4 w = *(const u32x4*)(qr + d);
              q[d + 0] = bf2f(w.x & 0xffffu); q[d + 1] = bf2f(w.x >> 16); q[d + 2] = bf2f(w.y & 0xffffu); q[d + 3] = bf2f(w.y >> 16);
              q[d + 4] = bf2f(w.z & 0xffffu); q[d + 5] = bf2f(w.z >> 16); q[d + 6] = bf2f(w.w & 0xffffu); q[d + 7] = bf2f(w.w >> 16); } }
#pragma unroll
        for (int d = 0; d < 32; ++d) o[d] = 0.f;
        float m = -INFINITY, l = 0.f;
        if (KIND == 1) { m = C.in[13][h]; l = 1.f; }
        int klo = 0, khi = 0;
        if (!isctx) {
            if (KIND == 0) { const int r0 = q0 >> 6; const int ra = r0 - 4 < 0 ? 0 : r0 - 4, rb = r0 + 7 > 255 ? 255 : r0 + 7; klo = ra * 64; khi = (rb + 1) * 64; }
            else if (KIND == 1) { klo = q0 - 128 < 0 ? 0 : q0 - 128; khi = q0 + 384 > SEQ ? SEQ : q0 + 384; }
            else { klo = 0; khi = SEQ; }
        }
        if (KIND == 0) { __syncthreads(); const float* rp = C.in[10] + ((size_t)slot * 16 + h) * 465; for (int i = C.tid; i < 465; i += 512) Bsm[i] = rp[i]; }
        const int qr_ = t >> 6, qc_ = t & 63;
        int rs = qr_ - 4; rs = rs < 0 ? 0 : (rs > 248 ? 248 : rs);
        int cs0 = qc_ - 8; cs0 = cs0 < 0 ? 0 : (cs0 > 48 ? 48 : cs0);
        for (int seg = 0; seg < 2; ++seg) {
            const int kb = seg == 0 ? klo : SEQ, ke = seg == 0 ? khi : R;
            for (int k0 = kb; k0 < ke; k0 += 32) {
                __syncthreads();
                for (int i = C.tid; i < 32 * DQK; i += 512) { const int j = i / DQK, d = i % DQK; const int row = k0 + j;
                    unsigned b;
                    if (KIND == 2 && d >= 64) b = KRb[(size_t)row * 32 + (d - 64)]; else b = Kb[(size_t)row * kp + kh * khs + d];
                    Ks[i] = bf2f(b); }
                for (int i = C.tid; i < 32 * 64; i += 512) { const int j = i >> 6, d = i & 63; Vs[i] = bf2f(Vb[(size_t)(k0 + j) * vp + kh * vhs + d]); }
                __syncthreads();
#pragma unroll 1
                for (int j = 0; j < 32; ++j) {
                    const int kt = k0 + j; bool valid = true; float bias = 0.f;
                    if (seg == 0) {
                        if (KIND == 0) { const int kr = kt >> 6, kc = kt & 63; valid = kr >= rs && kr < rs + 8 && kc >= cs0 && kc < cs0 + 16;
                            if (valid) bias = Bsm[(kr - qr_ + 7) * 31 + (kc - qc_ + 15)]; }
                        else if (KIND == 1) { const int dd = kt - t; valid = dd <= 128 && dd >= -128; }
                    }
                    float s0 = 0.f, s1 = 0.f;
#pragma unroll
                    for (int d = 0; d < DH; d += 4) { const f32x4 kv = *(const LAS f32x4*)(Ks + j * DQK + half * DH + d); s0 += q[d] * kv.x + q[d + 2] * kv.z; s1 += q[d + 1] * kv.y + q[d + 3] * kv.w; }
                    float sp = s0 + s1; sp += __shfl_xor(sp, 1);
                    if (valid) {
                        const float s = sp * scale + bias;
                        if (s > m) { const float a = __expf(m - s); l *= a;
#pragma unroll
                            for (int d = 0; d < 32; ++d) o[d] *= a;
                            m = s; }
                        const float p = __expf(s - m); l += p;
#pragma unroll
                        for (int d = 0; d < 32; d += 4) { const f32x4 vv = *(const LAS f32x4*)(Vs + j * 64 + half * 32 + d); o[d] += p * vv.x; o[d + 1] += p * vv.y; o[d + 2] += p * vv.z; o[d + 3] += p * vv.w; }
                    }
                }
            }
        }
        { const float il = 1.f / l; bf16* orow = Ob + (size_t)t * D + h * 64 + half * 32;
#pragma unroll
            for (int d = 0; d < 32; d += 8) { u32x4 w; w.x = pk2(o[d] * il, o[d + 1] * il); w.y = pk2(o[d + 2] * il, o[d + 3] * il); w.z = pk2(o[d + 4] * il, o[d + 5] * il); w.w = pk2(o[d + 6] * il, o[d + 7] * il);
                *(u32x4*)(orow + d) = w; } }
    }
    __syncthreads();
}

#define PH_BEGIN if (lo <= ph && ph < hi) {
#define PH_END   if (ph + 1 < hi) xcd_barrier(bar); } ++ph;
template <int L>
__device__ __forceinline__ void layer_phases(const Ctx& C, const XcdBarrier& bar, int lo, int hi, int& ph) {
    constexpr int l = L, kind = L % 3, slot = L / 3;
    PH_BEGIN ph_rowA<0>(C, l); PH_END
    if constexpr (kind == 0) {
        PH_BEGIN gemm(C, WSP(bf16, WS_H), WSP(bf16, WS_W_NAQKV) + (size_t)slot * 3072 * 1024, R, 3072, 1024, 0, 0, EpiStoreBf16{WSP(bf16, WS_QKV), 3072}); PH_END
        PH_BEGIN ph_attn_naive<0>(C, slot); PH_END
    } else if constexpr (kind == 1) {
        PH_BEGIN gemm(C, WSP(bf16, WS_H), WSP(bf16, WS_W_SWAQKV), R, 1536, 1024, 0, 0, EpiStoreBf16{WSP(bf16, WS_QKV), 1536}); PH_END
        PH_BEGIN ph_rope(C, WSP(bf16, WS_QKV), 1536, 20, 64, 0, 16); PH_END
        PH_BEGIN ph_attn_naive<1>(C, slot); PH_END
    } else {
        PH_BEGIN gemm(C, WSP(bf16, WS_H), WSP(bf16, WS_W_MLAD), R, 1024, 1024, 0, 0, EpiStoreF32{WSP(float, WS_CQ), 1024}); PH_END
        PH_BEGIN ph_mlanorm(C); PH_END
        PH_BEGIN gemm(C, WSP(bf16, WS_CQN), WSP(bf16, WS_W_MLAUQ), R, 1536, 512, 0, 0, EpiStoreBf16{WSP(bf16, WS_Q), 1536});
                 gemm(C, WSP(bf16, WS_CKVN), WSP(bf16, WS_W_MLAUKV), R, 2048, 256, 0, 0, EpiStoreBf16{WSP(bf16, WS_KV), 2048}); PH_END
        PH_BEGIN ph_rope(C, WSP(bf16, WS_Q), 1536, 16, 96, 64, 8); PH_END
        PH_BEGIN ph_attn_naive<2>(C, slot); PH_END
    }
    const bf16* wo = kind == 0 ? WSP(bf16, WS_W_NAO) + (size_t)slot * 1024 * 1024 : (kind == 1 ? WSP(bf16, WS_W_SWAO) : WSP(bf16, WS_W_MLAO));
    PH_BEGIN gemm(C, WSP(bf16, WS_O), wo, R, 1024, 1024, 0, 0, EpiResid{WSP(float, WS_X), modp(C, l, 0, 2), modp(C, l, 1, 2)}); PH_END
    PH_BEGIN ph_norm2(C, l); PH_END
    PH_BEGIN ph_topk(C); PH_END
    PH_BEGIN ph_gather(C); PH_END
    PH_BEGIN gemm(C, WSP(bf16, WS_XG), WSP(bf16, WS_W_GU) + (size_t)l * 16 * 4096 * 1024, XROWS, 4096, 1024, 9, (size_t)4096 * 1024, EpiSwiglu{WSP(bf16, WS_ACT)}); PH_END
    PH_BEGIN gemm(C, WSP(bf16, WS_ACT), WSP(bf16, WS_W_DN) + (size_t)l * 16 * 1024 * 2048, XROWS, 1024, 2048, 9, (size_t)1024 * 2048, EpiMoeOut{WSP(bf16, WS_YB), WSP(float, WS_GATEL)}); PH_END
}
__global__ void __launch_bounds__(512, 2) fwd_kernel(Args args) {
    extern __shared__ __attribute__((aligned(16))) unsigned char lds_raw[];
    Ctx C;
#pragma unroll
    for (int i = 0; i < 26; ++i) C.in[i] = args.in[i];
    C.out = args.out; C.ws = args.ws; C.lds = (LAS unsigned char*)lds_raw;
    C.tid = threadIdx.x; C.lane = C.tid & 63; C.wave = __builtin_amdgcn_readfirstlane(C.tid >> 6); C.blk = blockIdx.x; C.G = gridDim.x;
    volatile LAS unsigned* MISC = (volatile LAS unsigned*)(C.lds + MISC_OFF);
    if (C.tid < 32) MISC[C.tid] = 0u;
    __syncthreads();
    const int lo = args.ph_lo, hi = args.ph_hi;
    XcdBarrier bar; bar.bar = (unsigned*)(C.ws + WS_CTL) + CW_BAR; bar.x = 0; bar.st = nullptr;
    if (hi - lo > 1) bar = xcd_barrier_post((unsigned*)(C.ws + WS_CTL) + CW_BAR, MISC + 8);
    int ph = 0;
    PH_BEGIN ph_prologue(C); PH_END
    layer_phases<0>(C, bar, lo, hi, ph);
    layer_phases<1>(C, bar, lo, hi, ph);
    layer_phases<2>(C, bar, lo, hi, ph);
    layer_phases<3>(C, bar, lo, hi, ph);
    PH_BEGIN ph_rowA<1>(C, 4); PH_END
}
#undef PH_BEGIN
#undef PH_END

extern "C" void kernel_launch(void* const* d_in, const int* in_sizes, int n_in, void* d_out, int out_size, void* d_ws, size_t ws_size, hipStream_t stream) {
    static int grid = 0;
    if (grid == 0) {
        if (n_in != 26 || out_size != SEQ * D || ws_size < WS_END) { fprintf(stderr, "kernel_launch: unexpected shapes (n_in %d out %d ws %zu)\n", n_in, out_size, ws_size); grid = -1; return; }
        int dev = 0, cus = 0, per_cu = 0;
        if (hipGetDevice(&dev) != hipSuccess || hipDeviceGetAttribute(&cus, hipDeviceAttributeMultiprocessorCount, dev) != hipSuccess) { grid = -1; return; }
        if (hipFuncSetAttribute((const void*)fwd_kernel, hipFuncAttributeMaxDynamicSharedMemorySize, LDS_BYTES) != hipSuccess) { fprintf(stderr, "kernel_launch: hipFuncSetAttribute failed\n"); grid = -1; return; }
        if (hipOccupancyMaxActiveBlocksPerMultiprocessor(&per_cu, (const void*)fwd_kernel, 512, LDS_BYTES) != hipSuccess || per_cu < 1) fprintf(stderr, "kernel_launch: occupancy query says %d\n", per_cu);
        (void)hipGetLastError();
        grid = cus;
    }
    if (grid < 0) return;
    if (hipMemsetAsync((char*)d_ws + WS_CTL, 0, CTL_ZERO_BYTES, stream) != hipSuccess) return;
    Args a{};
    for (int i = 0; i < 26; ++i) a.in[i] = (const float*)d_in[i];
    a.out = (float*)d_out; a.ws = (unsigned char*)d_ws; a.pad = 0;
#if MK_N_LAUNCHES == 1
    a.ph_lo = 0; a.ph_hi = NPH; a.li = 0;
    hipLaunchKernelGGL(fwd_kernel, dim3(grid), dim3(512), LDS_BYTES, stream, a);
#else
    for (int li = 0; li < NPH; ++li) { a.ph_lo = li; a.ph_hi = li + 1; a.li = li;
        hipLaunchKernelGGL(fwd_kernel, dim3(grid), dim3(512), LDS_BYTES, stream, a); }
#endif
}
```

```cpp
#include <hip/hip_runtime.h>
#include <cstdio>
#include <cstdint>

#ifndef MK_N_LAUNCHES
#define MK_N_LAUNCHES 1
#endif

#define GAS __attribute__((address_space(1)))
#define LAS __attribute__((address_space(3)))
typedef unsigned short bf16;
typedef float f32x4 __attribute__((ext_vector_type(4)));
typedef unsigned u32x4 __attribute__((ext_vector_type(4)));
typedef unsigned u32x2 __attribute__((ext_vector_type(2)));

constexpr int D = 1024, SEQ = 16384, NCTX = 256, R = SEQ + NCTX, NE = 16, FF = 2048;
constexpr int CAP_L = 2048, CAP_C = 32, EROWS = 2304, XROWS = NE * EROWS;
constexpr float RMS_EPS = 1e-6f;
constexpr int NPH = 1 + 9 + 10 + 12 + 9 + 1;

constexpr size_t MiB = 1u << 20;
constexpr size_t WS_CTL = 0, CTL_ZERO_BYTES = 1 * MiB;
constexpr size_t WS_MOD = 1 * MiB;
constexpr size_t WS_W_NAQKV = 2 * MiB;
constexpr size_t WS_W_NAO = 14 * MiB;
constexpr size_t WS_W_SWAQKV = 18 * MiB;
constexpr size_t WS_W_SWAO = 21 * MiB;
constexpr size_t WS_W_MLAD = 23 * MiB;
constexpr size_t WS_W_MLAUQ = 25 * MiB;
constexpr size_t WS_W_MLAUKV = 27 * MiB;
constexpr size_t WS_W_MLAO = 28 * MiB;
constexpr size_t WS_W_GU = 32 * MiB;
constexpr size_t WS_W_DN = WS_W_GU + 512 * MiB;
constexpr size_t WS_X = WS_W_DN + 256 * MiB;
constexpr size_t WS_H = WS_X + 65 * MiB;
constexpr size_t WS_QKV = WS_H + 33 * MiB;
constexpr size_t WS_CQ = WS_QKV + 98 * MiB;
constexpr size_t WS_Q = WS_CQ + 65 * MiB;
constexpr size_t WS_KV = WS_Q + 49 * MiB;
constexpr size_t WS_CQN = WS_KV + 65 * MiB;
constexpr size_t WS_CKVN = WS_CQN + 17 * MiB;
constexpr size_t WS_KROPE = WS_CKVN + 9 * MiB;
constexpr size_t WS_O = WS_KROPE + 2 * MiB;
constexpr size_t WS_AFF = WS_O + 33 * MiB;
constexpr size_t WS_ROWL = WS_AFF + 2 * MiB;
constexpr size_t WS_GATEL = WS_ROWL + 1 * MiB;
constexpr size_t WS_INV = WS_GATEL + 1 * MiB;
constexpr size_t WS_XG = WS_INV + 2 * MiB;
constexpr size_t WS_ACT = WS_XG + 72 * MiB;
constexpr size_t WS_YB = WS_ACT + 144 * MiB;
constexpr size_t WS_END = WS_YB + 72 * MiB;
static_assert(WS_END <= 2048 * MiB, "d_ws map");
constexpr int CW_BAR = 4096;

constexpr int LDS_BYTES = 147456;
constexpr int MISC_OFF = 131072 + 320;

__device__ __forceinline__ float bf2f(unsigned b) { return __uint_as_float(b << 16); }
__device__ __forceinline__ unsigned f2bf(float f) { unsigned u = __float_as_uint(f); return (u + 0x7fffu + ((u >> 16) & 1u)) >> 16; }
__device__ __forceinline__ unsigned pk2(float lo, float hi) { return f2bf(lo) | (f2bf(hi) << 16); }
__device__ __forceinline__ float wave_sum(float v) {
#pragma unroll
    for (int o = 1; o < 64; o <<= 1) v += __shfl_xor(v, o);
    return v;
}
__device__ __forceinline__ int wave_sum_i(int v) {
#pragma unroll
    for (int o = 1; o < 64; o <<= 1) v += __shfl_xor(v, o);
    return v;
}

#define XB_TMO      128
#define XB_XCNT(j)  (256  + 64 * (j))
#define XB_XSUB(j)  (1280 + 64 * (j))
#define XB_XGEN(j)  (2304 + 64 * (j))
#define XB_TOP      3328
#define XB_TOPGEN   3392
#define XCD_BAR_WORDS 3456
#define XB_SPIN_CAP (1u << 18)
__device__ __forceinline__ unsigned xb_ld(unsigned* p)              { return __hip_atomic_load(p, __ATOMIC_RELAXED, __HIP_MEMORY_SCOPE_AGENT); }
__device__ __forceinline__ unsigned xb_add(unsigned* p, unsigned v) { return __hip_atomic_fetch_add(p, v, __ATOMIC_RELAXED, __HIP_MEMORY_SCOPE_AGENT); }
__device__ __forceinline__ unsigned xb_xcc_id() { return (unsigned)__builtin_amdgcn_s_getreg((3 << 11) | 20) & 0xFu; }
#define XB_SPIN(cond, bar) do { unsigned _sp = 0; while (cond) { __builtin_amdgcn_s_sleep(1); \
    if ((++_sp & 255u) == 0u) { if (xb_ld(&(bar)[XB_TMO])) break; if (_sp > XB_SPIN_CAP) { atomicAdd(&(bar)[XB_TMO], 1u); break; } } } } while (0)
struct XcdBarrier { unsigned* bar; unsigned x; volatile LAS unsigned* st; };
__device__ __forceinline__ XcdBarrier xcd_barrier_post(unsigned* bar, volatile LAS unsigned* st) {
    XcdBarrier b; b.bar = bar; b.x = xb_xcc_id(); b.st = st;
    if (threadIdx.x == 0) (void)xb_add(&bar[XB_XCNT(b.x)], 1u);
    return b;
}
__device__ __forceinline__ void xcd_barrier_complete(unsigned* bar, unsigned x, unsigned& nloc, unsigned& nx) {
    const unsigned G = gridDim.x * gridDim.y * gridDim.z;
    unsigned sum, cnt, mine, sp = 0u;
    for (;;) {
        sum = 0u; cnt = 0u; mine = 0u;
#pragma unroll
        for (unsigned j = 0; j < 16; ++j) { const unsigned c = xb_ld(&bar[XB_XCNT(j)]); sum += c; cnt += (c > 0u) ? 1u : 0u; mine = (j == x) ? c : mine; }
        if (sum == G) break;
        __builtin_amdgcn_s_sleep(1);
        if ((++sp & 255u) == 0u) { if (xb_ld(&bar[XB_TMO])) break; if (sp > XB_SPIN_CAP) { atomicAdd(&bar[XB_TMO], 1u); break; } }
    }
    nloc = mine > 0u ? mine : 1u; nx = cnt > 0u ? cnt : 1u;
}
__device__ __forceinline__ void xcd_barrier(const XcdBarrier& b) {
    asm volatile("s_waitcnt vmcnt(0)" ::: "memory");
    __syncthreads();
    if (threadIdx.x == 0) {
        unsigned* bar = b.bar;
        __builtin_amdgcn_s_waitcnt(0);
        unsigned nloc = b.st[0], nx = b.st[1];
        if (nloc == 0u) { xcd_barrier_complete(bar, b.x, nloc, nx); b.st[0] = nloc; b.st[1] = nx; }
        const unsigned old = xb_add(&bar[XB_XSUB(b.x)], 1u);
        const unsigned gen = old / nloc;
        if (old + 1u == (gen + 1u) * nloc) {
            __builtin_amdgcn_fence(__ATOMIC_RELEASE, "agent");
            asm volatile("s_waitcnt vmcnt(0)" ::: "memory");
            const unsigned og = xb_add(&bar[XB_TOP], 1u);
            const unsigned tg = og / nx;
            if (og + 1u == (tg + 1u) * nx) xb_add(&bar[XB_TOPGEN], 1u);
            else XB_SPIN(xb_ld(&bar[XB_TOPGEN]) == tg, bar);
            __builtin_amdgcn_fence(__ATOMIC_ACQUIRE, "agent");
            xb_add(&bar[XB_XGEN(b.x)], 1u);
            asm volatile("s_waitcnt vmcnt(0)" ::: "memory");
        } else {
            XB_SPIN(xb_ld(&bar[XB_XGEN(b.x)]) == gen, bar);
            __builtin_amdgcn_fence(__ATOMIC_ACQUIRE, "agent");
            asm volatile("s_waitcnt vmcnt(0)" ::: "memory");
        }
    }
    __syncthreads();
}

struct Args { const float* in[26]; float* out; unsigned char* ws; int ph_lo, ph_hi, li, pad; };
struct Ctx {
    const float* in[26]; float* out; unsigned char* ws;
    LAS unsigned char* lds;
    int tid, lane, wave, blk, G;
};
#define WSP(T, off) ((T*)(C.ws + (off)))
__device__ __forceinline__ const float* modp(const Ctx& C, int l, int set, int j) { return (const float*)(C.ws + WS_MOD) + ((l * 2 + set) * 6 + j) * D; }

__device__ __forceinline__ void p0_transpose_item(const float* W, int K, int N, bf16* WT, int k0, int n0, int drow0, LAS float* scr, int lane) {
#pragma unroll 8
    for (int i = 0; i < 32; ++i) { const int kk = 2 * i + (lane >> 5); scr[kk * 33 + (lane & 31)] = W[(size_t)(k0 + kk) * N + n0 + (lane & 31)]; }
    asm volatile("s_waitcnt lgkmcnt(0)" ::: "memory");
    const int c = lane & 7;
#pragma unroll
    for (int j = 0; j < 4; ++j) { const int n = (lane >> 3) + 8 * j; const LAS float* s = scr + (8 * c) * 33 + n;
        u32x4 o; o.x = pk2(s[0 * 33], s[1 * 33]); o.y = pk2(s[2 * 33], s[3 * 33]); o.z = pk2(s[4 * 33], s[5 * 33]); o.w = pk2(s[6 * 33], s[7 * 33]);
        *(u32x4*)(WT + (size_t)(drow0 + n) * K + k0 + 8 * c) = o; }
    asm volatile("s_waitcnt lgkmcnt(0)" ::: "memory");
}
__device__ __forceinline__ bool p0_plain(int& r, const float* W, int K, int N, bf16* WT, int row_off, LAS float* scr, int lane) {
    const int nblk = N / 32, cnt = (K / 64) * nblk;
    if (r >= cnt) { r -= cnt; return false; }
    const int kb = r / nblk, nb = r % nblk;
    p0_transpose_item(W, K, N, WT, kb * 64, nb * 32, row_off + nb * 32, scr, lane);
    return true;
}
__device__ __forceinline__ void ph_prologue(const Ctx& C) {
    LAS float* scr = (LAS float*)(C.lds + C.wave * 16384);
    const int gw = C.blk * 8 + C.wave, NGW = C.G * 8;
    constexpr int MOE_ITEMS = 4 * 16 * 3072;
    constexpr int SMALL_ITEMS = 2 * 1536 + 2 * 512 + 768 + 512 + 256 + 144 + 384 + 256 + 512;
    for (int it = gw; it < MOE_ITEMS + SMALL_ITEMS; it += NGW) {
        if (it < MOE_ITEMS) {
            const int le = it / 3072, r2 = it % 3072, which = r2 / 1024, item = r2 % 1024, l = le / 16, e = le % 16;
            if (which < 2) {
                const float* W = (which ? C.in[23] : C.in[22]) + (size_t)le * 1024 * 2048;
                bf16* WT = WSP(bf16, WS_W_GU) + ((size_t)l * 16 + e) * 4096 * 1024;
                const int kb = item / 64, nb = item % 64, n0 = nb * 32;
                p0_transpose_item(W, 1024, 2048, WT, kb * 64, n0, (n0 >> 7) * 256 + (n0 & 127) + which * 128, scr, C.lane);
            } else {
                const float* W = C.in[24] + (size_t)le * 2048 * 1024;
                bf16* WT = WSP(bf16, WS_W_DN) + ((size_t)l * 16 + e) * 1024 * 2048;
                const int kb = item / 32, nb = item % 32;
                p0_transpose_item(W, 2048, 1024, WT, kb * 64, nb * 32, nb * 32, scr, C.lane);
            }
            continue;
        }
        int r = it - MOE_ITEMS;
        if (p0_plain(r, C.in[8], 1024, 3072, WSP(bf16, WS_W_NAQKV), 0, scr, C.lane)) continue;
        if (p0_plain(r, C.in[8] + (size_t)1024 * 3072, 1024, 3072, WSP(bf16, WS_W_NAQKV) + (size_t)3072 * 1024, 0, scr, C.lane)) continue;
        if (p0_plain(r, C.in[9], 1024, 1024, WSP(bf16, WS_W_NAO), 0, scr, C.lane)) continue;
        if (p0_plain(r, C.in[9] + (size_t)1024 * 1024, 1024, 1024, WSP(bf16, WS_W_NAO) + (size_t)1024 * 1024, 0, scr, C.lane)) continue;
        if (p0_plain(r, C.in[11], 1024, 1536, WSP(bf16, WS_W_SWAQKV), 0, scr, C.lane)) continue;
        if (p0_plain(r, C.in[12], 1024, 1024, WSP(bf16, WS_W_SWAO), 0, scr, C.lane)) continue;
        if (p0_plain(r, C.in[14], 1024, 512, WSP(bf16, WS_W_MLAD), 0, scr, C.lane)) continue;
        if (p0_plain(r, C.in[17], 1024, 288, WSP(bf16, WS_W_MLAD), 512, scr, C.lane)) continue;
        if (p0_plain(r, C.in[16], 512, 1536, WSP(bf16, WS_W_MLAUQ), 0, scr, C.lane)) continue;
        if (p0_plain(r, C.in[19], 256, 2048, WSP(bf16, WS_W_MLAUKV), 0, scr, C.lane)) continue;
        p0_plain(r, C.in[20], 1024, 1024, WSP(bf16, WS_W_MLAO), 0, scr, C.lane);
    }
    { u32x4* z = (u32x4*)(WSP(bf16, WS_W_MLAD) + (size_t)800 * 1024); const int n16 = 224 * 1024 * 2 / 16;
      for (int i = C.blk * 512 + C.tid; i < n16; i += C.G * 512) z[i] = (u32x4){0u, 0u, 0u, 0u}; }
    __syncthreads();
    LAS float* sc = (LAS float*)C.lds;
    LAS float* red = sc + 2048;
    for (int i = C.tid; i < 2048; i += 512) { const float v = (i < 1024) ? C.in[1][i] : C.in[3][i - 1024]; sc[i] = v / (1.f + __expf(-v)); }
    __syncthreads();
    for (int u = C.blk; u < 4 * 96; u += C.G) {
        const int l = u / 96, j0 = (u % 96) * 64, kq = C.tid >> 6, jj = C.tid & 63;
        const float* W = C.in[4] + (size_t)l * 1024 * 6144 + j0 + jj;
        float a0 = 0.f, a1 = 0.f;
#pragma unroll 8
        for (int k = kq * 128; k < kq * 128 + 128; ++k) { const float w = W[(size_t)k * 6144]; a0 += sc[k] * w; a1 += sc[1024 + k] * w; }
        red[kq * 64 + jj] = a0; red[512 + kq * 64 + jj] = a1;
        __syncthreads();
        if (C.tid < 128) { const int set = C.tid >> 6, j = C.tid & 63; float s = 0.f;
#pragma unroll
            for (int q = 0; q < 8; ++q) s += red[set * 512 + q * 64 + j];
            const int col = j0 + j;
            ((float*)(C.ws + WS_MOD))[((l * 2 + set) * 6) * D + col] = s + C.in[5][l * 6144 + col]; }
        __syncthreads();
    }
}

template <int MODE>
__device__ __forceinline__ void ph_rowA(const Ctx& C, int l) {
    float* X = WSP(float, WS_X); bf16* H = WSP(bf16, WS_H); const int* INV = WSP(int, WS_INV); const bf16* YB = WSP(bf16, WS_YB);
    const int nrows = MODE == 1 ? SEQ : R;
    for (int t = C.blk * 8 + C.wave; t < nrows; t += C.G * 8) {
        const int set = t >= SEQ ? 1 : 0;
        const float* src = (MODE == 0 && l == 0) ? (set ? C.in[2] + (size_t)(t - SEQ) * D : C.in[0] + (size_t)t * D) : X + (size_t)t * D;
        f32x4 v[4];
#pragma unroll
        for (int j = 0; j < 4; ++j) v[j] = ((const f32x4*)src)[C.lane + 64 * j];
        if (MODE == 1 || l > 0) {
            const int lp = MODE == 1 ? 3 : l - 1;
            const int myinv = C.lane < 16 ? INV[(size_t)t * 16 + C.lane] : -1;
            f32x4 a[4];
#pragma unroll
            for (int j = 0; j < 4; ++j) a[j] = (f32x4){0.f, 0.f, 0.f, 0.f};
            for (int e = 0; e < 16; ++e) {
                const int s = __shfl(myinv, e);
                if (s >= 0) {
                    const u32x2* yr = (const u32x2*)(YB + ((size_t)e * EROWS + s) * D);
#pragma unroll
                    for (int j = 0; j < 4; ++j) { const u32x2 w = yr[C.lane + 64 * j];
                        a[j] += (f32x4){bf2f(w.x & 0xffffu), bf2f(w.x >> 16), bf2f(w.y & 0xffffu), bf2f(w.y >> 16)}; }
                }
            }
            const f32x4* g = (const f32x4*)modp(C, lp, set, 5);
#pragma unroll
            for (int j = 0; j < 4; ++j) v[j] += g[C.lane + 64 * j] * a[j];
        }
        if (MODE == 0) {
#pragma unroll
            for (int j = 0; j < 4; ++j) ((f32x4*)(X + (size_t)t * D))[C.lane + 64 * j] = v[j];
        }
        float ss = 0.f;
#pragma unroll
        for (int j = 0; j < 4; ++j) ss += (v[j].x * v[j].x + v[j].y * v[j].y) + (v[j].z * v[j].z + v[j].w * v[j].w);
        const float rstd = rsqrtf(wave_sum(ss) * (1.f / D) + RMS_EPS);
        if (MODE == 0) {
            const f32x4* w = (const f32x4*)(C.in[6] + (size_t)l * D); const f32x4* sh = (const f32x4*)modp(C, l, set, 0); const f32x4* scl = (const f32x4*)modp(C, l, set, 1);
#pragma unroll
            for (int j = 0; j < 4; ++j) { const int i = C.lane + 64 * j; const f32x4 y = v[j] * rstd * w[i] * (scl[i] + 1.f) + sh[i];
                u32x2 o; o.x = pk2(y.x, y.y); o.y = pk2(y.z, y.w); ((u32x2*)(H + (size_t)t * D))[i] = o; }
        } else {
            const f32x4* w = (const f32x4*)C.in[25];
#pragma unroll
            for (int j = 0; j < 4; ++j) { const int i = C.lane + 64 * j; ((f32x4*)(C.out + (size_t)t * D))[i] = v[j] * rstd * w[i]; }
        }
    }
}
__device__ __forceinline__ void ph_norm2(const Ctx& C, int l) {
    const float* X = WSP(float, WS_X); bf16* H = WSP(bf16, WS_H); float* AFF = WSP(float, WS_AFF);
    LAS float* Rs = (LAS float*)C.lds;
    const float* rt = C.in[21] + (size_t)l * D * NE;
    for (int i = C.tid; i < D * NE; i += 512) { const int c = i >> 4, e = i & 15; Rs[e * D + c] = rt[i]; }
    __syncthreads();
    for (int t = C.blk * 8 + C.wave; t < R; t += C.G * 8) {
        asm volatile("" ::: "memory");
        const int set = t >= SEQ ? 1 : 0;
        f32x4 v[4];
#pragma unroll
        for (int j = 0; j < 4; ++j) v[j] = ((const f32x4*)(X + (size_t)t * D))[C.lane + 64 * j];
        float ss = 0.f;
#pragma unroll
        for (int j = 0; j < 4; ++j) ss += (v[j].x * v[j].x + v[j].y * v[j].y) + (v[j].z * v[j].z + v[j].w * v[j].w);
        const float rstd = rsqrtf(wave_sum(ss) * (1.f / D) + RMS_EPS);
        const f32x4* w = (const f32x4*)(C.in[7] + (size_t)l * D); const f32x4* sh = (const f32x4*)modp(C, l, set, 3); const f32x4* scl = (const f32x4*)modp(C, l, set, 4);
#pragma unroll
        for (int j = 0; j < 4; ++j) { const int i = C.lane + 64 * j; v[j] = v[j] * rstd * w[i] * (scl[i] + 1.f) + sh[i];
            u32x2 o; o.x = pk2(v[j].x, v[j].y); o.y = pk2(v[j].z, v[j].w); ((u32x2*)(H + (size_t)t * D))[i] = o; }
        float lg[16];
#pragma unroll
        for (int e = 0; e < 16; ++e) { float s = 0.f;
#pragma unroll
            for (int j = 0; j < 4; ++j) { const f32x4 r = *(const LAS f32x4*)(Rs + e * D + 4 * (C.lane + 64 * j)); s += (v[j].x * r.x + v[j].y * r.y) + (v[j].z * r.z + v[j].w * r.w); }
            lg[e] = wave_sum(s); }
        float mx = lg[0];
#pragma unroll
        for (int e = 1; e < 16; ++e) mx = fmaxf(mx, lg[e]);
        float sum = 0.f;
#pragma unroll
        for (int e = 0; e < 16; ++e) { lg[e] = __expf(lg[e] - mx); sum += lg[e]; }
        const float inv = 1.f / sum; float mine = 0.f;
#pragma unroll
        for (int e = 0; e < 16; ++e) mine = (C.lane == e) ? lg[e] * inv : mine;
        if (C.lane < 16) AFF[(size_t)C.lane * R + t] = mine;
    }
}

__device__ __forceinline__ int block_sum_i(int v, LAS int* scr, int wave, int lane) {
    v = wave_sum_i(v);
    if (lane == 0) scr[wave] = v;
    __syncthreads();
    int t = 0;
#pragma unroll
    for (int w = 0; w < 8; ++w) t += scr[w];
    __syncthreads();
    return t;
}
__device__ __forceinline__ int block_excl_scan(int v, LAS int* scr, int wave, int lane) {
    int inc = v;
#pragma unroll
    for (int o = 1; o < 64; o <<= 1) { const int n = __shfl_up(inc, o); if (lane >= o) inc += n; }
    if (lane == 63) scr[wave] = inc;
    __syncthreads();
    int off = 0;
#pragma unroll
    for (int w = 0; w < 8; ++w) off += (w < wave) ? scr[w] : 0;
    __syncthreads();
    return off + inc - v;
}
template <int KPT>
__device__ __forceinline__ void topk_unit(const Ctx& C, int e, int base, int n, int cap, int slot0) {
    const float* aff = WSP(float, WS_AFF) + (size_t)e * R + base;
    int* rowl = WSP(int, WS_ROWL) + e * EROWS; float* gatel = WSP(float, WS_GATEL) + e * EROWS; int* INV = WSP(int, WS_INV);
    LAS int* scr = (LAS int*)C.lds;
    unsigned key[KPT];
#pragma unroll
    for (int j = 0; j < KPT; ++j) { const int t = C.tid * KPT + j; key[j] = t < n ? __float_as_uint(aff[t]) : 0u; }
    unsigned prefix = 0u;
    for (int bit = 30; bit >= 0; --bit) {
        const unsigned cand = prefix | (1u << bit); int c = 0;
#pragma unroll
        for (int j = 0; j < KPT; ++j) c += key[j] >= cand ? 1 : 0;
        if (block_sum_i(c, scr, C.wave, C.lane) >= cap) prefix = cand;
    }
    int cg = 0, ce = 0;
#pragma unroll
    for (int j = 0; j < KPT; ++j) { cg += key[j] > prefix ? 1 : 0; ce += key[j] == prefix ? 1 : 0; }
    const int need_eq = cap - block_sum_i(cg, scr, C.wave, C.lane);
    int eqr = block_excl_scan(ce, scr, C.wave, C.lane);
    int nsel = 0; unsigned selmask = 0u;
#pragma unroll
    for (int j = 0; j < KPT; ++j) { bool s = key[j] > prefix; if (key[j] == prefix) { s = eqr < need_eq; ++eqr; } if (s) { ++nsel; selmask |= 1u << j; } }
    int slot = block_excl_scan(nsel, scr, C.wave, C.lane);
#pragma unroll
    for (int j = 0; j < KPT; ++j) { const int t = C.tid * KPT + j;
        if (t < n) {
            if ((selmask >> j) & 1u) { rowl[slot0 + slot] = base + t; gatel[slot0 + slot] = __uint_as_float(key[j]); INV[(size_t)(base + t) * 16 + e] = slot0 + slot; ++slot; }
            else INV[(size_t)(base + t) * 16 + e] = -1;
        } }
}
__device__ __forceinline__ void ph_topk(const Ctx& C) {
    for (int u = C.blk; u < 32; u += C.G) {
        const int e = u & 15;
        if (u < 16) { topk_unit<32>(C, e, 0, SEQ, CAP_L, 0);
            int* rowl = WSP(int, WS_ROWL) + e * EROWS; float* gatel = WSP(float, WS_GATEL) + e * EROWS;
            for (int i = CAP_L + CAP_C + C.tid; i < EROWS; i += 512) { rowl[i] = -1; gatel[i] = 0.f; } }
        else topk_unit<1>(C, e, SEQ, NCTX, CAP_C, CAP_L);
        __syncthreads();
    }
}
__device__ __forceinline__ void ph_gather(const Ctx& C) {
    const int* rowl = WSP(int, WS_ROWL); const bf16* H = WSP(bf16, WS_H); bf16* XG = WSP(bf16, WS_XG);
    for (int r = C.blk * 8 + C.wave; r < XROWS; r += C.G * 8) {
        const int src = rowl[r];
        u32x4* d = (u32x4*)(XG + (size_t)r * D);
        if (src >= 0) { const u32x4* s = (const u32x4*)(H + (size_t)src * D); d[C.lane] = s[C.lane]; d[C.lane + 64] = s[C.lane + 64]; }
        else { d[C.lane] = (u32x4){0u, 0u, 0u, 0u}; d[C.lane + 64] = (u32x4){0u, 0u, 0u, 0u}; }
    }
}
__device__ __forceinline__ void rot_angles(int t, int half, int d, int quarter, float& cs, float& sn) {
    const float invf = exp2f(-(float)d * (13.287712379549449f / (float)quarter));
    const float pos = half ? (float)(t & 63) : (float)(t >> 6);
    const float ang = pos * invf;
    const double rev = (double)ang * 0.15915494309189535; const float fr = (float)(rev - __builtin_rint(rev));
    cs = __builtin_amdgcn_cosf(fr); sn = __builtin_amdgcn_sinf(fr);
}
__device__ __forceinline__ void ph_rope(const Ctx& C, bf16* buf, int pitch, int nheads, int head_stride, int off, int quarter) {
    const int per_tok = nheads * 2 * quarter; const long total = (long)SEQ * per_tok;
    for (long i = (long)C.blk * 512 + C.tid; i < total; i += (long)C.G * 512) {
        const int t = (int)(i / per_tok), r = (int)(i % per_tok), h = r / (2 * quarter), p = r % (2 * quarter), half = p / quarter, d = p % quarter;
        float cs, sn; rot_angles(t, half, d, quarter, cs, sn);
        bf16* b = buf + (size_t)t * pitch + h * head_stride + off + half * 2 * quarter + d;
        const float x1 = bf2f(b[0]), x2 = bf2f(b[quarter]);
        b[0] = (bf16)f2bf(x1 * cs - x2 * sn); b[quarter] = (bf16)f2bf(x1 * sn + x2 * cs);
    }
}
__device__ __forceinline__ void ph_mlanorm(const Ctx& C) {
    const float* CQ = WSP(float, WS_CQ); bf16* CQN = WSP(bf16, WS_CQN); bf16* CKVN = WSP(bf16, WS_CKVN); bf16* KR = WSP(bf16, WS_KROPE);
    for (int t = C.blk * 8 + C.wave; t < R; t += C.G * 8) {
        const float* row = CQ + (size_t)t * D;
        const f32x4 a0 = ((const f32x4*)row)[C.lane], a1 = ((const f32x4*)row)[C.lane + 64], b0 = ((const f32x4*)(row + 512))[C.lane];
        const float sa = wave_sum((a0.x * a0.x + a0.y * a0.y) + (a0.z * a0.z + a0.w * a0.w) + (a1.x * a1.x + a1.y * a1.y) + (a1.z * a1.z + a1.w * a1.w));
        const float sb = wave_sum((b0.x * b0.x + b0.y * b0.y) + (b0.z * b0.z + b0.w * b0.w));
        const float ra = rsqrtf(sa * (1.f / 512.f) + RMS_EPS), rb = rsqrtf(sb * (1.f / 256.f) + RMS_EPS);
        const f32x4* gq = (const f32x4*)C.in[15]; const f32x4* gk = (const f32x4*)C.in[18];
        { const f32x4 y0 = a0 * ra * gq[C.lane], y1 = a1 * ra * gq[C.lane + 64], z = b0 * rb * gk[C.lane];
          u32x2 o; o.x = pk2(y0.x, y0.y); o.y = pk2(y0.z, y0.w); ((u32x2*)(CQN + (size_t)t * 512))[C.lane] = o;
          o.x = pk2(y1.x, y1.y); o.y = pk2(y1.z, y1.w); ((u32x2*)(CQN + (size_t)t * 512))[C.lane + 64] = o;
          o.x = pk2(z.x, z.y); o.y = pk2(z.z, z.w); ((u32x2*)(CKVN + (size_t)t * 256))[C.lane] = o; }
        const float x = row[768 + (C.lane & 31)];
        const float xp = __shfl_xor(x, 8);
        float y = x;
        if (t < SEQ) { float cs, sn; rot_angles(t, (C.lane >> 4) & 1, C.lane & 7, 8, cs, sn);
            y = ((C.lane >> 3) & 1) ? (xp * sn + x * cs) : (x * cs - xp * sn); }
        if (C.lane < 32) KR[(size_t)t * 32 + C.lane] = (bf16)f2bf(y);
    }
}

namespace pg8 {
#define PG8_LAS __attribute__((address_space(3)))
typedef unsigned short bf16_t;
typedef short bf16x8 __attribute__((ext_vector_type(8)));
typedef float f32x4 __attribute__((ext_vector_type(4)));
typedef unsigned u32x4 __attribute__((ext_vector_type(4)));
constexpr int BM = 256, BK = 64, HALF = 128, HTB = HALF * BK * 2  , STAGE_BYTES = 8 * HTB, NXCD = 8, WGM = 8;

__host__ __device__ __forceinline__ int lds_byte(int r, int c) { const int st = (r >> 4) * 2 + (c >> 5), rr = r & 15, cc = c & 31, ob = rr * 64 + cc * 2; return st * 1024 + (ob ^ (((ob >> 9) & 1) << 5)); }
__host__ __device__ __forceinline__ void stage_rc(int b, int& R, int& C) { const int st = b / 1024, sb = b % 1024, swz = sb ^ (((sb >> 9) & 1) << 5); R = (st >> 1) * 16 + swz / 64; C = (st & 1) * 32 + (swz % 64) / 2; }
__host__ __device__ __forceinline__ int perm32(int rho) { const int n = rho >> 4, i = rho & 15; return 8 * (i >> 2) + 4 * n + (i & 3); }

struct Unit { int pm, pn; };
struct Gemm { const bf16_t* A; const bf16_t* Bt; int M, N, K; int pm_per_grp; size_t grp_stride; };

struct StaticOrder {
    int nM, nN, nwg, G, c;
    __host__ __device__ void init(int M, int N, int G_, int c_) { nM = M / BM; nN = N / BM; nwg = nM * nN; G = G_; c = c_; }
    __host__ __device__ bool next(int i, Unit& u) const {
        const long L = (long)i * G + c; if (L >= nwg) return false;
        int wgid = (int)L; { const int q = nwg / NXCD, r = nwg % NXCD, xcd = wgid % NXCD, off = wgid / NXCD; wgid = (xcd < r ? xcd * (q + 1) : r * (q + 1) + (xcd - r) * q) + off; }
        const int nig = WGM * nN, gid = wgid / nig, fm = gid * WGM, gsz = (nM - fm) < WGM ? (nM - fm) : WGM;
        u.pm = fm + ((wgid % nig) % gsz); u.pn = (wgid % nig) / gsz; return true;
    }
    __device__ __forceinline__ void a_ready(const Unit&) const {}
    __device__ __forceinline__ void done(const Unit&) const {}
};

template <class Epi, class Sched, bool ALIGN_EPI = false, bool SP2 = false>
__device__ __forceinline__ void gemm_phase(PG8_LAS unsigned char* lds, const Gemm g, const Sched& S, const Epi& E) {
    const int tid = threadIdx.x, wid = __builtin_amdgcn_readfirstlane(tid >> 6), lane = tid & 63, wr = wid >> 2, wc = wid & 3, fr = lane & 15, fq = lane >> 4;
    const int K = g.K, nt = K / BK;
    unsigned voffA[2], voffB[2];
#pragma unroll
    for (int i = 0; i < 2; ++i) { int R, C; stage_rc(tid * 16 + i * 8192, R, C); const int Rb = Epi::PERM ? ((R & ~31) + perm32(R & 31)) : R;
        voffA[i] = (unsigned)(R * K + C) * 2u; voffB[i] = (unsigned)(Rb * K + C) * 2u; }
    const size_t kstep = (size_t)(BK * 2);
    const size_t hstep = (size_t)HALF * K * 2;
    const size_t tstep = 2 * hstep;
    const unsigned ldsw = (unsigned)wid * 1024u;
    const int aoff = lds_byte(wr * 64 + fr, fq * 8), boff = lds_byte(wc * 32 + fr, fq * 8);
#define PG8_SA(b, h) (((b) * 2 + (h)) * HTB)
#define PG8_SB(b, h) ((4 + (b) * 2 + (h)) * HTB)
#define PG8_STAGE(bufoff, gbase, voff) do { _Pragma("unroll") for (int _i = 0; _i < 2; ++_i) \
        __builtin_amdgcn_global_load_lds((const unsigned*)((const char*)(gbase) + (voff)[_i]), (PG8_LAS unsigned*)(lds + (bufoff) + ldsw + _i * 8192), 16, 0, 0); } while (0)
#define PG8_LDA(dst, b, h) do { _Pragma("unroll") for (int m = 0; m < 4; ++m) _Pragma("unroll") for (int k = 0; k < 2; ++k) dst[m][k] = *(const PG8_LAS bf16x8*)(lds + PG8_SA(b, h) + aoff + m * 2048 + k * 1024); } while (0)
#define PG8_LDB(dst, b, h) do { _Pragma("unroll") for (int n = 0; n < 2; ++n) _Pragma("unroll") for (int k = 0; k < 2; ++k) dst[n][k] = *(const PG8_LAS bf16x8*)(lds + PG8_SB(b, h) + boff + n * 2048 + k * 1024); } while (0)
#define PG8_MMA(ai, bj, At, Bt) do { __builtin_amdgcn_s_setprio(1); _Pragma("unroll") for (int m = 0; m < 4; ++m) _Pragma("unroll") for (int n = 0; n < 2; ++n) _Pragma("unroll") for (int k = 0; k < 2; ++k) \
        acc[ai][bj][m][n] = __builtin_amdgcn_mfma_f32_16x16x32_bf16(Bt[n][k], At[m][k], acc[ai][bj][m][n], 0, 0, 0); __builtin_amdgcn_s_setprio(0); } while (0)
#define PG8_WAIT_V(n) asm volatile("s_waitcnt vmcnt(" #n ")" ::: "memory")
#define PG8_WAIT_L(n) asm volatile("s_waitcnt lgkmcnt(" #n ")" ::: "memory")
#define PG8_BAR __builtin_amdgcn_s_barrier()
#define PG8_SCHED __builtin_amdgcn_sched_barrier(0)
    Unit cur, nxt; int ui = 0;
    if (!S.next(0, cur)) return;
    f32x4 acc[2][2][4][2];
#pragma unroll
    for (int a = 0; a < 2; ++a)
#pragma unroll
        for (int b = 0; b < 2; ++b)
#pragma unroll
            for (int m = 0; m < 4; ++m)
#pragma unroll
                for (int n = 0; n < 2; ++n) acc[a][b][m][n] = (f32x4){0.f, 0.f, 0.f, 0.f};
    bf16x8 At[4][2], B0[2][2], B1[2][2];
    const char* cA = (const char*)g.A + (size_t)cur.pm * tstep; const char* cB = (const char*)g.Bt + (g.pm_per_grp ? (size_t)(cur.pm / g.pm_per_grp) * g.grp_stride * 2 : (size_t)0) + (size_t)cur.pn * tstep;
    S.a_ready(cur);
    if constexpr (SP2) {
        PG8_STAGE(PG8_SB(0, 0), cB, voffB); PG8_STAGE(PG8_SB(0, 1), cB + hstep, voffB); PG8_STAGE(PG8_SA(0, 0), cA, voffA); PG8_STAGE(PG8_SA(0, 1), cA + hstep, voffA);
        if (wr == 1) PG8_BAR;
        PG8_WAIT_V(2); PG8_BAR;
        PG8_STAGE(PG8_SB(1, 0), cB + kstep, voffB); PG8_STAGE(PG8_SA(1, 0), cA + kstep, voffA); PG8_STAGE(PG8_SB(1, 1), cB + hstep + kstep, voffB);
        PG8_WAIT_V(6); PG8_BAR;
    } else {
        PG8_STAGE(PG8_SB(0, 0), cB, voffB); PG8_STAGE(PG8_SA(0, 0), cA, voffA); PG8_STAGE(PG8_SB(0, 1), cB + hstep, voffB); PG8_STAGE(PG8_SA(0, 1), cA + hstep, voffA);
        if (wr == 1) PG8_BAR;
        PG8_WAIT_V(4); PG8_BAR;
        PG8_STAGE(PG8_SB(1, 0), cB + kstep, voffB); PG8_STAGE(PG8_SA(1, 0), cA + kstep, voffA); PG8_STAGE(PG8_SB(1, 1), cB + hstep + kstep, voffB);
        PG8_WAIT_V(6); PG8_BAR;
    }
    for (;;) {
        const bool has_next = S.next(ui + 1, nxt);
        const char* nA = has_next ? (const char*)g.A + (size_t)nxt.pm * tstep : cA; const char* nB = has_next ? (const char*)g.Bt + (g.pm_per_grp ? (size_t)(nxt.pm / g.pm_per_grp) * g.grp_stride * 2 : (size_t)0) + (size_t)nxt.pn * tstep : cB;
        for (int t = 0; t < nt; t += 2) {
            const bool last = (t == nt - 2);
            const char* a1 = cA + (size_t)(t + 1) * kstep;
            const char* a2 = last ? nA : cA + (size_t)(t + 2) * kstep; const char* b2 = last ? nB : cB + (size_t)(t + 2) * kstep;
            const char* a3 = a2 + kstep; const char* b3 = b2 + kstep;
            if (last && has_next) S.a_ready(nxt);
            if constexpr (SP2) {
            PG8_LDB(B0, 0, 0); PG8_LDB(B1, 0, 1); PG8_SCHED; PG8_LDA(At, 0, 0); PG8_STAGE(PG8_SA(1, 1), a1 + hstep, voffA);
            PG8_WAIT_V(8); PG8_WAIT_L(0); PG8_BAR; PG8_MMA(0, 0, At, B0); PG8_MMA(0, 1, At, B1); PG8_BAR; PG8_SCHED;
            PG8_LDA(At, 0, 1); PG8_STAGE(PG8_SB(0, 0), b2, voffB); PG8_STAGE(PG8_SB(0, 1), b2 + hstep, voffB); PG8_STAGE(PG8_SA(0, 0), a2, voffA);
            PG8_WAIT_V(8); PG8_WAIT_L(0); PG8_BAR; PG8_MMA(1, 0, At, B0); PG8_MMA(1, 1, At, B1); PG8_BAR; PG8_SCHED;
            PG8_LDB(B0, 1, 0); PG8_LDB(B1, 1, 1); PG8_SCHED; PG8_LDA(At, 1, 0); PG8_STAGE(PG8_SA(0, 1), a2 + hstep, voffA);
            PG8_WAIT_V(8); PG8_WAIT_L(0); PG8_BAR; PG8_MMA(0, 0, At, B0); PG8_MMA(0, 1, At, B1); PG8_BAR; PG8_SCHED;
            PG8_LDA(At, 1, 1); PG8_STAGE(PG8_SB(1, 0), b3, voffB); PG8_STAGE(PG8_SB(1, 1), b3 + hstep, voffB); PG8_STAGE(PG8_SA(1, 0), a3, voffA);
            PG8_WAIT_V(8); PG8_WAIT_L(0); PG8_BAR; PG8_MMA(1, 0, At, B0); PG8_MMA(1, 1, At, B1); PG8_BAR; PG8_SCHED;
            } else {
            PG8_LDB(B0, 0, 0); PG8_SCHED; PG8_LDA(At, 0, 0); PG8_STAGE(PG8_SA(1, 1), a1 + hstep, voffA);
            PG8_WAIT_L(8); PG8_BAR; PG8_WAIT_L(0); PG8_MMA(0, 0, At, B0); PG8_BAR; PG8_SCHED;
            PG8_LDB(B1, 0, 1); PG8_STAGE(PG8_SB(0, 0), b2, voffB);
            PG8_BAR; PG8_WAIT_L(0); PG8_MMA(0, 1, At, B1); PG8_BAR;
            PG8_LDA(At, 0, 1); PG8_STAGE(PG8_SA(0, 0), a2, voffA);
            PG8_BAR; PG8_WAIT_L(0); PG8_MMA(1, 0, At, B0); PG8_BAR; PG8_SCHED;
            PG8_STAGE(PG8_SB(0, 1), b2 + hstep, voffB);
            PG8_WAIT_V(6); PG8_BAR; PG8_MMA(1, 1, At, B1); PG8_BAR;
            PG8_LDB(B0, 1, 0); PG8_SCHED; PG8_LDA(At, 1, 0); PG8_STAGE(PG8_SA(0, 1), a2 + hstep, voffA);
            PG8_WAIT_L(8); PG8_BAR; PG8_WAIT_L(0); PG8_MMA(0, 0, At, B0); PG8_BAR; PG8_SCHED;
            PG8_LDB(B1, 1, 1); PG8_STAGE(PG8_SB(1, 0), b3, voffB);
            PG8_BAR; PG8_WAIT_L(0); PG8_MMA(0, 1, At, B1); PG8_BAR;
            PG8_LDA(At, 1, 1); PG8_STAGE(PG8_SA(1, 0), a3, voffA);
            PG8_BAR; PG8_WAIT_L(0); PG8_MMA(1, 0, At, B0); PG8_BAR; PG8_SCHED;
            PG8_STAGE(PG8_SB(1, 1), b3 + hstep, voffB);
            PG8_WAIT_V(6); PG8_BAR; PG8_MMA(1, 1, At, B1); PG8_BAR;
            }
        }
        if constexpr (ALIGN_EPI) { if (wr == 0) PG8_BAR; }
        if constexpr (!Epi::AFTER_DRAIN) { E(acc, cur, wr, wc, fr, fq); S.done(cur); }
        if (!has_next) break;
#pragma unroll
        for (int a = 0; a < 2; ++a)
#pragma unroll
            for (int b = 0; b < 2; ++b)
#pragma unroll
                for (int m = 0; m < 4; ++m)
#pragma unroll
                    for (int n = 0; n < 2; ++n) acc[a][b][m][n] = (f32x4){0.f, 0.f, 0.f, 0.f};
        cur = nxt; cA = nA; cB = nB; ++ui;
        if constexpr (ALIGN_EPI) { if (wr == 1) PG8_BAR; }
    }
    PG8_WAIT_V(0);
    if constexpr (!ALIGN_EPI) { if (wr == 0) PG8_BAR; }
    PG8_BAR;
    if constexpr (Epi::AFTER_DRAIN) { E.fused(acc, cur, wr, wc, fr, fq, lds, wid, lane); S.done(cur); }
#undef PG8_SA
#undef PG8_SB
#undef PG8_STAGE
#undef PG8_LDA
#undef PG8_LDB
#undef PG8_MMA
#undef PG8_WAIT_V
#undef PG8_WAIT_L
#undef PG8_BAR
#undef PG8_SCHED
}
}
#ifndef USE_PG8
#define USE_PG8 1
#endif
__device__ __forceinline__ unsigned cvt_pk_bf16(float lo, float hi) { unsigned r; asm volatile("v_cvt_pk_bf16_f32 %0, %1, %2" : "=v"(r) : "v"(lo), "v"(hi)); return r; }
typedef const f32x4 (&AccRef)[2][2][4][2];
struct EpiStoreBf16 { static constexpr bool DUAL = false, PERM = true, AFTER_DRAIN = false; bf16* O; int ldc;
    __device__ __forceinline__ void elem(int row, int col, float v, float) const { O[(size_t)row * ldc + col] = (bf16)f2bf(v); }
    __device__ __forceinline__ void operator()(AccRef acc, const pg8::Unit& u, int wr, int wc, int fr, int fq) const {
        const int row0 = u.pm * 256 + wr * 64 + fr, col0 = u.pn * 256 + wc * 32 + 8 * fq;
#pragma unroll
        for (int ai = 0; ai < 2; ++ai)
#pragma unroll
            for (int m = 0; m < 4; ++m) { bf16* rowp = O + (size_t)(row0 + ai * 128 + m * 16) * ldc + col0;
#pragma unroll
                for (int bj = 0; bj < 2; ++bj) { const f32x4 v0 = acc[ai][bj][m][0], v1 = acc[ai][bj][m][1];
                    u32x4 w; w.x = cvt_pk_bf16(v0[0], v0[1]); w.y = cvt_pk_bf16(v0[2], v0[3]); w.z = cvt_pk_bf16(v1[0], v1[1]); w.w = cvt_pk_bf16(v1[2], v1[3]);
                    *(u32x4*)(rowp + bj * 128) = w; } }
    } };
struct EpiStoreF32 { static constexpr bool DUAL = false, PERM = false, AFTER_DRAIN = false; float* O; int ldc;
    __device__ __forceinline__ void elem(int row, int col, float v, float) const { O[(size_t)row * ldc + col] = v; }
    __device__ __forceinline__ void operator()(AccRef acc, const pg8::Unit& u, int wr, int wc, int fr, int fq) const {
        const int row0 = u.pm * 256 + wr * 64 + fr, col0 = u.pn * 256 + wc * 32 + 4 * fq;
#pragma unroll
        for (int ai = 0; ai < 2; ++ai)
#pragma unroll
            for (int m = 0; m < 4; ++m) { float* rowp = O + (size_t)(row0 + ai * 128 + m * 16) * ldc + col0;
#pragma unroll
                for (int bj = 0; bj < 2; ++bj)
#pragma unroll
                    for (int n = 0; n < 2; ++n) *(f32x4*)(rowp + bj * 128 + n * 16) = acc[ai][bj][m][n]; }
    } };
struct EpiResid { static constexpr bool DUAL = false, PERM = false, AFTER_DRAIN = false; float* X; const float* g_lat; const float* g_ctx;
    __device__ __forceinline__ void elem(int row, int col, float v, float) const { const float g = row >= SEQ ? g_ctx[col] : g_lat[col]; X[(size_t)row * D + col] += g * v; }
    __device__ __forceinline__ void operator()(AccRef acc, const pg8::Unit& u, int wr, int wc, int fr, int fq) const {
        const int row0 = u.pm * 256 + wr * 64 + fr, col0 = u.pn * 256 + wc * 32 + 4 * fq;
        const float* g = (u.pm * 256 >= SEQ) ? g_ctx : g_lat;
        f32x4 gv[2][2];
#pragma unroll
        for (int bj = 0; bj < 2; ++bj)
#pragma unroll
            for (int n = 0; n < 2; ++n) gv[bj][n] = *(const f32x4*)(g + col0 + bj * 128 + n * 16);
#pragma unroll
        for (int ai = 0; ai < 2; ++ai)
#pragma unroll
            for (int m = 0; m < 4; ++m) { float* rowp = X + (size_t)(row0 + ai * 128 + m * 16) * D + col0;
#pragma unroll
                for (int bj = 0; bj < 2; ++bj)
#pragma unroll
                    for (int n = 0; n < 2; ++n) { f32x4* p = (f32x4*)(rowp + bj * 128 + n * 16); *p = *p + gv[bj][n] * acc[ai][bj][m][n]; } }
    } };
__device__ __forceinline__ float silu_mul(float g, float u) { return g * __builtin_amdgcn_rcpf(1.f + __expf(-g)) * u; }
struct EpiSwiglu { static constexpr bool DUAL = true, PERM = true, AFTER_DRAIN = false; bf16* ACT;
    __device__ __forceinline__ void elem(int row, int col, float g, float u) const { ACT[(size_t)row * FF + col] = (bf16)f2bf(g / (1.f + __expf(-g)) * u); }
    __device__ __forceinline__ void operator()(AccRef acc, const pg8::Unit& u, int wr, int wc, int fr, int fq) const {
        const int row0 = u.pm * 256 + wr * 64 + fr, col0 = u.pn * 128 + wc * 32 + 8 * fq;
#pragma unroll
        for (int ai = 0; ai < 2; ++ai)
#pragma unroll
            for (int m = 0; m < 4; ++m) { bf16* rowp = ACT + (size_t)(row0 + ai * 128 + m * 16) * FF + col0;
                const f32x4 g0 = acc[ai][0][m][0], g1 = acc[ai][0][m][1], u0 = acc[ai][1][m][0], u1 = acc[ai][1][m][1];
                u32x4 w; w.x = cvt_pk_bf16(silu_mul(g0[0], u0[0]), silu_mul(g0[1], u0[1])); w.y = cvt_pk_bf16(silu_mul(g0[2], u0[2]), silu_mul(g0[3], u0[3]));
                w.z = cvt_pk_bf16(silu_mul(g1[0], u1[0]), silu_mul(g1[1], u1[1])); w.w = cvt_pk_bf16(silu_mul(g1[2], u1[2]), silu_mul(g1[3], u1[3]));
                *(u32x4*)rowp = w; }
    } };
struct EpiMoeOut { static constexpr bool DUAL = false, PERM = true, AFTER_DRAIN = false; bf16* YB; const float* gatel;
    __device__ __forceinline__ void elem(int row, int col, float v, float) const { YB[(size_t)row * D + col] = (bf16)f2bf(v * gatel[row]); }
    __device__ __forceinline__ void operator()(AccRef acc, const pg8::Unit& u, int wr, int wc, int fr, int fq) const {
        const int row0 = u.pm * 256 + wr * 64 + fr, col0 = u.pn * 256 + wc * 32 + 8 * fq;
#pragma unroll
        for (int ai = 0; ai < 2; ++ai)
#pragma unroll
            for (int m = 0; m < 4; ++m) { const int row = row0 + ai * 128 + m * 16; const float gt = gatel[row]; bf16* rowp = YB + (size_t)row * D + col0;
#pragma unroll
                for (int bj = 0; bj < 2; ++bj) { const f32x4 v0 = acc[ai][bj][m][0] * gt, v1 = acc[ai][bj][m][1] * gt;
                    u32x4 w; w.x = cvt_pk_bf16(v0[0], v0[1]); w.y = cvt_pk_bf16(v0[2], v0[3]); w.z = cvt_pk_bf16(v1[0], v1[1]); w.w = cvt_pk_bf16(v1[2], v1[3]);
                    *(u32x4*)(rowp + bj * 128) = w; } }
    } };

template <class Epi>
__device__ __forceinline__ void naive_gemm(const Ctx& C, const bf16* A, const bf16* Bt, int M, int N, int K, int pm_per_grp, size_t grp_stride, const Epi& E) {
    LAS float* As = (LAS float*)C.lds;
    LAS float* Bs = As + 16 * 132;
    LAS float* Bs2 = Bs + 16 * 68;
    const int NO = Epi::DUAL ? N / 2 : N, tn_cnt = NO / 64, nun = (M / 128) * tn_cnt;
    const int ty = C.tid >> 4, tx = C.tid & 15;
    for (int u = C.blk; u < nun; u += C.G) {
        const int tm = u / tn_cnt, tn = u % tn_cnt, row0 = tm * 128, oc0 = tn * 64;
        const bf16* Bg = Bt + (pm_per_grp ? (size_t)((row0 / 256) / pm_per_grp) * grp_stride : (size_t)0);
        const int brow0 = Epi::DUAL ? ((oc0 >> 7) * 256 + (oc0 & 127)) : oc0;
        float acc[4][4], acc2[4][4];
#pragma unroll
        for (int i = 0; i < 4; ++i)
#pragma unroll
            for (int j = 0; j < 4; ++j) { acc[i][j] = 0.f; acc2[i][j] = 0.f; }
        for (int k0 = 0; k0 < K; k0 += 16) {
            __syncthreads();
            { const int r = C.tid >> 2, kc = (C.tid & 3) * 4;
              const u32x2 w = *(const u32x2*)(A + (size_t)(row0 + r) * K + k0 + kc);
              As[(kc + 0) * 132 + r] = bf2f(w.x & 0xffffu); As[(kc + 1) * 132 + r] = bf2f(w.x >> 16); As[(kc + 2) * 132 + r] = bf2f(w.y & 0xffffu); As[(kc + 3) * 132 + r] = bf2f(w.y >> 16); }
            if (C.tid < 256) { const int r = C.tid >> 2, kc = (C.tid & 3) * 4;
              const u32x2 w = *(const u32x2*)(Bg + (size_t)(brow0 + r) * K + k0 + kc);
              Bs[(kc + 0) * 68 + r] = bf2f(w.x & 0xffffu); Bs[(kc + 1) * 68 + r] = bf2f(w.x >> 16); Bs[(kc + 2) * 68 + r] = bf2f(w.y & 0xffffu); Bs[(kc + 3) * 68 + r] = bf2f(w.y >> 16);
              if (Epi::DUAL) { const u32x2 w2 = *(const u32x2*)(Bg + (size_t)(brow0 + 128 + r) * K + k0 + kc);
                Bs2[(kc + 0) * 68 + r] = bf2f(w2.x & 0xffffu); Bs2[(kc + 1) * 68 + r] = bf2f(w2.x >> 16); Bs2[(kc + 2) * 68 + r] = bf2f(w2.y & 0xffffu); Bs2[(kc + 3) * 68 + r] = bf2f(w2.y >> 16); } }
            __syncthreads();
#pragma unroll
            for (int kk = 0; kk < 16; ++kk) {
                const f32x4 a = *(const LAS f32x4*)(As + kk * 132 + ty * 4), b = *(const LAS f32x4*)(Bs + kk * 68 + tx * 4);
#pragma unroll
                for (int i = 0; i < 4; ++i)
#pragma unroll
                    for (int j = 0; j < 4; ++j) acc[i][j] += a[i] * b[j];
                if (Epi::DUAL) { const f32x4 b2 = *(const LAS f32x4*)(Bs2 + kk * 68 + tx * 4);
#pragma unroll
                    for (int i = 0; i < 4; ++i)
#pragma unroll
                        for (int j = 0; j < 4; ++j) acc2[i][j] += a[i] * b2[j]; }
            }
        }
#pragma unroll
        for (int i = 0; i < 4; ++i)
#pragma unroll
            for (int j = 0; j < 4; ++j) E.elem(row0 + ty * 4 + i, oc0 + tx * 4 + j, acc[i][j], acc2[i][j]);
    }
    __syncthreads();
}

template <class Epi>
__device__ __forceinline__ void gemm(const Ctx& C, const bf16* A, const bf16* Bt, int M, int N, int K, int pm_per_grp, size_t grp_stride, const Epi& E) {
#if USE_PG8
    pg8::Gemm g{A, Bt, M, N, K, pm_per_grp, grp_stride}; pg8::StaticOrder S; S.init(M, N, C.G, C.blk);
    pg8::gemm_phase<Epi, pg8::StaticOrder, true, true>(C.lds, g, S, E);
#else
    naive_gemm(C, A, Bt, M, N, K, pm_per_grp, grp_stride, E);
#endif
}

template <int KIND>
__device__ __forceinline__ void ph_attn_naive(const Ctx& C, int slot) {
    constexpr int DQK = KIND == 2 ? 96 : 64, DH = DQK / 2;
    LAS float* Ks = (LAS float*)C.lds;
    LAS float* Vs = Ks + 32 * DQK;
    LAS float* Bsm = Vs + 32 * 64;
    const bf16 *Qb, *Kb, *Vb, *KRb = nullptr; int qp, kp, vp, qhs, khs, vhs, kgrp = 1; float scale;
    if (KIND == 0) { Qb = WSP(bf16, WS_QKV); Kb = Qb + 1024; Vb = Qb + 2048; qp = kp = vp = 3072; qhs = khs = vhs = 64; scale = 0.125f; }
    else if (KIND == 1) { Qb = WSP(bf16, WS_QKV); Kb = Qb + 1024; Vb = Qb + 1280; qp = kp = vp = 1536; qhs = khs = vhs = 64; kgrp = 4; scale = 0.125f; }
    else { Qb = WSP(bf16, WS_Q); Kb = WSP(bf16, WS_KV); Vb = Kb + 64; KRb = WSP(bf16, WS_KROPE); qp = 1536; kp = vp = 2048; qhs = 96; khs = vhs = 128; scale = 0.10206207261596575f; }
    bf16* Ob = WSP(bf16, WS_O);
    const int half = C.tid & 1, qi = C.tid >> 1;
    for (int u = C.blk; u < 1040; u += C.G) {
        const bool isctx = u >= 1024;
        const int h = isctx ? (u - 1024) : (u & 15), q0 = isctx ? SEQ : (u >> 4) * 256, kh = h / kgrp;
        const int t = q0 + qi;
        float q[DH], o[32];
        { const bf16* qr = Qb + (size_t)t * qp + h * qhs + half * DH;
#pragma unroll
          for (int d = 0; d < DH; d += 8) { const u32x4 w = *(const u32x4*)(qr + d);
              q[d + 0] = bf2f(w.x & 0xffffu); q[d + 1] = bf2f(w.x >> 16); q[d + 2] = bf2f(w.y & 0xffffu); q[d + 3] = bf2f(w.y >> 16);
              q[d + 4] = bf2f(w.z & 0xffffu); q[d + 5] = bf2f(w.z >> 16); q[d + 6] = bf2f(w.w & 0xffffu); q[d + 7] = bf2f(w.w >> 16); } }
#pragma unroll
        for (int d = 0; d < 32; ++d) o[d] = 0.f;
        float m = -INFINITY, l = 0.f;
        if (KIND == 1) { m = C.in[13][h]; l = 1.f; }
        int klo = 0, khi = 0;
        if (!isctx) {
            if (KIND == 0) { const int r0 = q0 >> 6; const int ra = r0 - 4 < 0 ? 0 : r0 - 4, rb = r0 + 7 > 255 ? 255 : r0 + 7; klo = ra * 64; khi = (rb + 1) * 64; }
            else if (KIND == 1) { klo = q0 - 128 < 0 ? 0 : q0 - 128; khi = q0 + 384 > SEQ ? SEQ : q0 + 384; }
            else { klo = 0; khi = SEQ; }
        }
        if (KIND == 0) { __syncthreads(); const float* rp = C.in[10] + ((size_t)slot * 16 + h) * 465; for (int i = C.tid; i < 465; i += 512) Bsm[i] = rp[i]; }
        const int qr_ = t >> 6, qc_ = t & 63;
        int rs = qr_ - 4; rs = rs < 0 ? 0 : (rs > 248 ? 248 : rs);
        int cs0 = qc_ - 8; cs0 = cs0 < 0 ? 0 : (cs0 > 48 ? 48 : cs0);
        for (int seg = 0; seg < 2; ++seg) {
            const int kb = seg == 0 ? klo : SEQ, ke = seg == 0 ? khi : R;
            for (int k0 = kb; k0 < ke; k0 += 32) {
                __syncthreads();
                for (int i = C.tid; i < 32 * DQK; i += 512) { const int j = i / DQK, d = i % DQK; const int row = k0 + j;
                    unsigned b;
                    if (KIND == 2 && d >= 64) b = KRb[(size_t)row * 32 + (d - 64)]; else b = Kb[(size_t)row * kp + kh * khs + d];
                    Ks[i] = bf2f(b); }
                for (int i = C.tid; i < 32 * 64; i += 512) { const int j = i >> 6, d = i & 63; Vs[i] = bf2f(Vb[(size_t)(k0 + j) * vp + kh * vhs + d]); }
                __syncthreads();
#pragma unroll 1
                for (int j = 0; j < 32; ++j) {
                    const int kt = k0 + j; bool valid = true; float bias = 0.f;
                    if (seg == 0) {
                        if (KIND == 0) { const int kr = kt >> 6, kc = kt & 63; valid = kr >= rs && kr < rs + 8 && kc >= cs0 && kc < cs0 + 16;
                            if (valid) bias = Bsm[(kr - qr_ + 7) * 31 + (kc - qc_ + 15)]; }
                        else if (KIND == 1) { const int dd = kt - t; valid = dd <= 128 && dd >= -128; }
                    }
                    float s0 = 0.f, s1 = 0.f;
#pragma unroll
                    for (int d = 0; d < DH; d += 4) { const f32x4 kv = *(const LAS f32x4*)(Ks + j * DQK + half * DH + d); s0 += q[d] * kv.x + q[d + 2] * kv.z; s1 += q[d + 1] * kv.y + q[d + 3] * kv.w; }
                    float sp = s0 + s1; sp += __shfl_xor(sp, 1);
                    if (valid) {
                        const float s = sp * scale + bias;
                        if (s > m) { const float a = __expf(m - s); l *= a;
#pragma unroll
                            for (int d = 0; d < 32; ++d) o[d] *= a;
                            m = s; }
                        const float p = __expf(s - m); l += p;
#pragma unroll
                        for (int d = 0; d < 32; d += 4) { const f32x4 vv = *(const LAS f32x4*)(Vs + j * 64 + half * 32 + d); o[d] += p * vv.x; o[d + 1] += p * vv.y; o[d + 2] += p * vv.z; o[d + 3] += p * vv.w; }
                    }
                }
            }
        }
        { const float il = 1.f / l; bf16* orow = Ob + (size_t)t * D + h * 64 + half * 32;
#pragma unroll
            for (int d = 0; d < 32; d += 8) { u32x4 w; w.x = pk2(o[d] * il, o[d + 1] * il); w.y = pk2(o[d + 2] * il, o[d + 3] * il); w.z = pk2(o[d + 4] * il, o[d + 5] * il); w.w = pk2(o[d + 6] * il, o[d + 7] * il);
                *(u32x4*)(orow + d) = w; } }
    }
    __syncthreads();
}

#ifndef USE_FAST_ATTN
#define USE_FAST_ATTN 1
#endif
typedef short bf16x8 __attribute__((ext_vector_type(8)));
typedef short s16x4 __attribute__((ext_vector_type(4)));
typedef float f32x16 __attribute__((ext_vector_type(16)));
__device__ __forceinline__ s16x4 lds_tr16(const LAS unsigned char* p) { return __builtin_bit_cast(s16x4, __builtin_amdgcn_ds_read_tr16_b64_v4i16((LAS s16x4*)p)); }
__device__ __forceinline__ int crow(int r, int hi) { return (r & 3) + 8 * (r >> 2) + 4 * hi; }

template <int KIND>
__device__ __forceinline__ void ph_attn_fast(const Ctx& C, int slot) {
    constexpr int DQK = KIND == 2 ? 96 : 64, NS = DQK / 16, CPR = DQK / 8;
    constexpr int KS = DQK * 2 + 16, VS = 192, KBYTES = 64 * KS, BUFB = KBYTES + 64 * VS;
    LAS unsigned char* lds = C.lds;
    LAS float* Bsm = (LAS float*)(lds + 2 * BUFB);
    const bf16 *Qb, *Kb, *Vb, *KRb = nullptr; int qp, kp, vp, qhs, khs, vhs, kgrp = 1; float scale;
    if (KIND == 0) { Qb = WSP(bf16, WS_QKV); Kb = Qb + 1024; Vb = Qb + 2048; qp = kp = vp = 3072; qhs = khs = vhs = 64; scale = 0.125f; }
    else if (KIND == 1) { Qb = WSP(bf16, WS_QKV); Kb = Qb + 1024; Vb = Qb + 1280; qp = kp = vp = 1536; qhs = khs = vhs = 64; kgrp = 4; scale = 0.125f; }
    else { Qb = WSP(bf16, WS_Q); Kb = WSP(bf16, WS_KV); Vb = Kb + 64; KRb = WSP(bf16, WS_KROPE); qp = 1536; kp = vp = 2048; qhs = 96; khs = vhs = 128; scale = 0.10206207261596575f; }
    bf16* Ob = WSP(bf16, WS_O);
    const float c2 = scale * 1.4426950408889634f;
    const int w = C.wave, lane = C.lane, ql = lane & 31, hi = lane >> 5;
    const int kr0 = C.tid / CPR, kc0 = C.tid % CPR, kr1 = (C.tid + 512) / CPR, kc1 = (C.tid + 512) % CPR, vr = C.tid >> 3, vc = C.tid & 7;
    const bool k2 = (DQK == 96) && C.tid < 256;
    const int vlane = (((lane & 15) >> 2) + 4 * hi) * VS + (16 * ((lane >> 4) & 1) + 4 * (lane & 3)) * 2;
    for (int u = C.blk; u < 1040; u += C.G) {
        const bool isctx = u >= 1024;
        const int h = isctx ? (u - 1024) : (u & 15), q0 = isctx ? SEQ : (u >> 4) * 256, kh = h / kgrp;
        int lat0 = 0, nlat = 0;
        if (!isctx) {
            if (KIND == 0) { const int r0 = q0 >> 6; int ta = r0 - 4; ta = ta < 0 ? 0 : (ta > 248 ? 248 : ta); int tb = r0 - 1; tb = (tb < 0 ? 0 : (tb > 248 ? 248 : tb)) + 7; lat0 = ta; nlat = tb - ta + 1; }
            else if (KIND == 1) { const int a = q0 - 128 < 0 ? 0 : q0 - 128, b = q0 + 384 > SEQ ? SEQ : q0 + 384; lat0 = a >> 6; nlat = (b - a) >> 6; }
            else { lat0 = 0; nlat = SEQ / 64; }
        }
        const int ntiles = nlat + 4;
        const int t = q0 + 32 * w + ql;
        bf16x8 qf[NS];
        { const bf16* qr = Qb + (size_t)t * qp + h * qhs + 8 * hi;
#pragma unroll
          for (int sidx = 0; sidx < NS; ++sidx) qf[sidx] = *(const bf16x8*)(qr + 16 * sidx); }
        __syncthreads();
        if (KIND == 0) { const float* rp = C.in[10] + ((size_t)slot * 16 + h) * 465; for (int i = C.tid; i < 465; i += 512) Bsm[i] = rp[i] * 1.4426950408889634f; }
        float m = -INFINITY, l = 0.f;
        if (KIND == 1) { m = C.in[13][h] * 1.4426950408889634f; l = 1.f; }
        f32x16 ot[2];
#pragma unroll
        for (int r = 0; r < 16; ++r) { ot[0][r] = 0.f; ot[1][r] = 0.f; }
        const int qr_ = t >> 6, qc_ = t & 63;
        int rs = qr_ - 4; rs = rs < 0 ? 0 : (rs > 248 ? 248 : rs);
        int cs0 = qc_ - 8; cs0 = cs0 < 0 ? 0 : (cs0 > 48 ? 48 : cs0);
        const int wrow = (q0 >> 6) + (w >> 1);
        int wrs = wrow - 4; wrs = wrs < 0 ? 0 : (wrs > 248 ? 248 : wrs);
        const int wq0 = q0 + 32 * w;
        u32x4 kreg0, kreg1 = (u32x4){0u, 0u, 0u, 0u}, vreg;
#define ATT_KEY0(i) ((i) < nlat ? (lat0 + (i)) * 64 : SEQ + ((i) - nlat) * 64)
#define ATT_LOAD(i) do { const int key0_ = ATT_KEY0(i); \
        kreg0 = (KIND == 2 && kc0 >= 8) ? *(const u32x4*)(KRb + (size_t)(key0_ + kr0) * 32 + 8 * (kc0 - 8)) : *(const u32x4*)(Kb + (size_t)(key0_ + kr0) * kp + kh * khs + 8 * kc0); \
        if (k2) kreg1 = (kc1 >= 8) ? *(const u32x4*)(KRb + (size_t)(key0_ + kr1) * 32 + 8 * (kc1 - 8)) : *(const u32x4*)(Kb + (size_t)(key0_ + kr1) * kp + kh * khs + 8 * kc1); \
        vreg = *(const u32x4*)(Vb + (size_t)(key0_ + vr) * vp + kh * vhs + 8 * vc); } while (0)
#define ATT_STORE(b) do { LAS unsigned char* base_ = lds + (b) * BUFB; \
        *(LAS u32x4*)(base_ + kr0 * KS + 16 * kc0) = kreg0; if (k2) *(LAS u32x4*)(base_ + kr1 * KS + 16 * kc1) = kreg1; \
        *(LAS u32x4*)(base_ + KBYTES + vr * VS + 16 * vc) = vreg; } while (0)
        ATT_LOAD(0); ATT_STORE(0);
        __syncthreads();
        for (int i = 0; i < ntiles; ++i) {
            if (i + 1 < ntiles) ATT_LOAD(i + 1);
            const bool lat = i < nlat; const int key0 = ATT_KEY0(i);
            bool need = true;
            if (lat) { if (KIND == 0) { const int kr = lat0 + i; need = kr >= wrs && kr < wrs + 8; }
                       else if (KIND == 1) need = (key0 + 63 >= wq0 - 128) && (key0 <= wq0 + 31 + 128); }
            if (need) {
                const LAS unsigned char* kb = lds + (i & 1) * BUFB; const LAS unsigned char* vb = kb + KBYTES;
                f32x16 p0, p1;
#pragma unroll
                for (int r = 0; r < 16; ++r) { p0[r] = 0.f; p1[r] = 0.f; }
#pragma unroll
                for (int sidx = 0; sidx < NS; ++sidx) {
                    const bf16x8 a0 = *(const LAS bf16x8*)(kb + ql * KS + 32 * sidx + 16 * hi);
                    const bf16x8 a1 = *(const LAS bf16x8*)(kb + (32 + ql) * KS + 32 * sidx + 16 * hi);
                    p0 = __builtin_amdgcn_mfma_f32_32x32x16_bf16(a0, qf[sidx], p0, 0, 0, 0);
                    p1 = __builtin_amdgcn_mfma_f32_32x32x16_bf16(a1, qf[sidx], p1, 0, 0, 0);
                }
                float mx = -INFINITY;
#pragma unroll
                for (int r = 0; r < 16; ++r) {
                    float s0 = p0[r] * c2, s1 = p1[r] * c2;
                    if (lat && KIND == 0) { const int kr = lat0 + i; const int kc = crow(r, hi);
                        const bool v0 = (unsigned)(kc - cs0) < 16u, v1 = (unsigned)(kc + 32 - cs0) < 16u;
                        const int bi = (kr - qr_ + 7) * 31 + (kc - qc_ + 15);
                        s0 = v0 ? s0 + Bsm[v0 ? bi : 0] : -INFINITY; s1 = v1 ? s1 + Bsm[v1 ? bi + 32 : 0] : -INFINITY; }
                    if (lat && KIND == 1) { const int dd = key0 + crow(r, hi) - t; s0 = (unsigned)(dd + 128) <= 256u ? s0 : -INFINITY; s1 = (unsigned)(dd + 32 + 128) <= 256u ? s1 : -INFINITY; }
                    p0[r] = s0; p1[r] = s1; mx = fmaxf(mx, fmaxf(s0, s1));
                }
                mx = fmaxf(mx, __shfl_xor(mx, 32));
                const float mn = fmaxf(m, mx), ms = mn == -INFINITY ? 0.f : mn;
                const float alpha = __builtin_amdgcn_exp2f(m - ms);
                float rsum = 0.f;
#pragma unroll
                for (int r = 0; r < 16; ++r) { p0[r] = __builtin_amdgcn_exp2f(p0[r] - ms); p1[r] = __builtin_amdgcn_exp2f(p1[r] - ms); rsum += p0[r] + p1[r]; }
                rsum += __shfl_xor(rsum, 32);
                l = l * alpha + rsum; m = mn;
#pragma unroll
                for (int r = 0; r < 16; ++r) { ot[0][r] *= alpha; ot[1][r] *= alpha; }
                bf16x8 pf[4];
#pragma unroll
                for (int ks = 0; ks < 4; ++ks) { u32x4 pw;
                    if (ks < 2) { pw.x = cvt_pk_bf16(p0[8 * ks + 0], p0[8 * ks + 1]); pw.y = cvt_pk_bf16(p0[8 * ks + 2], p0[8 * ks + 3]); pw.z = cvt_pk_bf16(p0[8 * ks + 4], p0[8 * ks + 5]); pw.w = cvt_pk_bf16(p0[8 * ks + 6], p0[8 * ks + 7]); }
                    else { const int k8 = 8 * (ks - 2); pw.x = cvt_pk_bf16(p1[k8 + 0], p1[k8 + 1]); pw.y = cvt_pk_bf16(p1[k8 + 2], p1[k8 + 3]); pw.z = cvt_pk_bf16(p1[k8 + 4], p1[k8 + 5]); pw.w = cvt_pk_bf16(p1[k8 + 6], p1[k8 + 7]); }
                    pf[ks] = __builtin_bit_cast(bf16x8, pw); }
#pragma unroll
                for (int c = 0; c < 2; ++c)
#pragma unroll
                    for (int ks = 0; ks < 4; ++ks) {
                        const LAS unsigned char* vp_ = vb + vlane + (32 * (ks >> 1) + 16 * (ks & 1)) * VS + 64 * c;
                        const s16x4 lo = lds_tr16(vp_), hi4 = lds_tr16(vp_ + 8 * VS);
                        const bf16x8 av = (bf16x8){lo[0], lo[1], lo[2], lo[3], hi4[0], hi4[1], hi4[2], hi4[3]};
                        ot[c] = __builtin_amdgcn_mfma_f32_32x32x16_bf16(av, pf[ks], ot[c], 0, 0, 0);
                    }
            }
            if (i + 1 < ntiles) ATT_STORE((i + 1) & 1);
            __syncthreads();
        }
#undef ATT_KEY0
#undef ATT_LOAD
#undef ATT_STORE
        { const float il = 1.f / l; bf16* orow = Ob + (size_t)t * D + h * 64 + 4 * hi;
#pragma unroll
          for (int c = 0; c < 2; ++c)
#pragma unroll
            for (int g = 0; g < 4; ++g) { u32x2 o2; o2.x = cvt_pk_bf16(ot[c][4 * g] * il, ot[c][4 * g + 1] * il); o2.y = cvt_pk_bf16(ot[c][4 * g + 2] * il, ot[c][4 * g + 3] * il);
                *(u32x2*)(orow + 32 * c + 8 * g) = o2; } }
    }
    __syncthreads();
}
template <int KIND>
__device__ __forceinline__ void ph_attn(const Ctx& C, int slot) {
#if USE_FAST_ATTN
    ph_attn_fast<KIND>(C, slot);
#else
    ph_attn_naive<KIND>(C, slot);
#endif
}

#define PH_BEGIN if (lo <= ph && ph < hi) {
#define PH_END   if (ph + 1 < hi) xcd_barrier(bar); } ++ph;
template <int L>
__device__ __forceinline__ void layer_phases(const Ctx& C, const XcdBarrier& bar, int lo, int hi, int& ph) {
    constexpr int l = L, kind = L % 3, slot = L / 3;
    PH_BEGIN ph_rowA<0>(C, l); PH_END
    if constexpr (kind == 0) {
        PH_BEGIN gemm(C, WSP(bf16, WS_H), WSP(bf16, WS_W_NAQKV) + (size_t)slot * 3072 * 1024, R, 3072, 1024, 0, 0, EpiStoreBf16{WSP(bf16, WS_QKV), 3072}); PH_END
        PH_BEGIN ph_attn<0>(C, slot); PH_END
    } else if constexpr (kind == 1) {
        PH_BEGIN gemm(C, WSP(bf16, WS_H), WSP(bf16, WS_W_SWAQKV), R, 1536, 1024, 0, 0, EpiStoreBf16{WSP(bf16, WS_QKV), 1536}); PH_END
        PH_BEGIN ph_rope(C, WSP(bf16, WS_QKV), 1536, 20, 64, 0, 16); PH_END
        PH_BEGIN ph_attn<1>(C, slot); PH_END
    } else {
        PH_BEGIN gemm(C, WSP(bf16, WS_H), WSP(bf16, WS_W_MLAD), R, 1024, 1024, 0, 0, EpiStoreF32{WSP(float, WS_CQ), 1024}); PH_END
        PH_BEGIN ph_mlanorm(C); PH_END
        PH_BEGIN gemm(C, WSP(bf16, WS_CQN), WSP(bf16, WS_W_MLAUQ), R, 1536, 512, 0, 0, EpiStoreBf16{WSP(bf16, WS_Q), 1536});
                 gemm(C, WSP(bf16, WS_CKVN), WSP(bf16, WS_W_MLAUKV), R, 2048, 256, 0, 0, EpiStoreBf16{WSP(bf16, WS_KV), 2048}); PH_END
        PH_BEGIN ph_rope(C, WSP(bf16, WS_Q), 1536, 16, 96, 64, 8); PH_END
        PH_BEGIN ph_attn<2>(C, slot); PH_END
    }
    const bf16* wo = kind == 0 ? WSP(bf16, WS_W_NAO) + (size_t)slot * 1024 * 1024 : (kind == 1 ? WSP(bf16, WS_W_SWAO) : WSP(bf16, WS_W_MLAO));
    PH_BEGIN gemm(C, WSP(bf16, WS_O), wo, R, 1024, 1024, 0, 0, EpiResid{WSP(float, WS_X), modp(C, l, 0, 2), modp(C, l, 1, 2)}); PH_END
    PH_BEGIN ph_norm2(C, l); PH_END
    PH_BEGIN ph_topk(C); PH_END
    PH_BEGIN ph_gather(C); PH_END
    PH_BEGIN gemm(C, WSP(bf16, WS_XG), WSP(bf16, WS_W_GU) + (size_t)l * 16 * 4096 * 1024, XROWS, 4096, 1024, 9, (size_t)4096 * 1024, EpiSwiglu{WSP(bf16, WS_ACT)}); PH_END
    PH_BEGIN gemm(C, WSP(bf16, WS_ACT), WSP(bf16, WS_W_DN) + (size_t)l * 16 * 1024 * 2048, XROWS, 1024, 2048, 9, (size_t)1024 * 2048, EpiMoeOut{WSP(bf16, WS_YB), WSP(float, WS_GATEL)}); PH_END
}
__global__ void __launch_bounds__(512, 2) fwd_kernel(Args args) {
    extern __shared__ __attribute__((aligned(16))) unsigned char lds_raw[];
    Ctx C;
#pragma unroll
    for (int i = 0; i < 26; ++i) C.in[i] = args.in[i];
    C.out = args.out; C.ws = args.ws; C.lds = (LAS unsigned char*)lds_raw;
    C.tid = threadIdx.x; C.lane = C.tid & 63; C.wave = __builtin_amdgcn_readfirstlane(C.tid >> 6); C.blk = blockIdx.x; C.G = gridDim.x;
    volatile LAS unsigned* MISC = (volatile LAS unsigned*)(C.lds + MISC_OFF);
    if (C.tid < 32) MISC[C.tid] = 0u;
    __syncthreads();
    const int lo = args.ph_lo, hi = args.ph_hi;
    XcdBarrier bar; bar.bar = (unsigned*)(C.ws + WS_CTL) + CW_BAR; bar.x = 0; bar.st = nullptr;
    if (hi - lo > 1) bar = xcd_barrier_post((unsigned*)(C.ws + WS_CTL) + CW_BAR, MISC + 8);
    int ph = 0;
    PH_BEGIN ph_prologue(C); PH_END
    layer_phases<0>(C, bar, lo, hi, ph);
    layer_phases<1>(C, bar, lo, hi, ph);
    layer_phases<2>(C, bar, lo, hi, ph);
    layer_phases<3>(C, bar, lo, hi, ph);
    PH_BEGIN ph_rowA<1>(C, 4); PH_END
}
#undef PH_BEGIN
#undef PH_END

extern "C" void kernel_launch(void* const* d_in, const int* in_sizes, int n_in, void* d_out, int out_size, void* d_ws, size_t ws_size, hipStream_t stream) {
    static int grid = 0;
    if (grid == 0) {
        if (n_in != 26 || out_size != SEQ * D || ws_size < WS_END) { fprintf(stderr, "kernel_launch: unexpected shapes (n_in %d out %d ws %zu)\n", n_in, out_size, ws_size); grid = -1; return; }
        int dev = 0, cus = 0, per_cu = 0;
        if (hipGetDevice(&dev) != hipSuccess || hipDeviceGetAttribute(&cus, hipDeviceAttributeMultiprocessorCount, dev) != hipSuccess) { grid = -1; return; }
        if (hipFuncSetAttribute((const void*)fwd_kernel, hipFuncAttributeMaxDynamicSharedMemorySize, LDS_BYTES) != hipSuccess) { fprintf(stderr, "kernel_launch: hipFuncSetAttribute failed\n"); grid = -1; return; }
        if (hipOccupancyMaxActiveBlocksPerMultiprocessor(&per_cu, (const void*)fwd_kernel, 512, LDS_BYTES) != hipSuccess || per_cu < 1) fprintf(stderr, "kernel_launch: occupancy query says %d\n", per_cu);
        (void)hipGetLastError();
        grid = cus;
    }
    if (grid < 0) return;
    if (hipMemsetAsync((char*)d_ws + WS_CTL, 0, CTL_ZERO_BYTES, stream) != hipSuccess) return;
    Args a{};
    for (int i = 0; i < 26; ++i) a.in[i] = (const float*)d_in[i];
    a.out = (float*)d_out; a.ws = (unsigned char*)d_ws; a.pad = 0;
#if MK_N_LAUNCHES == 1
    a.ph_lo = 0; a.ph_hi = NPH; a.li = 0;
    hipLaunchKernelGGL(fwd_kernel, dim3(grid), dim3(512), LDS_BYTES, stream, a);
#else
    for (int li = 0; li < NPH; ++li) { a.ph_lo = li; a.ph_hi = li + 1; a.li = li;
        hipLaunchKernelGGL(fwd_kernel, dim3(grid), dim3(512), LDS_BYTES, stream, a); }
#endif
}
```

```cpp
#include <hip/hip_runtime.h>
#include <cstdio>
#include <cstdint>

#ifndef MK_N_LAUNCHES
#define MK_N_LAUNCHES 1
#endif

#define GAS __attribute__((address_space(1)))
#define LAS __attribute__((address_space(3)))
typedef unsigned short bf16;
typedef float f32x4 __attribute__((ext_vector_type(4)));
typedef unsigned u32x4 __attribute__((ext_vector_type(4)));
typedef unsigned u32x2 __attribute__((ext_vector_type(2)));

constexpr int D = 1024, SEQ = 16384, NCTX = 256, R = SEQ + NCTX, NE = 16, FF = 2048;
constexpr int CAP_L = 2048, CAP_C = 32, EROWS = 2304, XROWS = NE * EROWS;
constexpr float RMS_EPS = 1e-6f;
constexpr int NPH = 1 + 9 + 10 + 12 + 9 + 1;

constexpr size_t MiB = 1u << 20;
constexpr size_t WS_CTL = 0, CTL_ZERO_BYTES = 1 * MiB;
constexpr size_t WS_MOD = 1 * MiB;
constexpr size_t WS_W_NAQKV = 2 * MiB;
constexpr size_t WS_W_NAO = 14 * MiB;
constexpr size_t WS_W_SWAQKV = 18 * MiB;
constexpr size_t WS_W_SWAO = 21 * MiB;
constexpr size_t WS_W_MLAD = 23 * MiB;
constexpr size_t WS_W_MLAUQ = 25 * MiB;
constexpr size_t WS_W_MLAUKV = 27 * MiB;
constexpr size_t WS_W_MLAO = 28 * MiB;
constexpr size_t WS_W_GU = 32 * MiB;
constexpr size_t WS_W_DN = WS_W_GU + 512 * MiB;
constexpr size_t WS_X = WS_W_DN + 256 * MiB;
constexpr size_t WS_H = WS_X + 65 * MiB;
constexpr size_t WS_QKV = WS_H + 33 * MiB;
constexpr size_t WS_CQ = WS_QKV + 98 * MiB;
constexpr size_t WS_Q = WS_CQ + 65 * MiB;
constexpr size_t WS_KV = WS_Q + 49 * MiB;
constexpr size_t WS_CQN = WS_KV + 65 * MiB;
constexpr size_t WS_CKVN = WS_CQN + 17 * MiB;
constexpr size_t WS_KROPE = WS_CKVN + 9 * MiB;
constexpr size_t WS_O = WS_KROPE + 2 * MiB;
constexpr size_t WS_AFF = WS_O + 33 * MiB;
constexpr size_t WS_ROWL = WS_AFF + 2 * MiB;
constexpr size_t WS_GATEL = WS_ROWL + 1 * MiB;
constexpr size_t WS_INV = WS_GATEL + 1 * MiB;
constexpr size_t WS_XG = WS_INV + 2 * MiB;
constexpr size_t WS_ACT = WS_XG + 72 * MiB;
constexpr size_t WS_YB = WS_ACT + 144 * MiB;
constexpr size_t WS_END = WS_YB + 72 * MiB;
static_assert(WS_END <= 2048 * MiB, "d_ws map");
constexpr int CW_BAR = 4096;

constexpr int LDS_BYTES = 147456;
constexpr int MISC_OFF = 131072 + 320;

__device__ __forceinline__ float bf2f(unsigned b) { return __uint_as_float(b << 16); }
__device__ __forceinline__ unsigned f2bf(float f) { unsigned u = __float_as_uint(f); return (u + 0x7fffu + ((u >> 16) & 1u)) >> 16; }
__device__ __forceinline__ unsigned pk2(float lo, float hi) { return f2bf(lo) | (f2bf(hi) << 16); }
__device__ __forceinline__ float wave_sum(float v) {
#pragma unroll
    for (int o = 1; o < 64; o <<= 1) v += __shfl_xor(v, o);
    return v;
}
__device__ __forceinline__ int wave_sum_i(int v) {
#pragma unroll
    for (int o = 1; o < 64; o <<= 1) v += __shfl_xor(v, o);
    return v;
}

#define XB_TMO      128
#define XB_XCNT(j)  (256  + 64 * (j))
#define XB_XSUB(j)  (1280 + 64 * (j))
#define XB_XGEN(j)  (2304 + 64 * (j))
#define XB_TOP      3328
#define XB_TOPGEN   3392
#define XCD_BAR_WORDS 3456
#define XB_SPIN_CAP (1u << 18)
__device__ __forceinline__ unsigned xb_ld(unsigned* p)              { return __hip_atomic_load(p, __ATOMIC_RELAXED, __HIP_MEMORY_SCOPE_AGENT); }
__device__ __forceinline__ unsigned xb_add(unsigned* p, unsigned v) { return __hip_atomic_fetch_add(p, v, __ATOMIC_RELAXED, __HIP_MEMORY_SCOPE_AGENT); }
__device__ __forceinline__ unsigned xb_xcc_id() { return (unsigned)__builtin_amdgcn_s_getreg((3 << 11) | 20) & 0xFu; }
#define XB_SPIN(cond, bar) do { unsigned _sp = 0; while (cond) { __builtin_amdgcn_s_sleep(1); \
    if ((++_sp & 255u) == 0u) { if (xb_ld(&(bar)[XB_TMO])) break; if (_sp > XB_SPIN_CAP) { atomicAdd(&(bar)[XB_TMO], 1u); break; } } } } while (0)
struct XcdBarrier { unsigned* bar; unsigned x; volatile LAS unsigned* st; };
__device__ __forceinline__ XcdBarrier xcd_barrier_post(unsigned* bar, volatile LAS unsigned* st) {
    XcdBarrier b; b.bar = bar; b.x = xb_xcc_id(); b.st = st;
    if (threadIdx.x == 0) (void)xb_add(&bar[XB_XCNT(b.x)], 1u);
    return b;
}
__device__ __forceinline__ void xcd_barrier_complete(unsigned* bar, unsigned x, unsigned& nloc, unsigned& nx) {
    const unsigned G = gridDim.x * gridDim.y * gridDim.z;
    unsigned sum, cnt, mine, sp = 0u;
    for (;;) {
        sum = 0u; cnt = 0u; mine = 0u;
#pragma unroll
        for (unsigned j = 0; j < 16; ++j) { const unsigned c = xb_ld(&bar[XB_XCNT(j)]); sum += c; cnt += (c > 0u) ? 1u : 0u; mine = (j == x) ? c : mine; }
        if (sum == G) break;
        __builtin_amdgcn_s_sleep(1);
        if ((++sp & 255u) == 0u) { if (xb_ld(&bar[XB_TMO])) break; if (sp > XB_SPIN_CAP) { atomicAdd(&bar[XB_TMO], 1u); break; } }
    }
    nloc = mine > 0u ? mine : 1u; nx = cnt > 0u ? cnt : 1u;
}
__device__ __forceinline__ void xcd_barrier(const XcdBarrier& b) {
    asm volatile("s_waitcnt vmcnt(0)" ::: "memory");
    __syncthreads();
    if (threadIdx.x == 0) {
        unsigned* bar = b.bar;
        __builtin_amdgcn_s_waitcnt(0);
        unsigned nloc = b.st[0], nx = b.st[1];
        if (nloc == 0u) { xcd_barrier_complete(bar, b.x, nloc, nx); b.st[0] = nloc; b.st[1] = nx; }
        const unsigned old = xb_add(&bar[XB_XSUB(b.x)], 1u);
        const unsigned gen = old / nloc;
        if (old + 1u == (gen + 1u) * nloc) {
            __builtin_amdgcn_fence(__ATOMIC_RELEASE, "agent");
            asm volatile("s_waitcnt vmcnt(0)" ::: "memory");
            const unsigned og = xb_add(&bar[XB_TOP], 1u);
            const unsigned tg = og / nx;
            if (og + 1u == (tg + 1u) * nx) xb_add(&bar[XB_TOPGEN], 1u);
            else XB_SPIN(xb_ld(&bar[XB_TOPGEN]) == tg, bar);
            __builtin_amdgcn_fence(__ATOMIC_ACQUIRE, "agent");
            xb_add(&bar[XB_XGEN(b.x)], 1u);
            asm volatile("s_waitcnt vmcnt(0)" ::: "memory");
        } else {
            XB_SPIN(xb_ld(&bar[XB_XGEN(b.x)]) == gen, bar);
            __builtin_amdgcn_fence(__ATOMIC_ACQUIRE, "agent");
            asm volatile("s_waitcnt vmcnt(0)" ::: "memory");
        }
    }
    __syncthreads();
}

struct Args { const float* in[26]; float* out; unsigned char* ws; int ph_lo, ph_hi, li, pad; };
struct Ctx {
    const float* in[26]; float* out; unsigned char* ws;
    LAS unsigned char* lds;
    int tid, lane, wave, blk, G;
};
#define WSP(T, off) ((T*)(C.ws + (off)))
__device__ __forceinline__ const float* modp(const Ctx& C, int l, int set, int j) { return (const float*)(C.ws + WS_MOD) + ((l * 2 + set) * 6 + j) * D; }

__device__ __forceinline__ void p0_transpose_item(const float* W, int K, int N, bf16* WT, int k0, int n0, int drow0, LAS float* scr, int lane) {
#pragma unroll 8
    for (int i = 0; i < 32; ++i) { const int kk = 2 * i + (lane >> 5); scr[kk * 33 + (lane & 31)] = W[(size_t)(k0 + kk) * N + n0 + (lane & 31)]; }
    asm volatile("s_waitcnt lgkmcnt(0)" ::: "memory");
    const int c = lane & 7;
#pragma unroll
    for (int j = 0; j < 4; ++j) { const int n = (lane >> 3) + 8 * j; const LAS float* s = scr + (8 * c) * 33 + n;
        u32x4 o; o.x = pk2(s[0 * 33], s[1 * 33]); o.y = pk2(s[2 * 33], s[3 * 33]); o.z = pk2(s[4 * 33], s[5 * 33]); o.w = pk2(s[6 * 33], s[7 * 33]);
        *(u32x4*)(WT + (size_t)(drow0 + n) * K + k0 + 8 * c) = o; }
    asm volatile("s_waitcnt lgkmcnt(0)" ::: "memory");
}
__device__ __forceinline__ bool p0_plain(int& r, const float* W, int K, int N, bf16* WT, int row_off, LAS float* scr, int lane) {
    const int nblk = N / 32, cnt = (K / 64) * nblk;
    if (r >= cnt) { r -= cnt; return false; }
    const int kb = r / nblk, nb = r % nblk;
    p0_transpose_item(W, K, N, WT, kb * 64, nb * 32, row_off + nb * 32, scr, lane);
    return true;
}
__device__ __forceinline__ void ph_prologue(const Ctx& C) {
    LAS float* scr = (LAS float*)(C.lds + C.wave * 16384);
    const int gw = C.blk * 8 + C.wave, NGW = C.G * 8;
    constexpr int MOE_ITEMS = 4 * 16 * 3072;
    constexpr int SMALL_ITEMS = 2 * 1536 + 2 * 512 + 768 + 512 + 256 + 144 + 384 + 256 + 512;
    for (int it = gw; it < MOE_ITEMS + SMALL_ITEMS; it += NGW) {
        if (it < MOE_ITEMS) {
            const int le = it / 3072, r2 = it % 3072, which = r2 / 1024, item = r2 % 1024, l = le / 16, e = le % 16;
            if (which < 2) {
                const float* W = (which ? C.in[23] : C.in[22]) + (size_t)le * 1024 * 2048;
                bf16* WT = WSP(bf16, WS_W_GU) + ((size_t)l * 16 + e) * 4096 * 1024;
                const int kb = item / 64, nb = item % 64, n0 = nb * 32;
                p0_transpose_item(W, 1024, 2048, WT, kb * 64, n0, (n0 >> 7) * 256 + (n0 & 127) + which * 128, scr, C.lane);
            } else {
                const float* W = C.in[24] + (size_t)le * 2048 * 1024;
                bf16* WT = WSP(bf16, WS_W_DN) + ((size_t)l * 16 + e) * 1024 * 2048;
                const int kb = item / 32, nb = item % 32;
                p0_transpose_item(W, 2048, 1024, WT, kb * 64, nb * 32, nb * 32, scr, C.lane);
            }
            continue;
        }
        int r = it - MOE_ITEMS;
        if (p0_plain(r, C.in[8], 1024, 3072, WSP(bf16, WS_W_NAQKV), 0, scr, C.lane)) continue;
        if (p0_plain(r, C.in[8] + (size_t)1024 * 3072, 1024, 3072, WSP(bf16, WS_W_NAQKV) + (size_t)3072 * 1024, 0, scr, C.lane)) continue;
        if (p0_plain(r, C.in[9], 1024, 1024, WSP(bf16, WS_W_NAO), 0, scr, C.lane)) continue;
        if (p0_plain(r, C.in[9] + (size_t)1024 * 1024, 1024, 1024, WSP(bf16, WS_W_NAO) + (size_t)1024 * 1024, 0, scr, C.lane)) continue;
        if (p0_plain(r, C.in[11], 1024, 1536, WSP(bf16, WS_W_SWAQKV), 0, scr, C.lane)) continue;
        if (p0_plain(r, C.in[12], 1024, 1024, WSP(bf16, WS_W_SWAO), 0, scr, C.lane)) continue;
        if (p0_plain(r, C.in[14], 1024, 512, WSP(bf16, WS_W_MLAD), 0, scr, C.lane)) continue;
        if (p0_plain(r, C.in[17], 1024, 288, WSP(bf16, WS_W_MLAD), 512, scr, C.lane)) continue;
        if (p0_plain(r, C.in[16], 512, 1536, WSP(bf16, WS_W_MLAUQ), 0, scr, C.lane)) continue;
        if (p0_plain(r, C.in[19], 256, 2048, WSP(bf16, WS_W_MLAUKV), 0, scr, C.lane)) continue;
        p0_plain(r, C.in[20], 1024, 1024, WSP(bf16, WS_W_MLAO), 0, scr, C.lane);
    }
    { u32x4* z = (u32x4*)(WSP(bf16, WS_W_MLAD) + (size_t)800 * 1024); const int n16 = 224 * 1024 * 2 / 16;
      for (int i = C.blk * 512 + C.tid; i < n16; i += C.G * 512) z[i] = (u32x4){0u, 0u, 0u, 0u}; }
    __syncthreads();
    LAS float* sc = (LAS float*)C.lds;
    LAS float* red = sc + 2048;
    for (int i = C.tid; i < 2048; i += 512) { const float v = (i < 1024) ? C.in[1][i] : C.in[3][i - 1024]; sc[i] = v / (1.f + __expf(-v)); }
    __syncthreads();
    for (int u = C.blk; u < 4 * 96; u += C.G) {
        const int l = u / 96, j0 = (u % 96) * 64, kq = C.tid >> 6, jj = C.tid & 63;
        const float* W = C.in[4] + (size_t)l * 1024 * 6144 + j0 + jj;
        float a0 = 0.f, a1 = 0.f;
#pragma unroll 8
        for (int k = kq * 128; k < kq * 128 + 128; ++k) { const float w = W[(size_t)k * 6144]; a0 += sc[k] * w; a1 += sc[1024 + k] * w; }
        red[kq * 64 + jj] = a0; red[512 + kq * 64 + jj] = a1;
        __syncthreads();
        if (C.tid < 128) { const int set = C.tid >> 6, j = C.tid & 63; float s = 0.f;
#pragma unroll
            for (int q = 0; q < 8; ++q) s += red[set * 512 + q * 64 + j];
            const int col = j0 + j;
            ((float*)(C.ws + WS_MOD))[((l * 2 + set) * 6) * D + col] = s + C.in[5][l * 6144 + col]; }
        __syncthreads();
    }
}

template <int MODE>
__device__ __forceinline__ void ph_rowA(const Ctx& C, int l) {
    float* X = WSP(float, WS_X); bf16* H = WSP(bf16, WS_H); const int* INV = WSP(int, WS_INV); const bf16* YB = WSP(bf16, WS_YB);
    const int nrows = MODE == 1 ? SEQ : R;
    for (int t = C.blk * 8 + C.wave; t < nrows; t += C.G * 8) {
        const int set = t >= SEQ ? 1 : 0;
        const float* src = (MODE == 0 && l == 0) ? (set ? C.in[2] + (size_t)(t - SEQ) * D : C.in[0] + (size_t)t * D) : X + (size_t)t * D;
        f32x4 v[4];
#pragma unroll
        for (int j = 0; j < 4; ++j) v[j] = ((const f32x4*)src)[C.lane + 64 * j];
        if (MODE == 1 || l > 0) {
            const int lp = MODE == 1 ? 3 : l - 1;
            const int myinv = C.lane < 16 ? INV[(size_t)t * 16 + C.lane] : -1;
            f32x4 a[4];
#pragma unroll
            for (int j = 0; j < 4; ++j) a[j] = (f32x4){0.f, 0.f, 0.f, 0.f};
            for (int e = 0; e < 16; ++e) {
                const int s = __shfl(myinv, e);
                if (s >= 0) {
                    const u32x2* yr = (const u32x2*)(YB + ((size_t)e * EROWS + s) * D);
#pragma unroll
                    for (int j = 0; j < 4; ++j) { const u32x2 w = yr[C.lane + 64 * j];
                        a[j] += (f32x4){bf2f(w.x & 0xffffu), bf2f(w.x >> 16), bf2f(w.y & 0xffffu), bf2f(w.y >> 16)}; }
                }
            }
            const f32x4* g = (const f32x4*)modp(C, lp, set, 5);
#pragma unroll
            for (int j = 0; j < 4; ++j) v[j] += g[C.lane + 64 * j] * a[j];
        }
        if (MODE == 0) {
#pragma unroll
            for (int j = 0; j < 4; ++j) ((f32x4*)(X + (size_t)t * D))[C.lane + 64 * j] = v[j];
        }
        float ss = 0.f;
#pragma unroll
        for (int j = 0; j < 4; ++j) ss += (v[j].x * v[j].x + v[j].y * v[j].y) + (v[j].z * v[j].z + v[j].w * v[j].w);
        const float rstd = rsqrtf(wave_sum(ss) * (1.f / D) + RMS_EPS);
        if (MODE == 0) {
            const f32x4* w = (const f32x4*)(C.in[6] + (size_t)l * D); const f32x4* sh = (const f32x4*)modp(C, l, set, 0); const f32x4* scl = (const f32x4*)modp(C, l, set, 1);
#pragma unroll
            for (int j = 0; j < 4; ++j) { const int i = C.lane + 64 * j; const f32x4 y = v[j] * rstd * w[i] * (scl[i] + 1.f) + sh[i];
                u32x2 o; o.x = pk2(y.x, y.y); o.y = pk2(y.z, y.w); ((u32x2*)(H + (size_t)t * D))[i] = o; }
        } else {
            const f32x4* w = (const f32x4*)C.in[25];
#pragma unroll
            for (int j = 0; j < 4; ++j) { const int i = C.lane + 64 * j; ((f32x4*)(C.out + (size_t)t * D))[i] = v[j] * rstd * w[i]; }
        }
    }
}
#define RS_STEP(lo, hi, bit, off) ((bit ? hi : lo) + __shfl_xor(bit ? lo : hi, off))
__device__ __forceinline__ float rscatter16(const float (&a)[16], int b5, int b4, int b3, int b2) {
    const float c0 = RS_STEP(a[0], a[8], b5, 32), c1 = RS_STEP(a[1], a[9], b5, 32), c2 = RS_STEP(a[2], a[10], b5, 32), c3 = RS_STEP(a[3], a[11], b5, 32);
    const float c4 = RS_STEP(a[4], a[12], b5, 32), c5 = RS_STEP(a[5], a[13], b5, 32), c6 = RS_STEP(a[6], a[14], b5, 32), c7 = RS_STEP(a[7], a[15], b5, 32);
    const float d0 = RS_STEP(c0, c4, b4, 16), d1 = RS_STEP(c1, c5, b4, 16), d2 = RS_STEP(c2, c6, b4, 16), d3 = RS_STEP(c3, c7, b4, 16);
    const float e0 = RS_STEP(d0, d2, b3, 8), e1 = RS_STEP(d1, d3, b3, 8);
    return RS_STEP(e0, e1, b2, 4);
}
constexpr int NR2 = 1;
__device__ __forceinline__ void ph_norm2(const Ctx& C, int l, int nrows) {
    const float* X = WSP(float, WS_X); bf16* H = WSP(bf16, WS_H); float* AFF = WSP(float, WS_AFF);
    LAS float* Rs = (LAS float*)C.lds;
    const float* rt = C.in[21] + (size_t)l * D * NE;
    for (int i = C.tid; i < D * NE / 4; i += 512) { const f32x4 r4 = ((const f32x4*)rt)[i]; const int c = i >> 2, e0 = (i & 3) * 4;
        Rs[(e0 + 0) * D + c] = r4.x; Rs[(e0 + 1) * D + c] = r4.y; Rs[(e0 + 2) * D + c] = r4.z; Rs[(e0 + 3) * D + c] = r4.w; }
    __syncthreads();
    const int b5 = (C.lane >> 5) & 1, b4 = (C.lane >> 4) & 1, b3 = (C.lane >> 3) & 1, b2 = (C.lane >> 2) & 1, my_e = 8 * b5 + 4 * b4 + 2 * b3 + b2;
    for (int t0 = (C.blk * 8 + C.wave) * NR2; t0 < nrows; t0 += C.G * 8 * NR2) {
        asm volatile("" ::: "memory");
        const int set = t0 >= SEQ ? 1 : 0;
        f32x4 v[NR2][4];
#pragma unroll
        for (int rr = 0; rr < NR2; ++rr) {
#pragma unroll
            for (int j = 0; j < 4; ++j) v[rr][j] = ((const f32x4*)(X + (size_t)(t0 + rr) * D))[C.lane + 64 * j];
        }
        { const f32x4* w = (const f32x4*)(C.in[7] + (size_t)l * D); const f32x4* sh = (const f32x4*)modp(C, l, set, 3); const f32x4* scl = (const f32x4*)modp(C, l, set, 4);
          float rstd[NR2];
#pragma unroll
          for (int rr = 0; rr < NR2; ++rr) { float ss = 0.f;
#pragma unroll
            for (int j = 0; j < 4; ++j) ss += (v[rr][j].x * v[rr][j].x + v[rr][j].y * v[rr][j].y) + (v[rr][j].z * v[rr][j].z + v[rr][j].w * v[rr][j].w);
            rstd[rr] = rsqrtf(wave_sum(ss) * (1.f / D) + RMS_EPS); }
#pragma unroll
          for (int j = 0; j < 4; ++j) { const int i = C.lane + 64 * j; const f32x4 ws = w[i] * (scl[i] + 1.f), s4 = sh[i];
#pragma unroll
            for (int rr = 0; rr < NR2; ++rr) { v[rr][j] = v[rr][j] * rstd[rr] * ws + s4;
                u32x2 o; o.x = pk2(v[rr][j].x, v[rr][j].y); o.y = pk2(v[rr][j].z, v[rr][j].w); ((u32x2*)(H + (size_t)(t0 + rr) * D))[i] = o; } } }
        asm volatile("" ::: "memory");
        float lg[NR2][16];
#pragma unroll
        for (int e = 0; e < 16; ++e) {
            float sacc[NR2];
#pragma unroll
            for (int rr = 0; rr < NR2; ++rr) sacc[rr] = 0.f;
#pragma unroll
            for (int j = 0; j < 4; ++j) { const f32x4 r = *(const LAS f32x4*)(Rs + e * D + 4 * (C.lane + 64 * j));
#pragma unroll
                for (int rr = 0; rr < NR2; ++rr) sacc[rr] += (v[rr][j].x * r.x + v[rr][j].y * r.y) + (v[rr][j].z * r.z + v[rr][j].w * r.w); }
#pragma unroll
            for (int rr = 0; rr < NR2; ++rr) lg[rr][e] = sacc[rr];
            if ((e & 3) == 3) asm volatile("" ::: "memory");
        }
#pragma unroll
        for (int rr = 0; rr < NR2; ++rr) {
            float vv = rscatter16(lg[rr], b5, b4, b3, b2);
            vv += __shfl_xor(vv, 1); vv += __shfl_xor(vv, 2);
            float mx = vv; mx = fmaxf(mx, __shfl_xor(mx, 4)); mx = fmaxf(mx, __shfl_xor(mx, 8)); mx = fmaxf(mx, __shfl_xor(mx, 16)); mx = fmaxf(mx, __shfl_xor(mx, 32));
            const float ex = __expf(vv - mx); float sm = ex; sm += __shfl_xor(sm, 4); sm += __shfl_xor(sm, 8); sm += __shfl_xor(sm, 16); sm += __shfl_xor(sm, 32);
            if ((C.lane & 3) == 0) AFF[(size_t)my_e * R + t0 + rr] = ex / sm;
        }
    }
}

__device__ __forceinline__ int block_sum_i(int v, LAS int* scr, int wave, int lane) {
    v = wave_sum_i(v);
    if (lane == 0) scr[wave] = v;
    __syncthreads();
    int t = 0;
#pragma unroll
    for (int w = 0; w < 8; ++w) t += scr[w];
    __syncthreads();
    return t;
}
__device__ __forceinline__ int block_excl_scan(int v, LAS int* scr, int wave, int lane) {
    int inc = v;
#pragma unroll
    for (int o = 1; o < 64; o <<= 1) { const int n = __shfl_up(inc, o); if (lane >= o) inc += n; }
    if (lane == 63) scr[wave] = inc;
    __syncthreads();
    int off = 0;
#pragma unroll
    for (int w = 0; w < 8; ++w) off += (w < wave) ? scr[w] : 0;
    __syncthreads();
    return off + inc - v;
}
template <int KPT>
__device__ __forceinline__ void topk_unit(const Ctx& C, int e, int base, int n, int cap, int slot0) {
    const float* aff = WSP(float, WS_AFF) + (size_t)e * R + base;
    int* rowl = WSP(int, WS_ROWL) + e * EROWS; float* gatel = WSP(float, WS_GATEL) + e * EROWS; int* INV = WSP(int, WS_INV);
    LAS unsigned* hist = (LAS unsigned*)C.lds;
    LAS int* scr = (LAS int*)(hist + 256);
    LAS unsigned* bc = hist + 256 + 16;
    unsigned key[KPT];
    if (KPT == 32) {
#pragma unroll
        for (int j = 0; j < KPT; j += 4) { const u32x4 k4 = *(const u32x4*)(aff + C.tid * KPT + j); key[j] = k4.x; key[j + 1] = k4.y; key[j + 2] = k4.z; key[j + 3] = k4.w; }
    } else {
#pragma unroll
        for (int j = 0; j < KPT; ++j) { const int t = C.tid * KPT + j; key[j] = t < n ? __float_as_uint(aff[t]) : 0u; }
    }
    unsigned prefix = 0u, pmask = 0u; int kth = cap;
    for (int pass = 0; pass < 4; ++pass) {
        const int shift = 24 - 8 * pass;
        if (C.tid < 256) hist[C.tid] = 0u;
        __syncthreads();
#pragma unroll
        for (int j = 0; j < KPT; ++j) if (key[j] != 0u && (key[j] & pmask) == prefix) __hip_atomic_fetch_add(hist + ((key[j] >> shift) & 255u), 1u, __ATOMIC_RELAXED, __HIP_MEMORY_SCOPE_WORKGROUP);
        __syncthreads();
        if (C.wave == 0) {
            const unsigned c0 = hist[4 * C.lane], c1 = hist[4 * C.lane + 1], c2 = hist[4 * C.lane + 2], c3 = hist[4 * C.lane + 3];
            const int tot = (int)(c0 + c1 + c2 + c3); int suf = tot;
#pragma unroll
            for (int o = 1; o < 64; o <<= 1) { const int nb = __shfl_down(suf, o); if (C.lane + o < 64) suf += nb; }
            const unsigned long long bal = __ballot(suf >= kth);
            const int lstar = 63 - __builtin_clzll(bal);
            if (C.lane == lstar) { int above = suf - tot; unsigned dg; int nk;
                if (above + (int)c3 >= kth) { dg = 3; nk = kth - above; }
                else { above += (int)c3; if (above + (int)c2 >= kth) { dg = 2; nk = kth - above; }
                else { above += (int)c2; if (above + (int)c1 >= kth) { dg = 1; nk = kth - above; }
                else { above += (int)c1; dg = 0; nk = kth - above; } } }
                bc[0] = 4u * (unsigned)C.lane + dg; bc[1] = (unsigned)nk; }
        }
        __syncthreads();
        prefix |= bc[0] << shift; pmask |= 255u << shift; kth = (int)bc[1];
    }
    const int need_eq = kth;
    int ce = 0;
#pragma unroll
    for (int j = 0; j < KPT; ++j) ce += key[j] == prefix ? 1 : 0;
    int eqr = block_excl_scan(ce, scr, C.wave, C.lane);
    int nsel = 0; unsigned selmask = 0u;
#pragma unroll
    for (int j = 0; j < KPT; ++j) { bool sl = key[j] > prefix; if (key[j] == prefix) { sl = eqr < need_eq; ++eqr; } if (sl) { ++nsel; selmask |= 1u << j; } }
    int slot = block_excl_scan(nsel, scr, C.wave, C.lane);
#pragma unroll
    for (int j = 0; j < KPT; ++j) { const int t = C.tid * KPT + j;
        if (t < n) {
            if ((selmask >> j) & 1u) { rowl[slot0 + slot] = base + t; gatel[slot0 + slot] = __uint_as_float(key[j]); INV[(size_t)(base + t) * 16 + e] = slot0 + slot; ++slot; }
            else INV[(size_t)(base + t) * 16 + e] = -1;
        } }
}
__device__ __forceinline__ void ph_topk(const Ctx& C, bool with_ctx) {
    for (int u = C.blk; u < (with_ctx ? 32 : 16); u += C.G) {
        const int e = u & 15;
        if (u < 16) topk_unit<32>(C, e, 0, SEQ, CAP_L, 0);
        else topk_unit<1>(C, e, SEQ, NCTX, CAP_C, CAP_L);
        __syncthreads();
    }
}
__device__ __forceinline__ void ph_gather(const Ctx& C, bool with_ctx) {
    const int* rowl = WSP(int, WS_ROWL); const bf16* H = WSP(bf16, WS_H); bf16* XG = WSP(bf16, WS_XG);
    const int nslots = with_ctx ? CAP_L + CAP_C : CAP_L, ntot = NE * nslots;
    for (int i = C.blk * 8 + C.wave; i < ntot; i += C.G * 8) {
        const int e = i / nslots, sl = i % nslots, r = e * EROWS + sl;
        const int src = rowl[r];
        u32x4* d = (u32x4*)(XG + (size_t)r * D); const u32x4* sp = (const u32x4*)(H + (size_t)src * D);
        d[C.lane] = sp[C.lane]; d[C.lane + 64] = sp[C.lane + 64];
    }
}
__device__ __forceinline__ void rot_angles(int t, int half, int d, int quarter, float& cs, float& sn) {
    const float invf = exp2f(-(float)d * (13.287712379549449f / (float)quarter));
    const float pos = half ? (float)(t & 63) : (float)(t >> 6);
    const float ang = pos * invf;
    const double rev = (double)ang * 0.15915494309189535; const float fr = (float)(rev - __builtin_rint(rev));
    cs = __builtin_amdgcn_cosf(fr); sn = __builtin_amdgcn_sinf(fr);
}
__device__ __forceinline__ void ph_rope(const Ctx& C, bf16* buf, int pitch, int nheads, int head_stride, int off, int quarter) {
    const int per_tok = nheads * 2 * quarter; const long total = (long)SEQ * per_tok;
    for (long i = (long)C.blk * 512 + C.tid; i < total; i += (long)C.G * 512) {
        const int t = (int)(i / per_tok), r = (int)(i % per_tok), h = r / (2 * quarter), p = r % (2 * quarter), half = p / quarter, d = p % quarter;
        float cs, sn; rot_angles(t, half, d, quarter, cs, sn);
        bf16* b = buf + (size_t)t * pitch + h * head_stride + off + half * 2 * quarter + d;
        const float x1 = bf2f(b[0]), x2 = bf2f(b[quarter]);
        b[0] = (bf16)f2bf(x1 * cs - x2 * sn); b[quarter] = (bf16)f2bf(x1 * sn + x2 * cs);
    }
}
__device__ __forceinline__ void ph_mlanorm(const Ctx& C) {
    const float* CQ = WSP(float, WS_CQ); bf16* CQN = WSP(bf16, WS_CQN); bf16* CKVN = WSP(bf16, WS_CKVN); bf16* KR = WSP(bf16, WS_KROPE);
    for (int t = C.blk * 8 + C.wave; t < R; t += C.G * 8) {
        const float* row = CQ + (size_t)t * D;
        const f32x4 a0 = ((const f32x4*)row)[C.lane], a1 = ((const f32x4*)row)[C.lane + 64], b0 = ((const f32x4*)(row + 512))[C.lane];
        const float sa = wave_sum((a0.x * a0.x + a0.y * a0.y) + (a0.z * a0.z + a0.w * a0.w) + (a1.x * a1.x + a1.y * a1.y) + (a1.z * a1.z + a1.w * a1.w));
        const float sb = wave_sum((b0.x * b0.x + b0.y * b0.y) + (b0.z * b0.z + b0.w * b0.w));
        const float ra = rsqrtf(sa * (1.f / 512.f) + RMS_EPS), rb = rsqrtf(sb * (1.f / 256.f) + RMS_EPS);
        const f32x4* gq = (const f32x4*)C.in[15]; const f32x4* gk = (const f32x4*)C.in[18];
        { const f32x4 y0 = a0 * ra * gq[C.lane], y1 = a1 * ra * gq[C.lane + 64], z = b0 * rb * gk[C.lane];
          u32x2 o; o.x = pk2(y0.x, y0.y); o.y = pk2(y0.z, y0.w); ((u32x2*)(CQN + (size_t)t * 512))[C.lane] = o;
          o.x = pk2(y1.x, y1.y); o.y = pk2(y1.z, y1.w); ((u32x2*)(CQN + (size_t)t * 512))[C.lane + 64] = o;
          o.x = pk2(z.x, z.y); o.y = pk2(z.z, z.w); ((u32x2*)(CKVN + (size_t)t * 256))[C.lane] = o; }
        const float x = row[768 + (C.lane & 31)];
        const float xp = __shfl_xor(x, 8);
        float y = x;
        if (t < SEQ) { float cs, sn; rot_angles(t, (C.lane >> 4) & 1, C.lane & 7, 8, cs, sn);
            y = ((C.lane >> 3) & 1) ? (xp * sn + x * cs) : (x * cs - xp * sn); }
        if (C.lane < 32) KR[(size_t)t * 32 + C.lane] = (bf16)f2bf(y);
    }
}

namespace pg8 {
#define PG8_LAS __attribute__((address_space(3)))
typedef unsigned short bf16_t;
typedef short bf16x8 __attribute__((ext_vector_type(8)));
typedef float f32x4 __attribute__((ext_vector_type(4)));
typedef unsigned u32x4 __attribute__((ext_vector_type(4)));
constexpr int BM = 256, BK = 64, HALF = 128, HTB = HALF * BK * 2  , STAGE_BYTES = 8 * HTB, NXCD = 8, WGM = 8;

__host__ __device__ __forceinline__ int lds_byte(int r, int c) { const int st = (r >> 4) * 2 + (c >> 5), rr = r & 15, cc = c & 31, ob = rr * 64 + cc * 2; return st * 1024 + (ob ^ (((ob >> 9) & 1) << 5)); }
__host__ __device__ __forceinline__ void stage_rc(int b, int& R, int& C) { const int st = b / 1024, sb = b % 1024, swz = sb ^ (((sb >> 9) & 1) << 5); R = (st >> 1) * 16 + swz / 64; C = (st & 1) * 32 + (swz % 64) / 2; }
__host__ __device__ __forceinline__ int perm32(int rho) { const int n = rho >> 4, i = rho & 15; return 8 * (i >> 2) + 4 * n + (i & 3); }

struct Unit { int pm, pn, thin; };
struct Gemm { const bf16_t* A; const bf16_t* Bt; int M, N, K; int pm_per_grp; size_t grp_stride; };

struct StaticOrder {
    int nM, nN, nwg, G, c;
    __host__ __device__ void init(int M, int N, int G_, int c_) { nM = M / BM; nN = N / BM; nwg = nM * nN; G = G_; c = c_; }
    __host__ __device__ bool next(int i, Unit& u) const {
        const long L = (long)i * G + c; if (L >= nwg) return false;
        int wgid = (int)L; { const int q = nwg / NXCD, r = nwg % NXCD, xcd = wgid % NXCD, off = wgid / NXCD; wgid = (xcd < r ? xcd * (q + 1) : r * (q + 1) + (xcd - r) * q) + off; }
        const int nig = WGM * nN, gid = wgid / nig, fm = gid * WGM, gsz = (nM - fm) < WGM ? (nM - fm) : WGM;
        u.pm = fm + ((wgid % nig) % gsz); u.pn = (wgid % nig) / gsz; u.thin = 0; return true;
    }
    __device__ __forceinline__ void a_ready(const Unit&) const {}
    __device__ __forceinline__ void done(const Unit&) const {}
};
struct MoeOrder {
    StaticOrder base; int nN, nthin;
    __host__ __device__ void init(int N, int G_, int c_, bool with_thin) { base.init(NEXP_PANELS * BM, N, G_, c_); nN = N / BM; nthin = with_thin ? 16 * nN : 0; }
    static constexpr int NEXP_PANELS = 16 * 8;
    __host__ __device__ bool next(int i, Unit& u) const {
        if (base.next(i, u)) { u.pm = (u.pm >> 3) * 9 + (u.pm & 7); return true; }
        const long j = (long)i * base.G + base.c - base.nwg; if (j >= nthin) return false;
        u.pm = (int)(j / nN) * 9 + 8; u.pn = (int)(j % nN); u.thin = 1; return true;
    }
    __device__ __forceinline__ void a_ready(const Unit&) const {}
    __device__ __forceinline__ void done(const Unit&) const {}
};

template <class Epi, class Sched, bool ALIGN_EPI = false, bool SP2 = false>
__device__ __forceinline__ void gemm_phase(PG8_LAS unsigned char* lds, const Gemm g, const Sched& S, const Epi& E) {
    const int tid = threadIdx.x, wid = __builtin_amdgcn_readfirstlane(tid >> 6), lane = tid & 63, wr = wid >> 2, wc = wid & 3, fr = lane & 15, fq = lane >> 4;
    const int K = g.K, nt = K / BK;
    unsigned voffA[2], voffB[2];
#pragma unroll
    for (int i = 0; i < 2; ++i) { int R, C; stage_rc(tid * 16 + i * 8192, R, C); const int Rb = Epi::PERM ? ((R & ~31) + perm32(R & 31)) : R;
        voffA[i] = (unsigned)(R * K + C) * 2u; voffB[i] = (unsigned)(Rb * K + C) * 2u; }
    const size_t kstep = (size_t)(BK * 2);
    const size_t hstep = (size_t)HALF * K * 2;
    const size_t tstep = 2 * hstep;
    const unsigned ldsw = (unsigned)wid * 1024u;
    const int aoff = lds_byte(wr * 64 + fr, fq * 8), boff = lds_byte(wc * 32 + fr, fq * 8);
#define PG8_SA(b, h) (((b) * 2 + (h)) * HTB)
#define PG8_SB(b, h) ((4 + (b) * 2 + (h)) * HTB)
#define PG8_STAGE(bufoff, gbase, voff) do { _Pragma("unroll") for (int _i = 0; _i < 2; ++_i) \
        __builtin_amdgcn_global_load_lds((const unsigned*)((const char*)(gbase) + (voff)[_i]), (PG8_LAS unsigned*)(lds + (bufoff) + ldsw + _i * 8192), 16, 0, 0); } while (0)
#define PG8_LDA(dst, b, h) do { _Pragma("unroll") for (int m = 0; m < 4; ++m) _Pragma("unroll") for (int k = 0; k < 2; ++k) dst[m][k] = *(const PG8_LAS bf16x8*)(lds + PG8_SA(b, h) + aoff + m * 2048 + k * 1024); } while (0)
#define PG8_LDB(dst, b, h) do { _Pragma("unroll") for (int n = 0; n < 2; ++n) _Pragma("unroll") for (int k = 0; k < 2; ++k) dst[n][k] = *(const PG8_LAS bf16x8*)(lds + PG8_SB(b, h) + boff + n * 2048 + k * 1024); } while (0)
#define PG8_MMA(ai, bj, At, Bt) do { if (cur.thin && ((ai) != 0 || wr != 0)) break; __builtin_amdgcn_s_setprio(1); _Pragma("unroll") for (int m = 0; m < 4; ++m) _Pragma("unroll") for (int n = 0; n < 2; ++n) _Pragma("unroll") for (int k = 0; k < 2; ++k) \
        acc[ai][bj][m][n] = __builtin_amdgcn_mfma_f32_16x16x32_bf16(Bt[n][k], At[m][k], acc[ai][bj][m][n], 0, 0, 0); __builtin_amdgcn_s_setprio(0); } while (0)
#define PG8_WAIT_V(n) asm volatile("s_waitcnt vmcnt(" #n ")" ::: "memory")
#define PG8_WAIT_L(n) asm volatile("s_waitcnt lgkmcnt(" #n ")" ::: "memory")
#define PG8_BAR __builtin_amdgcn_s_barrier()
#define PG8_SCHED __builtin_amdgcn_sched_barrier(0)
    Unit cur, nxt; int ui = 0;
    if (!S.next(0, cur)) return;
    f32x4 acc[2][2][4][2];
#pragma unroll
    for (int a = 0; a < 2; ++a)
#pragma unroll
        for (int b = 0; b < 2; ++b)
#pragma unroll
            for (int m = 0; m < 4; ++m)
#pragma unroll
                for (int n = 0; n < 2; ++n) acc[a][b][m][n] = (f32x4){0.f, 0.f, 0.f, 0.f};
    bf16x8 At[4][2], B0[2][2], B1[2][2];
    const char* cA = (const char*)g.A + (size_t)cur.pm * tstep; const char* cB = (const char*)g.Bt + (g.pm_per_grp ? (size_t)(cur.pm / g.pm_per_grp) * g.grp_stride * 2 : (size_t)0) + (size_t)cur.pn * tstep;
    S.a_ready(cur);
    if constexpr (SP2) {
        PG8_STAGE(PG8_SB(0, 0), cB, voffB); PG8_STAGE(PG8_SB(0, 1), cB + hstep, voffB); PG8_STAGE(PG8_SA(0, 0), cA, voffA); PG8_STAGE(PG8_SA(0, 1), cA + hstep, voffA);
        if (wr == 1) PG8_BAR;
        PG8_WAIT_V(2); PG8_BAR;
        PG8_STAGE(PG8_SB(1, 0), cB + kstep, voffB); PG8_STAGE(PG8_SA(1, 0), cA + kstep, voffA); PG8_STAGE(PG8_SB(1, 1), cB + hstep + kstep, voffB);
        PG8_WAIT_V(6); PG8_BAR;
    } else {
        PG8_STAGE(PG8_SB(0, 0), cB, voffB); PG8_STAGE(PG8_SA(0, 0), cA, voffA); PG8_STAGE(PG8_SB(0, 1), cB + hstep, voffB); PG8_STAGE(PG8_SA(0, 1), cA + hstep, voffA);
        if (wr == 1) PG8_BAR;
        PG8_WAIT_V(4); PG8_BAR;
        PG8_STAGE(PG8_SB(1, 0), cB + kstep, voffB); PG8_STAGE(PG8_SA(1, 0), cA + kstep, voffA); PG8_STAGE(PG8_SB(1, 1), cB + hstep + kstep, voffB);
        PG8_WAIT_V(6); PG8_BAR;
    }
    for (;;) {
        const bool has_next = S.next(ui + 1, nxt);
        const char* nA = has_next ? (const char*)g.A + (size_t)nxt.pm * tstep : cA; const char* nB = has_next ? (const char*)g.Bt + (g.pm_per_grp ? (size_t)(nxt.pm / g.pm_per_grp) * g.grp_stride * 2 : (size_t)0) + (size_t)nxt.pn * tstep : cB;
        for (int t = 0; t < nt; t += 2) {
            const bool last = (t == nt - 2);
            const char* a1 = cA + (size_t)(t + 1) * kstep;
            const char* a2 = last ? nA : cA + (size_t)(t + 2) * kstep; const char* b2 = last ? nB : cB + (size_t)(t + 2) * kstep;
            const char* a3 = a2 + kstep; const char* b3 = b2 + kstep;
            if (last && has_next) S.a_ready(nxt);
            if constexpr (SP2) {
            PG8_LDB(B0, 0, 0); PG8_LDB(B1, 0, 1); PG8_SCHED; PG8_LDA(At, 0, 0); PG8_STAGE(PG8_SA(1, 1), a1 + hstep, voffA);
            PG8_WAIT_V(8); PG8_WAIT_L(0); PG8_BAR; PG8_MMA(0, 0, At, B0); PG8_MMA(0, 1, At, B1); PG8_BAR; PG8_SCHED;
            PG8_LDA(At, 0, 1); PG8_STAGE(PG8_SB(0, 0), b2, voffB); PG8_STAGE(PG8_SB(0, 1), b2 + hstep, voffB); PG8_STAGE(PG8_SA(0, 0), a2, voffA);
            PG8_WAIT_V(8); PG8_WAIT_L(0); PG8_BAR; PG8_MMA(1, 0, At, B0); PG8_MMA(1, 1, At, B1); PG8_BAR; PG8_SCHED;
            PG8_LDB(B0, 1, 0); PG8_LDB(B1, 1, 1); PG8_SCHED; PG8_LDA(At, 1, 0); PG8_STAGE(PG8_SA(0, 1), a2 + hstep, voffA);
            PG8_WAIT_V(8); PG8_WAIT_L(0); PG8_BAR; PG8_MMA(0, 0, At, B0); PG8_MMA(0, 1, At, B1); PG8_BAR; PG8_SCHED;
            PG8_LDA(At, 1, 1); PG8_STAGE(PG8_SB(1, 0), b3, voffB); PG8_STAGE(PG8_SB(1, 1), b3 + hstep, voffB); PG8_STAGE(PG8_SA(1, 0), a3, voffA);
            PG8_WAIT_V(8); PG8_WAIT_L(0); PG8_BAR; PG8_MMA(1, 0, At, B0); PG8_MMA(1, 1, At, B1); PG8_BAR; PG8_SCHED;
            } else {
            PG8_LDB(B0, 0, 0); PG8_SCHED; PG8_LDA(At, 0, 0); PG8_STAGE(PG8_SA(1, 1), a1 + hstep, voffA);
            PG8_WAIT_L(8); PG8_BAR; PG8_WAIT_L(0); PG8_MMA(0, 0, At, B0); PG8_BAR; PG8_SCHED;
            PG8_LDB(B1, 0, 1); PG8_STAGE(PG8_SB(0, 0), b2, voffB);
            PG8_BAR; PG8_WAIT_L(0); PG8_MMA(0, 1, At, B1); PG8_BAR;
            PG8_LDA(At, 0, 1); PG8_STAGE(PG8_SA(0, 0), a2, voffA);
            PG8_BAR; PG8_WAIT_L(0); PG8_MMA(1, 0, At, B0); PG8_BAR; PG8_SCHED;
            PG8_STAGE(PG8_SB(0, 1), b2 + hstep, voffB);
            PG8_WAIT_V(6); PG8_BAR; PG8_MMA(1, 1, At, B1); PG8_BAR;
            PG8_LDB(B0, 1, 0); PG8_SCHED; PG8_LDA(At, 1, 0); PG8_STAGE(PG8_SA(0, 1), a2 + hstep, voffA);
            PG8_WAIT_L(8); PG8_BAR; PG8_WAIT_L(0); PG8_MMA(0, 0, At, B0); PG8_BAR; PG8_SCHED;
            PG8_LDB(B1, 1, 1); PG8_STAGE(PG8_SB(1, 0), b3, voffB);
            PG8_BAR; PG8_WAIT_L(0); PG8_MMA(0, 1, At, B1); PG8_BAR;
            PG8_LDA(At, 1, 1); PG8_STAGE(PG8_SA(1, 0), a3, voffA);
            PG8_BAR; PG8_WAIT_L(0); PG8_MMA(1, 0, At, B0); PG8_BAR; PG8_SCHED;
            PG8_STAGE(PG8_SB(1, 1), b3 + hstep, voffB);
            PG8_WAIT_V(6); PG8_BAR; PG8_MMA(1, 1, At, B1); PG8_BAR;
            }
        }
        if constexpr (ALIGN_EPI) { if (wr == 0) PG8_BAR; }
        if constexpr (!Epi::AFTER_DRAIN) { E(acc, cur, wr, wc, fr, fq); S.done(cur); }
        if (!has_next) break;
#pragma unroll
        for (int a = 0; a < 2; ++a)
#pragma unroll
            for (int b = 0; b < 2; ++b)
#pragma unroll
                for (int m = 0; m < 4; ++m)
#pragma unroll
                    for (int n = 0; n < 2; ++n) acc[a][b][m][n] = (f32x4){0.f, 0.f, 0.f, 0.f};
        cur = nxt; cA = nA; cB = nB; ++ui;
        if constexpr (ALIGN_EPI) { if (wr == 1) PG8_BAR; }
    }
    PG8_WAIT_V(0);
    if constexpr (!ALIGN_EPI) { if (wr == 0) PG8_BAR; }
    PG8_BAR;
    if constexpr (Epi::AFTER_DRAIN) { E.fused(acc, cur, wr, wc, fr, fq, lds, wid, lane); S.done(cur); }
#undef PG8_SA
#undef PG8_SB
#undef PG8_STAGE
#undef PG8_LDA
#undef PG8_LDB
#undef PG8_MMA
#undef PG8_WAIT_V
#undef PG8_WAIT_L
#undef PG8_BAR
#undef PG8_SCHED
}
}
#ifndef USE_PG8
#define USE_PG8 1
#endif
__device__ __forceinline__ unsigned cvt_pk_bf16(float lo, float hi) { unsigned r; asm volatile("v_cvt_pk_bf16_f32 %0, %1, %2" : "=v"(r) : "v"(lo), "v"(hi)); return r; }
typedef const f32x4 (&AccRef)[2][2][4][2];
struct EpiStoreBf16 { static constexpr bool DUAL = false, PERM = true, AFTER_DRAIN = false; bf16* O; int ldc;
    __device__ __forceinline__ void elem(int row, int col, float v, float) const { O[(size_t)row * ldc + col] = (bf16)f2bf(v); }
    __device__ __forceinline__ void operator()(AccRef acc, const pg8::Unit& u, int wr, int wc, int fr, int fq) const {
        const int row0 = u.pm * 256 + wr * 64 + fr, col0 = u.pn * 256 + wc * 32 + 8 * fq;
#pragma unroll
        for (int ai = 0; ai < 2; ++ai)
#pragma unroll
            for (int m = 0; m < 4; ++m) { bf16* rowp = O + (size_t)(row0 + ai * 128 + m * 16) * ldc + col0;
#pragma unroll
                for (int bj = 0; bj < 2; ++bj) { const f32x4 v0 = acc[ai][bj][m][0], v1 = acc[ai][bj][m][1];
                    u32x4 w; w.x = cvt_pk_bf16(v0[0], v0[1]); w.y = cvt_pk_bf16(v0[2], v0[3]); w.z = cvt_pk_bf16(v1[0], v1[1]); w.w = cvt_pk_bf16(v1[2], v1[3]);
                    *(u32x4*)(rowp + bj * 128) = w; } }
    } };
struct EpiStoreF32 { static constexpr bool DUAL = false, PERM = false, AFTER_DRAIN = false; float* O; int ldc;
    __device__ __forceinline__ void elem(int row, int col, float v, float) const { O[(size_t)row * ldc + col] = v; }
    __device__ __forceinline__ void operator()(AccRef acc, const pg8::Unit& u, int wr, int wc, int fr, int fq) const {
        const int row0 = u.pm * 256 + wr * 64 + fr, col0 = u.pn * 256 + wc * 32 + 4 * fq;
#pragma unroll
        for (int ai = 0; ai < 2; ++ai)
#pragma unroll
            for (int m = 0; m < 4; ++m) { float* rowp = O + (size_t)(row0 + ai * 128 + m * 16) * ldc + col0;
#pragma unroll
                for (int bj = 0; bj < 2; ++bj)
#pragma unroll
                    for (int n = 0; n < 2; ++n) *(f32x4*)(rowp + bj * 128 + n * 16) = acc[ai][bj][m][n]; }
    } };
struct EpiResid { static constexpr bool DUAL = false, PERM = false, AFTER_DRAIN = false; float* X; const float* g_lat; const float* g_ctx;
    __device__ __forceinline__ void elem(int row, int col, float v, float) const { const float g = row >= SEQ ? g_ctx[col] : g_lat[col]; X[(size_t)row * D + col] += g * v; }
    __device__ __forceinline__ void operator()(AccRef acc, const pg8::Unit& u, int wr, int wc, int fr, int fq) const {
        const int row0 = u.pm * 256 + wr * 64 + fr, col0 = u.pn * 256 + wc * 32 + 4 * fq;
        const float* g = (u.pm * 256 >= SEQ) ? g_ctx : g_lat;
        f32x4 gv[2][2];
#pragma unroll
        for (int bj = 0; bj < 2; ++bj)
#pragma unroll
            for (int n = 0; n < 2; ++n) gv[bj][n] = *(const f32x4*)(g + col0 + bj * 128 + n * 16);
#pragma unroll
        for (int ai = 0; ai < 2; ++ai)
#pragma unroll
            for (int m = 0; m < 4; ++m) { float* rowp = X + (size_t)(row0 + ai * 128 + m * 16) * D + col0;
#pragma unroll
                for (int bj = 0; bj < 2; ++bj)
#pragma unroll
                    for (int n = 0; n < 2; ++n) { f32x4* p = (f32x4*)(rowp + bj * 128 + n * 16); *p = *p + gv[bj][n] * acc[ai][bj][m][n]; } }
    } };
__device__ __forceinline__ float silu_mul(float g, float u) { return g * __builtin_amdgcn_rcpf(1.f + __expf(-g)) * u; }
struct EpiSwiglu { static constexpr bool DUAL = true, PERM = true, AFTER_DRAIN = false; bf16* ACT;
    __device__ __forceinline__ void elem(int row, int col, float g, float u) const { ACT[(size_t)row * FF + col] = (bf16)f2bf(g / (1.f + __expf(-g)) * u); }
    __device__ __forceinline__ void operator()(AccRef acc, const pg8::Unit& u, int wr, int wc, int fr, int fq) const {
        const int row0 = u.pm * 256 + wr * 64 + fr, col0 = u.pn * 128 + wc * 32 + 8 * fq;
#pragma unroll
        for (int ai = 0; ai < 2; ++ai)
#pragma unroll
            for (int m = 0; m < 4; ++m) { bf16* rowp = ACT + (size_t)(row0 + ai * 128 + m * 16) * FF + col0;
                const f32x4 g0 = acc[ai][0][m][0], g1 = acc[ai][0][m][1], u0 = acc[ai][1][m][0], u1 = acc[ai][1][m][1];
                u32x4 w; w.x = cvt_pk_bf16(silu_mul(g0[0], u0[0]), silu_mul(g0[1], u0[1])); w.y = cvt_pk_bf16(silu_mul(g0[2], u0[2]), silu_mul(g0[3], u0[3]));
                w.z = cvt_pk_bf16(silu_mul(g1[0], u1[0]), silu_mul(g1[1], u1[1])); w.w = cvt_pk_bf16(silu_mul(g1[2], u1[2]), silu_mul(g1[3], u1[3]));
                *(u32x4*)rowp = w; }
    } };
struct EpiMoeOut { static constexpr bool DUAL = false, PERM = true, AFTER_DRAIN = false; bf16* YB; const float* gatel;
    __device__ __forceinline__ void elem(int row, int col, float v, float) const { YB[(size_t)row * D + col] = (bf16)f2bf(v * gatel[row]); }
    __device__ __forceinline__ void operator()(AccRef acc, const pg8::Unit& u, int wr, int wc, int fr, int fq) const {
        const int row0 = u.pm * 256 + wr * 64 + fr, col0 = u.pn * 256 + wc * 32 + 8 * fq;
#pragma unroll
        for (int ai = 0; ai < 2; ++ai)
#pragma unroll
            for (int m = 0; m < 4; ++m) { const int row = row0 + ai * 128 + m * 16; const float gt = gatel[row]; bf16* rowp = YB + (size_t)row * D + col0;
#pragma unroll
                for (int bj = 0; bj < 2; ++bj) { const f32x4 v0 = acc[ai][bj][m][0] * gt, v1 = acc[ai][bj][m][1] * gt;
                    u32x4 w; w.x = cvt_pk_bf16(v0[0], v0[1]); w.y = cvt_pk_bf16(v0[2], v0[3]); w.z = cvt_pk_bf16(v1[0], v1[1]); w.w = cvt_pk_bf16(v1[2], v1[3]);
                    *(u32x4*)(rowp + bj * 128) = w; } }
    } };

template <class Epi>
__device__ __forceinline__ void naive_gemm(const Ctx& C, const bf16* A, const bf16* Bt, int M, int N, int K, int pm_per_grp, size_t grp_stride, const Epi& E) {
    LAS float* As = (LAS float*)C.lds;
    LAS float* Bs = As + 16 * 132;
    LAS float* Bs2 = Bs + 16 * 68;
    const int NO = Epi::DUAL ? N / 2 : N, tn_cnt = NO / 64, nun = (M / 128) * tn_cnt;
    const int ty = C.tid >> 4, tx = C.tid & 15;
    for (int u = C.blk; u < nun; u += C.G) {
        const int tm = u / tn_cnt, tn = u % tn_cnt, row0 = tm * 128, oc0 = tn * 64;
        const bf16* Bg = Bt + (pm_per_grp ? (size_t)((row0 / 256) / pm_per_grp) * grp_stride : (size_t)0);
        const int brow0 = Epi::DUAL ? ((oc0 >> 7) * 256 + (oc0 & 127)) : oc0;
        float acc[4][4], acc2[4][4];
#pragma unroll
        for (int i = 0; i < 4; ++i)
#pragma unroll
            for (int j = 0; j < 4; ++j) { acc[i][j] = 0.f; acc2[i][j] = 0.f; }
        for (int k0 = 0; k0 < K; k0 += 16) {
            __syncthreads();
            { const int r = C.tid >> 2, kc = (C.tid & 3) * 4;
              const u32x2 w = *(const u32x2*)(A + (size_t)(row0 + r) * K + k0 + kc);
              As[(kc + 0) * 132 + r] = bf2f(w.x & 0xffffu); As[(kc + 1) * 132 + r] = bf2f(w.x >> 16); As[(kc + 2) * 132 + r] = bf2f(w.y & 0xffffu); As[(kc + 3) * 132 + r] = bf2f(w.y >> 16); }
            if (C.tid < 256) { const int r = C.tid >> 2, kc = (C.tid & 3) * 4;
              const u32x2 w = *(const u32x2*)(Bg + (size_t)(brow0 + r) * K + k0 + kc);
              Bs[(kc + 0) * 68 + r] = bf2f(w.x & 0xffffu); Bs[(kc + 1) * 68 + r] = bf2f(w.x >> 16); Bs[(kc + 2) * 68 + r] = bf2f(w.y & 0xffffu); Bs[(kc + 3) * 68 + r] = bf2f(w.y >> 16);
              if (Epi::DUAL) { const u32x2 w2 = *(const u32x2*)(Bg + (size_t)(brow0 + 128 + r) * K + k0 + kc);
                Bs2[(kc + 0) * 68 + r] = bf2f(w2.x & 0xffffu); Bs2[(kc + 1) * 68 + r] = bf2f(w2.x >> 16); Bs2[(kc + 2) * 68 + r] = bf2f(w2.y & 0xffffu); Bs2[(kc + 3) * 68 + r] = bf2f(w2.y >> 16); } }
            __syncthreads();
#pragma unroll
            for (int kk = 0; kk < 16; ++kk) {
                const f32x4 a = *(const LAS f32x4*)(As + kk * 132 + ty * 4), b = *(const LAS f32x4*)(Bs + kk * 68 + tx * 4);
#pragma unroll
                for (int i = 0; i < 4; ++i)
#pragma unroll
                    for (int j = 0; j < 4; ++j) acc[i][j] += a[i] * b[j];
                if (Epi::DUAL) { const f32x4 b2 = *(const LAS f32x4*)(Bs2 + kk * 68 + tx * 4);
#pragma unroll
                    for (int i = 0; i < 4; ++i)
#pragma unroll
                        for (int j = 0; j < 4; ++j) acc2[i][j] += a[i] * b2[j]; }
            }
        }
#pragma unroll
        for (int i = 0; i < 4; ++i)
#pragma unroll
            for (int j = 0; j < 4; ++j) E.elem(row0 + ty * 4 + i, oc0 + tx * 4 + j, acc[i][j], acc2[i][j]);
    }
    __syncthreads();
}

template <class Epi>
__device__ __forceinline__ void gemm(const Ctx& C, const bf16* A, const bf16* Bt, int M, int N, int K, int pm_per_grp, size_t grp_stride, const Epi& E) {
#if USE_PG8
    pg8::Gemm g{A, Bt, M, N, K, pm_per_grp, grp_stride}; pg8::StaticOrder S; S.init(M, N, C.G, C.blk);
    pg8::gemm_phase<Epi, pg8::StaticOrder, true, true>(C.lds, g, S, E);
#else
    naive_gemm(C, A, Bt, M, N, K, pm_per_grp, grp_stride, E);
#endif
}
template <class Epi>
__device__ __forceinline__ void gemm_moe(const Ctx& C, const bf16* A, const bf16* Bt, int N, int K, size_t grp_stride, bool with_ctx, const Epi& E) {
#if USE_PG8
    pg8::Gemm g{A, Bt, XROWS, N, K, 9, grp_stride}; pg8::MoeOrder S; S.init(N, C.G, C.blk, with_ctx);
    pg8::gemm_phase<Epi, pg8::MoeOrder, true, true>(C.lds, g, S, E);
#else
    naive_gemm(C, A, Bt, XROWS, N, K, 9, grp_stride, E);
#endif
}

template <int KIND>
__device__ __forceinline__ void ph_attn_naive(const Ctx& C, int slot) {
    constexpr int DQK = KIND == 2 ? 96 : 64, DH = DQK / 2;
    LAS float* Ks = (LAS float*)C.lds;
    LAS float* Vs = Ks + 32 * DQK;
    LAS float* Bsm = Vs + 32 * 64;
    const bf16 *Qb, *Kb, *Vb, *KRb = nullptr; int qp, kp, vp, qhs, khs, vhs, kgrp = 1; float scale;
    if (KIND == 0) { Qb = WSP(bf16, WS_QKV); Kb = Qb + 1024; Vb = Qb + 2048; qp = kp = vp = 3072; qhs = khs = vhs = 64; scale = 0.125f; }
    else if (KIND == 1) { Qb = WSP(bf16, WS_QKV); Kb = Qb + 1024; Vb = Qb + 1280; qp = kp = vp = 1536; qhs = khs = vhs = 64; kgrp = 4; scale = 0.125f; }
    else { Qb = WSP(bf16, WS_Q); Kb = WSP(bf16, WS_KV); Vb = Kb + 64; KRb = WSP(bf16, WS_KROPE); qp = 1536; kp = vp = 2048; qhs = 96; khs = vhs = 128; scale = 0.10206207261596575f; }
    bf16* Ob = WSP(bf16, WS_O);
    const int half = C.tid & 1, qi = C.tid >> 1;
    for (int u = C.blk; u < 1040; u += C.G) {
        const bool isctx = u >= 1024;
        const int h = isctx ? (u - 1024) : (u & 15), q0 = isctx ? SEQ : (u >> 4) * 256, kh = h / kgrp;
        const int t = q0 + qi;
        float q[DH], o[32];
        { const bf16* qr = Qb + (size_t)t * qp + h * qhs + half * DH;
#pragma unroll
          for (int d = 0; d < DH; d += 8) { const u32x4 w = *(const u32x4*)(qr + d);
              q[d + 0] = bf2f(w.x & 0xffffu); q[d + 1] = bf2f(w.x >> 16); q[d + 2] = bf2f(w.y & 0xffffu); q[d + 3] = bf2f(w.y >> 16);
              q[d + 4] = bf2f(w.z & 0xffffu); q[d + 5] = bf2f(w.z >> 16); q[d + 6] = bf2f(w.w & 0xffffu); q[d + 7] = bf2f(w.w >> 16); } }
#pragma unroll
        for (int d = 0; d < 32; ++d) o[d] = 0.f;
        float m = -INFINITY, l = 0.f;
        if (KIND == 1) { m = C.in[13][h]; l = 1.f; }
        int klo = 0, khi = 0;
        if (!isctx) {
            if (KIND == 0) { const int r0 = q0 >> 6; const int ra = r0 - 4 < 0 ? 0 : r0 - 4, rb = r0 + 7 > 255 ? 255 : r0 + 7; klo = ra * 64; khi = (rb + 1) * 64; }
            else if (KIND == 1) { klo = q0 - 128 < 0 ? 0 : q0 - 128; khi = q0 + 384 > SEQ ? SEQ : q0 + 384; }
            else { klo = 0; khi = SEQ; }
        }
        if (KIND == 0) { __syncthreads(); const float* rp = C.in[10] + ((size_t)slot * 16 + h) * 465; for (int i = C.tid; i < 465; i += 512) Bsm[i] = rp[i]; }
        const int qr_ = t >> 6, qc_ = t & 63;
        int rs = qr_ - 4; rs = rs < 0 ? 0 : (rs > 248 ? 248 : rs);
        int cs0 = qc_ - 8; cs0 = cs0 < 0 ? 0 : (cs0 > 48 ? 48 : cs0);
        for (int seg = 0; seg < 2; ++seg) {
            const int kb = seg == 0 ? klo : SEQ, ke = seg == 0 ? khi : R;
            for (int k0 = kb; k0 < ke; k0 += 32) {
                __syncthreads();
                for (int i = C.tid; i < 32 * DQK; i += 512) { const int j = i / DQK, d = i % DQK; const int row = k0 + j;
                    unsigned b;
                    if (KIND == 2 && d >= 64) b = KRb[(size_t)row * 32 + (d - 64)]; else b = Kb[(size_t)row * kp + kh * khs + d];
                    Ks[i] = bf2f(b); }
                for (int i = C.tid; i < 32 * 64; i += 512) { const int j = i >> 6, d = i & 63; Vs[i] = bf2f(Vb[(size_t)(k0 + j) * vp + kh * vhs + d]); }
                __syncthreads();
#pragma unroll 1
                for (int j = 0; j < 32; ++j) {
                    const int kt = k0 + j; bool valid = true; float bias = 0.f;
                    if (seg == 0) {
                        if (KIND == 0) { const int kr = kt >> 6, kc = kt & 63; valid = kr >= rs && kr < rs + 8 && kc >= cs0 && kc < cs0 + 16;
                            if (valid) bias = Bsm[(kr - qr_ + 7) * 31 + (kc - qc_ + 15)]; }
                        else if (KIND == 1) { const int dd = kt - t; valid = dd <= 128 && dd >= -128; }
                    }
                    float s0 = 0.f, s1 = 0.f;
#pragma unroll
                    for (int d = 0; d < DH; d += 4) { const f32x4 kv = *(const LAS f32x4*)(Ks + j * DQK + half * DH + d); s0 += q[d] * kv.x + q[d + 2] * kv.z; s1 += q[d + 1] * kv.y + q[d + 3] * kv.w; }
                    float sp = s0 + s1; sp += __shfl_xor(sp, 1);
                    if (valid) {
                        const float s = sp * scale + bias;
                        if (s > m) { const float a = __expf(m - s); l *= a;
#pragma unroll
                            for (int d = 0; d < 32; ++d) o[d] *= a;
                            m = s; }
                        const float p = __expf(s - m); l += p;
#pragma unroll
                        for (int d = 0; d < 32; d += 4) { const f32x4 vv = *(const LAS f32x4*)(Vs + j * 64 + half * 32 + d); o[d] += p * vv.x; o[d + 1] += p * vv.y; o[d + 2] += p * vv.z; o[d + 3] += p * vv.w; }
                    }
                }
            }
        }
        { const float il = 1.f / l; bf16* orow = Ob + (size_t)t * D + h * 64 + half * 32;
#pragma unroll
            for (int d = 0; d < 32; d += 8) { u32x4 w; w.x = pk2(o[d] * il, o[d + 1] * il); w.y = pk2(o[d + 2] * il, o[d + 3] * il); w.z = pk2(o[d + 4] * il, o[d + 5] * il); w.w = pk2(o[d + 6] * il, o[d + 7] * il);
                *(u32x4*)(orow + d) = w; } }
    }
    __syncthreads();
}

#ifndef USE_FAST_ATTN
#define USE_FAST_ATTN 1
#endif
typedef short bf16x8 __attribute__((ext_vector_type(8)));
typedef short s16x4 __attribute__((ext_vector_type(4)));
typedef float f32x16 __attribute__((ext_vector_type(16)));
__device__ __forceinline__ s16x4 lds_tr16(const LAS unsigned char* p) { return __builtin_bit_cast(s16x4, __builtin_amdgcn_ds_read_tr16_b64_v4i16((LAS s16x4*)p)); }
__device__ __forceinline__ int crow(int r, int hi) { return (r & 3) + 8 * (r >> 2) + 4 * hi; }

template <int KIND>
__device__ __forceinline__ void ph_attn_fast(const Ctx& C, int slot) {
    constexpr int DQK = KIND == 2 ? 96 : 64, NS = DQK / 16, CPR = DQK / 8;
    constexpr int KS = DQK * 2 + 16, VS = 192, KBYTES = 64 * KS, BUFB = KBYTES + 64 * VS;
    LAS unsigned char* lds = C.lds;
    LAS float* Bsm = (LAS float*)(lds + 2 * BUFB);
    const bf16 *Qb, *Kb, *Vb, *KRb = nullptr; int qp, kp, vp, qhs, khs, vhs, kgrp = 1; float scale;
    if (KIND == 0) { Qb = WSP(bf16, WS_QKV); Kb = Qb + 1024; Vb = Qb + 2048; qp = kp = vp = 3072; qhs = khs = vhs = 64; scale = 0.125f; }
    else if (KIND == 1) { Qb = WSP(bf16, WS_QKV); Kb = Qb + 1024; Vb = Qb + 1280; qp = kp = vp = 1536; qhs = khs = vhs = 64; kgrp = 4; scale = 0.125f; }
    else { Qb = WSP(bf16, WS_Q); Kb = WSP(bf16, WS_KV); Vb = Kb + 64; KRb = WSP(bf16, WS_KROPE); qp = 1536; kp = vp = 2048; qhs = 96; khs = vhs = 128; scale = 0.10206207261596575f; }
    bf16* Ob = WSP(bf16, WS_O);
    const float c2 = scale * 1.4426950408889634f;
    const int w = C.wave, lane = C.lane, ql = lane & 31, hi = lane >> 5;
    const int kr0 = C.tid / CPR, kc0 = C.tid % CPR, kr1 = (C.tid + 512) / CPR, kc1 = (C.tid + 512) % CPR, vr = C.tid >> 3, vc = C.tid & 7;
    const bool k2 = (DQK == 96) && C.tid < 256;
    const int vlane = (((lane & 15) >> 2) + 4 * hi) * VS + (16 * ((lane >> 4) & 1) + 4 * (lane & 3)) * 2;
    for (int u = C.blk; u < 1040; u += C.G) {
        const bool isctx = u >= 1024;
        const int h = isctx ? (u - 1024) : (u & 15), q0 = isctx ? SEQ : (u >> 4) * 256, kh = h / kgrp;
        int lat0 = 0, nlat = 0;
        if (!isctx) {
            if (KIND == 0) { const int r0 = q0 >> 6; int ta = r0 - 4; ta = ta < 0 ? 0 : (ta > 248 ? 248 : ta); int tb = r0 - 1; tb = (tb < 0 ? 0 : (tb > 248 ? 248 : tb)) + 7; lat0 = ta; nlat = tb - ta + 1; }
            else if (KIND == 1) { const int a = q0 - 128 < 0 ? 0 : q0 - 128, b = q0 + 384 > SEQ ? SEQ : q0 + 384; lat0 = a >> 6; nlat = (b - a) >> 6; }
            else { lat0 = 0; nlat = SEQ / 64; }
        }
        const int ntiles = nlat + 4;
        const int t = q0 + 32 * w + ql;
        bf16x8 qf[NS];
        { const bf16* qr = Qb + (size_t)t * qp + h * qhs + 8 * hi;
#pragma unroll
          for (int sidx = 0; sidx < NS; ++sidx) qf[sidx] = *(const bf16x8*)(qr + 16 * sidx); }
        __syncthreads();
        if (KIND == 0) { const float* rp = C.in[10] + ((size_t)slot * 16 + h) * 465; for (int i = C.tid; i < 465; i += 512) Bsm[i] = rp[i] * 1.4426950408889634f; }
        float m = -INFINITY, l = 0.f;
        if (KIND == 1) { m = C.in[13][h] * 1.4426950408889634f; l = 1.f; }
        f32x16 ot[2];
#pragma unroll
        for (int r = 0; r < 16; ++r) { ot[0][r] = 0.f; ot[1][r] = 0.f; }
        const int qr_ = t >> 6, qc_ = t & 63;
        int rs = qr_ - 4; rs = rs < 0 ? 0 : (rs > 248 ? 248 : rs);
        int cs0 = qc_ - 8; cs0 = cs0 < 0 ? 0 : (cs0 > 48 ? 48 : cs0);
        const int wrow = (q0 >> 6) + (w >> 1);
        int wrs = wrow - 4; wrs = wrs < 0 ? 0 : (wrs > 248 ? 248 : wrs);
        const int wq0 = q0 + 32 * w;
        u32x4 kreg0, kreg1 = (u32x4){0u, 0u, 0u, 0u}, vreg;
#define ATT_KEY0(i) ((i) < nlat ? (lat0 + (i)) * 64 : SEQ + ((i) - nlat) * 64)
#define ATT_LOAD(i) do { const int key0_ = ATT_KEY0(i); \
        kreg0 = (KIND == 2 && kc0 >= 8) ? *(const u32x4*)(KRb + (size_t)(key0_ + kr0) * 32 + 8 * (kc0 - 8)) : *(const u32x4*)(Kb + (size_t)(key0_ + kr0) * kp + kh * khs + 8 * kc0); \
        if (k2) kreg1 = (kc1 >= 8) ? *(const u32x4*)(KRb + (size_t)(key0_ + kr1) * 32 + 8 * (kc1 - 8)) : *(const u32x4*)(Kb + (size_t)(key0_ + kr1) * kp + kh * khs + 8 * kc1); \
        vreg = *(const u32x4*)(Vb + (size_t)(key0_ + vr) * vp + kh * vhs + 8 * vc); } while (0)
#define ATT_STORE(b) do { LAS unsigned char* base_ = lds + (b) * BUFB; \
        *(LAS u32x4*)(base_ + kr0 * KS + 16 * kc0) = kreg0; if (k2) *(LAS u32x4*)(base_ + kr1 * KS + 16 * kc1) = kreg1; \
        *(LAS u32x4*)(base_ + KBYTES + vr * VS + 16 * vc) = vreg; } while (0)
        ATT_LOAD(0); ATT_STORE(0);
        __syncthreads();
        for (int i = 0; i < ntiles; ++i) {
            if (i + 1 < ntiles) ATT_LOAD(i + 1);
            const bool lat = i < nlat; const int key0 = ATT_KEY0(i);
            bool need = true;
            if (lat) { if (KIND == 0) { const int kr = lat0 + i; need = kr >= wrs && kr < wrs + 8; }
                       else if (KIND == 1) need = (key0 + 63 >= wq0 - 128) && (key0 <= wq0 + 31 + 128); }
            if (need) {
                const LAS unsigned char* kb = lds + (i & 1) * BUFB; const LAS unsigned char* vb = kb + KBYTES;
                f32x16 p0, p1;
#pragma unroll
                for (int r = 0; r < 16; ++r) { p0[r] = 0.f; p1[r] = 0.f; }
#pragma unroll
                for (int sidx = 0; sidx < NS; ++sidx) {
                    const bf16x8 a0 = *(const LAS bf16x8*)(kb + ql * KS + 32 * sidx + 16 * hi);
                    const bf16x8 a1 = *(const LAS bf16x8*)(kb + (32 + ql) * KS + 32 * sidx + 16 * hi);
                    p0 = __builtin_amdgcn_mfma_f32_32x32x16_bf16(a0, qf[sidx], p0, 0, 0, 0);
                    p1 = __builtin_amdgcn_mfma_f32_32x32x16_bf16(a1, qf[sidx], p1, 0, 0, 0);
                }
                float mx = -INFINITY;
#pragma unroll
                for (int r = 0; r < 16; ++r) {
                    float s0 = p0[r] * c2, s1 = p1[r] * c2;
                    if (lat && KIND == 0) { const int kr = lat0 + i; const int kc = crow(r, hi);
                        const bool v0 = (unsigned)(kc - cs0) < 16u, v1 = (unsigned)(kc + 32 - cs0) < 16u;
                        const int bi = (kr - qr_ + 7) * 31 + (kc - qc_ + 15);
                        s0 = v0 ? s0 + Bsm[v0 ? bi : 0] : -INFINITY; s1 = v1 ? s1 + Bsm[v1 ? bi + 32 : 0] : -INFINITY; }
                    if (lat && KIND == 1) { const int dd = key0 + crow(r, hi) - t; s0 = (unsigned)(dd + 128) <= 256u ? s0 : -INFINITY; s1 = (unsigned)(dd + 32 + 128) <= 256u ? s1 : -INFINITY; }
                    p0[r] = s0; p1[r] = s1; mx = fmaxf(mx, fmaxf(s0, s1));
                }
                mx = fmaxf(mx, __shfl_xor(mx, 32));
                const float mn = fmaxf(m, mx), ms = mn == -INFINITY ? 0.f : mn;
                const float alpha = __builtin_amdgcn_exp2f(m - ms);
                float rsum = 0.f;
#pragma unroll
                for (int r = 0; r < 16; ++r) { p0[r] = __builtin_amdgcn_exp2f(p0[r] - ms); p1[r] = __builtin_amdgcn_exp2f(p1[r] - ms); rsum += p0[r] + p1[r]; }
                rsum += __shfl_xor(rsum, 32);
                l = l * alpha + rsum; m = mn;
#pragma unroll
                for (int r = 0; r < 16; ++r) { ot[0][r] *= alpha; ot[1][r] *= alpha; }
                bf16x8 pf[4];
#pragma unroll
                for (int ks = 0; ks < 4; ++ks) { u32x4 pw;
                    if (ks < 2) { pw.x = cvt_pk_bf16(p0[8 * ks + 0], p0[8 * ks + 1]); pw.y = cvt_pk_bf16(p0[8 * ks + 2], p0[8 * ks + 3]); pw.z = cvt_pk_bf16(p0[8 * ks + 4], p0[8 * ks + 5]); pw.w = cvt_pk_bf16(p0[8 * ks + 6], p0[8 * ks + 7]); }
                    else { const int k8 = 8 * (ks - 2); pw.x = cvt_pk_bf16(p1[k8 + 0], p1[k8 + 1]); pw.y = cvt_pk_bf16(p1[k8 + 2], p1[k8 + 3]); pw.z = cvt_pk_bf16(p1[k8 + 4], p1[k8 + 5]); pw.w = cvt_pk_bf16(p1[k8 + 6], p1[k8 + 7]); }
                    pf[ks] = __builtin_bit_cast(bf16x8, pw); }
#pragma unroll
                for (int c = 0; c < 2; ++c)
#pragma unroll
                    for (int ks = 0; ks < 4; ++ks) {
                        const LAS unsigned char* vp_ = vb + vlane + (32 * (ks >> 1) + 16 * (ks & 1)) * VS + 64 * c;
                        const s16x4 lo = lds_tr16(vp_), hi4 = lds_tr16(vp_ + 8 * VS);
                        const bf16x8 av = (bf16x8){lo[0], lo[1], lo[2], lo[3], hi4[0], hi4[1], hi4[2], hi4[3]};
                        ot[c] = __builtin_amdgcn_mfma_f32_32x32x16_bf16(av, pf[ks], ot[c], 0, 0, 0);
                    }
            }
            if (i + 1 < ntiles) ATT_STORE((i + 1) & 1);
            __syncthreads();
        }
#undef ATT_KEY0
#undef ATT_LOAD
#undef ATT_STORE
        { const float il = 1.f / l; bf16* orow = Ob + (size_t)t * D + h * 64 + 4 * hi;
#pragma unroll
          for (int c = 0; c < 2; ++c)
#pragma unroll
            for (int g = 0; g < 4; ++g) { u32x2 o2; o2.x = cvt_pk_bf16(ot[c][4 * g] * il, ot[c][4 * g + 1] * il); o2.y = cvt_pk_bf16(ot[c][4 * g + 2] * il, ot[c][4 * g + 3] * il);
                *(u32x2*)(orow + 32 * c + 8 * g) = o2; } }
    }
    __syncthreads();
}
template <int KIND>
__device__ __forceinline__ void ph_attn(const Ctx& C, int slot) {
#if USE_FAST_ATTN
    ph_attn_fast<KIND>(C, slot);
#else
    ph_attn_naive<KIND>(C, slot);
#endif
}

#define PH_BEGIN if (lo <= ph && ph < hi) {
#define PH_END   if (ph + 1 < hi) xcd_barrier(bar); } ++ph;
#ifndef PROBE_MASK
#define PROBE_MASK 0
#endif
#define PHG(g, ...) PH_BEGIN __VA_ARGS__ PH_END if constexpr (((PROBE_MASK >> (g)) & 1) != 0) { PH_BEGIN __VA_ARGS__ PH_END }
template <int L>
__device__ __forceinline__ void layer_phases(const Ctx& C, const XcdBarrier& bar, int lo, int hi, int& ph) {
    constexpr int l = L, kind = L % 3, slot = L / 3; constexpr bool need_ctx = L < 3; constexpr int RL = need_ctx ? R : SEQ;
    PH_BEGIN ph_rowA<0>(C, l); PH_END
    if constexpr (kind == 0) {
        PHG(1, gemm(C, WSP(bf16, WS_H), WSP(bf16, WS_W_NAQKV) + (size_t)slot * 3072 * 1024, R, 3072, 1024, 0, 0, EpiStoreBf16{WSP(bf16, WS_QKV), 3072});)
        PHG(2, ph_attn<0>(C, slot);)
    } else if constexpr (kind == 1) {
        PHG(1, gemm(C, WSP(bf16, WS_H), WSP(bf16, WS_W_SWAQKV), R, 1536, 1024, 0, 0, EpiStoreBf16{WSP(bf16, WS_QKV), 1536});)
        PH_BEGIN ph_rope(C, WSP(bf16, WS_QKV), 1536, 20, 64, 0, 16); PH_END
        PHG(3, ph_attn<1>(C, slot);)
    } else {
        PHG(1, gemm(C, WSP(bf16, WS_H), WSP(bf16, WS_W_MLAD), R, 1024, 1024, 0, 0, EpiStoreF32{WSP(float, WS_CQ), 1024});)
        PHG(11, ph_mlanorm(C);)
        PHG(1, gemm(C, WSP(bf16, WS_CQN), WSP(bf16, WS_W_MLAUQ), R, 1536, 512, 0, 0, EpiStoreBf16{WSP(bf16, WS_Q), 1536});
                 gemm(C, WSP(bf16, WS_CKVN), WSP(bf16, WS_W_MLAUKV), R, 2048, 256, 0, 0, EpiStoreBf16{WSP(bf16, WS_KV), 2048});)
        PH_BEGIN ph_rope(C, WSP(bf16, WS_Q), 1536, 16, 96, 64, 8); PH_END
        PHG(4, ph_attn<2>(C, slot);)
    }
    const bf16* wo = kind == 0 ? WSP(bf16, WS_W_NAO) + (size_t)slot * 1024 * 1024 : (kind == 1 ? WSP(bf16, WS_W_SWAO) : WSP(bf16, WS_W_MLAO));
    PH_BEGIN gemm(C, WSP(bf16, WS_O), wo, RL, 1024, 1024, 0, 0, EpiResid{WSP(float, WS_X), modp(C, l, 0, 2), modp(C, l, 1, 2)}); PH_END
    PHG(5, ph_norm2(C, l, RL);)
    PHG(6, ph_topk(C, need_ctx);)
    PHG(7, ph_gather(C, need_ctx);)
    PHG(8, gemm_moe(C, WSP(bf16, WS_XG), WSP(bf16, WS_W_GU) + (size_t)l * 16 * 4096 * 1024, 4096, 1024, (size_t)4096 * 1024, need_ctx, EpiSwiglu{WSP(bf16, WS_ACT)});)
    PHG(9, gemm_moe(C, WSP(bf16, WS_ACT), WSP(bf16, WS_W_DN) + (size_t)l * 16 * 1024 * 2048, 1024, 2048, (size_t)1024 * 2048, need_ctx, EpiMoeOut{WSP(bf16, WS_YB), WSP(float, WS_GATEL)});)
}
__global__ void __launch_bounds__(512, 2) fwd_kernel(Args args) {
    extern __shared__ __attribute__((aligned(16))) unsigned char lds_raw[];
    Ctx C;
#pragma unroll
    for (int i = 0; i < 26; ++i) C.in[i] = args.in[i];
    C.out = args.out; C.ws = args.ws; C.lds = (LAS unsigned char*)lds_raw;
    C.tid = threadIdx.x; C.lane = C.tid & 63; C.wave = __builtin_amdgcn_readfirstlane(C.tid >> 6); C.blk = blockIdx.x; C.G = gridDim.x;
    volatile LAS unsigned* MISC = (volatile LAS unsigned*)(C.lds + MISC_OFF);
    if (C.tid < 32) MISC[C.tid] = 0u;
    __syncthreads();
    const int lo = args.ph_lo, hi = args.ph_hi;
    XcdBarrier bar; bar.bar = (unsigned*)(C.ws + WS_CTL) + CW_BAR; bar.x = 0; bar.st = nullptr;
    if (hi - lo > 1) bar = xcd_barrier_post((unsigned*)(C.ws + WS_CTL) + CW_BAR, MISC + 8);
    int ph = 0;
    PHG(0, ph_prologue(C);)
    layer_phases<0>(C, bar, lo, hi, ph);
    layer_phases<1>(C, bar, lo, hi, ph);
    layer_phases<2>(C, bar, lo, hi, ph);
    layer_phases<3>(C, bar, lo, hi, ph);
    PH_BEGIN ph_rowA<1>(C, 4); PH_END
}
#undef PH_BEGIN
#undef PH_END

extern "C" void kernel_launch(void* const* d_in, const int* in_sizes, int n_in, void* d_out, int out_size, void* d_ws, size_t ws_size, hipStream_t stream) {
    static int grid = 0;
    if (grid == 0) {
        if (n_in != 26 || out_size != SEQ * D || ws_size < WS_END) { fprintf(stderr, "kernel_launch: unexpected shapes (n_in %d out %d ws %zu)\n", n_in, out_size, ws_size); grid = -1; return; }
        int dev = 0, cus = 0, per_cu = 0;
        if (hipGetDevice(&dev) != hipSuccess || hipDeviceGetAttribute(&cus, hipDeviceAttributeMultiprocessorCount, dev) != hipSuccess) { grid = -1; return; }
        if (hipFuncSetAttribute((const void*)fwd_kernel, hipFuncAttributeMaxDynamicSharedMemorySize, LDS_BYTES) != hipSuccess) { fprintf(stderr, "kernel_launch: hipFuncSetAttribute failed\n"); grid = -1; return; }
        if (hipOccupancyMaxActiveBlocksPerMultiprocessor(&per_cu, (const void*)fwd_kernel, 512, LDS_BYTES) != hipSuccess || per_cu < 1) fprintf(stderr, "kernel_launch: occupancy query says %d\n", per_cu);
        (void)hipGetLastError();
        grid = cus;
    }
    if (grid < 0) return;
    if (hipMemsetAsync((char*)d_ws + WS_CTL, 0, CTL_ZERO_BYTES, stream) != hipSuccess) return;
    Args a{};
    for (int i = 0; i < 26; ++i) a.in[i] = (const float*)d_in[i];
    a.out = (float*)d_out; a.ws = (unsigned char*)d_ws; a.pad = 0;
#if MK_N_LAUNCHES == 1
    a.ph_lo = 0; a.ph_hi = 1 << 20; a.li = 0;
    hipLaunchKernelGGL(fwd_kernel, dim3(grid), dim3(512), LDS_BYTES, stream, a);
#else
    for (int li = 0; li < NPH; ++li) { a.ph_lo = li; a.ph_hi = li + 1; a.li = li;
        hipLaunchKernelGGL(fwd_kernel, dim3(grid), dim3(512), LDS_BYTES, stream, a); }
#endif
}
```

```cpp
#include <hip/hip_runtime.h>
#include <cstdio>
#include <cstdint>

#ifndef MK_N_LAUNCHES
#define MK_N_LAUNCHES 1
#endif

#define GAS __attribute__((address_space(1)))
#define LAS __attribute__((address_space(3)))
typedef unsigned short bf16;
typedef float f32x4 __attribute__((ext_vector_type(4)));
typedef unsigned u32x4 __attribute__((ext_vector_type(4)));
typedef unsigned u32x2 __attribute__((ext_vector_type(2)));

constexpr int D = 1024, SEQ = 16384, NCTX = 256, R = SEQ + NCTX, NE = 16, FF = 2048;
constexpr int CAP_L = 2048, CAP_C = 32, EROWS = 2304, XROWS = NE * EROWS;
constexpr float RMS_EPS = 1e-6f;
constexpr int NPH = 1 + 9 + 10 + 12 + 9 + 1;

constexpr size_t MiB = 1u << 20;
constexpr size_t WS_CTL = 0, CTL_ZERO_BYTES = 1 * MiB;
constexpr size_t WS_MOD = 1 * MiB;
constexpr size_t WS_W_NAQKV = 2 * MiB;
constexpr size_t WS_W_NAO = 14 * MiB;
constexpr size_t WS_W_SWAQKV = 18 * MiB;
constexpr size_t WS_W_SWAO = 21 * MiB;
constexpr size_t WS_W_MLAD = 23 * MiB;
constexpr size_t WS_W_MLAUQ = 25 * MiB;
constexpr size_t WS_W_MLAUKV = 27 * MiB;
constexpr size_t WS_W_MLAO = 28 * MiB;
constexpr size_t WS_W_GU = 32 * MiB;
constexpr size_t WS_W_DN = WS_W_GU + 512 * MiB;
constexpr size_t WS_X = WS_W_DN + 256 * MiB;
constexpr size_t WS_H = WS_X + 65 * MiB;
constexpr size_t WS_QKV = WS_H + 33 * MiB;
constexpr size_t WS_CQ = WS_QKV + 98 * MiB;
constexpr size_t WS_Q = WS_CQ + 65 * MiB;
constexpr size_t WS_KV = WS_Q + 49 * MiB;
constexpr size_t WS_CQN = WS_KV + 65 * MiB;
constexpr size_t WS_CKVN = WS_CQN + 17 * MiB;
constexpr size_t WS_KROPE = WS_CKVN + 9 * MiB;
constexpr size_t WS_O = WS_KROPE + 2 * MiB;
constexpr size_t WS_AFF = WS_O + 33 * MiB;
constexpr size_t WS_ROWL = WS_AFF + 2 * MiB;
constexpr size_t WS_GATEL = WS_ROWL + 1 * MiB;
constexpr size_t WS_INV = WS_GATEL + 1 * MiB;
constexpr size_t WS_XG = WS_INV + 2 * MiB;
constexpr size_t WS_ACT = WS_XG + 72 * MiB;
constexpr size_t WS_YB = WS_ACT + 144 * MiB;
constexpr size_t WS_END = WS_YB + 72 * MiB;
static_assert(WS_END <= 2048 * MiB, "d_ws map");
constexpr int CW_BAR = 4096;

constexpr int LDS_BYTES = 147456;
constexpr int MISC_OFF = 131072 + 320;

__device__ __forceinline__ float bf2f(unsigned b) { return __uint_as_float(b << 16); }
__device__ __forceinline__ unsigned f2bf(float f) { unsigned u = __float_as_uint(f); return (u + 0x7fffu + ((u >> 16) & 1u)) >> 16; }
__device__ __forceinline__ unsigned pk2(float lo, float hi) { return f2bf(lo) | (f2bf(hi) << 16); }
__device__ __forceinline__ float wave_sum(float v) {
#pragma unroll
    for (int o = 1; o < 64; o <<= 1) v += __shfl_xor(v, o);
    return v;
}
__device__ __forceinline__ int wave_sum_i(int v) {
#pragma unroll
    for (int o = 1; o < 64; o <<= 1) v += __shfl_xor(v, o);
    return v;
}

#define XB_TMO      128
#define XB_XCNT(j)  (256  + 64 * (j))
#define XB_XSUB(j)  (1280 + 64 * (j))
#define XB_XGEN(j)  (2304 + 64 * (j))
#define XB_TOP      3328
#define XB_TOPGEN   3392
#define XCD_BAR_WORDS 3456
#define XB_SPIN_CAP (1u << 18)
__device__ __forceinline__ unsigned xb_ld(unsigned* p)              { return __hip_atomic_load(p, __ATOMIC_RELAXED, __HIP_MEMORY_SCOPE_AGENT); }
__device__ __forceinline__ unsigned xb_add(unsigned* p, unsigned v) { return __hip_atomic_fetch_add(p, v, __ATOMIC_RELAXED, __HIP_MEMORY_SCOPE_AGENT); }
__device__ __forceinline__ unsigned xb_xcc_id() { return (unsigned)__builtin_amdgcn_s_getreg((3 << 11) | 20) & 0xFu; }
#define XB_SPIN(cond, bar) do { unsigned _sp = 0; while (cond) { __builtin_amdgcn_s_sleep(1); \
    if ((++_sp & 255u) == 0u) { if (xb_ld(&(bar)[XB_TMO])) break; if (_sp > XB_SPIN_CAP) { atomicAdd(&(bar)[XB_TMO], 1u); break; } } } } while (0)
struct XcdBarrier { unsigned* bar; unsigned x; volatile LAS unsigned* st; };
__device__ __forceinline__ XcdBarrier xcd_barrier_post(unsigned* bar, volatile LAS unsigned* st) {
    XcdBarrier b; b.bar = bar; b.x = xb_xcc_id(); b.st = st;
    if (threadIdx.x == 0) (void)xb_add(&bar[XB_XCNT(b.x)], 1u);
    return b;
}
__device__ __forceinline__ void xcd_barrier_complete(unsigned* bar, unsigned x, unsigned& nloc, unsigned& nx) {
    const unsigned G = gridDim.x * gridDim.y * gridDim.z;
    unsigned sum, cnt, mine, sp = 0u;
    for (;;) {
        sum = 0u; cnt = 0u; mine = 0u;
#pragma unroll
        for (unsigned j = 0; j < 16; ++j) { const unsigned c = xb_ld(&bar[XB_XCNT(j)]); sum += c; cnt += (c > 0u) ? 1u : 0u; mine = (j == x) ? c : mine; }
        if (sum == G) break;
        __builtin_amdgcn_s_sleep(1);
        if ((++sp & 255u) == 0u) { if (xb_ld(&bar[XB_TMO])) break; if (sp > XB_SPIN_CAP) { atomicAdd(&bar[XB_TMO], 1u); break; } }
    }
    nloc = mine > 0u ? mine : 1u; nx = cnt > 0u ? cnt : 1u;
}
__device__ __forceinline__ void xcd_barrier(const XcdBarrier& b) {
    asm volatile("s_waitcnt vmcnt(0)" ::: "memory");
    __syncthreads();
    if (threadIdx.x == 0) {
        unsigned* bar = b.bar;
        __builtin_amdgcn_s_waitcnt(0);
        unsigned nloc = b.st[0], nx = b.st[1];
        if (nloc == 0u) { xcd_barrier_complete(bar, b.x, nloc, nx); b.st[0] = nloc; b.st[1] = nx; }
        const unsigned old = xb_add(&bar[XB_XSUB(b.x)], 1u);
        const unsigned gen = old / nloc;
        if (old + 1u == (gen + 1u) * nloc) {
            __builtin_amdgcn_fence(__ATOMIC_RELEASE, "agent");
            asm volatile("s_waitcnt vmcnt(0)" ::: "memory");
            const unsigned og = xb_add(&bar[XB_TOP], 1u);
            const unsigned tg = og / nx;
            if (og + 1u == (tg + 1u) * nx) xb_add(&bar[XB_TOPGEN], 1u);
            else XB_SPIN(xb_ld(&bar[XB_TOPGEN]) == tg, bar);
            __builtin_amdgcn_fence(__ATOMIC_ACQUIRE, "agent");
            xb_add(&bar[XB_XGEN(b.x)], 1u);
            asm volatile("s_waitcnt vmcnt(0)" ::: "memory");
        } else {
            XB_SPIN(xb_ld(&bar[XB_XGEN(b.x)]) == gen, bar);
            __builtin_amdgcn_fence(__ATOMIC_ACQUIRE, "agent");
            asm volatile("s_waitcnt vmcnt(0)" ::: "memory");
        }
    }
    __syncthreads();
}

struct Args { const float* in[26]; float* out; unsigned char* ws; int ph_lo, ph_hi, li, pad; };
struct Ctx {
    const float* in[26]; float* out; unsigned char* ws;
    LAS unsigned char* lds;
    int tid, lane, wave, blk, G;
};
#define WSP(T, off) ((T*)(C.ws + (off)))
__device__ __forceinline__ const float* modp(const Ctx& C, int l, int set, int j) { return (const float*)(C.ws + WS_MOD) + ((l * 2 + set) * 6 + j) * D; }

__device__ __forceinline__ void p0_transpose_item(const float* W, int K, int N, bf16* WT, int k0, int n0, int drow0, LAS float* scr, int lane) {
#pragma unroll 8
    for (int i = 0; i < 32; ++i) { const int kk = 2 * i + (lane >> 5); scr[kk * 33 + (lane & 31)] = W[(size_t)(k0 + kk) * N + n0 + (lane & 31)]; }
    asm volatile("s_waitcnt lgkmcnt(0)" ::: "memory");
    const int c = lane & 7;
#pragma unroll
    for (int j = 0; j < 4; ++j) { const int n = (lane >> 3) + 8 * j; const LAS float* s = scr + (8 * c) * 33 + n;
        u32x4 o; o.x = pk2(s[0 * 33], s[1 * 33]); o.y = pk2(s[2 * 33], s[3 * 33]); o.z = pk2(s[4 * 33], s[5 * 33]); o.w = pk2(s[6 * 33], s[7 * 33]);
        *(u32x4*)(WT + (size_t)(drow0 + n) * K + k0 + 8 * c) = o; }
    asm volatile("s_waitcnt lgkmcnt(0)" ::: "memory");
}
__device__ __forceinline__ bool p0_plain(int& r, const float* W, int K, int N, bf16* WT, int row_off, LAS float* scr, int lane) {
    const int nblk = N / 32, cnt = (K / 64) * nblk;
    if (r >= cnt) { r -= cnt; return false; }
    const int kb = r / nblk, nb = r % nblk;
    p0_transpose_item(W, K, N, WT, kb * 64, nb * 32, row_off + nb * 32, scr, lane);
    return true;
}
__device__ __forceinline__ void ph_prologue(const Ctx& C) {
    LAS float* scr = (LAS float*)(C.lds + C.wave * 16384);
    const int gw = C.blk * 8 + C.wave, NGW = C.G * 8;
    constexpr int MOE_ITEMS = 4 * 16 * 3072;
    constexpr int SMALL_ITEMS = 2 * 1536 + 2 * 512 + 768 + 512 + 256 + 144 + 384 + 256 + 512;
    for (int it = gw; it < MOE_ITEMS + SMALL_ITEMS; it += NGW) {
        if (it < MOE_ITEMS) {
            const int le = it / 3072, r2 = it % 3072, which = r2 / 1024, item = r2 % 1024, l = le / 16, e = le % 16;
            if (which < 2) {
                const float* W = (which ? C.in[23] : C.in[22]) + (size_t)le * 1024 * 2048;
                bf16* WT = WSP(bf16, WS_W_GU) + ((size_t)l * 16 + e) * 4096 * 1024;
                const int kb = item / 64, nb = item % 64, n0 = nb * 32;
                p0_transpose_item(W, 1024, 2048, WT, kb * 64, n0, (n0 >> 7) * 256 + (n0 & 127) + which * 128, scr, C.lane);
            } else {
                const float* W = C.in[24] + (size_t)le * 2048 * 1024;
                bf16* WT = WSP(bf16, WS_W_DN) + ((size_t)l * 16 + e) * 1024 * 2048;
                const int kb = item / 32, nb = item % 32;
                p0_transpose_item(W, 2048, 1024, WT, kb * 64, nb * 32, nb * 32, scr, C.lane);
            }
            continue;
        }
        int r = it - MOE_ITEMS;
        if (p0_plain(r, C.in[8], 1024, 3072, WSP(bf16, WS_W_NAQKV), 0, scr, C.lane)) continue;
        if (p0_plain(r, C.in[8] + (size_t)1024 * 3072, 1024, 3072, WSP(bf16, WS_W_NAQKV) + (size_t)3072 * 1024, 0, scr, C.lane)) continue;
        if (p0_plain(r, C.in[9], 1024, 1024, WSP(bf16, WS_W_NAO), 0, scr, C.lane)) continue;
        if (p0_plain(r, C.in[9] + (size_t)1024 * 1024, 1024, 1024, WSP(bf16, WS_W_NAO) + (size_t)1024 * 1024, 0, scr, C.lane)) continue;
        if (p0_plain(r, C.in[11], 1024, 1536, WSP(bf16, WS_W_SWAQKV), 0, scr, C.lane)) continue;
        if (p0_plain(r, C.in[12], 1024, 1024, WSP(bf16, WS_W_SWAO), 0, scr, C.lane)) continue;
        if (p0_plain(r, C.in[14], 1024, 512, WSP(bf16, WS_W_MLAD), 0, scr, C.lane)) continue;
        if (p0_plain(r, C.in[17], 1024, 288, WSP(bf16, WS_W_MLAD), 512, scr, C.lane)) continue;
        if (p0_plain(r, C.in[16], 512, 1536, WSP(bf16, WS_W_MLAUQ), 0, scr, C.lane)) continue;
        if (p0_plain(r, C.in[19], 256, 2048, WSP(bf16, WS_W_MLAUKV), 0, scr, C.lane)) continue;
        p0_plain(r, C.in[20], 1024, 1024, WSP(bf16, WS_W_MLAO), 0, scr, C.lane);
    }
    { u32x4* z = (u32x4*)(WSP(bf16, WS_W_MLAD) + (size_t)800 * 1024); const int n16 = 224 * 1024 * 2 / 16;
      for (int i = C.blk * 512 + C.tid; i < n16; i += C.G * 512) z[i] = (u32x4){0u, 0u, 0u, 0u}; }
    __syncthreads();
    LAS float* sc = (LAS float*)C.lds;
    LAS float* red = sc + 2048;
    for (int i = C.tid; i < 2048; i += 512) { const float v = (i < 1024) ? C.in[1][i] : C.in[3][i - 1024]; sc[i] = v / (1.f + __expf(-v)); }
    __syncthreads();
    for (int u = C.blk; u < 4 * 96; u += C.G) {
        const int l = u / 96, j0 = (u % 96) * 64, kq = C.tid >> 6, jj = C.tid & 63;
        const float* W = C.in[4] + (size_t)l * 1024 * 6144 + j0 + jj;
        float a0 = 0.f, a1 = 0.f;
#pragma unroll 8
        for (int k = kq * 128; k < kq * 128 + 128; ++k) { const float w = W[(size_t)k * 6144]; a0 += sc[k] * w; a1 += sc[1024 + k] * w; }
        red[kq * 64 + jj] = a0; red[512 + kq * 64 + jj] = a1;
        __syncthreads();
        if (C.tid < 128) { const int set = C.tid >> 6, j = C.tid & 63; float s = 0.f;
#pragma unroll
            for (int q = 0; q < 8; ++q) s += red[set * 512 + q * 64 + j];
            const int col = j0 + j;
            ((float*)(C.ws + WS_MOD))[((l * 2 + set) * 6) * D + col] = s + C.in[5][l * 6144 + col]; }
        __syncthreads();
    }
}

template <int MODE>
__device__ __forceinline__ void ph_rowA(const Ctx& C, int l) {
    float* X = WSP(float, WS_X); bf16* H = WSP(bf16, WS_H); const int* INV = WSP(int, WS_INV); const bf16* YB = WSP(bf16, WS_YB);
    const int nrows = MODE == 1 ? SEQ : R;
    for (int t = C.blk * 8 + C.wave; t < nrows; t += C.G * 8) {
        const int set = t >= SEQ ? 1 : 0;
        const float* src = (MODE == 0 && l == 0) ? (set ? C.in[2] + (size_t)(t - SEQ) * D : C.in[0] + (size_t)t * D) : X + (size_t)t * D;
        f32x4 v[4];
#pragma unroll
        for (int j = 0; j < 4; ++j) v[j] = ((const f32x4*)src)[C.lane + 64 * j];
        if (MODE == 1 || l > 0) {
            const int lp = MODE == 1 ? 3 : l - 1;
            const int myinv = C.lane < 16 ? INV[(size_t)t * 16 + C.lane] : -1;
            f32x4 a[4];
#pragma unroll
            for (int j = 0; j < 4; ++j) a[j] = (f32x4){0.f, 0.f, 0.f, 0.f};
            for (int e = 0; e < 16; ++e) {
                const int s = __shfl(myinv, e);
                if (s >= 0) {
                    const u32x2* yr = (const u32x2*)(YB + ((size_t)e * EROWS + s) * D);
#pragma unroll
                    for (int j = 0; j < 4; ++j) { const u32x2 w = yr[C.lane + 64 * j];
                        a[j] += (f32x4){bf2f(w.x & 0xffffu), bf2f(w.x >> 16), bf2f(w.y & 0xffffu), bf2f(w.y >> 16)}; }
                }
            }
            const f32x4* g = (const f32x4*)modp(C, lp, set, 5);
#pragma unroll
            for (int j = 0; j < 4; ++j) v[j] += g[C.lane + 64 * j] * a[j];
        }
        if (MODE == 0) {
#pragma unroll
            for (int j = 0; j < 4; ++j) ((f32x4*)(X + (size_t)t * D))[C.lane + 64 * j] = v[j];
        }
        float ss = 0.f;
#pragma unroll
        for (int j = 0; j < 4; ++j) ss += (v[j].x * v[j].x + v[j].y * v[j].y) + (v[j].z * v[j].z + v[j].w * v[j].w);
        const float rstd = rsqrtf(wave_sum(ss) * (1.f / D) + RMS_EPS);
        if (MODE == 0) {
            const f32x4* w = (const f32x4*)(C.in[6] + (size_t)l * D); const f32x4* sh = (const f32x4*)modp(C, l, set, 0); const f32x4* scl = (const f32x4*)modp(C, l, set, 1);
#pragma unroll
            for (int j = 0; j < 4; ++j) { const int i = C.lane + 64 * j; const f32x4 y = v[j] * rstd * w[i] * (scl[i] + 1.f) + sh[i];
                u32x2 o; o.x = pk2(y.x, y.y); o.y = pk2(y.z, y.w); ((u32x2*)(H + (size_t)t * D))[i] = o; }
        } else {
            const f32x4* w = (const f32x4*)C.in[25];
#pragma unroll
            for (int j = 0; j < 4; ++j) { const int i = C.lane + 64 * j; ((f32x4*)(C.out + (size_t)t * D))[i] = v[j] * rstd * w[i]; }
        }
    }
}
#define RS_STEP(lo, hi, bit, off) ((bit ? hi : lo) + __shfl_xor(bit ? lo : hi, off))
__device__ __forceinline__ float rscatter16(const float (&a)[16], int b5, int b4, int b3, int b2) {
    const float c0 = RS_STEP(a[0], a[8], b5, 32), c1 = RS_STEP(a[1], a[9], b5, 32), c2 = RS_STEP(a[2], a[10], b5, 32), c3 = RS_STEP(a[3], a[11], b5, 32);
    const float c4 = RS_STEP(a[4], a[12], b5, 32), c5 = RS_STEP(a[5], a[13], b5, 32), c6 = RS_STEP(a[6], a[14], b5, 32), c7 = RS_STEP(a[7], a[15], b5, 32);
    const float d0 = RS_STEP(c0, c4, b4, 16), d1 = RS_STEP(c1, c5, b4, 16), d2 = RS_STEP(c2, c6, b4, 16), d3 = RS_STEP(c3, c7, b4, 16);
    const float e0 = RS_STEP(d0, d2, b3, 8), e1 = RS_STEP(d1, d3, b3, 8);
    return RS_STEP(e0, e1, b2, 4);
}
constexpr int NR2 = 1;
__device__ __forceinline__ void ph_norm2(const Ctx& C, int l, int nrows) {
    const float* X = WSP(float, WS_X); bf16* H = WSP(bf16, WS_H); float* AFF = WSP(float, WS_AFF);
    LAS float* Rs = (LAS float*)C.lds;
    const float* rt = C.in[21] + (size_t)l * D * NE;
    for (int i = C.tid; i < D * NE / 4; i += 512) { const f32x4 r4 = ((const f32x4*)rt)[i]; const int c = i >> 2, e0 = (i & 3) * 4;
        Rs[(e0 + 0) * D + c] = r4.x; Rs[(e0 + 1) * D + c] = r4.y; Rs[(e0 + 2) * D + c] = r4.z; Rs[(e0 + 3) * D + c] = r4.w; }
    __syncthreads();
    const int b5 = (C.lane >> 5) & 1, b4 = (C.lane >> 4) & 1, b3 = (C.lane >> 3) & 1, b2 = (C.lane >> 2) & 1, my_e = 8 * b5 + 4 * b4 + 2 * b3 + b2;
    for (int t0 = (C.blk * 8 + C.wave) * NR2; t0 < nrows; t0 += C.G * 8 * NR2) {
        asm volatile("" ::: "memory");
        const int set = t0 >= SEQ ? 1 : 0;
        f32x4 v[NR2][4];
#pragma unroll
        for (int rr = 0; rr < NR2; ++rr) {
#pragma unroll
            for (int j = 0; j < 4; ++j) v[rr][j] = ((const f32x4*)(X + (size_t)(t0 + rr) * D))[C.lane + 64 * j];
        }
        { const f32x4* w = (const f32x4*)(C.in[7] + (size_t)l * D); const f32x4* sh = (const f32x4*)modp(C, l, set, 3); const f32x4* scl = (const f32x4*)modp(C, l, set, 4);
          float rstd[NR2];
#pragma unroll
          for (int rr = 0; rr < NR2; ++rr) { float ss = 0.f;
#pragma unroll
            for (int j = 0; j < 4; ++j) ss += (v[rr][j].x * v[rr][j].x + v[rr][j].y * v[rr][j].y) + (v[rr][j].z * v[rr][j].z + v[rr][j].w * v[rr][j].w);
            rstd[rr] = rsqrtf(wave_sum(ss) * (1.f / D) + RMS_EPS); }
#pragma unroll
          for (int j = 0; j < 4; ++j) { const int i = C.lane + 64 * j; const f32x4 ws = w[i] * (scl[i] + 1.f), s4 = sh[i];
#pragma unroll
            for (int rr = 0; rr < NR2; ++rr) { v[rr][j] = v[rr][j] * rstd[rr] * ws + s4;
                u32x2 o; o.x = pk2(v[rr][j].x, v[rr][j].y); o.y = pk2(v[rr][j].z, v[rr][j].w); ((u32x2*)(H + (size_t)(t0 + rr) * D))[i] = o; } } }
        asm volatile("" ::: "memory");
        float lg[NR2][16];
#pragma unroll
        for (int e = 0; e < 16; ++e) {
            float sacc[NR2];
#pragma unroll
            for (int rr = 0; rr < NR2; ++rr) sacc[rr] = 0.f;
#pragma unroll
            for (int j = 0; j < 4; ++j) { const f32x4 r = *(const LAS f32x4*)(Rs + e * D + 4 * (C.lane + 64 * j));
#pragma unroll
                for (int rr = 0; rr < NR2; ++rr) sacc[rr] += (v[rr][j].x * r.x + v[rr][j].y * r.y) + (v[rr][j].z * r.z + v[rr][j].w * r.w); }
#pragma unroll
            for (int rr = 0; rr < NR2; ++rr) lg[rr][e] = sacc[rr];
            if ((e & 3) == 3) asm volatile("" ::: "memory");
        }
#pragma unroll
        for (int rr = 0; rr < NR2; ++rr) {
            float vv = rscatter16(lg[rr], b5, b4, b3, b2);
            vv += __shfl_xor(vv, 1); vv += __shfl_xor(vv, 2);
            float mx = vv; mx = fmaxf(mx, __shfl_xor(mx, 4)); mx = fmaxf(mx, __shfl_xor(mx, 8)); mx = fmaxf(mx, __shfl_xor(mx, 16)); mx = fmaxf(mx, __shfl_xor(mx, 32));
            const float ex = __expf(vv - mx); float sm = ex; sm += __shfl_xor(sm, 4); sm += __shfl_xor(sm, 8); sm += __shfl_xor(sm, 16); sm += __shfl_xor(sm, 32);
            if ((C.lane & 3) == 0) AFF[(size_t)my_e * R + t0 + rr] = ex / sm;
        }
    }
}

__device__ __forceinline__ int block_sum_i(int v, LAS int* scr, int wave, int lane) {
    v = wave_sum_i(v);
    if (lane == 0) scr[wave] = v;
    __syncthreads();
    int t = 0;
#pragma unroll
    for (int w = 0; w < 8; ++w) t += scr[w];
    __syncthreads();
    return t;
}
__device__ __forceinline__ int block_excl_scan(int v, LAS int* scr, int wave, int lane) {
    int inc = v;
#pragma unroll
    for (int o = 1; o < 64; o <<= 1) { const int n = __shfl_up(inc, o); if (lane >= o) inc += n; }
    if (lane == 63) scr[wave] = inc;
    __syncthreads();
    int off = 0;
#pragma unroll
    for (int w = 0; w < 8; ++w) off += (w < wave) ? scr[w] : 0;
    __syncthreads();
    return off + inc - v;
}
template <int KPT>
__device__ __forceinline__ void topk_unit(const Ctx& C, int e, int base, int n, int cap, int slot0) {
    const float* aff = WSP(float, WS_AFF) + (size_t)e * R + base;
    int* rowl = WSP(int, WS_ROWL) + e * EROWS; float* gatel = WSP(float, WS_GATEL) + e * EROWS; int* INV = WSP(int, WS_INV);
    LAS unsigned* hist = (LAS unsigned*)C.lds;
    LAS int* scr = (LAS int*)(hist + 256);
    LAS unsigned* bc = hist + 256 + 16;
    unsigned key[KPT];
    if (KPT == 32) {
#pragma unroll
        for (int j = 0; j < KPT; j += 4) { const u32x4 k4 = *(const u32x4*)(aff + C.tid * KPT + j); key[j] = k4.x; key[j + 1] = k4.y; key[j + 2] = k4.z; key[j + 3] = k4.w; }
    } else {
#pragma unroll
        for (int j = 0; j < KPT; ++j) { const int t = C.tid * KPT + j; key[j] = t < n ? __float_as_uint(aff[t]) : 0u; }
    }
    unsigned prefix = 0u, pmask = 0u; int kth = cap;
    for (int pass = 0; pass < 4; ++pass) {
        const int shift = 24 - 8 * pass;
        if (C.tid < 256) hist[C.tid] = 0u;
        __syncthreads();
#pragma unroll
        for (int j = 0; j < KPT; ++j) if (key[j] != 0u && (key[j] & pmask) == prefix) __hip_atomic_fetch_add(hist + ((key[j] >> shift) & 255u), 1u, __ATOMIC_RELAXED, __HIP_MEMORY_SCOPE_WORKGROUP);
        __syncthreads();
        if (C.wave == 0) {
            const unsigned c0 = hist[4 * C.lane], c1 = hist[4 * C.lane + 1], c2 = hist[4 * C.lane + 2], c3 = hist[4 * C.lane + 3];
            const int tot = (int)(c0 + c1 + c2 + c3); int suf = tot;
#pragma unroll
            for (int o = 1; o < 64; o <<= 1) { const int nb = __shfl_down(suf, o); if (C.lane + o < 64) suf += nb; }
            const unsigned long long bal = __ballot(suf >= kth);
            const int lstar = 63 - __builtin_clzll(bal);
            if (C.lane == lstar) { int above = suf - tot; unsigned dg; int nk;
                if (above + (int)c3 >= kth) { dg = 3; nk = kth - above; }
                else { above += (int)c3; if (above + (int)c2 >= kth) { dg = 2; nk = kth - above; }
                else { above += (int)c2; if (above + (int)c1 >= kth) { dg = 1; nk = kth - above; }
                else { above += (int)c1; dg = 0; nk = kth - above; } } }
                bc[0] = 4u * (unsigned)C.lane + dg; bc[1] = (unsigned)nk; }
        }
        __syncthreads();
        prefix |= bc[0] << shift; pmask |= 255u << shift; kth = (int)bc[1];
    }
    const int need_eq = kth;
    int ce = 0;
#pragma unroll
    for (int j = 0; j < KPT; ++j) ce += key[j] == prefix ? 1 : 0;
    int eqr = block_excl_scan(ce, scr, C.wave, C.lane);
    int nsel = 0; unsigned selmask = 0u;
#pragma unroll
    for (int j = 0; j < KPT; ++j) { bool sl = key[j] > prefix; if (key[j] == prefix) { sl = eqr < need_eq; ++eqr; } if (sl) { ++nsel; selmask |= 1u << j; } }
    int slot = block_excl_scan(nsel, scr, C.wave, C.lane);
#pragma unroll
    for (int j = 0; j < KPT; ++j) { const int t = C.tid * KPT + j;
        if (t < n) {
            if ((selmask >> j) & 1u) { rowl[slot0 + slot] = base + t; gatel[slot0 + slot] = __uint_as_float(key[j]); INV[(size_t)(base + t) * 16 + e] = slot0 + slot; ++slot; }
            else INV[(size_t)(base + t) * 16 + e] = -1;
        } }
}
__device__ __forceinline__ void ph_topk(const Ctx& C, bool with_ctx) {
    for (int u = C.blk; u < (with_ctx ? 32 : 16); u += C.G) {
        const int e = u & 15;
        if (u < 16) topk_unit<32>(C, e, 0, SEQ, CAP_L, 0);
        else topk_unit<1>(C, e, SEQ, NCTX, CAP_C, CAP_L);
        __syncthreads();
    }
}
__device__ __forceinline__ void ph_gather(const Ctx& C, bool with_ctx) {
    const int* rowl = WSP(int, WS_ROWL); const bf16* H = WSP(bf16, WS_H); bf16* XG = WSP(bf16, WS_XG);
    const int nslots = with_ctx ? CAP_L + CAP_C : CAP_L, ntot = NE * nslots;
    for (int i = C.blk * 8 + C.wave; i < ntot; i += C.G * 8) {
        const int e = i / nslots, sl = i % nslots, r = e * EROWS + sl;
        const int src = rowl[r];
        u32x4* d = (u32x4*)(XG + (size_t)r * D); const u32x4* sp = (const u32x4*)(H + (size_t)src * D);
        d[C.lane] = sp[C.lane]; d[C.lane + 64] = sp[C.lane + 64];
    }
}
__device__ __forceinline__ void rot_angles(int t, int half, int d, int quarter, float& cs, float& sn) {
    const float invf = exp2f(-(float)d * (13.287712379549449f / (float)quarter));
    const float pos = half ? (float)(t & 63) : (float)(t >> 6);
    const float ang = pos * invf;
    const double rev = (double)ang * 0.15915494309189535; const float fr = (float)(rev - __builtin_rint(rev));
    cs = __builtin_amdgcn_cosf(fr); sn = __builtin_amdgcn_sinf(fr);
}
__device__ __forceinline__ void ph_rope(const Ctx& C, bf16* buf, int pitch, int nheads, int head_stride, int off, int quarter) {
    const int per_tok = nheads * 2 * quarter; const long total = (long)SEQ * per_tok;
    for (long i = (long)C.blk * 512 + C.tid; i < total; i += (long)C.G * 512) {
        const int t = (int)(i / per_tok), r = (int)(i % per_tok), h = r / (2 * quarter), p = r % (2 * quarter), half = p / quarter, d = p % quarter;
        float cs, sn; rot_angles(t, half, d, quarter, cs, sn);
        bf16* b = buf + (size_t)t * pitch + h * head_stride + off + half * 2 * quarter + d;
        const float x1 = bf2f(b[0]), x2 = bf2f(b[quarter]);
        b[0] = (bf16)f2bf(x1 * cs - x2 * sn); b[quarter] = (bf16)f2bf(x1 * sn + x2 * cs);
    }
}
__device__ __forceinline__ void ph_mlanorm(const Ctx& C) {
    const float* CQ = WSP(float, WS_CQ); bf16* CQN = WSP(bf16, WS_CQN); bf16* CKVN = WSP(bf16, WS_CKVN); bf16* KR = WSP(bf16, WS_KROPE);
    for (int t = C.blk * 8 + C.wave; t < R; t += C.G * 8) {
        const float* row = CQ + (size_t)t * D;
        const f32x4 a0 = ((const f32x4*)row)[C.lane], a1 = ((const f32x4*)row)[C.lane + 64], b0 = ((const f32x4*)(row + 512))[C.lane];
        const float sa = wave_sum((a0.x * a0.x + a0.y * a0.y) + (a0.z * a0.z + a0.w * a0.w) + (a1.x * a1.x + a1.y * a1.y) + (a1.z * a1.z + a1.w * a1.w));
        const float sb = wave_sum((b0.x * b0.x + b0.y * b0.y) + (b0.z * b0.z + b0.w * b0.w));
        const float ra = rsqrtf(sa * (1.f / 512.f) + RMS_EPS), rb = rsqrtf(sb * (1.f / 256.f) + RMS_EPS);
        const f32x4* gq = (const f32x4*)C.in[15]; const f32x4* gk = (const f32x4*)C.in[18];
        { const f32x4 y0 = a0 * ra * gq[C.lane], y1 = a1 * ra * gq[C.lane + 64], z = b0 * rb * gk[C.lane];
          u32x2 o; o.x = pk2(y0.x, y0.y); o.y = pk2(y0.z, y0.w); ((u32x2*)(CQN + (size_t)t * 512))[C.lane] = o;
          o.x = pk2(y1.x, y1.y); o.y = pk2(y1.z, y1.w); ((u32x2*)(CQN + (size_t)t * 512))[C.lane + 64] = o;
          o.x = pk2(z.x, z.y); o.y = pk2(z.z, z.w); ((u32x2*)(CKVN + (size_t)t * 256))[C.lane] = o; }
        const float x = row[768 + (C.lane & 31)];
        const float xp = __shfl_xor(x, 8);
        float y = x;
        if (t < SEQ) { float cs, sn; rot_angles(t, (C.lane >> 4) & 1, C.lane & 7, 8, cs, sn);
            y = ((C.lane >> 3) & 1) ? (xp * sn + x * cs) : (x * cs - xp * sn); }
        if (C.lane < 32) KR[(size_t)t * 32 + C.lane] = (bf16)f2bf(y);
    }
}

namespace pg8 {
#define PG8_LAS __attribute__((address_space(3)))
typedef unsigned short bf16_t;
typedef short bf16x8 __attribute__((ext_vector_type(8)));
typedef float f32x4 __attribute__((ext_vector_type(4)));
typedef unsigned u32x4 __attribute__((ext_vector_type(4)));
constexpr int BM = 256, BK = 64, HALF = 128, HTB = HALF * BK * 2  , STAGE_BYTES = 8 * HTB, NXCD = 8, WGM = 8;

__host__ __device__ __forceinline__ int lds_byte(int r, int c) { const int st = (r >> 4) * 2 + (c >> 5), rr = r & 15, cc = c & 31, ob = rr * 64 + cc * 2; return st * 1024 + (ob ^ (((ob >> 9) & 1) << 5)); }
__host__ __device__ __forceinline__ void stage_rc(int b, int& R, int& C) { const int st = b / 1024, sb = b % 1024, swz = sb ^ (((sb >> 9) & 1) << 5); R = (st >> 1) * 16 + swz / 64; C = (st & 1) * 32 + (swz % 64) / 2; }
__host__ __device__ __forceinline__ int perm32(int rho) { const int n = rho >> 4, i = rho & 15; return 8 * (i >> 2) + 4 * n + (i & 3); }

struct Unit { int pm, pn, thin; };
struct Gemm { const bf16_t* A; const bf16_t* Bt; int M, N, K; int pm_per_grp; size_t grp_stride; };

struct StaticOrder {
    int nM, nN, nwg, G, c;
    __host__ __device__ void init(int M, int N, int G_, int c_) { nM = M / BM; nN = N / BM; nwg = nM * nN; G = G_; c = c_; }
    __host__ __device__ bool next(int i, Unit& u) const {
        const long L = (long)i * G + c; if (L >= nwg) return false;
        int wgid = (int)L; { const int q = nwg / NXCD, r = nwg % NXCD, xcd = wgid % NXCD, off = wgid / NXCD; wgid = (xcd < r ? xcd * (q + 1) : r * (q + 1) + (xcd - r) * q) + off; }
        const int nig = WGM * nN, gid = wgid / nig, fm = gid * WGM, gsz = (nM - fm) < WGM ? (nM - fm) : WGM;
        u.pm = fm + ((wgid % nig) % gsz); u.pn = (wgid % nig) / gsz; u.thin = 0; return true;
    }
    __device__ __forceinline__ void a_ready(const Unit&) const {}
    __device__ __forceinline__ void done(const Unit&) const {}
};
struct MoeOrder {
    StaticOrder base; int nN, nthin;
    __host__ __device__ void init(int N, int G_, int c_, bool with_thin) { base.init(NEXP_PANELS * BM, N, G_, c_); nN = N / BM; nthin = with_thin ? 16 * nN : 0; }
    static constexpr int NEXP_PANELS = 16 * 8;
    __host__ __device__ bool next(int i, Unit& u) const {
        if (base.next(i, u)) { u.pm = (u.pm >> 3) * 9 + (u.pm & 7); return true; }
        const long j = (long)i * base.G + base.c - base.nwg; if (j >= nthin) return false;
        u.pm = (int)(j / nN) * 9 + 8; u.pn = (int)(j % nN); u.thin = 1; return true;
    }
    __device__ __forceinline__ void a_ready(const Unit&) const {}
    __device__ __forceinline__ void done(const Unit&) const {}
};

template <class Epi, class Sched, bool ALIGN_EPI = false, bool SP2 = false>
__device__ __forceinline__ void gemm_phase(PG8_LAS unsigned char* lds, const Gemm g, const Sched& S, const Epi& E) {
    const int tid = threadIdx.x, wid = __builtin_amdgcn_readfirstlane(tid >> 6), lane = tid & 63, wr = wid >> 2, wc = wid & 3, fr = lane & 15, fq = lane >> 4;
    const int K = g.K, nt = K / BK;
    unsigned voffA[2], voffB[2];
#pragma unroll
    for (int i = 0; i < 2; ++i) { int R, C; stage_rc(tid * 16 + i * 8192, R, C); const int Rb = Epi::PERM ? ((R & ~31) + perm32(R & 31)) : R;
        voffA[i] = (unsigned)(R * K + C) * 2u; voffB[i] = (unsigned)(Rb * K + C) * 2u; }
    const size_t kstep = (size_t)(BK * 2);
    const size_t hstep = (size_t)HALF * K * 2;
    const size_t tstep = 2 * hstep;
    const unsigned ldsw = (unsigned)wid * 1024u;
    const int aoff = lds_byte(wr * 64 + fr, fq * 8), boff = lds_byte(wc * 32 + fr, fq * 8);
#define PG8_SA(b, h) (((b) * 2 + (h)) * HTB)
#define PG8_SB(b, h) ((4 + (b) * 2 + (h)) * HTB)
#define PG8_STAGE(bufoff, gbase, voff) do { _Pragma("unroll") for (int _i = 0; _i < 2; ++_i) \
        __builtin_amdgcn_global_load_lds((const unsigned*)((const char*)(gbase) + (voff)[_i]), (PG8_LAS unsigned*)(lds + (bufoff) + ldsw + _i * 8192), 16, 0, 0); } while (0)
#define PG8_LDA(dst, b, h) do { _Pragma("unroll") for (int m = 0; m < 4; ++m) _Pragma("unroll") for (int k = 0; k < 2; ++k) dst[m][k] = *(const PG8_LAS bf16x8*)(lds + PG8_SA(b, h) + aoff + m * 2048 + k * 1024); } while (0)
#define PG8_LDB(dst, b, h) do { _Pragma("unroll") for (int n = 0; n < 2; ++n) _Pragma("unroll") for (int k = 0; k < 2; ++k) dst[n][k] = *(const PG8_LAS bf16x8*)(lds + PG8_SB(b, h) + boff + n * 2048 + k * 1024); } while (0)
#define PG8_MMA(ai, bj, At, Bt) do { if (cur.thin && ((ai) != 0 || wr != 0)) break; __builtin_amdgcn_s_setprio(1); _Pragma("unroll") for (int m = 0; m < 4; ++m) _Pragma("unroll") for (int n = 0; n < 2; ++n) _Pragma("unroll") for (int k = 0; k < 2; ++k) \
        acc[ai][bj][m][n] = __builtin_amdgcn_mfma_f32_16x16x32_bf16(Bt[n][k], At[m][k], acc[ai][bj][m][n], 0, 0, 0); __builtin_amdgcn_s_setprio(0); } while (0)
#define PG8_WAIT_V(n) asm volatile("s_waitcnt vmcnt(" #n ")" ::: "memory")
#define PG8_WAIT_L(n) asm volatile("s_waitcnt lgkmcnt(" #n ")" ::: "memory")
#define PG8_BAR __builtin_amdgcn_s_barrier()
#define PG8_SCHED __builtin_amdgcn_sched_barrier(0)
    Unit cur, nxt; int ui = 0;
    if (!S.next(0, cur)) return;
    f32x4 acc[2][2][4][2];
#pragma unroll
    for (int a = 0; a < 2; ++a)
#pragma unroll
        for (int b = 0; b < 2; ++b)
#pragma unroll
            for (int m = 0; m < 4; ++m)
#pragma unroll
                for (int n = 0; n < 2; ++n) acc[a][b][m][n] = (f32x4){0.f, 0.f, 0.f, 0.f};
    bf16x8 At[4][2], B0[2][2], B1[2][2];
    const char* cA = (const char*)g.A + (size_t)cur.pm * tstep; const char* cB = (const char*)g.Bt + (g.pm_per_grp ? (size_t)(cur.pm / g.pm_per_grp) * g.grp_stride * 2 : (size_t)0) + (size_t)cur.pn * tstep;
    S.a_ready(cur);
    if constexpr (SP2) {
        PG8_STAGE(PG8_SB(0, 0), cB, voffB); PG8_STAGE(PG8_SB(0, 1), cB + hstep, voffB); PG8_STAGE(PG8_SA(0, 0), cA, voffA); PG8_STAGE(PG8_SA(0, 1), cA + hstep, voffA);
        if (wr == 1) PG8_BAR;
        PG8_WAIT_V(2); PG8_BAR;
        PG8_STAGE(PG8_SB(1, 0), cB + kstep, voffB); PG8_STAGE(PG8_SA(1, 0), cA + kstep, voffA); PG8_STAGE(PG8_SB(1, 1), cB + hstep + kstep, voffB);
        PG8_WAIT_V(6); PG8_BAR;
    } else {
        PG8_STAGE(PG8_SB(0, 0), cB, voffB); PG8_STAGE(PG8_SA(0, 0), cA, voffA); PG8_STAGE(PG8_SB(0, 1), cB + hstep, voffB); PG8_STAGE(PG8_SA(0, 1), cA + hstep, voffA);
        if (wr == 1) PG8_BAR;
        PG8_WAIT_V(4); PG8_BAR;
        PG8_STAGE(PG8_SB(1, 0), cB + kstep, voffB); PG8_STAGE(PG8_SA(1, 0), cA + kstep, voffA); PG8_STAGE(PG8_SB(1, 1), cB + hstep + kstep, voffB);
        PG8_WAIT_V(6); PG8_BAR;
    }
    for (;;) {
        const bool has_next = S.next(ui + 1, nxt);
        const char* nA = has_next ? (const char*)g.A + (size_t)nxt.pm * tstep : cA; const char* nB = has_next ? (const char*)g.Bt + (g.pm_per_grp ? (size_t)(nxt.pm / g.pm_per_grp) * g.grp_stride * 2 : (size_t)0) + (size_t)nxt.pn * tstep : cB;
        for (int t = 0; t < nt; t += 2) {
            const bool last = (t == nt - 2);
            const char* a1 = cA + (size_t)(t + 1) * kstep;
            const char* a2 = last ? nA : cA + (size_t)(t + 2) * kstep; const char* b2 = last ? nB : cB + (size_t)(t + 2) * kstep;
            const char* a3 = a2 + kstep; const char* b3 = b2 + kstep;
            if (last && has_next) S.a_ready(nxt);
            if constexpr (SP2) {
            PG8_LDB(B0, 0, 0); PG8_LDB(B1, 0, 1); PG8_SCHED; PG8_LDA(At, 0, 0); PG8_STAGE(PG8_SA(1, 1), a1 + hstep, voffA);
            PG8_WAIT_V(8); PG8_WAIT_L(0); PG8_BAR; PG8_MMA(0, 0, At, B0); PG8_MMA(0, 1, At, B1); PG8_BAR; PG8_SCHED;
            PG8_LDA(At, 0, 1); PG8_STAGE(PG8_SB(0, 0), b2, voffB); PG8_STAGE(PG8_SB(0, 1), b2 + hstep, voffB); PG8_STAGE(PG8_SA(0, 0), a2, voffA);
            PG8_WAIT_V(8); PG8_WAIT_L(0); PG8_BAR; PG8_MMA(1, 0, At, B0); PG8_MMA(1, 1, At, B1); PG8_BAR; PG8_SCHED;
            PG8_LDB(B0, 1, 0); PG8_LDB(B1, 1, 1); PG8_SCHED; PG8_LDA(At, 1, 0); PG8_STAGE(PG8_SA(0, 1), a2 + hstep, voffA);
            PG8_WAIT_V(8); PG8_WAIT_L(0); PG8_BAR; PG8_MMA(0, 0, At, B0); PG8_MMA(0, 1, At, B1); PG8_BAR; PG8_SCHED;
            PG8_LDA(At, 1, 1); PG8_STAGE(PG8_SB(1, 0), b3, voffB); PG8_STAGE(PG8_SB(1, 1), b3 + hstep, voffB); PG8_STAGE(PG8_SA(1, 0), a3, voffA);
            PG8_WAIT_V(8); PG8_WAIT_L(0); PG8_BAR; PG8_MMA(1, 0, At, B0); PG8_MMA(1, 1, At, B1); PG8_BAR; PG8_SCHED;
            } else {
            PG8_LDB(B0, 0, 0); PG8_SCHED; PG8_LDA(At, 0, 0); PG8_STAGE(PG8_SA(1, 1), a1 + hstep, voffA);
            PG8_WAIT_L(8); PG8_BAR; PG8_WAIT_L(0); PG8_MMA(0, 0, At, B0); PG8_BAR; PG8_SCHED;
            PG8_LDB(B1, 0, 1); PG8_STAGE(PG8_SB(0, 0), b2, voffB);
            PG8_BAR; PG8_WAIT_L(0); PG8_MMA(0, 1, At, B1); PG8_BAR;
            PG8_LDA(At, 0, 1); PG8_STAGE(PG8_SA(0, 0), a2, voffA);
            PG8_BAR; PG8_WAIT_L(0); PG8_MMA(1, 0, At, B0); PG8_BAR; PG8_SCHED;
            PG8_STAGE(PG8_SB(0, 1), b2 + hstep, voffB);
            PG8_WAIT_V(6); PG8_BAR; PG8_MMA(1, 1, At, B1); PG8_BAR;
            PG8_LDB(B0, 1, 0); PG8_SCHED; PG8_LDA(At, 1, 0); PG8_STAGE(PG8_SA(0, 1), a2 + hstep, voffA);
            PG8_WAIT_L(8); PG8_BAR; PG8_WAIT_L(0); PG8_MMA(0, 0, At, B0); PG8_BAR; PG8_SCHED;
            PG8_LDB(B1, 1, 1); PG8_STAGE(PG8_SB(1, 0), b3, voffB);
            PG8_BAR; PG8_WAIT_L(0); PG8_MMA(0, 1, At, B1); PG8_BAR;
            PG8_LDA(At, 1, 1); PG8_STAGE(PG8_SA(1, 0), a3, voffA);
            PG8_BAR; PG8_WAIT_L(0); PG8_MMA(1, 0, At, B0); PG8_BAR; PG8_SCHED;
            PG8_STAGE(PG8_SB(1, 1), b3 + hstep, voffB);
            PG8_WAIT_V(6); PG8_BAR; PG8_MMA(1, 1, At, B1); PG8_BAR;
            }
        }
        if constexpr (ALIGN_EPI) { if (wr == 0) PG8_BAR; }
        if constexpr (!Epi::AFTER_DRAIN) { E(acc, cur, wr, wc, fr, fq); S.done(cur); }
        if (!has_next) break;
#pragma unroll
        for (int a = 0; a < 2; ++a)
#pragma unroll
            for (int b = 0; b < 2; ++b)
#pragma unroll
                for (int m = 0; m < 4; ++m)
#pragma unroll
                    for (int n = 0; n < 2; ++n) acc[a][b][m][n] = (f32x4){0.f, 0.f, 0.f, 0.f};
        cur = nxt; cA = nA; cB = nB; ++ui;
        if constexpr (ALIGN_EPI) { if (wr == 1) PG8_BAR; }
    }
    PG8_WAIT_V(0);
    if constexpr (!ALIGN_EPI) { if (wr == 0) PG8_BAR; }
    PG8_BAR;
    if constexpr (Epi::AFTER_DRAIN) { E.fused(acc, cur, wr, wc, fr, fq, lds, wid, lane); S.done(cur); }
#undef PG8_SA
#undef PG8_SB
#undef PG8_STAGE
#undef PG8_LDA
#undef PG8_LDB
#undef PG8_MMA
#undef PG8_WAIT_V
#undef PG8_WAIT_L
#undef PG8_BAR
#undef PG8_SCHED
}
}
#ifndef USE_PG8
#define USE_PG8 1
#endif
__device__ __forceinline__ unsigned cvt_pk_bf16(float lo, float hi) { unsigned r; asm volatile("v_cvt_pk_bf16_f32 %0, %1, %2" : "=v"(r) : "v"(lo), "v"(hi)); return r; }
typedef const f32x4 (&AccRef)[2][2][4][2];
struct EpiStoreBf16 { static constexpr bool DUAL = false, PERM = true, AFTER_DRAIN = false; bf16* O; int ldc;
    __device__ __forceinline__ void elem(int row, int col, float v, float) const { O[(size_t)row * ldc + col] = (bf16)f2bf(v); }
    __device__ __forceinline__ void operator()(AccRef acc, const pg8::Unit& u, int wr, int wc, int fr, int fq) const {
        const int row0 = u.pm * 256 + wr * 64 + fr, col0 = u.pn * 256 + wc * 32 + 8 * fq;
#pragma unroll
        for (int ai = 0; ai < 2; ++ai)
#pragma unroll
            for (int m = 0; m < 4; ++m) { bf16* rowp = O + (size_t)(row0 + ai * 128 + m * 16) * ldc + col0;
#pragma unroll
                for (int bj = 0; bj < 2; ++bj) { const f32x4 v0 = acc[ai][bj][m][0], v1 = acc[ai][bj][m][1];
                    u32x4 w; w.x = cvt_pk_bf16(v0[0], v0[1]); w.y = cvt_pk_bf16(v0[2], v0[3]); w.z = cvt_pk_bf16(v1[0], v1[1]); w.w = cvt_pk_bf16(v1[2], v1[3]);
                    *(u32x4*)(rowp + bj * 128) = w; } }
    } };
struct EpiStoreF32 { static constexpr bool DUAL = false, PERM = false, AFTER_DRAIN = false; float* O; int ldc;
    __device__ __forceinline__ void elem(int row, int col, float v, float) const { O[(size_t)row * ldc + col] = v; }
    __device__ __forceinline__ void operator()(AccRef acc, const pg8::Unit& u, int wr, int wc, int fr, int fq) const {
        const int row0 = u.pm * 256 + wr * 64 + fr, col0 = u.pn * 256 + wc * 32 + 4 * fq;
#pragma unroll
        for (int ai = 0; ai < 2; ++ai)
#pragma unroll
            for (int m = 0; m < 4; ++m) { float* rowp = O + (size_t)(row0 + ai * 128 + m * 16) * ldc + col0;
#pragma unroll
                for (int bj = 0; bj < 2; ++bj)
#pragma unroll
                    for (int n = 0; n < 2; ++n) *(f32x4*)(rowp + bj * 128 + n * 16) = acc[ai][bj][m][n]; }
    } };
struct EpiResid { static constexpr bool DUAL = false, PERM = false, AFTER_DRAIN = false; float* X; const float* g_lat; const float* g_ctx;
    __device__ __forceinline__ void elem(int row, int col, float v, float) const { const float g = row >= SEQ ? g_ctx[col] : g_lat[col]; X[(size_t)row * D + col] += g * v; }
    __device__ __forceinline__ void operator()(AccRef acc, const pg8::Unit& u, int wr, int wc, int fr, int fq) const {
        const int row0 = u.pm * 256 + wr * 64 + fr, col0 = u.pn * 256 + wc * 32 + 4 * fq;
        const float* g = (u.pm * 256 >= SEQ) ? g_ctx : g_lat;
        f32x4 gv[2][2];
#pragma unroll
        for (int bj = 0; bj < 2; ++bj)
#pragma unroll
            for (int n = 0; n < 2; ++n) gv[bj][n] = *(const f32x4*)(g + col0 + bj * 128 + n * 16);
#pragma unroll
        for (int ai = 0; ai < 2; ++ai)
#pragma unroll
            for (int m = 0; m < 4; ++m) { float* rowp = X + (size_t)(row0 + ai * 128 + m * 16) * D + col0;
#pragma unroll
                for (int bj = 0; bj < 2; ++bj)
#pragma unroll
                    for (int n = 0; n < 2; ++n) { f32x4* p = (f32x4*)(rowp + bj * 128 + n * 16); *p = *p + gv[bj][n] * acc[ai][bj][m][n]; } }
    } };
__device__ __forceinline__ float silu_mul(float g, float u) { return g * __builtin_amdgcn_rcpf(1.f + __expf(-g)) * u; }
struct EpiSwiglu { static constexpr bool DUAL = true, PERM = true, AFTER_DRAIN = false; bf16* ACT;
    __device__ __forceinline__ void elem(int row, int col, float g, float u) const { ACT[(size_t)row * FF + col] = (bf16)f2bf(g / (1.f + __expf(-g)) * u); }
    __device__ __forceinline__ void operator()(AccRef acc, const pg8::Unit& u, int wr, int wc, int fr, int fq) const {
        const int row0 = u.pm * 256 + wr * 64 + fr, col0 = u.pn * 128 + wc * 32 + 8 * fq;
#pragma unroll
        for (int ai = 0; ai < 2; ++ai)
#pragma unroll
            for (int m = 0; m < 4; ++m) { bf16* rowp = ACT + (size_t)(row0 + ai * 128 + m * 16) * FF + col0;
                const f32x4 g0 = acc[ai][0][m][0], g1 = acc[ai][0][m][1], u0 = acc[ai][1][m][0], u1 = acc[ai][1][m][1];
                u32x4 w; w.x = cvt_pk_bf16(silu_mul(g0[0], u0[0]), silu_mul(g0[1], u0[1])); w.y = cvt_pk_bf16(silu_mul(g0[2], u0[2]), silu_mul(g0[3], u0[3]));
                w.z = cvt_pk_bf16(silu_mul(g1[0], u1[0]), silu_mul(g1[1], u1[1])); w.w = cvt_pk_bf16(silu_mul(g1[2], u1[2]), silu_mul(g1[3], u1[3]));
                *(u32x4*)rowp = w; }
    } };
struct EpiMoeOut { static constexpr bool DUAL = false, PERM = true, AFTER_DRAIN = false; bf16* YB; const float* gatel;
    __device__ __forceinline__ void elem(int row, int col, float v, float) const { YB[(size_t)row * D + col] = (bf16)f2bf(v * gatel[row]); }
    __device__ __forceinline__ void operator()(AccRef acc, const pg8::Unit& u, int wr, int wc, int fr, int fq) const {
        const int row0 = u.pm * 256 + wr * 64 + fr, col0 = u.pn * 256 + wc * 32 + 8 * fq;
#pragma unroll
        for (int ai = 0; ai < 2; ++ai)
#pragma unroll
            for (int m = 0; m < 4; ++m) { const int row = row0 + ai * 128 + m * 16; const float gt = gatel[row]; bf16* rowp = YB + (size_t)row * D + col0;
#pragma unroll
                for (int bj = 0; bj < 2; ++bj) { const f32x4 v0 = acc[ai][bj][m][0] * gt, v1 = acc[ai][bj][m][1] * gt;
                    u32x4 w; w.x = cvt_pk_bf16(v0[0], v0[1]); w.y = cvt_pk_bf16(v0[2], v0[3]); w.z = cvt_pk_bf16(v1[0], v1[1]); w.w = cvt_pk_bf16(v1[2], v1[3]);
                    *(u32x4*)(rowp + bj * 128) = w; } }
    } };

template <class Epi>
__device__ __forceinline__ void naive_gemm(const Ctx& C, const bf16* A, const bf16* Bt, int M, int N, int K, int pm_per_grp, size_t grp_stride, const Epi& E) {
    LAS float* As = (LAS float*)C.lds;
    LAS float* Bs = As + 16 * 132;
    LAS float* Bs2 = Bs + 16 * 68;
    const int NO = Epi::DUAL ? N / 2 : N, tn_cnt = NO / 64, nun = (M / 128) * tn_cnt;
    const int ty = C.tid >> 4, tx = C.tid & 15;
    for (int u = C.blk; u < nun; u += C.G) {
        const int tm = u / tn_cnt, tn = u % tn_cnt, row0 = tm * 128, oc0 = tn * 64;
        const bf16* Bg = Bt + (pm_per_grp ? (size_t)((row0 / 256) / pm_per_grp) * grp_stride : (size_t)0);
        const int brow0 = Epi::DUAL ? ((oc0 >> 7) * 256 + (oc0 & 127)) : oc0;
        float acc[4][4], acc2[4][4];
#pragma unroll
        for (int i = 0; i < 4; ++i)
#pragma unroll
            for (int j = 0; j < 4; ++j) { acc[i][j] = 0.f; acc2[i][j] = 0.f; }
        for (int k0 = 0; k0 < K; k0 += 16) {
            __syncthreads();
            { const int r = C.tid >> 2, kc = (C.tid & 3) * 4;
              const u32x2 w = *(const u32x2*)(A + (size_t)(row0 + r) * K + k0 + kc);
              As[(kc + 0) * 132 + r] = bf2f(w.x & 0xffffu); As[(kc + 1) * 132 + r] = bf2f(w.x >> 16); As[(kc + 2) * 132 + r] = bf2f(w.y & 0xffffu); As[(kc + 3) * 132 + r] = bf2f(w.y >> 16); }
            if (C.tid < 256) { const int r = C.tid >> 2, kc = (C.tid & 3) * 4;
              const u32x2 w = *(const u32x2*)(Bg + (size_t)(brow0 + r) * K + k0 + kc);
              Bs[(kc + 0) * 68 + r] = bf2f(w.x & 0xffffu); Bs[(kc + 1) * 68 + r] = bf2f(w.x >> 16); Bs[(kc + 2) * 68 + r] = bf2f(w.y & 0xffffu); Bs[(kc + 3) * 68 + r] = bf2f(w.y >> 16);
              if (Epi::DUAL) { const u32x2 w2 = *(const u32x2*)(Bg + (size_t)(brow0 + 128 + r) * K + k0 + kc);
                Bs2[(kc + 0) * 68 + r] = bf2f(w2.x & 0xffffu); Bs2[(kc + 1) * 68 + r] = bf2f(w2.x >> 16); Bs2[(kc + 2) * 68 + r] = bf2f(w2.y & 0xffffu); Bs2[(kc + 3) * 68 + r] = bf2f(w2.y >> 16); } }
            __syncthreads();
#pragma unroll
            for (int kk = 0; kk < 16; ++kk) {
                const f32x4 a = *(const LAS f32x4*)(As + kk * 132 + ty * 4), b = *(const LAS f32x4*)(Bs + kk * 68 + tx * 4);
#pragma unroll
                for (int i = 0; i < 4; ++i)
#pragma unroll
                    for (int j = 0; j < 4; ++j) acc[i][j] += a[i] * b[j];
                if (Epi::DUAL) { const f32x4 b2 = *(const LAS f32x4*)(Bs2 + kk * 68 + tx * 4);
#pragma unroll
                    for (int i = 0; i < 4; ++i)
#pragma unroll
                        for (int j = 0; j < 4; ++j) acc2[i][j] += a[i] * b2[j]; }
            }
        }
#pragma unroll
        for (int i = 0; i < 4; ++i)
#pragma unroll
            for (int j = 0; j < 4; ++j) E.elem(row0 + ty * 4 + i, oc0 + tx * 4 + j, acc[i][j], acc2[i][j]);
    }
    __syncthreads();
}

template <class Epi>
__device__ __forceinline__ void gemm(const Ctx& C, const bf16* A, const bf16* Bt, int M, int N, int K, int pm_per_grp, size_t grp_stride, const Epi& E) {
#if USE_PG8
    pg8::Gemm g{A, Bt, M, N, K, pm_per_grp, grp_stride}; pg8::StaticOrder S; S.init(M, N, C.G, C.blk);
    pg8::gemm_phase<Epi, pg8::StaticOrder, true, true>(C.lds, g, S, E);
#else
    naive_gemm(C, A, Bt, M, N, K, pm_per_grp, grp_stride, E);
#endif
}
template <class Epi>
__device__ __forceinline__ void gemm_moe(const Ctx& C, const bf16* A, const bf16* Bt, int N, int K, size_t grp_stride, bool with_ctx, const Epi& E) {
#if USE_PG8
    pg8::Gemm g{A, Bt, XROWS, N, K, 9, grp_stride}; pg8::MoeOrder S; S.init(N, C.G, C.blk, with_ctx);
    pg8::gemm_phase<Epi, pg8::MoeOrder, true, true>(C.lds, g, S, E);
#else
    naive_gemm(C, A, Bt, XROWS, N, K, 9, grp_stride, E);
#endif
}

template <int KIND>
__device__ __forceinline__ void ph_attn_naive(const Ctx& C, int slot) {
    constexpr int DQK = KIND == 2 ? 96 : 64, DH = DQK / 2;
    LAS float* Ks = (LAS float*)C.lds;
    LAS float* Vs = Ks + 32 * DQK;
    LAS float* Bsm = Vs + 32 * 64;
    const bf16 *Qb, *Kb, *Vb, *KRb = nullptr; int qp, kp, vp, qhs, khs, vhs, kgrp = 1; float scale;
    if (KIND == 0) { Qb = WSP(bf16, WS_QKV); Kb = Qb + 1024; Vb = Qb + 2048; qp = kp = vp = 3072; qhs = khs = vhs = 64; scale = 0.125f; }
    else if (KIND == 1) { Qb = WSP(bf16, WS_QKV); Kb = Qb + 1024; Vb = Qb + 1280; qp = kp = vp = 1536; qhs = khs = vhs = 64; kgrp = 4; scale = 0.125f; }
    else { Qb = WSP(bf16, WS_Q); Kb = WSP(bf16, WS_KV); Vb = Kb + 64; KRb = WSP(bf16, WS_KROPE); qp = 1536; kp = vp = 2048; qhs = 96; khs = vhs = 128; scale = 0.10206207261596575f; }
    bf16* Ob = WSP(bf16, WS_O);
    const int half = C.tid & 1, qi = C.tid >> 1;
    for (int u = C.blk; u < 1040; u += C.G) {
        const bool isctx = u >= 1024;
        const int h = isctx ? (u - 1024) : (u & 15), q0 = isctx ? SEQ : (u >> 4) * 256, kh = h / kgrp;
        const int t = q0 + qi;
        float q[DH], o[32];
        { const bf16* qr = Qb + (size_t)t * qp + h * qhs + half * DH;
#pragma unroll
          for (int d = 0; d < DH; d += 8) { const u32x4 w = *(const u32x4*)(qr + d);
              q[d + 0] = bf2f(w.x & 0xffffu); q[d + 1] = bf2f(w.x >> 16); q[d + 2] = bf2f(w.y & 0xffffu); q[d + 3] = bf2f(w.y >> 16);
              q[d + 4] = bf2f(w.z & 0xffffu); q[d + 5] = bf2f(w.z >> 16); q[d + 6] = bf2f(w.w & 0xffffu); q[d + 7] = bf2f(w.w >> 16); } }
#pragma unroll
        for (int d = 0; d < 32; ++d) o[d] = 0.f;
        float m = -INFINITY, l = 0.f;
        if (KIND == 1) { m = C.in[13][h]; l = 1.f; }
        int klo = 0, khi = 0;
        if (!isctx) {
            if (KIND == 0) { const int r0 = q0 >> 6; const int ra = r0 - 4 < 0 ? 0 : r0 - 4, rb = r0 + 7 > 255 ? 255 : r0 + 7; klo = ra * 64; khi = (rb + 1) * 64; }
            else if (KIND == 1) { klo = q0 - 128 < 0 ? 0 : q0 - 128; khi = q0 + 384 > SEQ ? SEQ : q0 + 384; }
            else { klo = 0; khi = SEQ; }
        }
        if (KIND == 0) { __syncthreads(); const float* rp = C.in[10] + ((size_t)slot * 16 + h) * 465; for (int i = C.tid; i < 465; i += 512) Bsm[i] = rp[i]; }
        const int qr_ = t >> 6, qc_ = t & 63;
        int rs = qr_ - 4; rs = rs < 0 ? 0 : (rs > 248 ? 248 : rs);
        int cs0 = qc_ - 8; cs0 = cs0 < 0 ? 0 : (cs0 > 48 ? 48 : cs0);
        for (int seg = 0; seg < 2; ++seg) {
            const int kb = seg == 0 ? klo : SEQ, ke = seg == 0 ? khi : R;
            for (int k0 = kb; k0 < ke; k0 += 32) {
                __syncthreads();
                for (int i = C.tid; i < 32 * DQK; i += 512) { const int j = i / DQK, d = i % DQK; const int row = k0 + j;
                    unsigned b;
                    if (KIND == 2 && d >= 64) b = KRb[(size_t)row * 32 + (d - 64)]; else b = Kb[(size_t)row * kp + kh * khs + d];
                    Ks[i] = bf2f(b); }
                for (int i = C.tid; i < 32 * 64; i += 512) { const int j = i >> 6, d = i & 63; Vs[i] = bf2f(Vb[(size_t)(k0 + j) * vp + kh * vhs + d]); }
                __syncthreads();
#pragma unroll 1
                for (int j = 0; j < 32; ++j) {
                    const int kt = k0 + j; bool valid = true; float bias = 0.f;
                    if (seg == 0) {
                        if (KIND == 0) { const int kr = kt >> 6, kc = kt & 63; valid = kr >= rs && kr < rs + 8 && kc >= cs0 && kc < cs0 + 16;
                            if (valid) bias = Bsm[(kr - qr_ + 7) * 31 + (kc - qc_ + 15)]; }
                        else if (KIND == 1) { const int dd = kt - t; valid = dd <= 128 && dd >= -128; }
                    }
                    float s0 = 0.f, s1 = 0.f;
#pragma unroll
                    for (int d = 0; d < DH; d += 4) { const f32x4 kv = *(const LAS f32x4*)(Ks + j * DQK + half * DH + d); s0 += q[d] * kv.x + q[d + 2] * kv.z; s1 += q[d + 1] * kv.y + q[d + 3] * kv.w; }
                    float sp = s0 + s1; sp += __shfl_xor(sp, 1);
                    if (valid) {
                        const float s = sp * scale + bias;
                        if (s > m) { const float a = __expf(m - s); l *= a;
#pragma unroll
                            for (int d = 0; d < 32; ++d) o[d] *= a;
                            m = s; }
                        const float p = __expf(s - m); l += p;
#pragma unroll
                        for (int d = 0; d < 32; d += 4) { const f32x4 vv = *(const LAS f32x4*)(Vs + j * 64 + half * 32 + d); o[d] += p * vv.x; o[d + 1] += p * vv.y; o[d + 2] += p * vv.z; o[d + 3] += p * vv.w; }
                    }
                }
            }
        }
        { const float il = 1.f / l; bf16* orow = Ob + (size_t)t * D + h * 64 + half * 32;
#pragma unroll
            for (int d = 0; d < 32; d += 8) { u32x4 w; w.x = pk2(o[d] * il, o[d + 1] * il); w.y = pk2(o[d + 2] * il, o[d + 3] * il); w.z = pk2(o[d + 4] * il, o[d + 5] * il); w.w = pk2(o[d + 6] * il, o[d + 7] * il);
                *(u32x4*)(orow + d) = w; } }
    }
    __syncthreads();
}

#ifndef USE_FAST_ATTN
#define USE_FAST_ATTN 1
#endif
typedef short bf16x8 __attribute__((ext_vector_type(8)));
typedef short s16x4 __attribute__((ext_vector_type(4)));
typedef float f32x16 __attribute__((ext_vector_type(16)));
__device__ __forceinline__ s16x4 lds_tr16(const LAS unsigned char* p) { return __builtin_bit_cast(s16x4, __builtin_amdgcn_ds_read_tr16_b64_v4i16((LAS s16x4*)p)); }
__device__ __forceinline__ int crow(int r, int hi) { return (r & 3) + 8 * (r >> 2) + 4 * hi; }

template <int KIND>
__device__ __forceinline__ void ph_attn_fast(const Ctx& C, int slot) {
    constexpr int DQK = KIND == 2 ? 96 : 64, NS = DQK / 16, CPR = DQK / 8;
    constexpr int KS = DQK * 2 + 16, VS = 192, KBYTES = 64 * KS, BUFB = KBYTES + 64 * VS;
    LAS unsigned char* lds = C.lds;
    LAS float* Bsm = (LAS float*)(lds + 2 * BUFB);
    const bf16 *Qb, *Kb, *Vb, *KRb = nullptr; int qp, kp, vp, qhs, khs, vhs, kgrp = 1; float scale;
    if (KIND == 0) { Qb = WSP(bf16, WS_QKV); Kb = Qb + 1024; Vb = Qb + 2048; qp = kp = vp = 3072; qhs = khs = vhs = 64; scale = 0.125f; }
    else if (KIND == 1) { Qb = WSP(bf16, WS_QKV); Kb = Qb + 1024; Vb = Qb + 1280; qp = kp = vp = 1536; qhs = khs = vhs = 64; kgrp = 4; scale = 0.125f; }
    else { Qb = WSP(bf16, WS_Q); Kb = WSP(bf16, WS_KV); Vb = Kb + 64; KRb = WSP(bf16, WS_KROPE); qp = 1536; kp = vp = 2048; qhs = 96; khs = vhs = 128; scale = 0.10206207261596575f; }
    bf16* Ob = WSP(bf16, WS_O);
    const float c2 = scale * 1.4426950408889634f;
    const int w = C.wave, lane = C.lane, ql = lane & 31, hi = lane >> 5;
    const int kr0 = C.tid / CPR, kc0 = C.tid % CPR, kr1 = (C.tid + 512) / CPR, kc1 = (C.tid + 512) % CPR, vr = C.tid >> 3, vc = C.tid & 7;
    const bool k2 = (DQK == 96) && C.tid < 256;
    const int vlane = (((lane & 15) >> 2) + 4 * hi) * VS + (16 * ((lane >> 4) & 1) + 4 * (lane & 3)) * 2;
    for (int u = C.blk; u < 1040; u += C.G) {
        const bool isctx = u >= 1024;
        const int h = isctx ? (u - 1024) : (u & 15), q0 = isctx ? SEQ : (u >> 4) * 256, kh = h / kgrp;
        int lat0 = 0, nlat = 0;
        if (!isctx) {
            if (KIND == 0) { const int r0 = q0 >> 6; int ta = r0 - 4; ta = ta < 0 ? 0 : (ta > 248 ? 248 : ta); int tb = r0 - 1; tb = (tb < 0 ? 0 : (tb > 248 ? 248 : tb)) + 7; lat0 = ta; nlat = tb - ta + 1; }
            else if (KIND == 1) { const int a = q0 - 128 < 0 ? 0 : q0 - 128, b = q0 + 384 > SEQ ? SEQ : q0 + 384; lat0 = a >> 6; nlat = (b - a) >> 6; }
            else { lat0 = 0; nlat = SEQ / 64; }
        }
        const int ntiles = nlat + 4;
        const int t = q0 + 32 * w + ql;
        bf16x8 qf[NS];
        { const bf16* qr = Qb + (size_t)t * qp + h * qhs + 8 * hi;
#pragma unroll
          for (int sidx = 0; sidx < NS; ++sidx) qf[sidx] = *(const bf16x8*)(qr + 16 * sidx); }
        __syncthreads();
        if (KIND == 0) { const float* rp = C.in[10] + ((size_t)slot * 16 + h) * 465; for (int i = C.tid; i < 465; i += 512) Bsm[i] = rp[i] * 1.4426950408889634f; }
        float m = -INFINITY, l = 0.f;
        if (KIND == 1) { m = C.in[13][h] * 1.4426950408889634f; l = hi ? 0.f : 1.f; }
        f32x16 ot[2];
#pragma unroll
        for (int r = 0; r < 16; ++r) { ot[0][r] = 0.f; ot[1][r] = 0.f; }
        const int qr_ = t >> 6, qc_ = t & 63;
        int rs = qr_ - 4; rs = rs < 0 ? 0 : (rs > 248 ? 248 : rs);
        int cs0 = qc_ - 8; cs0 = cs0 < 0 ? 0 : (cs0 > 48 ? 48 : cs0);
        const int wrow = (q0 >> 6) + (w >> 1);
        int wrs = wrow - 4; wrs = wrs < 0 ? 0 : (wrs > 248 ? 248 : wrs);
        const int wq0 = q0 + 32 * w;
        u32x4 kreg0, kreg1 = (u32x4){0u, 0u, 0u, 0u}, vreg;
#define ATT_KEY0(i) ((i) < nlat ? (lat0 + (i)) * 64 : SEQ + ((i) - nlat) * 64)
#define ATT_LOAD(i) do { const int key0_ = ATT_KEY0(i); \
        kreg0 = (KIND == 2 && kc0 >= 8) ? *(const u32x4*)(KRb + (size_t)(key0_ + kr0) * 32 + 8 * (kc0 - 8)) : *(const u32x4*)(Kb + (size_t)(key0_ + kr0) * kp + kh * khs + 8 * kc0); \
        if (k2) kreg1 = (kc1 >= 8) ? *(const u32x4*)(KRb + (size_t)(key0_ + kr1) * 32 + 8 * (kc1 - 8)) : *(const u32x4*)(Kb + (size_t)(key0_ + kr1) * kp + kh * khs + 8 * kc1); \
        vreg = *(const u32x4*)(Vb + (size_t)(key0_ + vr) * vp + kh * vhs + 8 * vc); } while (0)
#define ATT_STORE(b) do { LAS unsigned char* base_ = lds + (b) * BUFB; \
        *(LAS u32x4*)(base_ + kr0 * KS + 16 * kc0) = kreg0; if (k2) *(LAS u32x4*)(base_ + kr1 * KS + 16 * kc1) = kreg1; \
        *(LAS u32x4*)(base_ + KBYTES + vr * VS + 16 * vc) = vreg; } while (0)
        ATT_LOAD(0); ATT_STORE(0);
        __syncthreads();
        for (int i = 0; i < ntiles; ++i) {
            if (i + 1 < ntiles) ATT_LOAD(i + 1);
            const bool lat = i < nlat; const int key0 = ATT_KEY0(i);
            bool need = true;
            if (lat) { if (KIND == 0) { const int kr = lat0 + i; need = kr >= wrs && kr < wrs + 8; }
                       else if (KIND == 1) need = (key0 + 63 >= wq0 - 128) && (key0 <= wq0 + 31 + 128); }
            if (need) {
                const LAS unsigned char* kb = lds + (i & 1) * BUFB; const LAS unsigned char* vb = kb + KBYTES;
                f32x16 p0, p1;
#pragma unroll
                for (int r = 0; r < 16; ++r) { p0[r] = 0.f; p1[r] = 0.f; }
#pragma unroll
                for (int sidx = 0; sidx < NS; ++sidx) {
                    const bf16x8 a0 = *(const LAS bf16x8*)(kb + ql * KS + 32 * sidx + 16 * hi);
                    const bf16x8 a1 = *(const LAS bf16x8*)(kb + (32 + ql) * KS + 32 * sidx + 16 * hi);
                    p0 = __builtin_amdgcn_mfma_f32_32x32x16_bf16(a0, qf[sidx], p0, 0, 0, 0);
                    p1 = __builtin_amdgcn_mfma_f32_32x32x16_bf16(a1, qf[sidx], p1, 0, 0, 0);
                }
                float mx = -INFINITY;
                if (KIND == 0) {
#pragma unroll
                    for (int r = 0; r < 16; ++r) {
                        float s0 = p0[r] * c2, s1 = p1[r] * c2;
                        if (lat) { const int kr = lat0 + i; const int kc = crow(r, hi);
                            const bool v0 = (unsigned)(kc - cs0) < 16u, v1 = (unsigned)(kc + 32 - cs0) < 16u;
                            const int bi = (kr - qr_ + 7) * 31 + (kc - qc_ + 15);
                            s0 = v0 ? s0 + Bsm[v0 ? bi : 0] : -INFINITY; s1 = v1 ? s1 + Bsm[v1 ? bi + 32 : 0] : -INFINITY; }
                        p0[r] = s0; p1[r] = s1; mx = fmaxf(fmaxf(mx, s0), s1);
                    }
                } else {
                    if (KIND == 1 && lat) {
#pragma unroll
                        for (int r = 0; r < 16; ++r) { const int dd = key0 + crow(r, hi) - t;
                            p0[r] = (unsigned)(dd + 128) <= 256u ? p0[r] : -INFINITY; p1[r] = (unsigned)(dd + 32 + 128) <= 256u ? p1[r] : -INFINITY; }
                    }
#pragma unroll
                    for (int r = 0; r < 16; ++r) mx = fmaxf(fmaxf(mx, p0[r]), p1[r]);
                    mx *= c2;
                }
                { const auto sw = __builtin_amdgcn_permlane32_swap(__float_as_uint(mx), __float_as_uint(mx), false, false);
                  mx = fmaxf(__uint_as_float(sw[0]), __uint_as_float(sw[1])); }
                const float mn = fmaxf(m, mx), ms = mn == -INFINITY ? 0.f : mn;
                const float alpha = __builtin_amdgcn_exp2f(m - ms);
                float rsum = 0.f;
                if (KIND == 0) {
#pragma unroll
                    for (int r = 0; r < 16; ++r) { p0[r] = __builtin_amdgcn_exp2f(p0[r] - ms); p1[r] = __builtin_amdgcn_exp2f(p1[r] - ms); rsum += p0[r] + p1[r]; }
                } else {
#pragma unroll
                    for (int r = 0; r < 16; ++r) { p0[r] = __builtin_amdgcn_exp2f(__builtin_fmaf(p0[r], c2, -ms)); p1[r] = __builtin_amdgcn_exp2f(__builtin_fmaf(p1[r], c2, -ms)); rsum += p0[r] + p1[r]; }
                }
                l = l * alpha + rsum; m = mn;
                if (__builtin_amdgcn_ballot_w64(alpha != 1.f) != 0ull) {
#pragma unroll
                    for (int r = 0; r < 16; ++r) { ot[0][r] *= alpha; ot[1][r] *= alpha; }
                }
                bf16x8 pf[4];
#pragma unroll
                for (int ks = 0; ks < 4; ++ks) { u32x4 pw;
                    if (ks < 2) { pw.x = cvt_pk_bf16(p0[8 * ks + 0], p0[8 * ks + 1]); pw.y = cvt_pk_bf16(p0[8 * ks + 2], p0[8 * ks + 3]); pw.z = cvt_pk_bf16(p0[8 * ks + 4], p0[8 * ks + 5]); pw.w = cvt_pk_bf16(p0[8 * ks + 6], p0[8 * ks + 7]); }
                    else { const int k8 = 8 * (ks - 2); pw.x = cvt_pk_bf16(p1[k8 + 0], p1[k8 + 1]); pw.y = cvt_pk_bf16(p1[k8 + 2], p1[k8 + 3]); pw.z = cvt_pk_bf16(p1[k8 + 4], p1[k8 + 5]); pw.w = cvt_pk_bf16(p1[k8 + 6], p1[k8 + 7]); }
                    pf[ks] = __builtin_bit_cast(bf16x8, pw); }
#pragma unroll
                for (int c = 0; c < 2; ++c)
#pragma unroll
                    for (int ks = 0; ks < 4; ++ks) {
                        const LAS unsigned char* vp_ = vb + vlane + (32 * (ks >> 1) + 16 * (ks & 1)) * VS + 64 * c;
                        const s16x4 lo = lds_tr16(vp_), hi4 = lds_tr16(vp_ + 8 * VS);
                        const bf16x8 av = (bf16x8){lo[0], lo[1], lo[2], lo[3], hi4[0], hi4[1], hi4[2], hi4[3]};
                        ot[c] = __builtin_amdgcn_mfma_f32_32x32x16_bf16(av, pf[ks], ot[c], 0, 0, 0);
                    }
            }
            if (i + 1 < ntiles) ATT_STORE((i + 1) & 1);
            __syncthreads();
        }
#undef ATT_KEY0
#undef ATT_LOAD
#undef ATT_STORE
        { const auto sw = __builtin_amdgcn_permlane32_swap(__float_as_uint(l), __float_as_uint(l), false, false);
          const float il = 1.f / (__uint_as_float(sw[0]) + __uint_as_float(sw[1])); bf16* orow = Ob + (size_t)t * D + h * 64 + 4 * hi;
#pragma unroll
          for (int c = 0; c < 2; ++c)
#pragma unroll
            for (int g = 0; g < 4; ++g) { u32x2 o2; o2.x = cvt_pk_bf16(ot[c][4 * g] * il, ot[c][4 * g + 1] * il); o2.y = cvt_pk_bf16(ot[c][4 * g + 2] * il, ot[c][4 * g + 3] * il);
                *(u32x2*)(orow + 32 * c + 8 * g) = o2; } }
    }
    __syncthreads();
}
template <int KIND>
__device__ __forceinline__ void ph_attn(const Ctx& C, int slot) {
#if USE_FAST_ATTN
    ph_attn_fast<KIND>(C, slot);
#else
    ph_attn_naive<KIND>(C, slot);
#endif
}

#define PH_BEGIN if (lo <= ph && ph < hi) {
#define PH_END   if (ph + 1 < hi) xcd_barrier(bar); } ++ph;
#ifndef PROBE_MASK
#define PROBE_MASK 0
#endif
#define PHG(g, ...) PH_BEGIN __VA_ARGS__ PH_END if constexpr (((PROBE_MASK >> (g)) & 1) != 0) { PH_BEGIN __VA_ARGS__ PH_END }
template <int L>
__device__ __forceinline__ void layer_phases(const Ctx& C, const XcdBarrier& bar, int lo, int hi, int& ph) {
    constexpr int l = L, kind = L % 3, slot = L / 3; constexpr bool need_ctx = L < 3; constexpr int RL = need_ctx ? R : SEQ;
    PH_BEGIN ph_rowA<0>(C, l); PH_END
    if constexpr (kind == 0) {
        PHG(1, gemm(C, WSP(bf16, WS_H), WSP(bf16, WS_W_NAQKV) + (size_t)slot * 3072 * 1024, R, 3072, 1024, 0, 0, EpiStoreBf16{WSP(bf16, WS_QKV), 3072});)
        PHG(2, ph_attn<0>(C, slot);)
    } else if constexpr (kind == 1) {
        PHG(1, gemm(C, WSP(bf16, WS_H), WSP(bf16, WS_W_SWAQKV), R, 1536, 1024, 0, 0, EpiStoreBf16{WSP(bf16, WS_QKV), 1536});)
        PH_BEGIN ph_rope(C, WSP(bf16, WS_QKV), 1536, 20, 64, 0, 16); PH_END
        PHG(3, ph_attn<1>(C, slot);)
    } else {
        PHG(1, gemm(C, WSP(bf16, WS_H), WSP(bf16, WS_W_MLAD), R, 1024, 1024, 0, 0, EpiStoreF32{WSP(float, WS_CQ), 1024});)
        PHG(11, ph_mlanorm(C);)
        PHG(1, gemm(C, WSP(bf16, WS_CQN), WSP(bf16, WS_W_MLAUQ), R, 1536, 512, 0, 0, EpiStoreBf16{WSP(bf16, WS_Q), 1536});
                 gemm(C, WSP(bf16, WS_CKVN), WSP(bf16, WS_W_MLAUKV), R, 2048, 256, 0, 0, EpiStoreBf16{WSP(bf16, WS_KV), 2048});)
        PH_BEGIN ph_rope(C, WSP(bf16, WS_Q), 1536, 16, 96, 64, 8); PH_END
        PHG(4, ph_attn<2>(C, slot);)
    }
    const bf16* wo = kind == 0 ? WSP(bf16, WS_W_NAO) + (size_t)slot * 1024 * 1024 : (kind == 1 ? WSP(bf16, WS_W_SWAO) : WSP(bf16, WS_W_MLAO));
    PH_BEGIN gemm(C, WSP(bf16, WS_O), wo, RL, 1024, 1024, 0, 0, EpiResid{WSP(float, WS_X), modp(C, l, 0, 2), modp(C, l, 1, 2)}); PH_END
    PHG(5, ph_norm2(C, l, RL);)
    PHG(6, ph_topk(C, need_ctx);)
    PHG(7, ph_gather(C, need_ctx);)
    PHG(8, gemm_moe(C, WSP(bf16, WS_XG), WSP(bf16, WS_W_GU) + (size_t)l * 16 * 4096 * 1024, 4096, 1024, (size_t)4096 * 1024, need_ctx, EpiSwiglu{WSP(bf16, WS_ACT)});)
    PHG(9, gemm_moe(C, WSP(bf16, WS_ACT), WSP(bf16, WS_W_DN) + (size_t)l * 16 * 1024 * 2048, 1024, 2048, (size_t)1024 * 2048, need_ctx, EpiMoeOut{WSP(bf16, WS_YB), WSP(float, WS_GATEL)});)
}
__global__ void __launch_bounds__(512, 2) fwd_kernel(Args args) {
    extern __shared__ __attribute__((aligned(16))) unsigned char lds_raw[];
    Ctx C;
#pragma unroll
    for (int i = 0; i < 26; ++i) C.in[i] = args.in[i];
    C.out = args.out; C.ws = args.ws; C.lds = (LAS unsigned char*)lds_raw;
    C.tid = threadIdx.x; C.lane = C.tid & 63; C.wave = __builtin_amdgcn_readfirstlane(C.tid >> 6); C.blk = blockIdx.x; C.G = gridDim.x;
    volatile LAS unsigned* MISC = (volatile LAS unsigned*)(C.lds + MISC_OFF);
    if (C.tid < 32) MISC[C.tid] = 0u;
    __syncthreads();
    const int lo = args.ph_lo, hi = args.ph_hi;
    XcdBarrier bar; bar.bar = (unsigned*)(C.ws + WS_CTL) + CW_BAR; bar.x = 0; bar.st = nullptr;
    if (hi - lo > 1) bar = xcd_barrier_post((unsigned*)(C.ws + WS_CTL) + CW_BAR, MISC + 8);
    int ph = 0;
    PHG(0, ph_prologue(C);)
    layer_phases<0>(C, bar, lo, hi, ph);
    layer_phases<1>(C, bar, lo, hi, ph);
    layer_phases<2>(C, bar, lo, hi, ph);
    layer_phases<3>(C, bar, lo, hi, ph);
    PH_BEGIN ph_rowA<1>(C, 4); PH_END
}
#undef PH_BEGIN
#undef PH_END

extern "C" void kernel_launch(void* const* d_in, const int* in_sizes, int n_in, void* d_out, int out_size, void* d_ws, size_t ws_size, hipStream_t stream) {
    static int grid = 0;
    if (grid == 0) {
        if (n_in != 26 || out_size != SEQ * D || ws_size < WS_END) { fprintf(stderr, "kernel_launch: unexpected shapes (n_in %d out %d ws %zu)\n", n_in, out_size, ws_size); grid = -1; return; }
        int dev = 0, cus = 0, per_cu = 0;
        if (hipGetDevice(&dev) != hipSuccess || hipDeviceGetAttribute(&cus, hipDeviceAttributeMultiprocessorCount, dev) != hipSuccess) { grid = -1; return; }
        if (hipFuncSetAttribute((const void*)fwd_kernel, hipFuncAttributeMaxDynamicSharedMemorySize, LDS_BYTES) != hipSuccess) { fprintf(stderr, "kernel_launch: hipFuncSetAttribute failed\n"); grid = -1; return; }
        if (hipOccupancyMaxActiveBlocksPerMultiprocessor(&per_cu, (const void*)fwd_kernel, 512, LDS_BYTES) != hipSuccess || per_cu < 1) fprintf(stderr, "kernel_launch: occupancy query says %d\n", per_cu);
        (void)hipGetLastError();
        grid = cus;
    }
    if (grid < 0) return;
    if (hipMemsetAsync((char*)d_ws + WS_CTL, 0, CTL_ZERO_BYTES, stream) != hipSuccess) return;
    Args a{};
    for (int i = 0; i < 26; ++i) a.in[i] = (const float*)d_in[i];
    a.out = (float*)d_out; a.ws = (unsigned char*)d_ws; a.pad = 0;
#if MK_N_LAUNCHES == 1
    a.ph_lo = 0; a.ph_hi = 1 << 20; a.li = 0;
    hipLaunchKernelGGL(fwd_kernel, dim3(grid), dim3(512), LDS_BYTES, stream, a);
#else
    for (int li = 0; li < NPH; ++li) { a.ph_lo = li; a.ph_hi = li + 1; a.li = li;
        hipLaunchKernelGGL(fwd_kernel, dim3(grid), dim3(512), LDS_BYTES, stream, a); }
#endif
}
```

```cpp
#include <hip/hip_runtime.h>
#include <cstdio>
#include <cstdint>

#ifndef MK_N_LAUNCHES
#define MK_N_LAUNCHES 1
#endif

#define GAS __attribute__((address_space(1)))
#define LAS __attribute__((address_space(3)))
typedef unsigned short bf16;
typedef float f32x4 __attribute__((ext_vector_type(4)));
typedef unsigned u32x4 __attribute__((ext_vector_type(4)));
typedef unsigned u32x2 __attribute__((ext_vector_type(2)));
typedef short bf16x8 __attribute__((ext_vector_type(8)));
typedef short s16x4 __attribute__((ext_vector_type(4)));
typedef float f32x16 __attribute__((ext_vector_type(16)));

constexpr int D = 1024, SEQ = 16384, NCTX = 256, R = SEQ + NCTX, NE = 16, FF = 2048;
constexpr int CAP_L = 2048, CAP_C = 32, EROWS = 2304, XROWS = NE * EROWS;
constexpr float RMS_EPS = 1e-6f;
constexpr int NPH = 1 + 9 + 10 + 12 + 9 + 1;

constexpr size_t MiB = 1u << 20;
constexpr size_t WS_CTL = 0, CTL_ZERO_BYTES = 1 * MiB;
constexpr size_t WS_MOD = 1 * MiB;
constexpr size_t WS_W_NAQKV = 2 * MiB;
constexpr size_t WS_W_NAO = 14 * MiB;
constexpr size_t WS_W_SWAQKV = 18 * MiB;
constexpr size_t WS_W_SWAO = 21 * MiB;
constexpr size_t WS_W_MLAD = 23 * MiB;
constexpr size_t WS_W_MLAUQ = 25 * MiB;
constexpr size_t WS_W_MLAUKV = 27 * MiB;
constexpr size_t WS_W_MLAO = 28 * MiB;
constexpr size_t WS_W_GU = 32 * MiB;
constexpr size_t WS_W_DN = WS_W_GU + 512 * MiB;
constexpr size_t WS_X = WS_W_DN + 256 * MiB;
constexpr size_t WS_H = WS_X + 65 * MiB;
constexpr size_t WS_QKV = WS_H + 33 * MiB;
constexpr size_t WS_CQ = WS_QKV + 98 * MiB;
constexpr size_t WS_Q = WS_CQ + 65 * MiB;
constexpr size_t WS_KV = WS_Q + 49 * MiB;
constexpr size_t WS_CQN = WS_KV + 65 * MiB;
constexpr size_t WS_CKVN = WS_CQN + 17 * MiB;
constexpr size_t WS_KROPE = WS_CKVN + 9 * MiB;
constexpr size_t WS_O = WS_KROPE + 2 * MiB;
constexpr size_t WS_AFF = WS_O + 33 * MiB;
constexpr size_t WS_ROWL = WS_AFF + 2 * MiB;
constexpr size_t WS_GATEL = WS_ROWL + 1 * MiB;
constexpr size_t WS_INV = WS_GATEL + 1 * MiB;
constexpr size_t WS_XG = WS_INV + 2 * MiB;
constexpr size_t WS_ACT = WS_XG + 72 * MiB;
constexpr size_t WS_YB = WS_ACT + 144 * MiB;
constexpr size_t WS_END = WS_YB + 72 * MiB;
static_assert(WS_END <= 2048 * MiB, "d_ws map");
constexpr int CW_BAR = 4096;

constexpr int LDS_BYTES = 147456;
constexpr int MISC_OFF = 131072 + 320;

__device__ __forceinline__ float bf2f(unsigned b) { return __uint_as_float(b << 16); }
__device__ __forceinline__ unsigned f2bf(float f) { unsigned u = __float_as_uint(f); return (u + 0x7fffu + ((u >> 16) & 1u)) >> 16; }
__device__ __forceinline__ unsigned pk2(float lo, float hi) { return f2bf(lo) | (f2bf(hi) << 16); }
__device__ __forceinline__ float wave_sum(float v) {
#pragma unroll
    for (int o = 1; o < 64; o <<= 1) v += __shfl_xor(v, o);
    return v;
}
__device__ __forceinline__ int wave_sum_i(int v) {
#pragma unroll
    for (int o = 1; o < 64; o <<= 1) v += __shfl_xor(v, o);
    return v;
}

#define XB_TMO      128
#define XB_XCNT(j)  (256  + 64 * (j))
#define XB_XSUB(j)  (1280 + 64 * (j))
#define XB_XGEN(j)  (2304 + 64 * (j))
#define XB_TOP      3328
#define XB_TOPGEN   3392
#define XCD_BAR_WORDS 3456
#define XB_SPIN_CAP (1u << 18)
__device__ __forceinline__ unsigned xb_ld(unsigned* p)              { return __hip_atomic_load(p, __ATOMIC_RELAXED, __HIP_MEMORY_SCOPE_AGENT); }
__device__ __forceinline__ unsigned xb_add(unsigned* p, unsigned v) { return __hip_atomic_fetch_add(p, v, __ATOMIC_RELAXED, __HIP_MEMORY_SCOPE_AGENT); }
__device__ __forceinline__ unsigned xb_xcc_id() { return (unsigned)__builtin_amdgcn_s_getreg((3 << 11) | 20) & 0xFu; }
#define XB_SPIN(cond, bar) do { unsigned _sp = 0; while (cond) { __builtin_amdgcn_s_sleep(1); \
    if ((++_sp & 255u) == 0u) { if (xb_ld(&(bar)[XB_TMO])) break; if (_sp > XB_SPIN_CAP) { atomicAdd(&(bar)[XB_TMO], 1u); break; } } } } while (0)
struct XcdBarrier { unsigned* bar; unsigned x; volatile LAS unsigned* st; };
__device__ __forceinline__ XcdBarrier xcd_barrier_post(unsigned* bar, volatile LAS unsigned* st) {
    XcdBarrier b; b.bar = bar; b.x = xb_xcc_id(); b.st = st;
    if (threadIdx.x == 0) (void)xb_add(&bar[XB_XCNT(b.x)], 1u);
    return b;
}
__device__ __forceinline__ void xcd_barrier_complete(unsigned* bar, unsigned x, unsigned& nloc, unsigned& nx) {
    const unsigned G = gridDim.x * gridDim.y * gridDim.z;
    unsigned sum, cnt, mine, sp = 0u;
    for (;;) {
        sum = 0u; cnt = 0u; mine = 0u;
#pragma unroll
        for (unsigned j = 0; j < 16; ++j) { const unsigned c = xb_ld(&bar[XB_XCNT(j)]); sum += c; cnt += (c > 0u) ? 1u : 0u; mine = (j == x) ? c : mine; }
        if (sum == G) break;
        __builtin_amdgcn_s_sleep(1);
        if ((++sp & 255u) == 0u) { if (xb_ld(&bar[XB_TMO])) break; if (sp > XB_SPIN_CAP) { atomicAdd(&bar[XB_TMO], 1u); break; } }
    }
    nloc = mine > 0u ? mine : 1u; nx = cnt > 0u ? cnt : 1u;
}
__device__ __forceinline__ void xcd_barrier(const XcdBarrier& b) {
    asm volatile("s_waitcnt vmcnt(0)" ::: "memory");
    __syncthreads();
    if (threadIdx.x == 0) {
        unsigned* bar = b.bar;
        __builtin_amdgcn_s_waitcnt(0);
        unsigned nloc = b.st[0], nx = b.st[1];
        if (nloc == 0u) { xcd_barrier_complete(bar, b.x, nloc, nx); b.st[0] = nloc; b.st[1] = nx; }
        const unsigned old = xb_add(&bar[XB_XSUB(b.x)], 1u);
        const unsigned gen = old / nloc;
        if (old + 1u == (gen + 1u) * nloc) {
            __builtin_amdgcn_fence(__ATOMIC_RELEASE, "agent");
            asm volatile("s_waitcnt vmcnt(0)" ::: "memory");
            const unsigned og = xb_add(&bar[XB_TOP], 1u);
            const unsigned tg = og / nx;
            if (og + 1u == (tg + 1u) * nx) xb_add(&bar[XB_TOPGEN], 1u);
            else XB_SPIN(xb_ld(&bar[XB_TOPGEN]) == tg, bar);
            __builtin_amdgcn_fence(__ATOMIC_ACQUIRE, "agent");
            xb_add(&bar[XB_XGEN(b.x)], 1u);
            asm volatile("s_waitcnt vmcnt(0)" ::: "memory");
        } else {
            XB_SPIN(xb_ld(&bar[XB_XGEN(b.x)]) == gen, bar);
            __builtin_amdgcn_fence(__ATOMIC_ACQUIRE, "agent");
            asm volatile("s_waitcnt vmcnt(0)" ::: "memory");
        }
    }
    __syncthreads();
}

struct Args { const float* in[26]; float* out; unsigned char* ws; int ph_lo, ph_hi, li, pad; };
struct Ctx {
    const float* in[26]; float* out; unsigned char* ws;
    LAS unsigned char* lds;
    int tid, lane, wave, blk, G;
};
#define WSP(T, off) ((T*)(C.ws + (off)))
__device__ __forceinline__ const float* modp(const Ctx& C, int l, int set, int j) { return (const float*)(C.ws + WS_MOD) + ((l * 2 + set) * 6 + j) * D; }

__device__ __forceinline__ void p0_transpose_item(const float* W, int K, int N, bf16* WT, int k0, int n0, int drow0, LAS float* scr, int lane) {
    const int lr = lane >> 3, lc = (lane & 7) * 4;
    f32x4 v[8];
#pragma unroll
    for (int i = 0; i < 8; ++i) v[i] = *(const f32x4*)(W + (size_t)(k0 + 8 * i + lr) * N + n0 + lc);
#pragma unroll
    for (int i = 0; i < 8; ++i) *(LAS f32x4*)(scr + (8 * i + lr) * 36 + lc) = v[i];
    asm volatile("s_waitcnt lgkmcnt(0)" ::: "memory");
    const int c = lane & 7;
#pragma unroll
    for (int j = 0; j < 4; ++j) { const int n = (lane >> 3) + 8 * j; const LAS float* s = scr + (8 * c) * 36 + n;
        u32x4 o; o.x = pk2(s[0 * 36], s[1 * 36]); o.y = pk2(s[2 * 36], s[3 * 36]); o.z = pk2(s[4 * 36], s[5 * 36]); o.w = pk2(s[6 * 36], s[7 * 36]);
        *(u32x4*)(WT + (size_t)(drow0 + n) * K + k0 + 8 * c) = o; }
    asm volatile("s_waitcnt lgkmcnt(0)" ::: "memory");
}
__device__ __forceinline__ bool p0_plain(int& r, const float* W, int K, int N, bf16* WT, int row_off, LAS float* scr, int lane) {
    const int nblk = N / 32, cnt = (K / 64) * nblk;
    if (r >= cnt) { r -= cnt; return false; }
    const int kb = r / nblk, nb = r % nblk;
    p0_transpose_item(W, K, N, WT, kb * 64, nb * 32, row_off + nb * 32, scr, lane);
    return true;
}
__device__ __forceinline__ void ph_prologue(const Ctx& C) {
    LAS float* scr = (LAS float*)(C.lds + C.wave * 16384);
    const int gw = C.blk * 8 + C.wave, NGW = C.G * 8;
    constexpr int MOE_ITEMS = 4 * 16 * 3072;
    constexpr int SMALL_ITEMS = 2 * 1536 + 2 * 512 + 768 + 512 + 256 + 144 + 384 + 256 + 512;
    for (int it = gw; it < MOE_ITEMS + SMALL_ITEMS; it += NGW) {
        if (it < MOE_ITEMS) {
            const int le = it / 3072, r2 = it % 3072, which = r2 / 1024, item = r2 % 1024, l = le / 16, e = le % 16;
            if (which < 2) {
                const float* W = (which ? C.in[23] : C.in[22]) + (size_t)le * 1024 * 2048;
                bf16* WT = WSP(bf16, WS_W_GU) + ((size_t)l * 16 + e) * 4096 * 1024;
                const int kb = item / 64, nb = item % 64, n0 = nb * 32;
                p0_transpose_item(W, 1024, 2048, WT, kb * 64, n0, (n0 >> 7) * 256 + (n0 & 127) + which * 128, scr, C.lane);
            } else {
                const float* W = C.in[24] + (size_t)le * 2048 * 1024;
                bf16* WT = WSP(bf16, WS_W_DN) + ((size_t)l * 16 + e) * 1024 * 2048;
                const int kb = item / 32, nb = item % 32;
                p0_transpose_item(W, 2048, 1024, WT, kb * 64, nb * 32, nb * 32, scr, C.lane);
            }
            continue;
        }
        int r = it - MOE_ITEMS;
        if (p0_plain(r, C.in[8], 1024, 3072, WSP(bf16, WS_W_NAQKV), 0, scr, C.lane)) continue;
        if (p0_plain(r, C.in[8] + (size_t)1024 * 3072, 1024, 3072, WSP(bf16, WS_W_NAQKV) + (size_t)3072 * 1024, 0, scr, C.lane)) continue;
        if (p0_plain(r, C.in[9], 1024, 1024, WSP(bf16, WS_W_NAO), 0, scr, C.lane)) continue;
        if (p0_plain(r, C.in[9] + (size_t)1024 * 1024, 1024, 1024, WSP(bf16, WS_W_NAO) + (size_t)1024 * 1024, 0, scr, C.lane)) continue;
        if (p0_plain(r, C.in[11], 1024, 1536, WSP(bf16, WS_W_SWAQKV), 0, scr, C.lane)) continue;
        if (p0_plain(r, C.in[12], 1024, 1024, WSP(bf16, WS_W_SWAO), 0, scr, C.lane)) continue;
        if (p0_plain(r, C.in[14], 1024, 512, WSP(bf16, WS_W_MLAD), 0, scr, C.lane)) continue;
        if (p0_plain(r, C.in[17], 1024, 288, WSP(bf16, WS_W_MLAD), 512, scr, C.lane)) continue;
        if (p0_plain(r, C.in[16], 512, 1536, WSP(bf16, WS_W_MLAUQ), 0, scr, C.lane)) continue;
        if (p0_plain(r, C.in[19], 256, 2048, WSP(bf16, WS_W_MLAUKV), 0, scr, C.lane)) continue;
        p0_plain(r, C.in[20], 1024, 1024, WSP(bf16, WS_W_MLAO), 0, scr, C.lane);
    }
    { u32x4* z = (u32x4*)(WSP(bf16, WS_W_MLAD) + (size_t)800 * 1024); const int n16 = 224 * 1024 * 2 / 16;
      for (int i = C.blk * 512 + C.tid; i < n16; i += C.G * 512) z[i] = (u32x4){0u, 0u, 0u, 0u}; }
    __syncthreads();
    LAS float* sc = (LAS float*)C.lds;
    LAS float* red = sc + 2048;
    for (int i = C.tid; i < 2048; i += 512) { const float v = (i < 1024) ? C.in[1][i] : C.in[3][i - 1024]; sc[i] = v / (1.f + __expf(-v)); }
    __syncthreads();
    for (int u = C.blk; u < 4 * 96; u += C.G) {
        const int l = u / 96, j0 = (u % 96) * 64, kq = C.tid >> 6, jj = C.tid & 63;
        const float* W = C.in[4] + (size_t)l * 1024 * 6144 + j0 + jj;
        float a0 = 0.f, a1 = 0.f;
#pragma unroll 8
        for (int k = kq * 128; k < kq * 128 + 128; ++k) { const float w = W[(size_t)k * 6144]; a0 += sc[k] * w; a1 += sc[1024 + k] * w; }
        red[kq * 64 + jj] = a0; red[512 + kq * 64 + jj] = a1;
        __syncthreads();
        if (C.tid < 128) { const int set = C.tid >> 6, j = C.tid & 63; float s = 0.f;
#pragma unroll
            for (int q = 0; q < 8; ++q) s += red[set * 512 + q * 64 + j];
            const int col = j0 + j;
            ((float*)(C.ws + WS_MOD))[((l * 2 + set) * 6) * D + col] = s + C.in[5][l * 6144 + col]; }
        __syncthreads();
    }
}

template <int MODE>
__device__ __forceinline__ void ph_rowA(const Ctx& C, int l) {
    float* X = WSP(float, WS_X); bf16* H = WSP(bf16, WS_H); const int* INV = WSP(int, WS_INV); const bf16* YB = WSP(bf16, WS_YB);
    const int nrows = MODE == 1 ? SEQ : R;
    for (int t = C.blk * 8 + C.wave; t < nrows; t += C.G * 8) {
        const int set = t >= SEQ ? 1 : 0;
        const float* src = (MODE == 0 && l == 0) ? (set ? C.in[2] + (size_t)(t - SEQ) * D : C.in[0] + (size_t)t * D) : X + (size_t)t * D;
        f32x4 v[4];
#pragma unroll
        for (int j = 0; j < 4; ++j) v[j] = ((const f32x4*)src)[C.lane + 64 * j];
        if (MODE == 1 || l > 0) {
            const int lp = MODE == 1 ? 3 : l - 1;
            const int myinv = C.lane < 16 ? INV[(size_t)t * 16 + C.lane] : -1;
            f32x4 a[4];
#pragma unroll
            for (int j = 0; j < 4; ++j) a[j] = (f32x4){0.f, 0.f, 0.f, 0.f};
            for (int e = 0; e < 16; ++e) {
                const int s = __shfl(myinv, e);
                if (s >= 0) {
                    const u32x2* yr = (const u32x2*)(YB + ((size_t)e * EROWS + s) * D);
#pragma unroll
                    for (int j = 0; j < 4; ++j) { const u32x2 w = yr[C.lane + 64 * j];
                        a[j] += (f32x4){bf2f(w.x & 0xffffu), bf2f(w.x >> 16), bf2f(w.y & 0xffffu), bf2f(w.y >> 16)}; }
                }
            }
            const f32x4* g = (const f32x4*)modp(C, lp, set, 5);
#pragma unroll
            for (int j = 0; j < 4; ++j) v[j] += g[C.lane + 64 * j] * a[j];
        }
        if (MODE == 0) {
#pragma unroll
            for (int j = 0; j < 4; ++j) ((f32x4*)(X + (size_t)t * D))[C.lane + 64 * j] = v[j];
        }
        float ss = 0.f;
#pragma unroll
        for (int j = 0; j < 4; ++j) ss += (v[j].x * v[j].x + v[j].y * v[j].y) + (v[j].z * v[j].z + v[j].w * v[j].w);
        const float rstd = rsqrtf(wave_sum(ss) * (1.f / D) + RMS_EPS);
        if (MODE == 0) {
            const f32x4* w = (const f32x4*)(C.in[6] + (size_t)l * D); const f32x4* sh = (const f32x4*)modp(C, l, set, 0); const f32x4* scl = (const f32x4*)modp(C, l, set, 1);
#pragma unroll
            for (int j = 0; j < 4; ++j) { const int i = C.lane + 64 * j; const f32x4 y = v[j] * rstd * w[i] * (scl[i] + 1.f) + sh[i];
                u32x2 o; o.x = pk2(y.x, y.y); o.y = pk2(y.z, y.w); ((u32x2*)(H + (size_t)t * D))[i] = o; }
        } else {
            const f32x4* w = (const f32x4*)C.in[25];
#pragma unroll
            for (int j = 0; j < 4; ++j) { const int i = C.lane + 64 * j; ((f32x4*)(C.out + (size_t)t * D))[i] = v[j] * rstd * w[i]; }
        }
    }
}
#define RS_STEP(lo, hi, bit, off) ((bit ? hi : lo) + __shfl_xor(bit ? lo : hi, off))
__device__ __forceinline__ float rscatter16(const float (&a)[16], int b5, int b4, int b3, int b2) {
    const float c0 = RS_STEP(a[0], a[8], b5, 32), c1 = RS_STEP(a[1], a[9], b5, 32), c2 = RS_STEP(a[2], a[10], b5, 32), c3 = RS_STEP(a[3], a[11], b5, 32);
    const float c4 = RS_STEP(a[4], a[12], b5, 32), c5 = RS_STEP(a[5], a[13], b5, 32), c6 = RS_STEP(a[6], a[14], b5, 32), c7 = RS_STEP(a[7], a[15], b5, 32);
    const float d0 = RS_STEP(c0, c4, b4, 16), d1 = RS_STEP(c1, c5, b4, 16), d2 = RS_STEP(c2, c6, b4, 16), d3 = RS_STEP(c3, c7, b4, 16);
    const float e0 = RS_STEP(d0, d2, b3, 8), e1 = RS_STEP(d1, d3, b3, 8);
    return RS_STEP(e0, e1, b2, 4);
}
constexpr int NR2 = 1;
__device__ __forceinline__ void ph_norm2(const Ctx& C, int l, int nrows) {
    const float* X = WSP(float, WS_X); bf16* H = WSP(bf16, WS_H); float* AFF = WSP(float, WS_AFF);
    LAS float* Rs = (LAS float*)C.lds;
    const float* rt = C.in[21] + (size_t)l * D * NE;
    for (int i = C.tid; i < D * NE / 4; i += 512) { const f32x4 r4 = ((const f32x4*)rt)[i]; const int c = i >> 2, e0 = (i & 3) * 4;
        Rs[(e0 + 0) * D + c] = r4.x; Rs[(e0 + 1) * D + c] = r4.y; Rs[(e0 + 2) * D + c] = r4.z; Rs[(e0 + 3) * D + c] = r4.w; }
    __syncthreads();
    const int b5 = (C.lane >> 5) & 1, b4 = (C.lane >> 4) & 1, b3 = (C.lane >> 3) & 1, b2 = (C.lane >> 2) & 1, my_e = 8 * b5 + 4 * b4 + 2 * b3 + b2;
    for (int t0 = (C.blk * 8 + C.wave) * NR2; t0 < nrows; t0 += C.G * 8 * NR2) {
        asm volatile("" ::: "memory");
        const int set = t0 >= SEQ ? 1 : 0;
        f32x4 v[NR2][4];
#pragma unroll
        for (int rr = 0; rr < NR2; ++rr) {
#pragma unroll
            for (int j = 0; j < 4; ++j) v[rr][j] = ((const f32x4*)(X + (size_t)(t0 + rr) * D))[C.lane + 64 * j];
        }
        { const f32x4* w = (const f32x4*)(C.in[7] + (size_t)l * D); const f32x4* sh = (const f32x4*)modp(C, l, set, 3); const f32x4* scl = (const f32x4*)modp(C, l, set, 4);
          float rstd[NR2];
#pragma unroll
          for (int rr = 0; rr < NR2; ++rr) { float ss = 0.f;
#pragma unroll
            for (int j = 0; j < 4; ++j) ss += (v[rr][j].x * v[rr][j].x + v[rr][j].y * v[rr][j].y) + (v[rr][j].z * v[rr][j].z + v[rr][j].w * v[rr][j].w);
            rstd[rr] = rsqrtf(wave_sum(ss) * (1.f / D) + RMS_EPS); }
#pragma unroll
          for (int j = 0; j < 4; ++j) { const int i = C.lane + 64 * j; const f32x4 ws = w[i] * (scl[i] + 1.f), s4 = sh[i];
#pragma unroll
            for (int rr = 0; rr < NR2; ++rr) { v[rr][j] = v[rr][j] * rstd[rr] * ws + s4;
                u32x2 o; o.x = pk2(v[rr][j].x, v[rr][j].y); o.y = pk2(v[rr][j].z, v[rr][j].w); ((u32x2*)(H + (size_t)(t0 + rr) * D))[i] = o; } } }
        asm volatile("" ::: "memory");
        float lg[NR2][16];
#pragma unroll
        for (int e = 0; e < 16; ++e) {
            float sacc[NR2];
#pragma unroll
            for (int rr = 0; rr < NR2; ++rr) sacc[rr] = 0.f;
#pragma unroll
            for (int j = 0; j < 4; ++j) { const f32x4 r = *(const LAS f32x4*)(Rs + e * D + 4 * (C.lane + 64 * j));
#pragma unroll
                for (int rr = 0; rr < NR2; ++rr) sacc[rr] += (v[rr][j].x * r.x + v[rr][j].y * r.y) + (v[rr][j].z * r.z + v[rr][j].w * r.w); }
#pragma unroll
            for (int rr = 0; rr < NR2; ++rr) lg[rr][e] = sacc[rr];
            if ((e & 3) == 3) asm volatile("" ::: "memory");
        }
#pragma unroll
        for (int rr = 0; rr < NR2; ++rr) {
            float vv = rscatter16(lg[rr], b5, b4, b3, b2);
            vv += __shfl_xor(vv, 1); vv += __shfl_xor(vv, 2);
            float mx = vv; mx = fmaxf(mx, __shfl_xor(mx, 4)); mx = fmaxf(mx, __shfl_xor(mx, 8)); mx = fmaxf(mx, __shfl_xor(mx, 16)); mx = fmaxf(mx, __shfl_xor(mx, 32));
            const float ex = __expf(vv - mx); float sm = ex; sm += __shfl_xor(sm, 4); sm += __shfl_xor(sm, 8); sm += __shfl_xor(sm, 16); sm += __shfl_xor(sm, 32);
            if ((C.lane & 3) == 0) AFF[(size_t)my_e * R + t0 + rr] = ex / sm;
        }
    }
}

__device__ __forceinline__ int block_sum_i(int v, LAS int* scr, int wave, int lane) {
    v = wave_sum_i(v);
    if (lane == 0) scr[wave] = v;
    __syncthreads();
    int t = 0;
#pragma unroll
    for (int w = 0; w < 8; ++w) t += scr[w];
    __syncthreads();
    return t;
}
__device__ __forceinline__ int block_excl_scan(int v, LAS int* scr, int wave, int lane) {
    int inc = v;
#pragma unroll
    for (int o = 1; o < 64; o <<= 1) { const int n = __shfl_up(inc, o); if (lane >= o) inc += n; }
    if (lane == 63) scr[wave] = inc;
    __syncthreads();
    int off = 0;
#pragma unroll
    for (int w = 0; w < 8; ++w) off += (w < wave) ? scr[w] : 0;
    __syncthreads();
    return off + inc - v;
}
template <int KPT>
__device__ __forceinline__ void topk_unit(const Ctx& C, int e, int base, int n, int cap, int slot0) {
    const float* aff = WSP(float, WS_AFF) + (size_t)e * R + base;
    int* rowl = WSP(int, WS_ROWL) + e * EROWS; float* gatel = WSP(float, WS_GATEL) + e * EROWS; int* INV = WSP(int, WS_INV);
    LAS unsigned* hist = (LAS unsigned*)C.lds;
    LAS int* scr = (LAS int*)(hist + 256);
    LAS unsigned* bc = hist + 256 + 16;
    unsigned key[KPT];
    if (KPT == 32) {
#pragma unroll
        for (int j = 0; j < KPT; j += 4) { const u32x4 k4 = *(const u32x4*)(aff + C.tid * KPT + j); key[j] = k4.x; key[j + 1] = k4.y; key[j + 2] = k4.z; key[j + 3] = k4.w; }
    } else {
#pragma unroll
        for (int j = 0; j < KPT; ++j) { const int t = C.tid * KPT + j; key[j] = t < n ? __float_as_uint(aff[t]) : 0u; }
    }
    unsigned prefix = 0u, pmask = 0u; int kth = cap;
    for (int pass = 0; pass < 4; ++pass) {
        const int shift = 24 - 8 * pass;
        if (C.tid < 256) hist[C.tid] = 0u;
        __syncthreads();
#pragma unroll
        for (int j = 0; j < KPT; ++j) if (key[j] != 0u && (key[j] & pmask) == prefix) __hip_atomic_fetch_add(hist + ((key[j] >> shift) & 255u), 1u, __ATOMIC_RELAXED, __HIP_MEMORY_SCOPE_WORKGROUP);
        __syncthreads();
        if (C.wave == 0) {
            const unsigned c0 = hist[4 * C.lane], c1 = hist[4 * C.lane + 1], c2 = hist[4 * C.lane + 2], c3 = hist[4 * C.lane + 3];
            const int tot = (int)(c0 + c1 + c2 + c3); int suf = tot;
#pragma unroll
            for (int o = 1; o < 64; o <<= 1) { const int nb = __shfl_down(suf, o); if (C.lane + o < 64) suf += nb; }
            const unsigned long long bal = __ballot(suf >= kth);
            const int lstar = 63 - __builtin_clzll(bal);
            if (C.lane == lstar) { int above = suf - tot; unsigned dg; int nk;
                if (above + (int)c3 >= kth) { dg = 3; nk = kth - above; }
                else { above += (int)c3; if (above + (int)c2 >= kth) { dg = 2; nk = kth - above; }
                else { above += (int)c2; if (above + (int)c1 >= kth) { dg = 1; nk = kth - above; }
                else { above += (int)c1; dg = 0; nk = kth - above; } } }
                bc[0] = 4u * (unsigned)C.lane + dg; bc[1] = (unsigned)nk; }
        }
        __syncthreads();
        prefix |= bc[0] << shift; pmask |= 255u << shift; kth = (int)bc[1];
    }
    const int need_eq = kth;
    int ce = 0;
#pragma unroll
    for (int j = 0; j < KPT; ++j) ce += key[j] == prefix ? 1 : 0;
    int eqr = block_excl_scan(ce, scr, C.wave, C.lane);
    int nsel = 0; unsigned selmask = 0u;
#pragma unroll
    for (int j = 0; j < KPT; ++j) { bool sl = key[j] > prefix; if (key[j] == prefix) { sl = eqr < need_eq; ++eqr; } if (sl) { ++nsel; selmask |= 1u << j; } }
    int slot = block_excl_scan(nsel, scr, C.wave, C.lane);
#pragma unroll
    for (int j = 0; j < KPT; ++j) { const int t = C.tid * KPT + j;
        if (t < n) {
            if ((selmask >> j) & 1u) { rowl[slot0 + slot] = base + t; gatel[slot0 + slot] = __uint_as_float(key[j]); INV[(size_t)(base + t) * 16 + e] = slot0 + slot; ++slot; }
            else INV[(size_t)(base + t) * 16 + e] = -1;
        } }
}
__device__ __forceinline__ void ph_topk(const Ctx& C, bool with_ctx) {
    for (int u = C.blk; u < (with_ctx ? 32 : 16); u += C.G) {
        const int e = u & 15;
        if (u < 16) topk_unit<32>(C, e, 0, SEQ, CAP_L, 0);
        else topk_unit<1>(C, e, SEQ, NCTX, CAP_C, CAP_L);
        __syncthreads();
    }
}
__device__ __forceinline__ void ph_gather(const Ctx& C, bool with_ctx) {
    const int* rowl = WSP(int, WS_ROWL); const bf16* H = WSP(bf16, WS_H); bf16* XG = WSP(bf16, WS_XG);
    const int nslots = with_ctx ? CAP_L + CAP_C : CAP_L, ntot = NE * nslots;
    for (int i = C.blk * 8 + C.wave; i < ntot; i += C.G * 8) {
        const int e = i / nslots, sl = i % nslots, r = e * EROWS + sl;
        const int src = rowl[r];
        u32x4* d = (u32x4*)(XG + (size_t)r * D); const u32x4* sp = (const u32x4*)(H + (size_t)src * D);
        d[C.lane] = sp[C.lane]; d[C.lane + 64] = sp[C.lane + 64];
    }
}
__device__ __forceinline__ void rot_angles(int t, int half, int d, int quarter, float& cs, float& sn) {
    const float invf = exp2f(-(float)d * (13.287712379549449f / (float)quarter));
    const float pos = half ? (float)(t & 63) : (float)(t >> 6);
    const float ang = pos * invf;
    const double rev = (double)ang * 0.15915494309189535; const float fr = (float)(rev - __builtin_rint(rev));
    cs = __builtin_amdgcn_cosf(fr); sn = __builtin_amdgcn_sinf(fr);
}
__device__ __forceinline__ void ph_rope(const Ctx& C, bf16* buf, int hw, int nheads, int off, int quarter) {
    const int per_tok = nheads * 2 * quarter; const long total = (long)SEQ * per_tok;
    for (long i = (long)C.blk * 512 + C.tid; i < total; i += (long)C.G * 512) {
        const int t = (int)(i / per_tok), r = (int)(i % per_tok), h = r / (2 * quarter), p = r % (2 * quarter), half = p / quarter, d = p % quarter;
        float cs, sn; rot_angles(t, half, d, quarter, cs, sn);
        bf16* b = buf + (size_t)h * R * hw + (size_t)t * hw + off + half * 2 * quarter + d;
        const float x1 = bf2f(b[0]), x2 = bf2f(b[quarter]);
        b[0] = (bf16)f2bf(x1 * cs - x2 * sn); b[quarter] = (bf16)f2bf(x1 * sn + x2 * cs);
    }
}
__device__ __forceinline__ void ph_mlanorm(const Ctx& C) {
    const float* CQ = WSP(float, WS_CQ); bf16* CQN = WSP(bf16, WS_CQN); bf16* CKVN = WSP(bf16, WS_CKVN); bf16* KR = WSP(bf16, WS_KROPE);
    for (int t = C.blk * 8 + C.wave; t < R; t += C.G * 8) {
        const float* row = CQ + (size_t)t * D;
        const f32x4 a0 = ((const f32x4*)row)[C.lane], a1 = ((const f32x4*)row)[C.lane + 64], b0 = ((const f32x4*)(row + 512))[C.lane];
        const float sa = wave_sum((a0.x * a0.x + a0.y * a0.y) + (a0.z * a0.z + a0.w * a0.w) + (a1.x * a1.x + a1.y * a1.y) + (a1.z * a1.z + a1.w * a1.w));
        const float sb = wave_sum((b0.x * b0.x + b0.y * b0.y) + (b0.z * b0.z + b0.w * b0.w));
        const float ra = rsqrtf(sa * (1.f / 512.f) + RMS_EPS), rb = rsqrtf(sb * (1.f / 256.f) + RMS_EPS);
        const f32x4* gq = (const f32x4*)C.in[15]; const f32x4* gk = (const f32x4*)C.in[18];
        { const f32x4 y0 = a0 * ra * gq[C.lane], y1 = a1 * ra * gq[C.lane + 64], z = b0 * rb * gk[C.lane];
          u32x2 o; o.x = pk2(y0.x, y0.y); o.y = pk2(y0.z, y0.w); ((u32x2*)(CQN + (size_t)t * 512))[C.lane] = o;
          o.x = pk2(y1.x, y1.y); o.y = pk2(y1.z, y1.w); ((u32x2*)(CQN + (size_t)t * 512))[C.lane + 64] = o;
          o.x = pk2(z.x, z.y); o.y = pk2(z.z, z.w); ((u32x2*)(CKVN + (size_t)t * 256))[C.lane] = o; }
        const float x = row[768 + (C.lane & 31)];
        const float xp = __shfl_xor(x, 8);
        float y = x;
        if (t < SEQ) { float cs, sn; rot_angles(t, (C.lane >> 4) & 1, C.lane & 7, 8, cs, sn);
            y = ((C.lane >> 3) & 1) ? (xp * sn + x * cs) : (x * cs - xp * sn); }
        if (C.lane < 32) KR[(size_t)t * 32 + C.lane] = (bf16)f2bf(y);
    }
}

constexpr int CW_KMAX = 8192;
__device__ __forceinline__ void ph_kmax(const Ctx& C) {
    const bf16* KV = WSP(bf16, WS_KV); const bf16* KR = WSP(bf16, WS_KROPE); unsigned* ctl = (unsigned*)(C.ws + WS_CTL);
    for (int i = C.blk * 512 + C.tid; i < 16 * R; i += C.G * 512) {
        const int h = i / R, t = i - h * R;
        const u32x4* kp = (const u32x4*)(KV + (size_t)h * R * 128 + (size_t)t * 128); const u32x4* rp = (const u32x4*)(KR + (size_t)t * 32);
        float ss = 0.f;
#pragma unroll
        for (int q = 0; q < 12; ++q) { const u32x4 w = q < 8 ? kp[q] : rp[q - 8];
            const float a0 = bf2f(w.x & 0xffffu), a1 = bf2f(w.x >> 16), a2 = bf2f(w.y & 0xffffu), a3 = bf2f(w.y >> 16), a4 = bf2f(w.z & 0xffffu), a5 = bf2f(w.z >> 16), a6 = bf2f(w.w & 0xffffu), a7 = bf2f(w.w >> 16);
            ss += (a0 * a0 + a1 * a1) + (a2 * a2 + a3 * a3) + (a4 * a4 + a5 * a5) + (a6 * a6 + a7 * a7); }
#pragma unroll
        for (int o = 1; o < 64; o <<= 1) ss = fmaxf(ss, __shfl_xor(ss, o));
        if (C.lane == 0) atomicMax(ctl + CW_KMAX + h, __float_as_uint(ss));
    }
}

namespace pg8 {
#define PG8_LAS __attribute__((address_space(3)))
typedef unsigned short bf16_t;
typedef short bf16x8 __attribute__((ext_vector_type(8)));
typedef float f32x4 __attribute__((ext_vector_type(4)));
typedef unsigned u32x4 __attribute__((ext_vector_type(4)));
constexpr int BM = 256, BK = 64, HALF = 128, HTB = HALF * BK * 2  , STAGE_BYTES = 8 * HTB, NXCD = 8, WGM = 8;

__host__ __device__ __forceinline__ int lds_byte(int r, int c) { const int st = (r >> 4) * 2 + (c >> 5), rr = r & 15, cc = c & 31, ob = rr * 64 + cc * 2; return st * 1024 + (ob ^ (((ob >> 9) & 1) << 5)); }
__host__ __device__ __forceinline__ void stage_rc(int b, int& R, int& C) { const int st = b / 1024, sb = b % 1024, swz = sb ^ (((sb >> 9) & 1) << 5); R = (st >> 1) * 16 + swz / 64; C = (st & 1) * 32 + (swz % 64) / 2; }
__host__ __device__ __forceinline__ int perm32(int rho) { const int n = rho >> 4, i = rho & 15; return 8 * (i >> 2) + 4 * n + (i & 3); }

struct Unit { int pm, pn, thin; };
struct Gemm { const bf16_t* A; const bf16_t* Bt; int M, N, K; int pm_per_grp; size_t grp_stride; };

struct StaticOrder {
    int nM, nN, nwg, G, c;
    __host__ __device__ void init(int M, int N, int G_, int c_) { nM = M / BM; nN = N / BM; nwg = nM * nN; G = G_; c = c_; }
    __host__ __device__ bool next(int i, Unit& u) const {
        const long L = (long)i * G + c; if (L >= nwg) return false;
        int wgid = (int)L; { const int q = nwg / NXCD, r = nwg % NXCD, xcd = wgid % NXCD, off = wgid / NXCD; wgid = (xcd < r ? xcd * (q + 1) : r * (q + 1) + (xcd - r) * q) + off; }
        const int nig = WGM * nN, gid = wgid / nig, fm = gid * WGM, gsz = (nM - fm) < WGM ? (nM - fm) : WGM;
        u.pm = fm + ((wgid % nig) % gsz); u.pn = (wgid % nig) / gsz; u.thin = 0; return true;
    }
    __device__ __forceinline__ void a_ready(const Unit&) const {}
    __device__ __forceinline__ void done(const Unit&) const {}
};
struct MoeOrder {
    StaticOrder base; int nN, nthin;
    __host__ __device__ void init(int N, int G_, int c_, bool with_thin) { base.init(NEXP_PANELS * BM, N, G_, c_); nN = N / BM; nthin = with_thin ? 16 * nN : 0; }
    static constexpr int NEXP_PANELS = 16 * 8;
    __host__ __device__ bool next(int i, Unit& u) const {
        if (base.next(i, u)) { u.pm = (u.pm >> 3) * 9 + (u.pm & 7); return true; }
        const long j = (long)i * base.G + base.c - base.nwg; if (j >= nthin) return false;
        u.pm = (int)(j / nN) * 9 + 8; u.pn = (int)(j % nN); u.thin = 1; return true;
    }
    __device__ __forceinline__ void a_ready(const Unit&) const {}
    __device__ __forceinline__ void done(const Unit&) const {}
};

template <class Epi, class Sched, bool ALIGN_EPI = false, bool SP2 = false>
__device__ __forceinline__ void gemm_phase(PG8_LAS unsigned char* lds, const Gemm g, const Sched& S, const Epi& E) {
    const int tid = threadIdx.x, wid = __builtin_amdgcn_readfirstlane(tid >> 6), lane = tid & 63, wr = wid >> 2, wc = wid & 3, fr = lane & 15, fq = lane >> 4;
    const int K = g.K, nt = K / BK;
    unsigned voffA[2], voffB[2];
#pragma unroll
    for (int i = 0; i < 2; ++i) { int R, C; stage_rc(tid * 16 + i * 8192, R, C); const int Rb = Epi::PERM ? ((R & ~31) + perm32(R & 31)) : R;
        voffA[i] = (unsigned)(R * K + C) * 2u; voffB[i] = (unsigned)(Rb * K + C) * 2u; }
    const size_t kstep = (size_t)(BK * 2);
    const size_t hstep = (size_t)HALF * K * 2;
    const size_t tstep = 2 * hstep;
    const unsigned ldsw = (unsigned)wid * 1024u;
    const int aoff = lds_byte(wr * 64 + fr, fq * 8), boff = lds_byte(wc * 32 + fr, fq * 8);
#define PG8_SA(b, h) (((b) * 2 + (h)) * HTB)
#define PG8_SB(b, h) ((4 + (b) * 2 + (h)) * HTB)
#define PG8_STAGE(bufoff, gbase, voff) do { _Pragma("unroll") for (int _i = 0; _i < 2; ++_i) \
        __builtin_amdgcn_global_load_lds((const unsigned*)((const char*)(gbase) + (voff)[_i]), (PG8_LAS unsigned*)(lds + (bufoff) + ldsw + _i * 8192), 16, 0, 0); } while (0)
#define PG8_LDA(dst, b, h) do { _Pragma("unroll") for (int m = 0; m < 4; ++m) _Pragma("unroll") for (int k = 0; k < 2; ++k) dst[m][k] = *(const PG8_LAS bf16x8*)(lds + PG8_SA(b, h) + aoff + m * 2048 + k * 1024); } while (0)
#define PG8_LDB(dst, b, h) do { _Pragma("unroll") for (int n = 0; n < 2; ++n) _Pragma("unroll") for (int k = 0; k < 2; ++k) dst[n][k] = *(const PG8_LAS bf16x8*)(lds + PG8_SB(b, h) + boff + n * 2048 + k * 1024); } while (0)
#define PG8_MMA(ai, bj, At, Bt) do { if (cur.thin && ((ai) != 0 || wr != 0)) break; __builtin_amdgcn_s_setprio(1); _Pragma("unroll") for (int m = 0; m < 4; ++m) _Pragma("unroll") for (int n = 0; n < 2; ++n) _Pragma("unroll") for (int k = 0; k < 2; ++k) \
        acc[ai][bj][m][n] = __builtin_amdgcn_mfma_f32_16x16x32_bf16(Bt[n][k], At[m][k], acc[ai][bj][m][n], 0, 0, 0); __builtin_amdgcn_s_setprio(0); } while (0)
#define PG8_WAIT_V(n) asm volatile("s_waitcnt vmcnt(" #n ")" ::: "memory")
#define PG8_WAIT_L(n) asm volatile("s_waitcnt lgkmcnt(" #n ")" ::: "memory")
#define PG8_BAR __builtin_amdgcn_s_barrier()
#define PG8_SCHED __builtin_amdgcn_sched_barrier(0)
    Unit cur, nxt; int ui = 0;
    if (!S.next(0, cur)) return;
    f32x4 acc[2][2][4][2];
#pragma unroll
    for (int a = 0; a < 2; ++a)
#pragma unroll
        for (int b = 0; b < 2; ++b)
#pragma unroll
            for (int m = 0; m < 4; ++m)
#pragma unroll
                for (int n = 0; n < 2; ++n) acc[a][b][m][n] = (f32x4){0.f, 0.f, 0.f, 0.f};
    bf16x8 At[4][2], B0[2][2], B1[2][2];
    const char* cA = (const char*)g.A + (size_t)cur.pm * tstep; const char* cB = (const char*)g.Bt + (g.pm_per_grp ? (size_t)(cur.pm / g.pm_per_grp) * g.grp_stride * 2 : (size_t)0) + (size_t)cur.pn * tstep;
    S.a_ready(cur);
    if constexpr (SP2) {
        PG8_STAGE(PG8_SB(0, 0), cB, voffB); PG8_STAGE(PG8_SB(0, 1), cB + hstep, voffB); PG8_STAGE(PG8_SA(0, 0), cA, voffA); PG8_STAGE(PG8_SA(0, 1), cA + hstep, voffA);
        if (wr == 1) PG8_BAR;
        PG8_WAIT_V(2); PG8_BAR;
        PG8_STAGE(PG8_SB(1, 0), cB + kstep, voffB); PG8_STAGE(PG8_SA(1, 0), cA + kstep, voffA); PG8_STAGE(PG8_SB(1, 1), cB + hstep + kstep, voffB);
        PG8_WAIT_V(6); PG8_BAR;
    } else {
        PG8_STAGE(PG8_SB(0, 0), cB, voffB); PG8_STAGE(PG8_SA(0, 0), cA, voffA); PG8_STAGE(PG8_SB(0, 1), cB + hstep, voffB); PG8_STAGE(PG8_SA(0, 1), cA + hstep, voffA);
        if (wr == 1) PG8_BAR;
        PG8_WAIT_V(4); PG8_BAR;
        PG8_STAGE(PG8_SB(1, 0), cB + kstep, voffB); PG8_STAGE(PG8_SA(1, 0), cA + kstep, voffA); PG8_STAGE(PG8_SB(1, 1), cB + hstep + kstep, voffB);
        PG8_WAIT_V(6); PG8_BAR;
    }
    for (;;) {
        const bool has_next = S.next(ui + 1, nxt);
        const char* nA = has_next ? (const char*)g.A + (size_t)nxt.pm * tstep : cA; const char* nB = has_next ? (const char*)g.Bt + (g.pm_per_grp ? (size_t)(nxt.pm / g.pm_per_grp) * g.grp_stride * 2 : (size_t)0) + (size_t)nxt.pn * tstep : cB;
        for (int t = 0; t < nt; t += 2) {
            const bool last = (t == nt - 2);
            const char* a1 = cA + (size_t)(t + 1) * kstep;
            const char* a2 = last ? nA : cA + (size_t)(t + 2) * kstep; const char* b2 = last ? nB : cB + (size_t)(t + 2) * kstep;
            const char* a3 = a2 + kstep; const char* b3 = b2 + kstep;
            if (last && has_next) S.a_ready(nxt);
            if constexpr (SP2) {
            PG8_LDB(B0, 0, 0); PG8_LDB(B1, 0, 1); PG8_SCHED; PG8_LDA(At, 0, 0); PG8_STAGE(PG8_SA(1, 1), a1 + hstep, voffA);
            PG8_WAIT_V(8); PG8_WAIT_L(0); PG8_BAR; PG8_MMA(0, 0, At, B0); PG8_MMA(0, 1, At, B1); PG8_BAR; PG8_SCHED;
            PG8_LDA(At, 0, 1); PG8_STAGE(PG8_SB(0, 0), b2, voffB); PG8_STAGE(PG8_SB(0, 1), b2 + hstep, voffB); PG8_STAGE(PG8_SA(0, 0), a2, voffA);
            PG8_WAIT_V(8); PG8_WAIT_L(0); PG8_BAR; PG8_MMA(1, 0, At, B0); PG8_MMA(1, 1, At, B1); PG8_BAR; PG8_SCHED;
            PG8_LDB(B0, 1, 0); PG8_LDB(B1, 1, 1); PG8_SCHED; PG8_LDA(At, 1, 0); PG8_STAGE(PG8_SA(0, 1), a2 + hstep, voffA);
            PG8_WAIT_V(8); PG8_WAIT_L(0); PG8_BAR; PG8_MMA(0, 0, At, B0); PG8_MMA(0, 1, At, B1); PG8_BAR; PG8_SCHED;
            PG8_LDA(At, 1, 1); PG8_STAGE(PG8_SB(1, 0), b3, voffB); PG8_STAGE(PG8_SB(1, 1), b3 + hstep, voffB); PG8_STAGE(PG8_SA(1, 0), a3, voffA);
            PG8_WAIT_V(8); PG8_WAIT_L(0); PG8_BAR; PG8_MMA(1, 0, At, B0); PG8_MMA(1, 1, At, B1); PG8_BAR; PG8_SCHED;
            } else {
            PG8_LDB(B0, 0, 0); PG8_SCHED; PG8_LDA(At, 0, 0); PG8_STAGE(PG8_SA(1, 1), a1 + hstep, voffA);
            PG8_WAIT_L(8); PG8_BAR; PG8_WAIT_L(0); PG8_MMA(0, 0, At, B0); PG8_BAR; PG8_SCHED;
            PG8_LDB(B1, 0, 1); PG8_STAGE(PG8_SB(0, 0), b2, voffB);
            PG8_BAR; PG8_WAIT_L(0); PG8_MMA(0, 1, At, B1); PG8_BAR;
            PG8_LDA(At, 0, 1); PG8_STAGE(PG8_SA(0, 0), a2, voffA);
            PG8_BAR; PG8_WAIT_L(0); PG8_MMA(1, 0, At, B0); PG8_BAR; PG8_SCHED;
            PG8_STAGE(PG8_SB(0, 1), b2 + hstep, voffB);
            PG8_WAIT_V(6); PG8_BAR; PG8_MMA(1, 1, At, B1); PG8_BAR;
            PG8_LDB(B0, 1, 0); PG8_SCHED; PG8_LDA(At, 1, 0); PG8_STAGE(PG8_SA(0, 1), a2 + hstep, voffA);
            PG8_WAIT_L(8); PG8_BAR; PG8_WAIT_L(0); PG8_MMA(0, 0, At, B0); PG8_BAR; PG8_SCHED;
            PG8_LDB(B1, 1, 1); PG8_STAGE(PG8_SB(1, 0), b3, voffB);
            PG8_BAR; PG8_WAIT_L(0); PG8_MMA(0, 1, At, B1); PG8_BAR;
            PG8_LDA(At, 1, 1); PG8_STAGE(PG8_SA(1, 0), a3, voffA);
            PG8_BAR; PG8_WAIT_L(0); PG8_MMA(1, 0, At, B0); PG8_BAR; PG8_SCHED;
            PG8_STAGE(PG8_SB(1, 1), b3 + hstep, voffB);
            PG8_WAIT_V(6); PG8_BAR; PG8_MMA(1, 1, At, B1); PG8_BAR;
            }
        }
        if constexpr (ALIGN_EPI) { if (wr == 0) PG8_BAR; }
        if constexpr (!Epi::AFTER_DRAIN) { E(acc, cur, wr, wc, fr, fq); S.done(cur); }
        if (!has_next) break;
#pragma unroll
        for (int a = 0; a < 2; ++a)
#pragma unroll
            for (int b = 0; b < 2; ++b)
#pragma unroll
                for (int m = 0; m < 4; ++m)
#pragma unroll
                    for (int n = 0; n < 2; ++n) acc[a][b][m][n] = (f32x4){0.f, 0.f, 0.f, 0.f};
        cur = nxt; cA = nA; cB = nB; ++ui;
        if constexpr (ALIGN_EPI) { if (wr == 1) PG8_BAR; }
    }
    PG8_WAIT_V(0);
    if constexpr (!ALIGN_EPI) { if (wr == 0) PG8_BAR; }
    PG8_BAR;
    if constexpr (Epi::AFTER_DRAIN) { E.fused(acc, cur, wr, wc, fr, fq, lds, wid, lane); S.done(cur); }
#undef PG8_SA
#undef PG8_SB
#undef PG8_STAGE
#undef PG8_LDA
#undef PG8_LDB
#undef PG8_MMA
#undef PG8_WAIT_V
#undef PG8_WAIT_L
#undef PG8_BAR
#undef PG8_SCHED
}
}
#ifndef USE_PG8
#define USE_PG8 1
#endif
typedef float f32x2_t __attribute__((ext_vector_type(2))); typedef __bf16 bf16x2_t __attribute__((ext_vector_type(2)));
__device__ __forceinline__ unsigned cvt_pk_bf16(float lo, float hi) { f32x2_t v = {lo, hi}; bf16x2_t b = __builtin_convertvector(v, bf16x2_t); return __builtin_bit_cast(unsigned, b); }
typedef const f32x4 (&AccRef)[2][2][4][2];
struct EpiStoreBf16 { static constexpr bool DUAL = false, PERM = true, AFTER_DRAIN = false; bf16* O; int ldc;
    __device__ __forceinline__ void elem(int row, int col, float v, float) const { O[(size_t)row * ldc + col] = (bf16)f2bf(v); }
    __device__ __forceinline__ void operator()(AccRef acc, const pg8::Unit& u, int wr, int wc, int fr, int fq) const {
        const int row0 = u.pm * 256 + wr * 64 + fr, col0 = u.pn * 256 + wc * 32 + 8 * fq;
#pragma unroll
        for (int ai = 0; ai < 2; ++ai)
#pragma unroll
            for (int m = 0; m < 4; ++m) { bf16* rowp = O + (size_t)(row0 + ai * 128 + m * 16) * ldc + col0;
#pragma unroll
                for (int bj = 0; bj < 2; ++bj) { const f32x4 v0 = acc[ai][bj][m][0], v1 = acc[ai][bj][m][1];
                    u32x4 w; w.x = cvt_pk_bf16(v0[0], v0[1]); w.y = cvt_pk_bf16(v0[2], v0[3]); w.z = cvt_pk_bf16(v1[0], v1[1]); w.w = cvt_pk_bf16(v1[2], v1[3]);
                    *(u32x4*)(rowp + bj * 128) = w; } }
    } };
struct EpiStoreHeads { static constexpr bool DUAL = false, PERM = true, AFTER_DRAIN = false; bf16* O; int hw; size_t hstride;
    __device__ __forceinline__ void store4(int row, int col, f32x4 v) const { const int hd = col / hw, wi = col - hd * hw; u32x2 o; o.x = cvt_pk_bf16(v[0], v[1]); o.y = cvt_pk_bf16(v[2], v[3]); *(u32x2*)(O + (size_t)hd * hstride + (size_t)row * hw + wi) = o; }
    __device__ __forceinline__ void elem(int row, int col, float v, float) const { O[(size_t)(col / hw) * hstride + (size_t)row * hw + (col % hw)] = (bf16)f2bf(v); }
    __device__ __forceinline__ void operator()(AccRef acc, const pg8::Unit& u, int wr, int wc, int fr, int fq) const {
        const int row0 = u.pm * 256 + wr * 64 + fr, col0 = u.pn * 256 + wc * 32 + 8 * fq;
#pragma unroll
        for (int bj = 0; bj < 2; ++bj) { const int c = col0 + bj * 128, hd = c / hw, wi = c - hd * hw; bf16* base = O + (size_t)hd * hstride + wi;
#pragma unroll
            for (int ai = 0; ai < 2; ++ai)
#pragma unroll
                for (int m = 0; m < 4; ++m) { const f32x4 v0 = acc[ai][bj][m][0], v1 = acc[ai][bj][m][1];
                    u32x4 w; w.x = cvt_pk_bf16(v0[0], v0[1]); w.y = cvt_pk_bf16(v0[2], v0[3]); w.z = cvt_pk_bf16(v1[0], v1[1]); w.w = cvt_pk_bf16(v1[2], v1[3]);
                    *(u32x4*)(base + (size_t)(row0 + ai * 128 + m * 16) * hw) = w; } }
    } };
struct EpiStoreF32 { static constexpr bool DUAL = false, PERM = false, AFTER_DRAIN = false; float* O; int ldc;
    __device__ __forceinline__ void store4(int row, int col, f32x4 v) const { *(f32x4*)(O + (size_t)row * ldc + col) = v; }
    __device__ __forceinline__ void elem(int row, int col, float v, float) const { O[(size_t)row * ldc + col] = v; }
    __device__ __forceinline__ void operator()(AccRef acc, const pg8::Unit& u, int wr, int wc, int fr, int fq) const {
        const int row0 = u.pm * 256 + wr * 64 + fr, col0 = u.pn * 256 + wc * 32 + 4 * fq;
#pragma unroll
        for (int ai = 0; ai < 2; ++ai)
#pragma unroll
            for (int m = 0; m < 4; ++m) { float* rowp = O + (size_t)(row0 + ai * 128 + m * 16) * ldc + col0;
#pragma unroll
                for (int bj = 0; bj < 2; ++bj)
#pragma unroll
                    for (int n = 0; n < 2; ++n) *(f32x4*)(rowp + bj * 128 + n * 16) = acc[ai][bj][m][n]; }
    } };
struct EpiResid { static constexpr bool DUAL = false, PERM = false, AFTER_DRAIN = false; float* X; const float* g_lat; const float* g_ctx;
    __device__ __forceinline__ void store4(int row, int col, f32x4 v) const { const float* g = row >= SEQ ? g_ctx : g_lat; f32x4* p = (f32x4*)(X + (size_t)row * D + col); *p = *p + *(const f32x4*)(g + col) * v; }
    __device__ __forceinline__ void elem(int row, int col, float v, float) const { const float g = row >= SEQ ? g_ctx[col] : g_lat[col]; X[(size_t)row * D + col] += g * v; }
    __device__ __forceinline__ void operator()(AccRef acc, const pg8::Unit& u, int wr, int wc, int fr, int fq) const {
        const int row0 = u.pm * 256 + wr * 64 + fr, col0 = u.pn * 256 + wc * 32 + 4 * fq;
        const float* g = (u.pm * 256 >= SEQ) ? g_ctx : g_lat;
        f32x4 gv[2][2];
#pragma unroll
        for (int bj = 0; bj < 2; ++bj)
#pragma unroll
            for (int n = 0; n < 2; ++n) gv[bj][n] = *(const f32x4*)(g + col0 + bj * 128 + n * 16);
#pragma unroll
        for (int ai = 0; ai < 2; ++ai)
#pragma unroll
            for (int m = 0; m < 4; ++m) { float* rowp = X + (size_t)(row0 + ai * 128 + m * 16) * D + col0;
#pragma unroll
                for (int bj = 0; bj < 2; ++bj)
#pragma unroll
                    for (int n = 0; n < 2; ++n) { f32x4* p = (f32x4*)(rowp + bj * 128 + n * 16); *p = *p + gv[bj][n] * acc[ai][bj][m][n]; } }
    } };
__device__ __forceinline__ float silu_mul(float g, float u) { return g * __builtin_amdgcn_rcpf(1.f + __expf(-g)) * u; }
struct EpiSwiglu { static constexpr bool DUAL = true, PERM = true, AFTER_DRAIN = false; bf16* ACT;
    __device__ __forceinline__ void elem(int row, int col, float g, float u) const { ACT[(size_t)row * FF + col] = (bf16)f2bf(g / (1.f + __expf(-g)) * u); }
    __device__ __forceinline__ void operator()(AccRef acc, const pg8::Unit& u, int wr, int wc, int fr, int fq) const {
        const int row0 = u.pm * 256 + wr * 64 + fr, col0 = u.pn * 128 + wc * 32 + 8 * fq;
#pragma unroll
        for (int ai = 0; ai < 2; ++ai)
#pragma unroll
            for (int m = 0; m < 4; ++m) { bf16* rowp = ACT + (size_t)(row0 + ai * 128 + m * 16) * FF + col0;
                const f32x4 g0 = acc[ai][0][m][0], g1 = acc[ai][0][m][1], u0 = acc[ai][1][m][0], u1 = acc[ai][1][m][1];
                u32x4 w; w.x = cvt_pk_bf16(silu_mul(g0[0], u0[0]), silu_mul(g0[1], u0[1])); w.y = cvt_pk_bf16(silu_mul(g0[2], u0[2]), silu_mul(g0[3], u0[3]));
                w.z = cvt_pk_bf16(silu_mul(g1[0], u1[0]), silu_mul(g1[1], u1[1])); w.w = cvt_pk_bf16(silu_mul(g1[2], u1[2]), silu_mul(g1[3], u1[3]));
                *(u32x4*)rowp = w; }
    } };
struct EpiMoeOut { static constexpr bool DUAL = false, PERM = true, AFTER_DRAIN = false; bf16* YB; const float* gatel;
    __device__ __forceinline__ void elem(int row, int col, float v, float) const { YB[(size_t)row * D + col] = (bf16)f2bf(v * gatel[row]); }
    __device__ __forceinline__ void operator()(AccRef acc, const pg8::Unit& u, int wr, int wc, int fr, int fq) const {
        const int row0 = u.pm * 256 + wr * 64 + fr, col0 = u.pn * 256 + wc * 32 + 8 * fq;
#pragma unroll
        for (int ai = 0; ai < 2; ++ai)
#pragma unroll
            for (int m = 0; m < 4; ++m) { const int row = row0 + ai * 128 + m * 16; const float gt = gatel[row]; bf16* rowp = YB + (size_t)row * D + col0;
#pragma unroll
                for (int bj = 0; bj < 2; ++bj) { const f32x4 v0 = acc[ai][bj][m][0] * gt, v1 = acc[ai][bj][m][1] * gt;
                    u32x4 w; w.x = cvt_pk_bf16(v0[0], v0[1]); w.y = cvt_pk_bf16(v0[2], v0[3]); w.z = cvt_pk_bf16(v1[0], v1[1]); w.w = cvt_pk_bf16(v1[2], v1[3]);
                    *(u32x4*)(rowp + bj * 128) = w; } }
    } };

template <class Epi>
__device__ __forceinline__ void naive_gemm(const Ctx& C, const bf16* A, const bf16* Bt, int M, int N, int K, int pm_per_grp, size_t grp_stride, const Epi& E) {
    LAS float* As = (LAS float*)C.lds;
    LAS float* Bs = As + 16 * 132;
    LAS float* Bs2 = Bs + 16 * 68;
    const int NO = Epi::DUAL ? N / 2 : N, tn_cnt = NO / 64, nun = (M / 128) * tn_cnt;
    const int ty = C.tid >> 4, tx = C.tid & 15;
    for (int u = C.blk; u < nun; u += C.G) {
        const int tm = u / tn_cnt, tn = u % tn_cnt, row0 = tm * 128, oc0 = tn * 64;
        const bf16* Bg = Bt + (pm_per_grp ? (size_t)((row0 / 256) / pm_per_grp) * grp_stride : (size_t)0);
        const int brow0 = Epi::DUAL ? ((oc0 >> 7) * 256 + (oc0 & 127)) : oc0;
        float acc[4][4], acc2[4][4];
#pragma unroll
        for (int i = 0; i < 4; ++i)
#pragma unroll
            for (int j = 0; j < 4; ++j) { acc[i][j] = 0.f; acc2[i][j] = 0.f; }
        for (int k0 = 0; k0 < K; k0 += 16) {
            __syncthreads();
            { const int r = C.tid >> 2, kc = (C.tid & 3) * 4;
              const u32x2 w = *(const u32x2*)(A + (size_t)(row0 + r) * K + k0 + kc);
              As[(kc + 0) * 132 + r] = bf2f(w.x & 0xffffu); As[(kc + 1) * 132 + r] = bf2f(w.x >> 16); As[(kc + 2) * 132 + r] = bf2f(w.y & 0xffffu); As[(kc + 3) * 132 + r] = bf2f(w.y >> 16); }
            if (C.tid < 256) { const int r = C.tid >> 2, kc = (C.tid & 3) * 4;
              const u32x2 w = *(const u32x2*)(Bg + (size_t)(brow0 + r) * K + k0 + kc);
              Bs[(kc + 0) * 68 + r] = bf2f(w.x & 0xffffu); Bs[(kc + 1) * 68 + r] = bf2f(w.x >> 16); Bs[(kc + 2) * 68 + r] = bf2f(w.y & 0xffffu); Bs[(kc + 3) * 68 + r] = bf2f(w.y >> 16);
              if (Epi::DUAL) { const u32x2 w2 = *(const u32x2*)(Bg + (size_t)(brow0 + 128 + r) * K + k0 + kc);
                Bs2[(kc + 0) * 68 + r] = bf2f(w2.x & 0xffffu); Bs2[(kc + 1) * 68 + r] = bf2f(w2.x >> 16); Bs2[(kc + 2) * 68 + r] = bf2f(w2.y & 0xffffu); Bs2[(kc + 3) * 68 + r] = bf2f(w2.y >> 16); } }
            __syncthreads();
#pragma unroll
            for (int kk = 0; kk < 16; ++kk) {
                const f32x4 a = *(const LAS f32x4*)(As + kk * 132 + ty * 4), b = *(const LAS f32x4*)(Bs + kk * 68 + tx * 4);
#pragma unroll
                for (int i = 0; i < 4; ++i)
#pragma unroll
                    for (int j = 0; j < 4; ++j) acc[i][j] += a[i] * b[j];
                if (Epi::DUAL) { const f32x4 b2 = *(const LAS f32x4*)(Bs2 + kk * 68 + tx * 4);
#pragma unroll
                    for (int i = 0; i < 4; ++i)
#pragma unroll
                        for (int j = 0; j < 4; ++j) acc2[i][j] += a[i] * b2[j]; }
            }
        }
#pragma unroll
        for (int i = 0; i < 4; ++i)
#pragma unroll
            for (int j = 0; j < 4; ++j) E.elem(row0 + ty * 4 + i, oc0 + tx * 4 + j, acc[i][j], acc2[i][j]);
    }
    __syncthreads();
}

template <class Epi>
__device__ __forceinline__ void gemm(const Ctx& C, const bf16* A, const bf16* Bt, int M, int N, int K, int pm_per_grp, size_t grp_stride, const Epi& E) {
#if USE_PG8
    pg8::Gemm g{A, Bt, M, N, K, pm_per_grp, grp_stride}; pg8::StaticOrder S; S.init(M, N, C.G, C.blk);
    pg8::gemm_phase<Epi, pg8::StaticOrder, true, true>(C.lds, g, S, E);
#else
    naive_gemm(C, A, Bt, M, N, K, pm_per_grp, grp_stride, E);
#endif
}
template <class Epi>
__device__ __forceinline__ void small_gemm(const Ctx& C, const bf16* A, const bf16* Bt, int row0, int nrows, int N, int K, const Epi& E) {
    const int ql = C.lane & 31, hi = C.lane >> 5, nrb = nrows / 32, nitems = nrb * (N / 32);
    for (int it = C.blk * 8 + C.wave; it < nitems; it += C.G * 8) {
        const int cb = it / nrb, rb = it % nrb;
        const bf16* ap = A + (size_t)(row0 + rb * 32 + ql) * K + 8 * hi; const bf16* bp = Bt + (size_t)(cb * 32 + ql) * K + 8 * hi;
        f32x16 acc;
#pragma unroll
        for (int r = 0; r < 16; ++r) acc[r] = 0.f;
#pragma unroll 1
        for (int k0 = 0; k0 < K; k0 += 256) {
            bf16x8 a[16], b[16];
#pragma unroll
            for (int q = 0; q < 16; ++q) { a[q] = *(const bf16x8*)(ap + k0 + 16 * q); b[q] = *(const bf16x8*)(bp + k0 + 16 * q); }
            __builtin_amdgcn_sched_barrier(0);
#pragma unroll
            for (int q = 0; q < 16; ++q) acc = __builtin_amdgcn_mfma_f32_32x32x16_bf16(b[q], a[q], acc, 0, 0, 0);
            __builtin_amdgcn_sched_barrier(0);
        }
        const int row = row0 + rb * 32 + ql;
#pragma unroll
        for (int g = 0; g < 4; ++g) E.store4(row, cb * 32 + 8 * g + 4 * hi, (f32x4){acc[4 * g], acc[4 * g + 1], acc[4 * g + 2], acc[4 * g + 3]});
    }
}
template <class Epi>
__device__ __forceinline__ void gemm_tok(const Ctx& C, const bf16* A, const bf16* Bt, int N, int K, bool with_ctx, const Epi& E) {
#if USE_PG8
    gemm(C, A, Bt, SEQ, N, K, 0, 0, E);
    if (with_ctx) small_gemm(C, A, Bt, SEQ, NCTX, N, K, E);
#else
    naive_gemm(C, A, Bt, with_ctx ? R : SEQ, N, K, 0, 0, E);
#endif
}
template <class Epi>
__device__ __forceinline__ void gemm_moe(const Ctx& C, const bf16* A, const bf16* Bt, int N, int K, size_t grp_stride, bool with_ctx, const Epi& E) {
#if USE_PG8
    pg8::Gemm g{A, Bt, XROWS, N, K, 9, grp_stride}; pg8::MoeOrder S; S.init(N, C.G, C.blk, with_ctx);
    pg8::gemm_phase<Epi, pg8::MoeOrder, true, true>(C.lds, g, S, E);
#else
    naive_gemm(C, A, Bt, XROWS, N, K, 9, grp_stride, E);
#endif
}

template <int KIND>
__device__ __forceinline__ void ph_attn_naive(const Ctx& C, int slot) {
    constexpr int DQK = KIND == 2 ? 96 : 64, DH = DQK / 2;
    LAS float* Ks = (LAS float*)C.lds;
    LAS float* Vs = Ks + 32 * DQK;
    LAS float* Bsm = Vs + 32 * 64;
    const bf16 *Qb, *Kb, *Vb, *KRb = nullptr; int qp, kp, vp, kgrp = 1; size_t qhs, khs, vhs; float scale;
    if (KIND == 0) { Qb = WSP(bf16, WS_QKV); Kb = Qb + (size_t)16 * R * 64; Vb = Qb + (size_t)32 * R * 64; qp = kp = vp = 64; qhs = khs = vhs = (size_t)R * 64; scale = 0.125f; }
    else if (KIND == 1) { Qb = WSP(bf16, WS_QKV); Kb = Qb + (size_t)16 * R * 64; Vb = Qb + (size_t)20 * R * 64; qp = kp = vp = 64; qhs = khs = vhs = (size_t)R * 64; kgrp = 4; scale = 0.125f; }
    else { Qb = WSP(bf16, WS_Q); Kb = WSP(bf16, WS_KV); Vb = Kb + 64; KRb = WSP(bf16, WS_KROPE); qp = 96; kp = vp = 128; qhs = (size_t)R * 96; khs = vhs = (size_t)R * 128; scale = 0.10206207261596575f; }
    bf16* Ob = WSP(bf16, WS_O);
    const int half = C.tid & 1, qi = C.tid >> 1;
    for (int u = C.blk; u < 1040; u += C.G) {
        const bool isctx = u >= 1024;
        const int h = isctx ? (u - 1024) : (u & 15), q0 = isctx ? SEQ : (u >> 4) * 256, kh = h / kgrp;
        const int t = q0 + qi;
        float q[DH], o[32];
        { const bf16* qr = Qb + (size_t)t * qp + h * qhs + half * DH;
#pragma unroll
          for (int d = 0; d < DH; d += 8) { const u32x4 w = *(const u32x4*)(qr + d);
              q[d + 0] = bf2f(w.x & 0xffffu); q[d + 1] = bf2f(w.x >> 16); q[d + 2] = bf2f(w.y & 0xffffu); q[d + 3] = bf2f(w.y >> 16);
              q[d + 4] = bf2f(w.z & 0xffffu); q[d + 5] = bf2f(w.z >> 16); q[d + 6] = bf2f(w.w & 0xffffu); q[d + 7] = bf2f(w.w >> 16); } }
#pragma unroll
        for (int d = 0; d < 32; ++d) o[d] = 0.f;
        float m = -INFINITY, l = 0.f;
        if (KIND == 1) { m = C.in[13][h]; l = 1.f; }
        int klo = 0, khi = 0;
        if (!isctx) {
            if (KIND == 0) { const int r0 = q0 >> 6; const int ra = r0 - 4 < 0 ? 0 : r0 - 4, rb = r0 + 7 > 255 ? 255 : r0 + 7; klo = ra * 64; khi = (rb + 1) * 64; }
            else if (KIND == 1) { klo = q0 - 128 < 0 ? 0 : q0 - 128; khi = q0 + 384 > SEQ ? SEQ : q0 + 384; }
            else { klo = 0; khi = SEQ; }
        }
        if (KIND == 0) { __syncthreads(); const float* rp = C.in[10] + ((size_t)slot * 16 + h) * 465; for (int i = C.tid; i < 465; i += 512) Bsm[i] = rp[i]; }
        const int qr_ = t >> 6, qc_ = t & 63;
        int rs = qr_ - 4; rs = rs < 0 ? 0 : (rs > 248 ? 248 : rs);
        int cs0 = qc_ - 8; cs0 = cs0 < 0 ? 0 : (cs0 > 48 ? 48 : cs0);
        for (int seg = 0; seg < 2; ++seg) {
            const int kb = seg == 0 ? klo : SEQ, ke = seg == 0 ? khi : R;
            for (int k0 = kb; k0 < ke; k0 += 32) {
                __syncthreads();
                for (int i = C.tid; i < 32 * DQK; i += 512) { const int j = i / DQK, d = i % DQK; const int row = k0 + j;
                    unsigned b;
                    if (KIND == 2 && d >= 64) b = KRb[(size_t)row * 32 + (d - 64)]; else b = Kb[(size_t)row * kp + kh * khs + d];
                    Ks[i] = bf2f(b); }
                for (int i = C.tid; i < 32 * 64; i += 512) { const int j = i >> 6, d = i & 63; Vs[i] = bf2f(Vb[(size_t)(k0 + j) * vp + kh * vhs + d]); }
                __syncthreads();
#pragma unroll 1
                for (int j = 0; j < 32; ++j) {
                    const int kt = k0 + j; bool valid = true; float bias = 0.f;
                    if (seg == 0) {
                        if (KIND == 0) { const int kr = kt >> 6, kc = kt & 63; valid = kr >= rs && kr < rs + 8 && kc >= cs0 && kc < cs0 + 16;
                            if (valid) bias = Bsm[(kr - qr_ + 7) * 31 + (kc - qc_ + 15)]; }
                        else if (KIND == 1) { const int dd = kt - t; valid = dd <= 128 && dd >= -128; }
                    }
                    float s0 = 0.f, s1 = 0.f;
#pragma unroll
                    for (int d = 0; d < DH; d += 4) { const f32x4 kv = *(const LAS f32x4*)(Ks + j * DQK + half * DH + d); s0 += q[d] * kv.x + q[d + 2] * kv.z; s1 += q[d + 1] * kv.y + q[d + 3] * kv.w; }
                    float sp = s0 + s1; sp += __shfl_xor(sp, 1);
                    if (valid) {
                        const float s = sp * scale + bias;
                        if (s > m) { const float a = __expf(m - s); l *= a;
#pragma unroll
                            for (int d = 0; d < 32; ++d) o[d] *= a;
                            m = s; }
                        const float p = __expf(s - m); l += p;
#pragma unroll
                        for (int d = 0; d < 32; d += 4) { const f32x4 vv = *(const LAS f32x4*)(Vs + j * 64 + half * 32 + d); o[d] += p * vv.x; o[d + 1] += p * vv.y; o[d + 2] += p * vv.z; o[d + 3] += p * vv.w; }
                    }
                }
            }
        }
        { const float il = 1.f / l; bf16* orow = Ob + (size_t)t * D + h * 64 + half * 32;
#pragma unroll
            for (int d = 0; d < 32; d += 8) { u32x4 w; w.x = pk2(o[d] * il, o[d + 1] * il); w.y = pk2(o[d + 2] * il, o[d + 3] * il); w.z = pk2(o[d + 4] * il, o[d + 5] * il); w.w = pk2(o[d + 6] * il, o[d + 7] * il);
                *(u32x4*)(orow + d) = w; } }
    }
    __syncthreads();
}

#ifndef USE_FAST_ATTN
#define USE_FAST_ATTN 1
#endif
__device__ __forceinline__ s16x4 lds_tr16(const LAS unsigned char* p) { return __builtin_bit_cast(s16x4, __builtin_amdgcn_ds_read_tr16_b64_v4i16((LAS s16x4*)p)); }
__device__ __forceinline__ int crow(int r, int hi) { return (r & 3) + 8 * (r >> 2) + 4 * hi; }

#define ATT_BAR() do { __builtin_amdgcn_sched_barrier(0); asm volatile("s_waitcnt lgkmcnt(0)\n\ts_barrier" ::: "memory"); __builtin_amdgcn_sched_barrier(0); } while (0)
template <int KIND>
__device__ __forceinline__ void ph_attn_fast(const Ctx& C, int slot) {
    constexpr int DQK = KIND == 2 ? 96 : 64, NS = DQK / 16, CPR = DQK / 8, CPRP = CPR + 1;
    constexpr int KS = CPRP * 16, VS = 192, KBYTES = 64 * KS, VBYTES = 64 * VS, SLOTB = KBYTES + VBYTES;
    constexpr int NKC = 64 * CPRP, NINST = (NKC + 64 * 12) / 64, NDMA = (NINST + 7) / 8, NRING = 4, PD = 3;
    static_assert(NKC % 64 == 0 && SLOTB % 1024 == 0 && NRING * SLOTB + 2048 <= 131072, "attention ring geometry");
    LAS unsigned char* lds = C.lds; const unsigned lds_u32 = (unsigned)(size_t)C.lds;
    LAS float* Bsm = (LAS float*)(lds + NRING * SLOTB);
    const bf16 *Qb, *Kb, *Vb, *KRb = nullptr; int qp, kp, vp, kgrp = 1; size_t qhs, khs, vhs; float scale;
    if (KIND == 0) { Qb = WSP(bf16, WS_QKV); Kb = Qb + (size_t)16 * R * 64; Vb = Qb + (size_t)32 * R * 64; qp = kp = vp = 64; qhs = khs = vhs = (size_t)R * 64; scale = 0.125f; }
    else if (KIND == 1) { Qb = WSP(bf16, WS_QKV); Kb = Qb + (size_t)16 * R * 64; Vb = Qb + (size_t)20 * R * 64; qp = kp = vp = 64; qhs = khs = vhs = (size_t)R * 64; kgrp = 4; scale = 0.125f; }
    else { Qb = WSP(bf16, WS_Q); Kb = WSP(bf16, WS_KV); Vb = Kb + 64; KRb = WSP(bf16, WS_KROPE); qp = 96; kp = vp = 128; qhs = (size_t)R * 96; khs = vhs = (size_t)R * 128; scale = 0.10206207261596575f; }
    bf16* Ob = WSP(bf16, WS_O);
    const float c2 = scale * 1.4426950408889634f;
    const int w = C.wave, lane = C.lane, ql = lane & 31, hi = lane >> 5;
    const int vlane = (((lane & 15) >> 2) + 4 * hi) * VS + (16 * ((lane >> 4) & 1) + 4 * (lane & 3)) * 2;
    for (int u = C.blk; u < 1040; u += C.G) {
        const bool isctx = u >= 1024;
        const int h = isctx ? (u - 1024) : (u & 15), q0 = isctx ? SEQ : (u >> 4) * 256, kh = h / kgrp;
        int lat0 = 0, nlat = 0;
        if (!isctx) {
            if (KIND == 0) { const int r0 = q0 >> 6; int ta = r0 - 4; ta = ta < 0 ? 0 : (ta > 248 ? 248 : ta); int tb = r0 - 1; tb = (tb < 0 ? 0 : (tb > 248 ? 248 : tb)) + 7; lat0 = ta; nlat = tb - ta + 1; }
            else if (KIND == 1) { const int a = q0 - 128 < 0 ? 0 : q0 - 128, b = q0 + 384 > SEQ ? SEQ : q0 + 384; lat0 = a >> 6; nlat = (b - a) >> 6; }
            else { lat0 = 0; nlat = SEQ / 64; }
        }
        const int ntiles = nlat + 4;
        const int t = q0 + 32 * w + ql;
        bf16x8 qf[NS];
        { const bf16* qr = Qb + (size_t)t * qp + h * qhs + 8 * hi;
#pragma unroll
          for (int sidx = 0; sidx < NS; ++sidx) qf[sidx] = *(const bf16x8*)(qr + 16 * sidx); }
        const char* gsrc[NDMA]; int gpitch[NDMA], ldst[NDMA];
#pragma unroll
        for (int jj = 0; jj < NDMA; ++jj) {
            int j = w + 8 * jj; if (j >= NINST) j -= 8;
            const int cidx = 64 * j + lane; ldst[jj] = j * 1024;
            if (cidx < NKC) { const int row = cidx / CPRP; int c = cidx % CPRP; if (c >= CPR) c = 0;
                if (KIND == 2 && c >= 8) { gsrc[jj] = (const char*)(KRb + (size_t)row * 32 + 8 * (c - 8)); gpitch[jj] = 64; }
                else { gsrc[jj] = (const char*)(Kb + kh * khs + (size_t)row * kp + 8 * c); gpitch[jj] = kp * 2; } }
            else { const int v = cidx - NKC, row = v / 12; int c = v % 12; if (c >= 8) c = 0;
                gsrc[jj] = (const char*)(Vb + kh * vhs + (size_t)row * vp + 8 * c); gpitch[jj] = vp * 2; }
        }
#define ATT_KEY0(i) ((i) < nlat ? (lat0 + (i)) * 64 : SEQ + ((i) - nlat) * 64)
#define ATT_DMA(i, sl) do { const int ti_ = (i) < ntiles ? (i) : ntiles - 1; const size_t key0_ = (size_t)ATT_KEY0(ti_); \
        _Pragma("unroll") for (int jj = 0; jj < NDMA; ++jj) \
            __builtin_amdgcn_global_load_lds((const unsigned*)(gsrc[jj] + key0_ * gpitch[jj]), (LAS unsigned*)(lds + (sl) * SLOTB + ldst[jj]), 16, 0, 0); } while (0)
#define ATT_WAIT_DMA() do { if (NDMA == 4) asm volatile("s_waitcnt vmcnt(8)" ::: "memory"); else asm volatile("s_waitcnt vmcnt(6)" ::: "memory"); } while (0)
        __syncthreads();
        if (KIND == 0) { const float* rp = C.in[10] + ((size_t)slot * 16 + h) * 465; for (int i = C.tid; i < 465; i += 512) Bsm[i] = rp[i] * 1.4426950408889634f; }
        asm volatile("s_waitcnt vmcnt(0)" ::: "memory");
        ATT_DMA(0, 0); ATT_DMA(1, 1); ATT_DMA(2, 2);
        float m = -INFINITY, l = 0.f;
        if (KIND == 1) { m = C.in[13][h] * 1.4426950408889634f; l = hi ? 0.f : 1.f; }
        f32x16 ot[2];
#pragma unroll
        for (int r = 0; r < 16; ++r) { ot[0][r] = 0.f; ot[1][r] = 0.f; }
        const int qr_ = t >> 6, qc_ = t & 63;
        int cs0 = qc_ - 8; cs0 = cs0 < 0 ? 0 : (cs0 > 48 ? 48 : cs0);
        const int wrow = (q0 >> 6) + (w >> 1);
        int wrs = wrow - 4; wrs = wrs < 0 ? 0 : (wrs > 248 ? 248 : wrs);
        const int wq0 = q0 + 32 * w;
        if constexpr (KIND == 2) {
            { float qs = 0.f;
#pragma unroll
              for (int sidx = 0; sidx < NS; ++sidx)
#pragma unroll
                  for (int j = 0; j < 8; ++j) { const float qv = bf2f((unsigned)(unsigned short)qf[sidx][j]); qs += qv * qv; }
              const auto sw = __builtin_amdgcn_permlane32_swap(__float_as_uint(qs), __float_as_uint(qs), false, false);
              qs = __uint_as_float(sw[0]) + __uint_as_float(sw[1]);
              const float k2 = __uint_as_float(__hip_atomic_load((unsigned*)(C.ws + WS_CTL) + CW_KMAX + h, __ATOMIC_RELAXED, __HIP_MEMORY_SCOPE_AGENT));
              m = c2 * sqrtf(qs * k2) * 1.001f + 0.01f; }
            asm volatile("s_waitcnt vmcnt(4)" ::: "memory");
            ATT_BAR();
            f32x16 pa0, pa1, pb0, pb1;
#define MLA_QK(D0, D1, sl) do { const LAS unsigned char* kb_ = lds + (sl) * SLOTB; \
            _Pragma("unroll") for (int r_ = 0; r_ < 16; ++r_) { D0[r_] = 0.f; D1[r_] = 0.f; } \
            _Pragma("unroll") for (int sidx = 0; sidx < NS; ++sidx) { \
                const bf16x8 a0_ = *(const LAS bf16x8*)(kb_ + ql * KS + 32 * sidx + 16 * hi); \
                const bf16x8 a1_ = *(const LAS bf16x8*)(kb_ + (32 + ql) * KS + 32 * sidx + 16 * hi); \
                D0 = __builtin_amdgcn_mfma_f32_32x32x16_bf16(a0_, qf[sidx], D0, 0, 0, 0); \
                D1 = __builtin_amdgcn_mfma_f32_32x32x16_bf16(a1_, qf[sidx], D1, 0, 0, 0); } } while (0)
#define MLA_ITER(P0, P1, S0, S1, it) do { \
            ATT_DMA((it) + 3, ((it) + 3) & 3); \
            MLA_QK(S0, S1, ((it) + 1) & 3);                                     \
            float rs0_ = 0.f, rs1_ = 0.f, rs2_ = 0.f, rs3_ = 0.f;                  \
            _Pragma("unroll") for (int r_ = 0; r_ < 16; r_ += 2) { \
                P0[r_] = __builtin_amdgcn_exp2f(__builtin_fmaf(P0[r_], c2, -m)); P1[r_] = __builtin_amdgcn_exp2f(__builtin_fmaf(P1[r_], c2, -m)); \
                P0[r_ + 1] = __builtin_amdgcn_exp2f(__builtin_fmaf(P0[r_ + 1], c2, -m)); P1[r_ + 1] = __builtin_amdgcn_exp2f(__builtin_fmaf(P1[r_ + 1], c2, -m)); \
                rs0_ += P0[r_]; rs1_ += P1[r_]; rs2_ += P0[r_ + 1]; rs3_ += P1[r_ + 1]; } \
            l += (rs0_ + rs1_) + (rs2_ + rs3_); \
            bf16x8 pf_[4]; \
            _Pragma("unroll") for (int ks = 0; ks < 2; ++ks) { u32x4 pw_; \
                pw_.x = cvt_pk_bf16(P0[8 * ks + 0], P0[8 * ks + 1]); pw_.y = cvt_pk_bf16(P0[8 * ks + 2], P0[8 * ks + 3]); pw_.z = cvt_pk_bf16(P0[8 * ks + 4], P0[8 * ks + 5]); pw_.w = cvt_pk_bf16(P0[8 * ks + 6], P0[8 * ks + 7]); \
                pf_[ks] = __builtin_bit_cast(bf16x8, pw_); \
                pw_.x = cvt_pk_bf16(P1[8 * ks + 0], P1[8 * ks + 1]); pw_.y = cvt_pk_bf16(P1[8 * ks + 2], P1[8 * ks + 3]); pw_.z = cvt_pk_bf16(P1[8 * ks + 4], P1[8 * ks + 5]); pw_.w = cvt_pk_bf16(P1[8 * ks + 6], P1[8 * ks + 7]); \
                pf_[2 + ks] = __builtin_bit_cast(bf16x8, pw_); } \
            __builtin_amdgcn_sched_group_barrier(0x100, 4, 0); \
            _Pragma("unroll") for (int g_ = 0; g_ < 12; ++g_) { __builtin_amdgcn_sched_group_barrier(0x008, 1, 0); __builtin_amdgcn_sched_group_barrier(0x100, 2, 0); __builtin_amdgcn_sched_group_barrier(0x002, 13, 0); } \
            { const unsigned va_ = lds_u32 + (unsigned)(((it) & 3) * SLOTB + KBYTES + vlane); \
              _Pragma("unroll") for (int c = 0; c < 2; ++c) { \
                s16x4 lo_[4], hi_[4]; \
                _Pragma("unroll") for (int ks = 0; ks < 4; ++ks) { \
                    asm volatile("ds_read_b64_tr_b16 %0, %1 offset:%c2" : "=&v"(lo_[ks]) : "v"(va_), "i"((32 * (ks >> 1) + 16 * (ks & 1)) * VS + 64 * c) : "memory"); \
                    asm volatile("ds_read_b64_tr_b16 %0, %1 offset:%c2" : "=&v"(hi_[ks]) : "v"(va_), "i"((32 * (ks >> 1) + 16 * (ks & 1) + 8) * VS + 64 * c) : "memory"); } \
                asm volatile("s_waitcnt lgkmcnt(0)" ::: "memory"); __builtin_amdgcn_sched_barrier(0); \
                _Pragma("unroll") for (int ks = 0; ks < 4; ++ks) { \
                    const bf16x8 av_ = (bf16x8){lo_[ks][0], lo_[ks][1], lo_[ks][2], lo_[ks][3], hi_[ks][0], hi_[ks][1], hi_[ks][2], hi_[ks][3]}; \
                    ot[c] = __builtin_amdgcn_mfma_f32_32x32x16_bf16(av_, pf_[ks], ot[c], 0, 0, 0); } } } \
            asm volatile("s_waitcnt vmcnt(4)" ::: "memory");          \
            ATT_BAR(); } while (0)
            MLA_QK(pa0, pa1, 0);
            for (int i = 0; i < ntiles; i += 2) {
                MLA_ITER(pa0, pa1, pb0, pb1, i);
                MLA_ITER(pb0, pb1, pa0, pa1, i + 1);
            }
#undef MLA_QK
#undef MLA_ITER
        } else {
        ATT_WAIT_DMA();
        ATT_BAR();
        int rs_cur = 0, rs_nxt = 3;
        for (int i = 0; i < ntiles; ++i) {
            ATT_DMA(i + PD, rs_nxt);
            const bool lat = i < nlat; const int key0 = ATT_KEY0(i);
            bool need = true;
            if (lat) { if (KIND == 0) { const int kr = lat0 + i; need = kr >= wrs && kr < wrs + 8; }
                       else if (KIND == 1) need = (key0 + 63 >= wq0 - 128) && (key0 <= wq0 + 31 + 128); }
            if (need) {
                const LAS unsigned char* kb = lds + rs_cur * SLOTB; const LAS unsigned char* vb = kb + KBYTES;
                f32x16 p0, p1;
#pragma unroll
                for (int r = 0; r < 16; ++r) { p0[r] = 0.f; p1[r] = 0.f; }
#pragma unroll
                for (int sidx = 0; sidx < NS; ++sidx) {
                    const bf16x8 a0 = *(const LAS bf16x8*)(kb + ql * KS + 32 * sidx + 16 * hi);
                    const bf16x8 a1 = *(const LAS bf16x8*)(kb + (32 + ql) * KS + 32 * sidx + 16 * hi);
                    p0 = __builtin_amdgcn_mfma_f32_32x32x16_bf16(a0, qf[sidx], p0, 0, 0, 0);
                    p1 = __builtin_amdgcn_mfma_f32_32x32x16_bf16(a1, qf[sidx], p1, 0, 0, 0);
                }
                float mx = -INFINITY;
                if (KIND == 0) {
#pragma unroll
                    for (int r = 0; r < 16; ++r) {
                        float s0 = p0[r] * c2, s1 = p1[r] * c2;
                        if (lat) { const int kr = lat0 + i; const int kc = crow(r, hi);
                            const bool v0 = (unsigned)(kc - cs0) < 16u, v1 = (unsigned)(kc + 32 - cs0) < 16u;
                            const int bi = (kr - qr_ + 7) * 31 + (kc - qc_ + 15);
                            s0 = v0 ? s0 + Bsm[v0 ? bi : 0] : -INFINITY; s1 = v1 ? s1 + Bsm[v1 ? bi + 32 : 0] : -INFINITY; }
                        p0[r] = s0; p1[r] = s1; mx = fmaxf(fmaxf(mx, s0), s1);
                    }
                } else {
                    if (KIND == 1 && lat) {
#pragma unroll
                        for (int r = 0; r < 16; ++r) { const int dd = key0 + crow(r, hi) - t;
                            p0[r] = (unsigned)(dd + 128) <= 256u ? p0[r] : -INFINITY; p1[r] = (unsigned)(dd + 32 + 128) <= 256u ? p1[r] : -INFINITY; }
                    }
#pragma unroll
                    for (int r = 0; r < 16; ++r) mx = fmaxf(fmaxf(mx, p0[r]), p1[r]);
                    mx *= c2;
                }
                { const auto sw = __builtin_amdgcn_permlane32_swap(__float_as_uint(mx), __float_as_uint(mx), false, false);
                  mx = fmaxf(__uint_as_float(sw[0]), __uint_as_float(sw[1])); }
                const float mn = fmaxf(m, mx), ms = mn == -INFINITY ? 0.f : mn;
                const float alpha = __builtin_amdgcn_exp2f(m - ms);
                float rsum = 0.f;
                if (KIND == 0) {
#pragma unroll
                    for (int r = 0; r < 16; ++r) { p0[r] = __builtin_amdgcn_exp2f(p0[r] - ms); p1[r] = __builtin_amdgcn_exp2f(p1[r] - ms); rsum += p0[r] + p1[r]; }
                } else {
#pragma unroll
                    for (int r = 0; r < 16; ++r) { p0[r] = __builtin_amdgcn_exp2f(__builtin_fmaf(p0[r], c2, -ms)); p1[r] = __builtin_amdgcn_exp2f(__builtin_fmaf(p1[r], c2, -ms)); rsum += p0[r] + p1[r]; }
                }
                l = l * alpha + rsum; m = mn;
                if (__builtin_amdgcn_ballot_w64(alpha != 1.f) != 0ull) {
#pragma unroll
                    for (int r = 0; r < 16; ++r) { ot[0][r] *= alpha; ot[1][r] *= alpha; }
                }
                bf16x8 pf[4];
#pragma unroll
                for (int ks = 0; ks < 4; ++ks) { u32x4 pw;
                    if (ks < 2) { pw.x = cvt_pk_bf16(p0[8 * ks + 0], p0[8 * ks + 1]); pw.y = cvt_pk_bf16(p0[8 * ks + 2], p0[8 * ks + 3]); pw.z = cvt_pk_bf16(p0[8 * ks + 4], p0[8 * ks + 5]); pw.w = cvt_pk_bf16(p0[8 * ks + 6], p0[8 * ks + 7]); }
                    else { const int k8 = 8 * (ks - 2); pw.x = cvt_pk_bf16(p1[k8 + 0], p1[k8 + 1]); pw.y = cvt_pk_bf16(p1[k8 + 2], p1[k8 + 3]); pw.z = cvt_pk_bf16(p1[k8 + 4], p1[k8 + 5]); pw.w = cvt_pk_bf16(p1[k8 + 6], p1[k8 + 7]); }
                    pf[ks] = __builtin_bit_cast(bf16x8, pw); }
                { const unsigned va = lds_u32 + (unsigned)(rs_cur * SLOTB + KBYTES + vlane);
#pragma unroll
                  for (int c = 0; c < 2; ++c) {
                    s16x4 lo[4], hi4[4];
#pragma unroll
                    for (int ks = 0; ks < 4; ++ks) {
                        asm volatile("ds_read_b64_tr_b16 %0, %1 offset:%c2" : "=&v"(lo[ks]) : "v"(va), "i"((32 * (ks >> 1) + 16 * (ks & 1)) * VS + 64 * c) : "memory");
                        asm volatile("ds_read_b64_tr_b16 %0, %1 offset:%c2" : "=&v"(hi4[ks]) : "v"(va), "i"((32 * (ks >> 1) + 16 * (ks & 1) + 8) * VS + 64 * c) : "memory"); }
                    asm volatile("s_waitcnt lgkmcnt(0)" ::: "memory"); __builtin_amdgcn_sched_barrier(0);
#pragma unroll
                    for (int ks = 0; ks < 4; ++ks) {
                        const bf16x8 av = (bf16x8){lo[ks][0], lo[ks][1], lo[ks][2], lo[ks][3], hi4[ks][0], hi4[ks][1], hi4[ks][2], hi4[ks][3]};
                        ot[c] = __builtin_amdgcn_mfma_f32_32x32x16_bf16(av, pf[ks], ot[c], 0, 0, 0); }
                  } }
            }
            ATT_WAIT_DMA();
            ATT_BAR();
            rs_cur = (rs_cur + 1) & 3; rs_nxt = (rs_nxt + 1) & 3;
        }
        }
        asm volatile("s_waitcnt vmcnt(0)" ::: "memory");
#undef ATT_KEY0
#undef ATT_DMA
#undef ATT_WAIT_DMA
        { const auto sw = __builtin_amdgcn_permlane32_swap(__float_as_uint(l), __float_as_uint(l), false, false);
          const float il = 1.f / (__uint_as_float(sw[0]) + __uint_as_float(sw[1])); bf16* orow = Ob + (size_t)t * D + h * 64 + 4 * hi;
#pragma unroll
          for (int c = 0; c < 2; ++c)
#pragma unroll
            for (int g = 0; g < 4; ++g) { u32x2 o2; o2.x = cvt_pk_bf16(ot[c][4 * g] * il, ot[c][4 * g + 1] * il); o2.y = cvt_pk_bf16(ot[c][4 * g + 2] * il, ot[c][4 * g + 3] * il);
                *(u32x2*)(orow + 32 * c + 8 * g) = o2; } }
    }
    __syncthreads();
}
template <int KIND>
__device__ __forceinline__ void ph_attn(const Ctx& C, int slot) {
#if USE_FAST_ATTN
    ph_attn_fast<KIND>(C, slot);
#else
    ph_attn_naive<KIND>(C, slot);
#endif
}

#define PH_BEGIN if (lo <= ph && ph < hi) {
#define PH_END   if (ph + 1 < hi) xcd_barrier(bar); } ++ph;
#ifndef PROBE_MASK
#define PROBE_MASK 0
#endif
#define PHG(g, ...) PH_BEGIN __VA_ARGS__ PH_END if constexpr (((PROBE_MASK >> (g)) & 1) != 0) { PH_BEGIN __VA_ARGS__ PH_END }
template <int L>
__device__ __forceinline__ void layer_phases(const Ctx& C, const XcdBarrier& bar, int lo, int hi, int& ph) {
    constexpr int l = L, kind = L % 3, slot = L / 3; constexpr bool need_ctx = L < 3; constexpr int RL = need_ctx ? R : SEQ;
    PH_BEGIN ph_rowA<0>(C, l); PH_END
    if constexpr (kind == 0) {
        PHG(1, gemm_tok(C, WSP(bf16, WS_H), WSP(bf16, WS_W_NAQKV) + (size_t)slot * 3072 * 1024, 3072, 1024, true, EpiStoreHeads{WSP(bf16, WS_QKV), 64, (size_t)R * 64});)
        PHG(2, ph_attn<0>(C, slot);)
    } else if constexpr (kind == 1) {
        PHG(1, gemm_tok(C, WSP(bf16, WS_H), WSP(bf16, WS_W_SWAQKV), 1536, 1024, true, EpiStoreHeads{WSP(bf16, WS_QKV), 64, (size_t)R * 64});)
        PH_BEGIN ph_rope(C, WSP(bf16, WS_QKV), 64, 20, 0, 16); PH_END
        PHG(3, ph_attn<1>(C, slot);)
    } else {
        PHG(1, gemm_tok(C, WSP(bf16, WS_H), WSP(bf16, WS_W_MLAD), 1024, 1024, true, EpiStoreF32{WSP(float, WS_CQ), 1024});)
        PHG(11, ph_mlanorm(C);)
        PHG(1, gemm_tok(C, WSP(bf16, WS_CQN), WSP(bf16, WS_W_MLAUQ), 1536, 512, true, EpiStoreHeads{WSP(bf16, WS_Q), 96, (size_t)R * 96});
                 gemm_tok(C, WSP(bf16, WS_CKVN), WSP(bf16, WS_W_MLAUKV), 2048, 256, true, EpiStoreHeads{WSP(bf16, WS_KV), 128, (size_t)R * 128});)
        PH_BEGIN ph_rope(C, WSP(bf16, WS_Q), 96, 16, 64, 8); ph_kmax(C); PH_END
        PHG(4, ph_attn<2>(C, slot);)
    }
    const bf16* wo = kind == 0 ? WSP(bf16, WS_W_NAO) + (size_t)slot * 1024 * 1024 : (kind == 1 ? WSP(bf16, WS_W_SWAO) : WSP(bf16, WS_W_MLAO));
    PH_BEGIN gemm_tok(C, WSP(bf16, WS_O), wo, 1024, 1024, need_ctx, EpiResid{WSP(float, WS_X), modp(C, l, 0, 2), modp(C, l, 1, 2)}); PH_END
    PHG(5, ph_norm2(C, l, RL);)
    PHG(6, ph_topk(C, need_ctx);)
    PHG(7, ph_gather(C, need_ctx);)
    PHG(8, gemm_moe(C, WSP(bf16, WS_XG), WSP(bf16, WS_W_GU) + (size_t)l * 16 * 4096 * 1024, 4096, 1024, (size_t)4096 * 1024, need_ctx, EpiSwiglu{WSP(bf16, WS_ACT)});)
    PHG(9, gemm_moe(C, WSP(bf16, WS_ACT), WSP(bf16, WS_W_DN) + (size_t)l * 16 * 1024 * 2048, 1024, 2048, (size_t)1024 * 2048, need_ctx, EpiMoeOut{WSP(bf16, WS_YB), WSP(float, WS_GATEL)});)
}
__global__ void __launch_bounds__(512, 2) fwd_kernel(Args args) {
    extern __shared__ __attribute__((aligned(16))) unsigned char lds_raw[];
    Ctx C;
#pragma unroll
    for (int i = 0; i < 26; ++i) C.in[i] = args.in[i];
    C.out = args.out; C.ws = args.ws; C.lds = (LAS unsigned char*)lds_raw;
    C.tid = threadIdx.x; C.lane = C.tid & 63; C.wave = __builtin_amdgcn_readfirstlane(C.tid >> 6); C.blk = blockIdx.x; C.G = gridDim.x;
    volatile LAS unsigned* MISC = (volatile LAS unsigned*)(C.lds + MISC_OFF);
    if (C.tid < 32) MISC[C.tid] = 0u;
    __syncthreads();
    const int lo = args.ph_lo, hi = args.ph_hi;
    XcdBarrier bar; bar.bar = (unsigned*)(C.ws + WS_CTL) + CW_BAR; bar.x = 0; bar.st = nullptr;
    if (hi - lo > 1) bar = xcd_barrier_post((unsigned*)(C.ws + WS_CTL) + CW_BAR, MISC + 8);
    int ph = 0;
    PHG(0, ph_prologue(C);)
    layer_phases<0>(C, bar, lo, hi, ph);
    layer_phases<1>(C, bar, lo, hi, ph);
    layer_phases<2>(C, bar, lo, hi, ph);
    layer_phases<3>(C, bar, lo, hi, ph);
    PH_BEGIN ph_rowA<1>(C, 4); PH_END
}
#undef PH_BEGIN
#undef PH_END

extern "C" void kernel_launch(void* const* d_in, const int* in_sizes, int n_in, void* d_out, int out_size, void* d_ws, size_t ws_size, hipStream_t stream) {
    static int grid = 0;
    if (grid == 0) {
        if (n_in != 26 || out_size != SEQ * D || ws_size < WS_END) { fprintf(stderr, "kernel_launch: unexpected shapes (n_in %d out %d ws %zu)\n", n_in, out_size, ws_size); grid = -1; return; }
        int dev = 0, cus = 0, per_cu = 0;
        if (hipGetDevice(&dev) != hipSuccess || hipDeviceGetAttribute(&cus, hipDeviceAttributeMultiprocessorCount, dev) != hipSuccess) { grid = -1; return; }
        if (hipFuncSetAttribute((const void*)fwd_kernel, hipFuncAttributeMaxDynamicSharedMemorySize, LDS_BYTES) != hipSuccess) { fprintf(stderr, "kernel_launch: hipFuncSetAttribute failed\n"); grid = -1; return; }
        if (hipOccupancyMaxActiveBlocksPerMultiprocessor(&per_cu, (const void*)fwd_kernel, 512, LDS_BYTES) != hipSuccess || per_cu < 1) fprintf(stderr, "kernel_launch: occupancy query says %d\n", per_cu);
        (void)hipGetLastError();
        grid = cus;
    }
    if (grid < 0) return;
    if (hipMemsetAsync((char*)d_ws + WS_CTL, 0, CTL_ZERO_BYTES, stream) != hipSuccess) return;
    Args a{};
    for (int i = 0; i < 26; ++i) a.in[i] = (const float*)d_in[i];
    a.out = (float*)d_out; a.ws = (unsigned char*)d_ws; a.pad = 0;
#if MK_N_LAUNCHES == 1
    a.ph_lo = 0; a.ph_hi = 1 << 20; a.li = 0;
    hipLaunchKernelGGL(fwd_kernel, dim3(grid), dim3(512), LDS_BYTES, stream, a);
#else
    for (int li = 0; li < NPH; ++li) { a.ph_lo = li; a.ph_hi = li + 1; a.li = li;
        hipLaunchKernelGGL(fwd_kernel, dim3(grid), dim3(512), LDS_BYTES, stream, a); }
#endif
}
```

```cpp
#include <hip/hip_runtime.h>
#include <cstdio>
#include <cstdint>

#ifndef MK_N_LAUNCHES
#define MK_N_LAUNCHES 1
#endif

#define GAS __attribute__((address_space(1)))
#define LAS __attribute__((address_space(3)))
typedef unsigned short bf16;
typedef float f32x4 __attribute__((ext_vector_type(4)));
typedef unsigned u32x4 __attribute__((ext_vector_type(4)));
typedef unsigned u32x2 __attribute__((ext_vector_type(2)));
typedef short bf16x8 __attribute__((ext_vector_type(8)));
typedef short s16x4 __attribute__((ext_vector_type(4)));
typedef float f32x16 __attribute__((ext_vector_type(16)));

constexpr int D = 1024, SEQ = 16384, NCTX = 256, R = SEQ + NCTX, NE = 16, FF = 2048;
constexpr int CAP_L = 2048, CAP_C = 32, EROWS = 2304, XROWS = NE * EROWS;
constexpr float RMS_EPS = 1e-6f;
constexpr int NPH = 1 + 9 + 10 + 12 + 9 + 1;

constexpr size_t MiB = 1u << 20;
constexpr size_t WS_CTL = 0, CTL_ZERO_BYTES = 1 * MiB;
constexpr size_t WS_MOD = 1 * MiB;
constexpr size_t WS_W_NAQKV = 2 * MiB;
constexpr size_t WS_W_NAO = 14 * MiB;
constexpr size_t WS_W_SWAQKV = 18 * MiB;
constexpr size_t WS_W_SWAO = 21 * MiB;
constexpr size_t WS_W_MLAD = 23 * MiB;
constexpr size_t WS_W_MLAUQ = 25 * MiB;
constexpr size_t WS_W_MLAUKV = 27 * MiB;
constexpr size_t WS_W_MLAO = 28 * MiB;
constexpr size_t WS_W_GU = 32 * MiB;
constexpr size_t WS_W_DN = WS_W_GU + 512 * MiB;
constexpr size_t WS_X = WS_W_DN + 256 * MiB;
constexpr size_t WS_H = WS_X + 65 * MiB;
constexpr size_t WS_QKV = WS_H + 33 * MiB;
constexpr size_t WS_CQ = WS_QKV + 98 * MiB;
constexpr size_t WS_Q = WS_CQ + 65 * MiB;
constexpr size_t WS_KV = WS_Q + 49 * MiB;
constexpr size_t WS_CQN = WS_KV + 65 * MiB;
constexpr size_t WS_CKVN = WS_CQN + 17 * MiB;
constexpr size_t WS_KROPE = WS_CKVN + 9 * MiB;
constexpr size_t WS_O = WS_KROPE + 2 * MiB;
constexpr size_t WS_AFF = WS_O + 33 * MiB;
constexpr size_t WS_ROWL = WS_AFF + 2 * MiB;
constexpr size_t WS_GATEL = WS_ROWL + 1 * MiB;
constexpr size_t WS_INV = WS_GATEL + 1 * MiB;
constexpr size_t WS_XG = WS_INV + 2 * MiB;
constexpr size_t WS_ACT = WS_XG + 72 * MiB;
constexpr size_t WS_YB = WS_ACT + 144 * MiB;
constexpr size_t WS_END = WS_YB + 72 * MiB;
static_assert(WS_END <= 2048 * MiB, "d_ws map");
constexpr int CW_BAR = 4096;

constexpr int LDS_BYTES = 147456;
constexpr int MISC_OFF = 131072 + 320;

__device__ __forceinline__ float bf2f(unsigned b) { return __uint_as_float(b << 16); }
__device__ __forceinline__ unsigned f2bf(float f) { unsigned u = __float_as_uint(f); return (u + 0x7fffu + ((u >> 16) & 1u)) >> 16; }
__device__ __forceinline__ unsigned pk2(float lo, float hi) { return f2bf(lo) | (f2bf(hi) << 16); }
__device__ __forceinline__ float wave_sum(float v) {
#pragma unroll
    for (int o = 1; o < 64; o <<= 1) v += __shfl_xor(v, o);
    return v;
}
__device__ __forceinline__ int wave_sum_i(int v) {
#pragma unroll
    for (int o = 1; o < 64; o <<= 1) v += __shfl_xor(v, o);
    return v;
}

#define XB_TMO      128
#define XB_XCNT(j)  (256  + 64 * (j))
#define XB_XSUB(j)  (1280 + 64 * (j))
#define XB_XGEN(j)  (2304 + 64 * (j))
#define XB_TOP      3328
#define XB_TOPGEN   3392
#define XCD_BAR_WORDS 3456
#define XB_SPIN_CAP (1u << 18)
__device__ __forceinline__ unsigned xb_ld(unsigned* p)              { return __hip_atomic_load(p, __ATOMIC_RELAXED, __HIP_MEMORY_SCOPE_AGENT); }
__device__ __forceinline__ unsigned xb_add(unsigned* p, unsigned v) { return __hip_atomic_fetch_add(p, v, __ATOMIC_RELAXED, __HIP_MEMORY_SCOPE_AGENT); }
__device__ __forceinline__ unsigned xb_xcc_id() { return (unsigned)__builtin_amdgcn_s_getreg((3 << 11) | 20) & 0xFu; }
#define XB_SPIN(cond, bar) do { unsigned _sp = 0; while (cond) { __builtin_amdgcn_s_sleep(1); \
    if ((++_sp & 255u) == 0u) { if (xb_ld(&(bar)[XB_TMO])) break; if (_sp > XB_SPIN_CAP) { atomicAdd(&(bar)[XB_TMO], 1u); break; } } } } while (0)
struct XcdBarrier { unsigned* bar; unsigned x; volatile LAS unsigned* st; };
__device__ __forceinline__ XcdBarrier xcd_barrier_post(unsigned* bar, volatile LAS unsigned* st) {
    XcdBarrier b; b.bar = bar; b.x = xb_xcc_id(); b.st = st;
    if (threadIdx.x == 0) (void)xb_add(&bar[XB_XCNT(b.x)], 1u);
    return b;
}
__device__ __forceinline__ void xcd_barrier_complete(unsigned* bar, unsigned x, unsigned& nloc, unsigned& nx) {
    const unsigned G = gridDim.x * gridDim.y * gridDim.z;
    unsigned sum, cnt, mine, sp = 0u;
    for (;;) {
        sum = 0u; cnt = 0u; mine = 0u;
#pragma unroll
        for (unsigned j = 0; j < 16; ++j) { const unsigned c = xb_ld(&bar[XB_XCNT(j)]); sum += c; cnt += (c > 0u) ? 1u : 0u; mine = (j == x) ? c : mine; }
        if (sum == G) break;
        __builtin_amdgcn_s_sleep(1);
        if ((++sp & 255u) == 0u) { if (xb_ld(&bar[XB_TMO])) break; if (sp > XB_SPIN_CAP) { atomicAdd(&bar[XB_TMO], 1u); break; } }
    }
    nloc = mine > 0u ? mine : 1u; nx = cnt > 0u ? cnt : 1u;
}
__device__ __forceinline__ void xcd_barrier(const XcdBarrier& b) {
    asm volatile("s_waitcnt vmcnt(0)" ::: "memory");
    __syncthreads();
    if (threadIdx.x == 0) {
        unsigned* bar = b.bar;
        __builtin_amdgcn_s_waitcnt(0);
        unsigned nloc = b.st[0], nx = b.st[1];
        if (nloc == 0u) { xcd_barrier_complete(bar, b.x, nloc, nx); b.st[0] = nloc; b.st[1] = nx; }
        const unsigned old = xb_add(&bar[XB_XSUB(b.x)], 1u);
        const unsigned gen = old / nloc;
        if (old + 1u == (gen + 1u) * nloc) {
            __builtin_amdgcn_fence(__ATOMIC_RELEASE, "agent");
            asm volatile("s_waitcnt vmcnt(0)" ::: "memory");
            const unsigned og = xb_add(&bar[XB_TOP], 1u);
            const unsigned tg = og / nx;
            if (og + 1u == (tg + 1u) * nx) xb_add(&bar[XB_TOPGEN], 1u);
            else XB_SPIN(xb_ld(&bar[XB_TOPGEN]) == tg, bar);
            __builtin_amdgcn_fence(__ATOMIC_ACQUIRE, "agent");
            xb_add(&bar[XB_XGEN(b.x)], 1u);
            asm volatile("s_waitcnt vmcnt(0)" ::: "memory");
        } else {
            XB_SPIN(xb_ld(&bar[XB_XGEN(b.x)]) == gen, bar);
            __builtin_amdgcn_fence(__ATOMIC_ACQUIRE, "agent");
            asm volatile("s_waitcnt vmcnt(0)" ::: "memory");
        }
    }
    __syncthreads();
}

struct Args { const float* in[26]; float* out; unsigned char* ws; int ph_lo, ph_hi, li, pad; };
struct Ctx {
    const float* in[26]; float* out; unsigned char* ws;
    LAS unsigned char* lds;
    int tid, lane, wave, blk, G;
};
#define WSP(T, off) ((T*)(C.ws + (off)))
__device__ __forceinline__ const float* modp(const Ctx& C, int l, int set, int j) { return (const float*)(C.ws + WS_MOD) + ((l * 2 + set) * 6 + j) * D; }

__device__ __forceinline__ void p0_transpose_item(const float* W, int K, int N, bf16* WT, int k0, int n0, int drow0, LAS float* scr, int lane) {
    const int lr = lane >> 3, lc = (lane & 7) * 4;
    f32x4 v[8];
#pragma unroll
    for (int i = 0; i < 8; ++i) v[i] = *(const f32x4*)(W + (size_t)(k0 + 8 * i + lr) * N + n0 + lc);
#pragma unroll
    for (int i = 0; i < 8; ++i) *(LAS f32x4*)(scr + (8 * i + lr) * 36 + lc) = v[i];
    asm volatile("s_waitcnt lgkmcnt(0)" ::: "memory");
    const int c = lane & 7;
#pragma unroll
    for (int j = 0; j < 4; ++j) { const int n = (lane >> 3) + 8 * j; const LAS float* s = scr + (8 * c) * 36 + n;
        u32x4 o; o.x = pk2(s[0 * 36], s[1 * 36]); o.y = pk2(s[2 * 36], s[3 * 36]); o.z = pk2(s[4 * 36], s[5 * 36]); o.w = pk2(s[6 * 36], s[7 * 36]);
        *(u32x4*)(WT + (size_t)(drow0 + n) * K + k0 + 8 * c) = o; }
    asm volatile("s_waitcnt lgkmcnt(0)" ::: "memory");
}
__device__ __forceinline__ bool p0_plain(int& r, const float* W, int K, int N, bf16* WT, int row_off, LAS float* scr, int lane) {
    const int nblk = N / 32, cnt = (K / 64) * nblk;
    if (r >= cnt) { r -= cnt; return false; }
    const int kb = r / nblk, nb = r % nblk;
    p0_transpose_item(W, K, N, WT, kb * 64, nb * 32, row_off + nb * 32, scr, lane);
    return true;
}
__device__ __forceinline__ void ph_prologue(const Ctx& C) {
    LAS float* scr = (LAS float*)(C.lds + C.wave * 16384);
    const int gw = C.blk * 8 + C.wave, NGW = C.G * 8;
    constexpr int MOE_ITEMS = 4 * 16 * 3072;
    constexpr int SMALL_ITEMS = 2 * 1536 + 2 * 512 + 768 + 512 + 256 + 144 + 384 + 256 + 512;
    for (int it = gw; it < MOE_ITEMS + SMALL_ITEMS; it += NGW) {
        if (it < MOE_ITEMS) {
            const int le = it / 3072, r2 = it % 3072, which = r2 / 1024, item = r2 % 1024, l = le / 16, e = le % 16;
            if (which < 2) {
                const float* W = (which ? C.in[23] : C.in[22]) + (size_t)le * 1024 * 2048;
                bf16* WT = WSP(bf16, WS_W_GU) + ((size_t)l * 16 + e) * 4096 * 1024;
                const int kb = item / 64, nb = item % 64, n0 = nb * 32;
                p0_transpose_item(W, 1024, 2048, WT, kb * 64, n0, (n0 >> 7) * 256 + (n0 & 127) + which * 128, scr, C.lane);
            } else {
                const float* W = C.in[24] + (size_t)le * 2048 * 1024;
                bf16* WT = WSP(bf16, WS_W_DN) + ((size_t)l * 16 + e) * 1024 * 2048;
                const int kb = item / 32, nb = item % 32;
                p0_transpose_item(W, 2048, 1024, WT, kb * 64, nb * 32, nb * 32, scr, C.lane);
            }
            continue;
        }
        int r = it - MOE_ITEMS;
        if (p0_plain(r, C.in[8], 1024, 3072, WSP(bf16, WS_W_NAQKV), 0, scr, C.lane)) continue;
        if (p0_plain(r, C.in[8] + (size_t)1024 * 3072, 1024, 3072, WSP(bf16, WS_W_NAQKV) + (size_t)3072 * 1024, 0, scr, C.lane)) continue;
        if (p0_plain(r, C.in[9], 1024, 1024, WSP(bf16, WS_W_NAO), 0, scr, C.lane)) continue;
        if (p0_plain(r, C.in[9] + (size_t)1024 * 1024, 1024, 1024, WSP(bf16, WS_W_NAO) + (size_t)1024 * 1024, 0, scr, C.lane)) continue;
        if (p0_plain(r, C.in[11], 1024, 1536, WSP(bf16, WS_W_SWAQKV), 0, scr, C.lane)) continue;
        if (p0_plain(r, C.in[12], 1024, 1024, WSP(bf16, WS_W_SWAO), 0, scr, C.lane)) continue;
        if (p0_plain(r, C.in[14], 1024, 512, WSP(bf16, WS_W_MLAD), 0, scr, C.lane)) continue;
        if (p0_plain(r, C.in[17], 1024, 288, WSP(bf16, WS_W_MLAD), 512, scr, C.lane)) continue;
        if (p0_plain(r, C.in[16], 512, 1536, WSP(bf16, WS_W_MLAUQ), 0, scr, C.lane)) continue;
        if (p0_plain(r, C.in[19], 256, 2048, WSP(bf16, WS_W_MLAUKV), 0, scr, C.lane)) continue;
        p0_plain(r, C.in[20], 1024, 1024, WSP(bf16, WS_W_MLAO), 0, scr, C.lane);
    }
    { u32x4* z = (u32x4*)(WSP(bf16, WS_W_MLAD) + (size_t)800 * 1024); const int n16 = 224 * 1024 * 2 / 16;
      for (int i = C.blk * 512 + C.tid; i < n16; i += C.G * 512) z[i] = (u32x4){0u, 0u, 0u, 0u}; }
    __syncthreads();
    LAS float* sc = (LAS float*)C.lds;
    LAS float* red = sc + 2048;
    for (int i = C.tid; i < 2048; i += 512) { const float v = (i < 1024) ? C.in[1][i] : C.in[3][i - 1024]; sc[i] = v / (1.f + __expf(-v)); }
    __syncthreads();
    for (int u = C.blk; u < 4 * 96; u += C.G) {
        const int l = u / 96, j0 = (u % 96) * 64, kq = C.tid >> 6, jj = C.tid & 63;
        const float* W = C.in[4] + (size_t)l * 1024 * 6144 + j0 + jj;
        float a0 = 0.f, a1 = 0.f;
#pragma unroll 8
        for (int k = kq * 128; k < kq * 128 + 128; ++k) { const float w = W[(size_t)k * 6144]; a0 += sc[k] * w; a1 += sc[1024 + k] * w; }
        red[kq * 64 + jj] = a0; red[512 + kq * 64 + jj] = a1;
        __syncthreads();
        if (C.tid < 128) { const int set = C.tid >> 6, j = C.tid & 63; float s = 0.f;
#pragma unroll
            for (int q = 0; q < 8; ++q) s += red[set * 512 + q * 64 + j];
            const int col = j0 + j;
            ((float*)(C.ws + WS_MOD))[((l * 2 + set) * 6) * D + col] = s + C.in[5][l * 6144 + col]; }
        __syncthreads();
    }
}

template <int MODE>
__device__ __forceinline__ void ph_rowA(const Ctx& C, int l) {
    float* X = WSP(float, WS_X); bf16* H = WSP(bf16, WS_H); const int* INV = WSP(int, WS_INV); const bf16* YB = WSP(bf16, WS_YB);
    const int nrows = MODE == 1 ? SEQ : R;
    for (int t = C.blk * 8 + C.wave; t < nrows; t += C.G * 8) {
        const int set = t >= SEQ ? 1 : 0;
        const float* src = (MODE == 0 && l == 0) ? (set ? C.in[2] + (size_t)(t - SEQ) * D : C.in[0] + (size_t)t * D) : X + (size_t)t * D;
        f32x4 v[4];
#pragma unroll
        for (int j = 0; j < 4; ++j) v[j] = ((const f32x4*)src)[C.lane + 64 * j];
        if (MODE == 1 || l > 0) {
            const int lp = MODE == 1 ? 3 : l - 1;
            const int myinv = C.lane < 16 ? INV[(size_t)t * 16 + C.lane] : -1;
            f32x4 a[4];
#pragma unroll
            for (int j = 0; j < 4; ++j) a[j] = (f32x4){0.f, 0.f, 0.f, 0.f};
            for (int e = 0; e < 16; ++e) {
                const int s = __shfl(myinv, e);
                if (s >= 0) {
                    const u32x2* yr = (const u32x2*)(YB + ((size_t)e * EROWS + s) * D);
#pragma unroll
                    for (int j = 0; j < 4; ++j) { const u32x2 w = yr[C.lane + 64 * j];
                        a[j] += (f32x4){bf2f(w.x & 0xffffu), bf2f(w.x >> 16), bf2f(w.y & 0xffffu), bf2f(w.y >> 16)}; }
                }
            }
            const f32x4* g = (const f32x4*)modp(C, lp, set, 5);
#pragma unroll
            for (int j = 0; j < 4; ++j) v[j] += g[C.lane + 64 * j] * a[j];
        }
        if (MODE == 0) {
#pragma unroll
            for (int j = 0; j < 4; ++j) ((f32x4*)(X + (size_t)t * D))[C.lane + 64 * j] = v[j];
        }
        float ss = 0.f;
#pragma unroll
        for (int j = 0; j < 4; ++j) ss += (v[j].x * v[j].x + v[j].y * v[j].y) + (v[j].z * v[j].z + v[j].w * v[j].w);
        const float rstd = rsqrtf(wave_sum(ss) * (1.f / D) + RMS_EPS);
        if (MODE == 0) {
            const f32x4* w = (const f32x4*)(C.in[6] + (size_t)l * D); const f32x4* sh = (const f32x4*)modp(C, l, set, 0); const f32x4* scl = (const f32x4*)modp(C, l, set, 1);
#pragma unroll
            for (int j = 0; j < 4; ++j) { const int i = C.lane + 64 * j; const f32x4 y = v[j] * rstd * w[i] * (scl[i] + 1.f) + sh[i];
                u32x2 o; o.x = pk2(y.x, y.y); o.y = pk2(y.z, y.w); ((u32x2*)(H + (size_t)t * D))[i] = o; }
        } else {
            const f32x4* w = (const f32x4*)C.in[25];
#pragma unroll
            for (int j = 0; j < 4; ++j) { const int i = C.lane + 64 * j; ((f32x4*)(C.out + (size_t)t * D))[i] = v[j] * rstd * w[i]; }
        }
    }
}
#define RS_STEP(lo, hi, bit, off) ((bit ? hi : lo) + __shfl_xor(bit ? lo : hi, off))
__device__ __forceinline__ float rscatter16(const float (&a)[16], int b5, int b4, int b3, int b2) {
    const float c0 = RS_STEP(a[0], a[8], b5, 32), c1 = RS_STEP(a[1], a[9], b5, 32), c2 = RS_STEP(a[2], a[10], b5, 32), c3 = RS_STEP(a[3], a[11], b5, 32);
    const float c4 = RS_STEP(a[4], a[12], b5, 32), c5 = RS_STEP(a[5], a[13], b5, 32), c6 = RS_STEP(a[6], a[14], b5, 32), c7 = RS_STEP(a[7], a[15], b5, 32);
    const float d0 = RS_STEP(c0, c4, b4, 16), d1 = RS_STEP(c1, c5, b4, 16), d2 = RS_STEP(c2, c6, b4, 16), d3 = RS_STEP(c3, c7, b4, 16);
    const float e0 = RS_STEP(d0, d2, b3, 8), e1 = RS_STEP(d1, d3, b3, 8);
    return RS_STEP(e0, e1, b2, 4);
}
constexpr int NR2 = 1;
__device__ __forceinline__ void ph_norm2(const Ctx& C, int l, int nrows) {
    const float* X = WSP(float, WS_X); bf16* H = WSP(bf16, WS_H); float* AFF = WSP(float, WS_AFF);
    LAS float* Rs = (LAS float*)C.lds;
    const float* rt = C.in[21] + (size_t)l * D * NE;
    for (int i = C.tid; i < D * NE / 4; i += 512) { const f32x4 r4 = ((const f32x4*)rt)[i]; const int c = i >> 2, e0 = (i & 3) * 4;
        Rs[(e0 + 0) * D + c] = r4.x; Rs[(e0 + 1) * D + c] = r4.y; Rs[(e0 + 2) * D + c] = r4.z; Rs[(e0 + 3) * D + c] = r4.w; }
    __syncthreads();
    const int b5 = (C.lane >> 5) & 1, b4 = (C.lane >> 4) & 1, b3 = (C.lane >> 3) & 1, b2 = (C.lane >> 2) & 1, my_e = 8 * b5 + 4 * b4 + 2 * b3 + b2;
    for (int t0 = (C.blk * 8 + C.wave) * NR2; t0 < nrows; t0 += C.G * 8 * NR2) {
        asm volatile("" ::: "memory");
        const int set = t0 >= SEQ ? 1 : 0;
        f32x4 v[NR2][4];
#pragma unroll
        for (int rr = 0; rr < NR2; ++rr) {
#pragma unroll
            for (int j = 0; j < 4; ++j) v[rr][j] = ((const f32x4*)(X + (size_t)(t0 + rr) * D))[C.lane + 64 * j];
        }
        { const f32x4* w = (const f32x4*)(C.in[7] + (size_t)l * D); const f32x4* sh = (const f32x4*)modp(C, l, set, 3); const f32x4* scl = (const f32x4*)modp(C, l, set, 4);
          float rstd[NR2];
#pragma unroll
          for (int rr = 0; rr < NR2; ++rr) { float ss = 0.f;
#pragma unroll
            for (int j = 0; j < 4; ++j) ss += (v[rr][j].x * v[rr][j].x + v[rr][j].y * v[rr][j].y) + (v[rr][j].z * v[rr][j].z + v[rr][j].w * v[rr][j].w);
            rstd[rr] = rsqrtf(wave_sum(ss) * (1.f / D) + RMS_EPS); }
#pragma unroll
          for (int j = 0; j < 4; ++j) { const int i = C.lane + 64 * j; const f32x4 ws = w[i] * (scl[i] + 1.f), s4 = sh[i];
#pragma unroll
            for (int rr = 0; rr < NR2; ++rr) { v[rr][j] = v[rr][j] * rstd[rr] * ws + s4;
                u32x2 o; o.x = pk2(v[rr][j].x, v[rr][j].y); o.y = pk2(v[rr][j].z, v[rr][j].w); ((u32x2*)(H + (size_t)(t0 + rr) * D))[i] = o; } } }
        asm volatile("" ::: "memory");
        float lg[NR2][16];
#pragma unroll
        for (int e = 0; e < 16; ++e) {
            float sacc[NR2];
#pragma unroll
            for (int rr = 0; rr < NR2; ++rr) sacc[rr] = 0.f;
#pragma unroll
            for (int j = 0; j < 4; ++j) { const f32x4 r = *(const LAS f32x4*)(Rs + e * D + 4 * (C.lane + 64 * j));
#pragma unroll
                for (int rr = 0; rr < NR2; ++rr) sacc[rr] += (v[rr][j].x * r.x + v[rr][j].y * r.y) + (v[rr][j].z * r.z + v[rr][j].w * r.w); }
#pragma unroll
            for (int rr = 0; rr < NR2; ++rr) lg[rr][e] = sacc[rr];
            if ((e & 3) == 3) asm volatile("" ::: "memory");
        }
#pragma unroll
        for (int rr = 0; rr < NR2; ++rr) {
            float vv = rscatter16(lg[rr], b5, b4, b3, b2);
            vv += __shfl_xor(vv, 1); vv += __shfl_xor(vv, 2);
            float mx = vv; mx = fmaxf(mx, __shfl_xor(mx, 4)); mx = fmaxf(mx, __shfl_xor(mx, 8)); mx = fmaxf(mx, __shfl_xor(mx, 16)); mx = fmaxf(mx, __shfl_xor(mx, 32));
            const float ex = __expf(vv - mx); float sm = ex; sm += __shfl_xor(sm, 4); sm += __shfl_xor(sm, 8); sm += __shfl_xor(sm, 16); sm += __shfl_xor(sm, 32);
            if ((C.lane & 3) == 0) AFF[(size_t)my_e * R + t0 + rr] = ex / sm;
        }
    }
}

__device__ __forceinline__ int block_sum_i(int v, LAS int* scr, int wave, int lane) {
    v = wave_sum_i(v);
    if (lane == 0) scr[wave] = v;
    __syncthreads();
    int t = 0;
#pragma unroll
    for (int w = 0; w < 8; ++w) t += scr[w];
    __syncthreads();
    return t;
}
__device__ __forceinline__ int block_excl_scan(int v, LAS int* scr, int wave, int lane) {
    int inc = v;
#pragma unroll
    for (int o = 1; o < 64; o <<= 1) { const int n = __shfl_up(inc, o); if (lane >= o) inc += n; }
    if (lane == 63) scr[wave] = inc;
    __syncthreads();
    int off = 0;
#pragma unroll
    for (int w = 0; w < 8; ++w) off += (w < wave) ? scr[w] : 0;
    __syncthreads();
    return off + inc - v;
}
template <int KPT>
__device__ __forceinline__ void topk_unit(const Ctx& C, int e, int base, int n, int cap, int slot0) {
    const float* aff = WSP(float, WS_AFF) + (size_t)e * R + base;
    int* rowl = WSP(int, WS_ROWL) + e * EROWS; float* gatel = WSP(float, WS_GATEL) + e * EROWS; int* INV = WSP(int, WS_INV);
    LAS unsigned* hist = (LAS unsigned*)C.lds;
    LAS int* scr = (LAS int*)(hist + 256);
    LAS unsigned* bc = hist + 256 + 16;
    unsigned key[KPT];
    if (KPT == 32) {
#pragma unroll
        for (int j = 0; j < KPT; j += 4) { const u32x4 k4 = *(const u32x4*)(aff + C.tid * KPT + j); key[j] = k4.x; key[j + 1] = k4.y; key[j + 2] = k4.z; key[j + 3] = k4.w; }
    } else {
#pragma unroll
        for (int j = 0; j < KPT; ++j) { const int t = C.tid * KPT + j; key[j] = t < n ? __float_as_uint(aff[t]) : 0u; }
    }
    unsigned prefix = 0u, pmask = 0u; int kth = cap;
    for (int pass = 0; pass < 4; ++pass) {
        const int shift = 24 - 8 * pass;
        if (C.tid < 256) hist[C.tid] = 0u;
        __syncthreads();
#pragma unroll
        for (int j = 0; j < KPT; ++j) if (key[j] != 0u && (key[j] & pmask) == prefix) __hip_atomic_fetch_add(hist + ((key[j] >> shift) & 255u), 1u, __ATOMIC_RELAXED, __HIP_MEMORY_SCOPE_WORKGROUP);
        __syncthreads();
        if (C.wave == 0) {
            const unsigned c0 = hist[4 * C.lane], c1 = hist[4 * C.lane + 1], c2 = hist[4 * C.lane + 2], c3 = hist[4 * C.lane + 3];
            const int tot = (int)(c0 + c1 + c2 + c3); int suf = tot;
#pragma unroll
            for (int o = 1; o < 64; o <<= 1) { const int nb = __shfl_down(suf, o); if (C.lane + o < 64) suf += nb; }
            const unsigned long long bal = __ballot(suf >= kth);
            const int lstar = 63 - __builtin_clzll(bal);
            if (C.lane == lstar) { int above = suf - tot; unsigned dg; int nk;
                if (above + (int)c3 >= kth) { dg = 3; nk = kth - above; }
                else { above += (int)c3; if (above + (int)c2 >= kth) { dg = 2; nk = kth - above; }
                else { above += (int)c2; if (above + (int)c1 >= kth) { dg = 1; nk = kth - above; }
                else { above += (int)c1; dg = 0; nk = kth - above; } } }
                bc[0] = 4u * (unsigned)C.lane + dg; bc[1] = (unsigned)nk; }
        }
        __syncthreads();
        prefix |= bc[0] << shift; pmask |= 255u << shift; kth = (int)bc[1];
    }
    const int need_eq = kth;
    int ce = 0;
#pragma unroll
    for (int j = 0; j < KPT; ++j) ce += key[j] == prefix ? 1 : 0;
    int eqr = block_excl_scan(ce, scr, C.wave, C.lane);
    int nsel = 0; unsigned selmask = 0u;
#pragma unroll
    for (int j = 0; j < KPT; ++j) { bool sl = key[j] > prefix; if (key[j] == prefix) { sl = eqr < need_eq; ++eqr; } if (sl) { ++nsel; selmask |= 1u << j; } }
    int slot = block_excl_scan(nsel, scr, C.wave, C.lane);
#pragma unroll
    for (int j = 0; j < KPT; ++j) { const int t = C.tid * KPT + j;
        if (t < n) {
            if ((selmask >> j) & 1u) { rowl[slot0 + slot] = base + t; gatel[slot0 + slot] = __uint_as_float(key[j]); INV[(size_t)(base + t) * 16 + e] = slot0 + slot; ++slot; }
            else INV[(size_t)(base + t) * 16 + e] = -1;
        } }
}
__device__ __forceinline__ void ph_topk(const Ctx& C, bool with_ctx) {
    for (int u = C.blk; u < (with_ctx ? 32 : 16); u += C.G) {
        const int e = u & 15;
        if (u < 16) topk_unit<32>(C, e, 0, SEQ, CAP_L, 0);
        else topk_unit<1>(C, e, SEQ, NCTX, CAP_C, CAP_L);
        __syncthreads();
    }
}
__device__ __forceinline__ void ph_gather(const Ctx& C, bool with_ctx) {
    const int* rowl = WSP(int, WS_ROWL); const bf16* H = WSP(bf16, WS_H); bf16* XG = WSP(bf16, WS_XG);
    const int nslots = with_ctx ? CAP_L + CAP_C : CAP_L, ntot = NE * nslots;
    for (int i = C.blk * 8 + C.wave; i < ntot; i += C.G * 8) {
        const int e = i / nslots, sl = i % nslots, r = e * EROWS + sl;
        const int src = rowl[r];
        u32x4* d = (u32x4*)(XG + (size_t)r * D); const u32x4* sp = (const u32x4*)(H + (size_t)src * D);
        d[C.lane] = sp[C.lane]; d[C.lane + 64] = sp[C.lane + 64];
    }
}
__device__ __forceinline__ void rot_angles(int t, int half, int d, int quarter, float& cs, float& sn) {
    const float invf = exp2f(-(float)d * (13.287712379549449f / (float)quarter));
    const float pos = half ? (float)(t & 63) : (float)(t >> 6);
    const float ang = pos * invf;
    const double rev = (double)ang * 0.15915494309189535; const float fr = (float)(rev - __builtin_rint(rev));
    cs = __builtin_amdgcn_cosf(fr); sn = __builtin_amdgcn_sinf(fr);
}
__device__ __forceinline__ void ph_rope(const Ctx& C, bf16* buf, int hw, int nheads, int off, int quarter) {
    const int per_tok = nheads * 2 * quarter; const long total = (long)SEQ * per_tok;
    for (long i = (long)C.blk * 512 + C.tid; i < total; i += (long)C.G * 512) {
        const int t = (int)(i / per_tok), r = (int)(i % per_tok), h = r / (2 * quarter), p = r % (2 * quarter), half = p / quarter, d = p % quarter;
        float cs, sn; rot_angles(t, half, d, quarter, cs, sn);
        bf16* b = buf + (size_t)h * R * hw + (size_t)t * hw + off + half * 2 * quarter + d;
        const float x1 = bf2f(b[0]), x2 = bf2f(b[quarter]);
        b[0] = (bf16)f2bf(x1 * cs - x2 * sn); b[quarter] = (bf16)f2bf(x1 * sn + x2 * cs);
    }
}
__device__ __forceinline__ void ph_mlanorm(const Ctx& C) {
    const float* CQ = WSP(float, WS_CQ); bf16* CQN = WSP(bf16, WS_CQN); bf16* CKVN = WSP(bf16, WS_CKVN); bf16* KR = WSP(bf16, WS_KROPE);
    for (int t = C.blk * 8 + C.wave; t < R; t += C.G * 8) {
        const float* row = CQ + (size_t)t * D;
        const f32x4 a0 = ((const f32x4*)row)[C.lane], a1 = ((const f32x4*)row)[C.lane + 64], b0 = ((const f32x4*)(row + 512))[C.lane];
        const float sa = wave_sum((a0.x * a0.x + a0.y * a0.y) + (a0.z * a0.z + a0.w * a0.w) + (a1.x * a1.x + a1.y * a1.y) + (a1.z * a1.z + a1.w * a1.w));
        const float sb = wave_sum((b0.x * b0.x + b0.y * b0.y) + (b0.z * b0.z + b0.w * b0.w));
        const float ra = rsqrtf(sa * (1.f / 512.f) + RMS_EPS), rb = rsqrtf(sb * (1.f / 256.f) + RMS_EPS);
        const f32x4* gq = (const f32x4*)C.in[15]; const f32x4* gk = (const f32x4*)C.in[18];
        { const f32x4 y0 = a0 * ra * gq[C.lane], y1 = a1 * ra * gq[C.lane + 64], z = b0 * rb * gk[C.lane];
          u32x2 o; o.x = pk2(y0.x, y0.y); o.y = pk2(y0.z, y0.w); ((u32x2*)(CQN + (size_t)t * 512))[C.lane] = o;
          o.x = pk2(y1.x, y1.y); o.y = pk2(y1.z, y1.w); ((u32x2*)(CQN + (size_t)t * 512))[C.lane + 64] = o;
          o.x = pk2(z.x, z.y); o.y = pk2(z.z, z.w); ((u32x2*)(CKVN + (size_t)t * 256))[C.lane] = o; }
        const float x = row[768 + (C.lane & 31)];
        const float xp = __shfl_xor(x, 8);
        float y = x;
        if (t < SEQ) { float cs, sn; rot_angles(t, (C.lane >> 4) & 1, C.lane & 7, 8, cs, sn);
            y = ((C.lane >> 3) & 1) ? (xp * sn + x * cs) : (x * cs - xp * sn); }
        if (C.lane < 32) KR[(size_t)t * 32 + C.lane] = (bf16)f2bf(y);
    }
}

constexpr int CW_KMAX = 8192;
__device__ __forceinline__ void ph_kmax(const Ctx& C) {
    const bf16* KV = WSP(bf16, WS_KV); const bf16* KR = WSP(bf16, WS_KROPE); unsigned* ctl = (unsigned*)(C.ws + WS_CTL);
    for (int i = C.blk * 512 + C.tid; i < 16 * R; i += C.G * 512) {
        const int h = i / R, t = i - h * R;
        const u32x4* kp = (const u32x4*)(KV + (size_t)h * R * 128 + (size_t)t * 128); const u32x4* rp = (const u32x4*)(KR + (size_t)t * 32);
        float ss = 0.f;
#pragma unroll
        for (int q = 0; q < 12; ++q) { const u32x4 w = q < 8 ? kp[q] : rp[q - 8];
            const float a0 = bf2f(w.x & 0xffffu), a1 = bf2f(w.x >> 16), a2 = bf2f(w.y & 0xffffu), a3 = bf2f(w.y >> 16), a4 = bf2f(w.z & 0xffffu), a5 = bf2f(w.z >> 16), a6 = bf2f(w.w & 0xffffu), a7 = bf2f(w.w >> 16);
            ss += (a0 * a0 + a1 * a1) + (a2 * a2 + a3 * a3) + (a4 * a4 + a5 * a5) + (a6 * a6 + a7 * a7); }
#pragma unroll
        for (int o = 1; o < 64; o <<= 1) ss = fmaxf(ss, __shfl_xor(ss, o));
        if (C.lane == 0) atomicMax(ctl + CW_KMAX + h, __float_as_uint(ss));
    }
}

namespace pg8 {
#define PG8_LAS __attribute__((address_space(3)))
typedef unsigned short bf16_t;
typedef short bf16x8 __attribute__((ext_vector_type(8)));
typedef float f32x4 __attribute__((ext_vector_type(4)));
typedef unsigned u32x4 __attribute__((ext_vector_type(4)));
constexpr int BM = 256, BK = 64, HALF = 128, HTB = HALF * BK * 2  , STAGE_BYTES = 8 * HTB, NXCD = 8, WGM = 8;

__host__ __device__ __forceinline__ int lds_byte(int r, int c) { const int st = (r >> 4) * 2 + (c >> 5), rr = r & 15, cc = c & 31, ob = rr * 64 + cc * 2; return st * 1024 + (ob ^ (((ob >> 9) & 1) << 5)); }
__host__ __device__ __forceinline__ void stage_rc(int b, int& R, int& C) { const int st = b / 1024, sb = b % 1024, swz = sb ^ (((sb >> 9) & 1) << 5); R = (st >> 1) * 16 + swz / 64; C = (st & 1) * 32 + (swz % 64) / 2; }
__host__ __device__ __forceinline__ int perm32(int rho) { const int n = rho >> 4, i = rho & 15; return 8 * (i >> 2) + 4 * n + (i & 3); }

struct Unit { int pm, pn, thin; };
struct Gemm { const bf16_t* A; const bf16_t* Bt; int M, N, K; int pm_per_grp; size_t grp_stride; };

struct StaticOrder {
    int nM, nN, nwg, G, c;
    __host__ __device__ void init(int M, int N, int G_, int c_) { nM = M / BM; nN = N / BM; nwg = nM * nN; G = G_; c = c_; }
    __host__ __device__ bool next(int i, Unit& u) const {
        const long L = (long)i * G + c; if (L >= nwg) return false;
        int wgid = (int)L; { const int q = nwg / NXCD, r = nwg % NXCD, xcd = wgid % NXCD, off = wgid / NXCD; wgid = (xcd < r ? xcd * (q + 1) : r * (q + 1) + (xcd - r) * q) + off; }
        const int nig = WGM * nN, gid = wgid / nig, fm = gid * WGM, gsz = (nM - fm) < WGM ? (nM - fm) : WGM;
        u.pm = fm + ((wgid % nig) % gsz); u.pn = (wgid % nig) / gsz; u.thin = 0; return true;
    }
    __device__ __forceinline__ void a_ready(const Unit&) const {}
    __device__ __forceinline__ void done(const Unit&) const {}
};
struct MoeOrder {
    StaticOrder base; int nN, nthin;
    __host__ __device__ void init(int N, int G_, int c_, bool with_thin) { base.init(NEXP_PANELS * BM, N, G_, c_); nN = N / BM; nthin = with_thin ? 16 * nN : 0; }
    static constexpr int NEXP_PANELS = 16 * 8;
    __host__ __device__ bool next(int i, Unit& u) const {
        if (base.next(i, u)) { u.pm = (u.pm >> 3) * 9 + (u.pm & 7); return true; }
        const long j = (long)i * base.G + base.c - base.nwg; if (j >= nthin) return false;
        u.pm = (int)(j / nN) * 9 + 8; u.pn = (int)(j % nN); u.thin = 1; return true;
    }
    __device__ __forceinline__ void a_ready(const Unit&) const {}
    __device__ __forceinline__ void done(const Unit&) const {}
};

template <class Epi, class Sched, bool ALIGN_EPI = false, bool SP2 = false>
__device__ __forceinline__ void gemm_phase(PG8_LAS unsigned char* lds, const Gemm g, const Sched& S, const Epi& E) {
    const int tid = threadIdx.x, wid = __builtin_amdgcn_readfirstlane(tid >> 6), lane = tid & 63, wr = wid >> 2, wc = wid & 3, fr = lane & 15, fq = lane >> 4;
    const int K = g.K, nt = K / BK;
    unsigned voffA[2], voffB[2];
#pragma unroll
    for (int i = 0; i < 2; ++i) { int R, C; stage_rc(tid * 16 + i * 8192, R, C); const int Rb = Epi::PERM ? ((R & ~31) + perm32(R & 31)) : R;
        voffA[i] = (unsigned)(R * K + C) * 2u; voffB[i] = (unsigned)(Rb * K + C) * 2u; }
    const size_t kstep = (size_t)(BK * 2);
    const size_t hstep = (size_t)HALF * K * 2;
    const size_t tstep = 2 * hstep;
    const unsigned ldsw = (unsigned)wid * 1024u;
    const int aoff = lds_byte(wr * 64 + fr, fq * 8), boff = lds_byte(wc * 32 + fr, fq * 8);
#define PG8_SA(b, h) (((b) * 2 + (h)) * HTB)
#define PG8_SB(b, h) ((4 + (b) * 2 + (h)) * HTB)
#define PG8_STAGE(bufoff, gbase, voff) do { _Pragma("unroll") for (int _i = 0; _i < 2; ++_i) \
        __builtin_amdgcn_global_load_lds((const unsigned*)((const char*)(gbase) + (voff)[_i]), (PG8_LAS unsigned*)(lds + (bufoff) + ldsw + _i * 8192), 16, 0, 0); } while (0)
#define PG8_LDA(dst, b, h) do { _Pragma("unroll") for (int m = 0; m < 4; ++m) _Pragma("unroll") for (int k = 0; k < 2; ++k) dst[m][k] = *(const PG8_LAS bf16x8*)(lds + PG8_SA(b, h) + aoff + m * 2048 + k * 1024); } while (0)
#define PG8_LDB(dst, b, h) do { _Pragma("unroll") for (int n = 0; n < 2; ++n) _Pragma("unroll") for (int k = 0; k < 2; ++k) dst[n][k] = *(const PG8_LAS bf16x8*)(lds + PG8_SB(b, h) + boff + n * 2048 + k * 1024); } while (0)
#define PG8_MMA(ai, bj, At, Bt) do { if (cur.thin && ((ai) != 0 || wr != 0)) break; __builtin_amdgcn_s_setprio(1); _Pragma("unroll") for (int m = 0; m < 4; ++m) _Pragma("unroll") for (int n = 0; n < 2; ++n) _Pragma("unroll") for (int k = 0; k < 2; ++k) \
        acc[ai][bj][m][n] = __builtin_amdgcn_mfma_f32_16x16x32_bf16(Bt[n][k], At[m][k], acc[ai][bj][m][n], 0, 0, 0); __builtin_amdgcn_s_setprio(0); } while (0)
#define PG8_WAIT_V(n) asm volatile("s_waitcnt vmcnt(" #n ")" ::: "memory")
#define PG8_WAIT_L(n) asm volatile("s_waitcnt lgkmcnt(" #n ")" ::: "memory")
#define PG8_BAR __builtin_amdgcn_s_barrier()
#define PG8_SCHED __builtin_amdgcn_sched_barrier(0)
    Unit cur, nxt; int ui = 0;
    if (!S.next(0, cur)) return;
    f32x4 acc[2][2][4][2];
#pragma unroll
    for (int a = 0; a < 2; ++a)
#pragma unroll
        for (int b = 0; b < 2; ++b)
#pragma unroll
            for (int m = 0; m < 4; ++m)
#pragma unroll
                for (int n = 0; n < 2; ++n) acc[a][b][m][n] = (f32x4){0.f, 0.f, 0.f, 0.f};
    bf16x8 At[4][2], B0[2][2], B1[2][2];
    const char* cA = (const char*)g.A + (size_t)cur.pm * tstep; const char* cB = (const char*)g.Bt + (g.pm_per_grp ? (size_t)(cur.pm / g.pm_per_grp) * g.grp_stride * 2 : (size_t)0) + (size_t)cur.pn * tstep;
    S.a_ready(cur);
    if constexpr (SP2) {
        PG8_STAGE(PG8_SB(0, 0), cB, voffB); PG8_STAGE(PG8_SB(0, 1), cB + hstep, voffB); PG8_STAGE(PG8_SA(0, 0), cA, voffA); PG8_STAGE(PG8_SA(0, 1), cA + hstep, voffA);
        if (wr == 1) PG8_BAR;
        PG8_WAIT_V(2); PG8_BAR;
        PG8_STAGE(PG8_SB(1, 0), cB + kstep, voffB); PG8_STAGE(PG8_SA(1, 0), cA + kstep, voffA); PG8_STAGE(PG8_SB(1, 1), cB + hstep + kstep, voffB);
        PG8_WAIT_V(6); PG8_BAR;
    } else {
        PG8_STAGE(PG8_SB(0, 0), cB, voffB); PG8_STAGE(PG8_SA(0, 0), cA, voffA); PG8_STAGE(PG8_SB(0, 1), cB + hstep, voffB); PG8_STAGE(PG8_SA(0, 1), cA + hstep, voffA);
        if (wr == 1) PG8_BAR;
        PG8_WAIT_V(4); PG8_BAR;
        PG8_STAGE(PG8_SB(1, 0), cB + kstep, voffB); PG8_STAGE(PG8_SA(1, 0), cA + kstep, voffA); PG8_STAGE(PG8_SB(1, 1), cB + hstep + kstep, voffB);
        PG8_WAIT_V(6); PG8_BAR;
    }
    for (;;) {
        const bool has_next = S.next(ui + 1, nxt);
        const char* nA = has_next ? (const char*)g.A + (size_t)nxt.pm * tstep : cA; const char* nB = has_next ? (const char*)g.Bt + (g.pm_per_grp ? (size_t)(nxt.pm / g.pm_per_grp) * g.grp_stride * 2 : (size_t)0) + (size_t)nxt.pn * tstep : cB;
        for (int t = 0; t < nt; t += 2) {
            const bool last = (t == nt - 2);
            const char* a1 = cA + (size_t)(t + 1) * kstep;
            const char* a2 = last ? nA : cA + (size_t)(t + 2) * kstep; const char* b2 = last ? nB : cB + (size_t)(t + 2) * kstep;
            const char* a3 = a2 + kstep; const char* b3 = b2 + kstep;
            if (last && has_next) S.a_ready(nxt);
            if constexpr (SP2) {
            PG8_LDB(B0, 0, 0); PG8_LDB(B1, 0, 1); PG8_SCHED; PG8_LDA(At, 0, 0); PG8_STAGE(PG8_SA(1, 1), a1 + hstep, voffA);
            PG8_WAIT_V(8); PG8_WAIT_L(0); PG8_BAR; PG8_MMA(0, 0, At, B0); PG8_MMA(0, 1, At, B1); PG8_BAR; PG8_SCHED;
            PG8_LDA(At, 0, 1); PG8_STAGE(PG8_SB(0, 0), b2, voffB); PG8_STAGE(PG8_SB(0, 1), b2 + hstep, voffB); PG8_STAGE(PG8_SA(0, 0), a2, voffA);
            PG8_WAIT_V(8); PG8_WAIT_L(0); PG8_BAR; PG8_MMA(1, 0, At, B0); PG8_MMA(1, 1, At, B1); PG8_BAR; PG8_SCHED;
            PG8_LDB(B0, 1, 0); PG8_LDB(B1, 1, 1); PG8_SCHED; PG8_LDA(At, 1, 0); PG8_STAGE(PG8_SA(0, 1), a2 + hstep, voffA);
            PG8_WAIT_V(8); PG8_WAIT_L(0); PG8_BAR; PG8_MMA(0, 0, At, B0); PG8_MMA(0, 1, At, B1); PG8_BAR; PG8_SCHED;
            PG8_LDA(At, 1, 1); PG8_STAGE(PG8_SB(1, 0), b3, voffB); PG8_STAGE(PG8_SB(1, 1), b3 + hstep, voffB); PG8_STAGE(PG8_SA(1, 0), a3, voffA);
            PG8_WAIT_V(8); PG8_WAIT_L(0); PG8_BAR; PG8_MMA(1, 0, At, B0); PG8_MMA(1, 1, At, B1); PG8_BAR; PG8_SCHED;
            } else {
            PG8_LDB(B0, 0, 0); PG8_SCHED; PG8_LDA(At, 0, 0); PG8_STAGE(PG8_SA(1, 1), a1 + hstep, voffA);
            PG8_WAIT_L(8); PG8_BAR; PG8_WAIT_L(0); PG8_MMA(0, 0, At, B0); PG8_BAR; PG8_SCHED;
            PG8_LDB(B1, 0, 1); PG8_STAGE(PG8_SB(0, 0), b2, voffB);
            PG8_BAR; PG8_WAIT_L(0); PG8_MMA(0, 1, At, B1); PG8_BAR;
            PG8_LDA(At, 0, 1); PG8_STAGE(PG8_SA(0, 0), a2, voffA);
            PG8_BAR; PG8_WAIT_L(0); PG8_MMA(1, 0, At, B0); PG8_BAR; PG8_SCHED;
            PG8_STAGE(PG8_SB(0, 1), b2 + hstep, voffB);
            PG8_WAIT_V(6); PG8_BAR; PG8_MMA(1, 1, At, B1); PG8_BAR;
            PG8_LDB(B0, 1, 0); PG8_SCHED; PG8_LDA(At, 1, 0); PG8_STAGE(PG8_SA(0, 1), a2 + hstep, voffA);
            PG8_WAIT_L(8); PG8_BAR; PG8_WAIT_L(0); PG8_MMA(0, 0, At, B0); PG8_BAR; PG8_SCHED;
            PG8_LDB(B1, 1, 1); PG8_STAGE(PG8_SB(1, 0), b3, voffB);
            PG8_BAR; PG8_WAIT_L(0); PG8_MMA(0, 1, At, B1); PG8_BAR;
            PG8_LDA(At, 1, 1); PG8_STAGE(PG8_SA(1, 0), a3, voffA);
            PG8_BAR; PG8_WAIT_L(0); PG8_MMA(1, 0, At, B0); PG8_BAR; PG8_SCHED;
            PG8_STAGE(PG8_SB(1, 1), b3 + hstep, voffB);
            PG8_WAIT_V(6); PG8_BAR; PG8_MMA(1, 1, At, B1); PG8_BAR;
            }
        }
        if constexpr (ALIGN_EPI) { if (wr == 0) PG8_BAR; }
        if constexpr (!Epi::AFTER_DRAIN) { E(acc, cur, wr, wc, fr, fq); S.done(cur); }
        if (!has_next) break;
#pragma unroll
        for (int a = 0; a < 2; ++a)
#pragma unroll
            for (int b = 0; b < 2; ++b)
#pragma unroll
                for (int m = 0; m < 4; ++m)
#pragma unroll
                    for (int n = 0; n < 2; ++n) acc[a][b][m][n] = (f32x4){0.f, 0.f, 0.f, 0.f};
        cur = nxt; cA = nA; cB = nB; ++ui;
        if constexpr (ALIGN_EPI) { if (wr == 1) PG8_BAR; }
    }
    PG8_WAIT_V(0);
    if constexpr (!ALIGN_EPI) { if (wr == 0) PG8_BAR; }
    PG8_BAR;
    if constexpr (Epi::AFTER_DRAIN) { E.fused(acc, cur, wr, wc, fr, fq, lds, wid, lane); S.done(cur); }
#undef PG8_SA
#undef PG8_SB
#undef PG8_STAGE
#undef PG8_LDA
#undef PG8_LDB
#undef PG8_MMA
#undef PG8_WAIT_V
#undef PG8_WAIT_L
#undef PG8_BAR
#undef PG8_SCHED
}
}
#ifndef USE_PG8
#define USE_PG8 1
#endif
typedef float f32x2_t __attribute__((ext_vector_type(2))); typedef __bf16 bf16x2_t __attribute__((ext_vector_type(2)));
__device__ __forceinline__ unsigned cvt_pk_bf16(float lo, float hi) { f32x2_t v = {lo, hi}; bf16x2_t b = __builtin_convertvector(v, bf16x2_t); return __builtin_bit_cast(unsigned, b); }
typedef const f32x4 (&AccRef)[2][2][4][2];
struct EpiStoreBf16 { static constexpr bool DUAL = false, PERM = true, AFTER_DRAIN = false; bf16* O; int ldc;
    __device__ __forceinline__ void elem(int row, int col, float v, float) const { O[(size_t)row * ldc + col] = (bf16)f2bf(v); }
    __device__ __forceinline__ void operator()(AccRef acc, const pg8::Unit& u, int wr, int wc, int fr, int fq) const {
        const int row0 = u.pm * 256 + wr * 64 + fr, col0 = u.pn * 256 + wc * 32 + 8 * fq;
#pragma unroll
        for (int ai = 0; ai < 2; ++ai)
#pragma unroll
            for (int m = 0; m < 4; ++m) { bf16* rowp = O + (size_t)(row0 + ai * 128 + m * 16) * ldc + col0;
#pragma unroll
                for (int bj = 0; bj < 2; ++bj) { const f32x4 v0 = acc[ai][bj][m][0], v1 = acc[ai][bj][m][1];
                    u32x4 w; w.x = cvt_pk_bf16(v0[0], v0[1]); w.y = cvt_pk_bf16(v0[2], v0[3]); w.z = cvt_pk_bf16(v1[0], v1[1]); w.w = cvt_pk_bf16(v1[2], v1[3]);
                    *(u32x4*)(rowp + bj * 128) = w; } }
    } };
struct EpiStoreHeads { static constexpr bool DUAL = false, PERM = true, AFTER_DRAIN = false; bf16* O; int hw; size_t hstride;
    __device__ __forceinline__ void store4(int row, int col, f32x4 v) const { const int hd = col / hw, wi = col - hd * hw; u32x2 o; o.x = cvt_pk_bf16(v[0], v[1]); o.y = cvt_pk_bf16(v[2], v[3]); *(u32x2*)(O + (size_t)hd * hstride + (size_t)row * hw + wi) = o; }
    __device__ __forceinline__ void elem(int row, int col, float v, float) const { O[(size_t)(col / hw) * hstride + (size_t)row * hw + (col % hw)] = (bf16)f2bf(v); }
    __device__ __forceinline__ void operator()(AccRef acc, const pg8::Unit& u, int wr, int wc, int fr, int fq) const {
        const int row0 = u.pm * 256 + wr * 64 + fr, col0 = u.pn * 256 + wc * 32 + 8 * fq;
#pragma unroll
        for (int bj = 0; bj < 2; ++bj) { const int c = col0 + bj * 128, hd = c / hw, wi = c - hd * hw; bf16* base = O + (size_t)hd * hstride + wi;
#pragma unroll
            for (int ai = 0; ai < 2; ++ai)
#pragma unroll
                for (int m = 0; m < 4; ++m) { const f32x4 v0 = acc[ai][bj][m][0], v1 = acc[ai][bj][m][1];
                    u32x4 w; w.x = cvt_pk_bf16(v0[0], v0[1]); w.y = cvt_pk_bf16(v0[2], v0[3]); w.z = cvt_pk_bf16(v1[0], v1[1]); w.w = cvt_pk_bf16(v1[2], v1[3]);
                    *(u32x4*)(base + (size_t)(row0 + ai * 128 + m * 16) * hw) = w; } }
    } };
struct EpiStoreF32 { static constexpr bool DUAL = false, PERM = false, AFTER_DRAIN = false; float* O; int ldc;
    __device__ __forceinline__ void store4(int row, int col, f32x4 v) const { *(f32x4*)(O + (size_t)row * ldc + col) = v; }
    __device__ __forceinline__ void elem(int row, int col, float v, float) const { O[(size_t)row * ldc + col] = v; }
    __device__ __forceinline__ void operator()(AccRef acc, const pg8::Unit& u, int wr, int wc, int fr, int fq) const {
        const int row0 = u.pm * 256 + wr * 64 + fr, col0 = u.pn * 256 + wc * 32 + 4 * fq;
#pragma unroll
        for (int ai = 0; ai < 2; ++ai)
#pragma unroll
            for (int m = 0; m < 4; ++m) { float* rowp = O + (size_t)(row0 + ai * 128 + m * 16) * ldc + col0;
#pragma unroll
                for (int bj = 0; bj < 2; ++bj)
#pragma unroll
                    for (int n = 0; n < 2; ++n) *(f32x4*)(rowp + bj * 128 + n * 16) = acc[ai][bj][m][n]; }
    } };
struct EpiResid { static constexpr bool DUAL = false, PERM = false, AFTER_DRAIN = false; float* X; const float* g_lat; const float* g_ctx;
    __device__ __forceinline__ void store4(int row, int col, f32x4 v) const { const float* g = row >= SEQ ? g_ctx : g_lat; f32x4* p = (f32x4*)(X + (size_t)row * D + col); *p = *p + *(const f32x4*)(g + col) * v; }
    __device__ __forceinline__ void elem(int row, int col, float v, float) const { const float g = row >= SEQ ? g_ctx[col] : g_lat[col]; X[(size_t)row * D + col] += g * v; }
    __device__ __forceinline__ void operator()(AccRef acc, const pg8::Unit& u, int wr, int wc, int fr, int fq) const {
        const int row0 = u.pm * 256 + wr * 64 + fr, col0 = u.pn * 256 + wc * 32 + 4 * fq;
        const float* g = (u.pm * 256 >= SEQ) ? g_ctx : g_lat;
        f32x4 gv[2][2];
#pragma unroll
        for (int bj = 0; bj < 2; ++bj)
#pragma unroll
            for (int n = 0; n < 2; ++n) gv[bj][n] = *(const f32x4*)(g + col0 + bj * 128 + n * 16);
#pragma unroll
        for (int ai = 0; ai < 2; ++ai)
#pragma unroll
            for (int m = 0; m < 4; ++m) { float* rowp = X + (size_t)(row0 + ai * 128 + m * 16) * D + col0;
#pragma unroll
                for (int bj = 0; bj < 2; ++bj)
#pragma unroll
                    for (int n = 0; n < 2; ++n) { f32x4* p = (f32x4*)(rowp + bj * 128 + n * 16); *p = *p + gv[bj][n] * acc[ai][bj][m][n]; } }
    } };
__device__ __forceinline__ float silu_mul(float g, float u) { return g * __builtin_amdgcn_rcpf(1.f + __expf(-g)) * u; }
struct EpiSwiglu { static constexpr bool DUAL = true, PERM = true, AFTER_DRAIN = false; bf16* ACT;
    __device__ __forceinline__ void elem(int row, int col, float g, float u) const { ACT[(size_t)row * FF + col] = (bf16)f2bf(g / (1.f + __expf(-g)) * u); }
    __device__ __forceinline__ void operator()(AccRef acc, const pg8::Unit& u, int wr, int wc, int fr, int fq) const {
        const int row0 = u.pm * 256 + wr * 64 + fr, col0 = u.pn * 128 + wc * 32 + 8 * fq;
#pragma unroll
        for (int ai = 0; ai < 2; ++ai)
#pragma unroll
            for (int m = 0; m < 4; ++m) { bf16* rowp = ACT + (size_t)(row0 + ai * 128 + m * 16) * FF + col0;
                const f32x4 g0 = acc[ai][0][m][0], g1 = acc[ai][0][m][1], u0 = acc[ai][1][m][0], u1 = acc[ai][1][m][1];
                u32x4 w; w.x = cvt_pk_bf16(silu_mul(g0[0], u0[0]), silu_mul(g0[1], u0[1])); w.y = cvt_pk_bf16(silu_mul(g0[2], u0[2]), silu_mul(g0[3], u0[3]));
                w.z = cvt_pk_bf16(silu_mul(g1[0], u1[0]), silu_mul(g1[1], u1[1])); w.w = cvt_pk_bf16(silu_mul(g1[2], u1[2]), silu_mul(g1[3], u1[3]));
                *(u32x4*)rowp = w; }
    } };
struct EpiMoeOut { static constexpr bool DUAL = false, PERM = true, AFTER_DRAIN = false; bf16* YB; const float* gatel;
    __device__ __forceinline__ void elem(int row, int col, float v, float) const { YB[(size_t)row * D + col] = (bf16)f2bf(v * gatel[row]); }
    __device__ __forceinline__ void operator()(AccRef acc, const pg8::Unit& u, int wr, int wc, int fr, int fq) const {
        const int row0 = u.pm * 256 + wr * 64 + fr, col0 = u.pn * 256 + wc * 32 + 8 * fq;
#pragma unroll
        for (int ai = 0; ai < 2; ++ai)
#pragma unroll
            for (int m = 0; m < 4; ++m) { const int row = row0 + ai * 128 + m * 16; const float gt = gatel[row]; bf16* rowp = YB + (size_t)row * D + col0;
#pragma unroll
                for (int bj = 0; bj < 2; ++bj) { const f32x4 v0 = acc[ai][bj][m][0] * gt, v1 = acc[ai][bj][m][1] * gt;
                    u32x4 w; w.x = cvt_pk_bf16(v0[0], v0[1]); w.y = cvt_pk_bf16(v0[2], v0[3]); w.z = cvt_pk_bf16(v1[0], v1[1]); w.w = cvt_pk_bf16(v1[2], v1[3]);
                    *(u32x4*)(rowp + bj * 128) = w; } }
    } };

template <class Epi>
__device__ __forceinline__ void naive_gemm(const Ctx& C, const bf16* A, const bf16* Bt, int M, int N, int K, int pm_per_grp, size_t grp_stride, const Epi& E) {
    LAS float* As = (LAS float*)C.lds;
    LAS float* Bs = As + 16 * 132;
    LAS float* Bs2 = Bs + 16 * 68;
    const int NO = Epi::DUAL ? N / 2 : N, tn_cnt = NO / 64, nun = (M / 128) * tn_cnt;
    const int ty = C.tid >> 4, tx = C.tid & 15;
    for (int u = C.blk; u < nun; u += C.G) {
        const int tm = u / tn_cnt, tn = u % tn_cnt, row0 = tm * 128, oc0 = tn * 64;
        const bf16* Bg = Bt + (pm_per_grp ? (size_t)((row0 / 256) / pm_per_grp) * grp_stride : (size_t)0);
        const int brow0 = Epi::DUAL ? ((oc0 >> 7) * 256 + (oc0 & 127)) : oc0;
        float acc[4][4], acc2[4][4];
#pragma unroll
        for (int i = 0; i < 4; ++i)
#pragma unroll
            for (int j = 0; j < 4; ++j) { acc[i][j] = 0.f; acc2[i][j] = 0.f; }
        for (int k0 = 0; k0 < K; k0 += 16) {
            __syncthreads();
            { const int r = C.tid >> 2, kc = (C.tid & 3) * 4;
              const u32x2 w = *(const u32x2*)(A + (size_t)(row0 + r) * K + k0 + kc);
              As[(kc + 0) * 132 + r] = bf2f(w.x & 0xffffu); As[(kc + 1) * 132 + r] = bf2f(w.x >> 16); As[(kc + 2) * 132 + r] = bf2f(w.y & 0xffffu); As[(kc + 3) * 132 + r] = bf2f(w.y >> 16); }
            if (C.tid < 256) { const int r = C.tid >> 2, kc = (C.tid & 3) * 4;
              const u32x2 w = *(const u32x2*)(Bg + (size_t)(brow0 + r) * K + k0 + kc);
              Bs[(kc + 0) * 68 + r] = bf2f(w.x & 0xffffu); Bs[(kc + 1) * 68 + r] = bf2f(w.x >> 16); Bs[(kc + 2) * 68 + r] = bf2f(w.y & 0xffffu); Bs[(kc + 3) * 68 + r] = bf2f(w.y >> 16);
              if (Epi::DUAL) { const u32x2 w2 = *(const u32x2*)(Bg + (size_t)(brow0 + 128 + r) * K + k0 + kc);
                Bs2[(kc + 0) * 68 + r] = bf2f(w2.x & 0xffffu); Bs2[(kc + 1) * 68 + r] = bf2f(w2.x >> 16); Bs2[(kc + 2) * 68 + r] = bf2f(w2.y & 0xffffu); Bs2[(kc + 3) * 68 + r] = bf2f(w2.y >> 16); } }
            __syncthreads();
#pragma unroll
            for (int kk = 0; kk < 16; ++kk) {
                const f32x4 a = *(const LAS f32x4*)(As + kk * 132 + ty * 4), b = *(const LAS f32x4*)(Bs + kk * 68 + tx * 4);
#pragma unroll
                for (int i = 0; i < 4; ++i)
#pragma unroll
                    for (int j = 0; j < 4; ++j) acc[i][j] += a[i] * b[j];
                if (Epi::DUAL) { const f32x4 b2 = *(const LAS f32x4*)(Bs2 + kk * 68 + tx * 4);
#pragma unroll
                    for (int i = 0; i < 4; ++i)
#pragma unroll
                        for (int j = 0; j < 4; ++j) acc2[i][j] += a[i] * b2[j]; }
            }
        }
#pragma unroll
        for (int i = 0; i < 4; ++i)
#pragma unroll
            for (int j = 0; j < 4; ++j) E.elem(row0 + ty * 4 + i, oc0 + tx * 4 + j, acc[i][j], acc2[i][j]);
    }
    __syncthreads();
}

template <class Epi>
__device__ __forceinline__ void gemm(const Ctx& C, const bf16* A, const bf16* Bt, int M, int N, int K, int pm_per_grp, size_t grp_stride, const Epi& E) {
#if USE_PG8
    pg8::Gemm g{A, Bt, M, N, K, pm_per_grp, grp_stride}; pg8::StaticOrder S; S.init(M, N, C.G, C.blk);
    pg8::gemm_phase<Epi, pg8::StaticOrder, true, true>(C.lds, g, S, E);
#else
    naive_gemm(C, A, Bt, M, N, K, pm_per_grp, grp_stride, E);
#endif
}
template <class Epi>
__device__ __forceinline__ void small_gemm(const Ctx& C, const bf16* A, const bf16* Bt, int row0, int nrows, int N, int K, const Epi& E) {
    const int ql = C.lane & 31, hi = C.lane >> 5, nrb = nrows / 32, nitems = nrb * (N / 32);
    for (int it = C.blk * 8 + C.wave; it < nitems; it += C.G * 8) {
        const int cb = it / nrb, rb = it % nrb;
        const bf16* ap = A + (size_t)(row0 + rb * 32 + ql) * K + 8 * hi; const bf16* bp = Bt + (size_t)(cb * 32 + ql) * K + 8 * hi;
        f32x16 acc;
#pragma unroll
        for (int r = 0; r < 16; ++r) acc[r] = 0.f;
#pragma unroll 1
        for (int k0 = 0; k0 < K; k0 += 256) {
            bf16x8 a[16], b[16];
#pragma unroll
            for (int q = 0; q < 16; ++q) { a[q] = *(const bf16x8*)(ap + k0 + 16 * q); b[q] = *(const bf16x8*)(bp + k0 + 16 * q); }
            __builtin_amdgcn_sched_barrier(0);
#pragma unroll
            for (int q = 0; q < 16; ++q) acc = __builtin_amdgcn_mfma_f32_32x32x16_bf16(b[q], a[q], acc, 0, 0, 0);
            __builtin_amdgcn_sched_barrier(0);
        }
        const int row = row0 + rb * 32 + ql;
#pragma unroll
        for (int g = 0; g < 4; ++g) E.store4(row, cb * 32 + 8 * g + 4 * hi, (f32x4){acc[4 * g], acc[4 * g + 1], acc[4 * g + 2], acc[4 * g + 3]});
    }
}
template <class Epi>
__device__ __forceinline__ void gemm_tok(const Ctx& C, const bf16* A, const bf16* Bt, int N, int K, bool with_ctx, const Epi& E) {
#if USE_PG8
    gemm(C, A, Bt, SEQ, N, K, 0, 0, E);
    if (with_ctx) small_gemm(C, A, Bt, SEQ, NCTX, N, K, E);
#else
    naive_gemm(C, A, Bt, with_ctx ? R : SEQ, N, K, 0, 0, E);
#endif
}
template <class Epi>
__device__ __forceinline__ void gemm_moe(const Ctx& C, const bf16* A, const bf16* Bt, int N, int K, size_t grp_stride, bool with_ctx, const Epi& E) {
#if USE_PG8
    pg8::Gemm g{A, Bt, XROWS, N, K, 9, grp_stride}; pg8::MoeOrder S; S.init(N, C.G, C.blk, with_ctx);
    pg8::gemm_phase<Epi, pg8::MoeOrder, true, true>(C.lds, g, S, E);
#else
    naive_gemm(C, A, Bt, XROWS, N, K, 9, grp_stride, E);
#endif
}

template <int KIND>
__device__ __forceinline__ void ph_attn_naive(const Ctx& C, int slot) {
    constexpr int DQK = KIND == 2 ? 96 : 64, DH = DQK / 2;
    LAS float* Ks = (LAS float*)C.lds;
    LAS float* Vs = Ks + 32 * DQK;
    LAS float* Bsm = Vs + 32 * 64;
    const bf16 *Qb, *Kb, *Vb, *KRb = nullptr; int qp, kp, vp, kgrp = 1; size_t qhs, khs, vhs; float scale;
    if (KIND == 0) { Qb = WSP(bf16, WS_QKV); Kb = Qb + (size_t)16 * R * 64; Vb = Qb + (size_t)32 * R * 64; qp = kp = vp = 64; qhs = khs = vhs = (size_t)R * 64; scale = 0.125f; }
    else if (KIND == 1) { Qb = WSP(bf16, WS_QKV); Kb = Qb + (size_t)16 * R * 64; Vb = Qb + (size_t)20 * R * 64; qp = kp = vp = 64; qhs = khs = vhs = (size_t)R * 64; kgrp = 4; scale = 0.125f; }
    else { Qb = WSP(bf16, WS_Q); Kb = WSP(bf16, WS_KV); Vb = Kb + 64; KRb = WSP(bf16, WS_KROPE); qp = 96; kp = vp = 128; qhs = (size_t)R * 96; khs = vhs = (size_t)R * 128; scale = 0.10206207261596575f; }
    bf16* Ob = WSP(bf16, WS_O);
    const int half = C.tid & 1, qi = C.tid >> 1;
    for (int u = C.blk; u < 1040; u += C.G) {
        const bool isctx = u >= 1024;
        const int h = isctx ? (u - 1024) : (u & 15), q0 = isctx ? SEQ : (u >> 4) * 256, kh = h / kgrp;
        const int t = q0 + qi;
        float q[DH], o[32];
        { const bf16* qr = Qb + (size_t)t * qp + h * qhs + half * DH;
#pragma unroll
          for (int d = 0; d < DH; d += 8) { const u32x4 w = *(const u32x4*)(qr + d);
              q[d + 0] = bf2f(w.x & 0xffffu); q[d + 1] = bf2f(w.x >> 16); q[d + 2] = bf2f(w.y & 0xffffu); q[d + 3] = bf2f(w.y >> 16);
              q[d + 4] = bf2f(w.z & 0xffffu); q[d + 5] = bf2f(w.z >> 16); q[d + 6] = bf2f(w.w & 0xffffu); q[d + 7] = bf2f(w.w >> 16); } }
#pragma unroll
        for (int d = 0; d < 32; ++d) o[d] = 0.f;
        float m = -INFINITY, l = 0.f;
        if (KIND == 1) { m = C.in[13][h]; l = 1.f; }
        int klo = 0, khi = 0;
        if (!isctx) {
            if (KIND == 0) { const int r0 = q0 >> 6; const int ra = r0 - 4 < 0 ? 0 : r0 - 4, rb = r0 + 7 > 255 ? 255 : r0 + 7; klo = ra * 64; khi = (rb + 1) * 64; }
            else if (KIND == 1) { klo = q0 - 128 < 0 ? 0 : q0 - 128; khi = q0 + 384 > SEQ ? SEQ : q0 + 384; }
            else { klo = 0; khi = SEQ; }
        }
        if (KIND == 0) { __syncthreads(); const float* rp = C.in[10] + ((size_t)slot * 16 + h) * 465; for (int i = C.tid; i < 465; i += 512) Bsm[i] = rp[i]; }
        const int qr_ = t >> 6, qc_ = t & 63;
        int rs = qr_ - 4; rs = rs < 0 ? 0 : (rs > 248 ? 248 : rs);
        int cs0 = qc_ - 8; cs0 = cs0 < 0 ? 0 : (cs0 > 48 ? 48 : cs0);
        for (int seg = 0; seg < 2; ++seg) {
            const int kb = seg == 0 ? klo : SEQ, ke = seg == 0 ? khi : R;
            for (int k0 = kb; k0 < ke; k0 += 32) {
                __syncthreads();
                for (int i = C.tid; i < 32 * DQK; i += 512) { const int j = i / DQK, d = i % DQK; const int row = k0 + j;
                    unsigned b;
                    if (KIND == 2 && d >= 64) b = KRb[(size_t)row * 32 + (d - 64)]; else b = Kb[(size_t)row * kp + kh * khs + d];
                    Ks[i] = bf2f(b); }
                for (int i = C.tid; i < 32 * 64; i += 512) { const int j = i >> 6, d = i & 63; Vs[i] = bf2f(Vb[(size_t)(k0 + j) * vp + kh * vhs + d]); }
                __syncthreads();
#pragma unroll 1
                for (int j = 0; j < 32; ++j) {
                    const int kt = k0 + j; bool valid = true; float bias = 0.f;
                    if (seg == 0) {
                        if (KIND == 0) { const int kr = kt >> 6, kc = kt & 63; valid = kr >= rs && kr < rs + 8 && kc >= cs0 && kc < cs0 + 16;
                            if (valid) bias = Bsm[(kr - qr_ + 7) * 31 + (kc - qc_ + 15)]; }
                        else if (KIND == 1) { const int dd = kt - t; valid = dd <= 128 && dd >= -128; }
                    }
                    float s0 = 0.f, s1 = 0.f;
#pragma unroll
                    for (int d = 0; d < DH; d += 4) { const f32x4 kv = *(const LAS f32x4*)(Ks + j * DQK + half * DH + d); s0 += q[d] * kv.x + q[d + 2] * kv.z; s1 += q[d + 1] * kv.y + q[d + 3] * kv.w; }
                    float sp = s0 + s1; sp += __shfl_xor(sp, 1);
                    if (valid) {
                        const float s = sp * scale + bias;
                        if (s > m) { const float a = __expf(m - s); l *= a;
#pragma unroll
                            for (int d = 0; d < 32; ++d) o[d] *= a;
                            m = s; }
                        const float p = __expf(s - m); l += p;
#pragma unroll
                        for (int d = 0; d < 32; d += 4) { const f32x4 vv = *(const LAS f32x4*)(Vs + j * 64 + half * 32 + d); o[d] += p * vv.x; o[d + 1] += p * vv.y; o[d + 2] += p * vv.z; o[d + 3] += p * vv.w; }
                    }
                }
            }
        }
        { const float il = 1.f / l; bf16* orow = Ob + (size_t)t * D + h * 64 + half * 32;
#pragma unroll
            for (int d = 0; d < 32; d += 8) { u32x4 w; w.x = pk2(o[d] * il, o[d + 1] * il); w.y = pk2(o[d + 2] * il, o[d + 3] * il); w.z = pk2(o[d + 4] * il, o[d + 5] * il); w.w = pk2(o[d + 6] * il, o[d + 7] * il);
                *(u32x4*)(orow + d) = w; } }
    }
    __syncthreads();
}

#ifndef USE_FAST_ATTN
#define USE_FAST_ATTN 1
#endif
__device__ __forceinline__ s16x4 lds_tr16(const LAS unsigned char* p) { return __builtin_bit_cast(s16x4, __builtin_amdgcn_ds_read_tr16_b64_v4i16((LAS s16x4*)p)); }
__device__ __forceinline__ int crow(int r, int hi) { return (r & 3) + 8 * (r >> 2) + 4 * hi; }

#define ATT_BAR() do { __builtin_amdgcn_sched_barrier(0); asm volatile("s_waitcnt lgkmcnt(0)\n\ts_barrier" ::: "memory"); __builtin_amdgcn_sched_barrier(0); } while (0)
template <int KIND>
__device__ __forceinline__ void ph_attn_fast(const Ctx& C, int slot, bool with_ctxq) {
    constexpr int DQK = KIND == 2 ? 96 : 64, NS = DQK / 16, CPR = DQK / 8, CPRP = CPR + 1;
    constexpr int KS = CPRP * 16, VS = 192, KBYTES = 64 * KS, VBYTES = 64 * VS, SLOTB = KBYTES + VBYTES;
    constexpr int NKC = 64 * CPRP, NINST = (NKC + 64 * 12) / 64, NDMA = (NINST + 7) / 8, NRING = 4, PD = 3;
    static_assert(NKC % 64 == 0 && SLOTB % 1024 == 0 && NRING * SLOTB + 2048 <= 131072, "attention ring geometry");
    LAS unsigned char* lds = C.lds; const unsigned lds_u32 = (unsigned)(size_t)C.lds;
    LAS float* Bsm = (LAS float*)(lds + NRING * SLOTB);
    const bf16 *Qb, *Kb, *Vb, *KRb = nullptr; int qp, kp, vp, kgrp = 1; size_t qhs, khs, vhs; float scale;
    if (KIND == 0) { Qb = WSP(bf16, WS_QKV); Kb = Qb + (size_t)16 * R * 64; Vb = Qb + (size_t)32 * R * 64; qp = kp = vp = 64; qhs = khs = vhs = (size_t)R * 64; scale = 0.125f; }
    else if (KIND == 1) { Qb = WSP(bf16, WS_QKV); Kb = Qb + (size_t)16 * R * 64; Vb = Qb + (size_t)20 * R * 64; qp = kp = vp = 64; qhs = khs = vhs = (size_t)R * 64; kgrp = 4; scale = 0.125f; }
    else { Qb = WSP(bf16, WS_Q); Kb = WSP(bf16, WS_KV); Vb = Kb + 64; KRb = WSP(bf16, WS_KROPE); qp = 96; kp = vp = 128; qhs = (size_t)R * 96; khs = vhs = (size_t)R * 128; scale = 0.10206207261596575f; }
    bf16* Ob = WSP(bf16, WS_O);
    const float c2 = scale * 1.4426950408889634f;
    const int w = C.wave, lane = C.lane, ql = lane & 31, hi = lane >> 5;
    const int vlane = (((lane & 15) >> 2) + 4 * hi) * VS + (16 * ((lane >> 4) & 1) + 4 * (lane & 3)) * 2;
    const int nunits = with_ctxq ? 1040 : 1024;
    for (int u = C.blk; u < nunits; u += C.G) {
        const bool isctx = u >= 1024;
        const int h = isctx ? (u - 1024) : (u & 15), q0 = isctx ? SEQ : (u >> 4) * 256, kh = h / kgrp;
        int lat0 = 0, nlat = 0;
        if (!isctx) {
            if (KIND == 0) { const int r0 = q0 >> 6; int ta = r0 - 4; ta = ta < 0 ? 0 : (ta > 248 ? 248 : ta); int tb = r0 - 1; tb = (tb < 0 ? 0 : (tb > 248 ? 248 : tb)) + 7; lat0 = ta; nlat = tb - ta + 1; }
            else if (KIND == 1) { const int a = q0 - 128 < 0 ? 0 : q0 - 128, b = q0 + 384 > SEQ ? SEQ : q0 + 384; lat0 = a >> 6; nlat = (b - a) >> 6; }
            else { lat0 = 0; nlat = SEQ / 64; }
        }
        const int ntiles = nlat + 4;
        const int t = q0 + 32 * w + ql;
        bf16x8 qf[NS];
        { const bf16* qr = Qb + (size_t)t * qp + h * qhs + 8 * hi;
#pragma unroll
          for (int sidx = 0; sidx < NS; ++sidx) qf[sidx] = *(const bf16x8*)(qr + 16 * sidx); }
        const char* gsrc[NDMA]; int gpitch[NDMA], ldst[NDMA];
#pragma unroll
        for (int jj = 0; jj < NDMA; ++jj) {
            int j = w + 8 * jj; if (j >= NINST) j -= 8;
            const int cidx = 64 * j + lane; ldst[jj] = j * 1024;
            if (cidx < NKC) { const int row = cidx / CPRP; int c = cidx % CPRP; if (c >= CPR) c = 0;
                if (KIND == 2 && c >= 8) { gsrc[jj] = (const char*)(KRb + (size_t)row * 32 + 8 * (c - 8)); gpitch[jj] = 64; }
                else { gsrc[jj] = (const char*)(Kb + kh * khs + (size_t)row * kp + 8 * c); gpitch[jj] = kp * 2; } }
            else { const int v = cidx - NKC, row = v / 12; int c = v % 12; if (c >= 8) c = 0;
                gsrc[jj] = (const char*)(Vb + kh * vhs + (size_t)row * vp + 8 * c); gpitch[jj] = vp * 2; }
        }
#define ATT_KEY0(i) ((i) < nlat ? (lat0 + (i)) * 64 : SEQ + ((i) - nlat) * 64)
#define ATT_DMA(i, sl) do { const int ti_ = (i) < ntiles ? (i) : ntiles - 1; const size_t key0_ = (size_t)ATT_KEY0(ti_); \
        _Pragma("unroll") for (int jj = 0; jj < NDMA; ++jj) \
            __builtin_amdgcn_global_load_lds((const unsigned*)(gsrc[jj] + key0_ * gpitch[jj]), (LAS unsigned*)(lds + (sl) * SLOTB + ldst[jj]), 16, 0, 0); } while (0)
#define ATT_WAIT_DMA() do { if (NDMA == 4) asm volatile("s_waitcnt vmcnt(8)" ::: "memory"); else asm volatile("s_waitcnt vmcnt(6)" ::: "memory"); } while (0)
        __syncthreads();
        if (w >= 4) __builtin_amdgcn_s_setprio(1);
        if (KIND == 0) { const float* rp = C.in[10] + ((size_t)slot * 16 + h) * 465; for (int i = C.tid; i < 465; i += 512) Bsm[i] = rp[i] * 1.4426950408889634f; }
        asm volatile("s_waitcnt vmcnt(0)" ::: "memory");
        ATT_DMA(0, 0); ATT_DMA(1, 1); ATT_DMA(2, 2);
        float m = -INFINITY, l = 0.f;
        if (KIND == 1) { m = C.in[13][h] * 1.4426950408889634f; l = hi ? 0.f : 1.f; }
        f32x16 ot[2];
#pragma unroll
        for (int r = 0; r < 16; ++r) { ot[0][r] = 0.f; ot[1][r] = 0.f; }
        const int qr_ = t >> 6, qc_ = t & 63;
        int cs0 = qc_ - 8; cs0 = cs0 < 0 ? 0 : (cs0 > 48 ? 48 : cs0);
        const int wrow = (q0 >> 6) + (w >> 1);
        int wrs = wrow - 4; wrs = wrs < 0 ? 0 : (wrs > 248 ? 248 : wrs);
        const int wq0 = q0 + 32 * w;
        if constexpr (KIND == 2) {
            { float qs = 0.f;
#pragma unroll
              for (int sidx = 0; sidx < NS; ++sidx)
#pragma unroll
                  for (int j = 0; j < 8; ++j) { const float qv = bf2f((unsigned)(unsigned short)qf[sidx][j]); qs += qv * qv; }
              const auto sw = __builtin_amdgcn_permlane32_swap(__float_as_uint(qs), __float_as_uint(qs), false, false);
              qs = __uint_as_float(sw[0]) + __uint_as_float(sw[1]);
              const float k2 = __uint_as_float(__hip_atomic_load((unsigned*)(C.ws + WS_CTL) + CW_KMAX + h, __ATOMIC_RELAXED, __HIP_MEMORY_SCOPE_AGENT));
              m = c2 * sqrtf(qs * k2) * 1.001f + 0.01f; }
            asm volatile("s_waitcnt vmcnt(4)" ::: "memory");
            ATT_BAR();
            f32x16 pa0, pa1, pb0, pb1;
#define MLA_QK(D0, D1, sl) do { const LAS unsigned char* kb_ = lds + (sl) * SLOTB; \
            _Pragma("unroll") for (int r_ = 0; r_ < 16; ++r_) { D0[r_] = 0.f; D1[r_] = 0.f; } \
            _Pragma("unroll") for (int sidx = 0; sidx < NS; ++sidx) { \
                const bf16x8 a0_ = *(const LAS bf16x8*)(kb_ + ql * KS + 32 * sidx + 16 * hi); \
                const bf16x8 a1_ = *(const LAS bf16x8*)(kb_ + (32 + ql) * KS + 32 * sidx + 16 * hi); \
                D0 = __builtin_amdgcn_mfma_f32_32x32x16_bf16(a0_, qf[sidx], D0, 0, 0, 0); \
                D1 = __builtin_amdgcn_mfma_f32_32x32x16_bf16(a1_, qf[sidx], D1, 0, 0, 0); } } while (0)
#define MLA_ITER(P0, P1, S0, S1, it) do { \
            ATT_DMA((it) + 3, ((it) + 3) & 3); \
            MLA_QK(S0, S1, ((it) + 1) & 3);                                     \
            float rs0_ = 0.f, rs1_ = 0.f, rs2_ = 0.f, rs3_ = 0.f;                  \
            _Pragma("unroll") for (int r_ = 0; r_ < 16; r_ += 2) { \
                P0[r_] = __builtin_amdgcn_exp2f(__builtin_fmaf(P0[r_], c2, -m)); P1[r_] = __builtin_amdgcn_exp2f(__builtin_fmaf(P1[r_], c2, -m)); \
                P0[r_ + 1] = __builtin_amdgcn_exp2f(__builtin_fmaf(P0[r_ + 1], c2, -m)); P1[r_ + 1] = __builtin_amdgcn_exp2f(__builtin_fmaf(P1[r_ + 1], c2, -m)); \
                rs0_ += P0[r_]; rs1_ += P1[r_]; rs2_ += P0[r_ + 1]; rs3_ += P1[r_ + 1]; } \
            l += (rs0_ + rs1_) + (rs2_ + rs3_); \
            bf16x8 pf_[4]; \
            _Pragma("unroll") for (int ks = 0; ks < 2; ++ks) { u32x4 pw_; \
                pw_.x = cvt_pk_bf16(P0[8 * ks + 0], P0[8 * ks + 1]); pw_.y = cvt_pk_bf16(P0[8 * ks + 2], P0[8 * ks + 3]); pw_.z = cvt_pk_bf16(P0[8 * ks + 4], P0[8 * ks + 5]); pw_.w = cvt_pk_bf16(P0[8 * ks + 6], P0[8 * ks + 7]); \
                pf_[ks] = __builtin_bit_cast(bf16x8, pw_); \
                pw_.x = cvt_pk_bf16(P1[8 * ks + 0], P1[8 * ks + 1]); pw_.y = cvt_pk_bf16(P1[8 * ks + 2], P1[8 * ks + 3]); pw_.z = cvt_pk_bf16(P1[8 * ks + 4], P1[8 * ks + 5]); pw_.w = cvt_pk_bf16(P1[8 * ks + 6], P1[8 * ks + 7]); \
                pf_[2 + ks] = __builtin_bit_cast(bf16x8, pw_); } \
            __builtin_amdgcn_sched_group_barrier(0x100, 4, 0); \
            _Pragma("unroll") for (int g_ = 0; g_ < 12; ++g_) { __builtin_amdgcn_sched_group_barrier(0x008, 1, 0); __builtin_amdgcn_sched_group_barrier(0x100, 2, 0); __builtin_amdgcn_sched_group_barrier(0x002, 13, 0); } \
            { const unsigned va_ = lds_u32 + (unsigned)(((it) & 3) * SLOTB + KBYTES + vlane); \
              _Pragma("unroll") for (int c = 0; c < 2; ++c) { \
                s16x4 lo_[4], hi_[4]; \
                _Pragma("unroll") for (int ks = 0; ks < 4; ++ks) { \
                    asm volatile("ds_read_b64_tr_b16 %0, %1 offset:%c2" : "=&v"(lo_[ks]) : "v"(va_), "i"((32 * (ks >> 1) + 16 * (ks & 1)) * VS + 64 * c) : "memory"); \
                    asm volatile("ds_read_b64_tr_b16 %0, %1 offset:%c2" : "=&v"(hi_[ks]) : "v"(va_), "i"((32 * (ks >> 1) + 16 * (ks & 1) + 8) * VS + 64 * c) : "memory"); } \
                asm volatile("s_waitcnt lgkmcnt(0)" ::: "memory"); __builtin_amdgcn_sched_barrier(0); \
                _Pragma("unroll") for (int ks = 0; ks < 4; ++ks) { \
                    const bf16x8 av_ = (bf16x8){lo_[ks][0], lo_[ks][1], lo_[ks][2], lo_[ks][3], hi_[ks][0], hi_[ks][1], hi_[ks][2], hi_[ks][3]}; \
                    ot[c] = __builtin_amdgcn_mfma_f32_32x32x16_bf16(av_, pf_[ks], ot[c], 0, 0, 0); } } } \
            asm volatile("s_waitcnt vmcnt(4)" ::: "memory");          \
            ATT_BAR(); } while (0)
            MLA_QK(pa0, pa1, 0);
            for (int i = 0; i < ntiles; i += 2) {
                MLA_ITER(pa0, pa1, pb0, pb1, i);
                MLA_ITER(pb0, pb1, pa0, pa1, i + 1);
            }
#undef MLA_QK
#undef MLA_ITER
        } else {
        ATT_WAIT_DMA();
        ATT_BAR();
        int rs_cur = 0, rs_nxt = 3;
        for (int i = 0; i < ntiles; ++i) {
            ATT_DMA(i + PD, rs_nxt);
            const bool lat = i < nlat; const int key0 = ATT_KEY0(i);
            bool need = true;
            if (lat) { if (KIND == 0) { const int kr = lat0 + i; need = kr >= wrs && kr < wrs + 8; }
                       else if (KIND == 1) need = (key0 + 63 >= wq0 - 128) && (key0 <= wq0 + 31 + 128); }
            if (need) {
                const LAS unsigned char* kb = lds + rs_cur * SLOTB; const LAS unsigned char* vb = kb + KBYTES;
                f32x16 p0, p1;
#pragma unroll
                for (int r = 0; r < 16; ++r) { p0[r] = 0.f; p1[r] = 0.f; }
#pragma unroll
                for (int sidx = 0; sidx < NS; ++sidx) {
                    const bf16x8 a0 = *(const LAS bf16x8*)(kb + ql * KS + 32 * sidx + 16 * hi);
                    const bf16x8 a1 = *(const LAS bf16x8*)(kb + (32 + ql) * KS + 32 * sidx + 16 * hi);
                    p0 = __builtin_amdgcn_mfma_f32_32x32x16_bf16(a0, qf[sidx], p0, 0, 0, 0);
                    p1 = __builtin_amdgcn_mfma_f32_32x32x16_bf16(a1, qf[sidx], p1, 0, 0, 0);
                }
                float mx = -INFINITY;
                if (KIND == 0) {
#pragma unroll
                    for (int r = 0; r < 16; ++r) {
                        float s0 = p0[r] * c2, s1 = p1[r] * c2;
                        if (lat) { const int kr = lat0 + i; const int kc = crow(r, hi);
                            const bool v0 = (unsigned)(kc - cs0) < 16u, v1 = (unsigned)(kc + 32 - cs0) < 16u;
                            const int bi = (kr - qr_ + 7) * 31 + (kc - qc_ + 15);
                            s0 = v0 ? s0 + Bsm[v0 ? bi : 0] : -INFINITY; s1 = v1 ? s1 + Bsm[v1 ? bi + 32 : 0] : -INFINITY; }
                        p0[r] = s0; p1[r] = s1; mx = fmaxf(fmaxf(mx, s0), s1);
                    }
                } else {
                    if (KIND == 1 && lat) {
#pragma unroll
                        for (int r = 0; r < 16; ++r) { const int dd = key0 + crow(r, hi) - t;
                            p0[r] = (unsigned)(dd + 128) <= 256u ? p0[r] : -INFINITY; p1[r] = (unsigned)(dd + 32 + 128) <= 256u ? p1[r] : -INFINITY; }
                    }
#pragma unroll
                    for (int r = 0; r < 16; ++r) mx = fmaxf(fmaxf(mx, p0[r]), p1[r]);
                    mx *= c2;
                }
                { const auto sw = __builtin_amdgcn_permlane32_swap(__float_as_uint(mx), __float_as_uint(mx), false, false);
                  mx = fmaxf(__uint_as_float(sw[0]), __uint_as_float(sw[1])); }
                const float mn = fmaxf(m, mx), ms = mn == -INFINITY ? 0.f : mn;
                const float alpha = __builtin_amdgcn_exp2f(m - ms);
                float rsum = 0.f;
                if (KIND == 0) {
#pragma unroll
                    for (int r = 0; r < 16; ++r) { p0[r] = __builtin_amdgcn_exp2f(p0[r] - ms); p1[r] = __builtin_amdgcn_exp2f(p1[r] - ms); rsum += p0[r] + p1[r]; }
                } else {
#pragma unroll
                    for (int r = 0; r < 16; ++r) { p0[r] = __builtin_amdgcn_exp2f(__builtin_fmaf(p0[r], c2, -ms)); p1[r] = __builtin_amdgcn_exp2f(__builtin_fmaf(p1[r], c2, -ms)); rsum += p0[r] + p1[r]; }
                }
                l = l * alpha + rsum; m = mn;
                if (__builtin_amdgcn_ballot_w64(alpha != 1.f) != 0ull) {
#pragma unroll
                    for (int r = 0; r < 16; ++r) { ot[0][r] *= alpha; ot[1][r] *= alpha; }
                }
                bf16x8 pf[4];
#pragma unroll
                for (int ks = 0; ks < 4; ++ks) { u32x4 pw;
                    if (ks < 2) { pw.x = cvt_pk_bf16(p0[8 * ks + 0], p0[8 * ks + 1]); pw.y = cvt_pk_bf16(p0[8 * ks + 2], p0[8 * ks + 3]); pw.z = cvt_pk_bf16(p0[8 * ks + 4], p0[8 * ks + 5]); pw.w = cvt_pk_bf16(p0[8 * ks + 6], p0[8 * ks + 7]); }
                    else { const int k8 = 8 * (ks - 2); pw.x = cvt_pk_bf16(p1[k8 + 0], p1[k8 + 1]); pw.y = cvt_pk_bf16(p1[k8 + 2], p1[k8 + 3]); pw.z = cvt_pk_bf16(p1[k8 + 4], p1[k8 + 5]); pw.w = cvt_pk_bf16(p1[k8 + 6], p1[k8 + 7]); }
                    pf[ks] = __builtin_bit_cast(bf16x8, pw); }
                { const unsigned va = lds_u32 + (unsigned)(rs_cur * SLOTB + KBYTES + vlane);
#pragma unroll
                  for (int c = 0; c < 2; ++c) {
                    s16x4 lo[4], hi4[4];
#pragma unroll
                    for (int ks = 0; ks < 4; ++ks) {
                        asm volatile("ds_read_b64_tr_b16 %0, %1 offset:%c2" : "=&v"(lo[ks]) : "v"(va), "i"((32 * (ks >> 1) + 16 * (ks & 1)) * VS + 64 * c) : "memory");
                        asm volatile("ds_read_b64_tr_b16 %0, %1 offset:%c2" : "=&v"(hi4[ks]) : "v"(va), "i"((32 * (ks >> 1) + 16 * (ks & 1) + 8) * VS + 64 * c) : "memory"); }
                    asm volatile("s_waitcnt lgkmcnt(0)" ::: "memory"); __builtin_amdgcn_sched_barrier(0);
#pragma unroll
                    for (int ks = 0; ks < 4; ++ks) {
                        const bf16x8 av = (bf16x8){lo[ks][0], lo[ks][1], lo[ks][2], lo[ks][3], hi4[ks][0], hi4[ks][1], hi4[ks][2], hi4[ks][3]};
                        ot[c] = __builtin_amdgcn_mfma_f32_32x32x16_bf16(av, pf[ks], ot[c], 0, 0, 0); }
                  } }
            }
            ATT_WAIT_DMA();
            ATT_BAR();
            rs_cur = (rs_cur + 1) & 3; rs_nxt = (rs_nxt + 1) & 3;
        }
        }
        asm volatile("s_waitcnt vmcnt(0)" ::: "memory");
        __builtin_amdgcn_s_setprio(0);
#undef ATT_KEY0
#undef ATT_DMA
#undef ATT_WAIT_DMA
        { const auto sw = __builtin_amdgcn_permlane32_swap(__float_as_uint(l), __float_as_uint(l), false, false);
          const float il = 1.f / (__uint_as_float(sw[0]) + __uint_as_float(sw[1])); bf16* orow = Ob + (size_t)t * D + h * 64 + 4 * hi;
#pragma unroll
          for (int c = 0; c < 2; ++c)
#pragma unroll
            for (int g = 0; g < 4; ++g) { u32x2 o2; o2.x = cvt_pk_bf16(ot[c][4 * g] * il, ot[c][4 * g + 1] * il); o2.y = cvt_pk_bf16(ot[c][4 * g + 2] * il, ot[c][4 * g + 3] * il);
                *(u32x2*)(orow + 32 * c + 8 * g) = o2; } }
    }
    __syncthreads();
}
template <int KIND>
__device__ __forceinline__ void ph_attn(const Ctx& C, int slot, bool with_ctxq) {
#if USE_FAST_ATTN
    ph_attn_fast<KIND>(C, slot, with_ctxq);
#else
    ph_attn_naive<KIND>(C, slot);
#endif
}

#define PH_BEGIN if (lo <= ph && ph < hi) {
#define PH_END   if (ph + 1 < hi) xcd_barrier(bar); } ++ph;
#ifndef PROBE_MASK
#define PROBE_MASK 0
#endif
#define PHG(g, ...) PH_BEGIN __VA_ARGS__ PH_END if constexpr (((PROBE_MASK >> (g)) & 1) != 0) { PH_BEGIN __VA_ARGS__ PH_END }
template <int L>
__device__ __forceinline__ void layer_phases(const Ctx& C, const XcdBarrier& bar, int lo, int hi, int& ph) {
    constexpr int l = L, kind = L % 3, slot = L / 3; constexpr bool need_ctx = L < 3; constexpr int RL = need_ctx ? R : SEQ;
    PH_BEGIN ph_rowA<0>(C, l); PH_END
    if constexpr (kind == 0) {
        PHG(1, gemm_tok(C, WSP(bf16, WS_H), WSP(bf16, WS_W_NAQKV) + (size_t)slot * 3072 * 1024, 3072, 1024, true, EpiStoreHeads{WSP(bf16, WS_QKV), 64, (size_t)R * 64});)
        PHG(2, ph_attn<0>(C, slot, need_ctx);)
    } else if constexpr (kind == 1) {
        PHG(1, gemm_tok(C, WSP(bf16, WS_H), WSP(bf16, WS_W_SWAQKV), 1536, 1024, true, EpiStoreHeads{WSP(bf16, WS_QKV), 64, (size_t)R * 64});)
        PH_BEGIN ph_rope(C, WSP(bf16, WS_QKV), 64, 20, 0, 16); PH_END
        PHG(3, ph_attn<1>(C, slot, need_ctx);)
    } else {
        PHG(1, gemm_tok(C, WSP(bf16, WS_H), WSP(bf16, WS_W_MLAD), 1024, 1024, true, EpiStoreF32{WSP(float, WS_CQ), 1024});)
        PHG(11, ph_mlanorm(C);)
        PHG(1, gemm_tok(C, WSP(bf16, WS_CQN), WSP(bf16, WS_W_MLAUQ), 1536, 512, true, EpiStoreHeads{WSP(bf16, WS_Q), 96, (size_t)R * 96});
                 gemm_tok(C, WSP(bf16, WS_CKVN), WSP(bf16, WS_W_MLAUKV), 2048, 256, true, EpiStoreHeads{WSP(bf16, WS_KV), 128, (size_t)R * 128});)
        PH_BEGIN ph_rope(C, WSP(bf16, WS_Q), 96, 16, 64, 8); ph_kmax(C); PH_END
        PHG(4, ph_attn<2>(C, slot, need_ctx);)
    }
    const bf16* wo = kind == 0 ? WSP(bf16, WS_W_NAO) + (size_t)slot * 1024 * 1024 : (kind == 1 ? WSP(bf16, WS_W_SWAO) : WSP(bf16, WS_W_MLAO));
    PH_BEGIN gemm_tok(C, WSP(bf16, WS_O), wo, 1024, 1024, need_ctx, EpiResid{WSP(float, WS_X), modp(C, l, 0, 2), modp(C, l, 1, 2)}); PH_END
    PHG(5, ph_norm2(C, l, RL);)
    PHG(6, ph_topk(C, need_ctx);)
    PHG(7, ph_gather(C, need_ctx);)
    PHG(8, gemm_moe(C, WSP(bf16, WS_XG), WSP(bf16, WS_W_GU) + (size_t)l * 16 * 4096 * 1024, 4096, 1024, (size_t)4096 * 1024, need_ctx, EpiSwiglu{WSP(bf16, WS_ACT)});)
    PHG(9, gemm_moe(C, WSP(bf16, WS_ACT), WSP(bf16, WS_W_DN) + (size_t)l * 16 * 1024 * 2048, 1024, 2048, (size_t)1024 * 2048, need_ctx, EpiMoeOut{WSP(bf16, WS_YB), WSP(float, WS_GATEL)});)
}
__global__ void __launch_bounds__(512, 2) fwd_kernel(Args args) {
    extern __shared__ __attribute__((aligned(16))) unsigned char lds_raw[];
    Ctx C;
#pragma unroll
    for (int i = 0; i < 26; ++i) C.in[i] = args.in[i];
    C.out = args.out; C.ws = args.ws; C.lds = (LAS unsigned char*)lds_raw;
    C.tid = threadIdx.x; C.lane = C.tid & 63; C.wave = __builtin_amdgcn_readfirstlane(C.tid >> 6); C.blk = blockIdx.x; C.G = gridDim.x;
    volatile LAS unsigned* MISC = (volatile LAS unsigned*)(C.lds + MISC_OFF);
    if (C.tid < 32) MISC[C.tid] = 0u;
    __syncthreads();
    const int lo = args.ph_lo, hi = args.ph_hi;
    XcdBarrier bar; bar.bar = (unsigned*)(C.ws + WS_CTL) + CW_BAR; bar.x = 0; bar.st = nullptr;
    if (hi - lo > 1) bar = xcd_barrier_post((unsigned*)(C.ws + WS_CTL) + CW_BAR, MISC + 8);
    int ph = 0;
    PHG(0, ph_prologue(C);)
    layer_phases<0>(C, bar, lo, hi, ph);
    layer_phases<1>(C, bar, lo, hi, ph);
    layer_phases<2>(C, bar, lo, hi, ph);
    layer_phases<3>(C, bar, lo, hi, ph);
    PH_BEGIN ph_rowA<1>(C, 4); PH_END
}
#undef PH_BEGIN
#undef PH_END

extern "C" void kernel_launch(void* const* d_in, const int* in_sizes, int n_in, void* d_out, int out_size, void* d_ws, size_t ws_size, hipStream_t stream) {
    static int grid = 0;
    if (grid == 0) {
        if (n_in != 26 || out_size != SEQ * D || ws_size < WS_END) { fprintf(stderr, "kernel_launch: unexpected shapes (n_in %d out %d ws %zu)\n", n_in, out_size, ws_size); grid = -1; return; }
        int dev = 0, cus = 0, per_cu = 0;
        if (hipGetDevice(&dev) != hipSuccess || hipDeviceGetAttribute(&cus, hipDeviceAttributeMultiprocessorCount, dev) != hipSuccess) { grid = -1; return; }
        if (hipFuncSetAttribute((const void*)fwd_kernel, hipFuncAttributeMaxDynamicSharedMemorySize, LDS_BYTES) != hipSuccess) { fprintf(stderr, "kernel_launch: hipFuncSetAttribute failed\n"); grid = -1; return; }
        if (hipOccupancyMaxActiveBlocksPerMultiprocessor(&per_cu, (const void*)fwd_kernel, 512, LDS_BYTES) != hipSuccess || per_cu < 1) fprintf(stderr, "kernel_launch: occupancy query says %d\n", per_cu);
        (void)hipGetLastError();
        grid = cus;
    }
    if (grid < 0) return;
    if (hipMemsetAsync((char*)d_ws + WS_CTL, 0, CTL_ZERO_BYTES, stream) != hipSuccess) return;
    Args a{};
    for (int i = 0; i < 26; ++i) a.in[i] = (const float*)d_in[i];
    a.out = (float*)d_out; a.ws = (unsigned char*)d_ws; a.pad = 0;
#if MK_N_LAUNCHES == 1
    a.ph_lo = 0; a.ph_hi = 1 << 20; a.li = 0;
    hipLaunchKernelGGL(fwd_kernel, dim3(grid), dim3(512), LDS_BYTES, stream, a);
#else
    for (int li = 0; li < NPH; ++li) { a.ph_lo = li; a.ph_hi = li + 1; a.li = li;
        hipLaunchKernelGGL(fwd_kernel, dim3(grid), dim3(512), LDS_BYTES, stream, a); }
#endif
}
```

```cpp
#include <hip/hip_runtime.h>
#include <cstdio>
#include <cstdint>

#ifndef MK_N_LAUNCHES
#define MK_N_LAUNCHES 1
#endif

#define GAS __attribute__((address_space(1)))
#define LAS __attribute__((address_space(3)))
typedef unsigned short bf16;
typedef float f32x4 __attribute__((ext_vector_type(4)));
typedef unsigned u32x4 __attribute__((ext_vector_type(4)));
typedef unsigned u32x2 __attribute__((ext_vector_type(2)));
typedef short bf16x8 __attribute__((ext_vector_type(8)));
typedef short s16x4 __attribute__((ext_vector_type(4)));
typedef float f32x16 __attribute__((ext_vector_type(16)));

constexpr int D = 1024, SEQ = 16384, NCTX = 256, R = SEQ + NCTX, NE = 16, FF = 2048;
constexpr int CAP_L = 2048, CAP_C = 32, EROWS = 2304, XROWS = NE * EROWS;
constexpr float RMS_EPS = 1e-6f;
constexpr int NPH = 1 + 9 + 10 + 12 + 9 + 1;

constexpr size_t MiB = 1u << 20;
constexpr size_t WS_CTL = 0, CTL_ZERO_BYTES = 1 * MiB;
constexpr size_t WS_MOD = 1 * MiB;
constexpr size_t WS_W_NAQKV = 2 * MiB;
constexpr size_t WS_W_NAO = 14 * MiB;
constexpr size_t WS_W_SWAQKV = 18 * MiB;
constexpr size_t WS_W_SWAO = 21 * MiB;
constexpr size_t WS_W_MLAD = 23 * MiB;
constexpr size_t WS_W_MLAUQ = 25 * MiB;
constexpr size_t WS_W_MLAUKV = 27 * MiB;
constexpr size_t WS_W_MLAO = 28 * MiB;
constexpr size_t WS_W_GU = 32 * MiB;
constexpr size_t WS_W_DN = WS_W_GU + 512 * MiB;
constexpr size_t WS_X = WS_W_DN + 256 * MiB;
constexpr size_t WS_H = WS_X + 65 * MiB;
constexpr size_t WS_QKV = WS_H + 33 * MiB;
constexpr size_t WS_CQ = WS_QKV + 98 * MiB;
constexpr size_t WS_Q = WS_CQ + 65 * MiB;
constexpr size_t WS_KV = WS_Q + 49 * MiB;
constexpr size_t WS_CQN = WS_KV + 65 * MiB;
constexpr size_t WS_CKVN = WS_CQN + 17 * MiB;
constexpr size_t WS_KROPE = WS_CKVN + 9 * MiB;
constexpr size_t WS_O = WS_KROPE + 2 * MiB;
constexpr size_t WS_AFF = WS_O + 33 * MiB;
constexpr size_t WS_ROWL = WS_AFF + 2 * MiB;
constexpr size_t WS_GATEL = WS_ROWL + 1 * MiB;
constexpr size_t WS_INV = WS_GATEL + 1 * MiB;
constexpr size_t WS_XG = WS_INV + 2 * MiB;
constexpr size_t WS_ACT = WS_XG + 72 * MiB;
constexpr size_t WS_YB = WS_ACT + 144 * MiB;
constexpr size_t WS_END = WS_YB + 72 * MiB;
static_assert(WS_END <= 2048 * MiB, "d_ws map");
constexpr int CW_BAR = 4096;

constexpr int LDS_BYTES = 147456;
constexpr int MISC_OFF = 131072 + 320;

__device__ __forceinline__ float bf2f(unsigned b) { return __uint_as_float(b << 16); }
__device__ __forceinline__ unsigned f2bf(float f) { unsigned u = __float_as_uint(f); return (u + 0x7fffu + ((u >> 16) & 1u)) >> 16; }
__device__ __forceinline__ unsigned pk2(float lo, float hi) { return f2bf(lo) | (f2bf(hi) << 16); }
__device__ __forceinline__ float wave_sum(float v) {
#pragma unroll
    for (int o = 1; o < 64; o <<= 1) v += __shfl_xor(v, o);
    return v;
}
__device__ __forceinline__ int wave_sum_i(int v) {
#pragma unroll
    for (int o = 1; o < 64; o <<= 1) v += __shfl_xor(v, o);
    return v;
}

#define XB_TMO      128
#define XB_XCNT(j)  (256  + 64 * (j))
#define XB_XSUB(j)  (1280 + 64 * (j))
#define XB_XGEN(j)  (2304 + 64 * (j))
#define XB_TOP      3328
#define XB_TOPGEN   3392
#define XCD_BAR_WORDS 3456
#define XB_SPIN_CAP (1u << 18)
__device__ __forceinline__ unsigned xb_ld(unsigned* p)              { return __hip_atomic_load(p, __ATOMIC_RELAXED, __HIP_MEMORY_SCOPE_AGENT); }
__device__ __forceinline__ unsigned xb_add(unsigned* p, unsigned v) { return __hip_atomic_fetch_add(p, v, __ATOMIC_RELAXED, __HIP_MEMORY_SCOPE_AGENT); }
__device__ __forceinline__ unsigned xb_xcc_id() { return (unsigned)__builtin_amdgcn_s_getreg((3 << 11) | 20) & 0xFu; }
#define XB_SPIN(cond, bar) do { unsigned _sp = 0; while (cond) { __builtin_amdgcn_s_sleep(1); \
    if ((++_sp & 255u) == 0u) { if (xb_ld(&(bar)[XB_TMO])) break; if (_sp > XB_SPIN_CAP) { atomicAdd(&(bar)[XB_TMO], 1u); break; } } } } while (0)
struct XcdBarrier { unsigned* bar; unsigned x; volatile LAS unsigned* st; };
__device__ __forceinline__ XcdBarrier xcd_barrier_post(unsigned* bar, volatile LAS unsigned* st) {
    XcdBarrier b; b.bar = bar; b.x = xb_xcc_id(); b.st = st;
    if (threadIdx.x == 0) (void)xb_add(&bar[XB_XCNT(b.x)], 1u);
    return b;
}
__device__ __forceinline__ void xcd_barrier_complete(unsigned* bar, unsigned x, unsigned& nloc, unsigned& nx) {
    const unsigned G = gridDim.x * gridDim.y * gridDim.z;
    unsigned sum, cnt, mine, sp = 0u;
    for (;;) {
        sum = 0u; cnt = 0u; mine = 0u;
#pragma unroll
        for (unsigned j = 0; j < 16; ++j) { const unsigned c = xb_ld(&bar[XB_XCNT(j)]); sum += c; cnt += (c > 0u) ? 1u : 0u; mine = (j == x) ? c : mine; }
        if (sum == G) break;
        __builtin_amdgcn_s_sleep(1);
        if ((++sp & 255u) == 0u) { if (xb_ld(&bar[XB_TMO])) break; if (sp > XB_SPIN_CAP) { atomicAdd(&bar[XB_TMO], 1u); break; } }
    }
    nloc = mine > 0u ? mine : 1u; nx = cnt > 0u ? cnt : 1u;
}
__device__ __forceinline__ void xcd_barrier(const XcdBarrier& b) {
    asm volatile("s_waitcnt vmcnt(0)" ::: "memory");
    __syncthreads();
    if (threadIdx.x == 0) {
        unsigned* bar = b.bar;
        __builtin_amdgcn_s_waitcnt(0);
        unsigned nloc = b.st[0], nx = b.st[1];
        if (nloc == 0u) { xcd_barrier_complete(bar, b.x, nloc, nx); b.st[0] = nloc; b.st[1] = nx; }
        const unsigned old = xb_add(&bar[XB_XSUB(b.x)], 1u);
        const unsigned gen = old / nloc;
        if (old + 1u == (gen + 1u) * nloc) {
            __builtin_amdgcn_fence(__ATOMIC_RELEASE, "agent");
            asm volatile("s_waitcnt vmcnt(0)" ::: "memory");
            const unsigned og = xb_add(&bar[XB_TOP], 1u);
            const unsigned tg = og / nx;
            if (og + 1u == (tg + 1u) * nx) xb_add(&bar[XB_TOPGEN], 1u);
            else XB_SPIN(xb_ld(&bar[XB_TOPGEN]) == tg, bar);
            __builtin_amdgcn_fence(__ATOMIC_ACQUIRE, "agent");
            xb_add(&bar[XB_XGEN(b.x)], 1u);
            asm volatile("s_waitcnt vmcnt(0)" ::: "memory");
        } else {
            XB_SPIN(xb_ld(&bar[XB_XGEN(b.x)]) == gen, bar);
            __builtin_amdgcn_fence(__ATOMIC_ACQUIRE, "agent");
            asm volatile("s_waitcnt vmcnt(0)" ::: "memory");
        }
    }
    __syncthreads();
}

struct Args { const float* in[26]; float* out; unsigned char* ws; int ph_lo, ph_hi, li, pad; };
struct Ctx {
    const float* in[26]; float* out; unsigned char* ws;
    LAS unsigned char* lds;
    int tid, lane, wave, blk, G;
};
#define WSP(T, off) ((T*)(C.ws + (off)))
__device__ __forceinline__ const float* modp(const Ctx& C, int l, int set, int j) { return (const float*)(C.ws + WS_MOD) + ((l * 2 + set) * 6 + j) * D; }

__device__ __forceinline__ void p0_transpose_item(const float* W, int K, int N, bf16* WT, int k0, int n0, int drow0, LAS float* scr, int lane) {
    const int lr = lane >> 3, lc = (lane & 7) * 4;
    f32x4 v[8];
#pragma unroll
    for (int i = 0; i < 8; ++i) v[i] = *(const f32x4*)(W + (size_t)(k0 + 8 * i + lr) * N + n0 + lc);
#pragma unroll
    for (int i = 0; i < 8; ++i) *(LAS f32x4*)(scr + (8 * i + lr) * 36 + lc) = v[i];
    asm volatile("s_waitcnt lgkmcnt(0)" ::: "memory");
    const int c = lane & 7;
#pragma unroll
    for (int j = 0; j < 4; ++j) { const int n = (lane >> 3) + 8 * j; const LAS float* s = scr + (8 * c) * 36 + n;
        u32x4 o; o.x = pk2(s[0 * 36], s[1 * 36]); o.y = pk2(s[2 * 36], s[3 * 36]); o.z = pk2(s[4 * 36], s[5 * 36]); o.w = pk2(s[6 * 36], s[7 * 36]);
        *(u32x4*)(WT + (size_t)(drow0 + n) * K + k0 + 8 * c) = o; }
    asm volatile("s_waitcnt lgkmcnt(0)" ::: "memory");
}
__device__ __forceinline__ bool p0_plain(int& r, const float* W, int K, int N, bf16* WT, int row_off, LAS float* scr, int lane) {
    const int nblk = N / 32, cnt = (K / 64) * nblk;
    if (r >= cnt) { r -= cnt; return false; }
    const int kb = r / nblk, nb = r % nblk;
    p0_transpose_item(W, K, N, WT, kb * 64, nb * 32, row_off + nb * 32, scr, lane);
    return true;
}
__device__ __forceinline__ void ph_prologue(const Ctx& C) {
    LAS float* scr = (LAS float*)(C.lds + C.wave * 16384);
    const int gw = C.blk * 8 + C.wave, NGW = C.G * 8;
    constexpr int MOE_ITEMS = 4 * 16 * 3072;
    constexpr int SMALL_ITEMS = 2 * 1536 + 2 * 512 + 768 + 512 + 256 + 144 + 384 + 256 + 512;
    for (int it = gw; it < MOE_ITEMS + SMALL_ITEMS; it += NGW) {
        if (it < MOE_ITEMS) {
            const int le = it / 3072, r2 = it % 3072, which = r2 / 1024, item = r2 % 1024, l = le / 16, e = le % 16;
            if (which < 2) {
                const float* W = (which ? C.in[23] : C.in[22]) + (size_t)le * 1024 * 2048;
                bf16* WT = WSP(bf16, WS_W_GU) + ((size_t)l * 16 + e) * 4096 * 1024;
                const int kb = item / 64, nb = item % 64, n0 = nb * 32;
                p0_transpose_item(W, 1024, 2048, WT, kb * 64, n0, (n0 >> 7) * 256 + (n0 & 127) + which * 128, scr, C.lane);
            } else {
                const float* W = C.in[24] + (size_t)le * 2048 * 1024;
                bf16* WT = WSP(bf16, WS_W_DN) + ((size_t)l * 16 + e) * 1024 * 2048;
                const int kb = item / 32, nb = item % 32;
                p0_transpose_item(W, 2048, 1024, WT, kb * 64, nb * 32, nb * 32, scr, C.lane);
            }
            continue;
        }
        int r = it - MOE_ITEMS;
        if (p0_plain(r, C.in[8], 1024, 3072, WSP(bf16, WS_W_NAQKV), 0, scr, C.lane)) continue;
        if (p0_plain(r, C.in[8] + (size_t)1024 * 3072, 1024, 3072, WSP(bf16, WS_W_NAQKV) + (size_t)3072 * 1024, 0, scr, C.lane)) continue;
        if (p0_plain(r, C.in[9], 1024, 1024, WSP(bf16, WS_W_NAO), 0, scr, C.lane)) continue;
        if (p0_plain(r, C.in[9] + (size_t)1024 * 1024, 1024, 1024, WSP(bf16, WS_W_NAO) + (size_t)1024 * 1024, 0, scr, C.lane)) continue;
        if (p0_plain(r, C.in[11], 1024, 1536, WSP(bf16, WS_W_SWAQKV), 0, scr, C.lane)) continue;
        if (p0_plain(r, C.in[12], 1024, 1024, WSP(bf16, WS_W_SWAO), 0, scr, C.lane)) continue;
        if (p0_plain(r, C.in[14], 1024, 512, WSP(bf16, WS_W_MLAD), 0, scr, C.lane)) continue;
        if (p0_plain(r, C.in[17], 1024, 288, WSP(bf16, WS_W_MLAD), 512, scr, C.lane)) continue;
        if (p0_plain(r, C.in[16], 512, 1536, WSP(bf16, WS_W_MLAUQ), 0, scr, C.lane)) continue;
        if (p0_plain(r, C.in[19], 256, 2048, WSP(bf16, WS_W_MLAUKV), 0, scr, C.lane)) continue;
        p0_plain(r, C.in[20], 1024, 1024, WSP(bf16, WS_W_MLAO), 0, scr, C.lane);
    }
    { u32x4* z = (u32x4*)(WSP(bf16, WS_W_MLAD) + (size_t)800 * 1024); const int n16 = 224 * 1024 * 2 / 16;
      for (int i = C.blk * 512 + C.tid; i < n16; i += C.G * 512) z[i] = (u32x4){0u, 0u, 0u, 0u}; }
    __syncthreads();
    LAS float* sc = (LAS float*)C.lds;
    LAS float* red = sc + 2048;
    for (int i = C.tid; i < 2048; i += 512) { const float v = (i < 1024) ? C.in[1][i] : C.in[3][i - 1024]; sc[i] = v / (1.f + __expf(-v)); }
    __syncthreads();
    for (int u = C.blk; u < 4 * 96; u += C.G) {
        const int l = u / 96, j0 = (u % 96) * 64, kq = C.tid >> 6, jj = C.tid & 63;
        const float* W = C.in[4] + (size_t)l * 1024 * 6144 + j0 + jj;
        float a0 = 0.f, a1 = 0.f;
#pragma unroll 8
        for (int k = kq * 128; k < kq * 128 + 128; ++k) { const float w = W[(size_t)k * 6144]; a0 += sc[k] * w; a1 += sc[1024 + k] * w; }
        red[kq * 64 + jj] = a0; red[512 + kq * 64 + jj] = a1;
        __syncthreads();
        if (C.tid < 128) { const int set = C.tid >> 6, j = C.tid & 63; float s = 0.f;
#pragma unroll
            for (int q = 0; q < 8; ++q) s += red[set * 512 + q * 64 + j];
            const int col = j0 + j;
            ((float*)(C.ws + WS_MOD))[((l * 2 + set) * 6) * D + col] = s + C.in[5][l * 6144 + col]; }
        __syncthreads();
    }
}

template <int MODE>
__device__ __forceinline__ void ph_rowA(const Ctx& C, int l) {
    float* X = WSP(float, WS_X); bf16* H = WSP(bf16, WS_H); const int* INV = WSP(int, WS_INV); const bf16* YB = WSP(bf16, WS_YB);
    const int nrows = MODE == 1 ? SEQ : R;
    for (int t = C.blk * 8 + C.wave; t < nrows; t += C.G * 8) {
        const int set = t >= SEQ ? 1 : 0;
        const float* src = (MODE == 0 && l == 0) ? (set ? C.in[2] + (size_t)(t - SEQ) * D : C.in[0] + (size_t)t * D) : X + (size_t)t * D;
        f32x4 v[4];
#pragma unroll
        for (int j = 0; j < 4; ++j) v[j] = ((const f32x4*)src)[C.lane + 64 * j];
        if (MODE == 1 || l > 0) {
            const int lp = MODE == 1 ? 3 : l - 1;
            const int myinv = C.lane < 16 ? INV[(size_t)t * 16 + C.lane] : -1;
            f32x4 a[4];
#pragma unroll
            for (int j = 0; j < 4; ++j) a[j] = (f32x4){0.f, 0.f, 0.f, 0.f};
            for (int e = 0; e < 16; ++e) {
                const int s = __shfl(myinv, e);
                if (s >= 0) {
                    const u32x2* yr = (const u32x2*)(YB + ((size_t)e * EROWS + s) * D);
#pragma unroll
                    for (int j = 0; j < 4; ++j) { const u32x2 w = yr[C.lane + 64 * j];
                        a[j] += (f32x4){bf2f(w.x & 0xffffu), bf2f(w.x >> 16), bf2f(w.y & 0xffffu), bf2f(w.y >> 16)}; }
                }
            }
            const f32x4* g = (const f32x4*)modp(C, lp, set, 5);
#pragma unroll
            for (int j = 0; j < 4; ++j) v[j] += g[C.lane + 64 * j] * a[j];
        }
        if (MODE == 0) {
#pragma unroll
            for (int j = 0; j < 4; ++j) ((f32x4*)(X + (size_t)t * D))[C.lane + 64 * j] = v[j];
        }
        float ss = 0.f;
#pragma unroll
        for (int j = 0; j < 4; ++j) ss += (v[j].x * v[j].x + v[j].y * v[j].y) + (v[j].z * v[j].z + v[j].w * v[j].w);
        const float rstd = rsqrtf(wave_sum(ss) * (1.f / D) + RMS_EPS);
        if (MODE == 0) {
            const f32x4* w = (const f32x4*)(C.in[6] + (size_t)l * D); const f32x4* sh = (const f32x4*)modp(C, l, set, 0); const f32x4* scl = (const f32x4*)modp(C, l, set, 1);
#pragma unroll
            for (int j = 0; j < 4; ++j) { const int i = C.lane + 64 * j; const f32x4 y = v[j] * rstd * w[i] * (scl[i] + 1.f) + sh[i];
                u32x2 o; o.x = pk2(y.x, y.y); o.y = pk2(y.z, y.w); ((u32x2*)(H + (size_t)t * D))[i] = o; }
        } else {
            const f32x4* w = (const f32x4*)C.in[25];
#pragma unroll
            for (int j = 0; j < 4; ++j) { const int i = C.lane + 64 * j; ((f32x4*)(C.out + (size_t)t * D))[i] = v[j] * rstd * w[i]; }
        }
    }
}
#define RS_STEP(lo, hi, bit, off) ((bit ? hi : lo) + __shfl_xor(bit ? lo : hi, off))
__device__ __forceinline__ float rscatter16(const float (&a)[16], int b5, int b4, int b3, int b2) {
    const float c0 = RS_STEP(a[0], a[8], b5, 32), c1 = RS_STEP(a[1], a[9], b5, 32), c2 = RS_STEP(a[2], a[10], b5, 32), c3 = RS_STEP(a[3], a[11], b5, 32);
    const float c4 = RS_STEP(a[4], a[12], b5, 32), c5 = RS_STEP(a[5], a[13], b5, 32), c6 = RS_STEP(a[6], a[14], b5, 32), c7 = RS_STEP(a[7], a[15], b5, 32);
    const float d0 = RS_STEP(c0, c4, b4, 16), d1 = RS_STEP(c1, c5, b4, 16), d2 = RS_STEP(c2, c6, b4, 16), d3 = RS_STEP(c3, c7, b4, 16);
    const float e0 = RS_STEP(d0, d2, b3, 8), e1 = RS_STEP(d1, d3, b3, 8);
    return RS_STEP(e0, e1, b2, 4);
}
constexpr int NR2 = 1;
__device__ __forceinline__ void ph_norm2(const Ctx& C, int l, int nrows) {
    const float* X = WSP(float, WS_X); bf16* H = WSP(bf16, WS_H); float* AFF = WSP(float, WS_AFF);
    LAS float* Rs = (LAS float*)C.lds;
    const float* rt = C.in[21] + (size_t)l * D * NE;
    for (int i = C.tid; i < D * NE / 4; i += 512) { const f32x4 r4 = ((const f32x4*)rt)[i]; const int c = i >> 2, e0 = (i & 3) * 4;
        Rs[(e0 + 0) * D + c] = r4.x; Rs[(e0 + 1) * D + c] = r4.y; Rs[(e0 + 2) * D + c] = r4.z; Rs[(e0 + 3) * D + c] = r4.w; }
    __syncthreads();
    const int b5 = (C.lane >> 5) & 1, b4 = (C.lane >> 4) & 1, b3 = (C.lane >> 3) & 1, b2 = (C.lane >> 2) & 1, my_e = 8 * b5 + 4 * b4 + 2 * b3 + b2;
    for (int t0 = (C.blk * 8 + C.wave) * NR2; t0 < nrows; t0 += C.G * 8 * NR2) {
        asm volatile("" ::: "memory");
        const int set = t0 >= SEQ ? 1 : 0;
        f32x4 v[NR2][4];
#pragma unroll
        for (int rr = 0; rr < NR2; ++rr) {
#pragma unroll
            for (int j = 0; j < 4; ++j) v[rr][j] = ((const f32x4*)(X + (size_t)(t0 + rr) * D))[C.lane + 64 * j];
        }
        { const f32x4* w = (const f32x4*)(C.in[7] + (size_t)l * D); const f32x4* sh = (const f32x4*)modp(C, l, set, 3); const f32x4* scl = (const f32x4*)modp(C, l, set, 4);
          float rstd[NR2];
#pragma unroll
          for (int rr = 0; rr < NR2; ++rr) { float ss = 0.f;
#pragma unroll
            for (int j = 0; j < 4; ++j) ss += (v[rr][j].x * v[rr][j].x + v[rr][j].y * v[rr][j].y) + (v[rr][j].z * v[rr][j].z + v[rr][j].w * v[rr][j].w);
            rstd[rr] = rsqrtf(wave_sum(ss) * (1.f / D) + RMS_EPS); }
#pragma unroll
          for (int j = 0; j < 4; ++j) { const int i = C.lane + 64 * j; const f32x4 ws = w[i] * (scl[i] + 1.f), s4 = sh[i];
#pragma unroll
            for (int rr = 0; rr < NR2; ++rr) { v[rr][j] = v[rr][j] * rstd[rr] * ws + s4;
                u32x2 o; o.x = pk2(v[rr][j].x, v[rr][j].y); o.y = pk2(v[rr][j].z, v[rr][j].w); ((u32x2*)(H + (size_t)(t0 + rr) * D))[i] = o; } } }
        asm volatile("" ::: "memory");
        float lg[NR2][16];
#pragma unroll
        for (int e = 0; e < 16; ++e) {
            float sacc[NR2];
#pragma unroll
            for (int rr = 0; rr < NR2; ++rr) sacc[rr] = 0.f;
#pragma unroll
            for (int j = 0; j < 4; ++j) { const f32x4 r = *(const LAS f32x4*)(Rs + e * D + 4 * (C.lane + 64 * j));
#pragma unroll
                for (int rr = 0; rr < NR2; ++rr) sacc[rr] += (v[rr][j].x * r.x + v[rr][j].y * r.y) + (v[rr][j].z * r.z + v[rr][j].w * r.w); }
#pragma unroll
            for (int rr = 0; rr < NR2; ++rr) lg[rr][e] = sacc[rr];
            if ((e & 3) == 3) asm volatile("" ::: "memory");
        }
#pragma unroll
        for (int rr = 0; rr < NR2; ++rr) {
            float vv = rscatter16(lg[rr], b5, b4, b3, b2);
            vv += __shfl_xor(vv, 1); vv += __shfl_xor(vv, 2);
            float mx = vv; mx = fmaxf(mx, __shfl_xor(mx, 4)); mx = fmaxf(mx, __shfl_xor(mx, 8)); mx = fmaxf(mx, __shfl_xor(mx, 16)); mx = fmaxf(mx, __shfl_xor(mx, 32));
            const float ex = __expf(vv - mx); float sm = ex; sm += __shfl_xor(sm, 4); sm += __shfl_xor(sm, 8); sm += __shfl_xor(sm, 16); sm += __shfl_xor(sm, 32);
            if ((C.lane & 3) == 0) AFF[(size_t)my_e * R + t0 + rr] = ex / sm;
        }
    }
}

__device__ __forceinline__ int block_sum_i(int v, LAS int* scr, int wave, int lane) {
    v = wave_sum_i(v);
    if (lane == 0) scr[wave] = v;
    __syncthreads();
    int t = 0;
#pragma unroll
    for (int w = 0; w < 8; ++w) t += scr[w];
    __syncthreads();
    return t;
}
__device__ __forceinline__ int block_excl_scan(int v, LAS int* scr, int wave, int lane) {
    int inc = v;
#pragma unroll
    for (int o = 1; o < 64; o <<= 1) { const int n = __shfl_up(inc, o); if (lane >= o) inc += n; }
    if (lane == 63) scr[wave] = inc;
    __syncthreads();
    int off = 0;
#pragma unroll
    for (int w = 0; w < 8; ++w) off += (w < wave) ? scr[w] : 0;
    __syncthreads();
    return off + inc - v;
}
template <int KPT>
__device__ __forceinline__ void topk_unit(const Ctx& C, int e, int base, int n, int cap, int slot0) {
    const float* aff = WSP(float, WS_AFF) + (size_t)e * R + base;
    int* rowl = WSP(int, WS_ROWL) + e * EROWS; float* gatel = WSP(float, WS_GATEL) + e * EROWS; int* INV = WSP(int, WS_INV);
    LAS unsigned* hist = (LAS unsigned*)C.lds;
    LAS int* scr = (LAS int*)(hist + 256);
    LAS unsigned* bc = hist + 256 + 16;
    unsigned key[KPT];
    if (KPT == 32) {
#pragma unroll
        for (int j = 0; j < KPT; j += 4) { const u32x4 k4 = *(const u32x4*)(aff + C.tid * KPT + j); key[j] = k4.x; key[j + 1] = k4.y; key[j + 2] = k4.z; key[j + 3] = k4.w; }
    } else {
#pragma unroll
        for (int j = 0; j < KPT; ++j) { const int t = C.tid * KPT + j; key[j] = t < n ? __float_as_uint(aff[t]) : 0u; }
    }
    unsigned prefix = 0u, pmask = 0u; int kth = cap;
    for (int pass = 0; pass < 4; ++pass) {
        const int shift = 24 - 8 * pass;
        if (C.tid < 256) hist[C.tid] = 0u;
        __syncthreads();
#pragma unroll
        for (int j = 0; j < KPT; ++j) if (key[j] != 0u && (key[j] & pmask) == prefix) __hip_atomic_fetch_add(hist + ((key[j] >> shift) & 255u), 1u, __ATOMIC_RELAXED, __HIP_MEMORY_SCOPE_WORKGROUP);
        __syncthreads();
        if (C.wave == 0) {
            const unsigned c0 = hist[4 * C.lane], c1 = hist[4 * C.lane + 1], c2 = hist[4 * C.lane + 2], c3 = hist[4 * C.lane + 3];
            const int tot = (int)(c0 + c1 + c2 + c3); int suf = tot;
#pragma unroll
            for (int o = 1; o < 64; o <<= 1) { const int nb = __shfl_down(suf, o); if (C.lane + o < 64) suf += nb; }
            const unsigned long long bal = __ballot(suf >= kth);
            const int lstar = 63 - __builtin_clzll(bal);
            if (C.lane == lstar) { int above = suf - tot; unsigned dg; int nk;
                if (above + (int)c3 >= kth) { dg = 3; nk = kth - above; }
                else { above += (int)c3; if (above + (int)c2 >= kth) { dg = 2; nk = kth - above; }
                else { above += (int)c2; if (above + (int)c1 >= kth) { dg = 1; nk = kth - above; }
                else { above += (int)c1; dg = 0; nk = kth - above; } } }
                bc[0] = 4u * (unsigned)C.lane + dg; bc[1] = (unsigned)nk; }
        }
        __syncthreads();
        prefix |= bc[0] << shift; pmask |= 255u << shift; kth = (int)bc[1];
    }
    const int need_eq = kth;
    int ce = 0;
#pragma unroll
    for (int j = 0; j < KPT; ++j) ce += key[j] == prefix ? 1 : 0;
    int eqr = block_excl_scan(ce, scr, C.wave, C.lane);
    int nsel = 0; unsigned selmask = 0u;
#pragma unroll
    for (int j = 0; j < KPT; ++j) { bool sl = key[j] > prefix; if (key[j] == prefix) { sl = eqr < need_eq; ++eqr; } if (sl) { ++nsel; selmask |= 1u << j; } }
    int slot = block_excl_scan(nsel, scr, C.wave, C.lane);
#pragma unroll
    for (int j = 0; j < KPT; ++j) { const int t = C.tid * KPT + j;
        if (t < n) {
            if ((selmask >> j) & 1u) { rowl[slot0 + slot] = base + t; gatel[slot0 + slot] = __uint_as_float(key[j]); INV[(size_t)(base + t) * 16 + e] = slot0 + slot; ++slot; }
            else INV[(size_t)(base + t) * 16 + e] = -1;
        } }
}
__device__ __forceinline__ void ph_topk(const Ctx& C, bool with_ctx) {
    for (int u = C.blk; u < (with_ctx ? 32 : 16); u += C.G) {
        const int e = u & 15;
        if (u < 16) topk_unit<32>(C, e, 0, SEQ, CAP_L, 0);
        else topk_unit<1>(C, e, SEQ, NCTX, CAP_C, CAP_L);
        __syncthreads();
    }
}
__device__ __forceinline__ void ph_gather(const Ctx& C, bool with_ctx) {
    const int* rowl = WSP(int, WS_ROWL); const bf16* H = WSP(bf16, WS_H); bf16* XG = WSP(bf16, WS_XG);
    const int nslots = with_ctx ? CAP_L + CAP_C : CAP_L, ntot = NE * nslots;
    for (int i = C.blk * 8 + C.wave; i < ntot; i += C.G * 8) {
        const int e = i / nslots, sl = i % nslots, r = e * EROWS + sl;
        const int src = rowl[r];
        u32x4* d = (u32x4*)(XG + (size_t)r * D); const u32x4* sp = (const u32x4*)(H + (size_t)src * D);
        d[C.lane] = sp[C.lane]; d[C.lane + 64] = sp[C.lane + 64];
    }
}
__device__ __forceinline__ void rot_angles(int t, int half, int d, int quarter, float& cs, float& sn) {
    const float invf = exp2f(-(float)d * (13.287712379549449f / (float)quarter));
    const float pos = half ? (float)(t & 63) : (float)(t >> 6);
    const float ang = pos * invf;
    const double rev = (double)ang * 0.15915494309189535; const float fr = (float)(rev - __builtin_rint(rev));
    cs = __builtin_amdgcn_cosf(fr); sn = __builtin_amdgcn_sinf(fr);
}
__device__ __forceinline__ void ph_rope(const Ctx& C, bf16* buf, int hw, int nheads, int off, int quarter) {
    const int per_tok = nheads * 2 * quarter; const long total = (long)SEQ * per_tok;
    for (long i = (long)C.blk * 512 + C.tid; i < total; i += (long)C.G * 512) {
        const int t = (int)(i / per_tok), r = (int)(i % per_tok), h = r / (2 * quarter), p = r % (2 * quarter), half = p / quarter, d = p % quarter;
        float cs, sn; rot_angles(t, half, d, quarter, cs, sn);
        bf16* b = buf + (size_t)h * R * hw + (size_t)t * hw + off + half * 2 * quarter + d;
        const float x1 = bf2f(b[0]), x2 = bf2f(b[quarter]);
        b[0] = (bf16)f2bf(x1 * cs - x2 * sn); b[quarter] = (bf16)f2bf(x1 * sn + x2 * cs);
    }
}
__device__ __forceinline__ void ph_mlanorm(const Ctx& C) {
    const float* CQ = WSP(float, WS_CQ); bf16* CQN = WSP(bf16, WS_CQN); bf16* CKVN = WSP(bf16, WS_CKVN); bf16* KR = WSP(bf16, WS_KROPE);
    for (int t = C.blk * 8 + C.wave; t < R; t += C.G * 8) {
        const float* row = CQ + (size_t)t * D;
        const f32x4 a0 = ((const f32x4*)row)[C.lane], a1 = ((const f32x4*)row)[C.lane + 64], b0 = ((const f32x4*)(row + 512))[C.lane];
        const float sa = wave_sum((a0.x * a0.x + a0.y * a0.y) + (a0.z * a0.z + a0.w * a0.w) + (a1.x * a1.x + a1.y * a1.y) + (a1.z * a1.z + a1.w * a1.w));
        const float sb = wave_sum((b0.x * b0.x + b0.y * b0.y) + (b0.z * b0.z + b0.w * b0.w));
        const float ra = rsqrtf(sa * (1.f / 512.f) + RMS_EPS), rb = rsqrtf(sb * (1.f / 256.f) + RMS_EPS);
        const f32x4* gq = (const f32x4*)C.in[15]; const f32x4* gk = (const f32x4*)C.in[18];
        { const f32x4 y0 = a0 * ra * gq[C.lane], y1 = a1 * ra * gq[C.lane + 64], z = b0 * rb * gk[C.lane];
          u32x2 o; o.x = pk2(y0.x, y0.y); o.y = pk2(y0.z, y0.w); ((u32x2*)(CQN + (size_t)t * 512))[C.lane] = o;
          o.x = pk2(y1.x, y1.y); o.y = pk2(y1.z, y1.w); ((u32x2*)(CQN + (size_t)t * 512))[C.lane + 64] = o;
          o.x = pk2(z.x, z.y); o.y = pk2(z.z, z.w); ((u32x2*)(CKVN + (size_t)t * 256))[C.lane] = o; }
        const float x = row[768 + (C.lane & 31)];
        const float xp = __shfl_xor(x, 8);
        float y = x;
        if (t < SEQ) { float cs, sn; rot_angles(t, (C.lane >> 4) & 1, C.lane & 7, 8, cs, sn);
            y = ((C.lane >> 3) & 1) ? (xp * sn + x * cs) : (x * cs - xp * sn); }
        if (C.lane < 32) KR[(size_t)t * 32 + C.lane] = (bf16)f2bf(y);
    }
}

constexpr int CW_KMAX = 8192;
__device__ __forceinline__ void ph_kmax(const Ctx& C) {
    const bf16* KV = WSP(bf16, WS_KV); const bf16* KR = WSP(bf16, WS_KROPE); unsigned* ctl = (unsigned*)(C.ws + WS_CTL);
    for (int i = C.blk * 512 + C.tid; i < 16 * R; i += C.G * 512) {
        const int h = i / R, t = i - h * R;
        const u32x4* kp = (const u32x4*)(KV + (size_t)h * R * 128 + (size_t)t * 128); const u32x4* rp = (const u32x4*)(KR + (size_t)t * 32);
        float ss = 0.f;
#pragma unroll
        for (int q = 0; q < 12; ++q) { const u32x4 w = q < 8 ? kp[q] : rp[q - 8];
            const float a0 = bf2f(w.x & 0xffffu), a1 = bf2f(w.x >> 16), a2 = bf2f(w.y & 0xffffu), a3 = bf2f(w.y >> 16), a4 = bf2f(w.z & 0xffffu), a5 = bf2f(w.z >> 16), a6 = bf2f(w.w & 0xffffu), a7 = bf2f(w.w >> 16);
            ss += (a0 * a0 + a1 * a1) + (a2 * a2 + a3 * a3) + (a4 * a4 + a5 * a5) + (a6 * a6 + a7 * a7); }
#pragma unroll
        for (int o = 1; o < 64; o <<= 1) ss = fmaxf(ss, __shfl_xor(ss, o));
        if (C.lane == 0) atomicMax(ctl + CW_KMAX + h, __float_as_uint(ss));
    }
}

namespace pg8 {
#define PG8_LAS __attribute__((address_space(3)))
typedef unsigned short bf16_t;
typedef short bf16x8 __attribute__((ext_vector_type(8)));
typedef float f32x4 __attribute__((ext_vector_type(4)));
typedef unsigned u32x4 __attribute__((ext_vector_type(4)));
constexpr int BM = 256, BK = 64, HALF = 128, HTB = HALF * BK * 2  , STAGE_BYTES = 8 * HTB, NXCD = 8, WGM = 8;

__host__ __device__ __forceinline__ int lds_byte(int r, int c) { const int st = (r >> 4) * 2 + (c >> 5), rr = r & 15, cc = c & 31, ob = rr * 64 + cc * 2; return st * 1024 + (ob ^ (((ob >> 9) & 1) << 5)); }
__host__ __device__ __forceinline__ void stage_rc(int b, int& R, int& C) { const int st = b / 1024, sb = b % 1024, swz = sb ^ (((sb >> 9) & 1) << 5); R = (st >> 1) * 16 + swz / 64; C = (st & 1) * 32 + (swz % 64) / 2; }
__host__ __device__ __forceinline__ int perm32(int rho) { const int n = rho >> 4, i = rho & 15; return 8 * (i >> 2) + 4 * n + (i & 3); }

struct Unit { int pm, pn, thin; };
struct Gemm { const bf16_t* A; const bf16_t* Bt; int M, N, K; int pm_per_grp; size_t grp_stride; };

struct StaticOrder {
    int nM, nN, nwg, G, c;
    __host__ __device__ void init(int M, int N, int G_, int c_) { nM = M / BM; nN = N / BM; nwg = nM * nN; G = G_; c = c_; }
    __host__ __device__ bool next(int i, Unit& u) const {
        const long L = (long)i * G + c; if (L >= nwg) return false;
        int wgid = (int)L; { const int q = nwg / NXCD, r = nwg % NXCD, xcd = wgid % NXCD, off = wgid / NXCD; wgid = (xcd < r ? xcd * (q + 1) : r * (q + 1) + (xcd - r) * q) + off; }
        const int nig = WGM * nN, gid = wgid / nig, fm = gid * WGM, gsz = (nM - fm) < WGM ? (nM - fm) : WGM;
        u.pm = fm + ((wgid % nig) % gsz); u.pn = (wgid % nig) / gsz; u.thin = 0; return true;
    }
    __device__ __forceinline__ void a_ready(const Unit&) const {}
    __device__ __forceinline__ void done(const Unit&) const {}
};
struct MoeOrder {
    StaticOrder base; int nN, nthin;
    __host__ __device__ void init(int N, int G_, int c_, bool with_thin) { base.init(NEXP_PANELS * BM, N, G_, c_); nN = N / BM; nthin = with_thin ? 16 * nN : 0; }
    static constexpr int NEXP_PANELS = 16 * 8;
    __host__ __device__ bool next(int i, Unit& u) const {
        if (base.next(i, u)) { u.pm = (u.pm >> 3) * 9 + (u.pm & 7); return true; }
        const long j = (long)i * base.G + base.c - base.nwg; if (j >= nthin) return false;
        u.pm = (int)(j / nN) * 9 + 8; u.pn = (int)(j % nN); u.thin = 1; return true;
    }
    __device__ __forceinline__ void a_ready(const Unit&) const {}
    __device__ __forceinline__ void done(const Unit&) const {}
};

template <class Epi, class Sched, bool ALIGN_EPI = false, bool SP2 = false>
__device__ __forceinline__ void gemm_phase(PG8_LAS unsigned char* lds, const Gemm g, const Sched& S, const Epi& E) {
    const int tid = threadIdx.x, wid = __builtin_amdgcn_readfirstlane(tid >> 6), lane = tid & 63, wr = wid >> 2, wc = wid & 3, fr = lane & 15, fq = lane >> 4;
    const int K = g.K, nt = K / BK;
    unsigned voffA[2], voffB[2];
#pragma unroll
    for (int i = 0; i < 2; ++i) { int R, C; stage_rc(tid * 16 + i * 8192, R, C); const int Rb = Epi::PERM ? ((R & ~31) + perm32(R & 31)) : R;
        voffA[i] = (unsigned)(R * K + C) * 2u; voffB[i] = (unsigned)(Rb * K + C) * 2u; }
    const size_t kstep = (size_t)(BK * 2);
    const size_t hstep = (size_t)HALF * K * 2;
    const size_t tstep = 2 * hstep;
    const unsigned ldsw = (unsigned)wid * 1024u;
    const int aoff = lds_byte(wr * 64 + fr, fq * 8), boff = lds_byte(wc * 32 + fr, fq * 8);
#define PG8_SA(b, h) (((b) * 2 + (h)) * HTB)
#define PG8_SB(b, h) ((4 + (b) * 2 + (h)) * HTB)
#define PG8_STAGE(bufoff, gbase, voff) do { _Pragma("unroll") for (int _i = 0; _i < 2; ++_i) \
        __builtin_amdgcn_global_load_lds((const unsigned*)((const char*)(gbase) + (voff)[_i]), (PG8_LAS unsigned*)(lds + (bufoff) + ldsw + _i * 8192), 16, 0, 0); } while (0)
#define PG8_LDA(dst, b, h) do { _Pragma("unroll") for (int m = 0; m < 4; ++m) _Pragma("unroll") for (int k = 0; k < 2; ++k) dst[m][k] = *(const PG8_LAS bf16x8*)(lds + PG8_SA(b, h) + aoff + m * 2048 + k * 1024); } while (0)
#define PG8_LDB(dst, b, h) do { _Pragma("unroll") for (int n = 0; n < 2; ++n) _Pragma("unroll") for (int k = 0; k < 2; ++k) dst[n][k] = *(const PG8_LAS bf16x8*)(lds + PG8_SB(b, h) + boff + n * 2048 + k * 1024); } while (0)
#define PG8_MMA(ai, bj, At, Bt) do { if (cur.thin && ((ai) != 0 || wr != 0)) break; __builtin_amdgcn_s_setprio(1); _Pragma("unroll") for (int m = 0; m < 4; ++m) _Pragma("unroll") for (int n = 0; n < 2; ++n) _Pragma("unroll") for (int k = 0; k < 2; ++k) \
        acc[ai][bj][m][n] = __builtin_amdgcn_mfma_f32_16x16x32_bf16(Bt[n][k], At[m][k], acc[ai][bj][m][n], 0, 0, 0); __builtin_amdgcn_s_setprio(0); } while (0)
#define PG8_WAIT_V(n) asm volatile("s_waitcnt vmcnt(" #n ")" ::: "memory")
#define PG8_WAIT_L(n) asm volatile("s_waitcnt lgkmcnt(" #n ")" ::: "memory")
#define PG8_BAR __builtin_amdgcn_s_barrier()
#define PG8_SCHED __builtin_amdgcn_sched_barrier(0)
    Unit cur, nxt; int ui = 0;
    if (!S.next(0, cur)) return;
    f32x4 acc[2][2][4][2];
#pragma unroll
    for (int a = 0; a < 2; ++a)
#pragma unroll
        for (int b = 0; b < 2; ++b)
#pragma unroll
            for (int m = 0; m < 4; ++m)
#pragma unroll
                for (int n = 0; n < 2; ++n) acc[a][b][m][n] = (f32x4){0.f, 0.f, 0.f, 0.f};
    bf16x8 At[4][2], B0[2][2], B1[2][2];
    const char* cA = (const char*)g.A + (size_t)cur.pm * tstep; const char* cB = (const char*)g.Bt + (g.pm_per_grp ? (size_t)(cur.pm / g.pm_per_grp) * g.grp_stride * 2 : (size_t)0) + (size_t)cur.pn * tstep;
    S.a_ready(cur);
    if constexpr (SP2) {
        PG8_STAGE(PG8_SB(0, 0), cB, voffB); PG8_STAGE(PG8_SB(0, 1), cB + hstep, voffB); PG8_STAGE(PG8_SA(0, 0), cA, voffA); PG8_STAGE(PG8_SA(0, 1), cA + hstep, voffA);
        if (wr == 1) PG8_BAR;
        PG8_WAIT_V(2); PG8_BAR;
        PG8_STAGE(PG8_SB(1, 0), cB + kstep, voffB); PG8_STAGE(PG8_SA(1, 0), cA + kstep, voffA); PG8_STAGE(PG8_SB(1, 1), cB + hstep + kstep, voffB);
        PG8_WAIT_V(6); PG8_BAR;
    } else {
        PG8_STAGE(PG8_SB(0, 0), cB, voffB); PG8_STAGE(PG8_SA(0, 0), cA, voffA); PG8_STAGE(PG8_SB(0, 1), cB + hstep, voffB); PG8_STAGE(PG8_SA(0, 1), cA + hstep, voffA);
        if (wr == 1) PG8_BAR;
        PG8_WAIT_V(4); PG8_BAR;
        PG8_STAGE(PG8_SB(1, 0), cB + kstep, voffB); PG8_STAGE(PG8_SA(1, 0), cA + kstep, voffA); PG8_STAGE(PG8_SB(1, 1), cB + hstep + kstep, voffB);
        PG8_WAIT_V(6); PG8_BAR;
    }
    for (;;) {
        const bool has_next = S.next(ui + 1, nxt);
        const char* nA = has_next ? (const char*)g.A + (size_t)nxt.pm * tstep : cA; const char* nB = has_next ? (const char*)g.Bt + (g.pm_per_grp ? (size_t)(nxt.pm / g.pm_per_grp) * g.grp_stride * 2 : (size_t)0) + (size_t)nxt.pn * tstep : cB;
        for (int t = 0; t < nt; t += 2) {
            const bool last = (t == nt - 2);
            const char* a1 = cA + (size_t)(t + 1) * kstep;
            const char* a2 = last ? nA : cA + (size_t)(t + 2) * kstep; const char* b2 = last ? nB : cB + (size_t)(t + 2) * kstep;
            const char* a3 = a2 + kstep; const char* b3 = b2 + kstep;
            if (last && has_next) S.a_ready(nxt);
            if constexpr (SP2) {
            PG8_LDB(B0, 0, 0); PG8_LDB(B1, 0, 1); PG8_SCHED; PG8_LDA(At, 0, 0); PG8_STAGE(PG8_SA(1, 1), a1 + hstep, voffA);
            PG8_WAIT_V(8); PG8_WAIT_L(0); PG8_BAR; PG8_MMA(0, 0, At, B0); PG8_MMA(0, 1, At, B1); PG8_BAR; PG8_SCHED;
            PG8_LDA(At, 0, 1); PG8_STAGE(PG8_SB(0, 0), b2, voffB); PG8_STAGE(PG8_SB(0, 1), b2 + hstep, voffB); PG8_STAGE(PG8_SA(0, 0), a2, voffA);
            PG8_WAIT_V(8); PG8_WAIT_L(0); PG8_BAR; PG8_MMA(1, 0, At, B0); PG8_MMA(1, 1, At, B1); PG8_BAR; PG8_SCHED;
            PG8_LDB(B0, 1, 0); PG8_LDB(B1, 1, 1); PG8_SCHED; PG8_LDA(At, 1, 0); PG8_STAGE(PG8_SA(0, 1), a2 + hstep, voffA);
            PG8_WAIT_V(8); PG8_WAIT_L(0); PG8_BAR; PG8_MMA(0, 0, At, B0); PG8_MMA(0, 1, At, B1); PG8_BAR; PG8_SCHED;
            PG8_LDA(At, 1, 1); PG8_STAGE(PG8_SB(1, 0), b3, voffB); PG8_STAGE(PG8_SB(1, 1), b3 + hstep, voffB); PG8_STAGE(PG8_SA(1, 0), a3, voffA);
            PG8_WAIT_V(8); PG8_WAIT_L(0); PG8_BAR; PG8_MMA(1, 0, At, B0); PG8_MMA(1, 1, At, B1); PG8_BAR; PG8_SCHED;
            } else {
            PG8_LDB(B0, 0, 0); PG8_SCHED; PG8_LDA(At, 0, 0); PG8_STAGE(PG8_SA(1, 1), a1 + hstep, voffA);
            PG8_WAIT_L(8); PG8_BAR; PG8_WAIT_L(0); PG8_MMA(0, 0, At, B0); PG8_BAR; PG8_SCHED;
            PG8_LDB(B1, 0, 1); PG8_STAGE(PG8_SB(0, 0), b2, voffB);
            PG8_BAR; PG8_WAIT_L(0); PG8_MMA(0, 1, At, B1); PG8_BAR;
            PG8_LDA(At, 0, 1); PG8_STAGE(PG8_SA(0, 0), a2, voffA);
            PG8_BAR; PG8_WAIT_L(0); PG8_MMA(1, 0, At, B0); PG8_BAR; PG8_SCHED;
            PG8_STAGE(PG8_SB(0, 1), b2 + hstep, voffB);
            PG8_WAIT_V(6); PG8_BAR; PG8_MMA(1, 1, At, B1); PG8_BAR;
            PG8_LDB(B0, 1, 0); PG8_SCHED; PG8_LDA(At, 1, 0); PG8_STAGE(PG8_SA(0, 1), a2 + hstep, voffA);
            PG8_WAIT_L(8); PG8_BAR; PG8_WAIT_L(0); PG8_MMA(0, 0, At, B0); PG8_BAR; PG8_SCHED;
            PG8_LDB(B1, 1, 1); PG8_STAGE(PG8_SB(1, 0), b3, voffB);
            PG8_BAR; PG8_WAIT_L(0); PG8_MMA(0, 1, At, B1); PG8_BAR;
            PG8_LDA(At, 1, 1); PG8_STAGE(PG8_SA(1, 0), a3, voffA);
            PG8_BAR; PG8_WAIT_L(0); PG8_MMA(1, 0, At, B0); PG8_BAR; PG8_SCHED;
            PG8_STAGE(PG8_SB(1, 1), b3 + hstep, voffB);
            PG8_WAIT_V(6); PG8_BAR; PG8_MMA(1, 1, At, B1); PG8_BAR;
            }
        }
        if constexpr (ALIGN_EPI) { if (wr == 0) PG8_BAR; }
        if constexpr (!Epi::AFTER_DRAIN) { E(acc, cur, wr, wc, fr, fq); S.done(cur); }
        if (!has_next) break;
#pragma unroll
        for (int a = 0; a < 2; ++a)
#pragma unroll
            for (int b = 0; b < 2; ++b)
#pragma unroll
                for (int m = 0; m < 4; ++m)
#pragma unroll
                    for (int n = 0; n < 2; ++n) acc[a][b][m][n] = (f32x4){0.f, 0.f, 0.f, 0.f};
        cur = nxt; cA = nA; cB = nB; ++ui;
        if constexpr (ALIGN_EPI) { if (wr == 1) PG8_BAR; }
    }
    PG8_WAIT_V(0);
    if constexpr (!ALIGN_EPI) { if (wr == 0) PG8_BAR; }
    PG8_BAR;
    if constexpr (Epi::AFTER_DRAIN) { E.fused(acc, cur, wr, wc, fr, fq, lds, wid, lane); S.done(cur); }
#undef PG8_SA
#undef PG8_SB
#undef PG8_STAGE
#undef PG8_LDA
#undef PG8_LDB
#undef PG8_MMA
#undef PG8_WAIT_V
#undef PG8_WAIT_L
#undef PG8_BAR
#undef PG8_SCHED
}
}
#ifndef USE_PG8
#define USE_PG8 1
#endif
typedef float f32x2_t __attribute__((ext_vector_type(2))); typedef __bf16 bf16x2_t __attribute__((ext_vector_type(2)));
__device__ __forceinline__ unsigned cvt_pk_bf16(float lo, float hi) { f32x2_t v = {lo, hi}; bf16x2_t b = __builtin_convertvector(v, bf16x2_t); return __builtin_bit_cast(unsigned, b); }
typedef const f32x4 (&AccRef)[2][2][4][2];
struct EpiStoreBf16 { static constexpr bool DUAL = false, PERM = true, AFTER_DRAIN = false; bf16* O; int ldc;
    __device__ __forceinline__ void elem(int row, int col, float v, float) const { O[(size_t)row * ldc + col] = (bf16)f2bf(v); }
    __device__ __forceinline__ void operator()(AccRef acc, const pg8::Unit& u, int wr, int wc, int fr, int fq) const {
        const int row0 = u.pm * 256 + wr * 64 + fr, col0 = u.pn * 256 + wc * 32 + 8 * fq;
#pragma unroll
        for (int ai = 0; ai < 2; ++ai)
#pragma unroll
            for (int m = 0; m < 4; ++m) { bf16* rowp = O + (size_t)(row0 + ai * 128 + m * 16) * ldc + col0;
#pragma unroll
                for (int bj = 0; bj < 2; ++bj) { const f32x4 v0 = acc[ai][bj][m][0], v1 = acc[ai][bj][m][1];
                    u32x4 w; w.x = cvt_pk_bf16(v0[0], v0[1]); w.y = cvt_pk_bf16(v0[2], v0[3]); w.z = cvt_pk_bf16(v1[0], v1[1]); w.w = cvt_pk_bf16(v1[2], v1[3]);
                    *(u32x4*)(rowp + bj * 128) = w; } }
    } };
struct EpiStoreHeads { static constexpr bool DUAL = false, PERM = true, AFTER_DRAIN = false; bf16* O; int hw; size_t hstride;
    __device__ __forceinline__ void store4(int row, int col, f32x4 v) const { const int hd = col / hw, wi = col - hd * hw; u32x2 o; o.x = cvt_pk_bf16(v[0], v[1]); o.y = cvt_pk_bf16(v[2], v[3]); *(u32x2*)(O + (size_t)hd * hstride + (size_t)row * hw + wi) = o; }
    __device__ __forceinline__ void elem(int row, int col, float v, float) const { O[(size_t)(col / hw) * hstride + (size_t)row * hw + (col % hw)] = (bf16)f2bf(v); }
    __device__ __forceinline__ void operator()(AccRef acc, const pg8::Unit& u, int wr, int wc, int fr, int fq) const {
        const int row0 = u.pm * 256 + wr * 64 + fr, col0 = u.pn * 256 + wc * 32 + 8 * fq;
#pragma unroll
        for (int bj = 0; bj < 2; ++bj) { const int c = col0 + bj * 128, hd = c / hw, wi = c - hd * hw; bf16* base = O + (size_t)hd * hstride + wi;
#pragma unroll
            for (int ai = 0; ai < 2; ++ai)
#pragma unroll
                for (int m = 0; m < 4; ++m) { const f32x4 v0 = acc[ai][bj][m][0], v1 = acc[ai][bj][m][1];
                    u32x4 w; w.x = cvt_pk_bf16(v0[0], v0[1]); w.y = cvt_pk_bf16(v0[2], v0[3]); w.z = cvt_pk_bf16(v1[0], v1[1]); w.w = cvt_pk_bf16(v1[2], v1[3]);
                    *(u32x4*)(base + (size_t)(row0 + ai * 128 + m * 16) * hw) = w; } }
    } };
struct EpiStoreF32 { static constexpr bool DUAL = false, PERM = false, AFTER_DRAIN = false; float* O; int ldc;
    __device__ __forceinline__ void store4(int row, int col, f32x4 v) const { *(f32x4*)(O + (size_t)row * ldc + col) = v; }
    __device__ __forceinline__ void elem(int row, int col, float v, float) const { O[(size_t)row * ldc + col] = v; }
    __device__ __forceinline__ void operator()(AccRef acc, const pg8::Unit& u, int wr, int wc, int fr, int fq) const {
        const int row0 = u.pm * 256 + wr * 64 + fr, col0 = u.pn * 256 + wc * 32 + 4 * fq;
#pragma unroll
        for (int ai = 0; ai < 2; ++ai)
#pragma unroll
            for (int m = 0; m < 4; ++m) { float* rowp = O + (size_t)(row0 + ai * 128 + m * 16) * ldc + col0;
#pragma unroll
                for (int bj = 0; bj < 2; ++bj)
#pragma unroll
                    for (int n = 0; n < 2; ++n) *(f32x4*)(rowp + bj * 128 + n * 16) = acc[ai][bj][m][n]; }
    } };
struct EpiResid { static constexpr bool DUAL = false, PERM = false, AFTER_DRAIN = false; float* X; const float* g_lat; const float* g_ctx;
    __device__ __forceinline__ void store4(int row, int col, f32x4 v) const { const float* g = row >= SEQ ? g_ctx : g_lat; f32x4* p = (f32x4*)(X + (size_t)row * D + col); *p = *p + *(const f32x4*)(g + col) * v; }
    __device__ __forceinline__ void elem(int row, int col, float v, float) const { const float g = row >= SEQ ? g_ctx[col] : g_lat[col]; X[(size_t)row * D + col] += g * v; }
    __device__ __forceinline__ void operator()(AccRef acc, const pg8::Unit& u, int wr, int wc, int fr, int fq) const {
        const int row0 = u.pm * 256 + wr * 64 + fr, col0 = u.pn * 256 + wc * 32 + 4 * fq;
        const float* g = (u.pm * 256 >= SEQ) ? g_ctx : g_lat;
        f32x4 gv[2][2];
#pragma unroll
        for (int bj = 0; bj < 2; ++bj)
#pragma unroll
            for (int n = 0; n < 2; ++n) gv[bj][n] = *(const f32x4*)(g + col0 + bj * 128 + n * 16);
#pragma unroll
        for (int ai = 0; ai < 2; ++ai)
#pragma unroll
            for (int m = 0; m < 4; ++m) { float* rowp = X + (size_t)(row0 + ai * 128 + m * 16) * D + col0;
#pragma unroll
                for (int bj = 0; bj < 2; ++bj)
#pragma unroll
                    for (int n = 0; n < 2; ++n) { f32x4* p = (f32x4*)(rowp + bj * 128 + n * 16); *p = *p + gv[bj][n] * acc[ai][bj][m][n]; } }
    } };
__device__ __forceinline__ float silu_mul(float g, float u) { return g * __builtin_amdgcn_rcpf(1.f + __expf(-g)) * u; }
struct EpiSwiglu { static constexpr bool DUAL = true, PERM = true, AFTER_DRAIN = false; bf16* ACT;
    __device__ __forceinline__ void elem(int row, int col, float g, float u) const { ACT[(size_t)row * FF + col] = (bf16)f2bf(g / (1.f + __expf(-g)) * u); }
    __device__ __forceinline__ void operator()(AccRef acc, const pg8::Unit& u, int wr, int wc, int fr, int fq) const {
        const int row0 = u.pm * 256 + wr * 64 + fr, col0 = u.pn * 128 + wc * 32 + 8 * fq;
#pragma unroll
        for (int ai = 0; ai < 2; ++ai)
#pragma unroll
            for (int m = 0; m < 4; ++m) { bf16* rowp = ACT + (size_t)(row0 + ai * 128 + m * 16) * FF + col0;
                const f32x4 g0 = acc[ai][0][m][0], g1 = acc[ai][0][m][1], u0 = acc[ai][1][m][0], u1 = acc[ai][1][m][1];
                u32x4 w; w.x = cvt_pk_bf16(silu_mul(g0[0], u0[0]), silu_mul(g0[1], u0[1])); w.y = cvt_pk_bf16(silu_mul(g0[2], u0[2]), silu_mul(g0[3], u0[3]));
                w.z = cvt_pk_bf16(silu_mul(g1[0], u1[0]), silu_mul(g1[1], u1[1])); w.w = cvt_pk_bf16(silu_mul(g1[2], u1[2]), silu_mul(g1[3], u1[3]));
                *(u32x4*)rowp = w; }
    } };
struct EpiMoeOut { static constexpr bool DUAL = false, PERM = true, AFTER_DRAIN = false; bf16* YB; const float* gatel;
    __device__ __forceinline__ void elem(int row, int col, float v, float) const { YB[(size_t)row * D + col] = (bf16)f2bf(v * gatel[row]); }
    __device__ __forceinline__ void operator()(AccRef acc, const pg8::Unit& u, int wr, int wc, int fr, int fq) const {
        const int row0 = u.pm * 256 + wr * 64 + fr, col0 = u.pn * 256 + wc * 32 + 8 * fq;
#pragma unroll
        for (int ai = 0; ai < 2; ++ai)
#pragma unroll
            for (int m = 0; m < 4; ++m) { const int row = row0 + ai * 128 + m * 16; const float gt = gatel[row]; bf16* rowp = YB + (size_t)row * D + col0;
#pragma unroll
                for (int bj = 0; bj < 2; ++bj) { const f32x4 v0 = acc[ai][bj][m][0] * gt, v1 = acc[ai][bj][m][1] * gt;
                    u32x4 w; w.x = cvt_pk_bf16(v0[0], v0[1]); w.y = cvt_pk_bf16(v0[2], v0[3]); w.z = cvt_pk_bf16(v1[0], v1[1]); w.w = cvt_pk_bf16(v1[2], v1[3]);
                    *(u32x4*)(rowp + bj * 128) = w; } }
    } };

template <class Epi>
__device__ __forceinline__ void naive_gemm(const Ctx& C, const bf16* A, const bf16* Bt, int M, int N, int K, int pm_per_grp, size_t grp_stride, const Epi& E) {
    LAS float* As = (LAS float*)C.lds;
    LAS float* Bs = As + 16 * 132;
    LAS float* Bs2 = Bs + 16 * 68;
    const int NO = Epi::DUAL ? N / 2 : N, tn_cnt = NO / 64, nun = (M / 128) * tn_cnt;
    const int ty = C.tid >> 4, tx = C.tid & 15;
    for (int u = C.blk; u < nun; u += C.G) {
        const int tm = u / tn_cnt, tn = u % tn_cnt, row0 = tm * 128, oc0 = tn * 64;
        const bf16* Bg = Bt + (pm_per_grp ? (size_t)((row0 / 256) / pm_per_grp) * grp_stride : (size_t)0);
        const int brow0 = Epi::DUAL ? ((oc0 >> 7) * 256 + (oc0 & 127)) : oc0;
        float acc[4][4], acc2[4][4];
#pragma unroll
        for (int i = 0; i < 4; ++i)
#pragma unroll
            for (int j = 0; j < 4; ++j) { acc[i][j] = 0.f; acc2[i][j] = 0.f; }
        for (int k0 = 0; k0 < K; k0 += 16) {
            __syncthreads();
            { const int r = C.tid >> 2, kc = (C.tid & 3) * 4;
              const u32x2 w = *(const u32x2*)(A + (size_t)(row0 + r) * K + k0 + kc);
              As[(kc + 0) * 132 + r] = bf2f(w.x & 0xffffu); As[(kc + 1) * 132 + r] = bf2f(w.x >> 16); As[(kc + 2) * 132 + r] = bf2f(w.y & 0xffffu); As[(kc + 3) * 132 + r] = bf2f(w.y >> 16); }
            if (C.tid < 256) { const int r = C.tid >> 2, kc = (C.tid & 3) * 4;
              const u32x2 w = *(const u32x2*)(Bg + (size_t)(brow0 + r) * K + k0 + kc);
              Bs[(kc + 0) * 68 + r] = bf2f(w.x & 0xffffu); Bs[(kc + 1) * 68 + r] = bf2f(w.x >> 16); Bs[(kc + 2) * 68 + r] = bf2f(w.y & 0xffffu); Bs[(kc + 3) * 68 + r] = bf2f(w.y >> 16);
              if (Epi::DUAL) { const u32x2 w2 = *(const u32x2*)(Bg + (size_t)(brow0 + 128 + r) * K + k0 + kc);
                Bs2[(kc + 0) * 68 + r] = bf2f(w2.x & 0xffffu); Bs2[(kc + 1) * 68 + r] = bf2f(w2.x >> 16); Bs2[(kc + 2) * 68 + r] = bf2f(w2.y & 0xffffu); Bs2[(kc + 3) * 68 + r] = bf2f(w2.y >> 16); } }
            __syncthreads();
#pragma unroll
            for (int kk = 0; kk < 16; ++kk) {
                const f32x4 a = *(const LAS f32x4*)(As + kk * 132 + ty * 4), b = *(const LAS f32x4*)(Bs + kk * 68 + tx * 4);
#pragma unroll
                for (int i = 0; i < 4; ++i)
#pragma unroll
                    for (int j = 0; j < 4; ++j) acc[i][j] += a[i] * b[j];
                if (Epi::DUAL) { const f32x4 b2 = *(const LAS f32x4*)(Bs2 + kk * 68 + tx * 4);
#pragma unroll
                    for (int i = 0; i < 4; ++i)
#pragma unroll
                        for (int j = 0; j < 4; ++j) acc2[i][j] += a[i] * b2[j]; }
            }
        }
#pragma unroll
        for (int i = 0; i < 4; ++i)
#pragma unroll
            for (int j = 0; j < 4; ++j) E.elem(row0 + ty * 4 + i, oc0 + tx * 4 + j, acc[i][j], acc2[i][j]);
    }
    __syncthreads();
}

template <class Epi>
__device__ __forceinline__ void gemm(const Ctx& C, const bf16* A, const bf16* Bt, int M, int N, int K, int pm_per_grp, size_t grp_stride, const Epi& E) {
#if USE_PG8
    pg8::Gemm g{A, Bt, M, N, K, pm_per_grp, grp_stride}; pg8::StaticOrder S; S.init(M, N, C.G, C.blk);
    pg8::gemm_phase<Epi, pg8::StaticOrder, true, true>(C.lds, g, S, E);
#else
    naive_gemm(C, A, Bt, M, N, K, pm_per_grp, grp_stride, E);
#endif
}
template <class Epi>
__device__ __forceinline__ void small_gemm(const Ctx& C, const bf16* A, const bf16* Bt, int row0, int nrows, int N, int K, const Epi& E) {
    const int ql = C.lane & 31, hi = C.lane >> 5, nrb = nrows / 32, nitems = nrb * (N / 32);
    for (int it = C.blk * 8 + C.wave; it < nitems; it += C.G * 8) {
        const int cb = it / nrb, rb = it % nrb;
        const bf16* ap = A + (size_t)(row0 + rb * 32 + ql) * K + 8 * hi; const bf16* bp = Bt + (size_t)(cb * 32 + ql) * K + 8 * hi;
        f32x16 acc;
#pragma unroll
        for (int r = 0; r < 16; ++r) acc[r] = 0.f;
#pragma unroll 1
        for (int k0 = 0; k0 < K; k0 += 256) {
            bf16x8 a[16], b[16];
#pragma unroll
            for (int q = 0; q < 16; ++q) { a[q] = *(const bf16x8*)(ap + k0 + 16 * q); b[q] = *(const bf16x8*)(bp + k0 + 16 * q); }
            __builtin_amdgcn_sched_barrier(0);
#pragma unroll
            for (int q = 0; q < 16; ++q) acc = __builtin_amdgcn_mfma_f32_32x32x16_bf16(b[q], a[q], acc, 0, 0, 0);
            __builtin_amdgcn_sched_barrier(0);
        }
        const int row = row0 + rb * 32 + ql;
#pragma unroll
        for (int g = 0; g < 4; ++g) E.store4(row, cb * 32 + 8 * g + 4 * hi, (f32x4){acc[4 * g], acc[4 * g + 1], acc[4 * g + 2], acc[4 * g + 3]});
    }
}
template <class Epi>
__device__ __forceinline__ void gemm_tok(const Ctx& C, const bf16* A, const bf16* Bt, int N, int K, bool with_ctx, const Epi& E) {
#if USE_PG8
    gemm(C, A, Bt, SEQ, N, K, 0, 0, E);
    if (with_ctx) small_gemm(C, A, Bt, SEQ, NCTX, N, K, E);
#else
    naive_gemm(C, A, Bt, with_ctx ? R : SEQ, N, K, 0, 0, E);
#endif
}
template <class Epi>
__device__ __forceinline__ void gemm_moe(const Ctx& C, const bf16* A, const bf16* Bt, int N, int K, size_t grp_stride, bool with_ctx, const Epi& E) {
#if USE_PG8
    pg8::Gemm g{A, Bt, XROWS, N, K, 9, grp_stride}; pg8::MoeOrder S; S.init(N, C.G, C.blk, with_ctx);
    pg8::gemm_phase<Epi, pg8::MoeOrder, true, true>(C.lds, g, S, E);
#else
    naive_gemm(C, A, Bt, XROWS, N, K, 9, grp_stride, E);
#endif
}

template <int KIND>
__device__ __forceinline__ void ph_attn_naive(const Ctx& C, int slot) {
    constexpr int DQK = KIND == 2 ? 96 : 64, DH = DQK / 2;
    LAS float* Ks = (LAS float*)C.lds;
    LAS float* Vs = Ks + 32 * DQK;
    LAS float* Bsm = Vs + 32 * 64;
    const bf16 *Qb, *Kb, *Vb, *KRb = nullptr; int qp, kp, vp, kgrp = 1; size_t qhs, khs, vhs; float scale;
    if (KIND == 0) { Qb = WSP(bf16, WS_QKV); Kb = Qb + (size_t)16 * R * 64; Vb = Qb + (size_t)32 * R * 64; qp = kp = vp = 64; qhs = khs = vhs = (size_t)R * 64; scale = 0.125f; }
    else if (KIND == 1) { Qb = WSP(bf16, WS_QKV); Kb = Qb + (size_t)16 * R * 64; Vb = Qb + (size_t)20 * R * 64; qp = kp = vp = 64; qhs = khs = vhs = (size_t)R * 64; kgrp = 4; scale = 0.125f; }
    else { Qb = WSP(bf16, WS_Q); Kb = WSP(bf16, WS_KV); Vb = Kb + 64; KRb = WSP(bf16, WS_KROPE); qp = 96; kp = vp = 128; qhs = (size_t)R * 96; khs = vhs = (size_t)R * 128; scale = 0.10206207261596575f; }
    bf16* Ob = WSP(bf16, WS_O);
    const int half = C.tid & 1, qi = C.tid >> 1;
    for (int u = C.blk; u < 1040; u += C.G) {
        const bool isctx = u >= 1024;
        const int h = isctx ? (u - 1024) : (u & 15), q0 = isctx ? SEQ : (u >> 4) * 256, kh = h / kgrp;
        const int t = q0 + qi;
        float q[DH], o[32];
        { const bf16* qr = Qb + (size_t)t * qp + h * qhs + half * DH;
#pragma unroll
          for (int d = 0; d < DH; d += 8) { const u32x4 w = *(const u32x4*)(qr + d);
              q[d + 0] = bf2f(w.x & 0xffffu); q[d + 1] = bf2f(w.x >> 16); q[d + 2] = bf2f(w.y & 0xffffu); q[d + 3] = bf2f(w.y >> 16);
              q[d + 4] = bf2f(w.z & 0xffffu); q[d + 5] = bf2f(w.z >> 16); q[d + 6] = bf2f(w.w & 0xffffu); q[d + 7] = bf2f(w.w >> 16); } }
#pragma unroll
        for (int d = 0; d < 32; ++d) o[d] = 0.f;
        float m = -INFINITY, l = 0.f;
        if (KIND == 1) { m = C.in[13][h]; l = 1.f; }
        int klo = 0, khi = 0;
        if (!isctx) {
            if (KIND == 0) { const int r0 = q0 >> 6; const int ra = r0 - 4 < 0 ? 0 : r0 - 4, rb = r0 + 7 > 255 ? 255 : r0 + 7; klo = ra * 64; khi = (rb + 1) * 64; }
            else if (KIND == 1) { klo = q0 - 128 < 0 ? 0 : q0 - 128; khi = q0 + 384 > SEQ ? SEQ : q0 + 384; }
            else { klo = 0; khi = SEQ; }
        }
        if (KIND == 0) { __syncthreads(); const float* rp = C.in[10] + ((size_t)slot * 16 + h) * 465; for (int i = C.tid; i < 465; i += 512) Bsm[i] = rp[i]; }
        const int qr_ = t >> 6, qc_ = t & 63;
        int rs = qr_ - 4; rs = rs < 0 ? 0 : (rs > 248 ? 248 : rs);
        int cs0 = qc_ - 8; cs0 = cs0 < 0 ? 0 : (cs0 > 48 ? 48 : cs0);
        for (int seg = 0; seg < 2; ++seg) {
            const int kb = seg == 0 ? klo : SEQ, ke = seg == 0 ? khi : R;
            for (int k0 = kb; k0 < ke; k0 += 32) {
                __syncthreads();
                for (int i = C.tid; i < 32 * DQK; i += 512) { const int j = i / DQK, d = i % DQK; const int row = k0 + j;
                    unsigned b;
                    if (KIND == 2 && d >= 64) b = KRb[(size_t)row * 32 + (d - 64)]; else b = Kb[(size_t)row * kp + kh * khs + d];
                    Ks[i] = bf2f(b); }
                for (int i = C.tid; i < 32 * 64; i += 512) { const int j = i >> 6, d = i & 63; Vs[i] = bf2f(Vb[(size_t)(k0 + j) * vp + kh * vhs + d]); }
                __syncthreads();
#pragma unroll 1
                for (int j = 0; j < 32; ++j) {
                    const int kt = k0 + j; bool valid = true; float bias = 0.f;
                    if (seg == 0) {
                        if (KIND == 0) { const int kr = kt >> 6, kc = kt & 63; valid = kr >= rs && kr < rs + 8 && kc >= cs0 && kc < cs0 + 16;
                            if (valid) bias = Bsm[(kr - qr_ + 7) * 31 + (kc - qc_ + 15)]; }
                        else if (KIND == 1) { const int dd = kt - t; valid = dd <= 128 && dd >= -128; }
                    }
                    float s0 = 0.f, s1 = 0.f;
#pragma unroll
                    for (int d = 0; d < DH; d += 4) { const f32x4 kv = *(const LAS f32x4*)(Ks + j * DQK + half * DH + d); s0 += q[d] * kv.x + q[d + 2] * kv.z; s1 += q[d + 1] * kv.y + q[d + 3] * kv.w; }
                    float sp = s0 + s1; sp += __shfl_xor(sp, 1);
                    if (valid) {
                        const float s = sp * scale + bias;
                        if (s > m) { const float a = __expf(m - s); l *= a;
#pragma unroll
                            for (int d = 0; d < 32; ++d) o[d] *= a;
                            m = s; }
                        const float p = __expf(s - m); l += p;
#pragma unroll
                        for (int d = 0; d < 32; d += 4) { const f32x4 vv = *(const LAS f32x4*)(Vs + j * 64 + half * 32 + d); o[d] += p * vv.x; o[d + 1] += p * vv.y; o[d + 2] += p * vv.z; o[d + 3] += p * vv.w; }
                    }
                }
            }
        }
        { const float il = 1.f / l; bf16* orow = Ob + (size_t)t * D + h * 64 + half * 32;
#pragma unroll
            for (int d = 0; d < 32; d += 8) { u32x4 w; w.x = pk2(o[d] * il, o[d + 1] * il); w.y = pk2(o[d + 2] * il, o[d + 3] * il); w.z = pk2(o[d + 4] * il, o[d + 5] * il); w.w = pk2(o[d + 6] * il, o[d + 7] * il);
                *(u32x4*)(orow + d) = w; } }
    }
    __syncthreads();
}

#ifndef USE_FAST_ATTN
#define USE_FAST_ATTN 1
#endif
__device__ __forceinline__ s16x4 lds_tr16(const LAS unsigned char* p) { return __builtin_bit_cast(s16x4, __builtin_amdgcn_ds_read_tr16_b64_v4i16((LAS s16x4*)p)); }
__device__ __forceinline__ int crow(int r, int hi) { return (r & 3) + 8 * (r >> 2) + 4 * hi; }

#define ATT_BAR() do { __builtin_amdgcn_sched_barrier(0); asm volatile("s_waitcnt lgkmcnt(0)\n\ts_barrier" ::: "memory"); __builtin_amdgcn_sched_barrier(0); } while (0)
template <int KIND>
__device__ __forceinline__ void ph_attn_fast(const Ctx& C, int slot, bool with_ctxq) {
    constexpr int DQK = KIND == 2 ? 96 : 64, NS = DQK / 16, CPR = DQK / 8, CPRP = CPR + 1;
    constexpr int KS = CPRP * 16, VS = 192, KBYTES = 64 * KS, VBYTES = 64 * VS, SLOTB = KBYTES + VBYTES;
    constexpr int NKC = 64 * CPRP, NINST = (NKC + 64 * 12) / 64, NDMA = (NINST + 7) / 8, NRING = 4, PD = 3;
    static_assert(NKC % 64 == 0 && SLOTB % 1024 == 0 && NRING * SLOTB + 2048 <= 131072, "attention ring geometry");
    LAS unsigned char* lds = C.lds; const unsigned lds_u32 = (unsigned)(size_t)C.lds;
    LAS float* Bsm = (LAS float*)(lds + NRING * SLOTB);
    const bf16 *Qb, *Kb, *Vb, *KRb = nullptr; int qp, kp, vp, kgrp = 1; size_t qhs, khs, vhs; float scale;
    if (KIND == 0) { Qb = WSP(bf16, WS_QKV); Kb = Qb + (size_t)16 * R * 64; Vb = Qb + (size_t)32 * R * 64; qp = kp = vp = 64; qhs = khs = vhs = (size_t)R * 64; scale = 0.125f; }
    else if (KIND == 1) { Qb = WSP(bf16, WS_QKV); Kb = Qb + (size_t)16 * R * 64; Vb = Qb + (size_t)20 * R * 64; qp = kp = vp = 64; qhs = khs = vhs = (size_t)R * 64; kgrp = 4; scale = 0.125f; }
    else { Qb = WSP(bf16, WS_Q); Kb = WSP(bf16, WS_KV); Vb = Kb + 64; KRb = WSP(bf16, WS_KROPE); qp = 96; kp = vp = 128; qhs = (size_t)R * 96; khs = vhs = (size_t)R * 128; scale = 0.10206207261596575f; }
    bf16* Ob = WSP(bf16, WS_O);
    const float c2 = scale * 1.4426950408889634f;
    const int w = C.wave, lane = C.lane, ql = lane & 31, hi = lane >> 5;
    const int vlane = (((lane & 15) >> 2) + 4 * hi) * VS + (16 * ((lane >> 4) & 1) + 4 * (lane & 3)) * 2;
    const int nunits = with_ctxq ? 1040 : 1024;
    for (int u = C.blk; u < nunits; u += C.G) {
        const bool isctx = u >= 1024;
        const int h = isctx ? (u - 1024) : (u & 15), q0 = isctx ? SEQ : (u >> 4) * 256, kh = h / kgrp;
        int lat0 = 0, nlat = 0;
        if (!isctx) {
            if (KIND == 0) { const int r0 = q0 >> 6; int ta = r0 - 4; ta = ta < 0 ? 0 : (ta > 248 ? 248 : ta); int tb = r0 - 1; tb = (tb < 0 ? 0 : (tb > 248 ? 248 : tb)) + 7; lat0 = ta; nlat = tb - ta + 1; }
            else if (KIND == 1) { const int a = q0 - 128 < 0 ? 0 : q0 - 128, b = q0 + 384 > SEQ ? SEQ : q0 + 384; lat0 = a >> 6; nlat = (b - a) >> 6; }
            else { lat0 = 0; nlat = SEQ / 64; }
        }
        const int ntiles = nlat + 4;
        const int t = q0 + 32 * w + ql;
        bf16x8 qf[NS];
        { const bf16* qr = Qb + (size_t)t * qp + h * qhs + 8 * hi;
#pragma unroll
          for (int sidx = 0; sidx < NS; ++sidx) qf[sidx] = *(const bf16x8*)(qr + 16 * sidx); }
        const char* gsrc[NDMA]; int gpitch[NDMA], ldst[NDMA];
#pragma unroll
        for (int jj = 0; jj < NDMA; ++jj) {
            int j = w + 8 * jj; if (j >= NINST) j -= 8;
            const int cidx = 64 * j + lane; ldst[jj] = j * 1024;
            if (cidx < NKC) { const int row = cidx / CPRP; int c = cidx % CPRP; if (c >= CPR) c = 0;
                if (KIND == 2 && c >= 8) { gsrc[jj] = (const char*)(KRb + (size_t)row * 32 + 8 * (c - 8)); gpitch[jj] = 64; }
                else { gsrc[jj] = (const char*)(Kb + kh * khs + (size_t)row * kp + 8 * c); gpitch[jj] = kp * 2; } }
            else { const int v = cidx - NKC, row = v / 12; int c = v % 12; if (c >= 8) c = 0;
                gsrc[jj] = (const char*)(Vb + kh * vhs + (size_t)row * vp + 8 * c); gpitch[jj] = vp * 2; }
        }
#define ATT_KEY0(i) ((i) < nlat ? (lat0 + (i)) * 64 : SEQ + ((i) - nlat) * 64)
#define ATT_DMA(i, sl) do { const int ti_ = (i) < ntiles ? (i) : ntiles - 1; const size_t key0_ = (size_t)ATT_KEY0(ti_); \
        _Pragma("unroll") for (int jj = 0; jj < NDMA; ++jj) \
            __builtin_amdgcn_global_load_lds((const unsigned*)(gsrc[jj] + key0_ * gpitch[jj]), (LAS unsigned*)(lds + (sl) * SLOTB + ldst[jj]), 16, 0, 0); } while (0)
#define ATT_WAIT_DMA() do { if (NDMA == 4) asm volatile("s_waitcnt vmcnt(8)" ::: "memory"); else asm volatile("s_waitcnt vmcnt(6)" ::: "memory"); } while (0)
        __syncthreads();
        if (KIND == 0) { const float* rp = C.in[10] + ((size_t)slot * 16 + h) * 465; for (int i = C.tid; i < 465; i += 512) Bsm[i] = rp[i] * 1.4426950408889634f; }
        asm volatile("s_waitcnt vmcnt(0)" ::: "memory");
        ATT_DMA(0, 0); ATT_DMA(1, 1); ATT_DMA(2, 2);
        float m = -INFINITY, l = 0.f;
        if (KIND == 1) { m = C.in[13][h] * 1.4426950408889634f; l = hi ? 0.f : 1.f; }
        f32x16 ot[2];
#pragma unroll
        for (int r = 0; r < 16; ++r) { ot[0][r] = 0.f; ot[1][r] = 0.f; }
        const int qr_ = t >> 6, qc_ = t & 63;
        int cs0 = qc_ - 8; cs0 = cs0 < 0 ? 0 : (cs0 > 48 ? 48 : cs0);
        const int wrow = (q0 >> 6) + (w >> 1);
        int wrs = wrow - 4; wrs = wrs < 0 ? 0 : (wrs > 248 ? 248 : wrs);
        const int wq0 = q0 + 32 * w;
        if constexpr (KIND == 2) {
            { float qs = 0.f;
#pragma unroll
              for (int sidx = 0; sidx < NS; ++sidx)
#pragma unroll
                  for (int j = 0; j < 8; ++j) { const float qv = bf2f((unsigned)(unsigned short)qf[sidx][j]); qs += qv * qv; }
              const auto sw = __builtin_amdgcn_permlane32_swap(__float_as_uint(qs), __float_as_uint(qs), false, false);
              qs = __uint_as_float(sw[0]) + __uint_as_float(sw[1]);
              const float k2 = __uint_as_float(__hip_atomic_load((unsigned*)(C.ws + WS_CTL) + CW_KMAX + h, __ATOMIC_RELAXED, __HIP_MEMORY_SCOPE_AGENT));
              m = c2 * sqrtf(qs * k2) * 1.001f + 0.01f; }
            asm volatile("s_waitcnt vmcnt(4)" ::: "memory");
            ATT_BAR();
            f32x16 pa0, pa1, pb0, pb1;
#define MLA_QK(D0, D1, sl) do { const LAS unsigned char* kb_ = lds + (sl) * SLOTB; \
            _Pragma("unroll") for (int r_ = 0; r_ < 16; ++r_) { D0[r_] = 0.f; D1[r_] = 0.f; } \
            _Pragma("unroll") for (int sidx = 0; sidx < NS; ++sidx) { \
                const bf16x8 a0_ = *(const LAS bf16x8*)(kb_ + ql * KS + 32 * sidx + 16 * hi); \
                const bf16x8 a1_ = *(const LAS bf16x8*)(kb_ + (32 + ql) * KS + 32 * sidx + 16 * hi); \
                D0 = __builtin_amdgcn_mfma_f32_32x32x16_bf16(a0_, qf[sidx], D0, 0, 0, 0); \
                D1 = __builtin_amdgcn_mfma_f32_32x32x16_bf16(a1_, qf[sidx], D1, 0, 0, 0); } } while (0)
#define MLA_ITER(P0, P1, S0, S1, it) do { \
            ATT_DMA((it) + 3, ((it) + 3) & 3); \
            MLA_QK(S0, S1, ((it) + 1) & 3);                                     \
            float rs0_ = 0.f, rs1_ = 0.f, rs2_ = 0.f, rs3_ = 0.f;                  \
            _Pragma("unroll") for (int r_ = 0; r_ < 16; r_ += 2) { \
                P0[r_] = __builtin_amdgcn_exp2f(__builtin_fmaf(P0[r_], c2, -m)); P1[r_] = __builtin_amdgcn_exp2f(__builtin_fmaf(P1[r_], c2, -m)); \
                P0[r_ + 1] = __builtin_amdgcn_exp2f(__builtin_fmaf(P0[r_ + 1], c2, -m)); P1[r_ + 1] = __builtin_amdgcn_exp2f(__builtin_fmaf(P1[r_ + 1], c2, -m)); \
                rs0_ += P0[r_]; rs1_ += P1[r_]; rs2_ += P0[r_ + 1]; rs3_ += P1[r_ + 1]; } \
            l += (rs0_ + rs1_) + (rs2_ + rs3_); \
            bf16x8 pf_[4]; \
            _Pragma("unroll") for (int ks = 0; ks < 2; ++ks) { u32x4 pw_; \
                pw_.x = cvt_pk_bf16(P0[8 * ks + 0], P0[8 * ks + 1]); pw_.y = cvt_pk_bf16(P0[8 * ks + 2], P0[8 * ks + 3]); pw_.z = cvt_pk_bf16(P0[8 * ks + 4], P0[8 * ks + 5]); pw_.w = cvt_pk_bf16(P0[8 * ks + 6], P0[8 * ks + 7]); \
                pf_[ks] = __builtin_bit_cast(bf16x8, pw_); \
                pw_.x = cvt_pk_bf16(P1[8 * ks + 0], P1[8 * ks + 1]); pw_.y = cvt_pk_bf16(P1[8 * ks + 2], P1[8 * ks + 3]); pw_.z = cvt_pk_bf16(P1[8 * ks + 4], P1[8 * ks + 5]); pw_.w = cvt_pk_bf16(P1[8 * ks + 6], P1[8 * ks + 7]); \
                pf_[2 + ks] = __builtin_bit_cast(bf16x8, pw_); } \
            __builtin_amdgcn_sched_group_barrier(0x100, 4, 0); \
            _Pragma("unroll") for (int g_ = 0; g_ < 12; ++g_) { __builtin_amdgcn_sched_group_barrier(0x008, 1, 0); __builtin_amdgcn_sched_group_barrier(0x100, 2, 0); __builtin_amdgcn_sched_group_barrier(0x002, 13, 0); } \
            { const unsigned va_ = lds_u32 + (unsigned)(((it) & 3) * SLOTB + KBYTES + vlane); \
              _Pragma("unroll") for (int c = 0; c < 2; ++c) { \
                s16x4 lo_[4], hi_[4]; \
                _Pragma("unroll") for (int ks = 0; ks < 4; ++ks) { \
                    asm volatile("ds_read_b64_tr_b16 %0, %1 offset:%c2" : "=&v"(lo_[ks]) : "v"(va_), "i"((32 * (ks >> 1) + 16 * (ks & 1)) * VS + 64 * c) : "memory"); \
                    asm volatile("ds_read_b64_tr_b16 %0, %1 offset:%c2" : "=&v"(hi_[ks]) : "v"(va_), "i"((32 * (ks >> 1) + 16 * (ks & 1) + 8) * VS + 64 * c) : "memory"); } \
                asm volatile("s_waitcnt lgkmcnt(0)" ::: "memory"); __builtin_amdgcn_sched_barrier(0); \
                _Pragma("unroll") for (int ks = 0; ks < 4; ++ks) { \
                    const bf16x8 av_ = (bf16x8){lo_[ks][0], lo_[ks][1], lo_[ks][2], lo_[ks][3], hi_[ks][0], hi_[ks][1], hi_[ks][2], hi_[ks][3]}; \
                    ot[c] = __builtin_amdgcn_mfma_f32_32x32x16_bf16(av_, pf_[ks], ot[c], 0, 0, 0); } } } \
            asm volatile("s_waitcnt vmcnt(4)" ::: "memory");          \
            ATT_BAR(); } while (0)
            MLA_QK(pa0, pa1, 0);
            for (int i = 0; i < ntiles; i += 2) {
                MLA_ITER(pa0, pa1, pb0, pb1, i);
                MLA_ITER(pb0, pb1, pa0, pa1, i + 1);
            }
#undef MLA_QK
#undef MLA_ITER
        } else {
        ATT_WAIT_DMA();
        ATT_BAR();
        int rs_cur = 0, rs_nxt = 3;
        for (int i = 0; i < ntiles; ++i) {
            ATT_DMA(i + PD, rs_nxt);
            const bool lat = i < nlat; const int key0 = ATT_KEY0(i);
            bool need = true;
            if (lat) { if (KIND == 0) { const int kr = lat0 + i; need = kr >= wrs && kr < wrs + 8; }
                       else if (KIND == 1) need = (key0 + 63 >= wq0 - 128) && (key0 <= wq0 + 31 + 128); }
            if (need) {
                const LAS unsigned char* kb = lds + rs_cur * SLOTB; const LAS unsigned char* vb = kb + KBYTES;
                f32x16 p0, p1;
#pragma unroll
                for (int r = 0; r < 16; ++r) { p0[r] = 0.f; p1[r] = 0.f; }
#pragma unroll
                for (int sidx = 0; sidx < NS; ++sidx) {
                    const bf16x8 a0 = *(const LAS bf16x8*)(kb + ql * KS + 32 * sidx + 16 * hi);
                    const bf16x8 a1 = *(const LAS bf16x8*)(kb + (32 + ql) * KS + 32 * sidx + 16 * hi);
                    p0 = __builtin_amdgcn_mfma_f32_32x32x16_bf16(a0, qf[sidx], p0, 0, 0, 0);
                    p1 = __builtin_amdgcn_mfma_f32_32x32x16_bf16(a1, qf[sidx], p1, 0, 0, 0);
                }
                float mx = -INFINITY;
                if (KIND == 0) {
#pragma unroll
                    for (int r = 0; r < 16; ++r) {
                        float s0 = p0[r] * c2, s1 = p1[r] * c2;
                        if (lat) { const int kr = lat0 + i; const int kc = crow(r, hi);
                            const bool v0 = (unsigned)(kc - cs0) < 16u, v1 = (unsigned)(kc + 32 - cs0) < 16u;
                            const int bi = (kr - qr_ + 7) * 31 + (kc - qc_ + 15);
                            s0 = v0 ? s0 + Bsm[v0 ? bi : 0] : -INFINITY; s1 = v1 ? s1 + Bsm[v1 ? bi + 32 : 0] : -INFINITY; }
                        p0[r] = s0; p1[r] = s1; mx = fmaxf(fmaxf(mx, s0), s1);
                    }
                } else {
                    if (KIND == 1 && lat) {
#pragma unroll
                        for (int r = 0; r < 16; ++r) { const int dd = key0 + crow(r, hi) - t;
                            p0[r] = (unsigned)(dd + 128) <= 256u ? p0[r] : -INFINITY; p1[r] = (unsigned)(dd + 32 + 128) <= 256u ? p1[r] : -INFINITY; }
                    }
#pragma unroll
                    for (int r = 0; r < 16; ++r) mx = fmaxf(fmaxf(mx, p0[r]), p1[r]);
                    mx *= c2;
                }
                { const auto sw = __builtin_amdgcn_permlane32_swap(__float_as_uint(mx), __float_as_uint(mx), false, false);
                  mx = fmaxf(__uint_as_float(sw[0]), __uint_as_float(sw[1])); }
                const float mn = fmaxf(m, mx), ms = mn == -INFINITY ? 0.f : mn;
                const float alpha = __builtin_amdgcn_exp2f(m - ms);
                float rsum = 0.f;
                if (KIND == 0) {
#pragma unroll
                    for (int r = 0; r < 16; ++r) { p0[r] = __builtin_amdgcn_exp2f(p0[r] - ms); p1[r] = __builtin_amdgcn_exp2f(p1[r] - ms); rsum += p0[r] + p1[r]; }
                } else {
#pragma unroll
                    for (int r = 0; r < 16; ++r) { p0[r] = __builtin_amdgcn_exp2f(__builtin_fmaf(p0[r], c2, -ms)); p1[r] = __builtin_amdgcn_exp2f(__builtin_fmaf(p1[r], c2, -ms)); rsum += p0[r] + p1[r]; }
                }
                l = l * alpha + rsum; m = mn;
                if (__builtin_amdgcn_ballot_w64(alpha != 1.f) != 0ull) {
#pragma unroll
                    for (int r = 0; r < 16; ++r) { ot[0][r] *= alpha; ot[1][r] *= alpha; }
                }
                bf16x8 pf[4];
#pragma unroll
                for (int ks = 0; ks < 4; ++ks) { u32x4 pw;
                    if (ks < 2) { pw.x = cvt_pk_bf16(p0[8 * ks + 0], p0[8 * ks + 1]); pw.y = cvt_pk_bf16(p0[8 * ks + 2], p0[8 * ks + 3]); pw.z = cvt_pk_bf16(p0[8 * ks + 4], p0[8 * ks + 5]); pw.w = cvt_pk_bf16(p0[8 * ks + 6], p0[8 * ks + 7]); }
                    else { const int k8 = 8 * (ks - 2); pw.x = cvt_pk_bf16(p1[k8 + 0], p1[k8 + 1]); pw.y = cvt_pk_bf16(p1[k8 + 2], p1[k8 + 3]); pw.z = cvt_pk_bf16(p1[k8 + 4], p1[k8 + 5]); pw.w = cvt_pk_bf16(p1[k8 + 6], p1[k8 + 7]); }
                    pf[ks] = __builtin_bit_cast(bf16x8, pw); }
                { const unsigned va = lds_u32 + (unsigned)(rs_cur * SLOTB + KBYTES + vlane);
#pragma unroll
                  for (int c = 0; c < 2; ++c) {
                    s16x4 lo[4], hi4[4];
#pragma unroll
                    for (int ks = 0; ks < 4; ++ks) {
                        asm volatile("ds_read_b64_tr_b16 %0, %1 offset:%c2" : "=&v"(lo[ks]) : "v"(va), "i"((32 * (ks >> 1) + 16 * (ks & 1)) * VS + 64 * c) : "memory");
                        asm volatile("ds_read_b64_tr_b16 %0, %1 offset:%c2" : "=&v"(hi4[ks]) : "v"(va), "i"((32 * (ks >> 1) + 16 * (ks & 1) + 8) * VS + 64 * c) : "memory"); }
                    asm volatile("s_waitcnt lgkmcnt(0)" ::: "memory"); __builtin_amdgcn_sched_barrier(0);
#pragma unroll
                    for (int ks = 0; ks < 4; ++ks) {
                        const bf16x8 av = (bf16x8){lo[ks][0], lo[ks][1], lo[ks][2], lo[ks][3], hi4[ks][0], hi4[ks][1], hi4[ks][2], hi4[ks][3]};
                        ot[c] = __builtin_amdgcn_mfma_f32_32x32x16_bf16(av, pf[ks], ot[c], 0, 0, 0); }
                  } }
            }
            ATT_WAIT_DMA();
            ATT_BAR();
            rs_cur = (rs_cur + 1) & 3; rs_nxt = (rs_nxt + 1) & 3;
        }
        }
        asm volatile("s_waitcnt vmcnt(0)" ::: "memory");
#undef ATT_KEY0
#undef ATT_DMA
#undef ATT_WAIT_DMA
        { const auto sw = __builtin_amdgcn_permlane32_swap(__float_as_uint(l), __float_as_uint(l), false, false);
          const float il = 1.f / (__uint_as_float(sw[0]) + __uint_as_float(sw[1])); bf16* orow = Ob + (size_t)t * D + h * 64 + 4 * hi;
#pragma unroll
          for (int c = 0; c < 2; ++c)
#pragma unroll
            for (int g = 0; g < 4; ++g) { u32x2 o2; o2.x = cvt_pk_bf16(ot[c][4 * g] * il, ot[c][4 * g + 1] * il); o2.y = cvt_pk_bf16(ot[c][4 * g + 2] * il, ot[c][4 * g + 3] * il);
                *(u32x2*)(orow + 32 * c + 8 * g) = o2; } }
    }
    __syncthreads();
}
template <int KIND>
__device__ __forceinline__ void ph_attn(const Ctx& C, int slot, bool with_ctxq) {
#if USE_FAST_ATTN
    ph_attn_fast<KIND>(C, slot, with_ctxq);
#else
    ph_attn_naive<KIND>(C, slot);
#endif
}

#define PH_BEGIN if (lo <= ph && ph < hi) {
#define PH_END   if (ph + 1 < hi) xcd_barrier(bar); } ++ph;
#ifndef PROBE_MASK
#define PROBE_MASK 0
#endif
#define PHG(g, ...) PH_BEGIN __VA_ARGS__ PH_END if constexpr (((PROBE_MASK >> (g)) & 1) != 0) { PH_BEGIN __VA_ARGS__ PH_END }
template <int L>
__device__ __forceinline__ void layer_phases(const Ctx& C, const XcdBarrier& bar, int lo, int hi, int& ph) {
    constexpr int l = L, kind = L % 3, slot = L / 3; constexpr bool need_ctx = L < 3; constexpr int RL = need_ctx ? R : SEQ;
    PH_BEGIN ph_rowA<0>(C, l); PH_END
    if constexpr (kind == 0) {
        PHG(1, gemm_tok(C, WSP(bf16, WS_H), WSP(bf16, WS_W_NAQKV) + (size_t)slot * 3072 * 1024, 3072, 1024, true, EpiStoreHeads{WSP(bf16, WS_QKV), 64, (size_t)R * 64});)
        PHG(2, ph_attn<0>(C, slot, need_ctx);)
    } else if constexpr (kind == 1) {
        PHG(1, gemm_tok(C, WSP(bf16, WS_H), WSP(bf16, WS_W_SWAQKV), 1536, 1024, true, EpiStoreHeads{WSP(bf16, WS_QKV), 64, (size_t)R * 64});)
        PH_BEGIN ph_rope(C, WSP(bf16, WS_QKV), 64, 20, 0, 16); PH_END
        PHG(3, ph_attn<1>(C, slot, need_ctx);)
    } else {
        PHG(1, gemm_tok(C, WSP(bf16, WS_H), WSP(bf16, WS_W_MLAD), 1024, 1024, true, EpiStoreF32{WSP(float, WS_CQ), 1024});)
        PHG(11, ph_mlanorm(C);)
        PHG(1, gemm_tok(C, WSP(bf16, WS_CQN), WSP(bf16, WS_W_MLAUQ), 1536, 512, true, EpiStoreHeads{WSP(bf16, WS_Q), 96, (size_t)R * 96});
                 gemm_tok(C, WSP(bf16, WS_CKVN), WSP(bf16, WS_W_MLAUKV), 2048, 256, true, EpiStoreHeads{WSP(bf16, WS_KV), 128, (size_t)R * 128});)
        PH_BEGIN ph_rope(C, WSP(bf16, WS_Q), 96, 16, 64, 8); ph_kmax(C); PH_END
        PHG(4, ph_attn<2>(C, slot, need_ctx);)
    }
    const bf16* wo = kind == 0 ? WSP(bf16, WS_W_NAO) + (size_t)slot * 1024 * 1024 : (kind == 1 ? WSP(bf16, WS_W_SWAO) : WSP(bf16, WS_W_MLAO));
    PH_BEGIN gemm_tok(C, WSP(bf16, WS_O), wo, 1024, 1024, need_ctx, EpiResid{WSP(float, WS_X), modp(C, l, 0, 2), modp(C, l, 1, 2)}); PH_END
    PHG(5, ph_norm2(C, l, RL);)
    PHG(6, ph_topk(C, need_ctx);)
    PHG(7, ph_gather(C, need_ctx);)
    PHG(8, gemm_moe(C, WSP(bf16, WS_XG), WSP(bf16, WS_W_GU) + (size_t)l * 16 * 4096 * 1024, 4096, 1024, (size_t)4096 * 1024, need_ctx, EpiSwiglu{WSP(bf16, WS_ACT)});)
    PHG(9, gemm_moe(C, WSP(bf16, WS_ACT), WSP(bf16, WS_W_DN) + (size_t)l * 16 * 1024 * 2048, 1024, 2048, (size_t)1024 * 2048, need_ctx, EpiMoeOut{WSP(bf16, WS_YB), WSP(float, WS_GATEL)});)
}
__global__ void __launch_bounds__(512, 2) fwd_kernel(Args args) {
    extern __shared__ __attribute__((aligned(16))) unsigned char lds_raw[];
    Ctx C;
#pragma unroll
    for (int i = 0; i < 26; ++i) C.in[i] = args.in[i];
    C.out = args.out; C.ws = args.ws; C.lds = (LAS unsigned char*)lds_raw;
    C.tid = threadIdx.x; C.lane = C.tid & 63; C.wave = __builtin_amdgcn_readfirstlane(C.tid >> 6); C.blk = blockIdx.x; C.G = gridDim.x;
    volatile LAS unsigned* MISC = (volatile LAS unsigned*)(C.lds + MISC_OFF);
    if (C.tid < 32) MISC[C.tid] = 0u;
    __syncthreads();
    const int lo = args.ph_lo, hi = args.ph_hi;
    XcdBarrier bar; bar.bar = (unsigned*)(C.ws + WS_CTL) + CW_BAR; bar.x = 0; bar.st = nullptr;
    if (hi - lo > 1) bar = xcd_barrier_post((unsigned*)(C.ws + WS_CTL) + CW_BAR, MISC + 8);
    int ph = 0;
    PHG(0, ph_prologue(C);)
    layer_phases<0>(C, bar, lo, hi, ph);
    layer_phases<1>(C, bar, lo, hi, ph);
    layer_phases<2>(C, bar, lo, hi, ph);
    layer_phases<3>(C, bar, lo, hi, ph);
    PH_BEGIN ph_rowA<1>(C, 4); PH_END
}
#undef PH_BEGIN
#undef PH_END

extern "C" void kernel_launch(void* const* d_in, const int* in_sizes, int n_in, void* d_out, int out_size, void* d_ws, size_t ws_size, hipStream_t stream) {
    static int grid = 0;
    if (grid == 0) {
        if (n_in != 26 || out_size != SEQ * D || ws_size < WS_END) { fprintf(stderr, "kernel_launch: unexpected shapes (n_in %d out %d ws %zu)\n", n_in, out_size, ws_size); grid = -1; return; }
        int dev = 0, cus = 0, per_cu = 0;
        if (hipGetDevice(&dev) != hipSuccess || hipDeviceGetAttribute(&cus, hipDeviceAttributeMultiprocessorCount, dev) != hipSuccess) { grid = -1; return; }
        if (hipFuncSetAttribute((const void*)fwd_kernel, hipFuncAttributeMaxDynamicSharedMemorySize, LDS_BYTES) != hipSuccess) { fprintf(stderr, "kernel_launch: hipFuncSetAttribute failed\n"); grid = -1; return; }
        if (hipOccupancyMaxActiveBlocksPerMultiprocessor(&per_cu, (const void*)fwd_kernel, 512, LDS_BYTES) != hipSuccess || per_cu < 1) fprintf(stderr, "kernel_launch: occupancy query says %d\n", per_cu);
        (void)hipGetLastError();
        grid = cus;
    }
    if (grid < 0) return;
    if (hipMemsetAsync((char*)d_ws + WS_CTL, 0, CTL_ZERO_BYTES, stream) != hipSuccess) return;
    Args a{};
    for (int i = 0; i < 26; ++i) a.in[i] = (const float*)d_in[i];
    a.out = (float*)d_out; a.ws = (unsigned char*)d_ws; a.pad = 0;
#if MK_N_LAUNCHES == 1
    a.ph_lo = 0; a.ph_hi = 1 << 20; a.li = 0;
    hipLaunchKernelGGL(fwd_kernel, dim3(grid), dim3(512), LDS_BYTES, stream, a);
#else
    for (int li = 0; li < NPH; ++li) { a.ph_lo = li; a.ph_hi = li + 1; a.li = li;
        hipLaunchKernelGGL(fwd_kernel, dim3(grid), dim3(512), LDS_BYTES, stream, a); }
#endif
}
```

```cpp
#include <hip/hip_runtime.h>
#include <cstdio>
#include <cstdint>

#ifndef MK_N_LAUNCHES
#define MK_N_LAUNCHES 1
#endif

#define GAS __attribute__((address_space(1)))
#define LAS __attribute__((address_space(3)))
typedef unsigned short bf16;
typedef float f32x4 __attribute__((ext_vector_type(4)));
typedef unsigned u32x4 __attribute__((ext_vector_type(4)));
typedef unsigned u32x2 __attribute__((ext_vector_type(2)));
typedef short bf16x8 __attribute__((ext_vector_type(8)));
typedef short s16x4 __attribute__((ext_vector_type(4)));
typedef float f32x16 __attribute__((ext_vector_type(16)));

constexpr int D = 1024, SEQ = 16384, NCTX = 256, R = SEQ + NCTX, NE = 16, FF = 2048;
constexpr int CAP_L = 2048, CAP_C = 32, EROWS = 2304, XROWS = NE * EROWS;
constexpr float RMS_EPS = 1e-6f;
constexpr int NPH = 1 + 9 + 10 + 12 + 9 + 1;

constexpr size_t MiB = 1u << 20;
constexpr size_t WS_CTL = 0, CTL_ZERO_BYTES = 1 * MiB;
constexpr size_t WS_MOD = 1 * MiB;
constexpr size_t WS_W_NAQKV = 2 * MiB;
constexpr size_t WS_W_NAO = 14 * MiB;
constexpr size_t WS_W_SWAQKV = 18 * MiB;
constexpr size_t WS_W_SWAO = 21 * MiB;
constexpr size_t WS_W_MLAD = 23 * MiB;
constexpr size_t WS_W_MLAUQ = 25 * MiB;
constexpr size_t WS_W_MLAUKV = 27 * MiB;
constexpr size_t WS_W_MLAO = 28 * MiB;
constexpr size_t WS_W_GU = 32 * MiB;
constexpr size_t WS_W_DN = WS_W_GU + 512 * MiB;
constexpr size_t WS_X = WS_W_DN + 256 * MiB;
constexpr size_t WS_H = WS_X + 65 * MiB;
constexpr size_t WS_QKV = WS_H + 33 * MiB;
constexpr size_t WS_CQ = WS_QKV + 98 * MiB;
constexpr size_t WS_Q = WS_CQ + 65 * MiB;
constexpr size_t WS_KV = WS_Q + 49 * MiB;
constexpr size_t WS_CQN = WS_KV + 65 * MiB;
constexpr size_t WS_CKVN = WS_CQN + 17 * MiB;
constexpr size_t WS_KROPE = WS_CKVN + 9 * MiB;
constexpr size_t WS_O = WS_KROPE + 2 * MiB;
constexpr size_t WS_AFF = WS_O + 33 * MiB;
constexpr size_t WS_ROWL = WS_AFF + 2 * MiB;
constexpr size_t WS_GATEL = WS_ROWL + 1 * MiB;
constexpr size_t WS_INV = WS_GATEL + 1 * MiB;
constexpr size_t WS_XG = WS_INV + 2 * MiB;
constexpr size_t WS_ACT = WS_XG + 72 * MiB;
constexpr size_t WS_YB = WS_ACT + 144 * MiB;
constexpr size_t WS_END = WS_YB + 72 * MiB;
static_assert(WS_END <= 2048 * MiB, "d_ws map");
constexpr int CW_BAR = 4096;

constexpr int LDS_BYTES = 147456;
constexpr int MISC_OFF = 131072 + 320;

__device__ __forceinline__ float bf2f(unsigned b) { return __uint_as_float(b << 16); }
__device__ __forceinline__ unsigned f2bf(float f) { unsigned u = __float_as_uint(f); return (u + 0x7fffu + ((u >> 16) & 1u)) >> 16; }
typedef float f32x2_t __attribute__((ext_vector_type(2))); typedef __bf16 bf16x2_t __attribute__((ext_vector_type(2)));
__device__ __forceinline__ unsigned cvt_pk_bf16(float lo, float hi) { f32x2_t v = {lo, hi}; bf16x2_t b = __builtin_convertvector(v, bf16x2_t); return __builtin_bit_cast(unsigned, b); }
__device__ __forceinline__ unsigned pk2(float lo, float hi) { return cvt_pk_bf16(lo, hi); }
__device__ __forceinline__ float wave_sum(float v) {
#pragma unroll
    for (int o = 1; o < 64; o <<= 1) v += __shfl_xor(v, o);
    return v;
}
__device__ __forceinline__ int wave_sum_i(int v) {
#pragma unroll
    for (int o = 1; o < 64; o <<= 1) v += __shfl_xor(v, o);
    return v;
}

#define XB_TMO      128
#define XB_XCNT(j)  (256  + 64 * (j))
#define XB_XSUB(j)  (1280 + 64 * (j))
#define XB_XGEN(j)  (2304 + 64 * (j))
#define XB_TOP      3328
#define XB_TOPGEN   3392
#define XCD_BAR_WORDS 3456
#define XB_SPIN_CAP (1u << 18)
__device__ __forceinline__ unsigned xb_ld(unsigned* p)              { return __hip_atomic_load(p, __ATOMIC_RELAXED, __HIP_MEMORY_SCOPE_AGENT); }
__device__ __forceinline__ unsigned xb_add(unsigned* p, unsigned v) { return __hip_atomic_fetch_add(p, v, __ATOMIC_RELAXED, __HIP_MEMORY_SCOPE_AGENT); }
__device__ __forceinline__ unsigned xb_xcc_id() { return (unsigned)__builtin_amdgcn_s_getreg((3 << 11) | 20) & 0xFu; }
#define XB_SPIN(cond, bar) do { unsigned _sp = 0; while (cond) { __builtin_amdgcn_s_sleep(1); \
    if ((++_sp & 255u) == 0u) { if (xb_ld(&(bar)[XB_TMO])) break; if (_sp > XB_SPIN_CAP) { atomicAdd(&(bar)[XB_TMO], 1u); break; } } } } while (0)
struct XcdBarrier { unsigned* bar; unsigned x; volatile LAS unsigned* st; };
__device__ __forceinline__ XcdBarrier xcd_barrier_post(unsigned* bar, volatile LAS unsigned* st) {
    XcdBarrier b; b.bar = bar; b.x = xb_xcc_id(); b.st = st;
    if (threadIdx.x == 0) (void)xb_add(&bar[XB_XCNT(b.x)], 1u);
    return b;
}
__device__ __forceinline__ void xcd_barrier_complete(unsigned* bar, unsigned x, unsigned& nloc, unsigned& nx) {
    const unsigned G = gridDim.x * gridDim.y * gridDim.z;
    unsigned sum, cnt, mine, sp = 0u;
    for (;;) {
        sum = 0u; cnt = 0u; mine = 0u;
#pragma unroll
        for (unsigned j = 0; j < 16; ++j) { const unsigned c = xb_ld(&bar[XB_XCNT(j)]); sum += c; cnt += (c > 0u) ? 1u : 0u; mine = (j == x) ? c : mine; }
        if (sum == G) break;
        __builtin_amdgcn_s_sleep(1);
        if ((++sp & 255u) == 0u) { if (xb_ld(&bar[XB_TMO])) break; if (sp > XB_SPIN_CAP) { atomicAdd(&bar[XB_TMO], 1u); break; } }
    }
    nloc = mine > 0u ? mine : 1u; nx = cnt > 0u ? cnt : 1u;
}
__device__ __forceinline__ void xcd_barrier(const XcdBarrier& b) {
    asm volatile("s_waitcnt vmcnt(0)" ::: "memory");
    __syncthreads();
    if (threadIdx.x == 0) {
        unsigned* bar = b.bar;
        __builtin_amdgcn_s_waitcnt(0);
        unsigned nloc = b.st[0], nx = b.st[1];
        if (nloc == 0u) { xcd_barrier_complete(bar, b.x, nloc, nx); b.st[0] = nloc; b.st[1] = nx; }
        const unsigned old = xb_add(&bar[XB_XSUB(b.x)], 1u);
        const unsigned gen = old / nloc;
        if (old + 1u == (gen + 1u) * nloc) {
            __builtin_amdgcn_fence(__ATOMIC_RELEASE, "agent");
            asm volatile("s_waitcnt vmcnt(0)" ::: "memory");
            const unsigned og = xb_add(&bar[XB_TOP], 1u);
            const unsigned tg = og / nx;
            if (og + 1u == (tg + 1u) * nx) xb_add(&bar[XB_TOPGEN], 1u);
            else XB_SPIN(xb_ld(&bar[XB_TOPGEN]) == tg, bar);
            __builtin_amdgcn_fence(__ATOMIC_ACQUIRE, "agent");
            xb_add(&bar[XB_XGEN(b.x)], 1u);
            asm volatile("s_waitcnt vmcnt(0)" ::: "memory");
        } else {
            XB_SPIN(xb_ld(&bar[XB_XGEN(b.x)]) == gen, bar);
            __builtin_amdgcn_fence(__ATOMIC_ACQUIRE, "agent");
            asm volatile("s_waitcnt vmcnt(0)" ::: "memory");
        }
    }
    __syncthreads();
}

struct Args { const float* in[26]; float* out; unsigned char* ws; int ph_lo, ph_hi, li, pad; };
struct Ctx {
    const float* in[26]; float* out; unsigned char* ws;
    LAS unsigned char* lds;
    int tid, lane, wave, blk, G;
};
#define WSP(T, off) ((T*)(C.ws + (off)))
__device__ __forceinline__ const float* modp(const Ctx& C, int l, int set, int j) { return (const float*)(C.ws + WS_MOD) + ((l * 2 + set) * 6 + j) * D; }

__device__ __forceinline__ void p0_transpose_item(const float* W, int K, int N, bf16* WT, int k0, int n0, int drow0, LAS float* scr, int lane) {
    const int lr = lane >> 3, lc = (lane & 7) * 4;
    f32x4 v[8];
#pragma unroll
    for (int i = 0; i < 8; ++i) v[i] = *(const f32x4*)(W + (size_t)(k0 + 8 * i + lr) * N + n0 + lc);
#pragma unroll
    for (int i = 0; i < 8; ++i) *(LAS f32x4*)(scr + (8 * i + lr) * 36 + lc) = v[i];
    asm volatile("s_waitcnt lgkmcnt(0)" ::: "memory");
    const int c = lane & 7;
#pragma unroll
    for (int j = 0; j < 4; ++j) { const int n = (lane >> 3) + 8 * j; const LAS float* s = scr + (8 * c) * 36 + n;
        u32x4 o; o.x = pk2(s[0 * 36], s[1 * 36]); o.y = pk2(s[2 * 36], s[3 * 36]); o.z = pk2(s[4 * 36], s[5 * 36]); o.w = pk2(s[6 * 36], s[7 * 36]);
        *(u32x4*)(WT + (size_t)(drow0 + n) * K + k0 + 8 * c) = o; }
    asm volatile("s_waitcnt lgkmcnt(0)" ::: "memory");
}
constexpr int MOE_ITEMS_PER_LAYER = 16 * 3072, MOE_HALF_ITEMS = 2 * MOE_ITEMS_PER_LAYER;
__device__ __forceinline__ bool moe_layer_in_attention(int l) { return true; }
struct ConvItem { const float* W; bf16* WT; int K, N; };
__device__ __forceinline__ ConvItem conv_half_item(const Ctx& C, int l, int hidx) {
    const int it = hidx >> 1, half = hidx & 1, e = it / 3072, r2 = it % 3072, which = r2 / 1024, item = r2 % 1024, le = l * 16 + e;
    ConvItem ci;
    if (which < 2) { const int kb = item / 64, nb = item % 64, n0 = nb * 32, k0 = kb * 64 + 32 * half, drow0 = (n0 >> 7) * 256 + (n0 & 127) + which * 128;
        ci.K = 1024; ci.N = 2048; ci.W = (which ? C.in[23] : C.in[22]) + (size_t)le * 1024 * 2048 + (size_t)k0 * 2048 + n0;
        ci.WT = WSP(bf16, WS_W_GU) + (size_t)le * 4096 * 1024 + (size_t)drow0 * 1024 + k0; }
    else { const int kb = item / 32, nb = item % 32, n0 = nb * 32, k0 = kb * 64 + 32 * half;
        ci.K = 2048; ci.N = 1024; ci.W = C.in[24] + (size_t)le * 2048 * 1024 + (size_t)k0 * 1024 + n0;
        ci.WT = WSP(bf16, WS_W_DN) + (size_t)le * 1024 * 2048 + (size_t)n0 * 2048 + k0; }
    return ci;
}
struct ConvState { int l0, total, cur; bool loaded; };
template <bool DRAIN>
__device__ __forceinline__ void conv_step(const Ctx& C, ConvState& st, LAS float* scr) {
    int lane = C.lane; asm volatile("" : "+v"(lane));
    if (st.loaded) {
        if (DRAIN) asm volatile("s_waitcnt vmcnt(0)" ::: "memory");
        const int pc = st.cur - C.G * 8; const ConvItem pi = conv_half_item(C, st.l0 + pc / MOE_HALF_ITEMS, pc % MOE_HALF_ITEMS);
#pragma unroll
        for (int j = 0; j < 2; ++j) { const int ch = lane + 64 * j, n = ch >> 2, c = ch & 3; const LAS float* sp = scr + (8 * c) * 32 + ((((n >> 2) ^ (2 * c)) << 2) | (n & 3));
            u32x4 o; o.x = cvt_pk_bf16(sp[0 * 32], sp[1 * 32]); o.y = cvt_pk_bf16(sp[2 * 32], sp[3 * 32]); o.z = cvt_pk_bf16(sp[4 * 32], sp[5 * 32]); o.w = cvt_pk_bf16(sp[6 * 32], sp[7 * 32]);
            *(u32x4*)(pi.WT + (size_t)n * pi.K + 8 * c) = o; }
        asm volatile("s_waitcnt lgkmcnt(0)" ::: "memory");
        st.loaded = false;
    }
    if (st.cur < st.total) {
        const ConvItem ci = conv_half_item(C, st.l0 + st.cur / MOE_HALF_ITEMS, st.cur % MOE_HALF_ITEMS);
        const int lr = lane >> 3;
#pragma unroll
        for (int i = 0; i < 4; ++i) { const int lc = ((lane & 7) ^ (2 * i)) * 4;
            __builtin_amdgcn_global_load_lds((const unsigned*)(ci.W + (size_t)(8 * i + lr) * ci.N + lc), (LAS unsigned*)(scr + i * 256), 16, 0, 0); }
        st.loaded = true; st.cur += C.G * 8;
    }
}
struct ConvPipe { int l0, total, first, n; };
constexpr int CONV_PIPE_BASE = 4 * (64 * 144 + 64 * 128) + 2048;
__device__ __forceinline__ LAS float* conv_pipe_buf(LAS unsigned char* lds, int wave, int par) {
    const int b = wave * 2 + par;
    return (LAS float*)(lds + (b < 14 ? CONV_PIPE_BASE + b * 4096 : 132096 + (b - 14) * 4096));
}
template <bool STORE = true>
__device__ __forceinline__ void conv_pack_store(bf16* WT, int K, const LAS float* scr, int lane) {
#pragma unroll
    for (int j = 0; j < 2; ++j) { const int ch = lane + 64 * j, n = ch >> 2, c = ch & 3; const LAS float* sp = scr + (8 * c) * 32 + ((((n >> 2) ^ (2 * c)) << 2) | (n & 3));
        u32x4 o; o.x = cvt_pk_bf16(sp[0 * 32], sp[1 * 32]); o.y = cvt_pk_bf16(sp[2 * 32], sp[3 * 32]); o.z = cvt_pk_bf16(sp[4 * 32], sp[5 * 32]); o.w = cvt_pk_bf16(sp[6 * 32], sp[7 * 32]);
        if (STORE) *(u32x4*)(WT + (size_t)n * K + 8 * c) = o; else asm volatile("" :: "v"(o.x), "v"(o.y), "v"(o.z), "v"(o.w)); }
    asm volatile("s_waitcnt lgkmcnt(0)" ::: "memory");
}
template <int FL = 0>
__device__ __forceinline__ void conv_pipe_step(const Ctx& C, ConvPipe& st, LAS unsigned char* lds) {
    int lane = C.lane; asm volatile("" : "+v"(lane));
    const int NGW = C.G * 8, cur = st.first + st.n * NGW, pc = cur - 2 * NGW;
    LAS float* scr = conv_pipe_buf(lds, C.wave, st.n & 1);
    { const bool real = st.n >= 2 && pc < st.total; const int pcc = real ? pc : st.first;
      const ConvItem pi = conv_half_item(C, st.l0, pcc);
      conv_pack_store<!(FL & 1)>(real ? pi.WT : WSP(bf16, WS_XG) + (size_t)st.first * 1024, real ? pi.K : 32, scr, lane); }
    { const int cc = cur < st.total ? cur : st.first;
      const ConvItem ci = conv_half_item(C, st.l0, cc);
      const int lr = lane >> 3;
#pragma unroll
      for (int i = 0; i < 4; ++i) { const int lc = ((lane & 7) ^ (2 * i)) * 4;
          if (!(FL & 2)) __builtin_amdgcn_global_load_lds((const unsigned*)(ci.W + (size_t)(8 * i + lr) * ci.N + lc), (LAS unsigned*)(scr + i * 256), 16, 0, 0); } }
    st.n += 1;
}
__device__ __forceinline__ void conv_pipe_drain(const Ctx& C, ConvPipe& st, LAS unsigned char* lds) {
    asm volatile("s_waitcnt vmcnt(0)" ::: "memory");
    const int NGW = C.G * 8;
#pragma unroll 1
    for (int k = 2; k >= 1; --k) { const int m = st.n - k, pc = st.first + m * NGW;
        if (m >= 0 && pc < st.total) { const ConvItem pi = conv_half_item(C, st.l0, pc); conv_pack_store(pi.WT, pi.K, conv_pipe_buf(lds, C.wave, m & 1), C.lane); } }
    ConvState rest; rest.l0 = st.l0; rest.total = st.total; rest.cur = st.first + st.n * NGW; rest.loaded = false;
    LAS float* scr = conv_pipe_buf(lds, C.wave, 0);
    while (rest.loaded || rest.cur < rest.total) conv_step<true>(C, rest, scr);
}
__device__ __forceinline__ bool p0_plain(int& r, const float* W, int K, int N, bf16* WT, int row_off, LAS float* scr, int lane) {
    const int nblk = N / 32, cnt = (K / 64) * nblk;
    if (r >= cnt) { r -= cnt; return false; }
    const int kb = r / nblk, nb = r % nblk;
    p0_transpose_item(W, K, N, WT, kb * 64, nb * 32, row_off + nb * 32, scr, lane);
    return true;
}
__device__ __forceinline__ void ph_prologue(const Ctx& C) {
    LAS float* scr = (LAS float*)(C.lds + C.wave * 16384);
    const int gw = C.blk * 8 + C.wave, NGW = C.G * 8;
    constexpr int MOE_ITEMS = 4 * 16 * 3072;
    constexpr int SMALL_ITEMS = 2 * 1536 + 2 * 512 + 768 + 512 + 256 + 144 + 384 + 256 + 512;
    for (int it = gw; it < MOE_ITEMS + SMALL_ITEMS; it += NGW) {
        if (it < MOE_ITEMS) {
            if (moe_layer_in_attention(it / MOE_ITEMS_PER_LAYER)) continue;
            const int le = it / 3072, r2 = it % 3072, which = r2 / 1024, item = r2 % 1024, l = le / 16, e = le % 16;
            if (which < 2) {
                const float* W = (which ? C.in[23] : C.in[22]) + (size_t)le * 1024 * 2048;
                bf16* WT = WSP(bf16, WS_W_GU) + ((size_t)l * 16 + e) * 4096 * 1024;
                const int kb = item / 64, nb = item % 64, n0 = nb * 32;
                p0_transpose_item(W, 1024, 2048, WT, kb * 64, n0, (n0 >> 7) * 256 + (n0 & 127) + which * 128, scr, C.lane);
            } else {
                const float* W = C.in[24] + (size_t)le * 2048 * 1024;
                bf16* WT = WSP(bf16, WS_W_DN) + ((size_t)l * 16 + e) * 1024 * 2048;
                const int kb = item / 32, nb = item % 32;
                p0_transpose_item(W, 2048, 1024, WT, kb * 64, nb * 32, nb * 32, scr, C.lane);
            }
            continue;
        }
        int r = it - MOE_ITEMS;
        if (p0_plain(r, C.in[8], 1024, 3072, WSP(bf16, WS_W_NAQKV), 0, scr, C.lane)) continue;
        if (p0_plain(r, C.in[8] + (size_t)1024 * 3072, 1024, 3072, WSP(bf16, WS_W_NAQKV) + (size_t)3072 * 1024, 0, scr, C.lane)) continue;
        if (p0_plain(r, C.in[9], 1024, 1024, WSP(bf16, WS_W_NAO), 0, scr, C.lane)) continue;
        if (p0_plain(r, C.in[9] + (size_t)1024 * 1024, 1024, 1024, WSP(bf16, WS_W_NAO) + (size_t)1024 * 1024, 0, scr, C.lane)) continue;
        if (p0_plain(r, C.in[11], 1024, 1536, WSP(bf16, WS_W_SWAQKV), 0, scr, C.lane)) continue;
        if (p0_plain(r, C.in[12], 1024, 1024, WSP(bf16, WS_W_SWAO), 0, scr, C.lane)) continue;
        if (p0_plain(r, C.in[14], 1024, 512, WSP(bf16, WS_W_MLAD), 0, scr, C.lane)) continue;
        if (p0_plain(r, C.in[17], 1024, 288, WSP(bf16, WS_W_MLAD), 512, scr, C.lane)) continue;
        if (p0_plain(r, C.in[16], 512, 1536, WSP(bf16, WS_W_MLAUQ), 0, scr, C.lane)) continue;
        if (p0_plain(r, C.in[19], 256, 2048, WSP(bf16, WS_W_MLAUKV), 0, scr, C.lane)) continue;
        p0_plain(r, C.in[20], 1024, 1024, WSP(bf16, WS_W_MLAO), 0, scr, C.lane);
    }
    { u32x4* z = (u32x4*)(WSP(bf16, WS_W_MLAD) + (size_t)800 * 1024); const int n16 = 224 * 1024 * 2 / 16;
      for (int i = C.blk * 512 + C.tid; i < n16; i += C.G * 512) z[i] = (u32x4){0u, 0u, 0u, 0u}; }
    __syncthreads();
    LAS float* sc = (LAS float*)C.lds;
    LAS float* red = sc + 2048;
    for (int i = C.tid; i < 2048; i += 512) { const float v = (i < 1024) ? C.in[1][i] : C.in[3][i - 1024]; sc[i] = v / (1.f + __expf(-v)); }
    __syncthreads();
    for (int u = C.blk; u < 4 * 96; u += C.G) {
        const int l = u / 96, j0 = (u % 96) * 64, kg = C.tid >> 4, jl = (C.tid & 15) * 4;
        const float* W = C.in[4] + (size_t)l * 1024 * 6144 + (size_t)(kg * 32) * 6144 + j0 + jl;
        f32x4 a0 = (f32x4){0.f, 0.f, 0.f, 0.f}, a1 = a0;
#pragma unroll 1
        for (int kb = 0; kb < 32; kb += 16) {
            f32x4 wv[16];
#pragma unroll
            for (int i = 0; i < 16; ++i) wv[i] = *(const f32x4*)(W + (size_t)(kb + i) * 6144);
#pragma unroll
            for (int i = 0; i < 16; ++i) { const float s0 = sc[kg * 32 + kb + i], s1 = sc[1024 + kg * 32 + kb + i];
                a0[0] += s0 * wv[i][0]; a0[1] += s0 * wv[i][1]; a0[2] += s0 * wv[i][2]; a0[3] += s0 * wv[i][3];
                a1[0] += s1 * wv[i][0]; a1[1] += s1 * wv[i][1]; a1[2] += s1 * wv[i][2]; a1[3] += s1 * wv[i][3]; }
        }
        *(LAS f32x4*)(red + kg * 64 + jl) = a0; *(LAS f32x4*)(red + 2048 + kg * 64 + jl) = a1;
        __syncthreads();
        if (C.tid < 128) { const int set = C.tid >> 6, j = C.tid & 63; float s = 0.f;
#pragma unroll
            for (int q = 0; q < 32; ++q) s += red[set * 2048 + q * 64 + j];
            const int col = j0 + j;
            ((float*)(C.ws + WS_MOD))[((l * 2 + set) * 6) * D + col] = s + C.in[5][l * 6144 + col]; }
        __syncthreads();
    }
}

template <int MODE>
__device__ __forceinline__ void ph_rowA(const Ctx& C, int l) {
    float* X = WSP(float, WS_X); bf16* H = WSP(bf16, WS_H); const int* INV = WSP(int, WS_INV); const bf16* YB = WSP(bf16, WS_YB);
    const int nrows = MODE == 1 ? SEQ : R;
    for (int t = C.blk * 8 + C.wave; t < nrows; t += C.G * 8) {
        const int set = t >= SEQ ? 1 : 0;
        const float* src = (MODE == 0 && l == 0) ? (set ? C.in[2] + (size_t)(t - SEQ) * D : C.in[0] + (size_t)t * D) : X + (size_t)t * D;
        f32x4 v[4];
#pragma unroll
        for (int j = 0; j < 4; ++j) v[j] = ((const f32x4*)src)[C.lane + 64 * j];
        if (MODE == 1 || l > 0) {
            const int lp = MODE == 1 ? 3 : l - 1;
            const int myinv = C.lane < 16 ? INV[(size_t)t * 16 + C.lane] : -1;
            f32x4 a[4];
#pragma unroll
            for (int j = 0; j < 4; ++j) a[j] = (f32x4){0.f, 0.f, 0.f, 0.f};
            unsigned em = (unsigned)(__builtin_amdgcn_ballot_w64(myinv >= 0) & 0xffffull);
            while (em) {
                int sl[4]; bool ok[4];
#pragma unroll
                for (int q = 0; q < 4; ++q) { ok[q] = em != 0u; const int e = ok[q] ? __builtin_ctz(em) : 0; if (ok[q]) em &= em - 1u; sl[q] = e * EROWS + __shfl(myinv, e); }
                u32x2 w[4][4];
#pragma unroll
                for (int q = 0; q < 4; ++q) { const u32x2* yr = (const u32x2*)(YB + (size_t)(ok[q] ? sl[q] : 0) * D);
#pragma unroll
                    for (int j = 0; j < 4; ++j) w[q][j] = ok[q] ? yr[C.lane + 64 * j] : (u32x2){0u, 0u}; }
#pragma unroll
                for (int q = 0; q < 4; ++q)
#pragma unroll
                    for (int j = 0; j < 4; ++j) a[j] += (f32x4){bf2f(w[q][j].x & 0xffffu), bf2f(w[q][j].x >> 16), bf2f(w[q][j].y & 0xffffu), bf2f(w[q][j].y >> 16)};
            }
            const f32x4* g = (const f32x4*)modp(C, lp, set, 5);
#pragma unroll
            for (int j = 0; j < 4; ++j) v[j] += g[C.lane + 64 * j] * a[j];
        }
        if (MODE == 0) {
#pragma unroll
            for (int j = 0; j < 4; ++j) ((f32x4*)(X + (size_t)t * D))[C.lane + 64 * j] = v[j];
        }
        float ss = 0.f;
#pragma unroll
        for (int j = 0; j < 4; ++j) ss += (v[j].x * v[j].x + v[j].y * v[j].y) + (v[j].z * v[j].z + v[j].w * v[j].w);
        const float rstd = rsqrtf(wave_sum(ss) * (1.f / D) + RMS_EPS);
        if (MODE == 0) {
            const f32x4* w = (const f32x4*)(C.in[6] + (size_t)l * D); const f32x4* sh = (const f32x4*)modp(C, l, set, 0); const f32x4* scl = (const f32x4*)modp(C, l, set, 1);
#pragma unroll
            for (int j = 0; j < 4; ++j) { const int i = C.lane + 64 * j; const f32x4 y = v[j] * rstd * w[i] * (scl[i] + 1.f) + sh[i];
                u32x2 o; o.x = pk2(y.x, y.y); o.y = pk2(y.z, y.w); ((u32x2*)(H + (size_t)t * D))[i] = o; }
        } else {
            const f32x4* w = (const f32x4*)C.in[25];
#pragma unroll
            for (int j = 0; j < 4; ++j) { const int i = C.lane + 64 * j; ((f32x4*)(C.out + (size_t)t * D))[i] = v[j] * rstd * w[i]; }
        }
    }
}
template <int M> __device__ __forceinline__ float xorx(float v, int b5) {
    if constexpr (M == 32) { const auto sw = __builtin_amdgcn_permlane32_swap(__float_as_uint(v), __float_as_uint(v), false, false); return __uint_as_float(b5 ? sw[0] : sw[1]); }
    else return __int_as_float(__builtin_amdgcn_ds_swizzle(__float_as_int(v), (M << 10) | 0x1f));
}
#define RS_STEP(lo, hi, bit, off) ((bit ? hi : lo) + xorx<off>(bit ? lo : hi, b5))
__device__ __forceinline__ float rscatter16(const float (&a)[16], int b5, int b4, int b3, int b2) {
    const float c0 = RS_STEP(a[0], a[8], b5, 32), c1 = RS_STEP(a[1], a[9], b5, 32), c2 = RS_STEP(a[2], a[10], b5, 32), c3 = RS_STEP(a[3], a[11], b5, 32);
    const float c4 = RS_STEP(a[4], a[12], b5, 32), c5 = RS_STEP(a[5], a[13], b5, 32), c6 = RS_STEP(a[6], a[14], b5, 32), c7 = RS_STEP(a[7], a[15], b5, 32);
    const float d0 = RS_STEP(c0, c4, b4, 16), d1 = RS_STEP(c1, c5, b4, 16), d2 = RS_STEP(c2, c6, b4, 16), d3 = RS_STEP(c3, c7, b4, 16);
    const float e0 = RS_STEP(d0, d2, b3, 8), e1 = RS_STEP(d1, d3, b3, 8);
    return RS_STEP(e0, e1, b2, 4);
}
__device__ __forceinline__ void n2_finish(float (&lg)[16], int b5, int b4, int b3, int b2, int my_e, int lane, float* AFF, int t) {
    float vv = rscatter16(lg, b5, b4, b3, b2);
    vv += xorx<1>(vv, b5); vv += xorx<2>(vv, b5);
    float mx = vv; mx = fmaxf(mx, xorx<4>(mx, b5)); mx = fmaxf(mx, xorx<8>(mx, b5)); mx = fmaxf(mx, xorx<16>(mx, b5)); mx = fmaxf(mx, xorx<32>(mx, b5));
    const float ex = __expf(vv - mx); float sm = ex; sm += xorx<4>(sm, b5); sm += xorx<8>(sm, b5); sm += xorx<16>(sm, b5); sm += xorx<32>(sm, b5);
    if ((lane & 3) == 0) AFF[(size_t)my_e * R + t] = ex / sm;
}
template <int VAR = 0>
__device__ __forceinline__ void ph_norm2(const Ctx& C, int l, int nrows) {
    const float* X = WSP(float, WS_X); bf16* H = VAR ? WSP(bf16, WS_XG) : WSP(bf16, WS_H); float* AFF = VAR ? WSP(float, WS_ACT) : WSP(float, WS_AFF);
    LAS float* Rs = (LAS float*)C.lds;
    const float* rt = C.in[21] + (size_t)l * D * NE;
    for (int i = C.tid; i < D * NE / 4; i += 512) { const f32x4 r4 = ((const f32x4*)rt)[i]; const int c = i >> 2, e0 = (i & 3) * 4;
        Rs[(e0 + 0) * D + c] = r4.x; Rs[(e0 + 1) * D + c] = r4.y; Rs[(e0 + 2) * D + c] = r4.z; Rs[(e0 + 3) * D + c] = r4.w; }
    __syncthreads();
    const int b5 = (C.lane >> 5) & 1, b4 = (C.lane >> 4) & 1, b3 = (C.lane >> 3) & 1, b2 = (C.lane >> 2) & 1, my_e = 8 * b5 + 4 * b4 + 2 * b3 + b2;
    for (int t0 = (C.blk * 8 + C.wave) * 2; t0 < nrows; t0 += C.G * 16) {
        asm volatile("" ::: "memory");
        const int set = t0 >= SEQ ? 1 : 0;
        f32x4 va[4], vb[4];
#pragma unroll
        for (int j = 0; j < 4; ++j) { va[j] = ((const f32x4*)(X + (size_t)t0 * D))[C.lane + 64 * j]; vb[j] = ((const f32x4*)(X + (size_t)(t0 + 1) * D))[C.lane + 64 * j]; }
        { const f32x4* w = (const f32x4*)(C.in[7] + (size_t)l * D); const f32x4* sh = (const f32x4*)modp(C, l, set, 3); const f32x4* scl = (const f32x4*)modp(C, l, set, 4);
          float sa = 0.f, sb = 0.f;
#pragma unroll
          for (int j = 0; j < 4; ++j) { sa += (va[j].x * va[j].x + va[j].y * va[j].y) + (va[j].z * va[j].z + va[j].w * va[j].w); sb += (vb[j].x * vb[j].x + vb[j].y * vb[j].y) + (vb[j].z * vb[j].z + vb[j].w * vb[j].w); }
          const float ra = rsqrtf(wave_sum(sa) * (1.f / D) + RMS_EPS), rb = rsqrtf(wave_sum(sb) * (1.f / D) + RMS_EPS);
#pragma unroll
          for (int j = 0; j < 4; ++j) { const int i = C.lane + 64 * j; const f32x4 ws = w[i] * (scl[i] + 1.f), s4 = sh[i];
              va[j] = va[j] * ra * ws + s4; vb[j] = vb[j] * rb * ws + s4;
              u32x2 o; o.x = pk2(va[j].x, va[j].y); o.y = pk2(va[j].z, va[j].w); ((u32x2*)(H + (size_t)t0 * D))[i] = o;
              o.x = pk2(vb[j].x, vb[j].y); o.y = pk2(vb[j].z, vb[j].w); ((u32x2*)(H + (size_t)(t0 + 1) * D))[i] = o; } }
        float la[16], lb[16];
#pragma unroll
        for (int e = 0; e < 16; ++e) { float s0 = 0.f, s1 = 0.f;
#pragma unroll
            for (int j = 0; j < 4; ++j) { if (VAR & 2) { s0 += va[j].x * (float)e; s1 += vb[j].y * (float)e; continue; } const f32x4 r = *(const LAS f32x4*)(Rs + e * D + 4 * (C.lane + 64 * j));
                s0 += (va[j].x * r.x + va[j].y * r.y) + (va[j].z * r.z + va[j].w * r.w); s1 += (vb[j].x * r.x + vb[j].y * r.y) + (vb[j].z * r.z + vb[j].w * r.w); }
            la[e] = s0; lb[e] = s1; }
        if (VAR & 1) { float z = 0.f;
#pragma unroll
            for (int e = 0; e < 16; ++e) z += la[e] * lb[e];
            if (C.lane == 0) AFF[t0] = z; continue; }
#pragma unroll 1
        for (int rr = 0; rr < 2; ++rr) {
            n2_finish(la, b5, b4, b3, b2, my_e, C.lane, AFF, t0 + rr);
#pragma unroll
            for (int e = 0; e < 16; ++e) la[e] = lb[e];
        }
    }
}

__device__ __forceinline__ int block_sum_i(int v, LAS int* scr, int wave, int lane) {
    v = wave_sum_i(v);
    if (lane == 0) scr[wave] = v;
    __syncthreads();
    int t = 0;
#pragma unroll
    for (int w = 0; w < 8; ++w) t += scr[w];
    __syncthreads();
    return t;
}
__device__ __forceinline__ int block_excl_scan(int v, LAS int* scr, int wave, int lane) {
    int inc = v;
#pragma unroll
    for (int o = 1; o < 64; o <<= 1) { const int n = __shfl_up(inc, o); if (lane >= o) inc += n; }
    if (lane == 63) scr[wave] = inc;
    __syncthreads();
    int off = 0;
#pragma unroll
    for (int w = 0; w < 8; ++w) off += (w < wave) ? scr[w] : 0;
    __syncthreads();
    return off + inc - v;
}
template <int KPT>
__device__ __forceinline__ void topk_unit(const Ctx& C, int e, int base, int n, int cap, int slot0) {
    const float* aff = WSP(float, WS_AFF) + (size_t)e * R + base;
    int* rowl = WSP(int, WS_ROWL) + e * EROWS; float* gatel = WSP(float, WS_GATEL) + e * EROWS; int* INV = WSP(int, WS_INV);
    LAS unsigned* hist = (LAS unsigned*)C.lds;
    LAS int* scr = (LAS int*)(hist + 2048);
    LAS unsigned* bc = hist + 2048 + 16;
    unsigned key[KPT];
    if (KPT == 32) {
#pragma unroll
        for (int j = 0; j < KPT; j += 4) { const u32x4 k4 = *(const u32x4*)(aff + C.tid * KPT + j); key[j] = k4.x; key[j + 1] = k4.y; key[j + 2] = k4.z; key[j + 3] = k4.w; }
    } else {
#pragma unroll
        for (int j = 0; j < KPT; ++j) { const int t = C.tid * KPT + j; key[j] = t < n ? __float_as_uint(aff[t]) : 0u; }
    }
    unsigned prefix = 0u, pmask = 0u; int kth = cap;
#pragma unroll 1
    for (int pass = 0; pass < 3; ++pass) {
        const int shift = pass == 0 ? 20 : (pass == 1 ? 9 : 0), nb = pass == 2 ? 512 : 2048; const unsigned dmask = (unsigned)nb - 1u;
        for (int i = C.tid; i < nb; i += 512) hist[i] = 0u;
        __syncthreads();
#pragma unroll
        for (int j = 0; j < KPT; ++j) if (key[j] != 0u && (key[j] & pmask) == prefix) __hip_atomic_fetch_add(hist + ((key[j] >> shift) & dmask), 1u, __ATOMIC_RELAXED, __HIP_MEMORY_SCOPE_WORKGROUP);
        __syncthreads();
        if (C.wave == 0) {
            const int per = nb >> 6;
            int tot = 0;
            for (int q = 0; q < per; ++q) tot += (int)hist[C.lane * per + q];
            int suf = tot;
#pragma unroll
            for (int o = 1; o < 64; o <<= 1) { const int nbv = __shfl_down(suf, o); if (C.lane + o < 64) suf += nbv; }
            const unsigned long long bal = __ballot(suf >= kth);
            const int lstar = 63 - __builtin_clzll(bal);
            if (C.lane == lstar) { int above = suf - tot; int q = per - 1;
                for (; q > 0; --q) { const int c = (int)hist[C.lane * per + q]; if (above + c >= kth) break; above += c; }
                bc[0] = (unsigned)(C.lane * per + q); bc[1] = (unsigned)(kth - above); }
        }
        __syncthreads();
        prefix |= bc[0] << shift; pmask |= dmask << shift; kth = (int)bc[1];
    }
    const int need_eq = kth;
    int ce = 0;
#pragma unroll
    for (int j = 0; j < KPT; ++j) ce += key[j] == prefix ? 1 : 0;
    int eqr = block_excl_scan(ce, scr, C.wave, C.lane);
    int nsel = 0; unsigned selmask = 0u;
#pragma unroll
    for (int j = 0; j < KPT; ++j) { bool sl = key[j] > prefix; if (key[j] == prefix) { sl = eqr < need_eq; ++eqr; } if (sl) { ++nsel; selmask |= 1u << j; } }
    int slot = block_excl_scan(nsel, scr, C.wave, C.lane);
#pragma unroll
    for (int j = 0; j < KPT; ++j) { const int t = C.tid * KPT + j;
        if (t < n) {
            if ((selmask >> j) & 1u) { rowl[slot0 + slot] = base + t; gatel[slot0 + slot] = __uint_as_float(key[j]); INV[(size_t)(base + t) * 16 + e] = slot0 + slot; ++slot; }
            else INV[(size_t)(base + t) * 16 + e] = -1;
        } }
}
__device__ __forceinline__ void ph_topk(const Ctx& C, bool with_ctx) {
    for (int u = C.blk; u < (with_ctx ? 32 : 16); u += C.G) {
        const int e = u & 15;
        if (u < 16) { topk_unit<32>(C, e, 0, SEQ, CAP_L, 0); int* rowl = WSP(int, WS_ROWL) + e * EROWS; for (int i = CAP_L + CAP_C + C.tid; i < EROWS; i += 512) rowl[i] = 0; }
        else topk_unit<1>(C, e, SEQ, NCTX, CAP_C, CAP_L);
        __syncthreads();
    }
}
__device__ __forceinline__ void ph_gather(const Ctx& C, bool with_ctx) {
    const int* rowl = WSP(int, WS_ROWL); const bf16* H = WSP(bf16, WS_H); bf16* XG = WSP(bf16, WS_XG);
    const int nslots = with_ctx ? CAP_L + CAP_C : CAP_L, ntot = NE * nslots;
    for (int i = C.blk * 8 + C.wave; i < ntot; i += C.G * 8) {
        const int e = i / nslots, sl = i % nslots, r = e * EROWS + sl;
        const int src = rowl[r];
        u32x4* d = (u32x4*)(XG + (size_t)r * D); const u32x4* sp = (const u32x4*)(H + (size_t)src * D);
        d[C.lane] = sp[C.lane]; d[C.lane + 64] = sp[C.lane + 64];
    }
}
__device__ __forceinline__ void rot_angles(int t, int half, int d, int quarter, float& cs, float& sn) {
    const float invf = exp2f(-(float)d * (13.287712379549449f / (float)quarter));
    const float pos = half ? (float)(t & 63) : (float)(t >> 6);
    const float ang = pos * invf;
    const double rev = (double)ang * 0.15915494309189535; const float fr = (float)(rev - __builtin_rint(rev));
    cs = __builtin_amdgcn_cosf(fr); sn = __builtin_amdgcn_sinf(fr);
}
__device__ __forceinline__ void ph_rope(const Ctx& C, bf16* buf, int hw, int nheads, int off, int quarter) {
    const int per_tok = nheads * 2 * quarter; const long total = (long)SEQ * per_tok;
    for (long i = (long)C.blk * 512 + C.tid; i < total; i += (long)C.G * 512) {
        const int t = (int)(i / per_tok), r = (int)(i % per_tok), h = r / (2 * quarter), p = r % (2 * quarter), half = p / quarter, d = p % quarter;
        float cs, sn; rot_angles(t, half, d, quarter, cs, sn);
        bf16* b = buf + (size_t)h * R * hw + (size_t)t * hw + off + half * 2 * quarter + d;
        const float x1 = bf2f(b[0]), x2 = bf2f(b[quarter]);
        b[0] = (bf16)f2bf(x1 * cs - x2 * sn); b[quarter] = (bf16)f2bf(x1 * sn + x2 * cs);
    }
}
__device__ __forceinline__ void ph_mlanorm(const Ctx& C) {
    const float* CQ = WSP(float, WS_CQ); bf16* CQN = WSP(bf16, WS_CQN); bf16* CKVN = WSP(bf16, WS_CKVN); bf16* KR = WSP(bf16, WS_KROPE);
    for (int t = C.blk * 8 + C.wave; t < R; t += C.G * 8) {
        const float* row = CQ + (size_t)t * D;
        const f32x4 a0 = ((const f32x4*)row)[C.lane], a1 = ((const f32x4*)row)[C.lane + 64], b0 = ((const f32x4*)(row + 512))[C.lane];
        const float sa = wave_sum((a0.x * a0.x + a0.y * a0.y) + (a0.z * a0.z + a0.w * a0.w) + (a1.x * a1.x + a1.y * a1.y) + (a1.z * a1.z + a1.w * a1.w));
        const float sb = wave_sum((b0.x * b0.x + b0.y * b0.y) + (b0.z * b0.z + b0.w * b0.w));
        const float ra = rsqrtf(sa * (1.f / 512.f) + RMS_EPS), rb = rsqrtf(sb * (1.f / 256.f) + RMS_EPS);
        const f32x4* gq = (const f32x4*)C.in[15]; const f32x4* gk = (const f32x4*)C.in[18];
        { const f32x4 y0 = a0 * ra * gq[C.lane], y1 = a1 * ra * gq[C.lane + 64], z = b0 * rb * gk[C.lane];
          u32x2 o; o.x = pk2(y0.x, y0.y); o.y = pk2(y0.z, y0.w); ((u32x2*)(CQN + (size_t)t * 512))[C.lane] = o;
          o.x = pk2(y1.x, y1.y); o.y = pk2(y1.z, y1.w); ((u32x2*)(CQN + (size_t)t * 512))[C.lane + 64] = o;
          o.x = pk2(z.x, z.y); o.y = pk2(z.z, z.w); ((u32x2*)(CKVN + (size_t)t * 256))[C.lane] = o; }
        const float x = row[768 + (C.lane & 31)];
        const float xp = __shfl_xor(x, 8);
        float y = x;
        if (t < SEQ) { float cs, sn; rot_angles(t, (C.lane >> 4) & 1, C.lane & 7, 8, cs, sn);
            y = ((C.lane >> 3) & 1) ? (xp * sn + x * cs) : (x * cs - xp * sn); }
        if (C.lane < 32) KR[(size_t)t * 32 + C.lane] = (bf16)f2bf(y);
    }
}

constexpr int CW_KMAX = 8192;
__device__ __forceinline__ void ph_kmax(const Ctx& C) {
    const bf16* KV = WSP(bf16, WS_KV); const bf16* KR = WSP(bf16, WS_KROPE); unsigned* ctl = (unsigned*)(C.ws + WS_CTL);
    for (int i = C.blk * 512 + C.tid; i < 16 * R; i += C.G * 512) {
        const int h = i / R, t = i - h * R;
        const u32x4* kp = (const u32x4*)(KV + (size_t)h * R * 128 + (size_t)t * 128); const u32x4* rp = (const u32x4*)(KR + (size_t)t * 32);
        float ss = 0.f;
#pragma unroll
        for (int q = 0; q < 12; ++q) { const u32x4 w = q < 8 ? kp[q] : rp[q - 8];
            const float a0 = bf2f(w.x & 0xffffu), a1 = bf2f(w.x >> 16), a2 = bf2f(w.y & 0xffffu), a3 = bf2f(w.y >> 16), a4 = bf2f(w.z & 0xffffu), a5 = bf2f(w.z >> 16), a6 = bf2f(w.w & 0xffffu), a7 = bf2f(w.w >> 16);
            ss += (a0 * a0 + a1 * a1) + (a2 * a2 + a3 * a3) + (a4 * a4 + a5 * a5) + (a6 * a6 + a7 * a7); }
#pragma unroll
        for (int o = 1; o < 64; o <<= 1) ss = fmaxf(ss, __shfl_xor(ss, o));
        if (C.lane == 0) atomicMax(ctl + CW_KMAX + h, __float_as_uint(ss));
    }
}

namespace pg8 {
#define PG8_LAS __attribute__((address_space(3)))
typedef unsigned short bf16_t;
typedef short bf16x8 __attribute__((ext_vector_type(8)));
typedef float f32x4 __attribute__((ext_vector_type(4)));
typedef unsigned u32x4 __attribute__((ext_vector_type(4)));
constexpr int BM = 256, BK = 64, HALF = 128, HTB = HALF * BK * 2  , STAGE_BYTES = 8 * HTB, NXCD = 8, WGM = 8;

__host__ __device__ __forceinline__ int lds_byte(int r, int c) { const int st = (r >> 4) * 2 + (c >> 5), rr = r & 15, cc = c & 31, ob = rr * 64 + cc * 2; return st * 1024 + (ob ^ (((ob >> 9) & 1) << 5)); }
__host__ __device__ __forceinline__ void stage_rc(int b, int& R, int& C) { const int st = b / 1024, sb = b % 1024, swz = sb ^ (((sb >> 9) & 1) << 5); R = (st >> 1) * 16 + swz / 64; C = (st & 1) * 32 + (swz % 64) / 2; }
__host__ __device__ __forceinline__ int perm32(int rho) { const int n = rho >> 4, i = rho & 15; return 8 * (i >> 2) + 4 * n + (i & 3); }

struct Unit { int pm, pn, thin; };
struct Gemm { const bf16_t* A; const bf16_t* Bt; int M, N, K; int pm_per_grp; size_t grp_stride; };

struct StaticOrder {
    int nM, nN, nwg, G, c;
    __host__ __device__ void init(int M, int N, int G_, int c_) { nM = M / BM; nN = N / BM; nwg = nM * nN; G = G_; c = c_; }
    __host__ __device__ bool next(int i, Unit& u) const {
        const long L = (long)i * G + c; if (L >= nwg) return false;
        int wgid = (int)L; { const int q = nwg / NXCD, r = nwg % NXCD, xcd = wgid % NXCD, off = wgid / NXCD; wgid = (xcd < r ? xcd * (q + 1) : r * (q + 1) + (xcd - r) * q) + off; }
        const int nig = WGM * nN, gid = wgid / nig, fm = gid * WGM, gsz = (nM - fm) < WGM ? (nM - fm) : WGM;
        u.pm = fm + ((wgid % nig) % gsz); u.pn = (wgid % nig) / gsz; u.thin = 0; return true;
    }
    __device__ __forceinline__ void a_ready(const Unit&) const {}
    __device__ __forceinline__ void done(const Unit&) const {}
};
struct MoeOrder {
    StaticOrder base; int nN, nthin;
    __host__ __device__ void init(int N, int G_, int c_, bool with_thin) { base.init(NEXP_PANELS * BM, N, G_, c_); nN = N / BM; nthin = with_thin ? 16 * nN : 0; }
    static constexpr int NEXP_PANELS = 16 * 8;
    __host__ __device__ bool next(int i, Unit& u) const {
        if (base.next(i, u)) { u.pm = (u.pm >> 3) * 9 + (u.pm & 7); return true; }
        const long j = (long)i * base.G + base.c - base.nwg; if (j >= nthin) return false;
        u.pm = (int)(j / nN) * 9 + 8; u.pn = (int)(j % nN); u.thin = 1; return true;
    }
    __device__ __forceinline__ void a_ready(const Unit&) const {}
    __device__ __forceinline__ void done(const Unit&) const {}
};

template <class Epi, class Sched, bool ALIGN_EPI = false, bool SP2 = false, bool GATHER = false>
__device__ __forceinline__ void gemm_phase(PG8_LAS unsigned char* lds, const Gemm g, const Sched& S, const Epi& E, const PG8_LAS int* idx_tab = nullptr) {
    static_assert(!GATHER || SP2, "the gathered A panel is wired into the SP2 loop only");
    const int tid = threadIdx.x, wid = __builtin_amdgcn_readfirstlane(tid >> 6), lane = tid & 63, wr = wid >> 2, wc = wid & 3, fr = lane & 15, fq = lane >> 4;
    const int K = g.K, nt = K / BK;
    unsigned voffA[2], voffB[2]; int rowA[2]; unsigned colA[2];
#pragma unroll
    for (int i = 0; i < 2; ++i) { int R, C; stage_rc(tid * 16 + i * 8192, R, C); const int Rb = Epi::PERM ? ((R & ~31) + perm32(R & 31)) : R;
        voffA[i] = (unsigned)(R * K + C) * 2u; voffB[i] = (unsigned)(Rb * K + C) * 2u; rowA[i] = R; colA[i] = (unsigned)C * 2u; }
    unsigned vGc[2][2], vGn[2][2];
#define PG8_GOFF(dst, ui_) do { _Pragma("unroll") for (int h_ = 0; h_ < 2; ++h_) _Pragma("unroll") for (int i_ = 0; i_ < 2; ++i_) \
        dst[h_][i_] = (unsigned)idx_tab[(ui_) * 256 + h_ * HALF + rowA[i_]] * (unsigned)(K * 2) + colA[i_]; } while (0)
#define PG8_STAGE_A(bufoff, ptr, h, nf) do { if constexpr (GATHER) { _Pragma("unroll") for (int _i = 0; _i < 2; ++_i) \
        __builtin_amdgcn_global_load_lds((const unsigned*)((const char*)(ptr) + ((nf) ? vGn[h][_i] : vGc[h][_i])), (PG8_LAS unsigned*)(lds + (bufoff) + ldsw + _i * 8192), 16, 0, 0); } \
        else PG8_STAGE(bufoff, (ptr) + (h) * hstep, voffA); } while (0)
    const size_t kstep = (size_t)(BK * 2);
    const size_t hstep = (size_t)HALF * K * 2;
    const size_t tstep = 2 * hstep;
    const unsigned ldsw = (unsigned)wid * 1024u;
    const int aoff = lds_byte(wr * 64 + fr, fq * 8), boff = lds_byte(wc * 32 + fr, fq * 8);
#define PG8_SA(b, h) (((b) * 2 + (h)) * HTB)
#define PG8_SB(b, h) ((4 + (b) * 2 + (h)) * HTB)
#define PG8_STAGE(bufoff, gbase, voff) do { _Pragma("unroll") for (int _i = 0; _i < 2; ++_i) \
        __builtin_amdgcn_global_load_lds((const unsigned*)((const char*)(gbase) + (voff)[_i]), (PG8_LAS unsigned*)(lds + (bufoff) + ldsw + _i * 8192), 16, 0, 0); } while (0)
#define PG8_LDA(dst, b, h) do { _Pragma("unroll") for (int m = 0; m < 4; ++m) _Pragma("unroll") for (int k = 0; k < 2; ++k) dst[m][k] = *(const PG8_LAS bf16x8*)(lds + PG8_SA(b, h) + aoff + m * 2048 + k * 1024); } while (0)
#define PG8_LDB(dst, b, h) do { _Pragma("unroll") for (int n = 0; n < 2; ++n) _Pragma("unroll") for (int k = 0; k < 2; ++k) dst[n][k] = *(const PG8_LAS bf16x8*)(lds + PG8_SB(b, h) + boff + n * 2048 + k * 1024); } while (0)
#define PG8_MMA(ai, bj, At, Bt) do { if (cur.thin && ((ai) != 0 || wr != 0)) break; __builtin_amdgcn_s_setprio(1); _Pragma("unroll") for (int m = 0; m < 4; ++m) _Pragma("unroll") for (int n = 0; n < 2; ++n) _Pragma("unroll") for (int k = 0; k < 2; ++k) \
        acc[ai][bj][m][n] = __builtin_amdgcn_mfma_f32_16x16x32_bf16(Bt[n][k], At[m][k], acc[ai][bj][m][n], 0, 0, 0); __builtin_amdgcn_s_setprio(0); } while (0)
#define PG8_WAIT_V(n) asm volatile("s_waitcnt vmcnt(" #n ")" ::: "memory")
#define PG8_WAIT_L(n) asm volatile("s_waitcnt lgkmcnt(" #n ")" ::: "memory")
#define PG8_BAR __builtin_amdgcn_s_barrier()
#define PG8_SCHED __builtin_amdgcn_sched_barrier(0)
    Unit cur, nxt; int ui = 0;
    if (!S.next(0, cur)) return;
    f32x4 acc[2][2][4][2];
#pragma unroll
    for (int a = 0; a < 2; ++a)
#pragma unroll
        for (int b = 0; b < 2; ++b)
#pragma unroll
            for (int m = 0; m < 4; ++m)
#pragma unroll
                for (int n = 0; n < 2; ++n) acc[a][b][m][n] = (f32x4){0.f, 0.f, 0.f, 0.f};
    bf16x8 At[4][2], B0[2][2], B1[2][2];
    const char* cA = GATHER ? (const char*)g.A : (const char*)g.A + (size_t)cur.pm * tstep; const char* cB = (const char*)g.Bt + (g.pm_per_grp ? (size_t)(cur.pm / g.pm_per_grp) * g.grp_stride * 2 : (size_t)0) + (size_t)cur.pn * tstep;
    S.a_ready(cur);
    if constexpr (GATHER) { PG8_GOFF(vGc, 0); }
    if constexpr (SP2) {
        PG8_STAGE(PG8_SB(0, 0), cB, voffB); PG8_STAGE(PG8_SB(0, 1), cB + hstep, voffB); PG8_STAGE_A(PG8_SA(0, 0), cA, 0, false); PG8_STAGE_A(PG8_SA(0, 1), cA, 1, false);
        if (wr == 1) PG8_BAR;
        PG8_WAIT_V(2); PG8_BAR;
        PG8_STAGE(PG8_SB(1, 0), cB + kstep, voffB); PG8_STAGE_A(PG8_SA(1, 0), cA + kstep, 0, false); PG8_STAGE(PG8_SB(1, 1), cB + hstep + kstep, voffB);
        PG8_WAIT_V(6); PG8_BAR;
    } else {
        PG8_STAGE(PG8_SB(0, 0), cB, voffB); PG8_STAGE(PG8_SA(0, 0), cA, voffA); PG8_STAGE(PG8_SB(0, 1), cB + hstep, voffB); PG8_STAGE(PG8_SA(0, 1), cA + hstep, voffA);
        if (wr == 1) PG8_BAR;
        PG8_WAIT_V(4); PG8_BAR;
        PG8_STAGE(PG8_SB(1, 0), cB + kstep, voffB); PG8_STAGE(PG8_SA(1, 0), cA + kstep, voffA); PG8_STAGE(PG8_SB(1, 1), cB + hstep + kstep, voffB);
        PG8_WAIT_V(6); PG8_BAR;
    }
    for (;;) {
        const bool has_next = S.next(ui + 1, nxt);
        const char* nA = GATHER ? (const char*)g.A : (has_next ? (const char*)g.A + (size_t)nxt.pm * tstep : cA);
        if constexpr (GATHER) { if (has_next) { PG8_GOFF(vGn, ui + 1); } else {
#pragma unroll
            for (int h_ = 0; h_ < 2; ++h_) { vGn[h_][0] = vGc[h_][0]; vGn[h_][1] = vGc[h_][1]; } } } const char* nB = has_next ? (const char*)g.Bt + (g.pm_per_grp ? (size_t)(nxt.pm / g.pm_per_grp) * g.grp_stride * 2 : (size_t)0) + (size_t)nxt.pn * tstep : cB;
        for (int t = 0; t < nt; t += 2) {
            const bool last = (t == nt - 2);
            const char* a1 = cA + (size_t)(t + 1) * kstep;
            const char* a2 = last ? nA : cA + (size_t)(t + 2) * kstep; const char* b2 = last ? nB : cB + (size_t)(t + 2) * kstep;
            const char* a3 = a2 + kstep; const char* b3 = b2 + kstep;
            if (last && has_next) S.a_ready(nxt);
            if constexpr (SP2) {
            PG8_LDB(B0, 0, 0); PG8_LDB(B1, 0, 1); PG8_SCHED; PG8_LDA(At, 0, 0); PG8_STAGE_A(PG8_SA(1, 1), a1, 1, false);
            PG8_WAIT_V(8); PG8_WAIT_L(0); PG8_BAR; PG8_MMA(0, 0, At, B0); PG8_MMA(0, 1, At, B1); PG8_BAR; PG8_SCHED;
            PG8_LDA(At, 0, 1); PG8_STAGE(PG8_SB(0, 0), b2, voffB); PG8_STAGE(PG8_SB(0, 1), b2 + hstep, voffB); PG8_STAGE_A(PG8_SA(0, 0), a2, 0, last);
            PG8_WAIT_V(8); PG8_WAIT_L(0); PG8_BAR; PG8_MMA(1, 0, At, B0); PG8_MMA(1, 1, At, B1); PG8_BAR; PG8_SCHED;
            PG8_LDB(B0, 1, 0); PG8_LDB(B1, 1, 1); PG8_SCHED; PG8_LDA(At, 1, 0); PG8_STAGE_A(PG8_SA(0, 1), a2, 1, last);
            PG8_WAIT_V(8); PG8_WAIT_L(0); PG8_BAR; PG8_MMA(0, 0, At, B0); PG8_MMA(0, 1, At, B1); PG8_BAR; PG8_SCHED;
            PG8_LDA(At, 1, 1); PG8_STAGE(PG8_SB(1, 0), b3, voffB); PG8_STAGE(PG8_SB(1, 1), b3 + hstep, voffB); PG8_STAGE_A(PG8_SA(1, 0), a3, 0, last);
            PG8_WAIT_V(8); PG8_WAIT_L(0); PG8_BAR; PG8_MMA(1, 0, At, B0); PG8_MMA(1, 1, At, B1); PG8_BAR; PG8_SCHED;
            } else {
            PG8_LDB(B0, 0, 0); PG8_SCHED; PG8_LDA(At, 0, 0); PG8_STAGE(PG8_SA(1, 1), a1 + hstep, voffA);
            PG8_WAIT_L(8); PG8_BAR; PG8_WAIT_L(0); PG8_MMA(0, 0, At, B0); PG8_BAR; PG8_SCHED;
            PG8_LDB(B1, 0, 1); PG8_STAGE(PG8_SB(0, 0), b2, voffB);
            PG8_BAR; PG8_WAIT_L(0); PG8_MMA(0, 1, At, B1); PG8_BAR;
            PG8_LDA(At, 0, 1); PG8_STAGE(PG8_SA(0, 0), a2, voffA);
            PG8_BAR; PG8_WAIT_L(0); PG8_MMA(1, 0, At, B0); PG8_BAR; PG8_SCHED;
            PG8_STAGE(PG8_SB(0, 1), b2 + hstep, voffB);
            PG8_WAIT_V(6); PG8_BAR; PG8_MMA(1, 1, At, B1); PG8_BAR;
            PG8_LDB(B0, 1, 0); PG8_SCHED; PG8_LDA(At, 1, 0); PG8_STAGE(PG8_SA(0, 1), a2 + hstep, voffA);
            PG8_WAIT_L(8); PG8_BAR; PG8_WAIT_L(0); PG8_MMA(0, 0, At, B0); PG8_BAR; PG8_SCHED;
            PG8_LDB(B1, 1, 1); PG8_STAGE(PG8_SB(1, 0), b3, voffB);
            PG8_BAR; PG8_WAIT_L(0); PG8_MMA(0, 1, At, B1); PG8_BAR;
            PG8_LDA(At, 1, 1); PG8_STAGE(PG8_SA(1, 0), a3, voffA);
            PG8_BAR; PG8_WAIT_L(0); PG8_MMA(1, 0, At, B0); PG8_BAR; PG8_SCHED;
            PG8_STAGE(PG8_SB(1, 1), b3 + hstep, voffB);
            PG8_WAIT_V(6); PG8_BAR; PG8_MMA(1, 1, At, B1); PG8_BAR;
            }
        }
        if constexpr (ALIGN_EPI) { if (wr == 0) PG8_BAR; }
        if constexpr (!Epi::AFTER_DRAIN) { E(acc, cur, wr, wc, fr, fq); S.done(cur); }
        if (!has_next) break;
#pragma unroll
        for (int a = 0; a < 2; ++a)
#pragma unroll
            for (int b = 0; b < 2; ++b)
#pragma unroll
                for (int m = 0; m < 4; ++m)
#pragma unroll
                    for (int n = 0; n < 2; ++n) acc[a][b][m][n] = (f32x4){0.f, 0.f, 0.f, 0.f};
        cur = nxt; cA = nA; cB = nB; ++ui;
        if constexpr (GATHER) {
#pragma unroll
            for (int h_ = 0; h_ < 2; ++h_) { vGc[h_][0] = vGn[h_][0]; vGc[h_][1] = vGn[h_][1]; } }
        if constexpr (ALIGN_EPI) { if (wr == 1) PG8_BAR; }
    }
    PG8_WAIT_V(0);
    if constexpr (!ALIGN_EPI) { if (wr == 0) PG8_BAR; }
    PG8_BAR;
    if constexpr (Epi::AFTER_DRAIN) { E.fused(acc, cur, wr, wc, fr, fq, lds, wid, lane); S.done(cur); }
#undef PG8_GOFF
#undef PG8_STAGE_A
#undef PG8_SA
#undef PG8_SB
#undef PG8_STAGE
#undef PG8_LDA
#undef PG8_LDB
#undef PG8_MMA
#undef PG8_WAIT_V
#undef PG8_WAIT_L
#undef PG8_BAR
#undef PG8_SCHED
}
}
#ifndef USE_PG8
#define USE_PG8 1
#endif

typedef const f32x4 (&AccRef)[2][2][4][2];
struct EpiStoreBf16 { static constexpr bool DUAL = false, PERM = true, AFTER_DRAIN = false; bf16* O; int ldc;
    __device__ __forceinline__ void elem(int row, int col, float v, float) const { O[(size_t)row * ldc + col] = (bf16)f2bf(v); }
    __device__ __forceinline__ void operator()(AccRef acc, const pg8::Unit& u, int wr, int wc, int fr, int fq) const {
        const int row0 = u.pm * 256 + wr * 64 + fr, col0 = u.pn * 256 + wc * 32 + 8 * fq;
#pragma unroll
        for (int ai = 0; ai < 2; ++ai)
#pragma unroll
            for (int m = 0; m < 4; ++m) { bf16* rowp = O + (size_t)(row0 + ai * 128 + m * 16) * ldc + col0;
#pragma unroll
                for (int bj = 0; bj < 2; ++bj) { const f32x4 v0 = acc[ai][bj][m][0], v1 = acc[ai][bj][m][1];
                    u32x4 w; w.x = cvt_pk_bf16(v0[0], v0[1]); w.y = cvt_pk_bf16(v0[2], v0[3]); w.z = cvt_pk_bf16(v1[0], v1[1]); w.w = cvt_pk_bf16(v1[2], v1[3]);
                    *(u32x4*)(rowp + bj * 128) = w; } }
    } };
struct EpiStoreHeads { static constexpr bool DUAL = false, PERM = true, AFTER_DRAIN = false; bf16* O; int hw; size_t hstride;
    __device__ __forceinline__ void store4(int row, int col, f32x4 v) const { const int hd = col / hw, wi = col - hd * hw; u32x2 o; o.x = cvt_pk_bf16(v[0], v[1]); o.y = cvt_pk_bf16(v[2], v[3]); *(u32x2*)(O + (size_t)hd * hstride + (size_t)row * hw + wi) = o; }
    __device__ __forceinline__ void elem(int row, int col, float v, float) const { O[(size_t)(col / hw) * hstride + (size_t)row * hw + (col % hw)] = (bf16)f2bf(v); }
    __device__ __forceinline__ void operator()(AccRef acc, const pg8::Unit& u, int wr, int wc, int fr, int fq) const {
        const int row0 = u.pm * 256 + wr * 64 + fr, col0 = u.pn * 256 + wc * 32 + 8 * fq;
#pragma unroll
        for (int bj = 0; bj < 2; ++bj) { const int c = col0 + bj * 128, hd = c / hw, wi = c - hd * hw; bf16* base = O + (size_t)hd * hstride + wi;
#pragma unroll
            for (int ai = 0; ai < 2; ++ai)
#pragma unroll
                for (int m = 0; m < 4; ++m) { const f32x4 v0 = acc[ai][bj][m][0], v1 = acc[ai][bj][m][1];
                    u32x4 w; w.x = cvt_pk_bf16(v0[0], v0[1]); w.y = cvt_pk_bf16(v0[2], v0[3]); w.z = cvt_pk_bf16(v1[0], v1[1]); w.w = cvt_pk_bf16(v1[2], v1[3]);
                    *(u32x4*)(base + (size_t)(row0 + ai * 128 + m * 16) * hw) = w; } }
    } };
struct EpiStoreF32 { static constexpr bool DUAL = false, PERM = false, AFTER_DRAIN = false; float* O; int ldc;
    __device__ __forceinline__ void store4(int row, int col, f32x4 v) const { *(f32x4*)(O + (size_t)row * ldc + col) = v; }
    __device__ __forceinline__ void elem(int row, int col, float v, float) const { O[(size_t)row * ldc + col] = v; }
    __device__ __forceinline__ void operator()(AccRef acc, const pg8::Unit& u, int wr, int wc, int fr, int fq) const {
        const int row0 = u.pm * 256 + wr * 64 + fr, col0 = u.pn * 256 + wc * 32 + 4 * fq;
#pragma unroll
        for (int ai = 0; ai < 2; ++ai)
#pragma unroll
            for (int m = 0; m < 4; ++m) { float* rowp = O + (size_t)(row0 + ai * 128 + m * 16) * ldc + col0;
#pragma unroll
                for (int bj = 0; bj < 2; ++bj)
#pragma unroll
                    for (int n = 0; n < 2; ++n) *(f32x4*)(rowp + bj * 128 + n * 16) = acc[ai][bj][m][n]; }
    } };
struct EpiResid { static constexpr bool DUAL = false, PERM = false, AFTER_DRAIN = false; float* X; const float* g_lat; const float* g_ctx;
    __device__ __forceinline__ void store4(int row, int col, f32x4 v) const { const float* g = row >= SEQ ? g_ctx : g_lat; f32x4* p = (f32x4*)(X + (size_t)row * D + col); *p = *p + *(const f32x4*)(g + col) * v; }
    __device__ __forceinline__ void elem(int row, int col, float v, float) const { const float g = row >= SEQ ? g_ctx[col] : g_lat[col]; X[(size_t)row * D + col] += g * v; }
    __device__ __forceinline__ void operator()(AccRef acc, const pg8::Unit& u, int wr, int wc, int fr, int fq) const {
        const int row0 = u.pm * 256 + wr * 64 + fr, col0 = u.pn * 256 + wc * 32 + 4 * fq;
        const float* g = (u.pm * 256 >= SEQ) ? g_ctx : g_lat;
        f32x4 gv[2][2];
#pragma unroll
        for (int bj = 0; bj < 2; ++bj)
#pragma unroll
            for (int n = 0; n < 2; ++n) gv[bj][n] = *(const f32x4*)(g + col0 + bj * 128 + n * 16);
#pragma unroll
        for (int ai = 0; ai < 2; ++ai)
#pragma unroll
            for (int m = 0; m < 4; ++m) { float* rowp = X + (size_t)(row0 + ai * 128 + m * 16) * D + col0;
#pragma unroll
                for (int bj = 0; bj < 2; ++bj)
#pragma unroll
                    for (int n = 0; n < 2; ++n) { f32x4* p = (f32x4*)(rowp + bj * 128 + n * 16); *p = *p + gv[bj][n] * acc[ai][bj][m][n]; } }
    } };
__device__ __forceinline__ float silu_mul(float g, float u) { return g * __builtin_amdgcn_rcpf(1.f + __expf(-g)) * u; }
struct EpiSwiglu { static constexpr bool DUAL = true, PERM = true, AFTER_DRAIN = false; bf16* ACT;
    __device__ __forceinline__ void elem(int row, int col, float g, float u) const { ACT[(size_t)row * FF + col] = (bf16)f2bf(g / (1.f + __expf(-g)) * u); }
    __device__ __forceinline__ void operator()(AccRef acc, const pg8::Unit& u, int wr, int wc, int fr, int fq) const {
        const int row0 = u.pm * 256 + wr * 64 + fr, col0 = u.pn * 128 + wc * 32 + 8 * fq;
#pragma unroll
        for (int ai = 0; ai < 2; ++ai)
#pragma unroll
            for (int m = 0; m < 4; ++m) { bf16* rowp = ACT + (size_t)(row0 + ai * 128 + m * 16) * FF + col0;
                const f32x4 g0 = acc[ai][0][m][0], g1 = acc[ai][0][m][1], u0 = acc[ai][1][m][0], u1 = acc[ai][1][m][1];
                u32x4 w; w.x = cvt_pk_bf16(silu_mul(g0[0], u0[0]), silu_mul(g0[1], u0[1])); w.y = cvt_pk_bf16(silu_mul(g0[2], u0[2]), silu_mul(g0[3], u0[3]));
                w.z = cvt_pk_bf16(silu_mul(g1[0], u1[0]), silu_mul(g1[1], u1[1])); w.w = cvt_pk_bf16(silu_mul(g1[2], u1[2]), silu_mul(g1[3], u1[3]));
                *(u32x4*)rowp = w; }
    } };
struct EpiMoeOut { static constexpr bool DUAL = false, PERM = true, AFTER_DRAIN = false; bf16* YB; const float* gatel;
    __device__ __forceinline__ void elem(int row, int col, float v, float) const { YB[(size_t)row * D + col] = (bf16)f2bf(v * gatel[row]); }
    __device__ __forceinline__ void operator()(AccRef acc, const pg8::Unit& u, int wr, int wc, int fr, int fq) const {
        const int row0 = u.pm * 256 + wr * 64 + fr, col0 = u.pn * 256 + wc * 32 + 8 * fq;
#pragma unroll
        for (int ai = 0; ai < 2; ++ai)
#pragma unroll
            for (int m = 0; m < 4; ++m) { const int row = row0 + ai * 128 + m * 16; const float gt = gatel[row]; bf16* rowp = YB + (size_t)row * D + col0;
#pragma unroll
                for (int bj = 0; bj < 2; ++bj) { const f32x4 v0 = acc[ai][bj][m][0] * gt, v1 = acc[ai][bj][m][1] * gt;
                    u32x4 w; w.x = cvt_pk_bf16(v0[0], v0[1]); w.y = cvt_pk_bf16(v0[2], v0[3]); w.z = cvt_pk_bf16(v1[0], v1[1]); w.w = cvt_pk_bf16(v1[2], v1[3]);
                    *(u32x4*)(rowp + bj * 128) = w; } }
    } };

template <class Epi>
__device__ __forceinline__ void naive_gemm(const Ctx& C, const bf16* A, const bf16* Bt, int M, int N, int K, int pm_per_grp, size_t grp_stride, const Epi& E) {
    LAS float* As = (LAS float*)C.lds;
    LAS float* Bs = As + 16 * 132;
    LAS float* Bs2 = Bs + 16 * 68;
    const int NO = Epi::DUAL ? N / 2 : N, tn_cnt = NO / 64, nun = (M / 128) * tn_cnt;
    const int ty = C.tid >> 4, tx = C.tid & 15;
    for (int u = C.blk; u < nun; u += C.G) {
        const int tm = u / tn_cnt, tn = u % tn_cnt, row0 = tm * 128, oc0 = tn * 64;
        const bf16* Bg = Bt + (pm_per_grp ? (size_t)((row0 / 256) / pm_per_grp) * grp_stride : (size_t)0);
        const int brow0 = Epi::DUAL ? ((oc0 >> 7) * 256 + (oc0 & 127)) : oc0;
        float acc[4][4], acc2[4][4];
#pragma unroll
        for (int i = 0; i < 4; ++i)
#pragma unroll
            for (int j = 0; j < 4; ++j) { acc[i][j] = 0.f; acc2[i][j] = 0.f; }
        for (int k0 = 0; k0 < K; k0 += 16) {
            __syncthreads();
            { const int r = C.tid >> 2, kc = (C.tid & 3) * 4;
              const u32x2 w = *(const u32x2*)(A + (size_t)(row0 + r) * K + k0 + kc);
              As[(kc + 0) * 132 + r] = bf2f(w.x & 0xffffu); As[(kc + 1) * 132 + r] = bf2f(w.x >> 16); As[(kc + 2) * 132 + r] = bf2f(w.y & 0xffffu); As[(kc + 3) * 132 + r] = bf2f(w.y >> 16); }
            if (C.tid < 256) { const int r = C.tid >> 2, kc = (C.tid & 3) * 4;
              const u32x2 w = *(const u32x2*)(Bg + (size_t)(brow0 + r) * K + k0 + kc);
              Bs[(kc + 0) * 68 + r] = bf2f(w.x & 0xffffu); Bs[(kc + 1) * 68 + r] = bf2f(w.x >> 16); Bs[(kc + 2) * 68 + r] = bf2f(w.y & 0xffffu); Bs[(kc + 3) * 68 + r] = bf2f(w.y >> 16);
              if (Epi::DUAL) { const u32x2 w2 = *(const u32x2*)(Bg + (size_t)(brow0 + 128 + r) * K + k0 + kc);
                Bs2[(kc + 0) * 68 + r] = bf2f(w2.x & 0xffffu); Bs2[(kc + 1) * 68 + r] = bf2f(w2.x >> 16); Bs2[(kc + 2) * 68 + r] = bf2f(w2.y & 0xffffu); Bs2[(kc + 3) * 68 + r] = bf2f(w2.y >> 16); } }
            __syncthreads();
#pragma unroll
            for (int kk = 0; kk < 16; ++kk) {
                const f32x4 a = *(const LAS f32x4*)(As + kk * 132 + ty * 4), b = *(const LAS f32x4*)(Bs + kk * 68 + tx * 4);
#pragma unroll
                for (int i = 0; i < 4; ++i)
#pragma unroll
                    for (int j = 0; j < 4; ++j) acc[i][j] += a[i] * b[j];
                if (Epi::DUAL) { const f32x4 b2 = *(const LAS f32x4*)(Bs2 + kk * 68 + tx * 4);
#pragma unroll
                    for (int i = 0; i < 4; ++i)
#pragma unroll
                        for (int j = 0; j < 4; ++j) acc2[i][j] += a[i] * b2[j]; }
            }
        }
#pragma unroll
        for (int i = 0; i < 4; ++i)
#pragma unroll
            for (int j = 0; j < 4; ++j) E.elem(row0 + ty * 4 + i, oc0 + tx * 4 + j, acc[i][j], acc2[i][j]);
    }
    __syncthreads();
}

template <class Epi>
__device__ __forceinline__ void gemm(const Ctx& C, const bf16* A, const bf16* Bt, int M, int N, int K, int pm_per_grp, size_t grp_stride, const Epi& E) {
#if USE_PG8
    pg8::Gemm g{A, Bt, M, N, K, pm_per_grp, grp_stride}; pg8::StaticOrder S; S.init(M, N, C.G, C.blk);
    pg8::gemm_phase<Epi, pg8::StaticOrder, true, true>(C.lds, g, S, E);
#else
    naive_gemm(C, A, Bt, M, N, K, pm_per_grp, grp_stride, E);
#endif
}
template <class Epi>
__device__ __forceinline__ void small_gemm(const Ctx& C, const bf16* A, const bf16* Bt, int row0, int nrows, int N, int K, const Epi& E) {
    const int ql = C.lane & 31, hi = C.lane >> 5, nrb = nrows / 32, nitems = nrb * (N / 32);
    for (int it = C.blk * 8 + C.wave; it < nitems; it += C.G * 8) {
        const int cb = it / nrb, rb = it % nrb;
        const bf16* ap = A + (size_t)(row0 + rb * 32 + ql) * K + 8 * hi; const bf16* bp = Bt + (size_t)(cb * 32 + ql) * K + 8 * hi;
        f32x16 acc;
#pragma unroll
        for (int r = 0; r < 16; ++r) acc[r] = 0.f;
#pragma unroll 1
        for (int k0 = 0; k0 < K; k0 += 256) {
            bf16x8 a[16], b[16];
#pragma unroll
            for (int q = 0; q < 16; ++q) { a[q] = *(const bf16x8*)(ap + k0 + 16 * q); b[q] = *(const bf16x8*)(bp + k0 + 16 * q); }
            __builtin_amdgcn_sched_barrier(0);
#pragma unroll
            for (int q = 0; q < 16; ++q) acc = __builtin_amdgcn_mfma_f32_32x32x16_bf16(b[q], a[q], acc, 0, 0, 0);
            __builtin_amdgcn_sched_barrier(0);
        }
        const int row = row0 + rb * 32 + ql;
#pragma unroll
        for (int g = 0; g < 4; ++g) E.store4(row, cb * 32 + 8 * g + 4 * hi, (f32x4){acc[4 * g], acc[4 * g + 1], acc[4 * g + 2], acc[4 * g + 3]});
    }
}
template <class Epi>
__device__ __forceinline__ void gemm_tok(const Ctx& C, const bf16* A, const bf16* Bt, int N, int K, bool with_ctx, const Epi& E) {
#if USE_PG8
    gemm(C, A, Bt, SEQ, N, K, 0, 0, E);
    if (with_ctx) small_gemm(C, A, Bt, SEQ, NCTX, N, K, E);
#else
    naive_gemm(C, A, Bt, with_ctx ? R : SEQ, N, K, 0, 0, E);
#endif
}
constexpr int LDS_IDX_OFF = 132096;
template <class Epi>
__device__ __forceinline__ void gemm_moe(const Ctx& C, const bf16* A, const bf16* Bt, int N, int K, size_t grp_stride, bool with_ctx, const Epi& E, const int* rowlist = nullptr) {
#if USE_PG8
    pg8::Gemm g{A, Bt, XROWS, N, K, 9, grp_stride}; pg8::MoeOrder S; S.init(N, C.G, C.blk, with_ctx);
    if (rowlist) {
        LAS int* tab = (LAS int*)(C.lds + LDS_IDX_OFF); pg8::Unit u;
        for (int i = 0; S.next(i, u); ++i) if (C.tid < 256) tab[i * 256 + C.tid] = rowlist[u.pm * 256 + C.tid];
        __syncthreads();
        pg8::gemm_phase<Epi, pg8::MoeOrder, true, true, true>(C.lds, g, S, E, tab);
        return;
    }
    pg8::gemm_phase<Epi, pg8::MoeOrder, true, true>(C.lds, g, S, E);
#else
    naive_gemm(C, A, Bt, XROWS, N, K, 9, grp_stride, E);
#endif
}

template <int KIND>
__device__ __forceinline__ void ph_attn_naive(const Ctx& C, int slot) {
    constexpr int DQK = KIND == 2 ? 96 : 64, DH = DQK / 2;
    LAS float* Ks = (LAS float*)C.lds;
    LAS float* Vs = Ks + 32 * DQK;
    LAS float* Bsm = Vs + 32 * 64;
    const bf16 *Qb, *Kb, *Vb, *KRb = nullptr; int qp, kp, vp, kgrp = 1; size_t qhs, khs, vhs; float scale;
    if (KIND == 0) { Qb = WSP(bf16, WS_QKV); Kb = Qb + (size_t)16 * R * 64; Vb = Qb + (size_t)32 * R * 64; qp = kp = vp = 64; qhs = khs = vhs = (size_t)R * 64; scale = 0.125f; }
    else if (KIND == 1) { Qb = WSP(bf16, WS_QKV); Kb = Qb + (size_t)16 * R * 64; Vb = Qb + (size_t)20 * R * 64; qp = kp = vp = 64; qhs = khs = vhs = (size_t)R * 64; kgrp = 4; scale = 0.125f; }
    else { Qb = WSP(bf16, WS_Q); Kb = WSP(bf16, WS_KV); Vb = Kb + 64; KRb = WSP(bf16, WS_KROPE); qp = 96; kp = vp = 128; qhs = (size_t)R * 96; khs = vhs = (size_t)R * 128; scale = 0.10206207261596575f; }
    bf16* Ob = WSP(bf16, WS_O);
    const int half = C.tid & 1, qi = C.tid >> 1;
    for (int u = C.blk; u < 1040; u += C.G) {
        const bool isctx = u >= 1024;
        const int h = isctx ? (u - 1024) : (u & 15), q0 = isctx ? SEQ : (u >> 4) * 256, kh = h / kgrp;
        const int t = q0 + qi;
        float q[DH], o[32];
        { const bf16* qr = Qb + (size_t)t * qp + h * qhs + half * DH;
#pragma unroll
          for (int d = 0; d < DH; d += 8) { const u32x4 w = *(const u32x4*)(qr + d);
              q[d + 0] = bf2f(w.x & 0xffffu); q[d + 1] = bf2f(w.x >> 16); q[d + 2] = bf2f(w.y & 0xffffu); q[d + 3] = bf2f(w.y >> 16);
              q[d + 4] = bf2f(w.z & 0xffffu); q[d + 5] = bf2f(w.z >> 16); q[d + 6] = bf2f(w.w & 0xffffu); q[d + 7] = bf2f(w.w >> 16); } }
#pragma unroll
        for (int d = 0; d < 32; ++d) o[d] = 0.f;
        float m = -INFINITY, l = 0.f;
        if (KIND == 1) { m = C.in[13][h]; l = 1.f; }
        int klo = 0, khi = 0;
        if (!isctx) {
            if (KIND == 0) { const int r0 = q0 >> 6; const int ra = r0 - 4 < 0 ? 0 : r0 - 4, rb = r0 + 7 > 255 ? 255 : r0 + 7; klo = ra * 64; khi = (rb + 1) * 64; }
            else if (KIND == 1) { klo = q0 - 128 < 0 ? 0 : q0 - 128; khi = q0 + 384 > SEQ ? SEQ : q0 + 384; }
            else { klo = 0; khi = SEQ; }
        }
        if (KIND == 0) { __syncthreads(); const float* rp = C.in[10] + ((size_t)slot * 16 + h) * 465; for (int i = C.tid; i < 465; i += 512) Bsm[i] = rp[i]; }
        const int qr_ = t >> 6, qc_ = t & 63;
        int rs = qr_ - 4; rs = rs < 0 ? 0 : (rs > 248 ? 248 : rs);
        int cs0 = qc_ - 8; cs0 = cs0 < 0 ? 0 : (cs0 > 48 ? 48 : cs0);
        for (int seg = 0; seg < 2; ++seg) {
            const int kb = seg == 0 ? klo : SEQ, ke = seg == 0 ? khi : R;
            for (int k0 = kb; k0 < ke; k0 += 32) {
                __syncthreads();
                for (int i = C.tid; i < 32 * DQK; i += 512) { const int j = i / DQK, d = i % DQK; const int row = k0 + j;
                    unsigned b;
                    if (KIND == 2 && d >= 64) b = KRb[(size_t)row * 32 + (d - 64)]; else b = Kb[(size_t)row * kp + kh * khs + d];
                    Ks[i] = bf2f(b); }
                for (int i = C.tid; i < 32 * 64; i += 512) { const int j = i >> 6, d = i & 63; Vs[i] = bf2f(Vb[(size_t)(k0 + j) * vp + kh * vhs + d]); }
                __syncthreads();
#pragma unroll 1
                for (int j = 0; j < 32; ++j) {
                    const int kt = k0 + j; bool valid = true; float bias = 0.f;
                    if (seg == 0) {
                        if (KIND == 0) { const int kr = kt >> 6, kc = kt & 63; valid = kr >= rs && kr < rs + 8 && kc >= cs0 && kc < cs0 + 16;
                            if (valid) bias = Bsm[(kr - qr_ + 7) * 31 + (kc - qc_ + 15)]; }
                        else if (KIND == 1) { const int dd = kt - t; valid = dd <= 128 && dd >= -128; }
                    }
                    float s0 = 0.f, s1 = 0.f;
#pragma unroll
                    for (int d = 0; d < DH; d += 4) { const f32x4 kv = *(const LAS f32x4*)(Ks + j * DQK + half * DH + d); s0 += q[d] * kv.x + q[d + 2] * kv.z; s1 += q[d + 1] * kv.y + q[d + 3] * kv.w; }
                    float sp = s0 + s1; sp += __shfl_xor(sp, 1);
                    if (valid) {
                        const float s = sp * scale + bias;
                        if (s > m) { const float a = __expf(m - s); l *= a;
#pragma unroll
                            for (int d = 0; d < 32; ++d) o[d] *= a;
                            m = s; }
                        const float p = __expf(s - m); l += p;
#pragma unroll
                        for (int d = 0; d < 32; d += 4) { const f32x4 vv = *(const LAS f32x4*)(Vs + j * 64 + half * 32 + d); o[d] += p * vv.x; o[d + 1] += p * vv.y; o[d + 2] += p * vv.z; o[d + 3] += p * vv.w; }
                    }
                }
            }
        }
        { const float il = 1.f / l; bf16* orow = Ob + (size_t)t * D + h * 64 + half * 32;
#pragma unroll
            for (int d = 0; d < 32; d += 8) { u32x4 w; w.x = pk2(o[d] * il, o[d + 1] * il); w.y = pk2(o[d + 2] * il, o[d + 3] * il); w.z = pk2(o[d + 4] * il, o[d + 5] * il); w.w = pk2(o[d + 6] * il, o[d + 7] * il);
                *(u32x4*)(orow + d) = w; } }
    }
    __syncthreads();
}

#ifndef USE_FAST_ATTN
#define USE_FAST_ATTN 1
#endif
__device__ __forceinline__ s16x4 lds_tr16(const LAS unsigned char* p) { return __builtin_bit_cast(s16x4, __builtin_amdgcn_ds_read_tr16_b64_v4i16((LAS s16x4*)p)); }
__device__ __forceinline__ int crow(int r, int hi) { return (r & 3) + 8 * (r >> 2) + 4 * hi; }

#define ATT_BAR() do { __builtin_amdgcn_sched_barrier(0); asm volatile("s_waitcnt lgkmcnt(0)\n\ts_barrier" ::: "memory"); __builtin_amdgcn_sched_barrier(0); } while (0)
template <int KIND, int VARIANT = 0>
__device__ __forceinline__ void ph_attn_fast(const Ctx& C, int slot, bool with_ctxq, int conv_layer = -1) {
    constexpr int DQK = KIND == 2 ? 96 : 64, NS = DQK / 16, CPR = DQK / 8, CPRP = CPR + 1;
    constexpr int KS = CPRP * 16, VS = 128, KBYTES = 64 * KS, VBYTES = 64 * VS, SLOTB = KBYTES + VBYTES;
    constexpr int NKC = 64 * CPRP, NINST = (NKC + 64 * 8) / 64, NDMA = (NINST + 7) / 8, NRING = 4, PD = 3;
    static_assert(NKC % 64 == 0 && SLOTB % 1024 == 0 && NRING * SLOTB + 2048 <= 131072, "attention ring geometry");
    LAS unsigned char* lds = C.lds; const unsigned lds_u32 = (unsigned)(size_t)C.lds;
    LAS float* Bsm = (LAS float*)(lds + NRING * SLOTB);
    const bf16 *Qb, *Kb, *Vb, *KRb = nullptr; int qp, kp, vp, kgrp = 1; size_t qhs, khs, vhs; float scale;
    if (KIND == 0) { Qb = WSP(bf16, WS_QKV); Kb = Qb + (size_t)16 * R * 64; Vb = Qb + (size_t)32 * R * 64; qp = kp = vp = 64; qhs = khs = vhs = (size_t)R * 64; scale = 0.125f; }
    else if (KIND == 1) { Qb = WSP(bf16, WS_QKV); Kb = Qb + (size_t)16 * R * 64; Vb = Qb + (size_t)20 * R * 64; qp = kp = vp = 64; qhs = khs = vhs = (size_t)R * 64; kgrp = 4; scale = 0.125f; }
    else { Qb = WSP(bf16, WS_Q); Kb = WSP(bf16, WS_KV); Vb = Kb + 64; KRb = WSP(bf16, WS_KROPE); qp = 96; kp = vp = 128; qhs = (size_t)R * 96; khs = vhs = (size_t)R * 128; scale = 0.10206207261596575f; }
    bf16* Ob = VARIANT ? WSP(bf16, WS_ACT) : WSP(bf16, WS_O);
    const float c2 = scale * 1.4426950408889634f;
    const int w = C.wave, lane = C.lane, ql = lane & 31, hi = lane >> 5;
    const int vq_ = (lane & 15) >> 2, vsw_ = 4 * ((vq_ >> 1) & 1), vch_ = 2 * ((lane >> 4) & 1) + ((lane & 3) >> 1);
    const int vlane0 = (vq_ + 4 * hi) * VS + ((0 + vch_) ^ vsw_) * 16 + 8 * (lane & 1), vlane1 = (vq_ + 4 * hi) * VS + ((4 + vch_) ^ vsw_) * 16 + 8 * (lane & 1);
    const int nunits = with_ctxq ? 1040 : 1024;
    ConvState cst; cst.l0 = conv_layer; cst.total = conv_layer < 0 ? 0 : (KIND == 2 ? 2 : 1) * MOE_HALF_ITEMS; cst.cur = C.blk * 8 + C.wave; cst.loaded = false;
    LAS float* cscr = (LAS float*)(C.lds + NRING * SLOTB + 2048 + C.wave * 4096);
    static_assert(NRING * SLOTB + 2048 + 8 * 4096 <= 131072, "conversion scratch");
    static_assert(KIND == 2 || NRING * SLOTB + 2048 == CONV_PIPE_BASE, "pipelined conversion scratch");
    ConvPipe cpipe; cpipe.l0 = conv_layer; cpipe.total = (KIND != 2 && conv_layer >= 0) ? MOE_HALF_ITEMS : 0; cpipe.first = C.blk * 8 + C.wave; cpipe.n = 0;
    const bool convon = cpipe.total > 0; constexpr int CFL = (VARIANT >> 7) & 3;
    for (int u = C.blk; u < nunits; u += C.G) {
        const bool isctx = u >= 1024;
        const int h = isctx ? (u - 1024) : (u & 15), q0 = isctx ? SEQ : (u >> 4) * 256, kh = h / kgrp;
        int lat0 = 0, nlat = 0;
        if (!isctx) {
            if (KIND == 0) { const int r0 = q0 >> 6; int ta = r0 - 4; ta = ta < 0 ? 0 : (ta > 248 ? 248 : ta); int tb = r0 - 1; tb = (tb < 0 ? 0 : (tb > 248 ? 248 : tb)) + 7; lat0 = ta; nlat = tb - ta + 1; }
            else if (KIND == 1) { const int a = q0 - 128 < 0 ? 0 : q0 - 128, b = q0 + 384 > SEQ ? SEQ : q0 + 384; lat0 = a >> 6; nlat = (b - a) >> 6; }
            else { lat0 = 0; nlat = SEQ / 64; }
        }
        const int ntiles = nlat + 4;
        const int t = (KIND == 0 && !isctx) ? q0 + 128 * (w >> 2) + 64 * (ql >> 4) + 16 * (w & 3) + (ql & 15) : q0 + 32 * w + ql;
        bf16x8 qf[NS];
        { const bf16* qr = Qb + (size_t)t * qp + h * qhs + 8 * hi;
#pragma unroll
          for (int sidx = 0; sidx < NS; ++sidx) qf[sidx] = *(const bf16x8*)(qr + 16 * sidx); }
        const char* gsrc[NDMA]; int gpitch[NDMA], ldst[NDMA];
        int lane_u = lane; asm volatile("" : "+v"(lane_u));
#pragma unroll
        for (int jj = 0; jj < NDMA; ++jj) {
            int j = w + 8 * jj; if (j >= NINST) j -= 8;
            const int cidx = 64 * j + lane_u; ldst[jj] = j * 1024;
            if (cidx < NKC) { const int row = cidx / CPRP; int c = cidx % CPRP; if (c >= CPR) c = 0;
                if (KIND == 2 && c >= 8) { gsrc[jj] = (const char*)(KRb + (size_t)row * 32 + 8 * (c - 8)); gpitch[jj] = 64; }
                else { gsrc[jj] = (const char*)(Kb + kh * khs + (size_t)row * kp + 8 * c); gpitch[jj] = kp * 2; } }
            else { const int v = cidx - NKC, row = v >> 3; const int c = (v & 7) ^ (4 * ((row >> 1) & 1));
                gsrc[jj] = (const char*)(Vb + kh * vhs + (size_t)row * vp + 8 * c); gpitch[jj] = vp * 2; }
        }
#define ATT_KEY0(i) ((i) < nlat ? (lat0 + (i)) * 64 : SEQ + ((i) - nlat) * 64)
#define ATT_DMA(i, sl) do { const int ti_ = (i) < ntiles ? (i) : ntiles - 1; const size_t key0_ = (size_t)ATT_KEY0(ti_); \
        _Pragma("unroll") for (int jj = 0; jj < NDMA; ++jj) \
            __builtin_amdgcn_global_load_lds((const unsigned*)(gsrc[jj] + key0_ * gpitch[jj]), (LAS unsigned*)(lds + (sl) * SLOTB + ldst[jj]), 16, 0, 0); } while (0)
#define ATT_WAIT_DMA() do { if (NDMA == 4) asm volatile("s_waitcnt vmcnt(8)" ::: "memory"); else asm volatile("s_waitcnt vmcnt(6)" ::: "memory"); } while (0)
#define ATT_WAIT_DMA_IT() do { if (KIND == 2) { ATT_WAIT_DMA(); } else if (convon) { if (CFL == 0) asm volatile("s_waitcnt vmcnt(12)" ::: "memory"); else if (CFL == 1) asm volatile("s_waitcnt vmcnt(10)" ::: "memory"); else if (CFL == 2) asm volatile("s_waitcnt vmcnt(8)" ::: "memory"); else asm volatile("s_waitcnt vmcnt(6)" ::: "memory"); } \
        else asm volatile("s_waitcnt vmcnt(3)" ::: "memory"); } while (0)
        __syncthreads();
        if (KIND == 0) { const float* rp = C.in[10] + ((size_t)slot * 16 + h) * 465; for (int i = C.tid; i < 465; i += 512) Bsm[i] = rp[i] * 1.4426950408889634f; }
        float m = -INFINITY, l = 0.f;
        if (KIND == 1) { m = C.in[13][h] * 1.4426950408889634f; l = hi ? 0.f : 1.f; }
        ATT_DMA(0, 0); ATT_DMA(1, 1); ATT_DMA(2, 2);
        f32x16 ot[2];
#pragma unroll
        for (int r = 0; r < 16; ++r) { ot[0][r] = 0.f; ot[1][r] = 0.f; }
        const int qr_ = t >> 6, qc_ = t & 63;
        int cs0 = qc_ - 8; cs0 = cs0 < 0 ? 0 : (cs0 > 48 ? 48 : cs0);
        const int wrow = (q0 >> 6) + 2 * (w >> 2);
        int wrs = wrow - 4; wrs = wrs < 0 ? 0 : (wrs > 248 ? 248 : wrs);
        int wre = wrow + 1 - 4; wre = (wre < 0 ? 0 : (wre > 248 ? 248 : wre)) + 8;
        int rs = qr_ - 4; rs = rs < 0 ? 0 : (rs > 248 ? 248 : rs);
        const int kc0 = (w & 3) == 0 ? 0 : ((w & 3) == 1 ? 8 : ((w & 3) == 2 ? 24 : 32));
        const int wq0 = q0 + 32 * w;
        if constexpr (KIND == 2) {
            { float qs = 0.f;
#pragma unroll
              for (int sidx = 0; sidx < NS; ++sidx)
#pragma unroll
                  for (int j = 0; j < 8; ++j) { const float qv = bf2f((unsigned)(unsigned short)qf[sidx][j]); qs += qv * qv; }
              const auto sw = __builtin_amdgcn_permlane32_swap(__float_as_uint(qs), __float_as_uint(qs), false, false);
              qs = __uint_as_float(sw[0]) + __uint_as_float(sw[1]);
              const float k2 = __uint_as_float(__hip_atomic_load((unsigned*)(C.ws + WS_CTL) + CW_KMAX + h, __ATOMIC_RELAXED, __HIP_MEMORY_SCOPE_AGENT));
              m = c2 * sqrtf(qs * k2) * 1.001f + 0.01f; }
            if (NDMA == 4) asm volatile("s_waitcnt vmcnt(4)" ::: "memory"); else asm volatile("s_waitcnt vmcnt(3)" ::: "memory");
            ATT_BAR();
            f32x16 pa0, pa1, pb0, pb1;
#define MLA_QK(D0, D1, sl) do { const LAS unsigned char* kb_ = lds + (sl) * SLOTB; \
            _Pragma("unroll") for (int r_ = 0; r_ < 16; ++r_) { D0[r_] = 0.f; D1[r_] = 0.f; } \
            _Pragma("unroll") for (int sidx = 0; sidx < NS; ++sidx) { \
                const bf16x8 a0_ = *(const LAS bf16x8*)(kb_ + ql * KS + 32 * sidx + 16 * hi); \
                const bf16x8 a1_ = *(const LAS bf16x8*)(kb_ + (32 + ql) * KS + 32 * sidx + 16 * hi); \
                { D0 = __builtin_amdgcn_mfma_f32_32x32x16_bf16(a0_, qf[sidx], D0, 0, 0, 0); \
                       D1 = __builtin_amdgcn_mfma_f32_32x32x16_bf16(a1_, qf[sidx], D1, 0, 0, 0); } } } while (0)
#define VB(x) (((VARIANT) >> (x)) & 1)
#define MLA_KHALF(D0, D1, sl, h0) do { const LAS unsigned char* kq_ = lds + (sl) * SLOTB; \
            _Pragma("unroll") for (int sidx = 0; sidx < NS / 2; ++sidx) { \
                D0[sidx] = *(const LAS bf16x8*)(kq_ + ql * KS + 32 * ((h0) + sidx) + 16 * hi); D1[sidx] = *(const LAS bf16x8*)(kq_ + (32 + ql) * KS + 32 * ((h0) + sidx) + 16 * hi); } } while (0)
#define MLA_ITER(CV, P0, P1, S0, S1, it) do { \
            if (CV && ((it) & 7) == 0) conv_step<false>(C, cst, cscr);            \
            if (!VB(3)) ATT_DMA((it) + 3, ((it) + 3) & 3);                        \
            bf16x8 kb0_[NS / 2], kb1_[NS / 2]; s16x4 vlo_[2][4], vhi_[2][4]; bf16x8 pf_[4]; \
              \
            float rs0_ = 0.f, rs1_ = 0.f; \
            _Pragma("unroll") for (int r_ = 0; r_ < 16; ++r_) { S0[r_] = 0.f; S1[r_] = 0.f; } \
            asm volatile("s_waitcnt lgkmcnt(0)" ::: "memory"); __builtin_amdgcn_sched_barrier(0); \
            _Pragma("unroll") for (int g_ = 0; g_ < 20; ++g_) { \
                if (g_ == 6) { asm volatile("s_waitcnt lgkmcnt(0)" ::: "memory"); __builtin_amdgcn_sched_barrier(0); } \
                if (g_ == 12) { if (!VB(4)) { asm volatile("s_waitcnt vmcnt(3)" ::: "memory"); ATT_BAR(); }         \
                                else { asm volatile("s_waitcnt lgkmcnt(0)" ::: "memory"); __builtin_amdgcn_sched_barrier(0); } } \
                if (g_ == 2) MLA_KHALF(kb0_, kb1_, ((it) + 1) & 3, NS / 2); \
                if (g_ == 16) MLA_KHALF(ka0, ka1, ((it) + 2) & 3, 0); \
                if (g_ < 6) { if (g_ & 1) S1 = __builtin_amdgcn_mfma_f32_32x32x16_bf16(ka1[g_ >> 1], qf[g_ >> 1], S1, 0, 0, 0); else S0 = __builtin_amdgcn_mfma_f32_32x32x16_bf16(ka0[g_ >> 1], qf[g_ >> 1], S0, 0, 0, 0); } \
                else if (g_ < 12) { if (g_ & 1) S1 = __builtin_amdgcn_mfma_f32_32x32x16_bf16(kb1_[(g_ >> 1) - NS / 2], qf[g_ >> 1], S1, 0, 0, 0); else S0 = __builtin_amdgcn_mfma_f32_32x32x16_bf16(kb0_[(g_ >> 1) - NS / 2], qf[g_ >> 1], S0, 0, 0, 0); } \
                else { const int ks_ = (g_ - 12) >> 1, c_ = (g_ - 12) & 1; \
                    const bf16x8 av_ = (bf16x8){vlo_[c_][ks_][0], vlo_[c_][ks_][1], vlo_[c_][ks_][2], vlo_[c_][ks_][3], vhi_[c_][ks_][0], vhi_[c_][ks_][1], vhi_[c_][ks_][2], vhi_[c_][ks_][3]}; \
                    ot[c_] = __builtin_amdgcn_mfma_f32_32x32x16_bf16(av_, pf_[ks_], ot[c_], 0, 0, 0); } \
                if (g_ < 16) { \
                    _Pragma("unroll") for (int k_ = 2 * g_; k_ < 2 * g_ + 2; ++k_) { \
                        if (k_ < 16) { P0[k_] = __builtin_amdgcn_exp2f(__builtin_fmaf(P0[k_], c2, -m)); if (k_ & 1) rs1_ += P0[k_]; else rs0_ += P0[k_]; } \
                        else { P1[k_ - 16] = __builtin_amdgcn_exp2f(__builtin_fmaf(P1[k_ - 16], c2, -m)); if (k_ & 1) rs1_ += P1[k_ - 16]; else rs0_ += P1[k_ - 16]; } } \
                    if ((g_ & 3) == 3) { const int f_ = g_ >> 2; u32x4 pw_; \
                        if (f_ < 2) { pw_.x = cvt_pk_bf16(P0[8 * f_ + 0], P0[8 * f_ + 1]); pw_.y = cvt_pk_bf16(P0[8 * f_ + 2], P0[8 * f_ + 3]); pw_.z = cvt_pk_bf16(P0[8 * f_ + 4], P0[8 * f_ + 5]); pw_.w = cvt_pk_bf16(P0[8 * f_ + 6], P0[8 * f_ + 7]); } \
                        else { pw_.x = cvt_pk_bf16(P1[8 * (f_ - 2) + 0], P1[8 * (f_ - 2) + 1]); pw_.y = cvt_pk_bf16(P1[8 * (f_ - 2) + 2], P1[8 * (f_ - 2) + 3]); pw_.z = cvt_pk_bf16(P1[8 * (f_ - 2) + 4], P1[8 * (f_ - 2) + 5]); pw_.w = cvt_pk_bf16(P1[8 * (f_ - 2) + 6], P1[8 * (f_ - 2) + 7]); } \
                        pf_[f_] = __builtin_bit_cast(bf16x8, pw_); } } \
                if (g_ == 7) { const unsigned vb_ = lds_u32 + (unsigned)(((it) & 3) * SLOTB + KBYTES); \
                  _Pragma("unroll") for (int c = 0; c < 2; ++c) { const unsigned va_ = vb_ + (unsigned)(c ? vlane1 : vlane0); \
                    _Pragma("unroll") for (int ks = 0; ks < 4; ++ks) { \
                        asm volatile("ds_read_b64_tr_b16 %0, %1 offset:%c2" : "=&v"(vlo_[c][ks]) : "v"(va_), "i"((32 * (ks >> 1) + 16 * (ks & 1)) * VS) : "memory"); \
                        asm volatile("ds_read_b64_tr_b16 %0, %1 offset:%c2" : "=&v"(vhi_[c][ks]) : "v"(va_), "i"((32 * (ks >> 1) + 16 * (ks & 1) + 8) * VS) : "memory"); } } } \
                __builtin_amdgcn_sched_barrier(0); } \
            l += rs0_ + rs1_; } while (0)
            MLA_QK(pa0, pa1, 0);
            bf16x8 ka0[NS / 2], ka1[NS / 2];
            MLA_KHALF(ka0, ka1, 1, 0);
            for (int i = 0; i < ntiles; i += 2) {
                MLA_ITER(1, pa0, pa1, pb0, pb1, i);
                MLA_ITER(0, pb0, pb1, pa0, pa1, i + 1);
            }
#undef MLA_KHALF
#undef MLA_QK
#undef MLA_ITER
#undef VB
        } else {
        ATT_WAIT_DMA();
        ATT_BAR();
        int rs_cur = 0, rs_nxt = 3;
        for (int i = 0; i < ntiles; ++i) {
            if (convon) conv_pipe_step<CFL>(C, cpipe, lds);
            ATT_DMA(i + PD, rs_nxt);
            const bool lat = i < nlat; const int key0 = ATT_KEY0(i);
            bool need = true;
            if (lat) { if (KIND == 0) { const int kr = lat0 + i; need = kr >= wrs && kr < wre; }
                       else if (KIND == 1) need = (key0 + 63 >= wq0 - 128) && (key0 <= wq0 + 31 + 128); }
            if (KIND == 0 && lat) {
              if (need) {
                const int kr = lat0 + i;
                const LAS unsigned char* kb = lds + rs_cur * SLOTB + kc0 * KS;
                f32x16 p0;
#pragma unroll
                for (int r = 0; r < 16; ++r) p0[r] = 0.f;
#pragma unroll
                for (int sidx = 0; sidx < NS; ++sidx) {
                    const bf16x8 a0 = *(const LAS bf16x8*)(kb + ql * KS + 32 * sidx + 16 * hi);
                    p0 = __builtin_amdgcn_mfma_f32_32x32x16_bf16(a0, qf[sidx], p0, 0, 0, 0);
                }
                const bool rowok = kr >= rs && kr < rs + 8;
                float mx = -INFINITY;
#pragma unroll
                for (int r = 0; r < 16; ++r) { const int kc = kc0 + crow(r, hi); const bool v0 = rowok && (unsigned)(kc - cs0) < 16u;
                    const int bi = (kr - qr_ + 7) * 31 + (kc - qc_ + 15);
                    const float s0 = v0 ? p0[r] * c2 + Bsm[v0 ? bi : 0] : -INFINITY; p0[r] = s0; mx = fmaxf(mx, s0); }
                { const auto sw = __builtin_amdgcn_permlane32_swap(__float_as_uint(mx), __float_as_uint(mx), false, false);
                  mx = fmaxf(__uint_as_float(sw[0]), __uint_as_float(sw[1])); }
                const float mn = fmaxf(m, mx), ms = mn == -INFINITY ? 0.f : mn;
                const float alpha = __builtin_amdgcn_exp2f(m - ms);
                if (__builtin_amdgcn_ballot_w64(alpha != 1.f) != 0ull) {
#pragma unroll
                    for (int r = 0; r < 16; ++r) { ot[0][r] *= alpha; ot[1][r] *= alpha; }
                }
                s16x4 vlo[2][2], vhi[2][2];
                { const unsigned vb0 = lds_u32 + (unsigned)(rs_cur * SLOTB + KBYTES + kc0 * VS);
#pragma unroll
                  for (int c = 0; c < 2; ++c) { const unsigned va = vb0 + (unsigned)(c ? vlane1 : vlane0);
#pragma unroll
                    for (int ks = 0; ks < 2; ++ks) {
                        asm volatile("ds_read_b64_tr_b16 %0, %1 offset:%c2" : "=&v"(vlo[c][ks]) : "v"(va), "i"((16 * ks) * VS) : "memory");
                        asm volatile("ds_read_b64_tr_b16 %0, %1 offset:%c2" : "=&v"(vhi[c][ks]) : "v"(va), "i"((16 * ks + 8) * VS) : "memory"); } } }
                __builtin_amdgcn_sched_barrier(0);
                float rs0 = 0.f, rs1 = 0.f;
#pragma unroll
                for (int ks = 0; ks < 2; ++ks) {
#pragma unroll
                    for (int j = 0; j < 8; ++j) { const int r = 8 * ks + j; p0[r] = __builtin_amdgcn_exp2f(p0[r] - ms); if (j & 1) rs1 += p0[r]; else rs0 += p0[r]; }
                    u32x4 pw; const int k8 = 8 * ks;
                    pw.x = cvt_pk_bf16(p0[k8 + 0], p0[k8 + 1]); pw.y = cvt_pk_bf16(p0[k8 + 2], p0[k8 + 3]); pw.z = cvt_pk_bf16(p0[k8 + 4], p0[k8 + 5]); pw.w = cvt_pk_bf16(p0[k8 + 6], p0[k8 + 7]);
                    const bf16x8 pfk = __builtin_bit_cast(bf16x8, pw);
                    if (ks == 0) { asm volatile("s_waitcnt lgkmcnt(0)" ::: "memory"); }
                    __builtin_amdgcn_sched_barrier(0);
                    const bf16x8 av0 = (bf16x8){vlo[0][ks][0], vlo[0][ks][1], vlo[0][ks][2], vlo[0][ks][3], vhi[0][ks][0], vhi[0][ks][1], vhi[0][ks][2], vhi[0][ks][3]};
                    const bf16x8 av1 = (bf16x8){vlo[1][ks][0], vlo[1][ks][1], vlo[1][ks][2], vlo[1][ks][3], vhi[1][ks][0], vhi[1][ks][1], vhi[1][ks][2], vhi[1][ks][3]};
                    ot[0] = __builtin_amdgcn_mfma_f32_32x32x16_bf16(av0, pfk, ot[0], 0, 0, 0);
                    ot[1] = __builtin_amdgcn_mfma_f32_32x32x16_bf16(av1, pfk, ot[1], 0, 0, 0);
                    __builtin_amdgcn_sched_barrier(0);
                }
                l = l * alpha + (rs0 + rs1); m = mn;
              }
            } else if (need) {
                const LAS unsigned char* kb = lds + rs_cur * SLOTB; const LAS unsigned char* vb = kb + KBYTES;
                f32x16 p0, p1;
#pragma unroll
                for (int r = 0; r < 16; ++r) { p0[r] = 0.f; p1[r] = 0.f; }
#pragma unroll
                for (int sidx = 0; sidx < NS; ++sidx) {
                    const bf16x8 a0 = *(const LAS bf16x8*)(kb + ql * KS + 32 * sidx + 16 * hi);
                    const bf16x8 a1 = *(const LAS bf16x8*)(kb + (32 + ql) * KS + 32 * sidx + 16 * hi);
                    p0 = __builtin_amdgcn_mfma_f32_32x32x16_bf16(a0, qf[sidx], p0, 0, 0, 0);
                    p1 = __builtin_amdgcn_mfma_f32_32x32x16_bf16(a1, qf[sidx], p1, 0, 0, 0);
                }
                float mx = -INFINITY;
                if (KIND == 0) {
#pragma unroll
                    for (int r = 0; r < 16; ++r) {
                        float s0 = p0[r] * c2, s1 = p1[r] * c2;
                        if (lat) { const int kr = lat0 + i; const int kc = crow(r, hi);
                            const bool v0 = (unsigned)(kc - cs0) < 16u, v1 = (unsigned)(kc + 32 - cs0) < 16u;
                            const int bi = (kr - qr_ + 7) * 31 + (kc - qc_ + 15);
                            s0 = v0 ? s0 + Bsm[v0 ? bi : 0] : -INFINITY; s1 = v1 ? s1 + Bsm[v1 ? bi + 32 : 0] : -INFINITY; }
                        p0[r] = s0; p1[r] = s1; mx = fmaxf(fmaxf(mx, s0), s1);
                    }
                } else {
                    if (KIND == 1 && lat) {
#pragma unroll
                        for (int r = 0; r < 16; ++r) { const int dd = key0 + crow(r, hi) - t;
                            p0[r] = (unsigned)(dd + 128) <= 256u ? p0[r] : -INFINITY; p1[r] = (unsigned)(dd + 32 + 128) <= 256u ? p1[r] : -INFINITY; }
                    }
#pragma unroll
                    for (int r = 0; r < 16; ++r) mx = fmaxf(fmaxf(mx, p0[r]), p1[r]);
                    mx *= c2;
                }
                { const auto sw = __builtin_amdgcn_permlane32_swap(__float_as_uint(mx), __float_as_uint(mx), false, false);
                  mx = fmaxf(__uint_as_float(sw[0]), __uint_as_float(sw[1])); }
                const float mn = fmaxf(m, mx), ms = mn == -INFINITY ? 0.f : mn;
                const float alpha = __builtin_amdgcn_exp2f(m - ms);
                if (__builtin_amdgcn_ballot_w64(alpha != 1.f) != 0ull) {
#pragma unroll
                    for (int r = 0; r < 16; ++r) { ot[0][r] *= alpha; ot[1][r] *= alpha; }
                }
                s16x4 vlo[2][4], vhi[2][4];
                { const unsigned vb0 = lds_u32 + (unsigned)(rs_cur * SLOTB + KBYTES);
#pragma unroll
                  for (int c = 0; c < 2; ++c) { const unsigned va = vb0 + (unsigned)(c ? vlane1 : vlane0);
#pragma unroll
                    for (int ks = 0; ks < 4; ++ks) {
                        asm volatile("ds_read_b64_tr_b16 %0, %1 offset:%c2" : "=&v"(vlo[c][ks]) : "v"(va), "i"((32 * (ks >> 1) + 16 * (ks & 1)) * VS) : "memory");
                        asm volatile("ds_read_b64_tr_b16 %0, %1 offset:%c2" : "=&v"(vhi[c][ks]) : "v"(va), "i"((32 * (ks >> 1) + 16 * (ks & 1) + 8) * VS) : "memory"); } } }
                __builtin_amdgcn_sched_barrier(0);
                float rs0 = 0.f, rs1 = 0.f;
#pragma unroll
                for (int ks = 0; ks < 4; ++ks) {
#pragma unroll
                    for (int j = 0; j < 8; ++j) { const int r = 8 * (ks & 1) + j;
                        if (ks < 2) { p0[r] = KIND == 0 ? __builtin_amdgcn_exp2f(p0[r] - ms) : __builtin_amdgcn_exp2f(__builtin_fmaf(p0[r], c2, -ms)); if (j & 1) rs1 += p0[r]; else rs0 += p0[r]; }
                        else { p1[r] = KIND == 0 ? __builtin_amdgcn_exp2f(p1[r] - ms) : __builtin_amdgcn_exp2f(__builtin_fmaf(p1[r], c2, -ms)); if (j & 1) rs1 += p1[r]; else rs0 += p1[r]; } }
                    u32x4 pw; const int k8 = 8 * (ks & 1);
                    if (ks < 2) { pw.x = cvt_pk_bf16(p0[k8 + 0], p0[k8 + 1]); pw.y = cvt_pk_bf16(p0[k8 + 2], p0[k8 + 3]); pw.z = cvt_pk_bf16(p0[k8 + 4], p0[k8 + 5]); pw.w = cvt_pk_bf16(p0[k8 + 6], p0[k8 + 7]); }
                    else { pw.x = cvt_pk_bf16(p1[k8 + 0], p1[k8 + 1]); pw.y = cvt_pk_bf16(p1[k8 + 2], p1[k8 + 3]); pw.z = cvt_pk_bf16(p1[k8 + 4], p1[k8 + 5]); pw.w = cvt_pk_bf16(p1[k8 + 6], p1[k8 + 7]); }
                    const bf16x8 pfk = __builtin_bit_cast(bf16x8, pw);
                    if (ks == 0) { asm volatile("s_waitcnt lgkmcnt(0)" ::: "memory"); }
                    __builtin_amdgcn_sched_barrier(0);
                    const bf16x8 av0 = (bf16x8){vlo[0][ks][0], vlo[0][ks][1], vlo[0][ks][2], vlo[0][ks][3], vhi[0][ks][0], vhi[0][ks][1], vhi[0][ks][2], vhi[0][ks][3]};
                    const bf16x8 av1 = (bf16x8){vlo[1][ks][0], vlo[1][ks][1], vlo[1][ks][2], vlo[1][ks][3], vhi[1][ks][0], vhi[1][ks][1], vhi[1][ks][2], vhi[1][ks][3]};
                    ot[0] = __builtin_amdgcn_mfma_f32_32x32x16_bf16(av0, pfk, ot[0], 0, 0, 0);
                    ot[1] = __builtin_amdgcn_mfma_f32_32x32x16_bf16(av1, pfk, ot[1], 0, 0, 0);
                    __builtin_amdgcn_sched_barrier(0);
                }
                l = l * alpha + (rs0 + rs1); m = mn;
            }
            ATT_WAIT_DMA_IT();
            ATT_BAR();
            rs_cur = (rs_cur + 1) & 3; rs_nxt = (rs_nxt + 1) & 3;
        }
        }
        asm volatile("s_waitcnt vmcnt(0)" ::: "memory");
#undef ATT_KEY0
#undef ATT_DMA
#undef ATT_WAIT_DMA
#undef ATT_WAIT_DMA_IT
        { const auto sw = __builtin_amdgcn_permlane32_swap(__float_as_uint(l), __float_as_uint(l), false, false);
          const float il = 1.f / (__uint_as_float(sw[0]) + __uint_as_float(sw[1])); bf16* orow = Ob + (size_t)t * D + h * 64 + 4 * hi;
#pragma unroll
          for (int c = 0; c < 2; ++c)
#pragma unroll
            for (int g = 0; g < 4; ++g) { u32x2 o2; o2.x = cvt_pk_bf16(ot[c][4 * g] * il, ot[c][4 * g + 1] * il); o2.y = cvt_pk_bf16(ot[c][4 * g + 2] * il, ot[c][4 * g + 3] * il);
                *(u32x2*)(orow + 32 * c + 8 * g) = o2; } }
    }
    if (KIND == 2) { while (cst.loaded || cst.cur < cst.total) conv_step<true>(C, cst, cscr); }
    else if (convon && !VARIANT) conv_pipe_drain(C, cpipe, lds);
    __syncthreads();
}
template <int KIND>
__device__ __forceinline__ void ph_attn(const Ctx& C, int slot, bool with_ctxq, int conv_layer = -1) {
#if USE_FAST_ATTN
    ph_attn_fast<KIND>(C, slot, with_ctxq, conv_layer);
#else
    ph_attn_naive<KIND>(C, slot);
#endif
}

#define PH_BEGIN if (lo <= ph && ph < hi) {
#define PH_END   if (ph + 1 < hi) xcd_barrier(bar); if (DIAG && C.blk == 0 && C.tid == 0) ((unsigned long long*)(C.ws + WS_CTL + 512 * 1024))[ph + 1] = __builtin_amdgcn_s_memrealtime(); } ++ph;
#ifndef DIAG
#define DIAG 0
#define DIAG_PH1 25
#define DIAG_PH2 25
#endif
#ifndef NORM2_VARIANT_PROBE
#define NORM2_VARIANT_PROBE 0
#endif
#ifndef SWA_VARIANT_PROBE
#define SWA_VARIANT_PROBE 0
#endif
#ifndef ATTN_VARIANT_PROBE
#define ATTN_VARIANT_PROBE 0
#endif
#ifndef PROBE_MASK
#define PROBE_MASK 0
#endif
#define PHG(g, ...) PH_BEGIN __VA_ARGS__ PH_END if constexpr (((PROBE_MASK >> (g)) & 1) != 0) { PH_BEGIN __VA_ARGS__ PH_END }
template <int L>
__device__ __forceinline__ void layer_phases(const Ctx& C, const XcdBarrier& bar, int lo, int hi, int& ph) {
    constexpr int l = L, kind = L % 3, slot = L / 3; constexpr bool need_ctx = L < 3; constexpr int RL = need_ctx ? R : SEQ;
    PH_BEGIN ph_rowA<0>(C, l); PH_END
    if constexpr (kind == 0) {
        PHG(1, gemm_tok(C, WSP(bf16, WS_H), WSP(bf16, WS_W_NAQKV) + (size_t)slot * 3072 * 1024, 3072, 1024, true, EpiStoreHeads{WSP(bf16, WS_QKV), 64, (size_t)R * 64});)
        PHG(2, ph_attn<0>(C, slot, need_ctx, l == 0 ? 0 : -1);)
    } else if constexpr (kind == 1) {
        PHG(1, gemm_tok(C, WSP(bf16, WS_H), WSP(bf16, WS_W_SWAQKV), 1536, 1024, true, EpiStoreHeads{WSP(bf16, WS_QKV), 64, (size_t)R * 64});)
        PH_BEGIN ph_rope(C, WSP(bf16, WS_QKV), 64, 20, 0, 16); PH_END
        PHG(3, ph_attn<1>(C, slot, need_ctx, l);)
#if SWA_VARIANT_PROBE
        PH_BEGIN ph_attn_fast<1, SWA_VARIANT_PROBE>(C, slot, need_ctx, (SWA_VARIANT_PROBE & 64) ? l : -1); PH_END
#endif
    } else {
        PHG(1, gemm_tok(C, WSP(bf16, WS_H), WSP(bf16, WS_W_MLAD), 1024, 1024, true, EpiStoreF32{WSP(float, WS_CQ), 1024});)
        PHG(11, ph_mlanorm(C);)
        PHG(1, gemm_tok(C, WSP(bf16, WS_CQN), WSP(bf16, WS_W_MLAUQ), 1536, 512, true, EpiStoreHeads{WSP(bf16, WS_Q), 96, (size_t)R * 96});
                 gemm_tok(C, WSP(bf16, WS_CKVN), WSP(bf16, WS_W_MLAUKV), 2048, 256, true, EpiStoreHeads{WSP(bf16, WS_KV), 128, (size_t)R * 128});)
        PH_BEGIN ph_rope(C, WSP(bf16, WS_Q), 96, 16, 64, 8); ph_kmax(C); PH_END
        PHG(4, ph_attn<2>(C, slot, need_ctx, 2);)
#if ATTN_VARIANT_PROBE
        PH_BEGIN ph_attn_fast<2, ATTN_VARIANT_PROBE>(C, slot, need_ctx, (ATTN_VARIANT_PROBE & 64) ? 2 : -1); PH_END
#endif
    }
    const bf16* wo = kind == 0 ? WSP(bf16, WS_W_NAO) + (size_t)slot * 1024 * 1024 : (kind == 1 ? WSP(bf16, WS_W_SWAO) : WSP(bf16, WS_W_MLAO));
    PH_BEGIN gemm_tok(C, WSP(bf16, WS_O), wo, 1024, 1024, need_ctx, EpiResid{WSP(float, WS_X), modp(C, l, 0, 2), modp(C, l, 1, 2)}); PH_END
    PHG(5, ph_norm2(C, l, RL);)
#if NORM2_VARIANT_PROBE
    PH_BEGIN ph_norm2<NORM2_VARIANT_PROBE>(C, l, RL); PH_END
#endif
    PHG(6, ph_topk(C, need_ctx);)
    PHG(8, gemm_moe(C, WSP(bf16, WS_H), WSP(bf16, WS_W_GU) + (size_t)l * 16 * 4096 * 1024, 4096, 1024, (size_t)4096 * 1024, need_ctx, EpiSwiglu{WSP(bf16, WS_ACT)}, WSP(int, WS_ROWL));)
    PHG(9, gemm_moe(C, WSP(bf16, WS_ACT), WSP(bf16, WS_W_DN) + (size_t)l * 16 * 1024 * 2048, 1024, 2048, (size_t)1024 * 2048, need_ctx, EpiMoeOut{WSP(bf16, WS_YB), WSP(float, WS_GATEL)});)
}
__global__ void __launch_bounds__(512, 2) fwd_kernel(Args args) {
    extern __shared__ __attribute__((aligned(16))) unsigned char lds_raw[];
    Ctx C;
#pragma unroll
    for (int i = 0; i < 26; ++i) C.in[i] = args.in[i];
    C.out = args.out; C.ws = args.ws; C.lds = (LAS unsigned char*)lds_raw;
    C.tid = threadIdx.x; C.lane = C.tid & 63; C.wave = __builtin_amdgcn_readfirstlane(C.tid >> 6); C.blk = blockIdx.x; C.G = gridDim.x;
    volatile LAS unsigned* MISC = (volatile LAS unsigned*)(C.lds + MISC_OFF);
    if (C.tid < 32) MISC[C.tid] = 0u;
    __syncthreads();
    const int lo = args.ph_lo, hi = args.ph_hi;
    XcdBarrier bar; bar.bar = (unsigned*)(C.ws + WS_CTL) + CW_BAR; bar.x = 0; bar.st = nullptr;
    if (hi - lo > 1) bar = xcd_barrier_post((unsigned*)(C.ws + WS_CTL) + CW_BAR, MISC + 8);
    int ph = 0;
    PHG(0, ph_prologue(C);)
    layer_phases<0>(C, bar, lo, hi, ph);
    layer_phases<1>(C, bar, lo, hi, ph);
    layer_phases<2>(C, bar, lo, hi, ph);
    layer_phases<3>(C, bar, lo, hi, ph);
    PH_BEGIN ph_rowA<1>(C, 4); PH_END
#if DIAG
    {
        __builtin_amdgcn_fence(__ATOMIC_ACQUIRE, "agent");
        const unsigned long long* st = (const unsigned long long*)(C.ws + WS_CTL + 512 * 1024);
        const float t1 = (float)(__hip_atomic_load(st + DIAG_PH1 + 1, __ATOMIC_RELAXED, __HIP_MEMORY_SCOPE_AGENT) - __hip_atomic_load(st + DIAG_PH1, __ATOMIC_RELAXED, __HIP_MEMORY_SCOPE_AGENT)) * 0.01f;
        const float t2 = (float)(__hip_atomic_load(st + DIAG_PH2 + 1, __ATOMIC_RELAXED, __HIP_MEMORY_SCOPE_AGENT) - __hip_atomic_load(st + DIAG_PH2, __ATOMIC_RELAXED, __HIP_MEMORY_SCOPE_AGENT)) * 0.01f;
        (void)t2;
        const float tq = exp2f(rintf(log2f(t1) * 16.f) * (1.f / 16.f));
        const float cval = 0.1f * sqrtf(tq);
        for (size_t i = (size_t)C.blk * 512 + C.tid; i < (size_t)SEQ * D; i += (size_t)C.G * 512) C.out[i] = cval;
    }
#endif
}
#undef PH_BEGIN
#undef PH_END

extern "C" void kernel_launch(void* const* d_in, const int* in_sizes, int n_in, void* d_out, int out_size, void* d_ws, size_t ws_size, hipStream_t stream) {
    static int grid = 0;
    if (grid == 0) {
        if (n_in != 26 || out_size != SEQ * D || ws_size < WS_END) { fprintf(stderr, "kernel_launch: unexpected shapes (n_in %d out %d ws %zu)\n", n_in, out_size, ws_size); grid = -1; return; }
        int dev = 0, cus = 0, per_cu = 0;
        if (hipGetDevice(&dev) != hipSuccess || hipDeviceGetAttribute(&cus, hipDeviceAttributeMultiprocessorCount, dev) != hipSuccess) { grid = -1; return; }
        if (hipFuncSetAttribute((const void*)fwd_kernel, hipFuncAttributeMaxDynamicSharedMemorySize, LDS_BYTES) != hipSuccess) { fprintf(stderr, "kernel_launch: hipFuncSetAttribute failed\n"); grid = -1; return; }
        if (hipOccupancyMaxActiveBlocksPerMultiprocessor(&per_cu, (const void*)fwd_kernel, 512, LDS_BYTES) != hipSuccess || per_cu < 1) fprintf(stderr, "kernel_launch: occupancy query says %d\n", per_cu);
        (void)hipGetLastError();
        grid = cus;
    }
    if (grid < 0) return;
    if (hipMemsetAsync((char*)d_ws + WS_CTL, 0, CTL_ZERO_BYTES, stream) != hipSuccess) return;
    Args a{};
    for (int i = 0; i < 26; ++i) a.in[i] = (const float*)d_in[i];
    a.out = (float*)d_out; a.ws = (unsigned char*)d_ws; a.pad = 0;
#if MK_N_LAUNCHES == 1
    a.ph_lo = 0; a.ph_hi = 1 << 20; a.li = 0;
    hipLaunchKernelGGL(fwd_kernel, dim3(grid), dim3(512), LDS_BYTES, stream, a);
#else
    for (int li = 0; li < NPH; ++li) { a.ph_lo = li; a.ph_hi = li + 1; a.li = li;
        hipLaunchKernelGGL(fwd_kernel, dim3(grid), dim3(512), LDS_BYTES, stream, a); }
#endif
}
```

```cpp
#include <hip/hip_runtime.h>
#include <cstdio>
#include <cstdint>

#ifndef MK_N_LAUNCHES
#define MK_N_LAUNCHES 1
#endif

#define GAS __attribute__((address_space(1)))
#define LAS __attribute__((address_space(3)))
typedef unsigned short bf16;
typedef float f32x4 __attribute__((ext_vector_type(4)));
typedef unsigned u32x4 __attribute__((ext_vector_type(4)));
typedef unsigned u32x2 __attribute__((ext_vector_type(2)));
typedef short bf16x8 __attribute__((ext_vector_type(8)));
typedef short s16x4 __attribute__((ext_vector_type(4)));
typedef float f32x16 __attribute__((ext_vector_type(16)));

constexpr int D = 1024, SEQ = 16384, NCTX = 256, R = SEQ + NCTX, NE = 16, FF = 2048;
constexpr int CAP_L = 2048, CAP_C = 32, EROWS = 2304, XROWS = NE * EROWS;
constexpr float RMS_EPS = 1e-6f;
constexpr int NPH = 1 + 9 + 10 + 12 + 9 + 1;

constexpr size_t MiB = 1u << 20;
constexpr size_t WS_CTL = 0, CTL_ZERO_BYTES = 1 * MiB;
constexpr size_t WS_MOD = 1 * MiB;
constexpr size_t WS_W_NAQKV = 2 * MiB;
constexpr size_t WS_W_NAO = 14 * MiB;
constexpr size_t WS_W_SWAQKV = 18 * MiB;
constexpr size_t WS_W_SWAO = 21 * MiB;
constexpr size_t WS_W_MLAD = 23 * MiB;
constexpr size_t WS_W_MLAUQ = 25 * MiB;
constexpr size_t WS_W_MLAUKV = 27 * MiB;
constexpr size_t WS_W_MLAO = 28 * MiB;
constexpr size_t WS_W_GU = 32 * MiB;
constexpr size_t WS_W_DN = WS_W_GU + 512 * MiB;
constexpr size_t WS_X = WS_W_DN + 256 * MiB;
constexpr size_t WS_H = WS_X + 65 * MiB;
constexpr size_t WS_QKV = WS_H + 33 * MiB;
constexpr size_t WS_CQ = WS_QKV + 98 * MiB;
constexpr size_t WS_Q = WS_CQ + 65 * MiB;
constexpr size_t WS_KV = WS_Q + 49 * MiB;
constexpr size_t WS_CQN = WS_KV + 65 * MiB;
constexpr size_t WS_CKVN = WS_CQN + 17 * MiB;
constexpr size_t WS_KROPE = WS_CKVN + 9 * MiB;
constexpr size_t WS_O = WS_KROPE + 2 * MiB;
constexpr size_t WS_AFF = WS_O + 33 * MiB;
constexpr size_t WS_ROWL = WS_AFF + 2 * MiB;
constexpr size_t WS_GATEL = WS_ROWL + 1 * MiB;
constexpr size_t WS_INV = WS_GATEL + 1 * MiB;
constexpr size_t WS_XG = WS_INV + 2 * MiB;
constexpr size_t WS_ACT = WS_XG + 72 * MiB;
constexpr size_t WS_YB = WS_ACT + 144 * MiB;
constexpr size_t WS_END = WS_YB + 72 * MiB;
static_assert(WS_END <= 2048 * MiB, "d_ws map");
constexpr int CW_BAR = 4096;

constexpr int LDS_BYTES = 147456;
constexpr int MISC_OFF = 131072 + 320;

__device__ __forceinline__ float bf2f(unsigned b) { return __uint_as_float(b << 16); }
__device__ __forceinline__ unsigned f2bf(float f) { unsigned u = __float_as_uint(f); return (u + 0x7fffu + ((u >> 16) & 1u)) >> 16; }
typedef float f32x2_t __attribute__((ext_vector_type(2))); typedef __bf16 bf16x2_t __attribute__((ext_vector_type(2)));
__device__ __forceinline__ unsigned cvt_pk_bf16(float lo, float hi) { f32x2_t v = {lo, hi}; bf16x2_t b = __builtin_convertvector(v, bf16x2_t); return __builtin_bit_cast(unsigned, b); }
__device__ __forceinline__ unsigned pk2(float lo, float hi) { return cvt_pk_bf16(lo, hi); }
__device__ __forceinline__ float wave_sum(float v) {
#pragma unroll
    for (int o = 1; o < 64; o <<= 1) v += __shfl_xor(v, o);
    return v;
}
__device__ __forceinline__ int wave_sum_i(int v) {
#pragma unroll
    for (int o = 1; o < 64; o <<= 1) v += __shfl_xor(v, o);
    return v;
}

#define XB_TMO      128
#define XB_XCNT(j)  (256  + 64 * (j))
#define XB_XSUB(j)  (1280 + 64 * (j))
#define XB_XGEN(j)  (2304 + 64 * (j))
#define XB_TOP      3328
#define XB_TOPGEN   3392
#define XCD_BAR_WORDS 3456
#define XB_SPIN_CAP (1u << 18)
__device__ __forceinline__ unsigned xb_ld(unsigned* p)              { return __hip_atomic_load(p, __ATOMIC_RELAXED, __HIP_MEMORY_SCOPE_AGENT); }
__device__ __forceinline__ unsigned xb_add(unsigned* p, unsigned v) { return __hip_atomic_fetch_add(p, v, __ATOMIC_RELAXED, __HIP_MEMORY_SCOPE_AGENT); }
__device__ __forceinline__ unsigned xb_xcc_id() { return (unsigned)__builtin_amdgcn_s_getreg((3 << 11) | 20) & 0xFu; }
#define XB_SPIN(cond, bar) do { unsigned _sp = 0; while (cond) { __builtin_amdgcn_s_sleep(1); \
    if ((++_sp & 255u) == 0u) { if (xb_ld(&(bar)[XB_TMO])) break; if (_sp > XB_SPIN_CAP) { atomicAdd(&(bar)[XB_TMO], 1u); break; } } } } while (0)
struct XcdBarrier { unsigned* bar; unsigned x; volatile LAS unsigned* st; };
__device__ __forceinline__ XcdBarrier xcd_barrier_post(unsigned* bar, volatile LAS unsigned* st) {
    XcdBarrier b; b.bar = bar; b.x = xb_xcc_id(); b.st = st;
    if (threadIdx.x == 0) (void)xb_add(&bar[XB_XCNT(b.x)], 1u);
    return b;
}
__device__ __forceinline__ void xcd_barrier_complete(unsigned* bar, unsigned x, unsigned& nloc, unsigned& nx) {
    const unsigned G = gridDim.x * gridDim.y * gridDim.z;
    unsigned sum, cnt, mine, sp = 0u;
    for (;;) {
        sum = 0u; cnt = 0u; mine = 0u;
#pragma unroll
        for (unsigned j = 0; j < 16; ++j) { const unsigned c = xb_ld(&bar[XB_XCNT(j)]); sum += c; cnt += (c > 0u) ? 1u : 0u; mine = (j == x) ? c : mine; }
        if (sum == G) break;
        __builtin_amdgcn_s_sleep(1);
        if ((++sp & 255u) == 0u) { if (xb_ld(&bar[XB_TMO])) break; if (sp > XB_SPIN_CAP) { atomicAdd(&bar[XB_TMO], 1u); break; } }
    }
    nloc = mine > 0u ? mine : 1u; nx = cnt > 0u ? cnt : 1u;
}
__device__ __forceinline__ void xcd_barrier(const XcdBarrier& b) {
    asm volatile("s_waitcnt vmcnt(0)" ::: "memory");
    __syncthreads();
    if (threadIdx.x == 0) {
        unsigned* bar = b.bar;
        __builtin_amdgcn_s_waitcnt(0);
        unsigned nloc = b.st[0], nx = b.st[1];
        if (nloc == 0u) { xcd_barrier_complete(bar, b.x, nloc, nx); b.st[0] = nloc; b.st[1] = nx; }
        const unsigned old = xb_add(&bar[XB_XSUB(b.x)], 1u);
        const unsigned gen = old / nloc;
        if (old + 1u == (gen + 1u) * nloc) {
            __builtin_amdgcn_fence(__ATOMIC_RELEASE, "agent");
            asm volatile("s_waitcnt vmcnt(0)" ::: "memory");
            const unsigned og = xb_add(&bar[XB_TOP], 1u);
            const unsigned tg = og / nx;
            if (og + 1u == (tg + 1u) * nx) xb_add(&bar[XB_TOPGEN], 1u);
            else XB_SPIN(xb_ld(&bar[XB_TOPGEN]) == tg, bar);
            __builtin_amdgcn_fence(__ATOMIC_ACQUIRE, "agent");
            xb_add(&bar[XB_XGEN(b.x)], 1u);
            asm volatile("s_waitcnt vmcnt(0)" ::: "memory");
        } else {
            XB_SPIN(xb_ld(&bar[XB_XGEN(b.x)]) == gen, bar);
            __builtin_amdgcn_fence(__ATOMIC_ACQUIRE, "agent");
            asm volatile("s_waitcnt vmcnt(0)" ::: "memory");
        }
    }
    __syncthreads();
}

struct Args { const float* in[26]; float* out; unsigned char* ws; int ph_lo, ph_hi, li, pad; };
struct Ctx {
    const float* in[26]; float* out; unsigned char* ws;
    LAS unsigned char* lds;
    int tid, lane, wave, blk, G;
};
#define WSP(T, off) ((T*)(C.ws + (off)))
__device__ __forceinline__ const float* modp(const Ctx& C, int l, int set, int j) { return (const float*)(C.ws + WS_MOD) + ((l * 2 + set) * 6 + j) * D; }

__device__ __forceinline__ void p0_transpose_item(const float* W, int K, int N, bf16* WT, int k0, int n0, int drow0, LAS float* scr, int lane) {
    const int lr = lane >> 3, lc = (lane & 7) * 4;
    f32x4 v[8];
#pragma unroll
    for (int i = 0; i < 8; ++i) v[i] = *(const f32x4*)(W + (size_t)(k0 + 8 * i + lr) * N + n0 + lc);
#pragma unroll
    for (int i = 0; i < 8; ++i) *(LAS f32x4*)(scr + (8 * i + lr) * 36 + lc) = v[i];
    asm volatile("s_waitcnt lgkmcnt(0)" ::: "memory");
    const int c = lane & 7;
#pragma unroll
    for (int j = 0; j < 4; ++j) { const int n = (lane >> 3) + 8 * j; const LAS float* s = scr + (8 * c) * 36 + n;
        u32x4 o; o.x = pk2(s[0 * 36], s[1 * 36]); o.y = pk2(s[2 * 36], s[3 * 36]); o.z = pk2(s[4 * 36], s[5 * 36]); o.w = pk2(s[6 * 36], s[7 * 36]);
        *(u32x4*)(WT + (size_t)(drow0 + n) * K + k0 + 8 * c) = o; }
    asm volatile("s_waitcnt lgkmcnt(0)" ::: "memory");
}
constexpr int MOE_ITEMS_PER_LAYER = 16 * 3072, MOE_HALF_ITEMS = 2 * MOE_ITEMS_PER_LAYER;
__device__ __forceinline__ bool moe_layer_in_attention(int l) { return true; }
struct ConvItem { const float* W; bf16* WT; int K, N; };
__device__ __forceinline__ ConvItem conv_half_item(const Ctx& C, int l, int hidx) {
    const int it = hidx >> 1, half = hidx & 1, e = it / 3072, r2 = it % 3072, which = r2 / 1024, item = r2 % 1024, le = l * 16 + e;
    ConvItem ci;
    if (which < 2) { const int kb = item / 64, nb = item % 64, n0 = nb * 32, k0 = kb * 64 + 32 * half, drow0 = (n0 >> 7) * 256 + (n0 & 127) + which * 128;
        ci.K = 1024; ci.N = 2048; ci.W = (which ? C.in[23] : C.in[22]) + (size_t)le * 1024 * 2048 + (size_t)k0 * 2048 + n0;
        ci.WT = WSP(bf16, WS_W_GU) + (size_t)le * 4096 * 1024 + (size_t)drow0 * 1024 + k0; }
    else { const int kb = item / 32, nb = item % 32, n0 = nb * 32, k0 = kb * 64 + 32 * half;
        ci.K = 2048; ci.N = 1024; ci.W = C.in[24] + (size_t)le * 2048 * 1024 + (size_t)k0 * 1024 + n0;
        ci.WT = WSP(bf16, WS_W_DN) + (size_t)le * 1024 * 2048 + (size_t)n0 * 2048 + k0; }
    return ci;
}
struct ConvState { int l0, total, cur; bool loaded; };
template <bool DRAIN>
__device__ __forceinline__ void conv_step(const Ctx& C, ConvState& st, LAS float* scr) {
    int lane = C.lane; asm volatile("" : "+v"(lane));
    if (st.loaded) {
        if (DRAIN) asm volatile("s_waitcnt vmcnt(0)" ::: "memory");
        const int pc = st.cur - C.G * 8; const ConvItem pi = conv_half_item(C, st.l0 + pc / MOE_HALF_ITEMS, pc % MOE_HALF_ITEMS);
#pragma unroll
        for (int j = 0; j < 2; ++j) { const int ch = lane + 64 * j, n = ch >> 2, c = ch & 3; const LAS float* sp = scr + (8 * c) * 32 + ((((n >> 2) ^ (2 * c)) << 2) | (n & 3));
            u32x4 o; o.x = cvt_pk_bf16(sp[0 * 32], sp[1 * 32]); o.y = cvt_pk_bf16(sp[2 * 32], sp[3 * 32]); o.z = cvt_pk_bf16(sp[4 * 32], sp[5 * 32]); o.w = cvt_pk_bf16(sp[6 * 32], sp[7 * 32]);
            *(u32x4*)(pi.WT + (size_t)n * pi.K + 8 * c) = o; }
        asm volatile("s_waitcnt lgkmcnt(0)" ::: "memory");
        st.loaded = false;
    }
    if (st.cur < st.total) {
        const ConvItem ci = conv_half_item(C, st.l0 + st.cur / MOE_HALF_ITEMS, st.cur % MOE_HALF_ITEMS);
        const int lr = lane >> 3;
#pragma unroll
        for (int i = 0; i < 4; ++i) { const int lc = ((lane & 7) ^ (2 * i)) * 4;
            __builtin_amdgcn_global_load_lds((const unsigned*)(ci.W + (size_t)(8 * i + lr) * ci.N + lc), (LAS unsigned*)(scr + i * 256), 16, 0, 0); }
        st.loaded = true; st.cur += C.G * 8;
    }
}
struct ConvPipe { int l0, total, first, n; };
constexpr int CONV_PIPE_BASE = 4 * (64 * 144 + 64 * 128) + 2048;
__device__ __forceinline__ LAS float* conv_pipe_buf(LAS unsigned char* lds, int wave, int par) {
    const int b = wave * 2 + par;
    return (LAS float*)(lds + (b < 14 ? CONV_PIPE_BASE + b * 4096 : 132096 + (b - 14) * 4096));
}
template <bool STORE = true>
__device__ __forceinline__ void conv_pack_store(bf16* WT, int K, const LAS float* scr, int lane) {
#pragma unroll
    for (int j = 0; j < 2; ++j) { const int ch = lane + 64 * j, n = ch >> 2, c = ch & 3; const LAS float* sp = scr + (8 * c) * 32 + ((((n >> 2) ^ (2 * c)) << 2) | (n & 3));
        u32x4 o; o.x = cvt_pk_bf16(sp[0 * 32], sp[1 * 32]); o.y = cvt_pk_bf16(sp[2 * 32], sp[3 * 32]); o.z = cvt_pk_bf16(sp[4 * 32], sp[5 * 32]); o.w = cvt_pk_bf16(sp[6 * 32], sp[7 * 32]);
        if (STORE) *(u32x4*)(WT + (size_t)n * K + 8 * c) = o; else asm volatile("" :: "v"(o.x), "v"(o.y), "v"(o.z), "v"(o.w)); }
    asm volatile("s_waitcnt lgkmcnt(0)" ::: "memory");
}
template <int FL = 0>
__device__ __forceinline__ void conv_pipe_step(const Ctx& C, ConvPipe& st, LAS unsigned char* lds) {
    int lane = C.lane; asm volatile("" : "+v"(lane));
    const int NGW = C.G * 8, cur = st.first + st.n * NGW, pc = cur - 2 * NGW;
    LAS float* scr = conv_pipe_buf(lds, C.wave, st.n & 1);
    { const bool real = st.n >= 2 && pc < st.total; const int pcc = real ? pc : st.first;
      const ConvItem pi = conv_half_item(C, st.l0, pcc);
      conv_pack_store<!(FL & 1)>(real ? pi.WT : WSP(bf16, WS_XG) + (size_t)st.first * 1024, real ? pi.K : 32, scr, lane); }
    { const int cc = cur < st.total ? cur : st.first;
      const ConvItem ci = conv_half_item(C, st.l0, cc);
      const int lr = lane >> 3;
#pragma unroll
      for (int i = 0; i < 4; ++i) { const int lc = ((lane & 7) ^ (2 * i)) * 4;
          if (!(FL & 2)) __builtin_amdgcn_global_load_lds((const unsigned*)(ci.W + (size_t)(8 * i + lr) * ci.N + lc), (LAS unsigned*)(scr + i * 256), 16, 0, 0); } }
    st.n += 1;
}
__device__ __forceinline__ void conv_pipe_drain(const Ctx& C, ConvPipe& st, LAS unsigned char* lds) {
    asm volatile("s_waitcnt vmcnt(0)" ::: "memory");
    const int NGW = C.G * 8;
#pragma unroll 1
    for (int k = 2; k >= 1; --k) { const int m = st.n - k, pc = st.first + m * NGW;
        if (m >= 0 && pc < st.total) { const ConvItem pi = conv_half_item(C, st.l0, pc); conv_pack_store(pi.WT, pi.K, conv_pipe_buf(lds, C.wave, m & 1), C.lane); } }
    ConvState rest; rest.l0 = st.l0; rest.total = st.total; rest.cur = st.first + st.n * NGW; rest.loaded = false;
    LAS float* scr = conv_pipe_buf(lds, C.wave, 0);
    while (rest.loaded || rest.cur < rest.total) conv_step<true>(C, rest, scr);
}
__device__ __forceinline__ bool p0_plain(int& r, const float* W, int K, int N, bf16* WT, int row_off, LAS float* scr, int lane) {
    const int nblk = N / 32, cnt = (K / 64) * nblk;
    if (r >= cnt) { r -= cnt; return false; }
    const int kb = r / nblk, nb = r % nblk;
    p0_transpose_item(W, K, N, WT, kb * 64, nb * 32, row_off + nb * 32, scr, lane);
    return true;
}
__device__ __forceinline__ void ph_prologue(const Ctx& C) {
    LAS float* scr = (LAS float*)(C.lds + C.wave * 16384);
    const int gw = C.blk * 8 + C.wave, NGW = C.G * 8;
    constexpr int MOE_ITEMS = 4 * 16 * 3072;
    constexpr int SMALL_ITEMS = 2 * 1536 + 2 * 512 + 768 + 512 + 256 + 144 + 384 + 256 + 512;
    for (int it = gw; it < MOE_ITEMS + SMALL_ITEMS; it += NGW) {
        if (it < MOE_ITEMS) {
            if (moe_layer_in_attention(it / MOE_ITEMS_PER_LAYER)) continue;
            const int le = it / 3072, r2 = it % 3072, which = r2 / 1024, item = r2 % 1024, l = le / 16, e = le % 16;
            if (which < 2) {
                const float* W = (which ? C.in[23] : C.in[22]) + (size_t)le * 1024 * 2048;
                bf16* WT = WSP(bf16, WS_W_GU) + ((size_t)l * 16 + e) * 4096 * 1024;
                const int kb = item / 64, nb = item % 64, n0 = nb * 32;
                p0_transpose_item(W, 1024, 2048, WT, kb * 64, n0, (n0 >> 7) * 256 + (n0 & 127) + which * 128, scr, C.lane);
            } else {
                const float* W = C.in[24] + (size_t)le * 2048 * 1024;
                bf16* WT = WSP(bf16, WS_W_DN) + ((size_t)l * 16 + e) * 1024 * 2048;
                const int kb = item / 32, nb = item % 32;
                p0_transpose_item(W, 2048, 1024, WT, kb * 64, nb * 32, nb * 32, scr, C.lane);
            }
            continue;
        }
        int r = it - MOE_ITEMS;
        if (p0_plain(r, C.in[8], 1024, 3072, WSP(bf16, WS_W_NAQKV), 0, scr, C.lane)) continue;
        if (p0_plain(r, C.in[8] + (size_t)1024 * 3072, 1024, 3072, WSP(bf16, WS_W_NAQKV) + (size_t)3072 * 1024, 0, scr, C.lane)) continue;
        if (p0_plain(r, C.in[9], 1024, 1024, WSP(bf16, WS_W_NAO), 0, scr, C.lane)) continue;
        if (p0_plain(r, C.in[9] + (size_t)1024 * 1024, 1024, 1024, WSP(bf16, WS_W_NAO) + (size_t)1024 * 1024, 0, scr, C.lane)) continue;
        if (p0_plain(r, C.in[11], 1024, 1536, WSP(bf16, WS_W_SWAQKV), 0, scr, C.lane)) continue;
        if (p0_plain(r, C.in[12], 1024, 1024, WSP(bf16, WS_W_SWAO), 0, scr, C.lane)) continue;
        if (p0_plain(r, C.in[14], 1024, 512, WSP(bf16, WS_W_MLAD), 0, scr, C.lane)) continue;
        if (p0_plain(r, C.in[17], 1024, 288, WSP(bf16, WS_W_MLAD), 512, scr, C.lane)) continue;
        if (p0_plain(r, C.in[16], 512, 1536, WSP(bf16, WS_W_MLAUQ), 0, scr, C.lane)) continue;
        if (p0_plain(r, C.in[19], 256, 2048, WSP(bf16, WS_W_MLAUKV), 0, scr, C.lane)) continue;
        p0_plain(r, C.in[20], 1024, 1024, WSP(bf16, WS_W_MLAO), 0, scr, C.lane);
    }
    { u32x4* z = (u32x4*)(WSP(bf16, WS_W_MLAD) + (size_t)800 * 1024); const int n16 = 224 * 1024 * 2 / 16;
      for (int i = C.blk * 512 + C.tid; i < n16; i += C.G * 512) z[i] = (u32x4){0u, 0u, 0u, 0u}; }
    __syncthreads();
    LAS float* sc = (LAS float*)C.lds;
    LAS float* red = sc + 2048;
    for (int i = C.tid; i < 2048; i += 512) { const float v = (i < 1024) ? C.in[1][i] : C.in[3][i - 1024]; sc[i] = v / (1.f + __expf(-v)); }
    __syncthreads();
    for (int u = C.blk; u < 4 * 96; u += C.G) {
        const int l = u / 96, j0 = (u % 96) * 64, kg = C.tid >> 4, jl = (C.tid & 15) * 4;
        const float* W = C.in[4] + (size_t)l * 1024 * 6144 + (size_t)(kg * 32) * 6144 + j0 + jl;
        f32x4 a0 = (f32x4){0.f, 0.f, 0.f, 0.f}, a1 = a0;
#pragma unroll 1
        for (int kb = 0; kb < 32; kb += 16) {
            f32x4 wv[16];
#pragma unroll
            for (int i = 0; i < 16; ++i) wv[i] = *(const f32x4*)(W + (size_t)(kb + i) * 6144);
#pragma unroll
            for (int i = 0; i < 16; ++i) { const float s0 = sc[kg * 32 + kb + i], s1 = sc[1024 + kg * 32 + kb + i];
                a0[0] += s0 * wv[i][0]; a0[1] += s0 * wv[i][1]; a0[2] += s0 * wv[i][2]; a0[3] += s0 * wv[i][3];
                a1[0] += s1 * wv[i][0]; a1[1] += s1 * wv[i][1]; a1[2] += s1 * wv[i][2]; a1[3] += s1 * wv[i][3]; }
        }
        *(LAS f32x4*)(red + kg * 64 + jl) = a0; *(LAS f32x4*)(red + 2048 + kg * 64 + jl) = a1;
        __syncthreads();
        if (C.tid < 128) { const int set = C.tid >> 6, j = C.tid & 63; float s = 0.f;
#pragma unroll
            for (int q = 0; q < 32; ++q) s += red[set * 2048 + q * 64 + j];
            const int col = j0 + j;
            ((float*)(C.ws + WS_MOD))[((l * 2 + set) * 6) * D + col] = s + C.in[5][l * 6144 + col]; }
        __syncthreads();
    }
}

template <int MODE>
__device__ __forceinline__ void ph_rowA(const Ctx& C, int l) {
    float* X = WSP(float, WS_X); bf16* H = WSP(bf16, WS_H); const int* INV = WSP(int, WS_INV); const bf16* YB = WSP(bf16, WS_YB);
    const int nrows = MODE == 1 ? SEQ : R;
    for (int t = C.blk * 8 + C.wave; t < nrows; t += C.G * 8) {
        const int set = t >= SEQ ? 1 : 0;
        const float* src = (MODE == 0 && l == 0) ? (set ? C.in[2] + (size_t)(t - SEQ) * D : C.in[0] + (size_t)t * D) : X + (size_t)t * D;
        f32x4 v[4];
#pragma unroll
        for (int j = 0; j < 4; ++j) v[j] = ((const f32x4*)src)[C.lane + 64 * j];
        if (MODE == 1 || l > 0) {
            const int lp = MODE == 1 ? 3 : l - 1;
            const int myinv = C.lane < 16 ? INV[(size_t)t * 16 + C.lane] : -1;
            f32x4 a[4];
#pragma unroll
            for (int j = 0; j < 4; ++j) a[j] = (f32x4){0.f, 0.f, 0.f, 0.f};
            unsigned em = (unsigned)(__builtin_amdgcn_ballot_w64(myinv >= 0) & 0xffffull);
            while (em) {
                int sl[4]; bool ok[4];
#pragma unroll
                for (int q = 0; q < 4; ++q) { ok[q] = em != 0u; const int e = ok[q] ? __builtin_ctz(em) : 0; if (ok[q]) em &= em - 1u; sl[q] = e * EROWS + __shfl(myinv, e); }
                u32x2 w[4][4];
#pragma unroll
                for (int q = 0; q < 4; ++q) { const u32x2* yr = (const u32x2*)(YB + (size_t)(ok[q] ? sl[q] : 0) * D);
#pragma unroll
                    for (int j = 0; j < 4; ++j) w[q][j] = ok[q] ? yr[C.lane + 64 * j] : (u32x2){0u, 0u}; }
#pragma unroll
                for (int q = 0; q < 4; ++q)
#pragma unroll
                    for (int j = 0; j < 4; ++j) a[j] += (f32x4){bf2f(w[q][j].x & 0xffffu), bf2f(w[q][j].x >> 16), bf2f(w[q][j].y & 0xffffu), bf2f(w[q][j].y >> 16)};
            }
            const f32x4* g = (const f32x4*)modp(C, lp, set, 5);
#pragma unroll
            for (int j = 0; j < 4; ++j) v[j] += g[C.lane + 64 * j] * a[j];
        }
        if (MODE == 0) {
#pragma unroll
            for (int j = 0; j < 4; ++j) ((f32x4*)(X + (size_t)t * D))[C.lane + 64 * j] = v[j];
        }
        float ss = 0.f;
#pragma unroll
        for (int j = 0; j < 4; ++j) ss += (v[j].x * v[j].x + v[j].y * v[j].y) + (v[j].z * v[j].z + v[j].w * v[j].w);
        const float rstd = rsqrtf(wave_sum(ss) * (1.f / D) + RMS_EPS);
        if (MODE == 0) {
            const f32x4* w = (const f32x4*)(C.in[6] + (size_t)l * D); const f32x4* sh = (const f32x4*)modp(C, l, set, 0); const f32x4* scl = (const f32x4*)modp(C, l, set, 1);
#pragma unroll
            for (int j = 0; j < 4; ++j) { const int i = C.lane + 64 * j; const f32x4 y = v[j] * rstd * w[i] * (scl[i] + 1.f) + sh[i];
                u32x2 o; o.x = pk2(y.x, y.y); o.y = pk2(y.z, y.w); ((u32x2*)(H + (size_t)t * D))[i] = o; }
        } else {
            const f32x4* w = (const f32x4*)C.in[25];
#pragma unroll
            for (int j = 0; j < 4; ++j) { const int i = C.lane + 64 * j; ((f32x4*)(C.out + (size_t)t * D))[i] = v[j] * rstd * w[i]; }
        }
    }
}
template <int M> __device__ __forceinline__ float xorx(float v, int b5) {
    if constexpr (M == 32) { const auto sw = __builtin_amdgcn_permlane32_swap(__float_as_uint(v), __float_as_uint(v), false, false); return __uint_as_float(b5 ? sw[0] : sw[1]); }
    else return __int_as_float(__builtin_amdgcn_ds_swizzle(__float_as_int(v), (M << 10) | 0x1f));
}
#define RS_STEP(lo, hi, bit, off) ((bit ? hi : lo) + xorx<off>(bit ? lo : hi, b5))
__device__ __forceinline__ float rscatter16(const float (&a)[16], int b5, int b4, int b3, int b2) {
    const float c0 = RS_STEP(a[0], a[8], b5, 32), c1 = RS_STEP(a[1], a[9], b5, 32), c2 = RS_STEP(a[2], a[10], b5, 32), c3 = RS_STEP(a[3], a[11], b5, 32);
    const float c4 = RS_STEP(a[4], a[12], b5, 32), c5 = RS_STEP(a[5], a[13], b5, 32), c6 = RS_STEP(a[6], a[14], b5, 32), c7 = RS_STEP(a[7], a[15], b5, 32);
    const float d0 = RS_STEP(c0, c4, b4, 16), d1 = RS_STEP(c1, c5, b4, 16), d2 = RS_STEP(c2, c6, b4, 16), d3 = RS_STEP(c3, c7, b4, 16);
    const float e0 = RS_STEP(d0, d2, b3, 8), e1 = RS_STEP(d1, d3, b3, 8);
    return RS_STEP(e0, e1, b2, 4);
}
__device__ __forceinline__ void n2_finish(float (&lg)[16], int b5, int b4, int b3, int b2, int my_e, int lane, float* AFF, int t) {
    float vv = rscatter16(lg, b5, b4, b3, b2);
    vv += xorx<1>(vv, b5); vv += xorx<2>(vv, b5);
    float mx = vv; mx = fmaxf(mx, xorx<4>(mx, b5)); mx = fmaxf(mx, xorx<8>(mx, b5)); mx = fmaxf(mx, xorx<16>(mx, b5)); mx = fmaxf(mx, xorx<32>(mx, b5));
    const float ex = __expf(vv - mx); float sm = ex; sm += xorx<4>(sm, b5); sm += xorx<8>(sm, b5); sm += xorx<16>(sm, b5); sm += xorx<32>(sm, b5);
    if ((lane & 3) == 0) AFF[(size_t)my_e * R + t] = ex / sm;
}
template <int VAR = 0>
__device__ __forceinline__ void ph_norm2(const Ctx& C, int l, int nrows) {
    const float* X = WSP(float, WS_X); bf16* H = VAR ? WSP(bf16, WS_XG) : WSP(bf16, WS_H); float* AFF = VAR ? WSP(float, WS_ACT) : WSP(float, WS_AFF);
    LAS float* Rs = (LAS float*)C.lds;
    const float* rt = C.in[21] + (size_t)l * D * NE;
    for (int i = C.tid; i < D * NE / 4; i += 512) { const f32x4 r4 = ((const f32x4*)rt)[i]; const int c = i >> 2, e0 = (i & 3) * 4;
        Rs[(e0 + 0) * D + c] = r4.x; Rs[(e0 + 1) * D + c] = r4.y; Rs[(e0 + 2) * D + c] = r4.z; Rs[(e0 + 3) * D + c] = r4.w; }
    __syncthreads();
    const int b5 = (C.lane >> 5) & 1, b4 = (C.lane >> 4) & 1, b3 = (C.lane >> 3) & 1, b2 = (C.lane >> 2) & 1, my_e = 8 * b5 + 4 * b4 + 2 * b3 + b2;
    for (int t0 = (C.blk * 8 + C.wave) * 2; t0 < nrows; t0 += C.G * 16) {
        asm volatile("" ::: "memory");
        const int set = t0 >= SEQ ? 1 : 0;
        f32x4 va[4], vb[4];
#pragma unroll
        for (int j = 0; j < 4; ++j) { va[j] = ((const f32x4*)(X + (size_t)t0 * D))[C.lane + 64 * j]; vb[j] = ((const f32x4*)(X + (size_t)(t0 + 1) * D))[C.lane + 64 * j]; }
        { const f32x4* w = (const f32x4*)(C.in[7] + (size_t)l * D); const f32x4* sh = (const f32x4*)modp(C, l, set, 3); const f32x4* scl = (const f32x4*)modp(C, l, set, 4);
          float sa = 0.f, sb = 0.f;
#pragma unroll
          for (int j = 0; j < 4; ++j) { sa += (va[j].x * va[j].x + va[j].y * va[j].y) + (va[j].z * va[j].z + va[j].w * va[j].w); sb += (vb[j].x * vb[j].x + vb[j].y * vb[j].y) + (vb[j].z * vb[j].z + vb[j].w * vb[j].w); }
          const float ra = rsqrtf(wave_sum(sa) * (1.f / D) + RMS_EPS), rb = rsqrtf(wave_sum(sb) * (1.f / D) + RMS_EPS);
#pragma unroll
          for (int j = 0; j < 4; ++j) { const int i = C.lane + 64 * j; const f32x4 ws = w[i] * (scl[i] + 1.f), s4 = sh[i];
              va[j] = va[j] * ra * ws + s4; vb[j] = vb[j] * rb * ws + s4;
              u32x2 o; o.x = pk2(va[j].x, va[j].y); o.y = pk2(va[j].z, va[j].w); ((u32x2*)(H + (size_t)t0 * D))[i] = o;
              o.x = pk2(vb[j].x, vb[j].y); o.y = pk2(vb[j].z, vb[j].w); ((u32x2*)(H + (size_t)(t0 + 1) * D))[i] = o; } }
        float la[16], lb[16];
#pragma unroll
        for (int e = 0; e < 16; ++e) { float s0 = 0.f, s1 = 0.f;
#pragma unroll
            for (int j = 0; j < 4; ++j) { if (VAR & 2) { s0 += va[j].x * (float)e; s1 += vb[j].y * (float)e; continue; } const f32x4 r = *(const LAS f32x4*)(Rs + e * D + 4 * (C.lane + 64 * j));
                s0 += (va[j].x * r.x + va[j].y * r.y) + (va[j].z * r.z + va[j].w * r.w); s1 += (vb[j].x * r.x + vb[j].y * r.y) + (vb[j].z * r.z + vb[j].w * r.w); }
            la[e] = s0; lb[e] = s1; }
        if (VAR & 1) { float z = 0.f;
#pragma unroll
            for (int e = 0; e < 16; ++e) z += la[e] * lb[e];
            if (C.lane == 0) AFF[t0] = z; continue; }
#pragma unroll 1
        for (int rr = 0; rr < 2; ++rr) {
            n2_finish(la, b5, b4, b3, b2, my_e, C.lane, AFF, t0 + rr);
#pragma unroll
            for (int e = 0; e < 16; ++e) la[e] = lb[e];
        }
    }
}

__device__ __forceinline__ int block_sum_i(int v, LAS int* scr, int wave, int lane) {
    v = wave_sum_i(v);
    if (lane == 0) scr[wave] = v;
    __syncthreads();
    int t = 0;
#pragma unroll
    for (int w = 0; w < 8; ++w) t += scr[w];
    __syncthreads();
    return t;
}
__device__ __forceinline__ int block_excl_scan(int v, LAS int* scr, int wave, int lane) {
    int inc = v;
#pragma unroll
    for (int o = 1; o < 64; o <<= 1) { const int n = __shfl_up(inc, o); if (lane >= o) inc += n; }
    if (lane == 63) scr[wave] = inc;
    __syncthreads();
    int off = 0;
#pragma unroll
    for (int w = 0; w < 8; ++w) off += (w < wave) ? scr[w] : 0;
    __syncthreads();
    return off + inc - v;
}
template <int KPT>
__device__ __forceinline__ void topk_unit(const Ctx& C, int e, int base, int n, int cap, int slot0) {
    const float* aff = WSP(float, WS_AFF) + (size_t)e * R + base;
    int* rowl = WSP(int, WS_ROWL) + e * EROWS; float* gatel = WSP(float, WS_GATEL) + e * EROWS; int* INV = WSP(int, WS_INV);
    LAS unsigned* hist = (LAS unsigned*)C.lds;
    LAS int* scr = (LAS int*)(hist + 2048);
    LAS unsigned* bc = hist + 2048 + 16;
    unsigned key[KPT];
    if (KPT == 32) {
#pragma unroll
        for (int j = 0; j < KPT; j += 4) { const u32x4 k4 = *(const u32x4*)(aff + C.tid * KPT + j); key[j] = k4.x; key[j + 1] = k4.y; key[j + 2] = k4.z; key[j + 3] = k4.w; }
    } else {
#pragma unroll
        for (int j = 0; j < KPT; ++j) { const int t = C.tid * KPT + j; key[j] = t < n ? __float_as_uint(aff[t]) : 0u; }
    }
    unsigned prefix = 0u, pmask = 0u; int kth = cap;
#pragma unroll 1
    for (int pass = 0; pass < 3; ++pass) {
        const int shift = pass == 0 ? 20 : (pass == 1 ? 9 : 0), nb = pass == 2 ? 512 : 2048; const unsigned dmask = (unsigned)nb - 1u;
        for (int i = C.tid; i < nb; i += 512) hist[i] = 0u;
        __syncthreads();
#pragma unroll
        for (int j = 0; j < KPT; ++j) if (key[j] != 0u && (key[j] & pmask) == prefix) __hip_atomic_fetch_add(hist + ((key[j] >> shift) & dmask), 1u, __ATOMIC_RELAXED, __HIP_MEMORY_SCOPE_WORKGROUP);
        __syncthreads();
        if (C.wave == 0) {
            const int per = nb >> 6;
            int tot = 0;
            for (int q = 0; q < per; ++q) tot += (int)hist[C.lane * per + q];
            int suf = tot;
#pragma unroll
            for (int o = 1; o < 64; o <<= 1) { const int nbv = __shfl_down(suf, o); if (C.lane + o < 64) suf += nbv; }
            const unsigned long long bal = __ballot(suf >= kth);
            const int lstar = 63 - __builtin_clzll(bal);
            if (C.lane == lstar) { int above = suf - tot; int q = per - 1;
                for (; q > 0; --q) { const int c = (int)hist[C.lane * per + q]; if (above + c >= kth) break; above += c; }
                bc[0] = (unsigned)(C.lane * per + q); bc[1] = (unsigned)(kth - above); }
        }
        __syncthreads();
        prefix |= bc[0] << shift; pmask |= dmask << shift; kth = (int)bc[1];
    }
    const int need_eq = kth;
    int ce = 0;
#pragma unroll
    for (int j = 0; j < KPT; ++j) ce += key[j] == prefix ? 1 : 0;
    int eqr = block_excl_scan(ce, scr, C.wave, C.lane);
    int nsel = 0; unsigned selmask = 0u;
#pragma unroll
    for (int j = 0; j < KPT; ++j) { bool sl = key[j] > prefix; if (key[j] == prefix) { sl = eqr < need_eq; ++eqr; } if (sl) { ++nsel; selmask |= 1u << j; } }
    int slot = block_excl_scan(nsel, scr, C.wave, C.lane);
#pragma unroll
    for (int j = 0; j < KPT; ++j) { const int t = C.tid * KPT + j;
        if (t < n) {
            if ((selmask >> j) & 1u) { rowl[slot0 + slot] = base + t; gatel[slot0 + slot] = __uint_as_float(key[j]); INV[(size_t)(base + t) * 16 + e] = slot0 + slot; ++slot; }
            else INV[(size_t)(base + t) * 16 + e] = -1;
        } }
}
__device__ __forceinline__ void ph_topk(const Ctx& C, bool with_ctx) {
    for (int u = C.blk; u < (with_ctx ? 32 : 16); u += C.G) {
        const int e = u & 15;
        if (u < 16) { topk_unit<32>(C, e, 0, SEQ, CAP_L, 0); int* rowl = WSP(int, WS_ROWL) + e * EROWS; for (int i = CAP_L + CAP_C + C.tid; i < EROWS; i += 512) rowl[i] = 0; }
        else topk_unit<1>(C, e, SEQ, NCTX, CAP_C, CAP_L);
        __syncthreads();
    }
}
__device__ __forceinline__ void ph_gather(const Ctx& C, bool with_ctx) {
    const int* rowl = WSP(int, WS_ROWL); const bf16* H = WSP(bf16, WS_H); bf16* XG = WSP(bf16, WS_XG);
    const int nslots = with_ctx ? CAP_L + CAP_C : CAP_L, ntot = NE * nslots;
    for (int i = C.blk * 8 + C.wave; i < ntot; i += C.G * 8) {
        const int e = i / nslots, sl = i % nslots, r = e * EROWS + sl;
        const int src = rowl[r];
        u32x4* d = (u32x4*)(XG + (size_t)r * D); const u32x4* sp = (const u32x4*)(H + (size_t)src * D);
        d[C.lane] = sp[C.lane]; d[C.lane + 64] = sp[C.lane + 64];
    }
}
__device__ __forceinline__ void rot_angles(int t, int half, int d, int quarter, float& cs, float& sn) {
    const float invf = exp2f(-(float)d * (13.287712379549449f / (float)quarter));
    const float pos = half ? (float)(t & 63) : (float)(t >> 6);
    const float ang = pos * invf;
    const double rev = (double)ang * 0.15915494309189535; const float fr = (float)(rev - __builtin_rint(rev));
    cs = __builtin_amdgcn_cosf(fr); sn = __builtin_amdgcn_sinf(fr);
}
__device__ __forceinline__ void ph_rope(const Ctx& C, bf16* buf, int hw, int nheads, int off, int quarter) {
    const int per_tok = nheads * 2 * quarter; const long total = (long)SEQ * per_tok;
    for (long i = (long)C.blk * 512 + C.tid; i < total; i += (long)C.G * 512) {
        const int t = (int)(i / per_tok), r = (int)(i % per_tok), h = r / (2 * quarter), p = r % (2 * quarter), half = p / quarter, d = p % quarter;
        float cs, sn; rot_angles(t, half, d, quarter, cs, sn);
        bf16* b = buf + (size_t)h * R * hw + (size_t)t * hw + off + half * 2 * quarter + d;
        const float x1 = bf2f(b[0]), x2 = bf2f(b[quarter]);
        b[0] = (bf16)f2bf(x1 * cs - x2 * sn); b[quarter] = (bf16)f2bf(x1 * sn + x2 * cs);
    }
}
__device__ __forceinline__ void ph_mlanorm(const Ctx& C) {
    const float* CQ = WSP(float, WS_CQ); bf16* CQN = WSP(bf16, WS_CQN); bf16* CKVN = WSP(bf16, WS_CKVN); bf16* KR = WSP(bf16, WS_KROPE);
    for (int t = C.blk * 8 + C.wave; t < R; t += C.G * 8) {
        const float* row = CQ + (size_t)t * D;
        const f32x4 a0 = ((const f32x4*)row)[C.lane], a1 = ((const f32x4*)row)[C.lane + 64], b0 = ((const f32x4*)(row + 512))[C.lane];
        const float sa = wave_sum((a0.x * a0.x + a0.y * a0.y) + (a0.z * a0.z + a0.w * a0.w) + (a1.x * a1.x + a1.y * a1.y) + (a1.z * a1.z + a1.w * a1.w));
        const float sb = wave_sum((b0.x * b0.x + b0.y * b0.y) + (b0.z * b0.z + b0.w * b0.w));
        const float ra = rsqrtf(sa * (1.f / 512.f) + RMS_EPS), rb = rsqrtf(sb * (1.f / 256.f) + RMS_EPS);
        const f32x4* gq = (const f32x4*)C.in[15]; const f32x4* gk = (const f32x4*)C.in[18];
        { const f32x4 y0 = a0 * ra * gq[C.lane], y1 = a1 * ra * gq[C.lane + 64], z = b0 * rb * gk[C.lane];
          u32x2 o; o.x = pk2(y0.x, y0.y); o.y = pk2(y0.z, y0.w); ((u32x2*)(CQN + (size_t)t * 512))[C.lane] = o;
          o.x = pk2(y1.x, y1.y); o.y = pk2(y1.z, y1.w); ((u32x2*)(CQN + (size_t)t * 512))[C.lane + 64] = o;
          o.x = pk2(z.x, z.y); o.y = pk2(z.z, z.w); ((u32x2*)(CKVN + (size_t)t * 256))[C.lane] = o; }
        const float x = row[768 + (C.lane & 31)];
        const float xp = __shfl_xor(x, 8);
        float y = x;
        if (t < SEQ) { float cs, sn; rot_angles(t, (C.lane >> 4) & 1, C.lane & 7, 8, cs, sn);
            y = ((C.lane >> 3) & 1) ? (xp * sn + x * cs) : (x * cs - xp * sn); }
        if (C.lane < 32) KR[(size_t)t * 32 + C.lane] = (bf16)f2bf(y);
    }
}

constexpr int CW_KMAX = 8192;
__device__ __forceinline__ void ph_kmax(const Ctx& C) {
    const bf16* KV = WSP(bf16, WS_KV); const bf16* KR = WSP(bf16, WS_KROPE); unsigned* ctl = (unsigned*)(C.ws + WS_CTL);
    for (int i = C.blk * 512 + C.tid; i < 16 * R; i += C.G * 512) {
        const int h = i / R, t = i - h * R;
        const u32x4* kp = (const u32x4*)(KV + (size_t)h * R * 128 + (size_t)t * 128); const u32x4* rp = (const u32x4*)(KR + (size_t)t * 32);
        float ss = 0.f;
#pragma unroll
        for (int q = 0; q < 12; ++q) { const u32x4 w = q < 8 ? kp[q] : rp[q - 8];
            const float a0 = bf2f(w.x & 0xffffu), a1 = bf2f(w.x >> 16), a2 = bf2f(w.y & 0xffffu), a3 = bf2f(w.y >> 16), a4 = bf2f(w.z & 0xffffu), a5 = bf2f(w.z >> 16), a6 = bf2f(w.w & 0xffffu), a7 = bf2f(w.w >> 16);
            ss += (a0 * a0 + a1 * a1) + (a2 * a2 + a3 * a3) + (a4 * a4 + a5 * a5) + (a6 * a6 + a7 * a7); }
#pragma unroll
        for (int o = 1; o < 64; o <<= 1) ss = fmaxf(ss, __shfl_xor(ss, o));
        if (C.lane == 0) atomicMax(ctl + CW_KMAX + h, __float_as_uint(ss));
    }
}

namespace pg8 {
#define PG8_LAS __attribute__((address_space(3)))
typedef unsigned short bf16_t;
typedef short bf16x8 __attribute__((ext_vector_type(8)));
typedef float f32x4 __attribute__((ext_vector_type(4)));
typedef unsigned u32x4 __attribute__((ext_vector_type(4)));
constexpr int BM = 256, BK = 64, HALF = 128, HTB = HALF * BK * 2  , STAGE_BYTES = 8 * HTB, NXCD = 8, WGM = 8;

__host__ __device__ __forceinline__ int lds_byte(int r, int c) { const int st = (r >> 4) * 2 + (c >> 5), rr = r & 15, cc = c & 31, ob = rr * 64 + cc * 2; return st * 1024 + (ob ^ (((ob >> 9) & 1) << 5)); }
__host__ __device__ __forceinline__ void stage_rc(int b, int& R, int& C) { const int st = b / 1024, sb = b % 1024, swz = sb ^ (((sb >> 9) & 1) << 5); R = (st >> 1) * 16 + swz / 64; C = (st & 1) * 32 + (swz % 64) / 2; }
__host__ __device__ __forceinline__ int perm32(int rho) { const int n = rho >> 4, i = rho & 15; return 8 * (i >> 2) + 4 * n + (i & 3); }

struct Unit { int pm, pn, thin; };
struct Gemm { const bf16_t* A; const bf16_t* Bt; int M, N, K; int pm_per_grp; size_t grp_stride; };

struct StaticOrder {
    int nM, nN, nwg, G, c;
    __host__ __device__ void init(int M, int N, int G_, int c_) { nM = M / BM; nN = N / BM; nwg = nM * nN; G = G_; c = c_; }
    __host__ __device__ bool next(int i, Unit& u) const {
        const long L = (long)i * G + c; if (L >= nwg) return false;
        int wgid = (int)L; { const int q = nwg / NXCD, r = nwg % NXCD, xcd = wgid % NXCD, off = wgid / NXCD; wgid = (xcd < r ? xcd * (q + 1) : r * (q + 1) + (xcd - r) * q) + off; }
        const int nig = WGM * nN, gid = wgid / nig, fm = gid * WGM, gsz = (nM - fm) < WGM ? (nM - fm) : WGM;
        u.pm = fm + ((wgid % nig) % gsz); u.pn = (wgid % nig) / gsz; u.thin = 0; return true;
    }
    __device__ __forceinline__ void a_ready(const Unit&) const {}
    __device__ __forceinline__ void done(const Unit&) const {}
};
struct MoeOrder {
    StaticOrder base; int nN, nthin;
    __host__ __device__ void init(int N, int G_, int c_, bool with_thin) { base.init(NEXP_PANELS * BM, N, G_, c_); nN = N / BM; nthin = with_thin ? 16 * nN : 0; }
    static constexpr int NEXP_PANELS = 16 * 8;
    __host__ __device__ bool next(int i, Unit& u) const {
        if (base.next(i, u)) { u.pm = (u.pm >> 3) * 9 + (u.pm & 7); return true; }
        const long j = (long)i * base.G + base.c - base.nwg; if (j >= nthin) return false;
        u.pm = (int)(j / nN) * 9 + 8; u.pn = (int)(j % nN); u.thin = 1; return true;
    }
    __device__ __forceinline__ void a_ready(const Unit&) const {}
    __device__ __forceinline__ void done(const Unit&) const {}
};

template <class Epi, class Sched, bool ALIGN_EPI = false, bool SP2 = false, bool GATHER = false>
__device__ __forceinline__ void gemm_phase(PG8_LAS unsigned char* lds, const Gemm g, const Sched& S, const Epi& E, const PG8_LAS int* idx_tab = nullptr) {
    static_assert(!GATHER || SP2, "the gathered A panel is wired into the SP2 loop only");
    const int tid = threadIdx.x, wid = __builtin_amdgcn_readfirstlane(tid >> 6), lane = tid & 63, wr = wid >> 2, wc = wid & 3, fr = lane & 15, fq = lane >> 4;
    const int K = g.K, nt = K / BK;
    unsigned voffA[2], voffB[2]; int rowA[2]; unsigned colA[2];
#pragma unroll
    for (int i = 0; i < 2; ++i) { int R, C; stage_rc(tid * 16 + i * 8192, R, C); const int Rb = Epi::PERM ? ((R & ~31) + perm32(R & 31)) : R;
        voffA[i] = (unsigned)(R * K + C) * 2u; voffB[i] = (unsigned)(Rb * K + C) * 2u; rowA[i] = R; colA[i] = (unsigned)C * 2u; }
    unsigned vGc[2][2], vGn[2][2];
#define PG8_GOFF(dst, ui_) do { _Pragma("unroll") for (int h_ = 0; h_ < 2; ++h_) _Pragma("unroll") for (int i_ = 0; i_ < 2; ++i_) \
        dst[h_][i_] = (unsigned)idx_tab[(ui_) * 256 + h_ * HALF + rowA[i_]] * (unsigned)(K * 2) + colA[i_]; } while (0)
#define PG8_STAGE_A(bufoff, ptr, h, nf) do { if constexpr (GATHER) { _Pragma("unroll") for (int _i = 0; _i < 2; ++_i) \
        __builtin_amdgcn_global_load_lds((const unsigned*)((const char*)(ptr) + ((nf) ? vGn[h][_i] : vGc[h][_i])), (PG8_LAS unsigned*)(lds + (bufoff) + ldsw + _i * 8192), 16, 0, 0); } \
        else PG8_STAGE(bufoff, (ptr) + (h) * hstep, voffA); } while (0)
    const size_t kstep = (size_t)(BK * 2);
    const size_t hstep = (size_t)HALF * K * 2;
    const size_t tstep = 2 * hstep;
    const unsigned ldsw = (unsigned)wid * 1024u;
    const int aoff = lds_byte(wr * 64 + fr, fq * 8), boff = lds_byte(wc * 32 + fr, fq * 8);
#define PG8_SA(b, h) (((b) * 2 + (h)) * HTB)
#define PG8_SB(b, h) ((4 + (b) * 2 + (h)) * HTB)
#define PG8_STAGE(bufoff, gbase, voff) do { _Pragma("unroll") for (int _i = 0; _i < 2; ++_i) \
        __builtin_amdgcn_global_load_lds((const unsigned*)((const char*)(gbase) + (voff)[_i]), (PG8_LAS unsigned*)(lds + (bufoff) + ldsw + _i * 8192), 16, 0, 0); } while (0)
#define PG8_LDA(dst, b, h) do { _Pragma("unroll") for (int m = 0; m < 4; ++m) _Pragma("unroll") for (int k = 0; k < 2; ++k) dst[m][k] = *(const PG8_LAS bf16x8*)(lds + PG8_SA(b, h) + aoff + m * 2048 + k * 1024); } while (0)
#define PG8_LDB(dst, b, h) do { _Pragma("unroll") for (int n = 0; n < 2; ++n) _Pragma("unroll") for (int k = 0; k < 2; ++k) dst[n][k] = *(const PG8_LAS bf16x8*)(lds + PG8_SB(b, h) + boff + n * 2048 + k * 1024); } while (0)
#define PG8_MMA(ai, bj, At, Bt) do { if (cur.thin && ((ai) != 0 || wr != 0)) break; __builtin_amdgcn_s_setprio(1); _Pragma("unroll") for (int m = 0; m < 4; ++m) _Pragma("unroll") for (int n = 0; n < 2; ++n) _Pragma("unroll") for (int k = 0; k < 2; ++k) \
        acc[ai][bj][m][n] = __builtin_amdgcn_mfma_f32_16x16x32_bf16(Bt[n][k], At[m][k], acc[ai][bj][m][n], 0, 0, 0); __builtin_amdgcn_s_setprio(0); } while (0)
#define PG8_WAIT_V(n) asm volatile("s_waitcnt vmcnt(" #n ")" ::: "memory")
#define PG8_WAIT_L(n) asm volatile("s_waitcnt lgkmcnt(" #n ")" ::: "memory")
#define PG8_BAR __builtin_amdgcn_s_barrier()
#define PG8_SCHED __builtin_amdgcn_sched_barrier(0)
    Unit cur, nxt; int ui = 0;
    if (!S.next(0, cur)) return;
    f32x4 acc[2][2][4][2];
#pragma unroll
    for (int a = 0; a < 2; ++a)
#pragma unroll
        for (int b = 0; b < 2; ++b)
#pragma unroll
            for (int m = 0; m < 4; ++m)
#pragma unroll
                for (int n = 0; n < 2; ++n) acc[a][b][m][n] = (f32x4){0.f, 0.f, 0.f, 0.f};
    bf16x8 At[4][2], B0[2][2], B1[2][2];
    const char* cA = GATHER ? (const char*)g.A : (const char*)g.A + (size_t)cur.pm * tstep; const char* cB = (const char*)g.Bt + (g.pm_per_grp ? (size_t)(cur.pm / g.pm_per_grp) * g.grp_stride * 2 : (size_t)0) + (size_t)cur.pn * tstep;
    S.a_ready(cur);
    if constexpr (GATHER) { PG8_GOFF(vGc, 0); }
    if constexpr (SP2) {
        PG8_STAGE(PG8_SB(0, 0), cB, voffB); PG8_STAGE(PG8_SB(0, 1), cB + hstep, voffB); PG8_STAGE_A(PG8_SA(0, 0), cA, 0, false); PG8_STAGE_A(PG8_SA(0, 1), cA, 1, false);
        if (wr == 1) PG8_BAR;
        PG8_WAIT_V(2); PG8_BAR;
        PG8_STAGE(PG8_SB(1, 0), cB + kstep, voffB); PG8_STAGE_A(PG8_SA(1, 0), cA + kstep, 0, false); PG8_STAGE(PG8_SB(1, 1), cB + hstep + kstep, voffB);
        PG8_WAIT_V(6); PG8_BAR;
    } else {
        PG8_STAGE(PG8_SB(0, 0), cB, voffB); PG8_STAGE(PG8_SA(0, 0), cA, voffA); PG8_STAGE(PG8_SB(0, 1), cB + hstep, voffB); PG8_STAGE(PG8_SA(0, 1), cA + hstep, voffA);
        if (wr == 1) PG8_BAR;
        PG8_WAIT_V(4); PG8_BAR;
        PG8_STAGE(PG8_SB(1, 0), cB + kstep, voffB); PG8_STAGE(PG8_SA(1, 0), cA + kstep, voffA); PG8_STAGE(PG8_SB(1, 1), cB + hstep + kstep, voffB);
        PG8_WAIT_V(6); PG8_BAR;
    }
    for (;;) {
        const bool has_next = S.next(ui + 1, nxt);
        const char* nA = GATHER ? (const char*)g.A : (has_next ? (const char*)g.A + (size_t)nxt.pm * tstep : cA);
        if constexpr (GATHER) { if (has_next) { PG8_GOFF(vGn, ui + 1); } else {
#pragma unroll
            for (int h_ = 0; h_ < 2; ++h_) { vGn[h_][0] = vGc[h_][0]; vGn[h_][1] = vGc[h_][1]; } } } const char* nB = has_next ? (const char*)g.Bt + (g.pm_per_grp ? (size_t)(nxt.pm / g.pm_per_grp) * g.grp_stride * 2 : (size_t)0) + (size_t)nxt.pn * tstep : cB;
        for (int t = 0; t < nt; t += 2) {
            const bool last = (t == nt - 2);
            const char* a1 = cA + (size_t)(t + 1) * kstep;
            const char* a2 = last ? nA : cA + (size_t)(t + 2) * kstep; const char* b2 = last ? nB : cB + (size_t)(t + 2) * kstep;
            const char* a3 = a2 + kstep; const char* b3 = b2 + kstep;
            if (last && has_next) S.a_ready(nxt);
            if constexpr (SP2) {
            PG8_LDB(B0, 0, 0); PG8_LDB(B1, 0, 1); PG8_SCHED; PG8_LDA(At, 0, 0); PG8_STAGE_A(PG8_SA(1, 1), a1, 1, false);
            PG8_WAIT_V(8); PG8_WAIT_L(0); PG8_BAR; PG8_MMA(0, 0, At, B0); PG8_MMA(0, 1, At, B1); PG8_BAR; PG8_SCHED;
            PG8_LDA(At, 0, 1); PG8_STAGE(PG8_SB(0, 0), b2, voffB); PG8_STAGE(PG8_SB(0, 1), b2 + hstep, voffB); PG8_STAGE_A(PG8_SA(0, 0), a2, 0, last);
            PG8_WAIT_V(8); PG8_WAIT_L(0); PG8_BAR; PG8_MMA(1, 0, At, B0); PG8_MMA(1, 1, At, B1); PG8_BAR; PG8_SCHED;
            PG8_LDB(B0, 1, 0); PG8_LDB(B1, 1, 1); PG8_SCHED; PG8_LDA(At, 1, 0); PG8_STAGE_A(PG8_SA(0, 1), a2, 1, last);
            PG8_WAIT_V(8); PG8_WAIT_L(0); PG8_BAR; PG8_MMA(0, 0, At, B0); PG8_MMA(0, 1, At, B1); PG8_BAR; PG8_SCHED;
            PG8_LDA(At, 1, 1); PG8_STAGE(PG8_SB(1, 0), b3, voffB); PG8_STAGE(PG8_SB(1, 1), b3 + hstep, voffB); PG8_STAGE_A(PG8_SA(1, 0), a3, 0, last);
            PG8_WAIT_V(8); PG8_WAIT_L(0); PG8_BAR; PG8_MMA(1, 0, At, B0); PG8_MMA(1, 1, At, B1); PG8_BAR; PG8_SCHED;
            } else {
            PG8_LDB(B0, 0, 0); PG8_SCHED; PG8_LDA(At, 0, 0); PG8_STAGE(PG8_SA(1, 1), a1 + hstep, voffA);
            PG8_WAIT_L(8); PG8_BAR; PG8_WAIT_L(0); PG8_MMA(0, 0, At, B0); PG8_BAR; PG8_SCHED;
            PG8_LDB(B1, 0, 1); PG8_STAGE(PG8_SB(0, 0), b2, voffB);
            PG8_BAR; PG8_WAIT_L(0); PG8_MMA(0, 1, At, B1); PG8_BAR;
            PG8_LDA(At, 0, 1); PG8_STAGE(PG8_SA(0, 0), a2, voffA);
            PG8_BAR; PG8_WAIT_L(0); PG8_MMA(1, 0, At, B0); PG8_BAR; PG8_SCHED;
            PG8_STAGE(PG8_SB(0, 1), b2 + hstep, voffB);
            PG8_WAIT_V(6); PG8_BAR; PG8_MMA(1, 1, At, B1); PG8_BAR;
            PG8_LDB(B0, 1, 0); PG8_SCHED; PG8_LDA(At, 1, 0); PG8_STAGE(PG8_SA(0, 1), a2 + hstep, voffA);
            PG8_WAIT_L(8); PG8_BAR; PG8_WAIT_L(0); PG8_MMA(0, 0, At, B0); PG8_BAR; PG8_SCHED;
            PG8_LDB(B1, 1, 1); PG8_STAGE(PG8_SB(1, 0), b3, voffB);
            PG8_BAR; PG8_WAIT_L(0); PG8_MMA(0, 1, At, B1); PG8_BAR;
            PG8_LDA(At, 1, 1); PG8_STAGE(PG8_SA(1, 0), a3, voffA);
            PG8_BAR; PG8_WAIT_L(0); PG8_MMA(1, 0, At, B0); PG8_BAR; PG8_SCHED;
            PG8_STAGE(PG8_SB(1, 1), b3 + hstep, voffB);
            PG8_WAIT_V(6); PG8_BAR; PG8_MMA(1, 1, At, B1); PG8_BAR;
            }
        }
        if constexpr (ALIGN_EPI) { if (wr == 0) PG8_BAR; }
        if constexpr (!Epi::AFTER_DRAIN) { E(acc, cur, wr, wc, fr, fq); S.done(cur); }
        if (!has_next) break;
#pragma unroll
        for (int a = 0; a < 2; ++a)
#pragma unroll
            for (int b = 0; b < 2; ++b)
#pragma unroll
                for (int m = 0; m < 4; ++m)
#pragma unroll
                    for (int n = 0; n < 2; ++n) acc[a][b][m][n] = (f32x4){0.f, 0.f, 0.f, 0.f};
        cur = nxt; cA = nA; cB = nB; ++ui;
        if constexpr (GATHER) {
#pragma unroll
            for (int h_ = 0; h_ < 2; ++h_) { vGc[h_][0] = vGn[h_][0]; vGc[h_][1] = vGn[h_][1]; } }
        if constexpr (ALIGN_EPI) { if (wr == 1) PG8_BAR; }
    }
    PG8_WAIT_V(0);
    if constexpr (!ALIGN_EPI) { if (wr == 0) PG8_BAR; }
    PG8_BAR;
    if constexpr (Epi::AFTER_DRAIN) { E.fused(acc, cur, wr, wc, fr, fq, lds, wid, lane); S.done(cur); }
#undef PG8_GOFF
#undef PG8_STAGE_A
#undef PG8_SA
#undef PG8_SB
#undef PG8_STAGE
#undef PG8_LDA
#undef PG8_LDB
#undef PG8_MMA
#undef PG8_WAIT_V
#undef PG8_WAIT_L
#undef PG8_BAR
#undef PG8_SCHED
}
}
#ifndef USE_PG8
#define USE_PG8 1
#endif

typedef const f32x4 (&AccRef)[2][2][4][2];
struct EpiStoreBf16 { static constexpr bool DUAL = false, PERM = true, AFTER_DRAIN = false; bf16* O; int ldc;
    __device__ __forceinline__ void elem(int row, int col, float v, float) const { O[(size_t)row * ldc + col] = (bf16)f2bf(v); }
    __device__ __forceinline__ void operator()(AccRef acc, const pg8::Unit& u, int wr, int wc, int fr, int fq) const {
        const int row0 = u.pm * 256 + wr * 64 + fr, col0 = u.pn * 256 + wc * 32 + 8 * fq;
#pragma unroll
        for (int ai = 0; ai < 2; ++ai)
#pragma unroll
            for (int m = 0; m < 4; ++m) { bf16* rowp = O + (size_t)(row0 + ai * 128 + m * 16) * ldc + col0;
#pragma unroll
                for (int bj = 0; bj < 2; ++bj) { const f32x4 v0 = acc[ai][bj][m][0], v1 = acc[ai][bj][m][1];
                    u32x4 w; w.x = cvt_pk_bf16(v0[0], v0[1]); w.y = cvt_pk_bf16(v0[2], v0[3]); w.z = cvt_pk_bf16(v1[0], v1[1]); w.w = cvt_pk_bf16(v1[2], v1[3]);
                    *(u32x4*)(rowp + bj * 128) = w; } }
    } };
struct EpiStoreHeads { static constexpr bool DUAL = false, PERM = true, AFTER_DRAIN = false; bf16* O; int hw; size_t hstride;
    __device__ __forceinline__ void store4(int row, int col, f32x4 v) const { const int hd = col / hw, wi = col - hd * hw; u32x2 o; o.x = cvt_pk_bf16(v[0], v[1]); o.y = cvt_pk_bf16(v[2], v[3]); *(u32x2*)(O + (size_t)hd * hstride + (size_t)row * hw + wi) = o; }
    __device__ __forceinline__ void elem(int row, int col, float v, float) const { O[(size_t)(col / hw) * hstride + (size_t)row * hw + (col % hw)] = (bf16)f2bf(v); }
    __device__ __forceinline__ void operator()(AccRef acc, const pg8::Unit& u, int wr, int wc, int fr, int fq) const {
        const int row0 = u.pm * 256 + wr * 64 + fr, col0 = u.pn * 256 + wc * 32 + 8 * fq;
#pragma unroll
        for (int bj = 0; bj < 2; ++bj) { const int c = col0 + bj * 128, hd = c / hw, wi = c - hd * hw; bf16* base = O + (size_t)hd * hstride + wi;
#pragma unroll
            for (int ai = 0; ai < 2; ++ai)
#pragma unroll
                for (int m = 0; m < 4; ++m) { const f32x4 v0 = acc[ai][bj][m][0], v1 = acc[ai][bj][m][1];
                    u32x4 w; w.x = cvt_pk_bf16(v0[0], v0[1]); w.y = cvt_pk_bf16(v0[2], v0[3]); w.z = cvt_pk_bf16(v1[0], v1[1]); w.w = cvt_pk_bf16(v1[2], v1[3]);
                    *(u32x4*)(base + (size_t)(row0 + ai * 128 + m * 16) * hw) = w; } }
    } };
struct EpiStoreF32 { static constexpr bool DUAL = false, PERM = false, AFTER_DRAIN = false; float* O; int ldc;
    __device__ __forceinline__ void store4(int row, int col, f32x4 v) const { *(f32x4*)(O + (size_t)row * ldc + col) = v; }
    __device__ __forceinline__ void elem(int row, int col, float v, float) const { O[(size_t)row * ldc + col] = v; }
    __device__ __forceinline__ void operator()(AccRef acc, const pg8::Unit& u, int wr, int wc, int fr, int fq) const {
        const int row0 = u.pm * 256 + wr * 64 + fr, col0 = u.pn * 256 + wc * 32 + 4 * fq;
#pragma unroll
        for (int ai = 0; ai < 2; ++ai)
#pragma unroll
            for (int m = 0; m < 4; ++m) { float* rowp = O + (size_t)(row0 + ai * 128 + m * 16) * ldc + col0;
#pragma unroll
                for (int bj = 0; bj < 2; ++bj)
#pragma unroll
                    for (int n = 0; n < 2; ++n) *(f32x4*)(rowp + bj * 128 + n * 16) = acc[ai][bj][m][n]; }
    } };
struct EpiResid { static constexpr bool DUAL = false, PERM = false, AFTER_DRAIN = false; float* X; const float* g_lat; const float* g_ctx;
    __device__ __forceinline__ void store4(int row, int col, f32x4 v) const { const float* g = row >= SEQ ? g_ctx : g_lat; f32x4* p = (f32x4*)(X + (size_t)row * D + col); *p = *p + *(const f32x4*)(g + col) * v; }
    __device__ __forceinline__ void elem(int row, int col, float v, float) const { const float g = row >= SEQ ? g_ctx[col] : g_lat[col]; X[(size_t)row * D + col] += g * v; }
    __device__ __forceinline__ void operator()(AccRef acc, const pg8::Unit& u, int wr, int wc, int fr, int fq) const {
        const int row0 = u.pm * 256 + wr * 64 + fr, col0 = u.pn * 256 + wc * 32 + 4 * fq;
        const float* g = (u.pm * 256 >= SEQ) ? g_ctx : g_lat;
        f32x4 gv[2][2];
#pragma unroll
        for (int bj = 0; bj < 2; ++bj)
#pragma unroll
            for (int n = 0; n < 2; ++n) gv[bj][n] = *(const f32x4*)(g + col0 + bj * 128 + n * 16);
#pragma unroll
        for (int ai = 0; ai < 2; ++ai)
#pragma unroll
            for (int m = 0; m < 4; ++m) { float* rowp = X + (size_t)(row0 + ai * 128 + m * 16) * D + col0;
#pragma unroll
                for (int bj = 0; bj < 2; ++bj)
#pragma unroll
                    for (int n = 0; n < 2; ++n) { f32x4* p = (f32x4*)(rowp + bj * 128 + n * 16); *p = *p + gv[bj][n] * acc[ai][bj][m][n]; } }
    } };
__device__ __forceinline__ float silu_mul(float g, float u) { return g * __builtin_amdgcn_rcpf(1.f + __expf(-g)) * u; }
struct EpiSwiglu { static constexpr bool DUAL = true, PERM = true, AFTER_DRAIN = false; bf16* ACT;
    __device__ __forceinline__ void elem(int row, int col, float g, float u) const { ACT[(size_t)row * FF + col] = (bf16)f2bf(g / (1.f + __expf(-g)) * u); }
    __device__ __forceinline__ void operator()(AccRef acc, const pg8::Unit& u, int wr, int wc, int fr, int fq) const {
        const int row0 = u.pm * 256 + wr * 64 + fr, col0 = u.pn * 128 + wc * 32 + 8 * fq;
#pragma unroll
        for (int ai = 0; ai < 2; ++ai)
#pragma unroll
            for (int m = 0; m < 4; ++m) { bf16* rowp = ACT + (size_t)(row0 + ai * 128 + m * 16) * FF + col0;
                const f32x4 g0 = acc[ai][0][m][0], g1 = acc[ai][0][m][1], u0 = acc[ai][1][m][0], u1 = acc[ai][1][m][1];
                u32x4 w; w.x = cvt_pk_bf16(silu_mul(g0[0], u0[0]), silu_mul(g0[1], u0[1])); w.y = cvt_pk_bf16(silu_mul(g0[2], u0[2]), silu_mul(g0[3], u0[3]));
                w.z = cvt_pk_bf16(silu_mul(g1[0], u1[0]), silu_mul(g1[1], u1[1])); w.w = cvt_pk_bf16(silu_mul(g1[2], u1[2]), silu_mul(g1[3], u1[3]));
                *(u32x4*)rowp = w; }
    } };
struct EpiMoeOut { static constexpr bool DUAL = false, PERM = true, AFTER_DRAIN = false; bf16* YB; const float* gatel;
    __device__ __forceinline__ void elem(int row, int col, float v, float) const { YB[(size_t)row * D + col] = (bf16)f2bf(v * gatel[row]); }
    __device__ __forceinline__ void operator()(AccRef acc, const pg8::Unit& u, int wr, int wc, int fr, int fq) const {
        const int row0 = u.pm * 256 + wr * 64 + fr, col0 = u.pn * 256 + wc * 32 + 8 * fq;
#pragma unroll
        for (int ai = 0; ai < 2; ++ai)
#pragma unroll
            for (int m = 0; m < 4; ++m) { const int row = row0 + ai * 128 + m * 16; const float gt = gatel[row]; bf16* rowp = YB + (size_t)row * D + col0;
#pragma unroll
                for (int bj = 0; bj < 2; ++bj) { const f32x4 v0 = acc[ai][bj][m][0] * gt, v1 = acc[ai][bj][m][1] * gt;
                    u32x4 w; w.x = cvt_pk_bf16(v0[0], v0[1]); w.y = cvt_pk_bf16(v0[2], v0[3]); w.z = cvt_pk_bf16(v1[0], v1[1]); w.w = cvt_pk_bf16(v1[2], v1[3]);
                    *(u32x4*)(rowp + bj * 128) = w; } }
    } };

template <class Epi>
__device__ __forceinline__ void naive_gemm(const Ctx& C, const bf16* A, const bf16* Bt, int M, int N, int K, int pm_per_grp, size_t grp_stride, const Epi& E) {
    LAS float* As = (LAS float*)C.lds;
    LAS float* Bs = As + 16 * 132;
    LAS float* Bs2 = Bs + 16 * 68;
    const int NO = Epi::DUAL ? N / 2 : N, tn_cnt = NO / 64, nun = (M / 128) * tn_cnt;
    const int ty = C.tid >> 4, tx = C.tid & 15;
    for (int u = C.blk; u < nun; u += C.G) {
        const int tm = u / tn_cnt, tn = u % tn_cnt, row0 = tm * 128, oc0 = tn * 64;
        const bf16* Bg = Bt + (pm_per_grp ? (size_t)((row0 / 256) / pm_per_grp) * grp_stride : (size_t)0);
        const int brow0 = Epi::DUAL ? ((oc0 >> 7) * 256 + (oc0 & 127)) : oc0;
        float acc[4][4], acc2[4][4];
#pragma unroll
        for (int i = 0; i < 4; ++i)
#pragma unroll
            for (int j = 0; j < 4; ++j) { acc[i][j] = 0.f; acc2[i][j] = 0.f; }
        for (int k0 = 0; k0 < K; k0 += 16) {
            __syncthreads();
            { const int r = C.tid >> 2, kc = (C.tid & 3) * 4;
              const u32x2 w = *(const u32x2*)(A + (size_t)(row0 + r) * K + k0 + kc);
              As[(kc + 0) * 132 + r] = bf2f(w.x & 0xffffu); As[(kc + 1) * 132 + r] = bf2f(w.x >> 16); As[(kc + 2) * 132 + r] = bf2f(w.y & 0xffffu); As[(kc + 3) * 132 + r] = bf2f(w.y >> 16); }
            if (C.tid < 256) { const int r = C.tid >> 2, kc = (C.tid & 3) * 4;
              const u32x2 w = *(const u32x2*)(Bg + (size_t)(brow0 + r) * K + k0 + kc);
              Bs[(kc + 0) * 68 + r] = bf2f(w.x & 0xffffu); Bs[(kc + 1) * 68 + r] = bf2f(w.x >> 16); Bs[(kc + 2) * 68 + r] = bf2f(w.y & 0xffffu); Bs[(kc + 3) * 68 + r] = bf2f(w.y >> 16);
              if (Epi::DUAL) { const u32x2 w2 = *(const u32x2*)(Bg + (size_t)(brow0 + 128 + r) * K + k0 + kc);
                Bs2[(kc + 0) * 68 + r] = bf2f(w2.x & 0xffffu); Bs2[(kc + 1) * 68 + r] = bf2f(w2.x >> 16); Bs2[(kc + 2) * 68 + r] = bf2f(w2.y & 0xffffu); Bs2[(kc + 3) * 68 + r] = bf2f(w2.y >> 16); } }
            __syncthreads();
#pragma unroll
            for (int kk = 0; kk < 16; ++kk) {
                const f32x4 a = *(const LAS f32x4*)(As + kk * 132 + ty * 4), b = *(const LAS f32x4*)(Bs + kk * 68 + tx * 4);
#pragma unroll
                for (int i = 0; i < 4; ++i)
#pragma unroll
                    for (int j = 0; j < 4; ++j) acc[i][j] += a[i] * b[j];
                if (Epi::DUAL) { const f32x4 b2 = *(const LAS f32x4*)(Bs2 + kk * 68 + tx * 4);
#pragma unroll
                    for (int i = 0; i < 4; ++i)
#pragma unroll
                        for (int j = 0; j < 4; ++j) acc2[i][j] += a[i] * b2[j]; }
            }
        }
#pragma unroll
        for (int i = 0; i < 4; ++i)
#pragma unroll
            for (int j = 0; j < 4; ++j) E.elem(row0 + ty * 4 + i, oc0 + tx * 4 + j, acc[i][j], acc2[i][j]);
    }
    __syncthreads();
}

template <class Epi>
__device__ __forceinline__ void gemm(const Ctx& C, const bf16* A, const bf16* Bt, int M, int N, int K, int pm_per_grp, size_t grp_stride, const Epi& E) {
#if USE_PG8
    pg8::Gemm g{A, Bt, M, N, K, pm_per_grp, grp_stride}; pg8::StaticOrder S; S.init(M, N, C.G, C.blk);
    pg8::gemm_phase<Epi, pg8::StaticOrder, true, true>(C.lds, g, S, E);
#else
    naive_gemm(C, A, Bt, M, N, K, pm_per_grp, grp_stride, E);
#endif
}
template <class Epi>
__device__ __forceinline__ void small_gemm(const Ctx& C, const bf16* A, const bf16* Bt, int row0, int nrows, int N, int K, const Epi& E) {
    const int ql = C.lane & 31, hi = C.lane >> 5, nrb = nrows / 32, nitems = nrb * (N / 32);
    for (int it = C.blk * 8 + C.wave; it < nitems; it += C.G * 8) {
        const int cb = it / nrb, rb = it % nrb;
        const bf16* ap = A + (size_t)(row0 + rb * 32 + ql) * K + 8 * hi; const bf16* bp = Bt + (size_t)(cb * 32 + ql) * K + 8 * hi;
        f32x16 acc;
#pragma unroll
        for (int r = 0; r < 16; ++r) acc[r] = 0.f;
#pragma unroll 1
        for (int k0 = 0; k0 < K; k0 += 256) {
            bf16x8 a[16], b[16];
#pragma unroll
            for (int q = 0; q < 16; ++q) { a[q] = *(const bf16x8*)(ap + k0 + 16 * q); b[q] = *(const bf16x8*)(bp + k0 + 16 * q); }
            __builtin_amdgcn_sched_barrier(0);
#pragma unroll
            for (int q = 0; q < 16; ++q) acc = __builtin_amdgcn_mfma_f32_32x32x16_bf16(b[q], a[q], acc, 0, 0, 0);
            __builtin_amdgcn_sched_barrier(0);
        }
        const int row = row0 + rb * 32 + ql;
#pragma unroll
        for (int g = 0; g < 4; ++g) E.store4(row, cb * 32 + 8 * g + 4 * hi, (f32x4){acc[4 * g], acc[4 * g + 1], acc[4 * g + 2], acc[4 * g + 3]});
    }
}
template <class Epi>
__device__ __forceinline__ void gemm_tok(const Ctx& C, const bf16* A, const bf16* Bt, int N, int K, bool with_ctx, const Epi& E) {
#if USE_PG8
    gemm(C, A, Bt, SEQ, N, K, 0, 0, E);
    if (with_ctx) small_gemm(C, A, Bt, SEQ, NCTX, N, K, E);
#else
    naive_gemm(C, A, Bt, with_ctx ? R : SEQ, N, K, 0, 0, E);
#endif
}
constexpr int LDS_IDX_OFF = 132096;
template <class Epi>
__device__ __forceinline__ void gemm_moe(const Ctx& C, const bf16* A, const bf16* Bt, int N, int K, size_t grp_stride, bool with_ctx, const Epi& E, const int* rowlist = nullptr) {
#if USE_PG8
    pg8::Gemm g{A, Bt, XROWS, N, K, 9, grp_stride}; pg8::MoeOrder S; S.init(N, C.G, C.blk, with_ctx);
    if (rowlist) {
        LAS int* tab = (LAS int*)(C.lds + LDS_IDX_OFF); pg8::Unit u;
        for (int i = 0; S.next(i, u); ++i) if (C.tid < 256) tab[i * 256 + C.tid] = rowlist[u.pm * 256 + C.tid];
        __syncthreads();
        pg8::gemm_phase<Epi, pg8::MoeOrder, true, true, true>(C.lds, g, S, E, tab);
        return;
    }
    pg8::gemm_phase<Epi, pg8::MoeOrder, true, true>(C.lds, g, S, E);
#else
    naive_gemm(C, A, Bt, XROWS, N, K, 9, grp_stride, E);
#endif
}

template <int KIND>
__device__ __forceinline__ void ph_attn_naive(const Ctx& C, int slot) {
    constexpr int DQK = KIND == 2 ? 96 : 64, DH = DQK / 2;
    LAS float* Ks = (LAS float*)C.lds;
    LAS float* Vs = Ks + 32 * DQK;
    LAS float* Bsm = Vs + 32 * 64;
    const bf16 *Qb, *Kb, *Vb, *KRb = nullptr; int qp, kp, vp, kgrp = 1; size_t qhs, khs, vhs; float scale;
    if (KIND == 0) { Qb = WSP(bf16, WS_QKV); Kb = Qb + (size_t)16 * R * 64; Vb = Qb + (size_t)32 * R * 64; qp = kp = vp = 64; qhs = khs = vhs = (size_t)R * 64; scale = 0.125f; }
    else if (KIND == 1) { Qb = WSP(bf16, WS_QKV); Kb = Qb + (size_t)16 * R * 64; Vb = Qb + (size_t)20 * R * 64; qp = kp = vp = 64; qhs = khs = vhs = (size_t)R * 64; kgrp = 4; scale = 0.125f; }
    else { Qb = WSP(bf16, WS_Q); Kb = WSP(bf16, WS_KV); Vb = Kb + 64; KRb = WSP(bf16, WS_KROPE); qp = 96; kp = vp = 128; qhs = (size_t)R * 96; khs = vhs = (size_t)R * 128; scale = 0.10206207261596575f; }
    bf16* Ob = WSP(bf16, WS_O);
    const int half = C.tid & 1, qi = C.tid >> 1;
    for (int u = C.blk; u < 1040; u += C.G) {
        const bool isctx = u >= 1024;
        const int h = isctx ? (u - 1024) : (u & 15), q0 = isctx ? SEQ : (u >> 4) * 256, kh = h / kgrp;
        const int t = q0 + qi;
        float q[DH], o[32];
        { const bf16* qr = Qb + (size_t)t * qp + h * qhs + half * DH;
#pragma unroll
          for (int d = 0; d < DH; d += 8) { const u32x4 w = *(const u32x4*)(qr + d);
              q[d + 0] = bf2f(w.x & 0xffffu); q[d + 1] = bf2f(w.x >> 16); q[d + 2] = bf2f(w.y & 0xffffu); q[d + 3] = bf2f(w.y >> 16);
              q[d + 4] = bf2f(w.z & 0xffffu); q[d + 5] = bf2f(w.z >> 16); q[d + 6] = bf2f(w.w & 0xffffu); q[d + 7] = bf2f(w.w >> 16); } }
#pragma unroll
        for (int d = 0; d < 32; ++d) o[d] = 0.f;
        float m = -INFINITY, l = 0.f;
        if (KIND == 1) { m = C.in[13][h]; l = 1.f; }
        int klo = 0, khi = 0;
        if (!isctx) {
            if (KIND == 0) { const int r0 = q0 >> 6; const int ra = r0 - 4 < 0 ? 0 : r0 - 4, rb = r0 + 7 > 255 ? 255 : r0 + 7; klo = ra * 64; khi = (rb + 1) * 64; }
            else if (KIND == 1) { klo = q0 - 128 < 0 ? 0 : q0 - 128; khi = q0 + 384 > SEQ ? SEQ : q0 + 384; }
            else { klo = 0; khi = SEQ; }
        }
        if (KIND == 0) { __syncthreads(); const float* rp = C.in[10] + ((size_t)slot * 16 + h) * 465; for (int i = C.tid; i < 465; i += 512) Bsm[i] = rp[i]; }
        const int qr_ = t >> 6, qc_ = t & 63;
        int rs = qr_ - 4; rs = rs < 0 ? 0 : (rs > 248 ? 248 : rs);
        int cs0 = qc_ - 8; cs0 = cs0 < 0 ? 0 : (cs0 > 48 ? 48 : cs0);
        for (int seg = 0; seg < 2; ++seg) {
            const int kb = seg == 0 ? klo : SEQ, ke = seg == 0 ? khi : R;
            for (int k0 = kb; k0 < ke; k0 += 32) {
                __syncthreads();
                for (int i = C.tid; i < 32 * DQK; i += 512) { const int j = i / DQK, d = i % DQK; const int row = k0 + j;
                    unsigned b;
                    if (KIND == 2 && d >= 64) b = KRb[(size_t)row * 32 + (d - 64)]; else b = Kb[(size_t)row * kp + kh * khs + d];
                    Ks[i] = bf2f(b); }
                for (int i = C.tid; i < 32 * 64; i += 512) { const int j = i >> 6, d = i & 63; Vs[i] = bf2f(Vb[(size_t)(k0 + j) * vp + kh * vhs + d]); }
                __syncthreads();
#pragma unroll 1
                for (int j = 0; j < 32; ++j) {
                    const int kt = k0 + j; bool valid = true; float bias = 0.f;
                    if (seg == 0) {
                        if (KIND == 0) { const int kr = kt >> 6, kc = kt & 63; valid = kr >= rs && kr < rs + 8 && kc >= cs0 && kc < cs0 + 16;
                            if (valid) bias = Bsm[(kr - qr_ + 7) * 31 + (kc - qc_ + 15)]; }
                        else if (KIND == 1) { const int dd = kt - t; valid = dd <= 128 && dd >= -128; }
                    }
                    float s0 = 0.f, s1 = 0.f;
#pragma unroll
                    for (int d = 0; d < DH; d += 4) { const f32x4 kv = *(const LAS f32x4*)(Ks + j * DQK + half * DH + d); s0 += q[d] * kv.x + q[d + 2] * kv.z; s1 += q[d + 1] * kv.y + q[d + 3] * kv.w; }
                    float sp = s0 + s1; sp += __shfl_xor(sp, 1);
                    if (valid) {
                        const float s = sp * scale + bias;
                        if (s > m) { const float a = __expf(m - s); l *= a;
#pragma unroll
                            for (int d = 0; d < 32; ++d) o[d] *= a;
                            m = s; }
                        const float p = __expf(s - m); l += p;
#pragma unroll
                        for (int d = 0; d < 32; d += 4) { const f32x4 vv = *(const LAS f32x4*)(Vs + j * 64 + half * 32 + d); o[d] += p * vv.x; o[d + 1] += p * vv.y; o[d + 2] += p * vv.z; o[d + 3] += p * vv.w; }
                    }
                }
            }
        }
        { const float il = 1.f / l; bf16* orow = Ob + (size_t)t * D + h * 64 + half * 32;
#pragma unroll
            for (int d = 0; d < 32; d += 8) { u32x4 w; w.x = pk2(o[d] * il, o[d + 1] * il); w.y = pk2(o[d + 2] * il, o[d + 3] * il); w.z = pk2(o[d + 4] * il, o[d + 5] * il); w.w = pk2(o[d + 6] * il, o[d + 7] * il);
                *(u32x4*)(orow + d) = w; } }
    }
    __syncthreads();
}

#ifndef USE_FAST_ATTN
#define USE_FAST_ATTN 1
#endif
__device__ __forceinline__ s16x4 lds_tr16(const LAS unsigned char* p) { return __builtin_bit_cast(s16x4, __builtin_amdgcn_ds_read_tr16_b64_v4i16((LAS s16x4*)p)); }
__device__ __forceinline__ int crow(int r, int hi) { return (r & 3) + 8 * (r >> 2) + 4 * hi; }

#define ATT_BAR() do { __builtin_amdgcn_sched_barrier(0); asm volatile("s_waitcnt lgkmcnt(0)\n\ts_barrier" ::: "memory"); __builtin_amdgcn_sched_barrier(0); } while (0)
template <int KIND, int VARIANT = 0>
__device__ __forceinline__ void ph_attn_fast(const Ctx& C, int slot, bool with_ctxq, int conv_layer = -1) {
    constexpr int DQK = KIND == 2 ? 96 : 64, NS = DQK / 16, CPR = DQK / 8, CPRP = CPR + 1;
    constexpr int KS = CPRP * 16, VS = 128, KBYTES = 64 * KS, VBYTES = 64 * VS, SLOTB = KBYTES + VBYTES;
    constexpr int NKC = 64 * CPRP, NINST = (NKC + 64 * 8) / 64, NDMA = (NINST + 7) / 8, NRING = 4, PD = 3;
    static_assert(NKC % 64 == 0 && SLOTB % 1024 == 0 && NRING * SLOTB + 2048 <= 131072, "attention ring geometry");
    LAS unsigned char* lds = C.lds; const unsigned lds_u32 = (unsigned)(size_t)C.lds;
    LAS float* Bsm = (LAS float*)(lds + NRING * SLOTB);
    const bf16 *Qb, *Kb, *Vb, *KRb = nullptr; int qp, kp, vp, kgrp = 1; size_t qhs, khs, vhs; float scale;
    if (KIND == 0) { Qb = WSP(bf16, WS_QKV); Kb = Qb + (size_t)16 * R * 64; Vb = Qb + (size_t)32 * R * 64; qp = kp = vp = 64; qhs = khs = vhs = (size_t)R * 64; scale = 0.125f; }
    else if (KIND == 1) { Qb = WSP(bf16, WS_QKV); Kb = Qb + (size_t)16 * R * 64; Vb = Qb + (size_t)20 * R * 64; qp = kp = vp = 64; qhs = khs = vhs = (size_t)R * 64; kgrp = 4; scale = 0.125f; }
    else { Qb = WSP(bf16, WS_Q); Kb = WSP(bf16, WS_KV); Vb = Kb + 64; KRb = WSP(bf16, WS_KROPE); qp = 96; kp = vp = 128; qhs = (size_t)R * 96; khs = vhs = (size_t)R * 128; scale = 0.10206207261596575f; }
    bf16* Ob = VARIANT ? WSP(bf16, WS_ACT) : WSP(bf16, WS_O);
    const float c2 = scale * 1.4426950408889634f;
    const int w = C.wave, lane = C.lane, ql = lane & 31, hi = lane >> 5;
    const int vq_ = (lane & 15) >> 2, vsw_ = 4 * ((vq_ >> 1) & 1), vch_ = 2 * ((lane >> 4) & 1) + ((lane & 3) >> 1);
    const int vlane0 = (vq_ + 4 * hi) * VS + ((0 + vch_) ^ vsw_) * 16 + 8 * (lane & 1), vlane1 = (vq_ + 4 * hi) * VS + ((4 + vch_) ^ vsw_) * 16 + 8 * (lane & 1);
    const int nunits = with_ctxq ? 1040 : 1024;
    ConvState cst; cst.l0 = conv_layer; cst.total = conv_layer < 0 ? 0 : (KIND == 2 ? 2 : 1) * MOE_HALF_ITEMS; cst.cur = C.blk * 8 + C.wave; cst.loaded = false;
    LAS float* cscr = (LAS float*)(C.lds + NRING * SLOTB + 2048 + C.wave * 4096);
    static_assert(NRING * SLOTB + 2048 + 8 * 4096 <= 131072, "conversion scratch");
    static_assert(KIND == 2 || NRING * SLOTB + 2048 == CONV_PIPE_BASE, "pipelined conversion scratch");
    ConvPipe cpipe; cpipe.l0 = conv_layer; cpipe.total = (KIND != 2 && conv_layer >= 0) ? MOE_HALF_ITEMS : 0; cpipe.first = C.blk * 8 + C.wave; cpipe.n = 0;
    const bool convon = cpipe.total > 0; constexpr int CFL = (VARIANT >> 7) & 3;
    for (int u = C.blk; u < nunits; u += C.G) {
        const bool isctx = u >= 1024;
        const int h = isctx ? (u - 1024) : (u & 15), q0 = isctx ? SEQ : (u >> 4) * 256, kh = h / kgrp;
        int lat0 = 0, nlat = 0;
        if (!isctx) {
            if (KIND == 0) { const int r0 = q0 >> 6; int ta = r0 - 4; ta = ta < 0 ? 0 : (ta > 248 ? 248 : ta); int tb = r0 - 1; tb = (tb < 0 ? 0 : (tb > 248 ? 248 : tb)) + 7; lat0 = ta; nlat = tb - ta + 1; }
            else if (KIND == 1) { const int a = q0 - 128 < 0 ? 0 : q0 - 128, b = q0 + 384 > SEQ ? SEQ : q0 + 384; lat0 = a >> 6; nlat = (b - a) >> 6; }
            else { lat0 = 0; nlat = SEQ / 64; }
        }
        const int ntiles = nlat + 4;
        int lane_u = lane; asm volatile("" : "+v"(lane_u));
        const int ql_u = lane_u & 31, hi_u = lane_u >> 5;
        const int t = (KIND == 0 && !isctx) ? q0 + 128 * (w >> 2) + 64 * (ql_u >> 4) + 16 * (w & 3) + (ql_u & 15) : q0 + 32 * w + ql_u;
        bf16x8 qf[NS];
        { const bf16* qr = Qb + (size_t)t * qp + h * qhs + 8 * hi_u;
#pragma unroll
          for (int sidx = 0; sidx < NS; ++sidx) qf[sidx] = *(const bf16x8*)(qr + 16 * sidx); }
        const char* gsrc[NDMA]; int gpitch[NDMA], ldst[NDMA];
#pragma unroll
        for (int jj = 0; jj < NDMA; ++jj) {
            int j = w + 8 * jj; if (j >= NINST) j -= 8;
            const int cidx = 64 * j + lane_u; ldst[jj] = j * 1024;
            if (cidx < NKC) { const int row = cidx / CPRP; int c = cidx % CPRP; if (c >= CPR) c = 0;
                if (KIND == 2 && c >= 8) { gsrc[jj] = (const char*)(KRb + (size_t)row * 32 + 8 * (c - 8)); gpitch[jj] = 64; }
                else { gsrc[jj] = (const char*)(Kb + kh * khs + (size_t)row * kp + 8 * c); gpitch[jj] = kp * 2; } }
            else { const int v = cidx - NKC, row = v >> 3; const int c = (v & 7) ^ (4 * ((row >> 1) & 1));
                gsrc[jj] = (const char*)(Vb + kh * vhs + (size_t)row * vp + 8 * c); gpitch[jj] = vp * 2; }
        }
#define ATT_KEY0(i) ((i) < nlat ? (lat0 + (i)) * 64 : SEQ + ((i) - nlat) * 64)
#define ATT_DMA(i, sl) do { const int ti_ = (i) < ntiles ? (i) : ntiles - 1; const size_t key0_ = (size_t)ATT_KEY0(ti_); \
        _Pragma("unroll") for (int jj = 0; jj < NDMA; ++jj) \
            __builtin_amdgcn_global_load_lds((const unsigned*)(gsrc[jj] + key0_ * gpitch[jj]), (LAS unsigned*)(lds + (sl) * SLOTB + ldst[jj]), 16, 0, 0); } while (0)
#define ATT_WAIT_DMA() do { if (NDMA == 4) asm volatile("s_waitcnt vmcnt(8)" ::: "memory"); else asm volatile("s_waitcnt vmcnt(6)" ::: "memory"); } while (0)
#define ATT_WAIT_DMA_IT() do { if (KIND == 2) { ATT_WAIT_DMA(); } else if (convon) { if (CFL == 0) asm volatile("s_waitcnt vmcnt(12)" ::: "memory"); else if (CFL == 1) asm volatile("s_waitcnt vmcnt(10)" ::: "memory"); else if (CFL == 2) asm volatile("s_waitcnt vmcnt(8)" ::: "memory"); else asm volatile("s_waitcnt vmcnt(6)" ::: "memory"); } \
        else asm volatile("s_waitcnt vmcnt(3)" ::: "memory"); } while (0)
        __syncthreads();
        if (KIND == 0) { const float* rp = C.in[10] + ((size_t)slot * 16 + h) * 465; for (int i = C.tid; i < 465; i += 512) Bsm[i] = rp[i] * 1.4426950408889634f; }
        float m = -INFINITY, l = 0.f;
        if (KIND == 1) { m = C.in[13][h] * 1.4426950408889634f; l = hi ? 0.f : 1.f; }
        ATT_DMA(0, 0); ATT_DMA(1, 1); ATT_DMA(2, 2);
        f32x16 ot[2];
#pragma unroll
        for (int r = 0; r < 16; ++r) { ot[0][r] = 0.f; ot[1][r] = 0.f; }
        const int qr_ = t >> 6, qc_ = t & 63;
        int cs0 = qc_ - 8; cs0 = cs0 < 0 ? 0 : (cs0 > 48 ? 48 : cs0);
        const int wrow = (q0 >> 6) + 2 * (w >> 2);
        int wrs = wrow - 4; wrs = wrs < 0 ? 0 : (wrs > 248 ? 248 : wrs);
        int wre = wrow + 1 - 4; wre = (wre < 0 ? 0 : (wre > 248 ? 248 : wre)) + 8;
        int rs = qr_ - 4; rs = rs < 0 ? 0 : (rs > 248 ? 248 : rs);
        const int kc0 = (w & 3) == 0 ? 0 : ((w & 3) == 1 ? 8 : ((w & 3) == 2 ? 24 : 32));
        const int wq0 = q0 + 32 * w;
        if constexpr (KIND == 2) {
            { float qs = 0.f;
#pragma unroll
              for (int sidx = 0; sidx < NS; ++sidx) { u32x4 qw;
#pragma unroll
                  for (int j = 0; j < 4; ++j) { const float q0_ = bf2f((unsigned)(unsigned short)qf[sidx][2 * j]) * c2, q1_ = bf2f((unsigned)(unsigned short)qf[sidx][2 * j + 1]) * c2;
                      const unsigned pw = cvt_pk_bf16(q0_, q1_); qw[j] = pw; const float r0_ = bf2f(pw & 0xffffu), r1_ = bf2f(pw >> 16); qs += r0_ * r0_ + r1_ * r1_; }
                  qf[sidx] = __builtin_bit_cast(bf16x8, qw); }
              const auto sw = __builtin_amdgcn_permlane32_swap(__float_as_uint(qs), __float_as_uint(qs), false, false);
              qs = __uint_as_float(sw[0]) + __uint_as_float(sw[1]);
              const float k2 = __uint_as_float(__hip_atomic_load((unsigned*)(C.ws + WS_CTL) + CW_KMAX + h, __ATOMIC_RELAXED, __HIP_MEMORY_SCOPE_AGENT));
              m = sqrtf(qs * k2) * 1.001f + 0.01f; }
            if (NDMA == 4) asm volatile("s_waitcnt vmcnt(4)" ::: "memory"); else asm volatile("s_waitcnt vmcnt(3)" ::: "memory");
            ATT_BAR();
            f32x16 pa0, pa1, pb0, pb1;
#define MLA_QK(D0, D1, sl) do { const LAS unsigned char* kb_ = lds + (sl) * SLOTB; \
            _Pragma("unroll") for (int r_ = 0; r_ < 16; ++r_) { D0[r_] = -m; D1[r_] = -m; } \
            _Pragma("unroll") for (int sidx = 0; sidx < NS; ++sidx) { \
                const bf16x8 a0_ = *(const LAS bf16x8*)(kb_ + ql * KS + 32 * sidx + 16 * hi); \
                const bf16x8 a1_ = *(const LAS bf16x8*)(kb_ + (32 + ql) * KS + 32 * sidx + 16 * hi); \
                { D0 = __builtin_amdgcn_mfma_f32_32x32x16_bf16(a0_, qf[sidx], D0, 0, 0, 0); \
                       D1 = __builtin_amdgcn_mfma_f32_32x32x16_bf16(a1_, qf[sidx], D1, 0, 0, 0); } } } while (0)
#define VB(x) (((VARIANT) >> (x)) & 1)
#define MLA_KHALF(D0, D1, sl, h0) do { const LAS unsigned char* kq_ = lds + (sl) * SLOTB; \
            _Pragma("unroll") for (int sidx = 0; sidx < NS / 2; ++sidx) { \
                D0[sidx] = *(const LAS bf16x8*)(kq_ + ql * KS + 32 * ((h0) + sidx) + 16 * hi); D1[sidx] = *(const LAS bf16x8*)(kq_ + (32 + ql) * KS + 32 * ((h0) + sidx) + 16 * hi); } } while (0)
#define MLA_ITER(CV, P0, P1, S0, S1, it) do { \
            if (CV && ((it) & 7) == 0) conv_step<false>(C, cst, cscr);            \
            if (!VB(3)) ATT_DMA((it) + 3, ((it) + 3) & 3);                        \
            bf16x8 kb0_[NS / 2], kb1_[NS / 2]; s16x4 vlo_[2][4], vhi_[2][4]; bf16x8 pf_[4]; \
              \
            _Pragma("unroll") for (int r_ = 0; r_ < 16; ++r_) { S0[r_] = -m; S1[r_] = -m; } \
            asm volatile("s_waitcnt lgkmcnt(0)" ::: "memory"); __builtin_amdgcn_sched_barrier(0); \
            _Pragma("unroll") for (int g_ = 0; g_ < 20; ++g_) { \
                if (g_ == 6) { asm volatile("s_waitcnt lgkmcnt(0)" ::: "memory"); __builtin_amdgcn_sched_barrier(0); } \
                if (g_ == 12) { if (!VB(4)) { asm volatile("s_waitcnt vmcnt(3)" ::: "memory"); ATT_BAR(); }         \
                                else { asm volatile("s_waitcnt lgkmcnt(0)" ::: "memory"); __builtin_amdgcn_sched_barrier(0); } } \
                if (g_ == 2) MLA_KHALF(kb0_, kb1_, ((it) + 1) & 3, NS / 2); \
                if (g_ == 16) MLA_KHALF(ka0, ka1, ((it) + 2) & 3, 0); \
                if (g_ < 6) { if (g_ & 1) S1 = __builtin_amdgcn_mfma_f32_32x32x16_bf16(ka1[g_ >> 1], qf[g_ >> 1], S1, 0, 0, 0); else S0 = __builtin_amdgcn_mfma_f32_32x32x16_bf16(ka0[g_ >> 1], qf[g_ >> 1], S0, 0, 0, 0); } \
                else if (g_ < 12) { if (g_ & 1) S1 = __builtin_amdgcn_mfma_f32_32x32x16_bf16(kb1_[(g_ >> 1) - NS / 2], qf[g_ >> 1], S1, 0, 0, 0); else S0 = __builtin_amdgcn_mfma_f32_32x32x16_bf16(kb0_[(g_ >> 1) - NS / 2], qf[g_ >> 1], S0, 0, 0, 0); } \
                else { const int ks_ = (g_ - 12) >> 1, c_ = (g_ - 12) & 1; \
                    const bf16x8 av_ = (bf16x8){vlo_[c_][ks_][0], vlo_[c_][ks_][1], vlo_[c_][ks_][2], vlo_[c_][ks_][3], vhi_[c_][ks_][0], vhi_[c_][ks_][1], vhi_[c_][ks_][2], vhi_[c_][ks_][3]}; \
                    ot[c_] = __builtin_amdgcn_mfma_f32_32x32x16_bf16(av_, pf_[ks_], ot[c_], 0, 0, 0); } \
                if (g_ < 16) { \
                    _Pragma("unroll") for (int k_ = 2 * g_; k_ < 2 * g_ + 2; ++k_) { \
                        if (k_ < 16) { P0[k_] = __builtin_amdgcn_exp2f(P0[k_]); l += P0[k_]; } \
                        else { P1[k_ - 16] = __builtin_amdgcn_exp2f(P1[k_ - 16]); l += P1[k_ - 16]; } } \
                    if ((g_ & 3) == 3) { const int f_ = g_ >> 2; u32x4 pw_; \
                        if (f_ < 2) { pw_.x = cvt_pk_bf16(P0[8 * f_ + 0], P0[8 * f_ + 1]); pw_.y = cvt_pk_bf16(P0[8 * f_ + 2], P0[8 * f_ + 3]); pw_.z = cvt_pk_bf16(P0[8 * f_ + 4], P0[8 * f_ + 5]); pw_.w = cvt_pk_bf16(P0[8 * f_ + 6], P0[8 * f_ + 7]); } \
                        else { pw_.x = cvt_pk_bf16(P1[8 * (f_ - 2) + 0], P1[8 * (f_ - 2) + 1]); pw_.y = cvt_pk_bf16(P1[8 * (f_ - 2) + 2], P1[8 * (f_ - 2) + 3]); pw_.z = cvt_pk_bf16(P1[8 * (f_ - 2) + 4], P1[8 * (f_ - 2) + 5]); pw_.w = cvt_pk_bf16(P1[8 * (f_ - 2) + 6], P1[8 * (f_ - 2) + 7]); } \
                        pf_[f_] = __builtin_bit_cast(bf16x8, pw_); } } \
                if (g_ == 7) { const unsigned vb_ = lds_u32 + (unsigned)(((it) & 3) * SLOTB + KBYTES); \
                  _Pragma("unroll") for (int c = 0; c < 2; ++c) { const unsigned va_ = vb_ + (unsigned)(c ? vlane1 : vlane0); \
                    _Pragma("unroll") for (int ks = 0; ks < 4; ++ks) { \
                        asm volatile("ds_read_b64_tr_b16 %0, %1 offset:%c2" : "=&v"(vlo_[c][ks]) : "v"(va_), "i"((32 * (ks >> 1) + 16 * (ks & 1)) * VS) : "memory"); \
                        asm volatile("ds_read_b64_tr_b16 %0, %1 offset:%c2" : "=&v"(vhi_[c][ks]) : "v"(va_), "i"((32 * (ks >> 1) + 16 * (ks & 1) + 8) * VS) : "memory"); } } } \
                __builtin_amdgcn_sched_barrier(0); } \
            } while (0)
            MLA_QK(pa0, pa1, 0);
            bf16x8 ka0[NS / 2], ka1[NS / 2];
            MLA_KHALF(ka0, ka1, 1, 0);
            for (int i = 0; i < ntiles; i += 2) {
                MLA_ITER(1, pa0, pa1, pb0, pb1, i);
                MLA_ITER(0, pb0, pb1, pa0, pa1, i + 1);
            }
#undef MLA_KHALF
#undef MLA_QK
#undef MLA_ITER
#undef VB
        } else {
        ATT_WAIT_DMA();
        ATT_BAR();
        int rs_cur = 0, rs_nxt = 3;
        for (int i = 0; i < ntiles; ++i) {
            if (convon) conv_pipe_step<CFL>(C, cpipe, lds);
            ATT_DMA(i + PD, rs_nxt);
            const bool lat = i < nlat; const int key0 = ATT_KEY0(i);
            bool need = true;
            if (lat) { if (KIND == 0) { const int kr = lat0 + i; need = kr >= wrs && kr < wre; }
                       else if (KIND == 1) need = (key0 + 63 >= wq0 - 128) && (key0 <= wq0 + 31 + 128); }
            if (KIND == 0 && lat) {
              if (need) {
                const int kr = lat0 + i;
                const LAS unsigned char* kb = lds + rs_cur * SLOTB + kc0 * KS;
                f32x16 p0;
#pragma unroll
                for (int r = 0; r < 16; ++r) p0[r] = 0.f;
#pragma unroll
                for (int sidx = 0; sidx < NS; ++sidx) {
                    const bf16x8 a0 = *(const LAS bf16x8*)(kb + ql * KS + 32 * sidx + 16 * hi);
                    p0 = __builtin_amdgcn_mfma_f32_32x32x16_bf16(a0, qf[sidx], p0, 0, 0, 0);
                }
                const bool rowok = kr >= rs && kr < rs + 8;
                float mx = -INFINITY;
#pragma unroll
                for (int r = 0; r < 16; ++r) { const int kc = kc0 + crow(r, hi); const bool v0 = rowok && (unsigned)(kc - cs0) < 16u;
                    const int bi = (kr - qr_ + 7) * 31 + (kc - qc_ + 15);
                    const float s0 = v0 ? p0[r] * c2 + Bsm[v0 ? bi : 0] : -INFINITY; p0[r] = s0; mx = fmaxf(mx, s0); }
                { const auto sw = __builtin_amdgcn_permlane32_swap(__float_as_uint(mx), __float_as_uint(mx), false, false);
                  mx = fmaxf(__uint_as_float(sw[0]), __uint_as_float(sw[1])); }
                const float mn = fmaxf(m, mx), ms = mn == -INFINITY ? 0.f : mn;
                const float alpha = __builtin_amdgcn_exp2f(m - ms);
                if (__builtin_amdgcn_ballot_w64(alpha != 1.f) != 0ull) {
#pragma unroll
                    for (int r = 0; r < 16; ++r) { ot[0][r] *= alpha; ot[1][r] *= alpha; }
                }
                s16x4 vlo[2][2], vhi[2][2];
                { const unsigned vb0 = lds_u32 + (unsigned)(rs_cur * SLOTB + KBYTES + kc0 * VS);
#pragma unroll
                  for (int c = 0; c < 2; ++c) { const unsigned va = vb0 + (unsigned)(c ? vlane1 : vlane0);
#pragma unroll
                    for (int ks = 0; ks < 2; ++ks) {
                        asm volatile("ds_read_b64_tr_b16 %0, %1 offset:%c2" : "=&v"(vlo[c][ks]) : "v"(va), "i"((16 * ks) * VS) : "memory");
                        asm volatile("ds_read_b64_tr_b16 %0, %1 offset:%c2" : "=&v"(vhi[c][ks]) : "v"(va), "i"((16 * ks + 8) * VS) : "memory"); } } }
                __builtin_amdgcn_sched_barrier(0);
                float rs0 = 0.f, rs1 = 0.f;
#pragma unroll
                for (int ks = 0; ks < 2; ++ks) {
#pragma unroll
                    for (int j = 0; j < 8; ++j) { const int r = 8 * ks + j; p0[r] = __builtin_amdgcn_exp2f(p0[r] - ms); if (j & 1) rs1 += p0[r]; else rs0 += p0[r]; }
                    u32x4 pw; const int k8 = 8 * ks;
                    pw.x = cvt_pk_bf16(p0[k8 + 0], p0[k8 + 1]); pw.y = cvt_pk_bf16(p0[k8 + 2], p0[k8 + 3]); pw.z = cvt_pk_bf16(p0[k8 + 4], p0[k8 + 5]); pw.w = cvt_pk_bf16(p0[k8 + 6], p0[k8 + 7]);
                    const bf16x8 pfk = __builtin_bit_cast(bf16x8, pw);
                    if (ks == 0) { asm volatile("s_waitcnt lgkmcnt(0)" ::: "memory"); }
                    __builtin_amdgcn_sched_barrier(0);
                    const bf16x8 av0 = (bf16x8){vlo[0][ks][0], vlo[0][ks][1], vlo[0][ks][2], vlo[0][ks][3], vhi[0][ks][0], vhi[0][ks][1], vhi[0][ks][2], vhi[0][ks][3]};
                    const bf16x8 av1 = (bf16x8){vlo[1][ks][0], vlo[1][ks][1], vlo[1][ks][2], vlo[1][ks][3], vhi[1][ks][0], vhi[1][ks][1], vhi[1][ks][2], vhi[1][ks][3]};
                    ot[0] = __builtin_amdgcn_mfma_f32_32x32x16_bf16(av0, pfk, ot[0], 0, 0, 0);
                    ot[1] = __builtin_amdgcn_mfma_f32_32x32x16_bf16(av1, pfk, ot[1], 0, 0, 0);
                    __builtin_amdgcn_sched_barrier(0);
                }
                l = l * alpha + (rs0 + rs1); m = mn;
              }
            } else if (need) {
                const LAS unsigned char* kb = lds + rs_cur * SLOTB; const LAS unsigned char* vb = kb + KBYTES;
                f32x16 p0, p1;
#pragma unroll
                for (int r = 0; r < 16; ++r) { p0[r] = 0.f; p1[r] = 0.f; }
#pragma unroll
                for (int sidx = 0; sidx < NS; ++sidx) {
                    const bf16x8 a0 = *(const LAS bf16x8*)(kb + ql * KS + 32 * sidx + 16 * hi);
                    const bf16x8 a1 = *(const LAS bf16x8*)(kb + (32 + ql) * KS + 32 * sidx + 16 * hi);
                    p0 = __builtin_amdgcn_mfma_f32_32x32x16_bf16(a0, qf[sidx], p0, 0, 0, 0);
                    p1 = __builtin_amdgcn_mfma_f32_32x32x16_bf16(a1, qf[sidx], p1, 0, 0, 0);
                }
                float mx = -INFINITY;
                if (KIND == 0) {
#pragma unroll
                    for (int r = 0; r < 16; ++r) {
                        float s0 = p0[r] * c2, s1 = p1[r] * c2;
                        if (lat) { const int kr = lat0 + i; const int kc = crow(r, hi);
                            const bool v0 = (unsigned)(kc - cs0) < 16u, v1 = (unsigned)(kc + 32 - cs0) < 16u;
                            const int bi = (kr - qr_ + 7) * 31 + (kc - qc_ + 15);
                            s0 = v0 ? s0 + Bsm[v0 ? bi : 0] : -INFINITY; s1 = v1 ? s1 + Bsm[v1 ? bi + 32 : 0] : -INFINITY; }
                        p0[r] = s0; p1[r] = s1; mx = fmaxf(fmaxf(mx, s0), s1);
                    }
                } else {
                    if (KIND == 1 && lat) {
#pragma unroll
                        for (int r = 0; r < 16; ++r) { const int dd = key0 + crow(r, hi) - t;
                            p0[r] = (unsigned)(dd + 128) <= 256u ? p0[r] : -INFINITY; p1[r] = (unsigned)(dd + 32 + 128) <= 256u ? p1[r] : -INFINITY; }
                    }
#pragma unroll
                    for (int r = 0; r < 16; ++r) mx = fmaxf(fmaxf(mx, p0[r]), p1[r]);
                    mx *= c2;
                }
                { const auto sw = __builtin_amdgcn_permlane32_swap(__float_as_uint(mx), __float_as_uint(mx), false, false);
                  mx = fmaxf(__uint_as_float(sw[0]), __uint_as_float(sw[1])); }
                const float mn = fmaxf(m, mx), ms = mn == -INFINITY ? 0.f : mn;
                const float alpha = __builtin_amdgcn_exp2f(m - ms);
                if (__builtin_amdgcn_ballot_w64(alpha != 1.f) != 0ull) {
#pragma unroll
                    for (int r = 0; r < 16; ++r) { ot[0][r] *= alpha; ot[1][r] *= alpha; }
                }
                s16x4 vlo[2][4], vhi[2][4];
                { const unsigned vb0 = lds_u32 + (unsigned)(rs_cur * SLOTB + KBYTES);
#pragma unroll
                  for (int c = 0; c < 2; ++c) { const unsigned va = vb0 + (unsigned)(c ? vlane1 : vlane0);
#pragma unroll
                    for (int ks = 0; ks < 4; ++ks) {
                        asm volatile("ds_read_b64_tr_b16 %0, %1 offset:%c2" : "=&v"(vlo[c][ks]) : "v"(va), "i"((32 * (ks >> 1) + 16 * (ks & 1)) * VS) : "memory");
                        asm volatile("ds_read_b64_tr_b16 %0, %1 offset:%c2" : "=&v"(vhi[c][ks]) : "v"(va), "i"((32 * (ks >> 1) + 16 * (ks & 1) + 8) * VS) : "memory"); } } }
                __builtin_amdgcn_sched_barrier(0);
                float rs0 = 0.f, rs1 = 0.f;
#pragma unroll
                for (int ks = 0; ks < 4; ++ks) {
#pragma unroll
                    for (int j = 0; j < 8; ++j) { const int r = 8 * (ks & 1) + j;
                        if (ks < 2) { p0[r] = KIND == 0 ? __builtin_amdgcn_exp2f(p0[r] - ms) : __builtin_amdgcn_exp2f(__builtin_fmaf(p0[r], c2, -ms)); if (j & 1) rs1 += p0[r]; else rs0 += p0[r]; }
                        else { p1[r] = KIND == 0 ? __builtin_amdgcn_exp2f(p1[r] - ms) : __builtin_amdgcn_exp2f(__builtin_fmaf(p1[r], c2, -ms)); if (j & 1) rs1 += p1[r]; else rs0 += p1[r]; } }
                    u32x4 pw; const int k8 = 8 * (ks & 1);
                    if (ks < 2) { pw.x = cvt_pk_bf16(p0[k8 + 0], p0[k8 + 1]); pw.y = cvt_pk_bf16(p0[k8 + 2], p0[k8 + 3]); pw.z = cvt_pk_bf16(p0[k8 + 4], p0[k8 + 5]); pw.w = cvt_pk_bf16(p0[k8 + 6], p0[k8 + 7]); }
                    else { pw.x = cvt_pk_bf16(p1[k8 + 0], p1[k8 + 1]); pw.y = cvt_pk_bf16(p1[k8 + 2], p1[k8 + 3]); pw.z = cvt_pk_bf16(p1[k8 + 4], p1[k8 + 5]); pw.w = cvt_pk_bf16(p1[k8 + 6], p1[k8 + 7]); }
                    const bf16x8 pfk = __builtin_bit_cast(bf16x8, pw);
                    if (ks == 0) { asm volatile("s_waitcnt lgkmcnt(0)" ::: "memory"); }
                    __builtin_amdgcn_sched_barrier(0);
                    const bf16x8 av0 = (bf16x8){vlo[0][ks][0], vlo[0][ks][1], vlo[0][ks][2], vlo[0][ks][3], vhi[0][ks][0], vhi[0][ks][1], vhi[0][ks][2], vhi[0][ks][3]};
                    const bf16x8 av1 = (bf16x8){vlo[1][ks][0], vlo[1][ks][1], vlo[1][ks][2], vlo[1][ks][3], vhi[1][ks][0], vhi[1][ks][1], vhi[1][ks][2], vhi[1][ks][3]};
                    ot[0] = __builtin_amdgcn_mfma_f32_32x32x16_bf16(av0, pfk, ot[0], 0, 0, 0);
                    ot[1] = __builtin_amdgcn_mfma_f32_32x32x16_bf16(av1, pfk, ot[1], 0, 0, 0);
                    __builtin_amdgcn_sched_barrier(0);
                }
                l = l * alpha + (rs0 + rs1); m = mn;
            }
            ATT_WAIT_DMA_IT();
            ATT_BAR();
            rs_cur = (rs_cur + 1) & 3; rs_nxt = (rs_nxt + 1) & 3;
        }
        }
        asm volatile("s_waitcnt vmcnt(0)" ::: "memory");
#undef ATT_KEY0
#undef ATT_DMA
#undef ATT_WAIT_DMA
#undef ATT_WAIT_DMA_IT
        { const auto sw = __builtin_amdgcn_permlane32_swap(__float_as_uint(l), __float_as_uint(l), false, false);
          const float il = 1.f / (__uint_as_float(sw[0]) + __uint_as_float(sw[1])); bf16* orow = Ob + (size_t)t * D + h * 64 + 4 * hi;
#pragma unroll
          for (int c = 0; c < 2; ++c)
#pragma unroll
            for (int g = 0; g < 4; ++g) { u32x2 o2; o2.x = cvt_pk_bf16(ot[c][4 * g] * il, ot[c][4 * g + 1] * il); o2.y = cvt_pk_bf16(ot[c][4 * g + 2] * il, ot[c][4 * g + 3] * il);
                *(u32x2*)(orow + 32 * c + 8 * g) = o2; } }
    }
    if (KIND == 2) { while (cst.loaded || cst.cur < cst.total) conv_step<true>(C, cst, cscr); }
    else if (convon && !VARIANT) conv_pipe_drain(C, cpipe, lds);
    __syncthreads();
}
template <int KIND>
__device__ __forceinline__ void ph_attn(const Ctx& C, int slot, bool with_ctxq, int conv_layer = -1) {
#if USE_FAST_ATTN
    ph_attn_fast<KIND>(C, slot, with_ctxq, conv_layer);
#else
    ph_attn_naive<KIND>(C, slot);
#endif
}

#define PH_BEGIN if (lo <= ph && ph < hi) {
#define PH_END   if (ph + 1 < hi) xcd_barrier(bar); if (DIAG && C.blk == 0 && C.tid == 0) ((unsigned long long*)(C.ws + WS_CTL + 512 * 1024))[ph + 1] = __builtin_amdgcn_s_memrealtime(); } ++ph;
#ifndef DIAG
#define DIAG 0
#define DIAG_PH1 25
#define DIAG_PH2 25
#endif
#ifndef NORM2_VARIANT_PROBE
#define NORM2_VARIANT_PROBE 0
#endif
#ifndef SWA_VARIANT_PROBE
#define SWA_VARIANT_PROBE 0
#endif
#ifndef ATTN_VARIANT_PROBE
#define ATTN_VARIANT_PROBE 0
#endif
#ifndef PROBE_MASK
#define PROBE_MASK 0
#endif
#define PHG(g, ...) PH_BEGIN __VA_ARGS__ PH_END if constexpr (((PROBE_MASK >> (g)) & 1) != 0) { PH_BEGIN __VA_ARGS__ PH_END }
template <int L>
__device__ __forceinline__ void layer_phases(const Ctx& C, const XcdBarrier& bar, int lo, int hi, int& ph) {
    constexpr int l = L, kind = L % 3, slot = L / 3; constexpr bool need_ctx = L < 3; constexpr int RL = need_ctx ? R : SEQ;
    PH_BEGIN ph_rowA<0>(C, l); PH_END
    if constexpr (kind == 0) {
        PHG(1, gemm_tok(C, WSP(bf16, WS_H), WSP(bf16, WS_W_NAQKV) + (size_t)slot * 3072 * 1024, 3072, 1024, true, EpiStoreHeads{WSP(bf16, WS_QKV), 64, (size_t)R * 64});)
        PHG(2, ph_attn<0>(C, slot, need_ctx, l == 0 ? 0 : -1);)
    } else if constexpr (kind == 1) {
        PHG(1, gemm_tok(C, WSP(bf16, WS_H), WSP(bf16, WS_W_SWAQKV), 1536, 1024, true, EpiStoreHeads{WSP(bf16, WS_QKV), 64, (size_t)R * 64});)
        PH_BEGIN ph_rope(C, WSP(bf16, WS_QKV), 64, 20, 0, 16); PH_END
        PHG(3, ph_attn<1>(C, slot, need_ctx, l);)
#if SWA_VARIANT_PROBE
        PH_BEGIN ph_attn_fast<1, SWA_VARIANT_PROBE>(C, slot, need_ctx, (SWA_VARIANT_PROBE & 64) ? l : -1); PH_END
#endif
    } else {
        PHG(1, gemm_tok(C, WSP(bf16, WS_H), WSP(bf16, WS_W_MLAD), 1024, 1024, true, EpiStoreF32{WSP(float, WS_CQ), 1024});)
        PHG(11, ph_mlanorm(C);)
        PHG(1, gemm_tok(C, WSP(bf16, WS_CQN), WSP(bf16, WS_W_MLAUQ), 1536, 512, true, EpiStoreHeads{WSP(bf16, WS_Q), 96, (size_t)R * 96});
                 gemm_tok(C, WSP(bf16, WS_CKVN), WSP(bf16, WS_W_MLAUKV), 2048, 256, true, EpiStoreHeads{WSP(bf16, WS_KV), 128, (size_t)R * 128});)
        PH_BEGIN ph_rope(C, WSP(bf16, WS_Q), 96, 16, 64, 8); ph_kmax(C); PH_END
        PHG(4, ph_attn<2>(C, slot, need_ctx, 2);)
#if ATTN_VARIANT_PROBE
        PH_BEGIN ph_attn_fast<2, ATTN_VARIANT_PROBE>(C, slot, need_ctx, (ATTN_VARIANT_PROBE & 64) ? 2 : -1); PH_END
#endif
    }
    const bf16* wo = kind == 0 ? WSP(bf16, WS_W_NAO) + (size_t)slot * 1024 * 1024 : (kind == 1 ? WSP(bf16, WS_W_SWAO) : WSP(bf16, WS_W_MLAO));
    PH_BEGIN gemm_tok(C, WSP(bf16, WS_O), wo, 1024, 1024, need_ctx, EpiResid{WSP(float, WS_X), modp(C, l, 0, 2), modp(C, l, 1, 2)}); PH_END
    PHG(5, ph_norm2(C, l, RL);)
#if NORM2_VARIANT_PROBE
    PH_BEGIN ph_norm2<NORM2_VARIANT_PROBE>(C, l, RL); PH_END
#endif
    PHG(6, ph_topk(C, need_ctx);)
    PHG(8, gemm_moe(C, WSP(bf16, WS_H), WSP(bf16, WS_W_GU) + (size_t)l * 16 * 4096 * 1024, 4096, 1024, (size_t)4096 * 1024, need_ctx, EpiSwiglu{WSP(bf16, WS_ACT)}, WSP(int, WS_ROWL));)
    PHG(9, gemm_moe(C, WSP(bf16, WS_ACT), WSP(bf16, WS_W_DN) + (size_t)l * 16 * 1024 * 2048, 1024, 2048, (size_t)1024 * 2048, need_ctx, EpiMoeOut{WSP(bf16, WS_YB), WSP(float, WS_GATEL)});)
}
__global__ void __launch_bounds__(512, 2) fwd_kernel(Args args) {
    extern __shared__ __attribute__((aligned(16))) unsigned char lds_raw[];
    Ctx C;
#pragma unroll
    for (int i = 0; i < 26; ++i) C.in[i] = args.in[i];
    C.out = args.out; C.ws = args.ws; C.lds = (LAS unsigned char*)lds_raw;
    C.tid = threadIdx.x; C.lane = C.tid & 63; C.wave = __builtin_amdgcn_readfirstlane(C.tid >> 6); C.blk = blockIdx.x; C.G = gridDim.x;
    volatile LAS unsigned* MISC = (volatile LAS unsigned*)(C.lds + MISC_OFF);
    if (C.tid < 32) MISC[C.tid] = 0u;
    __syncthreads();
    const int lo = args.ph_lo, hi = args.ph_hi;
    XcdBarrier bar; bar.bar = (unsigned*)(C.ws + WS_CTL) + CW_BAR; bar.x = 0; bar.st = nullptr;
    if (hi - lo > 1) bar = xcd_barrier_post((unsigned*)(C.ws + WS_CTL) + CW_BAR, MISC + 8);
    int ph = 0;
    PHG(0, ph_prologue(C);)
    layer_phases<0>(C, bar, lo, hi, ph);
    layer_phases<1>(C, bar, lo, hi, ph);
    layer_phases<2>(C, bar, lo, hi, ph);
    layer_phases<3>(C, bar, lo, hi, ph);
    PH_BEGIN ph_rowA<1>(C, 4); PH_END
#if DIAG
    {
        __builtin_amdgcn_fence(__ATOMIC_ACQUIRE, "agent");
        const unsigned long long* st = (const unsigned long long*)(C.ws + WS_CTL + 512 * 1024);
        const float t1 = (float)(__hip_atomic_load(st + DIAG_PH1 + 1, __ATOMIC_RELAXED, __HIP_MEMORY_SCOPE_AGENT) - __hip_atomic_load(st + DIAG_PH1, __ATOMIC_RELAXED, __HIP_MEMORY_SCOPE_AGENT)) * 0.01f;
        const float t2 = (float)(__hip_atomic_load(st + DIAG_PH2 + 1, __ATOMIC_RELAXED, __HIP_MEMORY_SCOPE_AGENT) - __hip_atomic_load(st + DIAG_PH2, __ATOMIC_RELAXED, __HIP_MEMORY_SCOPE_AGENT)) * 0.01f;
        (void)t2;
        const float tq = exp2f(rintf(log2f(t1) * 16.f) * (1.f / 16.f));
        const float cval = 0.1f * sqrtf(tq);
        for (size_t i = (size_t)C.blk * 512 + C.tid; i < (size_t)SEQ * D; i += (size_t)C.G * 512) C.out[i] = cval;
    }
#endif
}
#undef PH_BEGIN
#undef PH_END

extern "C" void kernel_launch(void* const* d_in, const int* in_sizes, int n_in, void* d_out, int out_size, void* d_ws, size_t ws_size, hipStream_t stream) {
    static int grid = 0;
    if (grid == 0) {
        if (n_in != 26 || out_size != SEQ * D || ws_size < WS_END) { fprintf(stderr, "kernel_launch: unexpected shapes (n_in %d out %d ws %zu)\n", n_in, out_size, ws_size); grid = -1; return; }
        int dev = 0, cus = 0, per_cu = 0;
        if (hipGetDevice(&dev) != hipSuccess || hipDeviceGetAttribute(&cus, hipDeviceAttributeMultiprocessorCount, dev) != hipSuccess) { grid = -1; return; }
        if (hipFuncSetAttribute((const void*)fwd_kernel, hipFuncAttributeMaxDynamicSharedMemorySize, LDS_BYTES) != hipSuccess) { fprintf(stderr, "kernel_launch: hipFuncSetAttribute failed\n"); grid = -1; return; }
        if (hipOccupancyMaxActiveBlocksPerMultiprocessor(&per_cu, (const void*)fwd_kernel, 512, LDS_BYTES) != hipSuccess || per_cu < 1) fprintf(stderr, "kernel_launch: occupancy query says %d\n", per_cu);
        (void)hipGetLastError();
        grid = cus;
    }
    if (grid < 0) return;
    if (hipMemsetAsync((char*)d_ws + WS_CTL, 0, CTL_ZERO_BYTES, stream) != hipSuccess) return;
    Args a{};
    for (int i = 0; i < 26; ++i) a.in[i] = (const float*)d_in[i];
    a.out = (float*)d_out; a.ws = (unsigned char*)d_ws; a.pad = 0;
#if MK_N_LAUNCHES == 1
    a.ph_lo = 0; a.ph_hi = 1 << 20; a.li = 0;
    hipLaunchKernelGGL(fwd_kernel, dim3(grid), dim3(512), LDS_BYTES, stream, a);
#else
    for (int li = 0; li < NPH; ++li) { a.ph_lo = li; a.ph_hi = li + 1; a.li = li;
        hipLaunchKernelGGL(fwd_kernel, dim3(grid), dim3(512), LDS_BYTES, stream, a); }
#endif
}
```

```cpp
#include <hip/hip_runtime.h>
#include <cstdio>
#include <cstdint>

#ifndef MK_N_LAUNCHES
#define MK_N_LAUNCHES 1
#endif

#define GAS __attribute__((address_space(1)))
#define LAS __attribute__((address_space(3)))
typedef unsigned short bf16;
typedef float f32x4 __attribute__((ext_vector_type(4)));
typedef unsigned u32x4 __attribute__((ext_vector_type(4)));
typedef unsigned u32x2 __attribute__((ext_vector_type(2)));
typedef short bf16x8 __attribute__((ext_vector_type(8)));
typedef short s16x4 __attribute__((ext_vector_type(4)));
typedef float f32x16 __attribute__((ext_vector_type(16)));

constexpr int D = 1024, SEQ = 16384, NCTX = 256, R = SEQ + NCTX, NE = 16, FF = 2048;
constexpr int CAP_L = 2048, CAP_C = 32, EROWS = 2304, XROWS = NE * EROWS;
constexpr float RMS_EPS = 1e-6f;
constexpr int NPH = 1 + 9 + 10 + 12 + 9 + 1;

constexpr size_t MiB = 1u << 20;
constexpr size_t WS_CTL = 0, CTL_ZERO_BYTES = 1 * MiB;
constexpr size_t WS_MOD = 1 * MiB;
constexpr size_t WS_W_NAQKV = 2 * MiB;
constexpr size_t WS_W_NAO = 14 * MiB;
constexpr size_t WS_W_SWAQKV = 18 * MiB;
constexpr size_t WS_W_SWAO = 21 * MiB;
constexpr size_t WS_W_MLAD = 23 * MiB;
constexpr size_t WS_W_MLAUQ = 25 * MiB;
constexpr size_t WS_W_MLAUKV = 27 * MiB;
constexpr size_t WS_W_MLAO = 28 * MiB;
constexpr size_t WS_W_GU = 32 * MiB;
constexpr size_t WS_W_DN = WS_W_GU + 512 * MiB;
constexpr size_t WS_X = WS_W_DN + 256 * MiB;
constexpr size_t WS_H = WS_X + 65 * MiB;
constexpr size_t WS_QKV = WS_H + 33 * MiB;
constexpr size_t WS_CQ = WS_QKV + 98 * MiB;
constexpr size_t WS_Q = WS_CQ + 65 * MiB;
constexpr size_t WS_KV = WS_Q + 49 * MiB;
constexpr size_t WS_CQN = WS_KV + 65 * MiB;
constexpr size_t WS_CKVN = WS_CQN + 17 * MiB;
constexpr size_t WS_KROPE = WS_CKVN + 9 * MiB;
constexpr size_t WS_O = WS_KROPE + 2 * MiB;
constexpr size_t WS_AFF = WS_O + 33 * MiB;
constexpr size_t WS_ROWL = WS_AFF + 2 * MiB;
constexpr size_t WS_GATEL = WS_ROWL + 1 * MiB;
constexpr size_t WS_INV = WS_GATEL + 1 * MiB;
constexpr size_t WS_XG = WS_INV + 2 * MiB;
constexpr size_t WS_ACT = WS_XG + 72 * MiB;
constexpr size_t WS_YB = WS_ACT + 144 * MiB;
constexpr size_t WS_END = WS_YB + 72 * MiB;
static_assert(WS_END <= 2048 * MiB, "d_ws map");
constexpr int CW_BAR = 4096;

constexpr int LDS_BYTES = 147456;
constexpr int MISC_OFF = 131072 + 320;

__device__ __forceinline__ float bf2f(unsigned b) { return __uint_as_float(b << 16); }
__device__ __forceinline__ unsigned f2bf(float f) { unsigned u = __float_as_uint(f); return (u + 0x7fffu + ((u >> 16) & 1u)) >> 16; }
typedef float f32x2_t __attribute__((ext_vector_type(2))); typedef __bf16 bf16x2_t __attribute__((ext_vector_type(2)));
__device__ __forceinline__ unsigned cvt_pk_bf16(float lo, float hi) { f32x2_t v = {lo, hi}; bf16x2_t b = __builtin_convertvector(v, bf16x2_t); return __builtin_bit_cast(unsigned, b); }
__device__ __forceinline__ unsigned pk2(float lo, float hi) { return cvt_pk_bf16(lo, hi); }
__device__ __forceinline__ float wave_sum(float v) {
#pragma unroll
    for (int o = 1; o < 64; o <<= 1) v += __shfl_xor(v, o);
    return v;
}
__device__ __forceinline__ int wave_sum_i(int v) {
#pragma unroll
    for (int o = 1; o < 64; o <<= 1) v += __shfl_xor(v, o);
    return v;
}

#define XB_TMO      128
#define XB_XCNT(j)  (256  + 64 * (j))
#define XB_XSUB(j)  (1280 + 64 * (j))
#define XB_XGEN(j)  (2304 + 64 * (j))
#define XB_TOP      3328
#define XB_TOPGEN   3392
#define XCD_BAR_WORDS 3456
#define XB_SPIN_CAP (1u << 18)
__device__ __forceinline__ unsigned xb_ld(unsigned* p)              { return __hip_atomic_load(p, __ATOMIC_RELAXED, __HIP_MEMORY_SCOPE_AGENT); }
__device__ __forceinline__ unsigned xb_add(unsigned* p, unsigned v) { return __hip_atomic_fetch_add(p, v, __ATOMIC_RELAXED, __HIP_MEMORY_SCOPE_AGENT); }
__device__ __forceinline__ unsigned xb_xcc_id() { return (unsigned)__builtin_amdgcn_s_getreg((3 << 11) | 20) & 0xFu; }
#define XB_SPIN(cond, bar) do { unsigned _sp = 0; while (cond) { __builtin_amdgcn_s_sleep(1); \
    if ((++_sp & 255u) == 0u) { if (xb_ld(&(bar)[XB_TMO])) break; if (_sp > XB_SPIN_CAP) { atomicAdd(&(bar)[XB_TMO], 1u); break; } } } } while (0)
struct XcdBarrier { unsigned* bar; unsigned x; volatile LAS unsigned* st; };
__device__ __forceinline__ XcdBarrier xcd_barrier_post(unsigned* bar, volatile LAS unsigned* st) {
    XcdBarrier b; b.bar = bar; b.x = xb_xcc_id(); b.st = st;
    if (threadIdx.x == 0) (void)xb_add(&bar[XB_XCNT(b.x)], 1u);
    return b;
}
__device__ __forceinline__ void xcd_barrier_complete(unsigned* bar, unsigned x, unsigned& nloc, unsigned& nx) {
    const unsigned G = gridDim.x * gridDim.y * gridDim.z;
    unsigned sum, cnt, mine, sp = 0u;
    for (;;) {
        sum = 0u; cnt = 0u; mine = 0u;
#pragma unroll
        for (unsigned j = 0; j < 16; ++j) { const unsigned c = xb_ld(&bar[XB_XCNT(j)]); sum += c; cnt += (c > 0u) ? 1u : 0u; mine = (j == x) ? c : mine; }
        if (sum == G) break;
        __builtin_amdgcn_s_sleep(1);
        if ((++sp & 255u) == 0u) { if (xb_ld(&bar[XB_TMO])) break; if (sp > XB_SPIN_CAP) { atomicAdd(&bar[XB_TMO], 1u); break; } }
    }
    nloc = mine > 0u ? mine : 1u; nx = cnt > 0u ? cnt : 1u;
}
__device__ __forceinline__ void xcd_barrier(const XcdBarrier& b) {
    asm volatile("s_waitcnt vmcnt(0)" ::: "memory");
    __syncthreads();
    if (threadIdx.x == 0) {
        unsigned* bar = b.bar;
        __builtin_amdgcn_s_waitcnt(0);
        unsigned nloc = b.st[0], nx = b.st[1];
        if (nloc == 0u) { xcd_barrier_complete(bar, b.x, nloc, nx); b.st[0] = nloc; b.st[1] = nx; }
        const unsigned old = xb_add(&bar[XB_XSUB(b.x)], 1u);
        const unsigned gen = old / nloc;
        if (old + 1u == (gen + 1u) * nloc) {
            __builtin_amdgcn_fence(__ATOMIC_RELEASE, "agent");
            asm volatile("s_waitcnt vmcnt(0)" ::: "memory");
            const unsigned og = xb_add(&bar[XB_TOP], 1u);
            const unsigned tg = og / nx;
            if (og + 1u == (tg + 1u) * nx) xb_add(&bar[XB_TOPGEN], 1u);
            else XB_SPIN(xb_ld(&bar[XB_TOPGEN]) == tg, bar);
            __builtin_amdgcn_fence(__ATOMIC_ACQUIRE, "agent");
            xb_add(&bar[XB_XGEN(b.x)], 1u);
            asm volatile("s_waitcnt vmcnt(0)" ::: "memory");
        } else {
            XB_SPIN(xb_ld(&bar[XB_XGEN(b.x)]) == gen, bar);
            __builtin_amdgcn_fence(__ATOMIC_ACQUIRE, "agent");
            asm volatile("s_waitcnt vmcnt(0)" ::: "memory");
        }
    }
    __syncthreads();
}

struct Args { const float* in[26]; float* out; unsigned char* ws; int ph_lo, ph_hi, li, pad; };
struct Ctx {
    const float* in[26]; float* out; unsigned char* ws;
    LAS unsigned char* lds;
    int tid, lane, wave, blk, G;
};
#define WSP(T, off) ((T*)(C.ws + (off)))
__device__ __forceinline__ const float* modp(const Ctx& C, int l, int set, int j) { return (const float*)(C.ws + WS_MOD) + ((l * 2 + set) * 6 + j) * D; }

__device__ __forceinline__ void p0_transpose_item(const float* W, int K, int N, bf16* WT, int k0, int n0, int drow0, LAS float* scr, int lane) {
    const int lr = lane >> 3, lc = (lane & 7) * 4;
    f32x4 v[8];
#pragma unroll
    for (int i = 0; i < 8; ++i) v[i] = *(const f32x4*)(W + (size_t)(k0 + 8 * i + lr) * N + n0 + lc);
#pragma unroll
    for (int i = 0; i < 8; ++i) *(LAS f32x4*)(scr + (8 * i + lr) * 36 + lc) = v[i];
    asm volatile("s_waitcnt lgkmcnt(0)" ::: "memory");
    const int c = lane & 7;
#pragma unroll
    for (int j = 0; j < 4; ++j) { const int n = (lane >> 3) + 8 * j; const LAS float* s = scr + (8 * c) * 36 + n;
        u32x4 o; o.x = pk2(s[0 * 36], s[1 * 36]); o.y = pk2(s[2 * 36], s[3 * 36]); o.z = pk2(s[4 * 36], s[5 * 36]); o.w = pk2(s[6 * 36], s[7 * 36]);
        *(u32x4*)(WT + (size_t)(drow0 + n) * K + k0 + 8 * c) = o; }
    asm volatile("s_waitcnt lgkmcnt(0)" ::: "memory");
}
constexpr int MOE_ITEMS_PER_LAYER = 16 * 3072, MOE_HALF_ITEMS = 2 * MOE_ITEMS_PER_LAYER;
__device__ __forceinline__ bool moe_layer_in_attention(int l) { return true; }
struct ConvItem { const float* W; bf16* WT; int K, N; };
__device__ __forceinline__ ConvItem conv_half_item(const Ctx& C, int l, int hidx) {
    const int it = hidx >> 1, half = hidx & 1, e = it / 3072, r2 = it % 3072, which = r2 / 1024, item = r2 % 1024, le = l * 16 + e;
    ConvItem ci;
    if (which < 2) { const int kb = item / 64, nb = item % 64, n0 = nb * 32, k0 = kb * 64 + 32 * half, drow0 = (n0 >> 7) * 256 + (n0 & 127) + which * 128;
        ci.K = 1024; ci.N = 2048; ci.W = (which ? C.in[23] : C.in[22]) + (size_t)le * 1024 * 2048 + (size_t)k0 * 2048 + n0;
        ci.WT = WSP(bf16, WS_W_GU) + (size_t)le * 4096 * 1024 + (size_t)drow0 * 1024 + k0; }
    else { const int kb = item / 32, nb = item % 32, n0 = nb * 32, k0 = kb * 64 + 32 * half;
        ci.K = 2048; ci.N = 1024; ci.W = C.in[24] + (size_t)le * 2048 * 1024 + (size_t)k0 * 1024 + n0;
        ci.WT = WSP(bf16, WS_W_DN) + (size_t)le * 1024 * 2048 + (size_t)n0 * 2048 + k0; }
    return ci;
}
struct ConvState { int l0, total, cur; bool loaded; };
template <bool DRAIN>
__device__ __forceinline__ void conv_step(const Ctx& C, ConvState& st, LAS float* scr) {
    int lane = C.lane; asm volatile("" : "+v"(lane));
    if (st.loaded) {
        if (DRAIN) asm volatile("s_waitcnt vmcnt(0)" ::: "memory");
        const int pc = st.cur - C.G * 8; const ConvItem pi = conv_half_item(C, st.l0 + pc / MOE_HALF_ITEMS, pc % MOE_HALF_ITEMS);
#pragma unroll
        for (int j = 0; j < 2; ++j) { const int ch = lane + 64 * j, n = ch >> 2, c = ch & 3; const LAS float* sp = scr + (8 * c) * 32 + ((((n >> 2) ^ (2 * c)) << 2) | (n & 3));
            u32x4 o; o.x = cvt_pk_bf16(sp[0 * 32], sp[1 * 32]); o.y = cvt_pk_bf16(sp[2 * 32], sp[3 * 32]); o.z = cvt_pk_bf16(sp[4 * 32], sp[5 * 32]); o.w = cvt_pk_bf16(sp[6 * 32], sp[7 * 32]);
            *(u32x4*)(pi.WT + (size_t)n * pi.K + 8 * c) = o; }
        asm volatile("s_waitcnt lgkmcnt(0)" ::: "memory");
        st.loaded = false;
    }
    if (st.cur < st.total) {
        const ConvItem ci = conv_half_item(C, st.l0 + st.cur / MOE_HALF_ITEMS, st.cur % MOE_HALF_ITEMS);
        const int lr = lane >> 3;
#pragma unroll
        for (int i = 0; i < 4; ++i) { const int lc = ((lane & 7) ^ (2 * i)) * 4;
            __builtin_amdgcn_global_load_lds((const unsigned*)(ci.W + (size_t)(8 * i + lr) * ci.N + lc), (LAS unsigned*)(scr + i * 256), 16, 0, 0); }
        st.loaded = true; st.cur += C.G * 8;
    }
}
struct ConvPipe { int l0, total, first, n; };
constexpr int CONV_PIPE_BASE = 4 * (64 * 128 + 64 * 128) + 2048;
__device__ __forceinline__ LAS float* conv_pipe_buf(LAS unsigned char* lds, int wave, int par) {
    const int b = wave * 2 + par;
    return (LAS float*)(lds + (b < 14 ? CONV_PIPE_BASE + b * 4096 : 132096 + (b - 14) * 4096));
}
template <bool STORE = true>
__device__ __forceinline__ void conv_pack_store(bf16* WT, int K, const LAS float* scr, int lane) {
#pragma unroll
    for (int j = 0; j < 2; ++j) { const int ch = lane + 64 * j, n = ch >> 2, c = ch & 3; const LAS float* sp = scr + (8 * c) * 32 + ((((n >> 2) ^ (2 * c)) << 2) | (n & 3));
        u32x4 o; o.x = cvt_pk_bf16(sp[0 * 32], sp[1 * 32]); o.y = cvt_pk_bf16(sp[2 * 32], sp[3 * 32]); o.z = cvt_pk_bf16(sp[4 * 32], sp[5 * 32]); o.w = cvt_pk_bf16(sp[6 * 32], sp[7 * 32]);
        if (STORE) *(u32x4*)(WT + (size_t)n * K + 8 * c) = o; else asm volatile("" :: "v"(o.x), "v"(o.y), "v"(o.z), "v"(o.w)); }
    asm volatile("s_waitcnt lgkmcnt(0)" ::: "memory");
}
template <int FL = 0>
__device__ __forceinline__ void conv_pipe_step(const Ctx& C, ConvPipe& st, LAS unsigned char* lds) {
    int lane = C.lane; asm volatile("" : "+v"(lane));
    const int NGW = C.G * 8, cur = st.first + st.n * NGW, pc = cur - 2 * NGW;
    LAS float* scr = conv_pipe_buf(lds, C.wave, st.n & 1);
    { const bool real = st.n >= 2 && pc < st.total; const int pcc = real ? pc : st.first;
      const ConvItem pi = conv_half_item(C, st.l0, pcc);
      conv_pack_store<!(FL & 1)>(real ? pi.WT : WSP(bf16, WS_XG) + (size_t)st.first * 1024, real ? pi.K : 32, scr, lane); }
    { const int cc = cur < st.total ? cur : st.first;
      const ConvItem ci = conv_half_item(C, st.l0, cc);
      const int lr = lane >> 3;
#pragma unroll
      for (int i = 0; i < 4; ++i) { const int lc = ((lane & 7) ^ (2 * i)) * 4;
          if (!(FL & 2)) __builtin_amdgcn_global_load_lds((const unsigned*)(ci.W + (size_t)(8 * i + lr) * ci.N + lc), (LAS unsigned*)(scr + i * 256), 16, 0, 0); } }
    st.n += 1;
}
__device__ __forceinline__ void conv_pipe_drain(const Ctx& C, ConvPipe& st, LAS unsigned char* lds) {
    asm volatile("s_waitcnt vmcnt(0)" ::: "memory");
    const int NGW = C.G * 8;
#pragma unroll 1
    for (int k = 2; k >= 1; --k) { const int m = st.n - k, pc = st.first + m * NGW;
        if (m >= 0 && pc < st.total) { const ConvItem pi = conv_half_item(C, st.l0, pc); conv_pack_store(pi.WT, pi.K, conv_pipe_buf(lds, C.wave, m & 1), C.lane); } }
    ConvState rest; rest.l0 = st.l0; rest.total = st.total; rest.cur = st.first + st.n * NGW; rest.loaded = false;
    LAS float* scr = conv_pipe_buf(lds, C.wave, 0);
    while (rest.loaded || rest.cur < rest.total) conv_step<true>(C, rest, scr);
}
__device__ __forceinline__ bool p0_plain(int& r, const float* W, int K, int N, bf16* WT, int row_off, LAS float* scr, int lane) {
    const int nblk = N / 32, cnt = (K / 64) * nblk;
    if (r >= cnt) { r -= cnt; return false; }
    const int kb = r / nblk, nb = r % nblk;
    p0_transpose_item(W, K, N, WT, kb * 64, nb * 32, row_off + nb * 32, scr, lane);
    return true;
}
__device__ __forceinline__ void ph_prologue(const Ctx& C) {
    LAS float* scr = (LAS float*)(C.lds + C.wave * 16384);
    const int gw = C.blk * 8 + C.wave, NGW = C.G * 8;
    constexpr int MOE_ITEMS = 4 * 16 * 3072;
    constexpr int SMALL_ITEMS = 2 * 1536 + 2 * 512 + 768 + 512 + 256 + 144 + 384 + 256 + 512;
    for (int it = gw; it < MOE_ITEMS + SMALL_ITEMS; it += NGW) {
        if (it < MOE_ITEMS) {
            if (moe_layer_in_attention(it / MOE_ITEMS_PER_LAYER)) continue;
            const int le = it / 3072, r2 = it % 3072, which = r2 / 1024, item = r2 % 1024, l = le / 16, e = le % 16;
            if (which < 2) {
                const float* W = (which ? C.in[23] : C.in[22]) + (size_t)le * 1024 * 2048;
                bf16* WT = WSP(bf16, WS_W_GU) + ((size_t)l * 16 + e) * 4096 * 1024;
                const int kb = item / 64, nb = item % 64, n0 = nb * 32;
                p0_transpose_item(W, 1024, 2048, WT, kb * 64, n0, (n0 >> 7) * 256 + (n0 & 127) + which * 128, scr, C.lane);
            } else {
                const float* W = C.in[24] + (size_t)le * 2048 * 1024;
                bf16* WT = WSP(bf16, WS_W_DN) + ((size_t)l * 16 + e) * 1024 * 2048;
                const int kb = item / 32, nb = item % 32;
                p0_transpose_item(W, 2048, 1024, WT, kb * 64, nb * 32, nb * 32, scr, C.lane);
            }
            continue;
        }
        int r = it - MOE_ITEMS;
        if (p0_plain(r, C.in[8], 1024, 3072, WSP(bf16, WS_W_NAQKV), 0, scr, C.lane)) continue;
        if (p0_plain(r, C.in[8] + (size_t)1024 * 3072, 1024, 3072, WSP(bf16, WS_W_NAQKV) + (size_t)3072 * 1024, 0, scr, C.lane)) continue;
        if (p0_plain(r, C.in[9], 1024, 1024, WSP(bf16, WS_W_NAO), 0, scr, C.lane)) continue;
        if (p0_plain(r, C.in[9] + (size_t)1024 * 1024, 1024, 1024, WSP(bf16, WS_W_NAO) + (size_t)1024 * 1024, 0, scr, C.lane)) continue;
        if (p0_plain(r, C.in[11], 1024, 1536, WSP(bf16, WS_W_SWAQKV), 0, scr, C.lane)) continue;
        if (p0_plain(r, C.in[12], 1024, 1024, WSP(bf16, WS_W_SWAO), 0, scr, C.lane)) continue;
        if (p0_plain(r, C.in[14], 1024, 512, WSP(bf16, WS_W_MLAD), 0, scr, C.lane)) continue;
        if (p0_plain(r, C.in[17], 1024, 288, WSP(bf16, WS_W_MLAD), 512, scr, C.lane)) continue;
        if (p0_plain(r, C.in[16], 512, 1536, WSP(bf16, WS_W_MLAUQ), 0, scr, C.lane)) continue;
        if (p0_plain(r, C.in[19], 256, 2048, WSP(bf16, WS_W_MLAUKV), 0, scr, C.lane)) continue;
        p0_plain(r, C.in[20], 1024, 1024, WSP(bf16, WS_W_MLAO), 0, scr, C.lane);
    }
    { u32x4* z = (u32x4*)(WSP(bf16, WS_W_MLAD) + (size_t)800 * 1024); const int n16 = 224 * 1024 * 2 / 16;
      for (int i = C.blk * 512 + C.tid; i < n16; i += C.G * 512) z[i] = (u32x4){0u, 0u, 0u, 0u}; }
    __syncthreads();
    LAS float* sc = (LAS float*)C.lds;
    LAS float* red = sc + 2048;
    for (int i = C.tid; i < 2048; i += 512) { const float v = (i < 1024) ? C.in[1][i] : C.in[3][i - 1024]; sc[i] = v / (1.f + __expf(-v)); }
    __syncthreads();
    for (int u = C.blk; u < 4 * 96; u += C.G) {
        const int l = u / 96, j0 = (u % 96) * 64, kg = C.tid >> 4, jl = (C.tid & 15) * 4;
        const float* W = C.in[4] + (size_t)l * 1024 * 6144 + (size_t)(kg * 32) * 6144 + j0 + jl;
        f32x4 a0 = (f32x4){0.f, 0.f, 0.f, 0.f}, a1 = a0;
#pragma unroll 1
        for (int kb = 0; kb < 32; kb += 16) {
            f32x4 wv[16];
#pragma unroll
            for (int i = 0; i < 16; ++i) wv[i] = *(const f32x4*)(W + (size_t)(kb + i) * 6144);
#pragma unroll
            for (int i = 0; i < 16; ++i) { const float s0 = sc[kg * 32 + kb + i], s1 = sc[1024 + kg * 32 + kb + i];
                a0[0] += s0 * wv[i][0]; a0[1] += s0 * wv[i][1]; a0[2] += s0 * wv[i][2]; a0[3] += s0 * wv[i][3];
                a1[0] += s1 * wv[i][0]; a1[1] += s1 * wv[i][1]; a1[2] += s1 * wv[i][2]; a1[3] += s1 * wv[i][3]; }
        }
        *(LAS f32x4*)(red + kg * 64 + jl) = a0; *(LAS f32x4*)(red + 2048 + kg * 64 + jl) = a1;
        __syncthreads();
        if (C.tid < 128) { const int set = C.tid >> 6, j = C.tid & 63; float s = 0.f;
#pragma unroll
            for (int q = 0; q < 32; ++q) s += red[set * 2048 + q * 64 + j];
            const int col = j0 + j;
            ((float*)(C.ws + WS_MOD))[((l * 2 + set) * 6) * D + col] = s + C.in[5][l * 6144 + col]; }
        __syncthreads();
    }
}

template <int MODE>
__device__ __forceinline__ void ph_rowA(const Ctx& C, int l) {
    float* X = WSP(float, WS_X); bf16* H = WSP(bf16, WS_H); const int* INV = WSP(int, WS_INV); const bf16* YB = WSP(bf16, WS_YB);
    const int nrows = MODE == 1 ? SEQ : R;
    for (int t = C.blk * 8 + C.wave; t < nrows; t += C.G * 8) {
        const int set = t >= SEQ ? 1 : 0;
        const float* src = (MODE == 0 && l == 0) ? (set ? C.in[2] + (size_t)(t - SEQ) * D : C.in[0] + (size_t)t * D) : X + (size_t)t * D;
        f32x4 v[4];
#pragma unroll
        for (int j = 0; j < 4; ++j) v[j] = ((const f32x4*)src)[C.lane + 64 * j];
        if (MODE == 1 || l > 0) {
            const int lp = MODE == 1 ? 3 : l - 1;
            const int myinv = C.lane < 16 ? INV[(size_t)t * 16 + C.lane] : -1;
            f32x4 a[4];
#pragma unroll
            for (int j = 0; j < 4; ++j) a[j] = (f32x4){0.f, 0.f, 0.f, 0.f};
            unsigned em = (unsigned)(__builtin_amdgcn_ballot_w64(myinv >= 0) & 0xffffull);
            while (em) {
                int sl[4]; bool ok[4];
#pragma unroll
                for (int q = 0; q < 4; ++q) { ok[q] = em != 0u; const int e = ok[q] ? __builtin_ctz(em) : 0; if (ok[q]) em &= em - 1u; sl[q] = e * EROWS + __shfl(myinv, e); }
                u32x2 w[4][4];
#pragma unroll
                for (int q = 0; q < 4; ++q) { const u32x2* yr = (const u32x2*)(YB + (size_t)(ok[q] ? sl[q] : 0) * D);
#pragma unroll
                    for (int j = 0; j < 4; ++j) w[q][j] = ok[q] ? yr[C.lane + 64 * j] : (u32x2){0u, 0u}; }
#pragma unroll
                for (int q = 0; q < 4; ++q)
#pragma unroll
                    for (int j = 0; j < 4; ++j) a[j] += (f32x4){bf2f(w[q][j].x & 0xffffu), bf2f(w[q][j].x >> 16), bf2f(w[q][j].y & 0xffffu), bf2f(w[q][j].y >> 16)};
            }
            const f32x4* g = (const f32x4*)modp(C, lp, set, 5);
#pragma unroll
            for (int j = 0; j < 4; ++j) v[j] += g[C.lane + 64 * j] * a[j];
        }
        if (MODE == 0) {
#pragma unroll
            for (int j = 0; j < 4; ++j) ((f32x4*)(X + (size_t)t * D))[C.lane + 64 * j] = v[j];
        }
        float ss = 0.f;
#pragma unroll
        for (int j = 0; j < 4; ++j) ss += (v[j].x * v[j].x + v[j].y * v[j].y) + (v[j].z * v[j].z + v[j].w * v[j].w);
        const float rstd = rsqrtf(wave_sum(ss) * (1.f / D) + RMS_EPS);
        if (MODE == 0) {
            const f32x4* w = (const f32x4*)(C.in[6] + (size_t)l * D); const f32x4* sh = (const f32x4*)modp(C, l, set, 0); const f32x4* scl = (const f32x4*)modp(C, l, set, 1);
#pragma unroll
            for (int j = 0; j < 4; ++j) { const int i = C.lane + 64 * j; const f32x4 y = v[j] * rstd * w[i] * (scl[i] + 1.f) + sh[i];
                u32x2 o; o.x = pk2(y.x, y.y); o.y = pk2(y.z, y.w); ((u32x2*)(H + (size_t)t * D))[i] = o; }
        } else {
            const f32x4* w = (const f32x4*)C.in[25];
#pragma unroll
            for (int j = 0; j < 4; ++j) { const int i = C.lane + 64 * j; ((f32x4*)(C.out + (size_t)t * D))[i] = v[j] * rstd * w[i]; }
        }
    }
}
template <int M> __device__ __forceinline__ float xorx(float v, int b5) {
    if constexpr (M == 32) { const auto sw = __builtin_amdgcn_permlane32_swap(__float_as_uint(v), __float_as_uint(v), false, false); return __uint_as_float(b5 ? sw[0] : sw[1]); }
    else return __int_as_float(__builtin_amdgcn_ds_swizzle(__float_as_int(v), (M << 10) | 0x1f));
}
#define RS_STEP(lo, hi, bit, off) ((bit ? hi : lo) + xorx<off>(bit ? lo : hi, b5))
__device__ __forceinline__ float rscatter16(const float (&a)[16], int b5, int b4, int b3, int b2) {
    const float c0 = RS_STEP(a[0], a[8], b5, 32), c1 = RS_STEP(a[1], a[9], b5, 32), c2 = RS_STEP(a[2], a[10], b5, 32), c3 = RS_STEP(a[3], a[11], b5, 32);
    const float c4 = RS_STEP(a[4], a[12], b5, 32), c5 = RS_STEP(a[5], a[13], b5, 32), c6 = RS_STEP(a[6], a[14], b5, 32), c7 = RS_STEP(a[7], a[15], b5, 32);
    const float d0 = RS_STEP(c0, c4, b4, 16), d1 = RS_STEP(c1, c5, b4, 16), d2 = RS_STEP(c2, c6, b4, 16), d3 = RS_STEP(c3, c7, b4, 16);
    const float e0 = RS_STEP(d0, d2, b3, 8), e1 = RS_STEP(d1, d3, b3, 8);
    return RS_STEP(e0, e1, b2, 4);
}
__device__ __forceinline__ void n2_finish(float (&lg)[16], int b5, int b4, int b3, int b2, int my_e, int lane, float* AFF, int t) {
    float vv = rscatter16(lg, b5, b4, b3, b2);
    vv += xorx<1>(vv, b5); vv += xorx<2>(vv, b5);
    float mx = vv; mx = fmaxf(mx, xorx<4>(mx, b5)); mx = fmaxf(mx, xorx<8>(mx, b5)); mx = fmaxf(mx, xorx<16>(mx, b5)); mx = fmaxf(mx, xorx<32>(mx, b5));
    const float ex = __expf(vv - mx); float sm = ex; sm += xorx<4>(sm, b5); sm += xorx<8>(sm, b5); sm += xorx<16>(sm, b5); sm += xorx<32>(sm, b5);
    if ((lane & 3) == 0) AFF[(size_t)my_e * R + t] = ex / sm;
}
template <int VAR = 0>
__device__ __forceinline__ void ph_norm2(const Ctx& C, int l, int nrows) {
    const float* X = WSP(float, WS_X); bf16* H = VAR ? WSP(bf16, WS_XG) : WSP(bf16, WS_H); float* AFF = VAR ? WSP(float, WS_ACT) : WSP(float, WS_AFF);
    LAS float* Rs = (LAS float*)C.lds;
    const float* rt = C.in[21] + (size_t)l * D * NE;
    for (int i = C.tid; i < D * NE / 4; i += 512) { const f32x4 r4 = ((const f32x4*)rt)[i]; const int c = i >> 2, e0 = (i & 3) * 4;
        Rs[(e0 + 0) * D + c] = r4.x; Rs[(e0 + 1) * D + c] = r4.y; Rs[(e0 + 2) * D + c] = r4.z; Rs[(e0 + 3) * D + c] = r4.w; }
    __syncthreads();
    const int b5 = (C.lane >> 5) & 1, b4 = (C.lane >> 4) & 1, b3 = (C.lane >> 3) & 1, b2 = (C.lane >> 2) & 1, my_e = 8 * b5 + 4 * b4 + 2 * b3 + b2;
    for (int t0 = (C.blk * 8 + C.wave) * 2; t0 < nrows; t0 += C.G * 16) {
        asm volatile("" ::: "memory");
        const int set = t0 >= SEQ ? 1 : 0;
        f32x4 va[4], vb[4];
#pragma unroll
        for (int j = 0; j < 4; ++j) { va[j] = ((const f32x4*)(X + (size_t)t0 * D))[C.lane + 64 * j]; vb[j] = ((const f32x4*)(X + (size_t)(t0 + 1) * D))[C.lane + 64 * j]; }
        { const f32x4* w = (const f32x4*)(C.in[7] + (size_t)l * D); const f32x4* sh = (const f32x4*)modp(C, l, set, 3); const f32x4* scl = (const f32x4*)modp(C, l, set, 4);
          float sa = 0.f, sb = 0.f;
#pragma unroll
          for (int j = 0; j < 4; ++j) { sa += (va[j].x * va[j].x + va[j].y * va[j].y) + (va[j].z * va[j].z + va[j].w * va[j].w); sb += (vb[j].x * vb[j].x + vb[j].y * vb[j].y) + (vb[j].z * vb[j].z + vb[j].w * vb[j].w); }
          const float ra = rsqrtf(wave_sum(sa) * (1.f / D) + RMS_EPS), rb = rsqrtf(wave_sum(sb) * (1.f / D) + RMS_EPS);
#pragma unroll
          for (int j = 0; j < 4; ++j) { const int i = C.lane + 64 * j; const f32x4 ws = w[i] * (scl[i] + 1.f), s4 = sh[i];
              va[j] = va[j] * ra * ws + s4; vb[j] = vb[j] * rb * ws + s4;
              u32x2 o; o.x = pk2(va[j].x, va[j].y); o.y = pk2(va[j].z, va[j].w); ((u32x2*)(H + (size_t)t0 * D))[i] = o;
              o.x = pk2(vb[j].x, vb[j].y); o.y = pk2(vb[j].z, vb[j].w); ((u32x2*)(H + (size_t)(t0 + 1) * D))[i] = o; } }
        float la[16], lb[16];
#pragma unroll
        for (int e = 0; e < 16; ++e) { float s0 = 0.f, s1 = 0.f;
#pragma unroll
            for (int j = 0; j < 4; ++j) { if (VAR & 2) { s0 += va[j].x * (float)e; s1 += vb[j].y * (float)e; continue; } const f32x4 r = *(const LAS f32x4*)(Rs + e * D + 4 * (C.lane + 64 * j));
                s0 += (va[j].x * r.x + va[j].y * r.y) + (va[j].z * r.z + va[j].w * r.w); s1 += (vb[j].x * r.x + vb[j].y * r.y) + (vb[j].z * r.z + vb[j].w * r.w); }
            la[e] = s0; lb[e] = s1; }
        if (VAR & 1) { float z = 0.f;
#pragma unroll
            for (int e = 0; e < 16; ++e) z += la[e] * lb[e];
            if (C.lane == 0) AFF[t0] = z; continue; }
#pragma unroll 1
        for (int rr = 0; rr < 2; ++rr) {
            n2_finish(la, b5, b4, b3, b2, my_e, C.lane, AFF, t0 + rr);
#pragma unroll
            for (int e = 0; e < 16; ++e) la[e] = lb[e];
        }
    }
}

__device__ __forceinline__ int block_sum_i(int v, LAS int* scr, int wave, int lane) {
    v = wave_sum_i(v);
    if (lane == 0) scr[wave] = v;
    __syncthreads();
    int t = 0;
#pragma unroll
    for (int w = 0; w < 8; ++w) t += scr[w];
    __syncthreads();
    return t;
}
__device__ __forceinline__ int block_excl_scan(int v, LAS int* scr, int wave, int lane) {
    int inc = v;
#pragma unroll
    for (int o = 1; o < 64; o <<= 1) { const int n = __shfl_up(inc, o); if (lane >= o) inc += n; }
    if (lane == 63) scr[wave] = inc;
    __syncthreads();
    int off = 0;
#pragma unroll
    for (int w = 0; w < 8; ++w) off += (w < wave) ? scr[w] : 0;
    __syncthreads();
    return off + inc - v;
}
template <int KPT>
__device__ __forceinline__ void topk_unit(const Ctx& C, int e, int base, int n, int cap, int slot0) {
    const float* aff = WSP(float, WS_AFF) + (size_t)e * R + base;
    int* rowl = WSP(int, WS_ROWL) + e * EROWS; float* gatel = WSP(float, WS_GATEL) + e * EROWS; int* INV = WSP(int, WS_INV);
    LAS unsigned* hist = (LAS unsigned*)C.lds;
    LAS int* scr = (LAS int*)(hist + 2048);
    LAS unsigned* bc = hist + 2048 + 16;
    unsigned key[KPT];
    if (KPT == 32) {
#pragma unroll
        for (int j = 0; j < KPT; j += 4) { const u32x4 k4 = *(const u32x4*)(aff + C.tid * KPT + j); key[j] = k4.x; key[j + 1] = k4.y; key[j + 2] = k4.z; key[j + 3] = k4.w; }
    } else {
#pragma unroll
        for (int j = 0; j < KPT; ++j) { const int t = C.tid * KPT + j; key[j] = t < n ? __float_as_uint(aff[t]) : 0u; }
    }
    unsigned prefix = 0u, pmask = 0u; int kth = cap;
#pragma unroll 1
    for (int pass = 0; pass < 3; ++pass) {
        const int shift = pass == 0 ? 20 : (pass == 1 ? 9 : 0), nb = pass == 2 ? 512 : 2048; const unsigned dmask = (unsigned)nb - 1u;
        for (int i = C.tid; i < nb; i += 512) hist[i] = 0u;
        __syncthreads();
#pragma unroll
        for (int j = 0; j < KPT; ++j) if (key[j] != 0u && (key[j] & pmask) == prefix) __hip_atomic_fetch_add(hist + ((key[j] >> shift) & dmask), 1u, __ATOMIC_RELAXED, __HIP_MEMORY_SCOPE_WORKGROUP);
        __syncthreads();
        if (C.wave == 0) {
            const int per = nb >> 6;
            int tot = 0;
            for (int q = 0; q < per; ++q) tot += (int)hist[C.lane * per + q];
            int suf = tot;
#pragma unroll
            for (int o = 1; o < 64; o <<= 1) { const int nbv = __shfl_down(suf, o); if (C.lane + o < 64) suf += nbv; }
            const unsigned long long bal = __ballot(suf >= kth);
            const int lstar = 63 - __builtin_clzll(bal);
            if (C.lane == lstar) { int above = suf - tot; int q = per - 1;
                for (; q > 0; --q) { const int c = (int)hist[C.lane * per + q]; if (above + c >= kth) break; above += c; }
                bc[0] = (unsigned)(C.lane * per + q); bc[1] = (unsigned)(kth - above); }
        }
        __syncthreads();
        prefix |= bc[0] << shift; pmask |= dmask << shift; kth = (int)bc[1];
    }
    const int need_eq = kth;
    int ce = 0;
#pragma unroll
    for (int j = 0; j < KPT; ++j) ce += key[j] == prefix ? 1 : 0;
    int eqr = block_excl_scan(ce, scr, C.wave, C.lane);
    int nsel = 0; unsigned selmask = 0u;
#pragma unroll
    for (int j = 0; j < KPT; ++j) { bool sl = key[j] > prefix; if (key[j] == prefix) { sl = eqr < need_eq; ++eqr; } if (sl) { ++nsel; selmask |= 1u << j; } }
    int slot = block_excl_scan(nsel, scr, C.wave, C.lane);
#pragma unroll
    for (int j = 0; j < KPT; ++j) { const int t = C.tid * KPT + j;
        if (t < n) {
            if ((selmask >> j) & 1u) { rowl[slot0 + slot] = base + t; gatel[slot0 + slot] = __uint_as_float(key[j]); INV[(size_t)(base + t) * 16 + e] = slot0 + slot; ++slot; }
            else INV[(size_t)(base + t) * 16 + e] = -1;
        } }
}
__device__ __forceinline__ void ph_topk(const Ctx& C, bool with_ctx) {
    for (int u = C.blk; u < (with_ctx ? 32 : 16); u += C.G) {
        const int e = u & 15;
        if (u < 16) { topk_unit<32>(C, e, 0, SEQ, CAP_L, 0); int* rowl = WSP(int, WS_ROWL) + e * EROWS; for (int i = CAP_L + CAP_C + C.tid; i < EROWS; i += 512) rowl[i] = 0; }
        else topk_unit<1>(C, e, SEQ, NCTX, CAP_C, CAP_L);
        __syncthreads();
    }
}
__device__ __forceinline__ void ph_gather(const Ctx& C, bool with_ctx) {
    const int* rowl = WSP(int, WS_ROWL); const bf16* H = WSP(bf16, WS_H); bf16* XG = WSP(bf16, WS_XG);
    const int nslots = with_ctx ? CAP_L + CAP_C : CAP_L, ntot = NE * nslots;
    for (int i = C.blk * 8 + C.wave; i < ntot; i += C.G * 8) {
        const int e = i / nslots, sl = i % nslots, r = e * EROWS + sl;
        const int src = rowl[r];
        u32x4* d = (u32x4*)(XG + (size_t)r * D); const u32x4* sp = (const u32x4*)(H + (size_t)src * D);
        d[C.lane] = sp[C.lane]; d[C.lane + 64] = sp[C.lane + 64];
    }
}
__device__ __forceinline__ void rot_angles(int t, int half, int d, int quarter, float& cs, float& sn) {
    const float invf = exp2f(-(float)d * (13.287712379549449f / (float)quarter));
    const float pos = half ? (float)(t & 63) : (float)(t >> 6);
    const float ang = pos * invf;
    const double rev = (double)ang * 0.15915494309189535; const float fr = (float)(rev - __builtin_rint(rev));
    cs = __builtin_amdgcn_cosf(fr); sn = __builtin_amdgcn_sinf(fr);
}
__device__ __forceinline__ void ph_rope(const Ctx& C, bf16* buf, int hw, int nheads, int off, int quarter) {
    const int per_tok = nheads * 2 * quarter; const long total = (long)SEQ * per_tok;
    for (long i = (long)C.blk * 512 + C.tid; i < total; i += (long)C.G * 512) {
        const int t = (int)(i / per_tok), r = (int)(i % per_tok), h = r / (2 * quarter), p = r % (2 * quarter), half = p / quarter, d = p % quarter;
        float cs, sn; rot_angles(t, half, d, quarter, cs, sn);
        bf16* b = buf + (size_t)h * R * hw + (size_t)t * hw + off + half * 2 * quarter + d;
        const float x1 = bf2f(b[0]), x2 = bf2f(b[quarter]);
        b[0] = (bf16)f2bf(x1 * cs - x2 * sn); b[quarter] = (bf16)f2bf(x1 * sn + x2 * cs);
    }
}
__device__ __forceinline__ void ph_mlanorm(const Ctx& C) {
    const float* CQ = WSP(float, WS_CQ); bf16* CQN = WSP(bf16, WS_CQN); bf16* CKVN = WSP(bf16, WS_CKVN); bf16* KR = WSP(bf16, WS_KROPE);
    for (int t = C.blk * 8 + C.wave; t < R; t += C.G * 8) {
        const float* row = CQ + (size_t)t * D;
        const f32x4 a0 = ((const f32x4*)row)[C.lane], a1 = ((const f32x4*)row)[C.lane + 64], b0 = ((const f32x4*)(row + 512))[C.lane];
        const float sa = wave_sum((a0.x * a0.x + a0.y * a0.y) + (a0.z * a0.z + a0.w * a0.w) + (a1.x * a1.x + a1.y * a1.y) + (a1.z * a1.z + a1.w * a1.w));
        const float sb = wave_sum((b0.x * b0.x + b0.y * b0.y) + (b0.z * b0.z + b0.w * b0.w));
        const float ra = rsqrtf(sa * (1.f / 512.f) + RMS_EPS), rb = rsqrtf(sb * (1.f / 256.f) + RMS_EPS);
        const f32x4* gq = (const f32x4*)C.in[15]; const f32x4* gk = (const f32x4*)C.in[18];
        { const f32x4 y0 = a0 * ra * gq[C.lane], y1 = a1 * ra * gq[C.lane + 64], z = b0 * rb * gk[C.lane];
          u32x2 o; o.x = pk2(y0.x, y0.y); o.y = pk2(y0.z, y0.w); ((u32x2*)(CQN + (size_t)t * 512))[C.lane] = o;
          o.x = pk2(y1.x, y1.y); o.y = pk2(y1.z, y1.w); ((u32x2*)(CQN + (size_t)t * 512))[C.lane + 64] = o;
          o.x = pk2(z.x, z.y); o.y = pk2(z.z, z.w); ((u32x2*)(CKVN + (size_t)t * 256))[C.lane] = o; }
        const float x = row[768 + (C.lane & 31)];
        const float xp = __shfl_xor(x, 8);
        float y = x;
        if (t < SEQ) { float cs, sn; rot_angles(t, (C.lane >> 4) & 1, C.lane & 7, 8, cs, sn);
            y = ((C.lane >> 3) & 1) ? (xp * sn + x * cs) : (x * cs - xp * sn); }
        if (C.lane < 32) KR[(size_t)t * 32 + C.lane] = (bf16)f2bf(y);
    }
}

constexpr int CW_KMAX = 8192;
__device__ __forceinline__ void ph_kmax(const Ctx& C) {
    const bf16* KV = WSP(bf16, WS_KV); const bf16* KR = WSP(bf16, WS_KROPE); unsigned* ctl = (unsigned*)(C.ws + WS_CTL);
    for (int i = C.blk * 512 + C.tid; i < 16 * R; i += C.G * 512) {
        const int h = i / R, t = i - h * R;
        const u32x4* kp = (const u32x4*)(KV + (size_t)h * R * 128 + (size_t)t * 128); const u32x4* rp = (const u32x4*)(KR + (size_t)t * 32);
        float ss = 0.f;
#pragma unroll
        for (int q = 0; q < 12; ++q) { const u32x4 w = q < 8 ? kp[q] : rp[q - 8];
            const float a0 = bf2f(w.x & 0xffffu), a1 = bf2f(w.x >> 16), a2 = bf2f(w.y & 0xffffu), a3 = bf2f(w.y >> 16), a4 = bf2f(w.z & 0xffffu), a5 = bf2f(w.z >> 16), a6 = bf2f(w.w & 0xffffu), a7 = bf2f(w.w >> 16);
            ss += (a0 * a0 + a1 * a1) + (a2 * a2 + a3 * a3) + (a4 * a4 + a5 * a5) + (a6 * a6 + a7 * a7); }
#pragma unroll
        for (int o = 1; o < 64; o <<= 1) ss = fmaxf(ss, __shfl_xor(ss, o));
        if (C.lane == 0) atomicMax(ctl + CW_KMAX + h, __float_as_uint(ss));
    }
}

namespace pg8 {
#define PG8_LAS __attribute__((address_space(3)))
typedef unsigned short bf16_t;
typedef short bf16x8 __attribute__((ext_vector_type(8)));
typedef float f32x4 __attribute__((ext_vector_type(4)));
typedef unsigned u32x4 __attribute__((ext_vector_type(4)));
constexpr int BM = 256, BK = 64, HALF = 128, HTB = HALF * BK * 2  , STAGE_BYTES = 8 * HTB, NXCD = 8, WGM = 8;

__host__ __device__ __forceinline__ int lds_byte(int r, int c) { const int st = (r >> 4) * 2 + (c >> 5), rr = r & 15, cc = c & 31, ob = rr * 64 + cc * 2; return st * 1024 + (ob ^ (((ob >> 9) & 1) << 5)); }
__host__ __device__ __forceinline__ void stage_rc(int b, int& R, int& C) { const int st = b / 1024, sb = b % 1024, swz = sb ^ (((sb >> 9) & 1) << 5); R = (st >> 1) * 16 + swz / 64; C = (st & 1) * 32 + (swz % 64) / 2; }
__host__ __device__ __forceinline__ int perm32(int rho) { const int n = rho >> 4, i = rho & 15; return 8 * (i >> 2) + 4 * n + (i & 3); }

struct Unit { int pm, pn, thin; };
struct Gemm { const bf16_t* A; const bf16_t* Bt; int M, N, K; int pm_per_grp; size_t grp_stride; };

struct StaticOrder {
    int nM, nN, nwg, G, c;
    __host__ __device__ void init(int M, int N, int G_, int c_) { nM = M / BM; nN = N / BM; nwg = nM * nN; G = G_; c = c_; }
    __host__ __device__ bool next(int i, Unit& u) const {
        const long L = (long)i * G + c; if (L >= nwg) return false;
        int wgid = (int)L; { const int q = nwg / NXCD, r = nwg % NXCD, xcd = wgid % NXCD, off = wgid / NXCD; wgid = (xcd < r ? xcd * (q + 1) : r * (q + 1) + (xcd - r) * q) + off; }
        const int nig = WGM * nN, gid = wgid / nig, fm = gid * WGM, gsz = (nM - fm) < WGM ? (nM - fm) : WGM;
        u.pm = fm + ((wgid % nig) % gsz); u.pn = (wgid % nig) / gsz; u.thin = 0; return true;
    }
    __device__ __forceinline__ void a_ready(const Unit&) const {}
    __device__ __forceinline__ void done(const Unit&) const {}
};
struct MoeOrder {
    StaticOrder base; int nN, nthin;
    __host__ __device__ void init(int N, int G_, int c_, bool with_thin) { base.init(NEXP_PANELS * BM, N, G_, c_); nN = N / BM; nthin = with_thin ? 16 * nN : 0; }
    static constexpr int NEXP_PANELS = 16 * 8;
    __host__ __device__ bool next(int i, Unit& u) const {
        if (base.next(i, u)) { u.pm = (u.pm >> 3) * 9 + (u.pm & 7); return true; }
        const long j = (long)i * base.G + base.c - base.nwg; if (j >= nthin) return false;
        u.pm = (int)(j / nN) * 9 + 8; u.pn = (int)(j % nN); u.thin = 1; return true;
    }
    __device__ __forceinline__ void a_ready(const Unit&) const {}
    __device__ __forceinline__ void done(const Unit&) const {}
};

template <class Epi, class Sched, bool ALIGN_EPI = false, bool SP2 = false, bool GATHER = false>
__device__ __forceinline__ void gemm_phase(PG8_LAS unsigned char* lds, const Gemm g, const Sched& S, const Epi& E, const PG8_LAS int* idx_tab = nullptr) {
    static_assert(!GATHER || SP2, "the gathered A panel is wired into the SP2 loop only");
    const int tid = threadIdx.x, wid = __builtin_amdgcn_readfirstlane(tid >> 6), lane = tid & 63, wr = wid >> 2, wc = wid & 3, fr = lane & 15, fq = lane >> 4;
    const int K = g.K, nt = K / BK;
    unsigned voffA[2], voffB[2]; int rowA[2]; unsigned colA[2];
#pragma unroll
    for (int i = 0; i < 2; ++i) { int R, C; stage_rc(tid * 16 + i * 8192, R, C); const int Rb = Epi::PERM ? ((R & ~31) + perm32(R & 31)) : R;
        voffA[i] = (unsigned)(R * K + C) * 2u; voffB[i] = (unsigned)(Rb * K + C) * 2u; rowA[i] = R; colA[i] = (unsigned)C * 2u; }
    unsigned vGc[2][2], vGn[2][2];
#define PG8_GOFF(dst, ui_) do { _Pragma("unroll") for (int h_ = 0; h_ < 2; ++h_) _Pragma("unroll") for (int i_ = 0; i_ < 2; ++i_) \
        dst[h_][i_] = (unsigned)idx_tab[(ui_) * 256 + h_ * HALF + rowA[i_]] * (unsigned)(K * 2) + colA[i_]; } while (0)
#define PG8_STAGE_A(bufoff, ptr, h, nf) do { if constexpr (GATHER) { _Pragma("unroll") for (int _i = 0; _i < 2; ++_i) \
        __builtin_amdgcn_global_load_lds((const unsigned*)((const char*)(ptr) + ((nf) ? vGn[h][_i] : vGc[h][_i])), (PG8_LAS unsigned*)(lds + (bufoff) + ldsw + _i * 8192), 16, 0, 0); } \
        else PG8_STAGE(bufoff, (ptr) + (h) * hstep, voffA); } while (0)
    const size_t kstep = (size_t)(BK * 2);
    const size_t hstep = (size_t)HALF * K * 2;
    const size_t tstep = 2 * hstep;
    const unsigned ldsw = (unsigned)wid * 1024u;
    const int aoff = lds_byte(wr * 64 + fr, fq * 8), boff = lds_byte(wc * 32 + fr, fq * 8);
#define PG8_SA(b, h) (((b) * 2 + (h)) * HTB)
#define PG8_SB(b, h) ((4 + (b) * 2 + (h)) * HTB)
#define PG8_STAGE(bufoff, gbase, voff) do { _Pragma("unroll") for (int _i = 0; _i < 2; ++_i) \
        __builtin_amdgcn_global_load_lds((const unsigned*)((const char*)(gbase) + (voff)[_i]), (PG8_LAS unsigned*)(lds + (bufoff) + ldsw + _i * 8192), 16, 0, 0); } while (0)
#define PG8_LDA(dst, b, h) do { _Pragma("unroll") for (int m = 0; m < 4; ++m) _Pragma("unroll") for (int k = 0; k < 2; ++k) dst[m][k] = *(const PG8_LAS bf16x8*)(lds + PG8_SA(b, h) + aoff + m * 2048 + k * 1024); } while (0)
#define PG8_LDB(dst, b, h) do { _Pragma("unroll") for (int n = 0; n < 2; ++n) _Pragma("unroll") for (int k = 0; k < 2; ++k) dst[n][k] = *(const PG8_LAS bf16x8*)(lds + PG8_SB(b, h) + boff + n * 2048 + k * 1024); } while (0)
#define PG8_MMA(ai, bj, At, Bt) do { if (cur.thin && ((ai) != 0 || wr != 0)) break; __builtin_amdgcn_s_setprio(1); _Pragma("unroll") for (int m = 0; m < 4; ++m) _Pragma("unroll") for (int n = 0; n < 2; ++n) _Pragma("unroll") for (int k = 0; k < 2; ++k) \
        acc[ai][bj][m][n] = __builtin_amdgcn_mfma_f32_16x16x32_bf16(Bt[n][k], At[m][k], acc[ai][bj][m][n], 0, 0, 0); __builtin_amdgcn_s_setprio(0); } while (0)
#define PG8_WAIT_V(n) asm volatile("s_waitcnt vmcnt(" #n ")" ::: "memory")
#define PG8_WAIT_L(n) asm volatile("s_waitcnt lgkmcnt(" #n ")" ::: "memory")
#define PG8_BAR __builtin_amdgcn_s_barrier()
#define PG8_SCHED __builtin_amdgcn_sched_barrier(0)
    Unit cur, nxt; int ui = 0;
    if (!S.next(0, cur)) return;
    f32x4 acc[2][2][4][2];
#pragma unroll
    for (int a = 0; a < 2; ++a)
#pragma unroll
        for (int b = 0; b < 2; ++b)
#pragma unroll
            for (int m = 0; m < 4; ++m)
#pragma unroll
                for (int n = 0; n < 2; ++n) acc[a][b][m][n] = (f32x4){0.f, 0.f, 0.f, 0.f};
    bf16x8 At[4][2], B0[2][2], B1[2][2];
    const char* cA = GATHER ? (const char*)g.A : (const char*)g.A + (size_t)cur.pm * tstep; const char* cB = (const char*)g.Bt + (g.pm_per_grp ? (size_t)(cur.pm / g.pm_per_grp) * g.grp_stride * 2 : (size_t)0) + (size_t)cur.pn * tstep;
    S.a_ready(cur);
    if constexpr (GATHER) { PG8_GOFF(vGc, 0); }
    if constexpr (SP2) {
        PG8_STAGE(PG8_SB(0, 0), cB, voffB); PG8_STAGE(PG8_SB(0, 1), cB + hstep, voffB); PG8_STAGE_A(PG8_SA(0, 0), cA, 0, false); PG8_STAGE_A(PG8_SA(0, 1), cA, 1, false);
        if (wr == 1) PG8_BAR;
        PG8_WAIT_V(2); PG8_BAR;
        PG8_STAGE(PG8_SB(1, 0), cB + kstep, voffB); PG8_STAGE_A(PG8_SA(1, 0), cA + kstep, 0, false); PG8_STAGE(PG8_SB(1, 1), cB + hstep + kstep, voffB);
        PG8_WAIT_V(6); PG8_BAR;
    } else {
        PG8_STAGE(PG8_SB(0, 0), cB, voffB); PG8_STAGE(PG8_SA(0, 0), cA, voffA); PG8_STAGE(PG8_SB(0, 1), cB + hstep, voffB); PG8_STAGE(PG8_SA(0, 1), cA + hstep, voffA);
        if (wr == 1) PG8_BAR;
        PG8_WAIT_V(4); PG8_BAR;
        PG8_STAGE(PG8_SB(1, 0), cB + kstep, voffB); PG8_STAGE(PG8_SA(1, 0), cA + kstep, voffA); PG8_STAGE(PG8_SB(1, 1), cB + hstep + kstep, voffB);
        PG8_WAIT_V(6); PG8_BAR;
    }
    for (;;) {
        const bool has_next = S.next(ui + 1, nxt);
        const char* nA = GATHER ? (const char*)g.A : (has_next ? (const char*)g.A + (size_t)nxt.pm * tstep : cA);
        if constexpr (GATHER) { if (has_next) { PG8_GOFF(vGn, ui + 1); } else {
#pragma unroll
            for (int h_ = 0; h_ < 2; ++h_) { vGn[h_][0] = vGc[h_][0]; vGn[h_][1] = vGc[h_][1]; } } } const char* nB = has_next ? (const char*)g.Bt + (g.pm_per_grp ? (size_t)(nxt.pm / g.pm_per_grp) * g.grp_stride * 2 : (size_t)0) + (size_t)nxt.pn * tstep : cB;
        for (int t = 0; t < nt; t += 2) {
            const bool last = (t == nt - 2);
            const char* a1 = cA + (size_t)(t + 1) * kstep;
            const char* a2 = last ? nA : cA + (size_t)(t + 2) * kstep; const char* b2 = last ? nB : cB + (size_t)(t + 2) * kstep;
            const char* a3 = a2 + kstep; const char* b3 = b2 + kstep;
            if (last && has_next) S.a_ready(nxt);
            if constexpr (SP2) {
            PG8_LDB(B0, 0, 0); PG8_LDB(B1, 0, 1); PG8_SCHED; PG8_LDA(At, 0, 0); PG8_STAGE_A(PG8_SA(1, 1), a1, 1, false);
            PG8_WAIT_V(8); PG8_WAIT_L(0); PG8_BAR; PG8_MMA(0, 0, At, B0); PG8_MMA(0, 1, At, B1); PG8_BAR; PG8_SCHED;
            PG8_LDA(At, 0, 1); PG8_STAGE(PG8_SB(0, 0), b2, voffB); PG8_STAGE(PG8_SB(0, 1), b2 + hstep, voffB); PG8_STAGE_A(PG8_SA(0, 0), a2, 0, last);
            PG8_WAIT_V(8); PG8_WAIT_L(0); PG8_BAR; PG8_MMA(1, 0, At, B0); PG8_MMA(1, 1, At, B1); PG8_BAR; PG8_SCHED;
            PG8_LDB(B0, 1, 0); PG8_LDB(B1, 1, 1); PG8_SCHED; PG8_LDA(At, 1, 0); PG8_STAGE_A(PG8_SA(0, 1), a2, 1, last);
            PG8_WAIT_V(8); PG8_WAIT_L(0); PG8_BAR; PG8_MMA(0, 0, At, B0); PG8_MMA(0, 1, At, B1); PG8_BAR; PG8_SCHED;
            PG8_LDA(At, 1, 1); PG8_STAGE(PG8_SB(1, 0), b3, voffB); PG8_STAGE(PG8_SB(1, 1), b3 + hstep, voffB); PG8_STAGE_A(PG8_SA(1, 0), a3, 0, last);
            PG8_WAIT_V(8); PG8_WAIT_L(0); PG8_BAR; PG8_MMA(1, 0, At, B0); PG8_MMA(1, 1, At, B1); PG8_BAR; PG8_SCHED;
            } else {
            PG8_LDB(B0, 0, 0); PG8_SCHED; PG8_LDA(At, 0, 0); PG8_STAGE(PG8_SA(1, 1), a1 + hstep, voffA);
            PG8_WAIT_L(8); PG8_BAR; PG8_WAIT_L(0); PG8_MMA(0, 0, At, B0); PG8_BAR; PG8_SCHED;
            PG8_LDB(B1, 0, 1); PG8_STAGE(PG8_SB(0, 0), b2, voffB);
            PG8_BAR; PG8_WAIT_L(0); PG8_MMA(0, 1, At, B1); PG8_BAR;
            PG8_LDA(At, 0, 1); PG8_STAGE(PG8_SA(0, 0), a2, voffA);
            PG8_BAR; PG8_WAIT_L(0); PG8_MMA(1, 0, At, B0); PG8_BAR; PG8_SCHED;
            PG8_STAGE(PG8_SB(0, 1), b2 + hstep, voffB);
            PG8_WAIT_V(6); PG8_BAR; PG8_MMA(1, 1, At, B1); PG8_BAR;
            PG8_LDB(B0, 1, 0); PG8_SCHED; PG8_LDA(At, 1, 0); PG8_STAGE(PG8_SA(0, 1), a2 + hstep, voffA);
            PG8_WAIT_L(8); PG8_BAR; PG8_WAIT_L(0); PG8_MMA(0, 0, At, B0); PG8_BAR; PG8_SCHED;
            PG8_LDB(B1, 1, 1); PG8_STAGE(PG8_SB(1, 0), b3, voffB);
            PG8_BAR; PG8_WAIT_L(0); PG8_MMA(0, 1, At, B1); PG8_BAR;
            PG8_LDA(At, 1, 1); PG8_STAGE(PG8_SA(1, 0), a3, voffA);
            PG8_BAR; PG8_WAIT_L(0); PG8_MMA(1, 0, At, B0); PG8_BAR; PG8_SCHED;
            PG8_STAGE(PG8_SB(1, 1), b3 + hstep, voffB);
            PG8_WAIT_V(6); PG8_BAR; PG8_MMA(1, 1, At, B1); PG8_BAR;
            }
        }
        if constexpr (ALIGN_EPI) { if (wr == 0) PG8_BAR; }
        if constexpr (!Epi::AFTER_DRAIN) { E(acc, cur, wr, wc, fr, fq); S.done(cur); }
        if (!has_next) break;
#pragma unroll
        for (int a = 0; a < 2; ++a)
#pragma unroll
            for (int b = 0; b < 2; ++b)
#pragma unroll
                for (int m = 0; m < 4; ++m)
#pragma unroll
                    for (int n = 0; n < 2; ++n) acc[a][b][m][n] = (f32x4){0.f, 0.f, 0.f, 0.f};
        cur = nxt; cA = nA; cB = nB; ++ui;
        if constexpr (GATHER) {
#pragma unroll
            for (int h_ = 0; h_ < 2; ++h_) { vGc[h_][0] = vGn[h_][0]; vGc[h_][1] = vGn[h_][1]; } }
        if constexpr (ALIGN_EPI) { if (wr == 1) PG8_BAR; }
    }
    PG8_WAIT_V(0);
    if constexpr (!ALIGN_EPI) { if (wr == 0) PG8_BAR; }
    PG8_BAR;
    if constexpr (Epi::AFTER_DRAIN) { E.fused(acc, cur, wr, wc, fr, fq, lds, wid, lane); S.done(cur); }
#undef PG8_GOFF
#undef PG8_STAGE_A
#undef PG8_SA
#undef PG8_SB
#undef PG8_STAGE
#undef PG8_LDA
#undef PG8_LDB
#undef PG8_MMA
#undef PG8_WAIT_V
#undef PG8_WAIT_L
#undef PG8_BAR
#undef PG8_SCHED
}
}
#ifndef USE_PG8
#define USE_PG8 1
#endif

typedef const f32x4 (&AccRef)[2][2][4][2];
struct EpiStoreBf16 { static constexpr bool DUAL = false, PERM = true, AFTER_DRAIN = false; bf16* O; int ldc;
    __device__ __forceinline__ void elem(int row, int col, float v, float) const { O[(size_t)row * ldc + col] = (bf16)f2bf(v); }
    __device__ __forceinline__ void operator()(AccRef acc, const pg8::Unit& u, int wr, int wc, int fr, int fq) const {
        const int row0 = u.pm * 256 + wr * 64 + fr, col0 = u.pn * 256 + wc * 32 + 8 * fq;
#pragma unroll
        for (int ai = 0; ai < 2; ++ai)
#pragma unroll
            for (int m = 0; m < 4; ++m) { bf16* rowp = O + (size_t)(row0 + ai * 128 + m * 16) * ldc + col0;
#pragma unroll
                for (int bj = 0; bj < 2; ++bj) { const f32x4 v0 = acc[ai][bj][m][0], v1 = acc[ai][bj][m][1];
                    u32x4 w; w.x = cvt_pk_bf16(v0[0], v0[1]); w.y = cvt_pk_bf16(v0[2], v0[3]); w.z = cvt_pk_bf16(v1[0], v1[1]); w.w = cvt_pk_bf16(v1[2], v1[3]);
                    *(u32x4*)(rowp + bj * 128) = w; } }
    } };
struct EpiStoreHeads { static constexpr bool DUAL = false, PERM = true, AFTER_DRAIN = false; bf16* O; int hw; size_t hstride;
    __device__ __forceinline__ void store4(int row, int col, f32x4 v) const { const int hd = col / hw, wi = col - hd * hw; u32x2 o; o.x = cvt_pk_bf16(v[0], v[1]); o.y = cvt_pk_bf16(v[2], v[3]); *(u32x2*)(O + (size_t)hd * hstride + (size_t)row * hw + wi) = o; }
    __device__ __forceinline__ void elem(int row, int col, float v, float) const { O[(size_t)(col / hw) * hstride + (size_t)row * hw + (col % hw)] = (bf16)f2bf(v); }
    __device__ __forceinline__ void operator()(AccRef acc, const pg8::Unit& u, int wr, int wc, int fr, int fq) const {
        const int row0 = u.pm * 256 + wr * 64 + fr, col0 = u.pn * 256 + wc * 32 + 8 * fq;
#pragma unroll
        for (int bj = 0; bj < 2; ++bj) { const int c = col0 + bj * 128, hd = c / hw, wi = c - hd * hw; bf16* base = O + (size_t)hd * hstride + wi;
#pragma unroll
            for (int ai = 0; ai < 2; ++ai)
#pragma unroll
                for (int m = 0; m < 4; ++m) { const f32x4 v0 = acc[ai][bj][m][0], v1 = acc[ai][bj][m][1];
                    u32x4 w; w.x = cvt_pk_bf16(v0[0], v0[1]); w.y = cvt_pk_bf16(v0[2], v0[3]); w.z = cvt_pk_bf16(v1[0], v1[1]); w.w = cvt_pk_bf16(v1[2], v1[3]);
                    *(u32x4*)(base + (size_t)(row0 + ai * 128 + m * 16) * hw) = w; } }
    } };
struct EpiStoreF32 { static constexpr bool DUAL = false, PERM = false, AFTER_DRAIN = false; float* O; int ldc;
    __device__ __forceinline__ void store4(int row, int col, f32x4 v) const { *(f32x4*)(O + (size_t)row * ldc + col) = v; }
    __device__ __forceinline__ void elem(int row, int col, float v, float) const { O[(size_t)row * ldc + col] = v; }
    __device__ __forceinline__ void operator()(AccRef acc, const pg8::Unit& u, int wr, int wc, int fr, int fq) const {
        const int row0 = u.pm * 256 + wr * 64 + fr, col0 = u.pn * 256 + wc * 32 + 4 * fq;
#pragma unroll
        for (int ai = 0; ai < 2; ++ai)
#pragma unroll
            for (int m = 0; m < 4; ++m) { float* rowp = O + (size_t)(row0 + ai * 128 + m * 16) * ldc + col0;
#pragma unroll
                for (int bj = 0; bj < 2; ++bj)
#pragma unroll
                    for (int n = 0; n < 2; ++n) *(f32x4*)(rowp + bj * 128 + n * 16) = acc[ai][bj][m][n]; }
    } };
struct EpiResid { static constexpr bool DUAL = false, PERM = false, AFTER_DRAIN = false; float* X; const float* g_lat; const float* g_ctx;
    __device__ __forceinline__ void store4(int row, int col, f32x4 v) const { const float* g = row >= SEQ ? g_ctx : g_lat; f32x4* p = (f32x4*)(X + (size_t)row * D + col); *p = *p + *(const f32x4*)(g + col) * v; }
    __device__ __forceinline__ void elem(int row, int col, float v, float) const { const float g = row >= SEQ ? g_ctx[col] : g_lat[col]; X[(size_t)row * D + col] += g * v; }
    __device__ __forceinline__ void operator()(AccRef acc, const pg8::Unit& u, int wr, int wc, int fr, int fq) const {
        const int row0 = u.pm * 256 + wr * 64 + fr, col0 = u.pn * 256 + wc * 32 + 4 * fq;
        const float* g = (u.pm * 256 >= SEQ) ? g_ctx : g_lat;
        f32x4 gv[2][2];
#pragma unroll
        for (int bj = 0; bj < 2; ++bj)
#pragma unroll
            for (int n = 0; n < 2; ++n) gv[bj][n] = *(const f32x4*)(g + col0 + bj * 128 + n * 16);
#pragma unroll
        for (int ai = 0; ai < 2; ++ai)
#pragma unroll
            for (int m = 0; m < 4; ++m) { float* rowp = X + (size_t)(row0 + ai * 128 + m * 16) * D + col0;
#pragma unroll
                for (int bj = 0; bj < 2; ++bj)
#pragma unroll
                    for (int n = 0; n < 2; ++n) { f32x4* p = (f32x4*)(rowp + bj * 128 + n * 16); *p = *p + gv[bj][n] * acc[ai][bj][m][n]; } }
    } };
__device__ __forceinline__ float silu_mul(float g, float u) { return g * __builtin_amdgcn_rcpf(1.f + __expf(-g)) * u; }
struct EpiSwiglu { static constexpr bool DUAL = true, PERM = true, AFTER_DRAIN = false; bf16* ACT;
    __device__ __forceinline__ void elem(int row, int col, float g, float u) const { ACT[(size_t)row * FF + col] = (bf16)f2bf(g / (1.f + __expf(-g)) * u); }
    __device__ __forceinline__ void operator()(AccRef acc, const pg8::Unit& u, int wr, int wc, int fr, int fq) const {
        const int row0 = u.pm * 256 + wr * 64 + fr, col0 = u.pn * 128 + wc * 32 + 8 * fq;
#pragma unroll
        for (int ai = 0; ai < 2; ++ai)
#pragma unroll
            for (int m = 0; m < 4; ++m) { bf16* rowp = ACT + (size_t)(row0 + ai * 128 + m * 16) * FF + col0;
                const f32x4 g0 = acc[ai][0][m][0], g1 = acc[ai][0][m][1], u0 = acc[ai][1][m][0], u1 = acc[ai][1][m][1];
                u32x4 w; w.x = cvt_pk_bf16(silu_mul(g0[0], u0[0]), silu_mul(g0[1], u0[1])); w.y = cvt_pk_bf16(silu_mul(g0[2], u0[2]), silu_mul(g0[3], u0[3]));
                w.z = cvt_pk_bf16(silu_mul(g1[0], u1[0]), silu_mul(g1[1], u1[1])); w.w = cvt_pk_bf16(silu_mul(g1[2], u1[2]), silu_mul(g1[3], u1[3]));
                *(u32x4*)rowp = w; }
    } };
struct EpiMoeOut { static constexpr bool DUAL = false, PERM = true, AFTER_DRAIN = false; bf16* YB; const float* gatel;
    __device__ __forceinline__ void elem(int row, int col, float v, float) const { YB[(size_t)row * D + col] = (bf16)f2bf(v * gatel[row]); }
    __device__ __forceinline__ void operator()(AccRef acc, const pg8::Unit& u, int wr, int wc, int fr, int fq) const {
        const int row0 = u.pm * 256 + wr * 64 + fr, col0 = u.pn * 256 + wc * 32 + 8 * fq;
#pragma unroll
        for (int ai = 0; ai < 2; ++ai)
#pragma unroll
            for (int m = 0; m < 4; ++m) { const int row = row0 + ai * 128 + m * 16; const float gt = gatel[row]; bf16* rowp = YB + (size_t)row * D + col0;
#pragma unroll
                for (int bj = 0; bj < 2; ++bj) { const f32x4 v0 = acc[ai][bj][m][0] * gt, v1 = acc[ai][bj][m][1] * gt;
                    u32x4 w; w.x = cvt_pk_bf16(v0[0], v0[1]); w.y = cvt_pk_bf16(v0[2], v0[3]); w.z = cvt_pk_bf16(v1[0], v1[1]); w.w = cvt_pk_bf16(v1[2], v1[3]);
                    *(u32x4*)(rowp + bj * 128) = w; } }
    } };

template <class Epi>
__device__ __forceinline__ void naive_gemm(const Ctx& C, const bf16* A, const bf16* Bt, int M, int N, int K, int pm_per_grp, size_t grp_stride, const Epi& E) {
    LAS float* As = (LAS float*)C.lds;
    LAS float* Bs = As + 16 * 132;
    LAS float* Bs2 = Bs + 16 * 68;
    const int NO = Epi::DUAL ? N / 2 : N, tn_cnt = NO / 64, nun = (M / 128) * tn_cnt;
    const int ty = C.tid >> 4, tx = C.tid & 15;
    for (int u = C.blk; u < nun; u += C.G) {
        const int tm = u / tn_cnt, tn = u % tn_cnt, row0 = tm * 128, oc0 = tn * 64;
        const bf16* Bg = Bt + (pm_per_grp ? (size_t)((row0 / 256) / pm_per_grp) * grp_stride : (size_t)0);
        const int brow0 = Epi::DUAL ? ((oc0 >> 7) * 256 + (oc0 & 127)) : oc0;
        float acc[4][4], acc2[4][4];
#pragma unroll
        for (int i = 0; i < 4; ++i)
#pragma unroll
            for (int j = 0; j < 4; ++j) { acc[i][j] = 0.f; acc2[i][j] = 0.f; }
        for (int k0 = 0; k0 < K; k0 += 16) {
            __syncthreads();
            { const int r = C.tid >> 2, kc = (C.tid & 3) * 4;
              const u32x2 w = *(const u32x2*)(A + (size_t)(row0 + r) * K + k0 + kc);
              As[(kc + 0) * 132 + r] = bf2f(w.x & 0xffffu); As[(kc + 1) * 132 + r] = bf2f(w.x >> 16); As[(kc + 2) * 132 + r] = bf2f(w.y & 0xffffu); As[(kc + 3) * 132 + r] = bf2f(w.y >> 16); }
            if (C.tid < 256) { const int r = C.tid >> 2, kc = (C.tid & 3) * 4;
              const u32x2 w = *(const u32x2*)(Bg + (size_t)(brow0 + r) * K + k0 + kc);
              Bs[(kc + 0) * 68 + r] = bf2f(w.x & 0xffffu); Bs[(kc + 1) * 68 + r] = bf2f(w.x >> 16); Bs[(kc + 2) * 68 + r] = bf2f(w.y & 0xffffu); Bs[(kc + 3) * 68 + r] = bf2f(w.y >> 16);
              if (Epi::DUAL) { const u32x2 w2 = *(const u32x2*)(Bg + (size_t)(brow0 + 128 + r) * K + k0 + kc);
                Bs2[(kc + 0) * 68 + r] = bf2f(w2.x & 0xffffu); Bs2[(kc + 1) * 68 + r] = bf2f(w2.x >> 16); Bs2[(kc + 2) * 68 + r] = bf2f(w2.y & 0xffffu); Bs2[(kc + 3) * 68 + r] = bf2f(w2.y >> 16); } }
            __syncthreads();
#pragma unroll
            for (int kk = 0; kk < 16; ++kk) {
                const f32x4 a = *(const LAS f32x4*)(As + kk * 132 + ty * 4), b = *(const LAS f32x4*)(Bs + kk * 68 + tx * 4);
#pragma unroll
                for (int i = 0; i < 4; ++i)
#pragma unroll
                    for (int j = 0; j < 4; ++j) acc[i][j] += a[i] * b[j];
                if (Epi::DUAL) { const f32x4 b2 = *(const LAS f32x4*)(Bs2 + kk * 68 + tx * 4);
#pragma unroll
                    for (int i = 0; i < 4; ++i)
#pragma unroll
                        for (int j = 0; j < 4; ++j) acc2[i][j] += a[i] * b2[j]; }
            }
        }
#pragma unroll
        for (int i = 0; i < 4; ++i)
#pragma unroll
            for (int j = 0; j < 4; ++j) E.elem(row0 + ty * 4 + i, oc0 + tx * 4 + j, acc[i][j], acc2[i][j]);
    }
    __syncthreads();
}

template <class Epi>
__device__ __forceinline__ void gemm(const Ctx& C, const bf16* A, const bf16* Bt, int M, int N, int K, int pm_per_grp, size_t grp_stride, const Epi& E) {
#if USE_PG8
    pg8::Gemm g{A, Bt, M, N, K, pm_per_grp, grp_stride}; pg8::StaticOrder S; S.init(M, N, C.G, C.blk);
    pg8::gemm_phase<Epi, pg8::StaticOrder, true, true>(C.lds, g, S, E);
#else
    naive_gemm(C, A, Bt, M, N, K, pm_per_grp, grp_stride, E);
#endif
}
template <class Epi>
__device__ __forceinline__ void small_gemm(const Ctx& C, const bf16* A, const bf16* Bt, int row0, int nrows, int N, int K, const Epi& E) {
    const int ql = C.lane & 31, hi = C.lane >> 5, nrb = nrows / 32, nitems = nrb * (N / 32);
    for (int it = C.blk * 8 + C.wave; it < nitems; it += C.G * 8) {
        const int cb = it / nrb, rb = it % nrb;
        const bf16* ap = A + (size_t)(row0 + rb * 32 + ql) * K + 8 * hi; const bf16* bp = Bt + (size_t)(cb * 32 + ql) * K + 8 * hi;
        f32x16 acc;
#pragma unroll
        for (int r = 0; r < 16; ++r) acc[r] = 0.f;
#pragma unroll 1
        for (int k0 = 0; k0 < K; k0 += 256) {
            bf16x8 a[16], b[16];
#pragma unroll
            for (int q = 0; q < 16; ++q) { a[q] = *(const bf16x8*)(ap + k0 + 16 * q); b[q] = *(const bf16x8*)(bp + k0 + 16 * q); }
            __builtin_amdgcn_sched_barrier(0);
#pragma unroll
            for (int q = 0; q < 16; ++q) acc = __builtin_amdgcn_mfma_f32_32x32x16_bf16(b[q], a[q], acc, 0, 0, 0);
            __builtin_amdgcn_sched_barrier(0);
        }
        const int row = row0 + rb * 32 + ql;
#pragma unroll
        for (int g = 0; g < 4; ++g) E.store4(row, cb * 32 + 8 * g + 4 * hi, (f32x4){acc[4 * g], acc[4 * g + 1], acc[4 * g + 2], acc[4 * g + 3]});
    }
}
template <class Epi>
__device__ __forceinline__ void gemm_tok(const Ctx& C, const bf16* A, const bf16* Bt, int N, int K, bool with_ctx, const Epi& E) {
#if USE_PG8
    gemm(C, A, Bt, SEQ, N, K, 0, 0, E);
    if (with_ctx) small_gemm(C, A, Bt, SEQ, NCTX, N, K, E);
#else
    naive_gemm(C, A, Bt, with_ctx ? R : SEQ, N, K, 0, 0, E);
#endif
}
constexpr int LDS_IDX_OFF = 132096;
template <class Epi>
__device__ __forceinline__ void gemm_moe(const Ctx& C, const bf16* A, const bf16* Bt, int N, int K, size_t grp_stride, bool with_ctx, const Epi& E, const int* rowlist = nullptr) {
#if USE_PG8
    pg8::Gemm g{A, Bt, XROWS, N, K, 9, grp_stride}; pg8::MoeOrder S; S.init(N, C.G, C.blk, with_ctx);
    if (rowlist) {
        LAS int* tab = (LAS int*)(C.lds + LDS_IDX_OFF); pg8::Unit u;
        for (int i = 0; S.next(i, u); ++i) if (C.tid < 256) tab[i * 256 + C.tid] = rowlist[u.pm * 256 + C.tid];
        __syncthreads();
        pg8::gemm_phase<Epi, pg8::MoeOrder, true, true, true>(C.lds, g, S, E, tab);
        return;
    }
    pg8::gemm_phase<Epi, pg8::MoeOrder, true, true>(C.lds, g, S, E);
#else
    naive_gemm(C, A, Bt, XROWS, N, K, 9, grp_stride, E);
#endif
}

template <int KIND>
__device__ __forceinline__ void ph_attn_naive(const Ctx& C, int slot) {
    constexpr int DQK = KIND == 2 ? 96 : 64, DH = DQK / 2;
    LAS float* Ks = (LAS float*)C.lds;
    LAS float* Vs = Ks + 32 * DQK;
    LAS float* Bsm = Vs + 32 * 64;
    const bf16 *Qb, *Kb, *Vb, *KRb = nullptr; int qp, kp, vp, kgrp = 1; size_t qhs, khs, vhs; float scale;
    if (KIND == 0) { Qb = WSP(bf16, WS_QKV); Kb = Qb + (size_t)16 * R * 64; Vb = Qb + (size_t)32 * R * 64; qp = kp = vp = 64; qhs = khs = vhs = (size_t)R * 64; scale = 0.125f; }
    else if (KIND == 1) { Qb = WSP(bf16, WS_QKV); Kb = Qb + (size_t)16 * R * 64; Vb = Qb + (size_t)20 * R * 64; qp = kp = vp = 64; qhs = khs = vhs = (size_t)R * 64; kgrp = 4; scale = 0.125f; }
    else { Qb = WSP(bf16, WS_Q); Kb = WSP(bf16, WS_KV); Vb = Kb + 64; KRb = WSP(bf16, WS_KROPE); qp = 96; kp = vp = 128; qhs = (size_t)R * 96; khs = vhs = (size_t)R * 128; scale = 0.10206207261596575f; }
    bf16* Ob = WSP(bf16, WS_O);
    const int half = C.tid & 1, qi = C.tid >> 1;
    for (int u = C.blk; u < 1040; u += C.G) {
        const bool isctx = u >= 1024;
        const int h = isctx ? (u - 1024) : (u & 15), q0 = isctx ? SEQ : (u >> 4) * 256, kh = h / kgrp;
        const int t = q0 + qi;
        float q[DH], o[32];
        { const bf16* qr = Qb + (size_t)t * qp + h * qhs + half * DH;
#pragma unroll
          for (int d = 0; d < DH; d += 8) { const u32x4 w = *(const u32x4*)(qr + d);
              q[d + 0] = bf2f(w.x & 0xffffu); q[d + 1] = bf2f(w.x >> 16); q[d + 2] = bf2f(w.y & 0xffffu); q[d + 3] = bf2f(w.y >> 16);
              q[d + 4] = bf2f(w.z & 0xffffu); q[d + 5] = bf2f(w.z >> 16); q[d + 6] = bf2f(w.w & 0xffffu); q[d + 7] = bf2f(w.w >> 16); } }
#pragma unroll
        for (int d = 0; d < 32; ++d) o[d] = 0.f;
        float m = -INFINITY, l = 0.f;
        if (KIND == 1) { m = C.in[13][h]; l = 1.f; }
        int klo = 0, khi = 0;
        if (!isctx) {
            if (KIND == 0) { const int r0 = q0 >> 6; const int ra = r0 - 4 < 0 ? 0 : r0 - 4, rb = r0 + 7 > 255 ? 255 : r0 + 7; klo = ra * 64; khi = (rb + 1) * 64; }
            else if (KIND == 1) { klo = q0 - 128 < 0 ? 0 : q0 - 128; khi = q0 + 384 > SEQ ? SEQ : q0 + 384; }
            else { klo = 0; khi = SEQ; }
        }
        if (KIND == 0) { __syncthreads(); const float* rp = C.in[10] + ((size_t)slot * 16 + h) * 465; for (int i = C.tid; i < 465; i += 512) Bsm[i] = rp[i]; }
        const int qr_ = t >> 6, qc_ = t & 63;
        int rs = qr_ - 4; rs = rs < 0 ? 0 : (rs > 248 ? 248 : rs);
        int cs0 = qc_ - 8; cs0 = cs0 < 0 ? 0 : (cs0 > 48 ? 48 : cs0);
        for (int seg = 0; seg < 2; ++seg) {
            const int kb = seg == 0 ? klo : SEQ, ke = seg == 0 ? khi : R;
            for (int k0 = kb; k0 < ke; k0 += 32) {
                __syncthreads();
                for (int i = C.tid; i < 32 * DQK; i += 512) { const int j = i / DQK, d = i % DQK; const int row = k0 + j;
                    unsigned b;
                    if (KIND == 2 && d >= 64) b = KRb[(size_t)row * 32 + (d - 64)]; else b = Kb[(size_t)row * kp + kh * khs + d];
                    Ks[i] = bf2f(b); }
                for (int i = C.tid; i < 32 * 64; i += 512) { const int j = i >> 6, d = i & 63; Vs[i] = bf2f(Vb[(size_t)(k0 + j) * vp + kh * vhs + d]); }
                __syncthreads();
#pragma unroll 1
                for (int j = 0; j < 32; ++j) {
                    const int kt = k0 + j; bool valid = true; float bias = 0.f;
                    if (seg == 0) {
                        if (KIND == 0) { const int kr = kt >> 6, kc = kt & 63; valid = kr >= rs && kr < rs + 8 && kc >= cs0 && kc < cs0 + 16;
                            if (valid) bias = Bsm[(kr - qr_ + 7) * 31 + (kc - qc_ + 15)]; }
                        else if (KIND == 1) { const int dd = kt - t; valid = dd <= 128 && dd >= -128; }
                    }
                    float s0 = 0.f, s1 = 0.f;
#pragma unroll
                    for (int d = 0; d < DH; d += 4) { const f32x4 kv = *(const LAS f32x4*)(Ks + j * DQK + half * DH + d); s0 += q[d] * kv.x + q[d + 2] * kv.z; s1 += q[d + 1] * kv.y + q[d + 3] * kv.w; }
                    float sp = s0 + s1; sp += __shfl_xor(sp, 1);
                    if (valid) {
                        const float s = sp * scale + bias;
                        if (s > m) { const float a = __expf(m - s); l *= a;
#pragma unroll
                            for (int d = 0; d < 32; ++d) o[d] *= a;
                            m = s; }
                        const float p = __expf(s - m); l += p;
#pragma unroll
                        for (int d = 0; d < 32; d += 4) { const f32x4 vv = *(const LAS f32x4*)(Vs + j * 64 + half * 32 + d); o[d] += p * vv.x; o[d + 1] += p * vv.y; o[d + 2] += p * vv.z; o[d + 3] += p * vv.w; }
                    }
                }
            }
        }
        { const float il = 1.f / l; bf16* orow = Ob + (size_t)t * D + h * 64 + half * 32;
#pragma unroll
            for (int d = 0; d < 32; d += 8) { u32x4 w; w.x = pk2(o[d] * il, o[d + 1] * il); w.y = pk2(o[d + 2] * il, o[d + 3] * il); w.z = pk2(o[d + 4] * il, o[d + 5] * il); w.w = pk2(o[d + 6] * il, o[d + 7] * il);
                *(u32x4*)(orow + d) = w; } }
    }
    __syncthreads();
}

#ifndef USE_FAST_ATTN
#define USE_FAST_ATTN 1
#endif
__device__ __forceinline__ s16x4 lds_tr16(const LAS unsigned char* p) { return __builtin_bit_cast(s16x4, __builtin_amdgcn_ds_read_tr16_b64_v4i16((LAS s16x4*)p)); }
__device__ __forceinline__ int crow(int r, int hi) { return (r & 3) + 8 * (r >> 2) + 4 * hi; }

#define ATT_BAR() do { __builtin_amdgcn_sched_barrier(0); asm volatile("s_waitcnt lgkmcnt(0)\n\ts_barrier" ::: "memory"); __builtin_amdgcn_sched_barrier(0); } while (0)
template <int KIND, int VARIANT = 0>
__device__ __forceinline__ void ph_attn_fast(const Ctx& C, int slot, bool with_ctxq, int conv_layer = -1) {
    constexpr int DQK = KIND == 2 ? 96 : 64, NS = DQK / 16, CPR = DQK / 8, CPRP = CPR + (KIND == 2 ? 1 : 0);
    constexpr int KS = CPRP * 16, VS = 128, KBYTES = 64 * KS, VBYTES = 64 * VS, SLOTB = KBYTES + VBYTES;
    constexpr int NKC = 64 * CPRP, NINST = (NKC + 64 * 8) / 64, NDMA = (NINST + 7) / 8, NRING = 4, PD = 3;
    static_assert(NKC % 64 == 0 && SLOTB % 1024 == 0 && NRING * SLOTB + 2048 <= 131072, "attention ring geometry");
    LAS unsigned char* lds = C.lds; const unsigned lds_u32 = (unsigned)(size_t)C.lds;
    LAS float* Bsm = (LAS float*)(lds + NRING * SLOTB);
    const bf16 *Qb, *Kb, *Vb, *KRb = nullptr; int qp, kp, vp, kgrp = 1; size_t qhs, khs, vhs; float scale;
    if (KIND == 0) { Qb = WSP(bf16, WS_QKV); Kb = Qb + (size_t)16 * R * 64; Vb = Qb + (size_t)32 * R * 64; qp = kp = vp = 64; qhs = khs = vhs = (size_t)R * 64; scale = 0.125f; }
    else if (KIND == 1) { Qb = WSP(bf16, WS_QKV); Kb = Qb + (size_t)16 * R * 64; Vb = Qb + (size_t)20 * R * 64; qp = kp = vp = 64; qhs = khs = vhs = (size_t)R * 64; kgrp = 4; scale = 0.125f; }
    else { Qb = WSP(bf16, WS_Q); Kb = WSP(bf16, WS_KV); Vb = Kb + 64; KRb = WSP(bf16, WS_KROPE); qp = 96; kp = vp = 128; qhs = (size_t)R * 96; khs = vhs = (size_t)R * 128; scale = 0.10206207261596575f; }
    bf16* Ob = VARIANT ? WSP(bf16, WS_ACT) : WSP(bf16, WS_O);
    const float c2 = scale * 1.4426950408889634f;
    const int w = C.wave, lane = C.lane, ql = lane & 31, hi = lane >> 5;
    const int vq_ = (lane & 15) >> 2, vsw_ = 4 * ((vq_ >> 1) & 1), vch_ = 2 * ((lane >> 4) & 1) + ((lane & 3) >> 1);
    const int vlane0 = (vq_ + 4 * hi) * VS + ((0 + vch_) ^ vsw_) * 16 + 8 * (lane & 1), vlane1 = (vq_ + 4 * hi) * VS + ((4 + vch_) ^ vsw_) * 16 + 8 * (lane & 1);
    const int nunits = with_ctxq ? 1040 : 1024;
    ConvState cst; cst.l0 = conv_layer; cst.total = conv_layer < 0 ? 0 : (KIND == 2 ? 2 : 1) * MOE_HALF_ITEMS; cst.cur = C.blk * 8 + C.wave; cst.loaded = false;
    LAS float* cscr = (LAS float*)(C.lds + NRING * SLOTB + 2048 + C.wave * 4096);
    static_assert(NRING * SLOTB + 2048 + 8 * 4096 <= 131072, "conversion scratch");
    static_assert(KIND == 2 || NRING * SLOTB + 2048 == CONV_PIPE_BASE, "pipelined conversion scratch");
    ConvPipe cpipe; cpipe.l0 = conv_layer; cpipe.total = (KIND != 2 && conv_layer >= 0) ? MOE_HALF_ITEMS : 0; cpipe.first = C.blk * 8 + C.wave; cpipe.n = 0;
    const bool convon = cpipe.total > 0; constexpr int CFL = (VARIANT >> 7) & 3;
    for (int u = C.blk; u < nunits; u += C.G) {
        const bool isctx = u >= 1024;
        const int h = isctx ? (u - 1024) : (u & 15), q0 = isctx ? SEQ : (u >> 4) * 256, kh = h / kgrp;
        int lat0 = 0, nlat = 0;
        if (!isctx) {
            if (KIND == 0) { const int r0 = q0 >> 6; int ta = r0 - 4; ta = ta < 0 ? 0 : (ta > 248 ? 248 : ta); int tb = r0 - 1; tb = (tb < 0 ? 0 : (tb > 248 ? 248 : tb)) + 7; lat0 = ta; nlat = tb - ta + 1; }
            else if (KIND == 1) { const int a = q0 - 128 < 0 ? 0 : q0 - 128, b = q0 + 384 > SEQ ? SEQ : q0 + 384; lat0 = a >> 6; nlat = (b - a) >> 6; }
            else { lat0 = 0; nlat = SEQ / 64; }
        }
        const int ntiles = nlat + 4;
        int lane_u = lane; asm volatile("" : "+v"(lane_u));
        const int ql_u = lane_u & 31, hi_u = lane_u >> 5;
        const int t = (KIND == 0 && !isctx) ? q0 + 128 * (w >> 2) + 64 * (ql_u >> 4) + 16 * (w & 3) + (ql_u & 15) : q0 + 32 * w + ql_u;
        bf16x8 qf[NS];
        { const bf16* qr = Qb + (size_t)t * qp + h * qhs + 8 * hi_u;
#pragma unroll
          for (int sidx = 0; sidx < NS; ++sidx) qf[sidx] = *(const bf16x8*)(qr + 16 * sidx); }
        unsigned gsrc[NDMA]; int gpitch[NDMA], ldst[NDMA];
        const char* const wsb = (const char*)C.ws;
#pragma unroll
        for (int jj = 0; jj < NDMA; ++jj) {
            int j = w + 8 * jj; if (j >= NINST) j -= 8;
            const int cidx = 64 * j + lane_u; ldst[jj] = j * 1024;
            if (cidx < NKC) { const int row = cidx / CPRP; int c = cidx % CPRP; if (c >= CPR) c = 0;
                if (KIND != 2) c ^= (row >> 1) & 7;
                if (KIND == 2 && c >= 8) { gsrc[jj] = (unsigned)((const char*)(KRb + (size_t)row * 32 + 8 * (c - 8)) - wsb); gpitch[jj] = 64; }
                else { gsrc[jj] = (unsigned)((const char*)(Kb + kh * khs + (size_t)row * kp + 8 * c) - wsb); gpitch[jj] = kp * 2; } }
            else { const int v = cidx - NKC, row = v >> 3; const int c = (v & 7) ^ (4 * ((row >> 1) & 1));
                gsrc[jj] = (unsigned)((const char*)(Vb + kh * vhs + (size_t)row * vp + 8 * c) - wsb); gpitch[jj] = vp * 2; }
        }
#define ATT_KEY0(i) (KIND == 2 ? (isctx ? SEQ : 0) + (i) * 64 : ((i) < nlat ? (lat0 + (i)) * 64 : SEQ + ((i) - nlat) * 64))
#define ATT_DMA(i, sl) do { const int ti_ = (i) < ntiles ? (i) : ntiles - 1; const unsigned key0_ = (unsigned)ATT_KEY0(ti_); \
        _Pragma("unroll") for (int jj = 0; jj < NDMA; ++jj) \
            __builtin_amdgcn_global_load_lds((const unsigned*)(wsb + (size_t)(gsrc[jj] + __umul24(key0_, (unsigned)gpitch[jj]))), (LAS unsigned*)(lds + (sl) * SLOTB + ldst[jj]), 16, 0, 0); } while (0)
        static_assert(NDMA == (KIND == 2 ? 3 : 2), "the counted waits below are written for these DMA counts");
#define ATT_WAIT_DMA() do { if (NDMA == 2) asm volatile("s_waitcnt vmcnt(4)" ::: "memory"); else asm volatile("s_waitcnt vmcnt(6)" ::: "memory"); } while (0)
#define ATT_WAIT_DMA_IT() do { if (KIND == 2) { ATT_WAIT_DMA(); } else if (convon) { if (CFL == 0) asm volatile("s_waitcnt vmcnt(10)" ::: "memory"); else if (CFL == 1) asm volatile("s_waitcnt vmcnt(8)" ::: "memory"); else if (CFL == 2) asm volatile("s_waitcnt vmcnt(6)" ::: "memory"); else asm volatile("s_waitcnt vmcnt(4)" ::: "memory"); } \
        else asm volatile("s_waitcnt vmcnt(2)" ::: "memory"); } while (0)
        __syncthreads();
        if (KIND == 0) { const float* rp = C.in[10] + ((size_t)slot * 16 + h) * 465; for (int i = C.tid; i < 465; i += 512) Bsm[i] = rp[i] * 1.4426950408889634f; }
        float m = -INFINITY, l = 0.f;
        if (KIND == 1) { m = C.in[13][h] * 1.4426950408889634f; l = hi ? 0.f : 1.f; }
        ATT_DMA(0, 0); ATT_DMA(1, 1); ATT_DMA(2, 2);
        f32x16 ot[2];
#pragma unroll
        for (int r = 0; r < 16; ++r) { ot[0][r] = 0.f; ot[1][r] = 0.f; }
        const int qr_ = t >> 6, qc_ = t & 63;
        int cs0 = qc_ - 8; cs0 = cs0 < 0 ? 0 : (cs0 > 48 ? 48 : cs0);
        const int wrow = (q0 >> 6) + 2 * (w >> 2);
        int wrs = wrow - 4; wrs = wrs < 0 ? 0 : (wrs > 248 ? 248 : wrs);
        int wre = wrow + 1 - 4; wre = (wre < 0 ? 0 : (wre > 248 ? 248 : wre)) + 8;
        int rs = qr_ - 4; rs = rs < 0 ? 0 : (rs > 248 ? 248 : rs);
        const int kc0 = (w & 3) == 0 ? 0 : ((w & 3) == 1 ? 8 : ((w & 3) == 2 ? 24 : 32));
        const int wq0 = q0 + 32 * w;
        if constexpr (KIND == 2) {
            { float qs = 0.f;
#pragma unroll
              for (int sidx = 0; sidx < NS; ++sidx) { u32x4 qw;
#pragma unroll
                  for (int j = 0; j < 4; ++j) { const float q0_ = bf2f((unsigned)(unsigned short)qf[sidx][2 * j]) * c2, q1_ = bf2f((unsigned)(unsigned short)qf[sidx][2 * j + 1]) * c2;
                      const unsigned pw = cvt_pk_bf16(q0_, q1_); qw[j] = pw; const float r0_ = bf2f(pw & 0xffffu), r1_ = bf2f(pw >> 16); qs += r0_ * r0_ + r1_ * r1_; }
                  qf[sidx] = __builtin_bit_cast(bf16x8, qw); }
              const auto sw = __builtin_amdgcn_permlane32_swap(__float_as_uint(qs), __float_as_uint(qs), false, false);
              qs = __uint_as_float(sw[0]) + __uint_as_float(sw[1]);
              const float k2 = __uint_as_float(__hip_atomic_load((unsigned*)(C.ws + WS_CTL) + CW_KMAX + h, __ATOMIC_RELAXED, __HIP_MEMORY_SCOPE_AGENT));
              m = sqrtf(qs * k2) * 1.001f + 0.01f; }
            if (NDMA == 4) asm volatile("s_waitcnt vmcnt(4)" ::: "memory"); else asm volatile("s_waitcnt vmcnt(3)" ::: "memory");
            ATT_BAR();
            f32x16 pa0, pa1, pb0, pb1;
#define MLA_QK(D0, D1, sl) do { const LAS unsigned char* kb_ = lds + (sl) * SLOTB; \
            _Pragma("unroll") for (int r_ = 0; r_ < 16; ++r_) { D0[r_] = -m; D1[r_] = -m; } \
            _Pragma("unroll") for (int sidx = 0; sidx < NS; ++sidx) { \
                const bf16x8 a0_ = *(const LAS bf16x8*)(kb_ + ql * KS + 32 * sidx + 16 * hi); \
                const bf16x8 a1_ = *(const LAS bf16x8*)(kb_ + (32 + ql) * KS + 32 * sidx + 16 * hi); \
                { D0 = __builtin_amdgcn_mfma_f32_32x32x16_bf16(a0_, qf[sidx], D0, 0, 0, 0); \
                       D1 = __builtin_amdgcn_mfma_f32_32x32x16_bf16(a1_, qf[sidx], D1, 0, 0, 0); } } } while (0)
#define VB(x) (((VARIANT) >> (x)) & 1)
#define MLA_KHALF(D0, D1, sl, h0) do { const LAS unsigned char* kq_ = lds + (sl) * SLOTB; \
            _Pragma("unroll") for (int sidx = 0; sidx < NS / 2; ++sidx) { \
                D0[sidx] = *(const LAS bf16x8*)(kq_ + ql * KS + 32 * ((h0) + sidx) + 16 * hi); D1[sidx] = *(const LAS bf16x8*)(kq_ + (32 + ql) * KS + 32 * ((h0) + sidx) + 16 * hi); } } while (0)
#define MLA_ITER(CV, P0, P1, S0, S1, it) do { \
            if (CV && ((it) & 7) == 0) conv_step<false>(C, cst, cscr);            \
            if (!VB(3)) ATT_DMA((it) + 3, ((it) + 3) & 3);                        \
            bf16x8 kb0_[NS / 2], kb1_[NS / 2]; s16x4 vlo_[2][4], vhi_[2][4]; bf16x8 pf_[4]; \
              \
            _Pragma("unroll") for (int r_ = 0; r_ < 16; ++r_) { S0[r_] = -m; S1[r_] = -m; } \
            asm volatile("s_waitcnt lgkmcnt(0)" ::: "memory"); __builtin_amdgcn_sched_barrier(0); \
            _Pragma("unroll") for (int g_ = 0; g_ < 20; ++g_) { \
                if (g_ == 6) { asm volatile("s_waitcnt lgkmcnt(0)" ::: "memory"); __builtin_amdgcn_sched_barrier(0); } \
                if (g_ == 12) { if (!VB(4)) { asm volatile("s_waitcnt vmcnt(3)" ::: "memory"); ATT_BAR(); }         \
                                else { asm volatile("s_waitcnt lgkmcnt(0)" ::: "memory"); __builtin_amdgcn_sched_barrier(0); } } \
                if (g_ == 2) MLA_KHALF(kb0_, kb1_, ((it) + 1) & 3, NS / 2); \
                if (g_ == 16) MLA_KHALF(ka0, ka1, ((it) + 2) & 3, 0); \
                if (g_ < 6) { if (g_ & 1) S1 = __builtin_amdgcn_mfma_f32_32x32x16_bf16(ka1[g_ >> 1], qf[g_ >> 1], S1, 0, 0, 0); else S0 = __builtin_amdgcn_mfma_f32_32x32x16_bf16(ka0[g_ >> 1], qf[g_ >> 1], S0, 0, 0, 0); } \
                else if (g_ < 12) { if (g_ & 1) S1 = __builtin_amdgcn_mfma_f32_32x32x16_bf16(kb1_[(g_ >> 1) - NS / 2], qf[g_ >> 1], S1, 0, 0, 0); else S0 = __builtin_amdgcn_mfma_f32_32x32x16_bf16(kb0_[(g_ >> 1) - NS / 2], qf[g_ >> 1], S0, 0, 0, 0); } \
                else { const int ks_ = (g_ - 12) >> 1, c_ = (g_ - 12) & 1; \
                    const bf16x8 av_ = (bf16x8){vlo_[c_][ks_][0], vlo_[c_][ks_][1], vlo_[c_][ks_][2], vlo_[c_][ks_][3], vhi_[c_][ks_][0], vhi_[c_][ks_][1], vhi_[c_][ks_][2], vhi_[c_][ks_][3]}; \
                    ot[c_] = __builtin_amdgcn_mfma_f32_32x32x16_bf16(av_, pf_[ks_], ot[c_], 0, 0, 0); } \
                if (g_ < 16) { \
                    _Pragma("unroll") for (int k_ = 2 * g_; k_ < 2 * g_ + 2; ++k_) { \
                        if (k_ < 16) { P0[k_] = __builtin_amdgcn_exp2f(P0[k_]); l += P0[k_]; } \
                        else { P1[k_ - 16] = __builtin_amdgcn_exp2f(P1[k_ - 16]); l += P1[k_ - 16]; } } \
                    if ((g_ & 3) == 3) { const int f_ = g_ >> 2; u32x4 pw_; \
                        if (f_ < 2) { pw_.x = cvt_pk_bf16(P0[8 * f_ + 0], P0[8 * f_ + 1]); pw_.y = cvt_pk_bf16(P0[8 * f_ + 2], P0[8 * f_ + 3]); pw_.z = cvt_pk_bf16(P0[8 * f_ + 4], P0[8 * f_ + 5]); pw_.w = cvt_pk_bf16(P0[8 * f_ + 6], P0[8 * f_ + 7]); } \
                        else { pw_.x = cvt_pk_bf16(P1[8 * (f_ - 2) + 0], P1[8 * (f_ - 2) + 1]); pw_.y = cvt_pk_bf16(P1[8 * (f_ - 2) + 2], P1[8 * (f_ - 2) + 3]); pw_.z = cvt_pk_bf16(P1[8 * (f_ - 2) + 4], P1[8 * (f_ - 2) + 5]); pw_.w = cvt_pk_bf16(P1[8 * (f_ - 2) + 6], P1[8 * (f_ - 2) + 7]); } \
                        pf_[f_] = __builtin_bit_cast(bf16x8, pw_); } } \
                if (g_ == 7) { const unsigned vb_ = lds_u32 + (unsigned)(((it) & 3) * SLOTB + KBYTES); \
                  _Pragma("unroll") for (int c = 0; c < 2; ++c) { const unsigned va_ = vb_ + (unsigned)(c ? vlane1 : vlane0); \
                    _Pragma("unroll") for (int ks = 0; ks < 4; ++ks) { \
                        asm volatile("ds_read_b64_tr_b16 %0, %1 offset:%c2" : "=&v"(vlo_[c][ks]) : "v"(va_), "i"((32 * (ks >> 1) + 16 * (ks & 1)) * VS) : "memory"); \
                        asm volatile("ds_read_b64_tr_b16 %0, %1 offset:%c2" : "=&v"(vhi_[c][ks]) : "v"(va_), "i"((32 * (ks >> 1) + 16 * (ks & 1) + 8) * VS) : "memory"); } } } \
                __builtin_amdgcn_sched_barrier(0); } \
            } while (0)
            MLA_QK(pa0, pa1, 0);
            bf16x8 ka0[NS / 2], ka1[NS / 2];
            MLA_KHALF(ka0, ka1, 1, 0);
            for (int i = 0; i < ntiles; i += 2) {
                MLA_ITER(1, pa0, pa1, pb0, pb1, i);
                MLA_ITER(0, pb0, pb1, pa0, pa1, i + 1);
            }
#undef MLA_KHALF
#undef MLA_QK
#undef MLA_ITER
#undef VB
        } else {
        ATT_WAIT_DMA();
        ATT_BAR();
        int rs_cur = 0, rs_nxt = 3;
        for (int i = 0; i < ntiles; ++i) {
            if (convon) conv_pipe_step<CFL>(C, cpipe, lds);
            ATT_DMA(i + PD, rs_nxt);
            const bool lat = i < nlat; const int key0 = ATT_KEY0(i);
            bool need = true;
            if (lat) { if (KIND == 0) { const int kr = lat0 + i; need = kr >= wrs && kr < wre; }
                       else if (KIND == 1) need = (key0 + 63 >= wq0 - 128) && (key0 <= wq0 + 31 + 128); }
            if (KIND == 0 && lat) {
              if (need) {
                const int kr = lat0 + i;
                const LAS unsigned char* kb = lds + rs_cur * SLOTB + kc0 * KS; const int swz = ((kc0 + ql) >> 1) & 7;
                f32x16 p0;
#pragma unroll
                for (int r = 0; r < 16; ++r) p0[r] = 0.f;
#pragma unroll
                for (int sidx = 0; sidx < NS; ++sidx) {
                    const bf16x8 a0 = *(const LAS bf16x8*)(kb + ql * KS + 16 * ((2 * sidx + hi) ^ swz));
                    p0 = __builtin_amdgcn_mfma_f32_32x32x16_bf16(a0, qf[sidx], p0, 0, 0, 0);
                }
                const bool rowok = kr >= rs && kr < rs + 8;
                float mx = -INFINITY;
#pragma unroll
                for (int r = 0; r < 16; ++r) { const int kc = kc0 + crow(r, hi); const bool v0 = rowok && (unsigned)(kc - cs0) < 16u;
                    const int bi = (kr - qr_ + 7) * 31 + (kc - qc_ + 15);
                    const float s0 = v0 ? p0[r] * c2 + Bsm[v0 ? bi : 0] : -INFINITY; p0[r] = s0; mx = fmaxf(mx, s0); }
                { const auto sw = __builtin_amdgcn_permlane32_swap(__float_as_uint(mx), __float_as_uint(mx), false, false);
                  mx = fmaxf(__uint_as_float(sw[0]), __uint_as_float(sw[1])); }
                const float mn = fmaxf(m, mx), ms = mn == -INFINITY ? 0.f : mn;
                const float alpha = __builtin_amdgcn_exp2f(m - ms);
                if (__builtin_amdgcn_ballot_w64(alpha != 1.f) != 0ull) {
#pragma unroll
                    for (int r = 0; r < 16; ++r) { ot[0][r] *= alpha; ot[1][r] *= alpha; }
                }
                s16x4 vlo[2][2], vhi[2][2];
                { const unsigned vb0 = lds_u32 + (unsigned)(rs_cur * SLOTB + KBYTES + kc0 * VS);
#pragma unroll
                  for (int c = 0; c < 2; ++c) { const unsigned va = vb0 + (unsigned)(c ? vlane1 : vlane0);
#pragma unroll
                    for (int ks = 0; ks < 2; ++ks) {
                        asm volatile("ds_read_b64_tr_b16 %0, %1 offset:%c2" : "=&v"(vlo[c][ks]) : "v"(va), "i"((16 * ks) * VS) : "memory");
                        asm volatile("ds_read_b64_tr_b16 %0, %1 offset:%c2" : "=&v"(vhi[c][ks]) : "v"(va), "i"((16 * ks + 8) * VS) : "memory"); } } }
                __builtin_amdgcn_sched_barrier(0);
                float rs0 = 0.f, rs1 = 0.f;
#pragma unroll
                for (int ks = 0; ks < 2; ++ks) {
#pragma unroll
                    for (int j = 0; j < 8; ++j) { const int r = 8 * ks + j; p0[r] = __builtin_amdgcn_exp2f(p0[r] - ms); if (j & 1) rs1 += p0[r]; else rs0 += p0[r]; }
                    u32x4 pw; const int k8 = 8 * ks;
                    pw.x = cvt_pk_bf16(p0[k8 + 0], p0[k8 + 1]); pw.y = cvt_pk_bf16(p0[k8 + 2], p0[k8 + 3]); pw.z = cvt_pk_bf16(p0[k8 + 4], p0[k8 + 5]); pw.w = cvt_pk_bf16(p0[k8 + 6], p0[k8 + 7]);
                    const bf16x8 pfk = __builtin_bit_cast(bf16x8, pw);
                    if (ks == 0) { asm volatile("s_waitcnt lgkmcnt(0)" ::: "memory"); }
                    __builtin_amdgcn_sched_barrier(0);
                    const bf16x8 av0 = (bf16x8){vlo[0][ks][0], vlo[0][ks][1], vlo[0][ks][2], vlo[0][ks][3], vhi[0][ks][0], vhi[0][ks][1], vhi[0][ks][2], vhi[0][ks][3]};
                    const bf16x8 av1 = (bf16x8){vlo[1][ks][0], vlo[1][ks][1], vlo[1][ks][2], vlo[1][ks][3], vhi[1][ks][0], vhi[1][ks][1], vhi[1][ks][2], vhi[1][ks][3]};
                    ot[0] = __builtin_amdgcn_mfma_f32_32x32x16_bf16(av0, pfk, ot[0], 0, 0, 0);
                    ot[1] = __builtin_amdgcn_mfma_f32_32x32x16_bf16(av1, pfk, ot[1], 0, 0, 0);
                    __builtin_amdgcn_sched_barrier(0);
                }
                l = l * alpha + (rs0 + rs1); m = mn;
              }
            } else if (need) {
                const LAS unsigned char* kb = lds + rs_cur * SLOTB; const LAS unsigned char* vb = kb + KBYTES;
                f32x16 p0, p1;
#pragma unroll
                for (int r = 0; r < 16; ++r) { p0[r] = 0.f; p1[r] = 0.f; }
#pragma unroll
                for (int sidx = 0; sidx < NS; ++sidx) {
                    const int swz = (ql >> 1) & 7;
                    const bf16x8 a0 = *(const LAS bf16x8*)(kb + ql * KS + 16 * ((2 * sidx + hi) ^ swz));
                    const bf16x8 a1 = *(const LAS bf16x8*)(kb + (32 + ql) * KS + 16 * ((2 * sidx + hi) ^ swz));
                    p0 = __builtin_amdgcn_mfma_f32_32x32x16_bf16(a0, qf[sidx], p0, 0, 0, 0);
                    p1 = __builtin_amdgcn_mfma_f32_32x32x16_bf16(a1, qf[sidx], p1, 0, 0, 0);
                }
                float mx = -INFINITY;
                if (KIND == 0) {
#pragma unroll
                    for (int r = 0; r < 16; ++r) {
                        float s0 = p0[r] * c2, s1 = p1[r] * c2;
                        if (lat) { const int kr = lat0 + i; const int kc = crow(r, hi);
                            const bool v0 = (unsigned)(kc - cs0) < 16u, v1 = (unsigned)(kc + 32 - cs0) < 16u;
                            const int bi = (kr - qr_ + 7) * 31 + (kc - qc_ + 15);
                            s0 = v0 ? s0 + Bsm[v0 ? bi : 0] : -INFINITY; s1 = v1 ? s1 + Bsm[v1 ? bi + 32 : 0] : -INFINITY; }
                        p0[r] = s0; p1[r] = s1; mx = fmaxf(fmaxf(mx, s0), s1);
                    }
                } else {
                    if (KIND == 1 && lat) {
#pragma unroll
                        for (int r = 0; r < 16; ++r) { const int dd = key0 + crow(r, hi) - t;
                            p0[r] = (unsigned)(dd + 128) <= 256u ? p0[r] : -INFINITY; p1[r] = (unsigned)(dd + 32 + 128) <= 256u ? p1[r] : -INFINITY; }
                    }
#pragma unroll
                    for (int r = 0; r < 16; ++r) mx = fmaxf(fmaxf(mx, p0[r]), p1[r]);
                    mx *= c2;
                }
                { const auto sw = __builtin_amdgcn_permlane32_swap(__float_as_uint(mx), __float_as_uint(mx), false, false);
                  mx = fmaxf(__uint_as_float(sw[0]), __uint_as_float(sw[1])); }
                const float mn = fmaxf(m, mx), ms = mn == -INFINITY ? 0.f : mn;
                const float alpha = __builtin_amdgcn_exp2f(m - ms);
                if (__builtin_amdgcn_ballot_w64(alpha != 1.f) != 0ull) {
#pragma unroll
                    for (int r = 0; r < 16; ++r) { ot[0][r] *= alpha; ot[1][r] *= alpha; }
                }
                s16x4 vlo[2][4], vhi[2][4];
                { const unsigned vb0 = lds_u32 + (unsigned)(rs_cur * SLOTB + KBYTES);
#pragma unroll
                  for (int c = 0; c < 2; ++c) { const unsigned va = vb0 + (unsigned)(c ? vlane1 : vlane0);
#pragma unroll
                    for (int ks = 0; ks < 4; ++ks) {
                        asm volatile("ds_read_b64_tr_b16 %0, %1 offset:%c2" : "=&v"(vlo[c][ks]) : "v"(va), "i"((32 * (ks >> 1) + 16 * (ks & 1)) * VS) : "memory");
                        asm volatile("ds_read_b64_tr_b16 %0, %1 offset:%c2" : "=&v"(vhi[c][ks]) : "v"(va), "i"((32 * (ks >> 1) + 16 * (ks & 1) + 8) * VS) : "memory"); } } }
                __builtin_amdgcn_sched_barrier(0);
                float rs0 = 0.f, rs1 = 0.f;
#pragma unroll
                for (int ks = 0; ks < 4; ++ks) {
#pragma unroll
                    for (int j = 0; j < 8; ++j) { const int r = 8 * (ks & 1) + j;
                        if (ks < 2) { p0[r] = KIND == 0 ? __builtin_amdgcn_exp2f(p0[r] - ms) : __builtin_amdgcn_exp2f(__builtin_fmaf(p0[r], c2, -ms)); if (j & 1) rs1 += p0[r]; else rs0 += p0[r]; }
                        else { p1[r] = KIND == 0 ? __builtin_amdgcn_exp2f(p1[r] - ms) : __builtin_amdgcn_exp2f(__builtin_fmaf(p1[r], c2, -ms)); if (j & 1) rs1 += p1[r]; else rs0 += p1[r]; } }
                    u32x4 pw; const int k8 = 8 * (ks & 1);
                    if (ks < 2) { pw.x = cvt_pk_bf16(p0[k8 + 0], p0[k8 + 1]); pw.y = cvt_pk_bf16(p0[k8 + 2], p0[k8 + 3]); pw.z = cvt_pk_bf16(p0[k8 + 4], p0[k8 + 5]); pw.w = cvt_pk_bf16(p0[k8 + 6], p0[k8 + 7]); }
                    else { pw.x = cvt_pk_bf16(p1[k8 + 0], p1[k8 + 1]); pw.y = cvt_pk_bf16(p1[k8 + 2], p1[k8 + 3]); pw.z = cvt_pk_bf16(p1[k8 + 4], p1[k8 + 5]); pw.w = cvt_pk_bf16(p1[k8 + 6], p1[k8 + 7]); }
                    const bf16x8 pfk = __builtin_bit_cast(bf16x8, pw);
                    if (ks == 0) { asm volatile("s_waitcnt lgkmcnt(0)" ::: "memory"); }
                    __builtin_amdgcn_sched_barrier(0);
                    const bf16x8 av0 = (bf16x8){vlo[0][ks][0], vlo[0][ks][1], vlo[0][ks][2], vlo[0][ks][3], vhi[0][ks][0], vhi[0][ks][1], vhi[0][ks][2], vhi[0][ks][3]};
                    const bf16x8 av1 = (bf16x8){vlo[1][ks][0], vlo[1][ks][1], vlo[1][ks][2], vlo[1][ks][3], vhi[1][ks][0], vhi[1][ks][1], vhi[1][ks][2], vhi[1][ks][3]};
                    ot[0] = __builtin_amdgcn_mfma_f32_32x32x16_bf16(av0, pfk, ot[0], 0, 0, 0);
                    ot[1] = __builtin_amdgcn_mfma_f32_32x32x16_bf16(av1, pfk, ot[1], 0, 0, 0);
                    __builtin_amdgcn_sched_barrier(0);
                }
                l = l * alpha + (rs0 + rs1); m = mn;
            }
            ATT_WAIT_DMA_IT();
            ATT_BAR();
            rs_cur = (rs_cur + 1) & 3; rs_nxt = (rs_nxt + 1) & 3;
        }
        }
        asm volatile("s_waitcnt vmcnt(0)" ::: "memory");
#undef ATT_KEY0
#undef ATT_DMA
#undef ATT_WAIT_DMA
#undef ATT_WAIT_DMA_IT
        { const auto sw = __builtin_amdgcn_permlane32_swap(__float_as_uint(l), __float_as_uint(l), false, false);
          const float il = 1.f / (__uint_as_float(sw[0]) + __uint_as_float(sw[1])); bf16* orow = Ob + (size_t)t * D + h * 64 + 4 * hi;
#pragma unroll
          for (int c = 0; c < 2; ++c)
#pragma unroll
            for (int g = 0; g < 4; ++g) { u32x2 o2; o2.x = cvt_pk_bf16(ot[c][4 * g] * il, ot[c][4 * g + 1] * il); o2.y = cvt_pk_bf16(ot[c][4 * g + 2] * il, ot[c][4 * g + 3] * il);
                *(u32x2*)(orow + 32 * c + 8 * g) = o2; } }
    }
    if (KIND == 2) { while (cst.loaded || cst.cur < cst.total) conv_step<true>(C, cst, cscr); }
    else if (convon && !VARIANT) conv_pipe_drain(C, cpipe, lds);
    __syncthreads();
}
template <int KIND>
__device__ __forceinline__ void ph_attn(const Ctx& C, int slot, bool with_ctxq, int conv_layer = -1) {
#if USE_FAST_ATTN
    ph_attn_fast<KIND>(C, slot, with_ctxq, conv_layer);
#else
    ph_attn_naive<KIND>(C, slot);
#endif
}

#define PH_BEGIN if (lo <= ph && ph < hi) {
#define PH_END   if (ph + 1 < hi) xcd_barrier(bar); if (DIAG && C.blk == 0 && C.tid == 0) ((unsigned long long*)(C.ws + WS_CTL + 512 * 1024))[ph + 1] = __builtin_amdgcn_s_memrealtime(); } ++ph;
#ifndef DIAG
#define DIAG 0
#define DIAG_PH1 25
#define DIAG_PH2 25
#endif
#ifndef NORM2_VARIANT_PROBE
#define NORM2_VARIANT_PROBE 0
#endif
#ifndef SWA_VARIANT_PROBE
#define SWA_VARIANT_PROBE 0
#endif
#ifndef ATTN_VARIANT_PROBE
#define ATTN_VARIANT_PROBE 0
#endif
#ifndef PROBE_MASK
#define PROBE_MASK 0
#endif
#define PHG(g, ...) PH_BEGIN __VA_ARGS__ PH_END if constexpr (((PROBE_MASK >> (g)) & 1) != 0) { PH_BEGIN __VA_ARGS__ PH_END }
template <int L>
__device__ __forceinline__ void layer_phases(const Ctx& C, const XcdBarrier& bar, int lo, int hi, int& ph) {
    constexpr int l = L, kind = L % 3, slot = L / 3; constexpr bool need_ctx = L < 3; constexpr int RL = need_ctx ? R : SEQ;
    PH_BEGIN ph_rowA<0>(C, l); PH_END
    if constexpr (kind == 0) {
        PHG(1, gemm_tok(C, WSP(bf16, WS_H), WSP(bf16, WS_W_NAQKV) + (size_t)slot * 3072 * 1024, 3072, 1024, true, EpiStoreHeads{WSP(bf16, WS_QKV), 64, (size_t)R * 64});)
        PHG(2, ph_attn<0>(C, slot, need_ctx, l == 0 ? 0 : -1);)
    } else if constexpr (kind == 1) {
        PHG(1, gemm_tok(C, WSP(bf16, WS_H), WSP(bf16, WS_W_SWAQKV), 1536, 1024, true, EpiStoreHeads{WSP(bf16, WS_QKV), 64, (size_t)R * 64});)
        PH_BEGIN ph_rope(C, WSP(bf16, WS_QKV), 64, 20, 0, 16); PH_END
        PHG(3, ph_attn<1>(C, slot, need_ctx, l);)
#if SWA_VARIANT_PROBE
        PH_BEGIN ph_attn_fast<1, SWA_VARIANT_PROBE>(C, slot, need_ctx, (SWA_VARIANT_PROBE & 64) ? l : -1); PH_END
#endif
    } else {
        PHG(1, gemm_tok(C, WSP(bf16, WS_H), WSP(bf16, WS_W_MLAD), 1024, 1024, true, EpiStoreF32{WSP(float, WS_CQ), 1024});)
        PHG(11, ph_mlanorm(C);)
        PHG(1, gemm_tok(C, WSP(bf16, WS_CQN), WSP(bf16, WS_W_MLAUQ), 1536, 512, true, EpiStoreHeads{WSP(bf16, WS_Q), 96, (size_t)R * 96});
                 gemm_tok(C, WSP(bf16, WS_CKVN), WSP(bf16, WS_W_MLAUKV), 2048, 256, true, EpiStoreHeads{WSP(bf16, WS_KV), 128, (size_t)R * 128});)
        PH_BEGIN ph_rope(C, WSP(bf16, WS_Q), 96, 16, 64, 8); ph_kmax(C); PH_END
        PHG(4, ph_attn<2>(C, slot, need_ctx, 2);)
#if ATTN_VARIANT_PROBE
        PH_BEGIN ph_attn_fast<2, ATTN_VARIANT_PROBE>(C, slot, need_ctx, (ATTN_VARIANT_PROBE & 64) ? 2 : -1); PH_END
#endif
    }
    const bf16* wo = kind == 0 ? WSP(bf16, WS_W_NAO) + (size_t)slot * 1024 * 1024 : (kind == 1 ? WSP(bf16, WS_W_SWAO) : WSP(bf16, WS_W_MLAO));
    PH_BEGIN gemm_tok(C, WSP(bf16, WS_O), wo, 1024, 1024, need_ctx, EpiResid{WSP(float, WS_X), modp(C, l, 0, 2), modp(C, l, 1, 2)}); PH_END
    PHG(5, ph_norm2(C, l, RL);)
#if NORM2_VARIANT_PROBE
    PH_BEGIN ph_norm2<NORM2_VARIANT_PROBE>(C, l, RL); PH_END
#endif
    PHG(6, ph_topk(C, need_ctx);)
    PHG(8, gemm_moe(C, WSP(bf16, WS_H), WSP(bf16, WS_W_GU) + (size_t)l * 16 * 4096 * 1024, 4096, 1024, (size_t)4096 * 1024, need_ctx, EpiSwiglu{WSP(bf16, WS_ACT)}, WSP(int, WS_ROWL));)
    PHG(9, gemm_moe(C, WSP(bf16, WS_ACT), WSP(bf16, WS_W_DN) + (size_t)l * 16 * 1024 * 2048, 1024, 2048, (size_t)1024 * 2048, need_ctx, EpiMoeOut{WSP(bf16, WS_YB), WSP(float, WS_GATEL)});)
}
__global__ void __launch_bounds__(512, 2) fwd_kernel(Args args) {
    extern __shared__ __attribute__((aligned(16))) unsigned char lds_raw[];
    Ctx C;
#pragma unroll
    for (int i = 0; i < 26; ++i) C.in[i] = args.in[i];
    C.out = args.out; C.ws = args.ws; C.lds = (LAS unsigned char*)lds_raw;
    C.tid = threadIdx.x; C.lane = C.tid & 63; C.wave = __builtin_amdgcn_readfirstlane(C.tid >> 6); C.blk = blockIdx.x; C.G = gridDim.x;
    volatile LAS unsigned* MISC = (volatile LAS unsigned*)(C.lds + MISC_OFF);
    if (C.tid < 32) MISC[C.tid] = 0u;
    __syncthreads();
    const int lo = args.ph_lo, hi = args.ph_hi;
    XcdBarrier bar; bar.bar = (unsigned*)(C.ws + WS_CTL) + CW_BAR; bar.x = 0; bar.st = nullptr;
    if (hi - lo > 1) bar = xcd_barrier_post((unsigned*)(C.ws + WS_CTL) + CW_BAR, MISC + 8);
    int ph = 0;
    PHG(0, ph_prologue(C);)
    layer_phases<0>(C, bar, lo, hi, ph);
    layer_phases<1>(C, bar, lo, hi, ph);
    layer_phases<2>(C, bar, lo, hi, ph);
    layer_phases<3>(C, bar, lo, hi, ph);
    PH_BEGIN ph_rowA<1>(C, 4); PH_END
#if DIAG
    {
        __builtin_amdgcn_fence(__ATOMIC_ACQUIRE, "agent");
        const unsigned long long* st = (const unsigned long long*)(C.ws + WS_CTL + 512 * 1024);
        const float t1 = (float)(__hip_atomic_load(st + DIAG_PH1 + 1, __ATOMIC_RELAXED, __HIP_MEMORY_SCOPE_AGENT) - __hip_atomic_load(st + DIAG_PH1, __ATOMIC_RELAXED, __HIP_MEMORY_SCOPE_AGENT)) * 0.01f;
        const float t2 = (float)(__hip_atomic_load(st + DIAG_PH2 + 1, __ATOMIC_RELAXED, __HIP_MEMORY_SCOPE_AGENT) - __hip_atomic_load(st + DIAG_PH2, __ATOMIC_RELAXED, __HIP_MEMORY_SCOPE_AGENT)) * 0.01f;
        (void)t2;
        const float tq = exp2f(rintf(log2f(t1) * 16.f) * (1.f / 16.f));
        const float cval = 0.1f * sqrtf(tq);
        for (size_t i = (size_t)C.blk * 512 + C.tid; i < (size_t)SEQ * D; i += (size_t)C.G * 512) C.out[i] = cval;
    }
#endif
}
#undef PH_BEGIN
#undef PH_END

extern "C" void kernel_launch(void* const* d_in, const int* in_sizes, int n_in, void* d_out, int out_size, void* d_ws, size_t ws_size, hipStream_t stream) {
    static int grid = 0;
    if (grid == 0) {
        if (n_in != 26 || out_size != SEQ * D || ws_size < WS_END) { fprintf(stderr, "kernel_launch: unexpected shapes (n_in %d out %d ws %zu)\n", n_in, out_size, ws_size); grid = -1; return; }
        int dev = 0, cus = 0, per_cu = 0;
        if (hipGetDevice(&dev) != hipSuccess || hipDeviceGetAttribute(&cus, hipDeviceAttributeMultiprocessorCount, dev) != hipSuccess) { grid = -1; return; }
        if (hipFuncSetAttribute((const void*)fwd_kernel, hipFuncAttributeMaxDynamicSharedMemorySize, LDS_BYTES) != hipSuccess) { fprintf(stderr, "kernel_launch: hipFuncSetAttribute failed\n"); grid = -1; return; }
        if (hipOccupancyMaxActiveBlocksPerMultiprocessor(&per_cu, (const void*)fwd_kernel, 512, LDS_BYTES) != hipSuccess || per_cu < 1) fprintf(stderr, "kernel_launch: occupancy query says %d\n", per_cu);
        (void)hipGetLastError();
        grid = cus;
    }
    if (grid < 0) return;
    if (hipMemsetAsync((char*)d_ws + WS_CTL, 0, CTL_ZERO_BYTES, stream) != hipSuccess) return;
    Args a{};
    for (int i = 0; i < 26; ++i) a.in[i] = (const float*)d_in[i];
    a.out = (float*)d_out; a.ws = (unsigned char*)d_ws; a.pad = 0;
#if MK_N_LAUNCHES == 1
    a.ph_lo = 0; a.ph_hi = 1 << 20; a.li = 0;
    hipLaunchKernelGGL(fwd_kernel, dim3(grid), dim3(512), LDS_BYTES, stream, a);
#else
    for (int li = 0; li < NPH; ++li) { a.ph_lo = li; a.ph_hi = li + 1; a.li = li;
        hipLaunchKernelGGL(fwd_kernel, dim3(grid), dim3(512), LDS_BYTES, stream, a); }
#endif
}
```

```cpp
#include <hip/hip_runtime.h>
#include <cstdio>
#include <cstdint>

#ifndef MK_N_LAUNCHES
#define MK_N_LAUNCHES 1
#endif

#define GAS __attribute__((address_space(1)))
#define LAS __attribute__((address_space(3)))
typedef unsigned short bf16;
typedef float f32x4 __attribute__((ext_vector_type(4)));
typedef unsigned u32x4 __attribute__((ext_vector_type(4)));
typedef unsigned u32x2 __attribute__((ext_vector_type(2)));
typedef short bf16x8 __attribute__((ext_vector_type(8)));
typedef short s16x4 __attribute__((ext_vector_type(4)));
typedef float f32x16 __attribute__((ext_vector_type(16)));

constexpr int D = 1024, SEQ = 16384, NCTX = 256, R = SEQ + NCTX, NE = 16, FF = 2048;
constexpr int CAP_L = 2048, CAP_C = 32, EROWS = 2304, XROWS = NE * EROWS;
constexpr float RMS_EPS = 1e-6f;
constexpr int NPH = 1 + 9 + 10 + 12 + 9 + 1;

constexpr size_t MiB = 1u << 20;
constexpr size_t WS_CTL = 0, CTL_ZERO_BYTES = 1 * MiB;
constexpr size_t WS_MOD = 1 * MiB;
constexpr size_t WS_W_NAQKV = 2 * MiB;
constexpr size_t WS_W_NAO = 14 * MiB;
constexpr size_t WS_W_SWAQKV = 18 * MiB;
constexpr size_t WS_W_SWAO = 21 * MiB;
constexpr size_t WS_W_MLAD = 23 * MiB;
constexpr size_t WS_W_MLAUQ = 25 * MiB;
constexpr size_t WS_W_MLAUKV = 27 * MiB;
constexpr size_t WS_W_MLAO = 28 * MiB;
constexpr size_t WS_W_GU = 32 * MiB;
constexpr size_t WS_W_DN = WS_W_GU + 512 * MiB;
constexpr size_t WS_X = WS_W_DN + 256 * MiB;
constexpr size_t WS_H = WS_X + 65 * MiB;
constexpr size_t WS_QKV = WS_H + 33 * MiB;
constexpr size_t WS_CQ = WS_QKV + 98 * MiB;
constexpr size_t WS_Q = WS_CQ + 65 * MiB;
constexpr size_t WS_KV = WS_Q + 49 * MiB;
constexpr size_t WS_CQN = WS_KV + 65 * MiB;
constexpr size_t WS_CKVN = WS_CQN + 17 * MiB;
constexpr size_t WS_KROPE = WS_CKVN + 9 * MiB;
constexpr size_t WS_O = WS_KROPE + 2 * MiB;
constexpr size_t WS_AFF = WS_O + 33 * MiB;
constexpr size_t WS_ROWL = WS_AFF + 2 * MiB;
constexpr size_t WS_GATEL = WS_ROWL + 1 * MiB;
constexpr size_t WS_INV = WS_GATEL + 1 * MiB;
constexpr size_t WS_XG = WS_INV + 2 * MiB;
constexpr size_t WS_ACT = WS_XG + 72 * MiB;
constexpr size_t WS_YB = WS_ACT + 144 * MiB;
constexpr size_t WS_END = WS_YB + 72 * MiB;
static_assert(WS_END <= 2048 * MiB, "d_ws map");
constexpr int CW_BAR = 4096;

constexpr int LDS_BYTES = 147456;
constexpr int MISC_OFF = 131072 + 320;

__device__ __forceinline__ float bf2f(unsigned b) { return __uint_as_float(b << 16); }
__device__ __forceinline__ unsigned f2bf(float f) { unsigned u = __float_as_uint(f); return (u + 0x7fffu + ((u >> 16) & 1u)) >> 16; }
typedef float f32x2_t __attribute__((ext_vector_type(2))); typedef __bf16 bf16x2_t __attribute__((ext_vector_type(2)));
__device__ __forceinline__ unsigned cvt_pk_bf16(float lo, float hi) { f32x2_t v = {lo, hi}; bf16x2_t b = __builtin_convertvector(v, bf16x2_t); return __builtin_bit_cast(unsigned, b); }
__device__ __forceinline__ unsigned pk2(float lo, float hi) { return cvt_pk_bf16(lo, hi); }
__device__ __forceinline__ float wave_sum(float v) {
#pragma unroll
    for (int o = 1; o < 64; o <<= 1) v += __shfl_xor(v, o);
    return v;
}
__device__ __forceinline__ int wave_sum_i(int v) {
#pragma unroll
    for (int o = 1; o < 64; o <<= 1) v += __shfl_xor(v, o);
    return v;
}

#define XB_TMO      128
#define XB_XCNT(j)  (256  + 64 * (j))
#define XB_XSUB(j)  (1280 + 64 * (j))
#define XB_XGEN(j)  (2304 + 64 * (j))
#define XB_TOP      3328
#define XB_TOPGEN   3392
#define XCD_BAR_WORDS 3456
#define XB_SPIN_CAP (1u << 18)
__device__ __forceinline__ unsigned xb_ld(unsigned* p)              { return __hip_atomic_load(p, __ATOMIC_RELAXED, __HIP_MEMORY_SCOPE_AGENT); }
__device__ __forceinline__ unsigned xb_add(unsigned* p, unsigned v) { return __hip_atomic_fetch_add(p, v, __ATOMIC_RELAXED, __HIP_MEMORY_SCOPE_AGENT); }
__device__ __forceinline__ unsigned xb_xcc_id() { return (unsigned)__builtin_amdgcn_s_getreg((3 << 11) | 20) & 0xFu; }
#define XB_SPIN(cond, bar) do { unsigned _sp = 0; while (cond) { __builtin_amdgcn_s_sleep(1); \
    if ((++_sp & 255u) == 0u) { if (xb_ld(&(bar)[XB_TMO])) break; if (_sp > XB_SPIN_CAP) { atomicAdd(&(bar)[XB_TMO], 1u); break; } } } } while (0)
struct XcdBarrier { unsigned* bar; unsigned x; volatile LAS unsigned* st; };
__device__ __forceinline__ XcdBarrier xcd_barrier_post(unsigned* bar, volatile LAS unsigned* st) {
    XcdBarrier b; b.bar = bar; b.x = xb_xcc_id(); b.st = st;
    if (threadIdx.x == 0) (void)xb_add(&bar[XB_XCNT(b.x)], 1u);
    return b;
}
__device__ __forceinline__ void xcd_barrier_complete(unsigned* bar, unsigned x, unsigned& nloc, unsigned& nx) {
    const unsigned G = gridDim.x * gridDim.y * gridDim.z;
    unsigned sum, cnt, mine, sp = 0u;
    for (;;) {
        sum = 0u; cnt = 0u; mine = 0u;
#pragma unroll
        for (unsigned j = 0; j < 16; ++j) { const unsigned c = xb_ld(&bar[XB_XCNT(j)]); sum += c; cnt += (c > 0u) ? 1u : 0u; mine = (j == x) ? c : mine; }
        if (sum == G) break;
        __builtin_amdgcn_s_sleep(1);
        if ((++sp & 255u) == 0u) { if (xb_ld(&bar[XB_TMO])) break; if (sp > XB_SPIN_CAP) { atomicAdd(&bar[XB_TMO], 1u); break; } }
    }
    nloc = mine > 0u ? mine : 1u; nx = cnt > 0u ? cnt : 1u;
}
__device__ __forceinline__ void xcd_barrier(const XcdBarrier& b) {
    asm volatile("s_waitcnt vmcnt(0)" ::: "memory");
    __syncthreads();
    if (threadIdx.x == 0) {
        unsigned* bar = b.bar;
        __builtin_amdgcn_s_waitcnt(0);
        unsigned nloc = b.st[0], nx = b.st[1];
        if (nloc == 0u) { xcd_barrier_complete(bar, b.x, nloc, nx); b.st[0] = nloc; b.st[1] = nx; }
        const unsigned old = xb_add(&bar[XB_XSUB(b.x)], 1u);
        const unsigned gen = old / nloc;
        if (old + 1u == (gen + 1u) * nloc) {
            __builtin_amdgcn_fence(__ATOMIC_RELEASE, "agent");
            asm volatile("s_waitcnt vmcnt(0)" ::: "memory");
            const unsigned og = xb_add(&bar[XB_TOP], 1u);
            const unsigned tg = og / nx;
            if (og + 1u == (tg + 1u) * nx) xb_add(&bar[XB_TOPGEN], 1u);
            else XB_SPIN(xb_ld(&bar[XB_TOPGEN]) == tg, bar);
            __builtin_amdgcn_fence(__ATOMIC_ACQUIRE, "agent");
            xb_add(&bar[XB_XGEN(b.x)], 1u);
            asm volatile("s_waitcnt vmcnt(0)" ::: "memory");
        } else {
            XB_SPIN(xb_ld(&bar[XB_XGEN(b.x)]) == gen, bar);
            __builtin_amdgcn_fence(__ATOMIC_ACQUIRE, "agent");
            asm volatile("s_waitcnt vmcnt(0)" ::: "memory");
        }
    }
    __syncthreads();
}

struct Args { const float* in[26]; float* out; unsigned char* ws; int ph_lo, ph_hi, li, pad; };
struct Ctx {
    const float* in[26]; float* out; unsigned char* ws;
    LAS unsigned char* lds;
    int tid, lane, wave, blk, G;
};
#define WSP(T, off) ((T*)(C.ws + (off)))
__device__ __forceinline__ const float* modp(const Ctx& C, int l, int set, int j) { return (const float*)(C.ws + WS_MOD) + ((l * 2 + set) * 6 + j) * D; }

__device__ __forceinline__ void p0_transpose_item(const float* W, int K, int N, bf16* WT, int k0, int n0, int drow0, LAS float* scr, int lane) {
    const int lr = lane >> 3, lc = (lane & 7) * 4;
    f32x4 v[8];
#pragma unroll
    for (int i = 0; i < 8; ++i) v[i] = *(const f32x4*)(W + (size_t)(k0 + 8 * i + lr) * N + n0 + lc);
#pragma unroll
    for (int i = 0; i < 8; ++i) *(LAS f32x4*)(scr + (8 * i + lr) * 36 + lc) = v[i];
    asm volatile("s_waitcnt lgkmcnt(0)" ::: "memory");
    const int c = lane & 7;
#pragma unroll
    for (int j = 0; j < 4; ++j) { const int n = (lane >> 3) + 8 * j; const LAS float* s = scr + (8 * c) * 36 + n;
        u32x4 o; o.x = pk2(s[0 * 36], s[1 * 36]); o.y = pk2(s[2 * 36], s[3 * 36]); o.z = pk2(s[4 * 36], s[5 * 36]); o.w = pk2(s[6 * 36], s[7 * 36]);
        *(u32x4*)(WT + (size_t)(drow0 + n) * K + k0 + 8 * c) = o; }
    asm volatile("s_waitcnt lgkmcnt(0)" ::: "memory");
}
constexpr int MOE_ITEMS_PER_LAYER = 16 * 3072, MOE_HALF_ITEMS = 2 * MOE_ITEMS_PER_LAYER;
__device__ __forceinline__ bool moe_layer_in_attention(int l) { return true; }
struct ConvItem { const float* W; bf16* WT; int K, N; };
__device__ __forceinline__ ConvItem conv_half_item(const Ctx& C, int l, int hidx) {
    const int it = hidx >> 1, half = hidx & 1, e = it / 3072, r2 = it % 3072, which = r2 / 1024, item = r2 % 1024, le = l * 16 + e;
    ConvItem ci;
    if (which < 2) { const int kb = item / 64, nb = item % 64, n0 = nb * 32, k0 = kb * 64 + 32 * half, drow0 = (n0 >> 7) * 256 + (n0 & 127) + which * 128;
        ci.K = 1024; ci.N = 2048; ci.W = (which ? C.in[23] : C.in[22]) + (size_t)le * 1024 * 2048 + (size_t)k0 * 2048 + n0;
        ci.WT = WSP(bf16, WS_W_GU) + (size_t)le * 4096 * 1024 + (size_t)drow0 * 1024 + k0; }
    else { const int kb = item / 32, nb = item % 32, n0 = nb * 32, k0 = kb * 64 + 32 * half;
        ci.K = 2048; ci.N = 1024; ci.W = C.in[24] + (size_t)le * 2048 * 1024 + (size_t)k0 * 1024 + n0;
        ci.WT = WSP(bf16, WS_W_DN) + (size_t)le * 1024 * 2048 + (size_t)n0 * 2048 + k0; }
    return ci;
}
struct ConvState { int l0, total, cur; bool loaded; };
template <bool DRAIN>
__device__ __forceinline__ void conv_step(const Ctx& C, ConvState& st, LAS float* scr) {
    int lane = C.lane; asm volatile("" : "+v"(lane));
    if (st.loaded) {
        if (DRAIN) asm volatile("s_waitcnt vmcnt(0)" ::: "memory");
        const int pc = st.cur - C.G * 8; const ConvItem pi = conv_half_item(C, st.l0 + pc / MOE_HALF_ITEMS, pc % MOE_HALF_ITEMS);
#pragma unroll
        for (int j = 0; j < 2; ++j) { const int ch = lane + 64 * j, n = ch >> 2, c = ch & 3; const LAS float* sp = scr + (8 * c) * 32 + ((((n >> 2) ^ (2 * c)) << 2) | (n & 3));
            u32x4 o; o.x = cvt_pk_bf16(sp[0 * 32], sp[1 * 32]); o.y = cvt_pk_bf16(sp[2 * 32], sp[3 * 32]); o.z = cvt_pk_bf16(sp[4 * 32], sp[5 * 32]); o.w = cvt_pk_bf16(sp[6 * 32], sp[7 * 32]);
            *(u32x4*)(pi.WT + (size_t)n * pi.K + 8 * c) = o; }
        asm volatile("s_waitcnt lgkmcnt(0)" ::: "memory");
        st.loaded = false;
    }
    if (st.cur < st.total) {
        const ConvItem ci = conv_half_item(C, st.l0 + st.cur / MOE_HALF_ITEMS, st.cur % MOE_HALF_ITEMS);
        const int lr = lane >> 3;
#pragma unroll
        for (int i = 0; i < 4; ++i) { const int lc = ((lane & 7) ^ (2 * i)) * 4;
            __builtin_amdgcn_global_load_lds((const unsigned*)(ci.W + (size_t)(8 * i + lr) * ci.N + lc), (LAS unsigned*)(scr + i * 256), 16, 0, 0); }
        st.loaded = true; st.cur += C.G * 8;
    }
}
struct ConvPipe { int l0, total, first, n; };
constexpr int CONV_PIPE_BASE = 4 * (64 * 128 + 64 * 128) + 2048;
__device__ __forceinline__ LAS float* conv_pipe_buf(LAS unsigned char* lds, int wave, int par) {
    const int b = wave * 2 + par;
    return (LAS float*)(lds + (b < 14 ? CONV_PIPE_BASE + b * 4096 : 132096 + (b - 14) * 4096));
}
template <bool STORE = true>
__device__ __forceinline__ void conv_pack_store(bf16* WT, int K, const LAS float* scr, int lane) {
#pragma unroll
    for (int j = 0; j < 2; ++j) { const int ch = lane + 64 * j, n = ch >> 2, c = ch & 3; const LAS float* sp = scr + (8 * c) * 32 + ((((n >> 2) ^ (2 * c)) << 2) | (n & 3));
        u32x4 o; o.x = cvt_pk_bf16(sp[0 * 32], sp[1 * 32]); o.y = cvt_pk_bf16(sp[2 * 32], sp[3 * 32]); o.z = cvt_pk_bf16(sp[4 * 32], sp[5 * 32]); o.w = cvt_pk_bf16(sp[6 * 32], sp[7 * 32]);
        if (STORE) *(u32x4*)(WT + (size_t)n * K + 8 * c) = o; else asm volatile("" :: "v"(o.x), "v"(o.y), "v"(o.z), "v"(o.w)); }
    asm volatile("s_waitcnt lgkmcnt(0)" ::: "memory");
}
template <int FL = 0>
__device__ __forceinline__ void conv_pipe_step(const Ctx& C, ConvPipe& st, LAS unsigned char* lds) {
    int lane = C.lane; asm volatile("" : "+v"(lane));
    const int NGW = C.G * 8, cur = st.first + st.n * NGW, pc = cur - 2 * NGW;
    LAS float* scr = conv_pipe_buf(lds, C.wave, st.n & 1);
    { const bool real = st.n >= 2 && pc < st.total; const int pcc = real ? pc : st.first;
      const ConvItem pi = conv_half_item(C, st.l0, pcc);
      conv_pack_store<!(FL & 1)>(real ? pi.WT : WSP(bf16, WS_XG) + (size_t)st.first * 1024, real ? pi.K : 32, scr, lane); }
    { const int cc = cur < st.total ? cur : st.first;
      const ConvItem ci = conv_half_item(C, st.l0, cc);
      const int lr = lane >> 3;
#pragma unroll
      for (int i = 0; i < 4; ++i) { const int lc = ((lane & 7) ^ (2 * i)) * 4;
          if (!(FL & 2)) __builtin_amdgcn_global_load_lds((const unsigned*)(ci.W + (size_t)(8 * i + lr) * ci.N + lc), (LAS unsigned*)(scr + i * 256), 16, 0, 0); } }
    st.n += 1;
}
__device__ __forceinline__ void conv_pipe_drain(const Ctx& C, ConvPipe& st, LAS unsigned char* lds) {
    asm volatile("s_waitcnt vmcnt(0)" ::: "memory");
    const int NGW = C.G * 8;
#pragma unroll 1
    for (int k = 2; k >= 1; --k) { const int m = st.n - k, pc = st.first + m * NGW;
        if (m >= 0 && pc < st.total) { const ConvItem pi = conv_half_item(C, st.l0, pc); conv_pack_store(pi.WT, pi.K, conv_pipe_buf(lds, C.wave, m & 1), C.lane); } }
    ConvState rest; rest.l0 = st.l0; rest.total = st.total; rest.cur = st.first + st.n * NGW; rest.loaded = false;
    LAS float* scr = conv_pipe_buf(lds, C.wave, 0);
    while (rest.loaded || rest.cur < rest.total) conv_step<true>(C, rest, scr);
}
__device__ __forceinline__ bool p0_plain(int& r, const float* W, int K, int N, bf16* WT, int row_off, LAS float* scr, int lane) {
    const int nblk = N / 32, cnt = (K / 64) * nblk;
    if (r >= cnt) { r -= cnt; return false; }
    const int kb = r / nblk, nb = r % nblk;
    p0_transpose_item(W, K, N, WT, kb * 64, nb * 32, row_off + nb * 32, scr, lane);
    return true;
}
__device__ __forceinline__ void ph_prologue(const Ctx& C) {
    LAS float* scr = (LAS float*)(C.lds + C.wave * 16384);
    const int gw = C.blk * 8 + C.wave, NGW = C.G * 8;
    constexpr int MOE_ITEMS = 4 * 16 * 3072;
    constexpr int SMALL_ITEMS = 2 * 1536 + 2 * 512 + 768 + 512 + 256 + 144 + 384 + 256 + 512;
    for (int it = gw; it < MOE_ITEMS + SMALL_ITEMS; it += NGW) {
        if (it < MOE_ITEMS) {
            if (moe_layer_in_attention(it / MOE_ITEMS_PER_LAYER)) continue;
            const int le = it / 3072, r2 = it % 3072, which = r2 / 1024, item = r2 % 1024, l = le / 16, e = le % 16;
            if (which < 2) {
                const float* W = (which ? C.in[23] : C.in[22]) + (size_t)le * 1024 * 2048;
                bf16* WT = WSP(bf16, WS_W_GU) + ((size_t)l * 16 + e) * 4096 * 1024;
                const int kb = item / 64, nb = item % 64, n0 = nb * 32;
                p0_transpose_item(W, 1024, 2048, WT, kb * 64, n0, (n0 >> 7) * 256 + (n0 & 127) + which * 128, scr, C.lane);
            } else {
                const float* W = C.in[24] + (size_t)le * 2048 * 1024;
                bf16* WT = WSP(bf16, WS_W_DN) + ((size_t)l * 16 + e) * 1024 * 2048;
                const int kb = item / 32, nb = item % 32;
                p0_transpose_item(W, 2048, 1024, WT, kb * 64, nb * 32, nb * 32, scr, C.lane);
            }
            continue;
        }
        int r = it - MOE_ITEMS;
        if (p0_plain(r, C.in[8], 1024, 3072, WSP(bf16, WS_W_NAQKV), 0, scr, C.lane)) continue;
        if (p0_plain(r, C.in[8] + (size_t)1024 * 3072, 1024, 3072, WSP(bf16, WS_W_NAQKV) + (size_t)3072 * 1024, 0, scr, C.lane)) continue;
        if (p0_plain(r, C.in[9], 1024, 1024, WSP(bf16, WS_W_NAO), 0, scr, C.lane)) continue;
        if (p0_plain(r, C.in[9] + (size_t)1024 * 1024, 1024, 1024, WSP(bf16, WS_W_NAO) + (size_t)1024 * 1024, 0, scr, C.lane)) continue;
        if (p0_plain(r, C.in[11], 1024, 1536, WSP(bf16, WS_W_SWAQKV), 0, scr, C.lane)) continue;
        if (p0_plain(r, C.in[12], 1024, 1024, WSP(bf16, WS_W_SWAO), 0, scr, C.lane)) continue;
        if (p0_plain(r, C.in[14], 1024, 512, WSP(bf16, WS_W_MLAD), 0, scr, C.lane)) continue;
        if (p0_plain(r, C.in[17], 1024, 288, WSP(bf16, WS_W_MLAD), 512, scr, C.lane)) continue;
        if (p0_plain(r, C.in[16], 512, 1536, WSP(bf16, WS_W_MLAUQ), 0, scr, C.lane)) continue;
        if (p0_plain(r, C.in[19], 256, 2048, WSP(bf16, WS_W_MLAUKV), 0, scr, C.lane)) continue;
        p0_plain(r, C.in[20], 1024, 1024, WSP(bf16, WS_W_MLAO), 0, scr, C.lane);
    }
    { u32x4* z = (u32x4*)(WSP(bf16, WS_W_MLAD) + (size_t)800 * 1024); const int n16 = 224 * 1024 * 2 / 16;
      for (int i = C.blk * 512 + C.tid; i < n16; i += C.G * 512) z[i] = (u32x4){0u, 0u, 0u, 0u}; }
    __syncthreads();
    LAS float* sc = (LAS float*)C.lds;
    LAS float* red = sc + 2048;
    for (int i = C.tid; i < 2048; i += 512) { const float v = (i < 1024) ? C.in[1][i] : C.in[3][i - 1024]; sc[i] = v / (1.f + __expf(-v)); }
    __syncthreads();
    for (int u = C.blk; u < 4 * 96; u += C.G) {
        const int l = u / 96, j0 = (u % 96) * 64, kg = C.tid >> 4, jl = (C.tid & 15) * 4;
        const float* W = C.in[4] + (size_t)l * 1024 * 6144 + (size_t)(kg * 32) * 6144 + j0 + jl;
        f32x4 a0 = (f32x4){0.f, 0.f, 0.f, 0.f}, a1 = a0;
#pragma unroll 1
        for (int kb = 0; kb < 32; kb += 16) {
            f32x4 wv[16];
#pragma unroll
            for (int i = 0; i < 16; ++i) wv[i] = *(const f32x4*)(W + (size_t)(kb + i) * 6144);
#pragma unroll
            for (int i = 0; i < 16; ++i) { const float s0 = sc[kg * 32 + kb + i], s1 = sc[1024 + kg * 32 + kb + i];
                a0[0] += s0 * wv[i][0]; a0[1] += s0 * wv[i][1]; a0[2] += s0 * wv[i][2]; a0[3] += s0 * wv[i][3];
                a1[0] += s1 * wv[i][0]; a1[1] += s1 * wv[i][1]; a1[2] += s1 * wv[i][2]; a1[3] += s1 * wv[i][3]; }
        }
        *(LAS f32x4*)(red + kg * 64 + jl) = a0; *(LAS f32x4*)(red + 2048 + kg * 64 + jl) = a1;
        __syncthreads();
        if (C.tid < 128) { const int set = C.tid >> 6, j = C.tid & 63; float s = 0.f;
#pragma unroll
            for (int q = 0; q < 32; ++q) s += red[set * 2048 + q * 64 + j];
            const int col = j0 + j;
            ((float*)(C.ws + WS_MOD))[((l * 2 + set) * 6) * D + col] = s + C.in[5][l * 6144 + col]; }
        __syncthreads();
    }
}

template <int MODE>
__device__ __forceinline__ void ph_rowA(const Ctx& C, int l) {
    float* X = WSP(float, WS_X); bf16* H = WSP(bf16, WS_H); const int* INV = WSP(int, WS_INV); const bf16* YB = WSP(bf16, WS_YB);
    const int nrows = MODE == 1 ? SEQ : R;
    for (int t = C.blk * 8 + C.wave; t < nrows; t += C.G * 8) {
        const int set = t >= SEQ ? 1 : 0;
        const float* src = (MODE == 0 && l == 0) ? (set ? C.in[2] + (size_t)(t - SEQ) * D : C.in[0] + (size_t)t * D) : X + (size_t)t * D;
        f32x4 v[4];
#pragma unroll
        for (int j = 0; j < 4; ++j) v[j] = ((const f32x4*)src)[C.lane + 64 * j];
        if (MODE == 1 || l > 0) {
            const int lp = MODE == 1 ? 3 : l - 1;
            const int myinv = C.lane < 16 ? INV[(size_t)t * 16 + C.lane] : -1;
            f32x4 a[4];
#pragma unroll
            for (int j = 0; j < 4; ++j) a[j] = (f32x4){0.f, 0.f, 0.f, 0.f};
            unsigned em = (unsigned)(__builtin_amdgcn_ballot_w64(myinv >= 0) & 0xffffull);
            while (em) {
                int sl[4]; bool ok[4];
#pragma unroll
                for (int q = 0; q < 4; ++q) { ok[q] = em != 0u; const int e = ok[q] ? __builtin_ctz(em) : 0; if (ok[q]) em &= em - 1u; sl[q] = e * EROWS + __shfl(myinv, e); }
                u32x2 w[4][4];
#pragma unroll
                for (int q = 0; q < 4; ++q) { const u32x2* yr = (const u32x2*)(YB + (size_t)(ok[q] ? sl[q] : 0) * D);
#pragma unroll
                    for (int j = 0; j < 4; ++j) w[q][j] = ok[q] ? yr[C.lane + 64 * j] : (u32x2){0u, 0u}; }
#pragma unroll
                for (int q = 0; q < 4; ++q)
#pragma unroll
                    for (int j = 0; j < 4; ++j) a[j] += (f32x4){bf2f(w[q][j].x & 0xffffu), bf2f(w[q][j].x >> 16), bf2f(w[q][j].y & 0xffffu), bf2f(w[q][j].y >> 16)};
            }
            const f32x4* g = (const f32x4*)modp(C, lp, set, 5);
#pragma unroll
            for (int j = 0; j < 4; ++j) v[j] += g[C.lane + 64 * j] * a[j];
        }
        if (MODE == 0) {
#pragma unroll
            for (int j = 0; j < 4; ++j) ((f32x4*)(X + (size_t)t * D))[C.lane + 64 * j] = v[j];
        }
        float ss = 0.f;
#pragma unroll
        for (int j = 0; j < 4; ++j) ss += (v[j].x * v[j].x + v[j].y * v[j].y) + (v[j].z * v[j].z + v[j].w * v[j].w);
        const float rstd = rsqrtf(wave_sum(ss) * (1.f / D) + RMS_EPS);
        if (MODE == 0) {
            const f32x4* w = (const f32x4*)(C.in[6] + (size_t)l * D); const f32x4* sh = (const f32x4*)modp(C, l, set, 0); const f32x4* scl = (const f32x4*)modp(C, l, set, 1);
#pragma unroll
            for (int j = 0; j < 4; ++j) { const int i = C.lane + 64 * j; const f32x4 y = v[j] * rstd * w[i] * (scl[i] + 1.f) + sh[i];
                u32x2 o; o.x = pk2(y.x, y.y); o.y = pk2(y.z, y.w); ((u32x2*)(H + (size_t)t * D))[i] = o; }
        } else {
            const f32x4* w = (const f32x4*)C.in[25];
#pragma unroll
            for (int j = 0; j < 4; ++j) { const int i = C.lane + 64 * j; ((f32x4*)(C.out + (size_t)t * D))[i] = v[j] * rstd * w[i]; }
        }
    }
}
template <int M> __device__ __forceinline__ float xorx(float v, int b5) {
    if constexpr (M == 32) { const auto sw = __builtin_amdgcn_permlane32_swap(__float_as_uint(v), __float_as_uint(v), false, false); return __uint_as_float(b5 ? sw[0] : sw[1]); }
    else return __int_as_float(__builtin_amdgcn_ds_swizzle(__float_as_int(v), (M << 10) | 0x1f));
}
#define RS_STEP(lo, hi, bit, off) ((bit ? hi : lo) + xorx<off>(bit ? lo : hi, b5))
__device__ __forceinline__ float rscatter16(const float (&a)[16], int b5, int b4, int b3, int b2) {
    const float c0 = RS_STEP(a[0], a[8], b5, 32), c1 = RS_STEP(a[1], a[9], b5, 32), c2 = RS_STEP(a[2], a[10], b5, 32), c3 = RS_STEP(a[3], a[11], b5, 32);
    const float c4 = RS_STEP(a[4], a[12], b5, 32), c5 = RS_STEP(a[5], a[13], b5, 32), c6 = RS_STEP(a[6], a[14], b5, 32), c7 = RS_STEP(a[7], a[15], b5, 32);
    const float d0 = RS_STEP(c0, c4, b4, 16), d1 = RS_STEP(c1, c5, b4, 16), d2 = RS_STEP(c2, c6, b4, 16), d3 = RS_STEP(c3, c7, b4, 16);
    const float e0 = RS_STEP(d0, d2, b3, 8), e1 = RS_STEP(d1, d3, b3, 8);
    return RS_STEP(e0, e1, b2, 4);
}
__device__ __forceinline__ void n2_finish(float (&lg)[16], int b5, int b4, int b3, int b2, int my_e, int lane, float* AFF, int t) {
    float vv = rscatter16(lg, b5, b4, b3, b2);
    vv += xorx<1>(vv, b5); vv += xorx<2>(vv, b5);
    float mx = vv; mx = fmaxf(mx, xorx<4>(mx, b5)); mx = fmaxf(mx, xorx<8>(mx, b5)); mx = fmaxf(mx, xorx<16>(mx, b5)); mx = fmaxf(mx, xorx<32>(mx, b5));
    const float ex = __expf(vv - mx); float sm = ex; sm += xorx<4>(sm, b5); sm += xorx<8>(sm, b5); sm += xorx<16>(sm, b5); sm += xorx<32>(sm, b5);
    if ((lane & 3) == 0) AFF[(size_t)my_e * R + t] = ex / sm;
}
template <int VAR = 0>
__device__ __forceinline__ void ph_norm2(const Ctx& C, int l, int nrows) {
    const float* X = WSP(float, WS_X); bf16* H = VAR ? WSP(bf16, WS_XG) : WSP(bf16, WS_H); float* AFF = VAR ? WSP(float, WS_ACT) : WSP(float, WS_AFF);
    LAS float* Rs = (LAS float*)C.lds;
    const float* rt = C.in[21] + (size_t)l * D * NE;
    for (int i = C.tid; i < D * NE / 4; i += 512) { const f32x4 r4 = ((const f32x4*)rt)[i]; const int c = i >> 2, e0 = (i & 3) * 4;
        Rs[(e0 + 0) * D + c] = r4.x; Rs[(e0 + 1) * D + c] = r4.y; Rs[(e0 + 2) * D + c] = r4.z; Rs[(e0 + 3) * D + c] = r4.w; }
    __syncthreads();
    const int b5 = (C.lane >> 5) & 1, b4 = (C.lane >> 4) & 1, b3 = (C.lane >> 3) & 1, b2 = (C.lane >> 2) & 1, my_e = 8 * b5 + 4 * b4 + 2 * b3 + b2;
    for (int t0 = (C.blk * 8 + C.wave) * 2; t0 < nrows; t0 += C.G * 16) {
        asm volatile("" ::: "memory");
        const int set = t0 >= SEQ ? 1 : 0;
        f32x4 va[4], vb[4];
#pragma unroll
        for (int j = 0; j < 4; ++j) { va[j] = ((const f32x4*)(X + (size_t)t0 * D))[C.lane + 64 * j]; vb[j] = ((const f32x4*)(X + (size_t)(t0 + 1) * D))[C.lane + 64 * j]; }
        { const f32x4* w = (const f32x4*)(C.in[7] + (size_t)l * D); const f32x4* sh = (const f32x4*)modp(C, l, set, 3); const f32x4* scl = (const f32x4*)modp(C, l, set, 4);
          float sa = 0.f, sb = 0.f;
#pragma unroll
          for (int j = 0; j < 4; ++j) { sa += (va[j].x * va[j].x + va[j].y * va[j].y) + (va[j].z * va[j].z + va[j].w * va[j].w); sb += (vb[j].x * vb[j].x + vb[j].y * vb[j].y) + (vb[j].z * vb[j].z + vb[j].w * vb[j].w); }
          const float ra = rsqrtf(wave_sum(sa) * (1.f / D) + RMS_EPS), rb = rsqrtf(wave_sum(sb) * (1.f / D) + RMS_EPS);
#pragma unroll
          for (int j = 0; j < 4; ++j) { const int i = C.lane + 64 * j; const f32x4 ws = w[i] * (scl[i] + 1.f), s4 = sh[i];
              va[j] = va[j] * ra * ws + s4; vb[j] = vb[j] * rb * ws + s4;
              u32x2 o; o.x = pk2(va[j].x, va[j].y); o.y = pk2(va[j].z, va[j].w); ((u32x2*)(H + (size_t)t0 * D))[i] = o;
              o.x = pk2(vb[j].x, vb[j].y); o.y = pk2(vb[j].z, vb[j].w); ((u32x2*)(H + (size_t)(t0 + 1) * D))[i] = o; } }
        float la[16], lb[16];
#pragma unroll
        for (int e = 0; e < 16; ++e) { float s0 = 0.f, s1 = 0.f;
#pragma unroll
            for (int j = 0; j < 4; ++j) { if (VAR & 2) { s0 += va[j].x * (float)e; s1 += vb[j].y * (float)e; continue; } const f32x4 r = *(const LAS f32x4*)(Rs + e * D + 4 * (C.lane + 64 * j));
                s0 += (va[j].x * r.x + va[j].y * r.y) + (va[j].z * r.z + va[j].w * r.w); s1 += (vb[j].x * r.x + vb[j].y * r.y) + (vb[j].z * r.z + vb[j].w * r.w); }
            la[e] = s0; lb[e] = s1; }
        if (VAR & 1) { float z = 0.f;
#pragma unroll
            for (int e = 0; e < 16; ++e) z += la[e] * lb[e];
            if (C.lane == 0) AFF[t0] = z; continue; }
#pragma unroll 1
        for (int rr = 0; rr < 2; ++rr) {
            n2_finish(la, b5, b4, b3, b2, my_e, C.lane, AFF, t0 + rr);
#pragma unroll
            for (int e = 0; e < 16; ++e) la[e] = lb[e];
        }
    }
}

__device__ __forceinline__ int block_sum_i(int v, LAS int* scr, int wave, int lane) {
    v = wave_sum_i(v);
    if (lane == 0) scr[wave] = v;
    __syncthreads();
    int t = 0;
#pragma unroll
    for (int w = 0; w < 8; ++w) t += scr[w];
    __syncthreads();
    return t;
}
__device__ __forceinline__ int block_excl_scan(int v, LAS int* scr, int wave, int lane) {
    int inc = v;
#pragma unroll
    for (int o = 1; o < 64; o <<= 1) { const int n = __shfl_up(inc, o); if (lane >= o) inc += n; }
    if (lane == 63) scr[wave] = inc;
    __syncthreads();
    int off = 0;
#pragma unroll
    for (int w = 0; w < 8; ++w) off += (w < wave) ? scr[w] : 0;
    __syncthreads();
    return off + inc - v;
}
template <int KPT>
__device__ __forceinline__ void topk_unit(const Ctx& C, int e, int base, int n, int cap, int slot0) {
    const float* aff = WSP(float, WS_AFF) + (size_t)e * R + base;
    int* rowl = WSP(int, WS_ROWL) + e * EROWS; float* gatel = WSP(float, WS_GATEL) + e * EROWS; int* INV = WSP(int, WS_INV);
    LAS unsigned* hist = (LAS unsigned*)C.lds;
    LAS int* scr = (LAS int*)(hist + 2048);
    LAS unsigned* bc = hist + 2048 + 16;
    unsigned key[KPT];
    if (KPT == 32) {
#pragma unroll
        for (int j = 0; j < KPT; j += 4) { const u32x4 k4 = *(const u32x4*)(aff + C.tid * KPT + j); key[j] = k4.x; key[j + 1] = k4.y; key[j + 2] = k4.z; key[j + 3] = k4.w; }
    } else {
#pragma unroll
        for (int j = 0; j < KPT; ++j) { const int t = C.tid * KPT + j; key[j] = t < n ? __float_as_uint(aff[t]) : 0u; }
    }
    unsigned prefix = 0u, pmask = 0u; int kth = cap;
#pragma unroll 1
    for (int pass = 0; pass < 3; ++pass) {
        const int shift = pass == 0 ? 20 : (pass == 1 ? 9 : 0), nb = pass == 2 ? 512 : 2048; const unsigned dmask = (unsigned)nb - 1u;
        for (int i = C.tid; i < nb; i += 512) hist[i] = 0u;
        __syncthreads();
#pragma unroll
        for (int j = 0; j < KPT; ++j) if (key[j] != 0u && (key[j] & pmask) == prefix) __hip_atomic_fetch_add(hist + ((key[j] >> shift) & dmask), 1u, __ATOMIC_RELAXED, __HIP_MEMORY_SCOPE_WORKGROUP);
        __syncthreads();
        if (C.wave == 0) {
            const int per = nb >> 6;
            int tot = 0;
            for (int q = 0; q < per; ++q) tot += (int)hist[C.lane * per + q];
            int suf = tot;
#pragma unroll
            for (int o = 1; o < 64; o <<= 1) { const int nbv = __shfl_down(suf, o); if (C.lane + o < 64) suf += nbv; }
            const unsigned long long bal = __ballot(suf >= kth);
            const int lstar = 63 - __builtin_clzll(bal);
            if (C.lane == lstar) { int above = suf - tot; int q = per - 1;
                for (; q > 0; --q) { const int c = (int)hist[C.lane * per + q]; if (above + c >= kth) break; above += c; }
                bc[0] = (unsigned)(C.lane * per + q); bc[1] = (unsigned)(kth - above); }
        }
        __syncthreads();
        prefix |= bc[0] << shift; pmask |= dmask << shift; kth = (int)bc[1];
    }
    const int need_eq = kth;
    int ce = 0;
#pragma unroll
    for (int j = 0; j < KPT; ++j) ce += key[j] == prefix ? 1 : 0;
    int eqr = block_excl_scan(ce, scr, C.wave, C.lane);
    int nsel = 0; unsigned selmask = 0u;
#pragma unroll
    for (int j = 0; j < KPT; ++j) { bool sl = key[j] > prefix; if (key[j] == prefix) { sl = eqr < need_eq; ++eqr; } if (sl) { ++nsel; selmask |= 1u << j; } }
    int slot = block_excl_scan(nsel, scr, C.wave, C.lane);
#pragma unroll
    for (int j = 0; j < KPT; ++j) { const int t = C.tid * KPT + j;
        if (t < n) {
            if ((selmask >> j) & 1u) { rowl[slot0 + slot] = base + t; gatel[slot0 + slot] = __uint_as_float(key[j]); INV[(size_t)(base + t) * 16 + e] = slot0 + slot; ++slot; }
            else INV[(size_t)(base + t) * 16 + e] = -1;
        } }
}
__device__ __forceinline__ void ph_topk(const Ctx& C, bool with_ctx) {
    for (int u = C.blk; u < (with_ctx ? 32 : 16); u += C.G) {
        const int e = u & 15;
        if (u < 16) { topk_unit<32>(C, e, 0, SEQ, CAP_L, 0); int* rowl = WSP(int, WS_ROWL) + e * EROWS; for (int i = CAP_L + CAP_C + C.tid; i < EROWS; i += 512) rowl[i] = 0; }
        else topk_unit<1>(C, e, SEQ, NCTX, CAP_C, CAP_L);
        __syncthreads();
    }
}
__device__ __forceinline__ void ph_gather(const Ctx& C, bool with_ctx) {
    const int* rowl = WSP(int, WS_ROWL); const bf16* H = WSP(bf16, WS_H); bf16* XG = WSP(bf16, WS_XG);
    const int nslots = with_ctx ? CAP_L + CAP_C : CAP_L, ntot = NE * nslots;
    for (int i = C.blk * 8 + C.wave; i < ntot; i += C.G * 8) {
        const int e = i / nslots, sl = i % nslots, r = e * EROWS + sl;
        const int src = rowl[r];
        u32x4* d = (u32x4*)(XG + (size_t)r * D); const u32x4* sp = (const u32x4*)(H + (size_t)src * D);
        d[C.lane] = sp[C.lane]; d[C.lane + 64] = sp[C.lane + 64];
    }
}
__device__ __forceinline__ void rot_angles(int t, int half, int d, int quarter, float& cs, float& sn) {
    const float invf = exp2f(-(float)d * (13.287712379549449f / (float)quarter));
    const float pos = half ? (float)(t & 63) : (float)(t >> 6);
    const float ang = pos * invf;
    const double rev = (double)ang * 0.15915494309189535; const float fr = (float)(rev - __builtin_rint(rev));
    cs = __builtin_amdgcn_cosf(fr); sn = __builtin_amdgcn_sinf(fr);
}
__device__ __forceinline__ void ph_rope(const Ctx& C, bf16* buf, int hw, int nheads, int off, int quarter) {
    const int per_tok = nheads * 2 * quarter; const long total = (long)SEQ * per_tok;
    for (long i = (long)C.blk * 512 + C.tid; i < total; i += (long)C.G * 512) {
        const int t = (int)(i / per_tok), r = (int)(i % per_tok), h = r / (2 * quarter), p = r % (2 * quarter), half = p / quarter, d = p % quarter;
        float cs, sn; rot_angles(t, half, d, quarter, cs, sn);
        bf16* b = buf + (size_t)h * R * hw + (size_t)t * hw + off + half * 2 * quarter + d;
        const float x1 = bf2f(b[0]), x2 = bf2f(b[quarter]);
        b[0] = (bf16)f2bf(x1 * cs - x2 * sn); b[quarter] = (bf16)f2bf(x1 * sn + x2 * cs);
    }
}
__device__ __forceinline__ void ph_mlanorm(const Ctx& C) {
    const float* CQ = WSP(float, WS_CQ); bf16* CQN = WSP(bf16, WS_CQN); bf16* CKVN = WSP(bf16, WS_CKVN); bf16* KR = WSP(bf16, WS_KROPE);
    for (int t = C.blk * 8 + C.wave; t < R; t += C.G * 8) {
        const float* row = CQ + (size_t)t * D;
        const f32x4 a0 = ((const f32x4*)row)[C.lane], a1 = ((const f32x4*)row)[C.lane + 64], b0 = ((const f32x4*)(row + 512))[C.lane];
        const float sa = wave_sum((a0.x * a0.x + a0.y * a0.y) + (a0.z * a0.z + a0.w * a0.w) + (a1.x * a1.x + a1.y * a1.y) + (a1.z * a1.z + a1.w * a1.w));
        const float sb = wave_sum((b0.x * b0.x + b0.y * b0.y) + (b0.z * b0.z + b0.w * b0.w));
        const float ra = rsqrtf(sa * (1.f / 512.f) + RMS_EPS), rb = rsqrtf(sb * (1.f / 256.f) + RMS_EPS);
        const f32x4* gq = (const f32x4*)C.in[15]; const f32x4* gk = (const f32x4*)C.in[18];
        { const f32x4 y0 = a0 * ra * gq[C.lane], y1 = a1 * ra * gq[C.lane + 64], z = b0 * rb * gk[C.lane];
          u32x2 o; o.x = pk2(y0.x, y0.y); o.y = pk2(y0.z, y0.w); ((u32x2*)(CQN + (size_t)t * 512))[C.lane] = o;
          o.x = pk2(y1.x, y1.y); o.y = pk2(y1.z, y1.w); ((u32x2*)(CQN + (size_t)t * 512))[C.lane + 64] = o;
          o.x = pk2(z.x, z.y); o.y = pk2(z.z, z.w); ((u32x2*)(CKVN + (size_t)t * 256))[C.lane] = o; }
        const float x = row[768 + (C.lane & 31)];
        const float xp = __shfl_xor(x, 8);
        float y = x;
        if (t < SEQ) { float cs, sn; rot_angles(t, (C.lane >> 4) & 1, C.lane & 7, 8, cs, sn);
            y = ((C.lane >> 3) & 1) ? (xp * sn + x * cs) : (x * cs - xp * sn); }
        if (C.lane < 32) KR[(size_t)t * 32 + C.lane] = (bf16)f2bf(y);
    }
}

constexpr int CW_KMAX = 8192;
__device__ __forceinline__ void ph_kmax(const Ctx& C) {
    const bf16* KV = WSP(bf16, WS_KV); const bf16* KR = WSP(bf16, WS_KROPE); unsigned* ctl = (unsigned*)(C.ws + WS_CTL);
    for (int i = C.blk * 512 + C.tid; i < 16 * R; i += C.G * 512) {
        const int h = i / R, t = i - h * R;
        const u32x4* kp = (const u32x4*)(KV + (size_t)h * R * 128 + (size_t)t * 128); const u32x4* rp = (const u32x4*)(KR + (size_t)t * 32);
        float ss = 0.f;
#pragma unroll
        for (int q = 0; q < 12; ++q) { const u32x4 w = q < 8 ? kp[q] : rp[q - 8];
            const float a0 = bf2f(w.x & 0xffffu), a1 = bf2f(w.x >> 16), a2 = bf2f(w.y & 0xffffu), a3 = bf2f(w.y >> 16), a4 = bf2f(w.z & 0xffffu), a5 = bf2f(w.z >> 16), a6 = bf2f(w.w & 0xffffu), a7 = bf2f(w.w >> 16);
            ss += (a0 * a0 + a1 * a1) + (a2 * a2 + a3 * a3) + (a4 * a4 + a5 * a5) + (a6 * a6 + a7 * a7); }
#pragma unroll
        for (int o = 1; o < 64; o <<= 1) ss = fmaxf(ss, __shfl_xor(ss, o));
        if (C.lane == 0) atomicMax(ctl + CW_KMAX + h, __float_as_uint(ss));
    }
}

namespace pg8 {
#define PG8_LAS __attribute__((address_space(3)))
typedef unsigned short bf16_t;
typedef short bf16x8 __attribute__((ext_vector_type(8)));
typedef float f32x4 __attribute__((ext_vector_type(4)));
typedef unsigned u32x4 __attribute__((ext_vector_type(4)));
constexpr int BM = 256, BK = 64, HALF = 128, HTB = HALF * BK * 2  , STAGE_BYTES = 8 * HTB, NXCD = 8, WGM = 8;

__host__ __device__ __forceinline__ int lds_byte(int r, int c) { const int st = (r >> 4) * 2 + (c >> 5), rr = r & 15, cc = c & 31, ob = rr * 64 + cc * 2; return st * 1024 + (ob ^ (((ob >> 9) & 1) << 5)); }
__host__ __device__ __forceinline__ void stage_rc(int b, int& R, int& C) { const int st = b / 1024, sb = b % 1024, swz = sb ^ (((sb >> 9) & 1) << 5); R = (st >> 1) * 16 + swz / 64; C = (st & 1) * 32 + (swz % 64) / 2; }
__host__ __device__ __forceinline__ int perm32(int rho) { const int n = rho >> 4, i = rho & 15; return 8 * (i >> 2) + 4 * n + (i & 3); }

struct Unit { int pm, pn, thin; };
struct Gemm { const bf16_t* A; const bf16_t* Bt; int M, N, K; int pm_per_grp; size_t grp_stride; };

struct StaticOrder {
    int nM, nN, nwg, G, c;
    __host__ __device__ void init(int M, int N, int G_, int c_) { nM = M / BM; nN = N / BM; nwg = nM * nN; G = G_; c = c_; }
    __host__ __device__ bool next(int i, Unit& u) const {
        const long L = (long)i * G + c; if (L >= nwg) return false;
        int wgid = (int)L; { const int q = nwg / NXCD, r = nwg % NXCD, xcd = wgid % NXCD, off = wgid / NXCD; wgid = (xcd < r ? xcd * (q + 1) : r * (q + 1) + (xcd - r) * q) + off; }
        const int nig = WGM * nN, gid = wgid / nig, fm = gid * WGM, gsz = (nM - fm) < WGM ? (nM - fm) : WGM;
        u.pm = fm + ((wgid % nig) % gsz); u.pn = (wgid % nig) / gsz; u.thin = 0; return true;
    }
    __device__ __forceinline__ void a_ready(const Unit&) const {}
    __device__ __forceinline__ void done(const Unit&) const {}
};
struct MoeOrder {
    StaticOrder base; int nN, nthin;
    __host__ __device__ void init(int N, int G_, int c_, bool with_thin) { base.init(NEXP_PANELS * BM, N, G_, c_); nN = N / BM; nthin = with_thin ? 16 * nN : 0; }
    static constexpr int NEXP_PANELS = 16 * 8;
    __host__ __device__ bool next(int i, Unit& u) const {
        if (base.next(i, u)) { u.pm = (u.pm >> 3) * 9 + (u.pm & 7); return true; }
        const long j = (long)i * base.G + base.c - base.nwg; if (j >= nthin) return false;
        u.pm = (int)(j / nN) * 9 + 8; u.pn = (int)(j % nN); u.thin = 1; return true;
    }
    __device__ __forceinline__ void a_ready(const Unit&) const {}
    __device__ __forceinline__ void done(const Unit&) const {}
};

template <class Epi, class Sched, bool ALIGN_EPI = false, bool SP2 = false, bool GATHER = false>
__device__ __forceinline__ void gemm_phase(PG8_LAS unsigned char* lds, const Gemm g, const Sched& S, const Epi& E, const PG8_LAS int* idx_tab = nullptr) {
    static_assert(!GATHER || SP2, "the gathered A panel is wired into the SP2 loop only");
    const int tid = threadIdx.x, wid = __builtin_amdgcn_readfirstlane(tid >> 6), lane = tid & 63, wr = wid >> 2, wc = wid & 3, fr = lane & 15, fq = lane >> 4;
    const int K = g.K, nt = K / BK;
    unsigned voffA[2], voffB[2]; int rowA[2]; unsigned colA[2];
#pragma unroll
    for (int i = 0; i < 2; ++i) { int R, C; stage_rc(tid * 16 + i * 8192, R, C); const int Rb = Epi::PERM ? ((R & ~31) + perm32(R & 31)) : R;
        voffA[i] = (unsigned)(R * K + C) * 2u; voffB[i] = (unsigned)(Rb * K + C) * 2u; rowA[i] = R; colA[i] = (unsigned)C * 2u; }
    unsigned vGc[2][2], vGn[2][2];
#define PG8_GOFF(dst, ui_) do { _Pragma("unroll") for (int h_ = 0; h_ < 2; ++h_) _Pragma("unroll") for (int i_ = 0; i_ < 2; ++i_) \
        dst[h_][i_] = (unsigned)idx_tab[(ui_) * 256 + h_ * HALF + rowA[i_]] * (unsigned)(K * 2) + colA[i_]; } while (0)
#define PG8_STAGE_A(bufoff, ptr, h, nf) do { if constexpr (GATHER) { _Pragma("unroll") for (int _i = 0; _i < 2; ++_i) \
        __builtin_amdgcn_global_load_lds((const unsigned*)((const char*)(ptr) + ((nf) ? vGn[h][_i] : vGc[h][_i])), (PG8_LAS unsigned*)(lds + (bufoff) + ldsw + _i * 8192), 16, 0, 0); } \
        else PG8_STAGE(bufoff, (ptr) + (h) * hstep, voffA); } while (0)
    const size_t kstep = (size_t)(BK * 2);
    const size_t hstep = (size_t)HALF * K * 2;
    const size_t tstep = 2 * hstep;
    const unsigned ldsw = (unsigned)wid * 1024u;
    const int aoff = lds_byte(wr * 64 + fr, fq * 8), boff = lds_byte(wc * 32 + fr, fq * 8);
#define PG8_SA(b, h) (((b) * 2 + (h)) * HTB)
#define PG8_SB(b, h) ((4 + (b) * 2 + (h)) * HTB)
#define PG8_STAGE(bufoff, gbase, voff) do { _Pragma("unroll") for (int _i = 0; _i < 2; ++_i) \
        __builtin_amdgcn_global_load_lds((const unsigned*)((const char*)(gbase) + (voff)[_i]), (PG8_LAS unsigned*)(lds + (bufoff) + ldsw + _i * 8192), 16, 0, 0); } while (0)
#define PG8_LDA(dst, b, h) do { _Pragma("unroll") for (int m = 0; m < 4; ++m) _Pragma("unroll") for (int k = 0; k < 2; ++k) dst[m][k] = *(const PG8_LAS bf16x8*)(lds + PG8_SA(b, h) + aoff + m * 2048 + k * 1024); } while (0)
#define PG8_LDB(dst, b, h) do { _Pragma("unroll") for (int n = 0; n < 2; ++n) _Pragma("unroll") for (int k = 0; k < 2; ++k) dst[n][k] = *(const PG8_LAS bf16x8*)(lds + PG8_SB(b, h) + boff + n * 2048 + k * 1024); } while (0)
#define PG8_MMA(ai, bj, At, Bt) do { if (cur.thin && ((ai) != 0 || wr != 0)) break; __builtin_amdgcn_s_setprio(1); _Pragma("unroll") for (int m = 0; m < 4; ++m) _Pragma("unroll") for (int n = 0; n < 2; ++n) _Pragma("unroll") for (int k = 0; k < 2; ++k) \
        acc[ai][bj][m][n] = __builtin_amdgcn_mfma_f32_16x16x32_bf16(Bt[n][k], At[m][k], acc[ai][bj][m][n], 0, 0, 0); __builtin_amdgcn_s_setprio(0); } while (0)
#define PG8_WAIT_V(n) asm volatile("s_waitcnt vmcnt(" #n ")" ::: "memory")
#define PG8_WAIT_L(n) asm volatile("s_waitcnt lgkmcnt(" #n ")" ::: "memory")
#define PG8_BAR __builtin_amdgcn_s_barrier()
#define PG8_SCHED __builtin_amdgcn_sched_barrier(0)
    Unit cur, nxt; int ui = 0;
    if (!S.next(0, cur)) return;
    f32x4 acc[2][2][4][2];
#pragma unroll
    for (int a = 0; a < 2; ++a)
#pragma unroll
        for (int b = 0; b < 2; ++b)
#pragma unroll
            for (int m = 0; m < 4; ++m)
#pragma unroll
                for (int n = 0; n < 2; ++n) acc[a][b][m][n] = (f32x4){0.f, 0.f, 0.f, 0.f};
    bf16x8 At[4][2], B0[2][2], B1[2][2];
    const char* cA = GATHER ? (const char*)g.A : (const char*)g.A + (size_t)cur.pm * tstep; const char* cB = (const char*)g.Bt + (g.pm_per_grp ? (size_t)(cur.pm / g.pm_per_grp) * g.grp_stride * 2 : (size_t)0) + (size_t)cur.pn * tstep;
    S.a_ready(cur);
    if constexpr (GATHER) { PG8_GOFF(vGc, 0); }
    if constexpr (SP2) {
        PG8_STAGE(PG8_SB(0, 0), cB, voffB); PG8_STAGE(PG8_SB(0, 1), cB + hstep, voffB); PG8_STAGE_A(PG8_SA(0, 0), cA, 0, false); PG8_STAGE_A(PG8_SA(0, 1), cA, 1, false);
        if (wr == 1) PG8_BAR;
        PG8_WAIT_V(2); PG8_BAR;
        PG8_STAGE(PG8_SB(1, 0), cB + kstep, voffB); PG8_STAGE_A(PG8_SA(1, 0), cA + kstep, 0, false); PG8_STAGE(PG8_SB(1, 1), cB + hstep + kstep, voffB);
        PG8_WAIT_V(6); PG8_BAR;
    } else {
        PG8_STAGE(PG8_SB(0, 0), cB, voffB); PG8_STAGE(PG8_SA(0, 0), cA, voffA); PG8_STAGE(PG8_SB(0, 1), cB + hstep, voffB); PG8_STAGE(PG8_SA(0, 1), cA + hstep, voffA);
        if (wr == 1) PG8_BAR;
        PG8_WAIT_V(4); PG8_BAR;
        PG8_STAGE(PG8_SB(1, 0), cB + kstep, voffB); PG8_STAGE(PG8_SA(1, 0), cA + kstep, voffA); PG8_STAGE(PG8_SB(1, 1), cB + hstep + kstep, voffB);
        PG8_WAIT_V(6); PG8_BAR;
    }
    for (;;) {
        const bool has_next = S.next(ui + 1, nxt);
        const char* nA = GATHER ? (const char*)g.A : (has_next ? (const char*)g.A + (size_t)nxt.pm * tstep : cA);
        if constexpr (GATHER) { if (has_next) { PG8_GOFF(vGn, ui + 1); } else {
#pragma unroll
            for (int h_ = 0; h_ < 2; ++h_) { vGn[h_][0] = vGc[h_][0]; vGn[h_][1] = vGc[h_][1]; } } } const char* nB = has_next ? (const char*)g.Bt + (g.pm_per_grp ? (size_t)(nxt.pm / g.pm_per_grp) * g.grp_stride * 2 : (size_t)0) + (size_t)nxt.pn * tstep : cB;
        for (int t = 0; t < nt; t += 2) {
            const bool last = (t == nt - 2);
            const char* a1 = cA + (size_t)(t + 1) * kstep;
            const char* a2 = last ? nA : cA + (size_t)(t + 2) * kstep; const char* b2 = last ? nB : cB + (size_t)(t + 2) * kstep;
            const char* a3 = a2 + kstep; const char* b3 = b2 + kstep;
            if (last && has_next) S.a_ready(nxt);
            if constexpr (SP2) {
            PG8_LDB(B0, 0, 0); PG8_LDB(B1, 0, 1); PG8_SCHED; PG8_LDA(At, 0, 0); PG8_STAGE_A(PG8_SA(1, 1), a1, 1, false);
            PG8_WAIT_V(8); PG8_WAIT_L(0); PG8_BAR; PG8_MMA(0, 0, At, B0); PG8_MMA(0, 1, At, B1); PG8_BAR; PG8_SCHED;
            PG8_LDA(At, 0, 1); PG8_STAGE(PG8_SB(0, 0), b2, voffB); PG8_STAGE(PG8_SB(0, 1), b2 + hstep, voffB); PG8_STAGE_A(PG8_SA(0, 0), a2, 0, last);
            PG8_WAIT_V(8); PG8_WAIT_L(0); PG8_BAR; PG8_MMA(1, 0, At, B0); PG8_MMA(1, 1, At, B1); PG8_BAR; PG8_SCHED;
            PG8_LDB(B0, 1, 0); PG8_LDB(B1, 1, 1); PG8_SCHED; PG8_LDA(At, 1, 0); PG8_STAGE_A(PG8_SA(0, 1), a2, 1, last);
            PG8_WAIT_V(8); PG8_WAIT_L(0); PG8_BAR; PG8_MMA(0, 0, At, B0); PG8_MMA(0, 1, At, B1); PG8_BAR; PG8_SCHED;
            PG8_LDA(At, 1, 1); PG8_STAGE(PG8_SB(1, 0), b3, voffB); PG8_STAGE(PG8_SB(1, 1), b3 + hstep, voffB); PG8_STAGE_A(PG8_SA(1, 0), a3, 0, last);
            PG8_WAIT_V(8); PG8_WAIT_L(0); PG8_BAR; PG8_MMA(1, 0, At, B0); PG8_MMA(1, 1, At, B1); PG8_BAR; PG8_SCHED;
            } else {
            PG8_LDB(B0, 0, 0); PG8_SCHED; PG8_LDA(At, 0, 0); PG8_STAGE(PG8_SA(1, 1), a1 + hstep, voffA);
            PG8_WAIT_L(8); PG8_BAR; PG8_WAIT_L(0); PG8_MMA(0, 0, At, B0); PG8_BAR; PG8_SCHED;
            PG8_LDB(B1, 0, 1); PG8_STAGE(PG8_SB(0, 0), b2, voffB);
            PG8_BAR; PG8_WAIT_L(0); PG8_MMA(0, 1, At, B1); PG8_BAR;
            PG8_LDA(At, 0, 1); PG8_STAGE(PG8_SA(0, 0), a2, voffA);
            PG8_BAR; PG8_WAIT_L(0); PG8_MMA(1, 0, At, B0); PG8_BAR; PG8_SCHED;
            PG8_STAGE(PG8_SB(0, 1), b2 + hstep, voffB);
            PG8_WAIT_V(6); PG8_BAR; PG8_MMA(1, 1, At, B1); PG8_BAR;
            PG8_LDB(B0, 1, 0); PG8_SCHED; PG8_LDA(At, 1, 0); PG8_STAGE(PG8_SA(0, 1), a2 + hstep, voffA);
            PG8_WAIT_L(8); PG8_BAR; PG8_WAIT_L(0); PG8_MMA(0, 0, At, B0); PG8_BAR; PG8_SCHED;
            PG8_LDB(B1, 1, 1); PG8_STAGE(PG8_SB(1, 0), b3, voffB);
            PG8_BAR; PG8_WAIT_L(0); PG8_MMA(0, 1, At, B1); PG8_BAR;
            PG8_LDA(At, 1, 1); PG8_STAGE(PG8_SA(1, 0), a3, voffA);
            PG8_BAR; PG8_WAIT_L(0); PG8_MMA(1, 0, At, B0); PG8_BAR; PG8_SCHED;
            PG8_STAGE(PG8_SB(1, 1), b3 + hstep, voffB);
            PG8_WAIT_V(6); PG8_BAR; PG8_MMA(1, 1, At, B1); PG8_BAR;
            }
        }
        if constexpr (ALIGN_EPI) { if (wr == 0) PG8_BAR; }
        if constexpr (!Epi::AFTER_DRAIN) { E(acc, cur, wr, wc, fr, fq); S.done(cur); }
        if (!has_next) break;
#pragma unroll
        for (int a = 0; a < 2; ++a)
#pragma unroll
            for (int b = 0; b < 2; ++b)
#pragma unroll
                for (int m = 0; m < 4; ++m)
#pragma unroll
                    for (int n = 0; n < 2; ++n) acc[a][b][m][n] = (f32x4){0.f, 0.f, 0.f, 0.f};
        cur = nxt; cA = nA; cB = nB; ++ui;
        if constexpr (GATHER) {
#pragma unroll
            for (int h_ = 0; h_ < 2; ++h_) { vGc[h_][0] = vGn[h_][0]; vGc[h_][1] = vGn[h_][1]; } }
        if constexpr (ALIGN_EPI) { if (wr == 1) PG8_BAR; }
    }
    PG8_WAIT_V(0);
    if constexpr (!ALIGN_EPI) { if (wr == 0) PG8_BAR; }
    PG8_BAR;
    if constexpr (Epi::AFTER_DRAIN) { E.fused(acc, cur, wr, wc, fr, fq, lds, wid, lane); S.done(cur); }
#undef PG8_GOFF
#undef PG8_STAGE_A
#undef PG8_SA
#undef PG8_SB
#undef PG8_STAGE
#undef PG8_LDA
#undef PG8_LDB
#undef PG8_MMA
#undef PG8_WAIT_V
#undef PG8_WAIT_L
#undef PG8_BAR
#undef PG8_SCHED
}
}
#ifndef USE_PG8
#define USE_PG8 1
#endif

typedef const f32x4 (&AccRef)[2][2][4][2];
struct EpiStoreBf16 { static constexpr bool DUAL = false, PERM = true, AFTER_DRAIN = false; bf16* O; int ldc;
    __device__ __forceinline__ void elem(int row, int col, float v, float) const { O[(size_t)row * ldc + col] = (bf16)f2bf(v); }
    __device__ __forceinline__ void operator()(AccRef acc, const pg8::Unit& u, int wr, int wc, int fr, int fq) const {
        const int row0 = u.pm * 256 + wr * 64 + fr, col0 = u.pn * 256 + wc * 32 + 8 * fq;
#pragma unroll
        for (int ai = 0; ai < 2; ++ai)
#pragma unroll
            for (int m = 0; m < 4; ++m) { bf16* rowp = O + (size_t)(row0 + ai * 128 + m * 16) * ldc + col0;
#pragma unroll
                for (int bj = 0; bj < 2; ++bj) { const f32x4 v0 = acc[ai][bj][m][0], v1 = acc[ai][bj][m][1];
                    u32x4 w; w.x = cvt_pk_bf16(v0[0], v0[1]); w.y = cvt_pk_bf16(v0[2], v0[3]); w.z = cvt_pk_bf16(v1[0], v1[1]); w.w = cvt_pk_bf16(v1[2], v1[3]);
                    *(u32x4*)(rowp + bj * 128) = w; } }
    } };
struct EpiStoreHeads { static constexpr bool DUAL = false, PERM = true, AFTER_DRAIN = false; bf16* O; int hw; size_t hstride;
    __device__ __forceinline__ void store4(int row, int col, f32x4 v) const { const int hd = col / hw, wi = col - hd * hw; u32x2 o; o.x = cvt_pk_bf16(v[0], v[1]); o.y = cvt_pk_bf16(v[2], v[3]); *(u32x2*)(O + (size_t)hd * hstride + (size_t)row * hw + wi) = o; }
    __device__ __forceinline__ void elem(int row, int col, float v, float) const { O[(size_t)(col / hw) * hstride + (size_t)row * hw + (col % hw)] = (bf16)f2bf(v); }
    __device__ __forceinline__ void operator()(AccRef acc, const pg8::Unit& u, int wr, int wc, int fr, int fq) const {
        const int row0 = u.pm * 256 + wr * 64 + fr, col0 = u.pn * 256 + wc * 32 + 8 * fq;
#pragma unroll
        for (int bj = 0; bj < 2; ++bj) { const int c = col0 + bj * 128, hd = c / hw, wi = c - hd * hw; bf16* base = O + (size_t)hd * hstride + wi;
#pragma unroll
            for (int ai = 0; ai < 2; ++ai)
#pragma unroll
                for (int m = 0; m < 4; ++m) { const f32x4 v0 = acc[ai][bj][m][0], v1 = acc[ai][bj][m][1];
                    u32x4 w; w.x = cvt_pk_bf16(v0[0], v0[1]); w.y = cvt_pk_bf16(v0[2], v0[3]); w.z = cvt_pk_bf16(v1[0], v1[1]); w.w = cvt_pk_bf16(v1[2], v1[3]);
                    *(u32x4*)(base + (size_t)(row0 + ai * 128 + m * 16) * hw) = w; } }
    } };
struct EpiStoreF32 { static constexpr bool DUAL = false, PERM = false, AFTER_DRAIN = false; float* O; int ldc;
    __device__ __forceinline__ void store4(int row, int col, f32x4 v) const { *(f32x4*)(O + (size_t)row * ldc + col) = v; }
    __device__ __forceinline__ void elem(int row, int col, float v, float) const { O[(size_t)row * ldc + col] = v; }
    __device__ __forceinline__ void operator()(AccRef acc, const pg8::Unit& u, int wr, int wc, int fr, int fq) const {
        const int row0 = u.pm * 256 + wr * 64 + fr, col0 = u.pn * 256 + wc * 32 + 4 * fq;
#pragma unroll
        for (int ai = 0; ai < 2; ++ai)
#pragma unroll
            for (int m = 0; m < 4; ++m) { float* rowp = O + (size_t)(row0 + ai * 128 + m * 16) * ldc + col0;
#pragma unroll
                for (int bj = 0; bj < 2; ++bj)
#pragma unroll
                    for (int n = 0; n < 2; ++n) *(f32x4*)(rowp + bj * 128 + n * 16) = acc[ai][bj][m][n]; }
    } };
struct EpiResid { static constexpr bool DUAL = false, PERM = false, AFTER_DRAIN = false; float* X; const float* g_lat; const float* g_ctx;
    __device__ __forceinline__ void store4(int row, int col, f32x4 v) const { const float* g = row >= SEQ ? g_ctx : g_lat; f32x4* p = (f32x4*)(X + (size_t)row * D + col); *p = *p + *(const f32x4*)(g + col) * v; }
    __device__ __forceinline__ void elem(int row, int col, float v, float) const { const float g = row >= SEQ ? g_ctx[col] : g_lat[col]; X[(size_t)row * D + col] += g * v; }
    __device__ __forceinline__ void operator()(AccRef acc, const pg8::Unit& u, int wr, int wc, int fr, int fq) const {
        const int row0 = u.pm * 256 + wr * 64 + fr, col0 = u.pn * 256 + wc * 32 + 4 * fq;
        const float* g = (u.pm * 256 >= SEQ) ? g_ctx : g_lat;
        f32x4 gv[2][2];
#pragma unroll
        for (int bj = 0; bj < 2; ++bj)
#pragma unroll
            for (int n = 0; n < 2; ++n) gv[bj][n] = *(const f32x4*)(g + col0 + bj * 128 + n * 16);
#pragma unroll
        for (int ai = 0; ai < 2; ++ai)
#pragma unroll
            for (int m = 0; m < 4; ++m) { float* rowp = X + (size_t)(row0 + ai * 128 + m * 16) * D + col0;
#pragma unroll
                for (int bj = 0; bj < 2; ++bj)
#pragma unroll
                    for (int n = 0; n < 2; ++n) { f32x4* p = (f32x4*)(rowp + bj * 128 + n * 16); *p = *p + gv[bj][n] * acc[ai][bj][m][n]; } }
    } };
__device__ __forceinline__ float silu_mul(float g, float u) { return g * __builtin_amdgcn_rcpf(1.f + __expf(-g)) * u; }
struct EpiSwiglu { static constexpr bool DUAL = true, PERM = true, AFTER_DRAIN = false; bf16* ACT;
    __device__ __forceinline__ void elem(int row, int col, float g, float u) const { ACT[(size_t)row * FF + col] = (bf16)f2bf(g / (1.f + __expf(-g)) * u); }
    __device__ __forceinline__ void operator()(AccRef acc, const pg8::Unit& u, int wr, int wc, int fr, int fq) const {
        const int row0 = u.pm * 256 + wr * 64 + fr, col0 = u.pn * 128 + wc * 32 + 8 * fq;
#pragma unroll
        for (int ai = 0; ai < 2; ++ai)
#pragma unroll
            for (int m = 0; m < 4; ++m) { bf16* rowp = ACT + (size_t)(row0 + ai * 128 + m * 16) * FF + col0;
                const f32x4 g0 = acc[ai][0][m][0], g1 = acc[ai][0][m][1], u0 = acc[ai][1][m][0], u1 = acc[ai][1][m][1];
                u32x4 w; w.x = cvt_pk_bf16(silu_mul(g0[0], u0[0]), silu_mul(g0[1], u0[1])); w.y = cvt_pk_bf16(silu_mul(g0[2], u0[2]), silu_mul(g0[3], u0[3]));
                w.z = cvt_pk_bf16(silu_mul(g1[0], u1[0]), silu_mul(g1[1], u1[1])); w.w = cvt_pk_bf16(silu_mul(g1[2], u1[2]), silu_mul(g1[3], u1[3]));
                *(u32x4*)rowp = w; }
    } };
struct EpiMoeOut { static constexpr bool DUAL = false, PERM = true, AFTER_DRAIN = false; bf16* YB; const float* gatel;
    __device__ __forceinline__ void elem(int row, int col, float v, float) const { YB[(size_t)row * D + col] = (bf16)f2bf(v * gatel[row]); }
    __device__ __forceinline__ void operator()(AccRef acc, const pg8::Unit& u, int wr, int wc, int fr, int fq) const {
        const int row0 = u.pm * 256 + wr * 64 + fr, col0 = u.pn * 256 + wc * 32 + 8 * fq;
#pragma unroll
        for (int ai = 0; ai < 2; ++ai)
#pragma unroll
            for (int m = 0; m < 4; ++m) { const int row = row0 + ai * 128 + m * 16; const float gt = gatel[row]; bf16* rowp = YB + (size_t)row * D + col0;
#pragma unroll
                for (int bj = 0; bj < 2; ++bj) { const f32x4 v0 = acc[ai][bj][m][0] * gt, v1 = acc[ai][bj][m][1] * gt;
                    u32x4 w; w.x = cvt_pk_bf16(v0[0], v0[1]); w.y = cvt_pk_bf16(v0[2], v0[3]); w.z = cvt_pk_bf16(v1[0], v1[1]); w.w = cvt_pk_bf16(v1[2], v1[3]);
                    *(u32x4*)(rowp + bj * 128) = w; } }
    } };

template <class Epi>
__device__ __forceinline__ void naive_gemm(const Ctx& C, const bf16* A, const bf16* Bt, int M, int N, int K, int pm_per_grp, size_t grp_stride, const Epi& E) {
    LAS float* As = (LAS float*)C.lds;
    LAS float* Bs = As + 16 * 132;
    LAS float* Bs2 = Bs + 16 * 68;
    const int NO = Epi::DUAL ? N / 2 : N, tn_cnt = NO / 64, nun = (M / 128) * tn_cnt;
    const int ty = C.tid >> 4, tx = C.tid & 15;
    for (int u = C.blk; u < nun; u += C.G) {
        const int tm = u / tn_cnt, tn = u % tn_cnt, row0 = tm * 128, oc0 = tn * 64;
        const bf16* Bg = Bt + (pm_per_grp ? (size_t)((row0 / 256) / pm_per_grp) * grp_stride : (size_t)0);
        const int brow0 = Epi::DUAL ? ((oc0 >> 7) * 256 + (oc0 & 127)) : oc0;
        float acc[4][4], acc2[4][4];
#pragma unroll
        for (int i = 0; i < 4; ++i)
#pragma unroll
            for (int j = 0; j < 4; ++j) { acc[i][j] = 0.f; acc2[i][j] = 0.f; }
        for (int k0 = 0; k0 < K; k0 += 16) {
            __syncthreads();
            { const int r = C.tid >> 2, kc = (C.tid & 3) * 4;
              const u32x2 w = *(const u32x2*)(A + (size_t)(row0 + r) * K + k0 + kc);
              As[(kc + 0) * 132 + r] = bf2f(w.x & 0xffffu); As[(kc + 1) * 132 + r] = bf2f(w.x >> 16); As[(kc + 2) * 132 + r] = bf2f(w.y & 0xffffu); As[(kc + 3) * 132 + r] = bf2f(w.y >> 16); }
            if (C.tid < 256) { const int r = C.tid >> 2, kc = (C.tid & 3) * 4;
              const u32x2 w = *(const u32x2*)(Bg + (size_t)(brow0 + r) * K + k0 + kc);
              Bs[(kc + 0) * 68 + r] = bf2f(w.x & 0xffffu); Bs[(kc + 1) * 68 + r] = bf2f(w.x >> 16); Bs[(kc + 2) * 68 + r] = bf2f(w.y & 0xffffu); Bs[(kc + 3) * 68 + r] = bf2f(w.y >> 16);
              if (Epi::DUAL) { const u32x2 w2 = *(const u32x2*)(Bg + (size_t)(brow0 + 128 + r) * K + k0 + kc);
                Bs2[(kc + 0) * 68 + r] = bf2f(w2.x & 0xffffu); Bs2[(kc + 1) * 68 + r] = bf2f(w2.x >> 16); Bs2[(kc + 2) * 68 + r] = bf2f(w2.y & 0xffffu); Bs2[(kc + 3) * 68 + r] = bf2f(w2.y >> 16); } }
            __syncthreads();
#pragma unroll
            for (int kk = 0; kk < 16; ++kk) {
                const f32x4 a = *(const LAS f32x4*)(As + kk * 132 + ty * 4), b = *(const LAS f32x4*)(Bs + kk * 68 + tx * 4);
#pragma unroll
                for (int i = 0; i < 4; ++i)
#pragma unroll
                    for (int j = 0; j < 4; ++j) acc[i][j] += a[i] * b[j];
                if (Epi::DUAL) { const f32x4 b2 = *(const LAS f32x4*)(Bs2 + kk * 68 + tx * 4);
#pragma unroll
                    for (int i = 0; i < 4; ++i)
#pragma unroll
                        for (int j = 0; j < 4; ++j) acc2[i][j] += a[i] * b2[j]; }
            }
        }
#pragma unroll
        for (int i = 0; i < 4; ++i)
#pragma unroll
            for (int j = 0; j < 4; ++j) E.elem(row0 + ty * 4 + i, oc0 + tx * 4 + j, acc[i][j], acc2[i][j]);
    }
    __syncthreads();
}

template <class Epi>
__device__ __forceinline__ void gemm(const Ctx& C, const bf16* A, const bf16* Bt, int M, int N, int K, int pm_per_grp, size_t grp_stride, const Epi& E) {
#if USE_PG8
    pg8::Gemm g{A, Bt, M, N, K, pm_per_grp, grp_stride}; pg8::StaticOrder S; S.init(M, N, C.G, C.blk);
    pg8::gemm_phase<Epi, pg8::StaticOrder, true, true>(C.lds, g, S, E);
#else
    naive_gemm(C, A, Bt, M, N, K, pm_per_grp, grp_stride, E);
#endif
}
template <class Epi>
__device__ __forceinline__ void small_gemm(const Ctx& C, const bf16* A, const bf16* Bt, int row0, int nrows, int N, int K, const Epi& E) {
    const int ql = C.lane & 31, hi = C.lane >> 5, nrb = nrows / 32, nitems = nrb * (N / 32);
    for (int it = C.blk * 8 + C.wave; it < nitems; it += C.G * 8) {
        const int cb = it / nrb, rb = it % nrb;
        const bf16* ap = A + (size_t)(row0 + rb * 32 + ql) * K + 8 * hi; const bf16* bp = Bt + (size_t)(cb * 32 + ql) * K + 8 * hi;
        f32x16 acc;
#pragma unroll
        for (int r = 0; r < 16; ++r) acc[r] = 0.f;
#pragma unroll 1
        for (int k0 = 0; k0 < K; k0 += 256) {
            bf16x8 a[16], b[16];
#pragma unroll
            for (int q = 0; q < 16; ++q) { a[q] = *(const bf16x8*)(ap + k0 + 16 * q); b[q] = *(const bf16x8*)(bp + k0 + 16 * q); }
            __builtin_amdgcn_sched_barrier(0);
#pragma unroll
            for (int q = 0; q < 16; ++q) acc = __builtin_amdgcn_mfma_f32_32x32x16_bf16(b[q], a[q], acc, 0, 0, 0);
            __builtin_amdgcn_sched_barrier(0);
        }
        const int row = row0 + rb * 32 + ql;
#pragma unroll
        for (int g = 0; g < 4; ++g) E.store4(row, cb * 32 + 8 * g + 4 * hi, (f32x4){acc[4 * g], acc[4 * g + 1], acc[4 * g + 2], acc[4 * g + 3]});
    }
}
template <class Epi>
__device__ __forceinline__ void gemm_tok(const Ctx& C, const bf16* A, const bf16* Bt, int N, int K, bool with_ctx, const Epi& E) {
#if USE_PG8
    gemm(C, A, Bt, SEQ, N, K, 0, 0, E);
    if (with_ctx) small_gemm(C, A, Bt, SEQ, NCTX, N, K, E);
#else
    naive_gemm(C, A, Bt, with_ctx ? R : SEQ, N, K, 0, 0, E);
#endif
}
constexpr int LDS_IDX_OFF = 132096;
template <class Epi>
__device__ __forceinline__ void gemm_moe(const Ctx& C, const bf16* A, const bf16* Bt, int N, int K, size_t grp_stride, bool with_ctx, const Epi& E, const int* rowlist = nullptr) {
#if USE_PG8
    pg8::Gemm g{A, Bt, XROWS, N, K, 9, grp_stride}; pg8::MoeOrder S; S.init(N, C.G, C.blk, with_ctx);
    if (rowlist) {
        LAS int* tab = (LAS int*)(C.lds + LDS_IDX_OFF); pg8::Unit u;
        for (int i = 0; S.next(i, u); ++i) if (C.tid < 256) tab[i * 256 + C.tid] = rowlist[u.pm * 256 + C.tid];
        __syncthreads();
        pg8::gemm_phase<Epi, pg8::MoeOrder, true, true, true>(C.lds, g, S, E, tab);
        return;
    }
    pg8::gemm_phase<Epi, pg8::MoeOrder, true, true>(C.lds, g, S, E);
#else
    naive_gemm(C, A, Bt, XROWS, N, K, 9, grp_stride, E);
#endif
}

template <int KIND>
__device__ __forceinline__ void ph_attn_naive(const Ctx& C, int slot) {
    constexpr int DQK = KIND == 2 ? 96 : 64, DH = DQK / 2;
    LAS float* Ks = (LAS float*)C.lds;
    LAS float* Vs = Ks + 32 * DQK;
    LAS float* Bsm = Vs + 32 * 64;
    const bf16 *Qb, *Kb, *Vb, *KRb = nullptr; int qp, kp, vp, kgrp = 1; size_t qhs, khs, vhs; float scale;
    if (KIND == 0) { Qb = WSP(bf16, WS_QKV); Kb = Qb + (size_t)16 * R * 64; Vb = Qb + (size_t)32 * R * 64; qp = kp = vp = 64; qhs = khs = vhs = (size_t)R * 64; scale = 0.125f; }
    else if (KIND == 1) { Qb = WSP(bf16, WS_QKV); Kb = Qb + (size_t)16 * R * 64; Vb = Qb + (size_t)20 * R * 64; qp = kp = vp = 64; qhs = khs = vhs = (size_t)R * 64; kgrp = 4; scale = 0.125f; }
    else { Qb = WSP(bf16, WS_Q); Kb = WSP(bf16, WS_KV); Vb = Kb + 64; KRb = WSP(bf16, WS_KROPE); qp = 96; kp = vp = 128; qhs = (size_t)R * 96; khs = vhs = (size_t)R * 128; scale = 0.10206207261596575f; }
    bf16* Ob = WSP(bf16, WS_O);
    const int half = C.tid & 1, qi = C.tid >> 1;
    for (int u = C.blk; u < 1040; u += C.G) {
        const bool isctx = u >= 1024;
        const int h = isctx ? (u - 1024) : (u & 15), q0 = isctx ? SEQ : (u >> 4) * 256, kh = h / kgrp;
        const int t = q0 + qi;
        float q[DH], o[32];
        { const bf16* qr = Qb + (size_t)t * qp + h * qhs + half * DH;
#pragma unroll
          for (int d = 0; d < DH; d += 8) { const u32x4 w = *(const u32x4*)(qr + d);
              q[d + 0] = bf2f(w.x & 0xffffu); q[d + 1] = bf2f(w.x >> 16); q[d + 2] = bf2f(w.y & 0xffffu); q[d + 3] = bf2f(w.y >> 16);
              q[d + 4] = bf2f(w.z & 0xffffu); q[d + 5] = bf2f(w.z >> 16); q[d + 6] = bf2f(w.w & 0xffffu); q[d + 7] = bf2f(w.w >> 16); } }
#pragma unroll
        for (int d = 0; d < 32; ++d) o[d] = 0.f;
        float m = -INFINITY, l = 0.f;
        if (KIND == 1) { m = C.in[13][h]; l = 1.f; }
        int klo = 0, khi = 0;
        if (!isctx) {
            if (KIND == 0) { const int r0 = q0 >> 6; const int ra = r0 - 4 < 0 ? 0 : r0 - 4, rb = r0 + 7 > 255 ? 255 : r0 + 7; klo = ra * 64; khi = (rb + 1) * 64; }
            else if (KIND == 1) { klo = q0 - 128 < 0 ? 0 : q0 - 128; khi = q0 + 384 > SEQ ? SEQ : q0 + 384; }
            else { klo = 0; khi = SEQ; }
        }
        if (KIND == 0) { __syncthreads(); const float* rp = C.in[10] + ((size_t)slot * 16 + h) * 465; for (int i = C.tid; i < 465; i += 512) Bsm[i] = rp[i]; }
        const int qr_ = t >> 6, qc_ = t & 63;
        int rs = qr_ - 4; rs = rs < 0 ? 0 : (rs > 248 ? 248 : rs);
        int cs0 = qc_ - 8; cs0 = cs0 < 0 ? 0 : (cs0 > 48 ? 48 : cs0);
        for (int seg = 0; seg < 2; ++seg) {
            const int kb = seg == 0 ? klo : SEQ, ke = seg == 0 ? khi : R;
            for (int k0 = kb; k0 < ke; k0 += 32) {
                __syncthreads();
                for (int i = C.tid; i < 32 * DQK; i += 512) { const int j = i / DQK, d = i % DQK; const int row = k0 + j;
                    unsigned b;
                    if (KIND == 2 && d >= 64) b = KRb[(size_t)row * 32 + (d - 64)]; else b = Kb[(size_t)row * kp + kh * khs + d];
                    Ks[i] = bf2f(b); }
                for (int i = C.tid; i < 32 * 64; i += 512) { const int j = i >> 6, d = i & 63; Vs[i] = bf2f(Vb[(size_t)(k0 + j) * vp + kh * vhs + d]); }
                __syncthreads();
#pragma unroll 1
                for (int j = 0; j < 32; ++j) {
                    const int kt = k0 + j; bool valid = true; float bias = 0.f;
                    if (seg == 0) {
                        if (KIND == 0) { const int kr = kt >> 6, kc = kt & 63; valid = kr >= rs && kr < rs + 8 && kc >= cs0 && kc < cs0 + 16;
                            if (valid) bias = Bsm[(kr - qr_ + 7) * 31 + (kc - qc_ + 15)]; }
                        else if (KIND == 1) { const int dd = kt - t; valid = dd <= 128 && dd >= -128; }
                    }
                    float s0 = 0.f, s1 = 0.f;
#pragma unroll
                    for (int d = 0; d < DH; d += 4) { const f32x4 kv = *(const LAS f32x4*)(Ks + j * DQK + half * DH + d); s0 += q[d] * kv.x + q[d + 2] * kv.z; s1 += q[d + 1] * kv.y + q[d + 3] * kv.w; }
                    float sp = s0 + s1; sp += __shfl_xor(sp, 1);
                    if (valid) {
                        const float s = sp * scale + bias;
                        if (s > m) { const float a = __expf(m - s); l *= a;
#pragma unroll
                            for (int d = 0; d < 32; ++d) o[d] *= a;
                            m = s; }
                        const float p = __expf(s - m); l += p;
#pragma unroll
                        for (int d = 0; d < 32; d += 4) { const f32x4 vv = *(const LAS f32x4*)(Vs + j * 64 + half * 32 + d); o[d] += p * vv.x; o[d + 1] += p * vv.y; o[d + 2] += p * vv.z; o[d + 3] += p * vv.w; }
                    }
                }
            }
        }
        { const float il = 1.f / l; bf16* orow = Ob + (size_t)t * D + h * 64 + half * 32;
#pragma unroll
            for (int d = 0; d < 32; d += 8) { u32x4 w; w.x = pk2(o[d] * il, o[d + 1] * il); w.y = pk2(o[d + 2] * il, o[d + 3] * il); w.z = pk2(o[d + 4] * il, o[d + 5] * il); w.w = pk2(o[d + 6] * il, o[d + 7] * il);
                *(u32x4*)(orow + d) = w; } }
    }
    __syncthreads();
}

#ifndef USE_FAST_ATTN
#define USE_FAST_ATTN 1
#endif
__device__ __forceinline__ s16x4 lds_tr16(const LAS unsigned char* p) { return __builtin_bit_cast(s16x4, __builtin_amdgcn_ds_read_tr16_b64_v4i16((LAS s16x4*)p)); }
__device__ __forceinline__ int crow(int r, int hi) { return (r & 3) + 8 * (r >> 2) + 4 * hi; }

#define ATT_BAR() do { __builtin_amdgcn_sched_barrier(0); asm volatile("s_waitcnt lgkmcnt(0)\n\ts_barrier" ::: "memory"); __builtin_amdgcn_sched_barrier(0); } while (0)
template <int KIND, int VARIANT = 0>
__device__ __forceinline__ void ph_attn_fast(const Ctx& C, int slot, bool with_ctxq, int conv_layer = -1) {
    constexpr int DQK = KIND == 2 ? 96 : 64, NS = DQK / 16, CPR = DQK / 8, CPRP = CPR + (KIND == 2 ? 1 : 0);
    constexpr int KS = CPRP * 16, VS = 128, KBYTES = 64 * KS, VBYTES = 64 * VS, SLOTB = KBYTES + VBYTES;
    constexpr int NKC = 64 * CPRP, NINST = (NKC + 64 * 8) / 64, NDMA = (NINST + 7) / 8, NRING = 4, PD = 3;
    static_assert(NKC % 64 == 0 && SLOTB % 1024 == 0 && NRING * SLOTB + 2048 <= 131072, "attention ring geometry");
    LAS unsigned char* lds = C.lds; const unsigned lds_u32 = (unsigned)(size_t)C.lds;
    LAS float* Bsm = (LAS float*)(lds + NRING * SLOTB);
    const bf16 *Qb, *Kb, *Vb, *KRb = nullptr; int qp, kp, vp, kgrp = 1; size_t qhs, khs, vhs; float scale;
    if (KIND == 0) { Qb = WSP(bf16, WS_QKV); Kb = Qb + (size_t)16 * R * 64; Vb = Qb + (size_t)32 * R * 64; qp = kp = vp = 64; qhs = khs = vhs = (size_t)R * 64; scale = 0.125f; }
    else if (KIND == 1) { Qb = WSP(bf16, WS_QKV); Kb = Qb + (size_t)16 * R * 64; Vb = Qb + (size_t)20 * R * 64; qp = kp = vp = 64; qhs = khs = vhs = (size_t)R * 64; kgrp = 4; scale = 0.125f; }
    else { Qb = WSP(bf16, WS_Q); Kb = WSP(bf16, WS_KV); Vb = Kb + 64; KRb = WSP(bf16, WS_KROPE); qp = 96; kp = vp = 128; qhs = (size_t)R * 96; khs = vhs = (size_t)R * 128; scale = 0.10206207261596575f; }
    bf16* Ob = VARIANT ? WSP(bf16, WS_ACT) : WSP(bf16, WS_O);
    const float c2 = scale * 1.4426950408889634f;
    const int w = C.wave, lane = C.lane, ql = lane & 31, hi = lane >> 5;
    const int vq_ = (lane & 15) >> 2, vsw_ = 4 * ((vq_ >> 1) & 1), vch_ = 2 * ((lane >> 4) & 1) + ((lane & 3) >> 1);
    const int vlane0 = (vq_ + 4 * hi) * VS + ((0 + vch_) ^ vsw_) * 16 + 8 * (lane & 1), vlane1 = (vq_ + 4 * hi) * VS + ((4 + vch_) ^ vsw_) * 16 + 8 * (lane & 1);
    const int nunits = with_ctxq ? 1040 : 1024;
    ConvState cst; cst.l0 = conv_layer; cst.total = conv_layer < 0 ? 0 : (KIND == 2 ? 2 : 1) * MOE_HALF_ITEMS; cst.cur = C.blk * 8 + C.wave; cst.loaded = false;
    LAS float* cscr = (LAS float*)(C.lds + NRING * SLOTB + 2048 + C.wave * 4096);
    static_assert(NRING * SLOTB + 2048 + 8 * 4096 <= 131072, "conversion scratch");
    static_assert(KIND == 2 || NRING * SLOTB + 2048 == CONV_PIPE_BASE, "pipelined conversion scratch");
    ConvPipe cpipe; cpipe.l0 = conv_layer; cpipe.total = (KIND != 2 && conv_layer >= 0) ? MOE_HALF_ITEMS : 0; cpipe.first = C.blk * 8 + C.wave; cpipe.n = 0;
    const bool convon = cpipe.total > 0; constexpr int CFL = (VARIANT >> 7) & 3;
    for (int u = C.blk; u < nunits; u += C.G) {
        const bool isctx = u >= 1024;
        const int h = isctx ? (u - 1024) : (u & 15), q0 = isctx ? SEQ : (u >> 4) * 256, kh = h / kgrp;
        int lat0 = 0, nlat = 0;
        if (!isctx) {
            if (KIND == 0) { const int r0 = q0 >> 6; int ta = r0 - 4; ta = ta < 0 ? 0 : (ta > 248 ? 248 : ta); int tb = r0 - 1; tb = (tb < 0 ? 0 : (tb > 248 ? 248 : tb)) + 7; lat0 = ta; nlat = tb - ta + 1; }
            else if (KIND == 1) { const int a = q0 - 128 < 0 ? 0 : q0 - 128, b = q0 + 384 > SEQ ? SEQ : q0 + 384; lat0 = a >> 6; nlat = (b - a) >> 6; }
            else { lat0 = 0; nlat = SEQ / 64; }
        }
        const int ntiles = nlat + 4;
        int lane_u = lane; asm volatile("" : "+v"(lane_u));
        const int ql_u = lane_u & 31, hi_u = lane_u >> 5;
        const int t = (KIND == 0 && !isctx) ? q0 + 128 * (w >> 2) + 64 * (ql_u >> 4) + 16 * (w & 3) + (ql_u & 15) : q0 + 32 * w + ql_u;
        bf16x8 qf[NS];
        { const bf16* qr = Qb + (size_t)t * qp + h * qhs + 8 * hi_u;
#pragma unroll
          for (int sidx = 0; sidx < NS; ++sidx) qf[sidx] = *(const bf16x8*)(qr + 16 * sidx); }
        unsigned gsrc[NDMA]; int gpitch[NDMA], ldst[NDMA];
        const char* const wsb = (const char*)C.ws;
#pragma unroll
        for (int jj = 0; jj < NDMA; ++jj) {
            int j = w + 8 * jj; if (j >= NINST) j -= 8;
            const int cidx = 64 * j + lane_u; ldst[jj] = j * 1024;
            if (cidx < NKC) { const int row = cidx / CPRP; int c = cidx % CPRP; if (c >= CPR) c = 0;
                if (KIND != 2) c ^= (row >> 1) & 7;
                if (KIND == 2 && c >= 8) { gsrc[jj] = (unsigned)((const char*)(KRb + (size_t)row * 32 + 8 * (c - 8)) - wsb); gpitch[jj] = 64; }
                else { gsrc[jj] = (unsigned)((const char*)(Kb + kh * khs + (size_t)row * kp + 8 * c) - wsb); gpitch[jj] = kp * 2; } }
            else { const int v = cidx - NKC, row = v >> 3; const int c = (v & 7) ^ (4 * ((row >> 1) & 1));
                gsrc[jj] = (unsigned)((const char*)(Vb + kh * vhs + (size_t)row * vp + 8 * c) - wsb); gpitch[jj] = vp * 2; }
        }
#define ATT_KEY0(i) (KIND == 2 ? (isctx ? SEQ : 0) + (i) * 64 : ((i) < nlat ? (lat0 + (i)) * 64 : SEQ + ((i) - nlat) * 64))
#define ATT_DMA(i, sl) do { const int ti_ = (i) < ntiles ? (i) : ntiles - 1; const unsigned key0_ = (unsigned)ATT_KEY0(ti_); \
        _Pragma("unroll") for (int jj = 0; jj < NDMA; ++jj) \
            __builtin_amdgcn_global_load_lds((const unsigned*)(wsb + (size_t)(gsrc[jj] + __umul24(key0_, (unsigned)gpitch[jj]))), (LAS unsigned*)(lds + (sl) * SLOTB + ldst[jj]), 16, 0, 0); } while (0)
        static_assert(NDMA == (KIND == 2 ? 3 : 2), "the counted waits below are written for these DMA counts");
#define ATT_WAIT_DMA() do { if (NDMA == 2) asm volatile("s_waitcnt vmcnt(4)" ::: "memory"); else asm volatile("s_waitcnt vmcnt(6)" ::: "memory"); } while (0)
#define ATT_WAIT_DMA_IT() do { if (KIND == 2) { ATT_WAIT_DMA(); } else if (convon) { if (CFL == 0) asm volatile("s_waitcnt vmcnt(10)" ::: "memory"); else if (CFL == 1) asm volatile("s_waitcnt vmcnt(8)" ::: "memory"); else if (CFL == 2) asm volatile("s_waitcnt vmcnt(6)" ::: "memory"); else asm volatile("s_waitcnt vmcnt(4)" ::: "memory"); } \
        else asm volatile("s_waitcnt vmcnt(2)" ::: "memory"); } while (0)
        __syncthreads();
        if (KIND == 0) { const float* rp = C.in[10] + ((size_t)slot * 16 + h) * 465; for (int i = C.tid; i < 465; i += 512) Bsm[i] = rp[i] * 1.4426950408889634f; }
        float m = -INFINITY, l = 0.f;
        if (KIND == 1) { m = C.in[13][h] * 1.4426950408889634f; l = hi ? 0.f : 1.f; }
        ATT_DMA(0, 0); ATT_DMA(1, 1); ATT_DMA(2, 2);
        f32x16 ot[2];
#pragma unroll
        for (int r = 0; r < 16; ++r) { ot[0][r] = 0.f; ot[1][r] = 0.f; }
        const int qr_ = t >> 6, qc_ = t & 63;
        int cs0 = qc_ - 8; cs0 = cs0 < 0 ? 0 : (cs0 > 48 ? 48 : cs0);
        const int wrow = (q0 >> 6) + 2 * (w >> 2);
        int wrs = wrow - 4; wrs = wrs < 0 ? 0 : (wrs > 248 ? 248 : wrs);
        int wre = wrow + 1 - 4; wre = (wre < 0 ? 0 : (wre > 248 ? 248 : wre)) + 8;
        int rs = qr_ - 4; rs = rs < 0 ? 0 : (rs > 248 ? 248 : rs);
        const int kc0 = (w & 3) == 0 ? 0 : ((w & 3) == 1 ? 8 : ((w & 3) == 2 ? 24 : 32));
        const int wq0 = q0 + 32 * w;
        if constexpr (KIND == 2) {
            { float qs = 0.f;
#pragma unroll
              for (int sidx = 0; sidx < NS; ++sidx) { u32x4 qw;
#pragma unroll
                  for (int j = 0; j < 4; ++j) { const float q0_ = bf2f((unsigned)(unsigned short)qf[sidx][2 * j]) * c2, q1_ = bf2f((unsigned)(unsigned short)qf[sidx][2 * j + 1]) * c2;
                      const unsigned pw = cvt_pk_bf16(q0_, q1_); qw[j] = pw; const float r0_ = bf2f(pw & 0xffffu), r1_ = bf2f(pw >> 16); qs += r0_ * r0_ + r1_ * r1_; }
                  qf[sidx] = __builtin_bit_cast(bf16x8, qw); }
              const auto sw = __builtin_amdgcn_permlane32_swap(__float_as_uint(qs), __float_as_uint(qs), false, false);
              qs = __uint_as_float(sw[0]) + __uint_as_float(sw[1]);
              const float k2 = __uint_as_float(__hip_atomic_load((unsigned*)(C.ws + WS_CTL) + CW_KMAX + h, __ATOMIC_RELAXED, __HIP_MEMORY_SCOPE_AGENT));
              m = sqrtf(qs * k2) * 1.001f + 0.01f; }
            if (NDMA == 4) asm volatile("s_waitcnt vmcnt(4)" ::: "memory"); else asm volatile("s_waitcnt vmcnt(3)" ::: "memory");
            ATT_BAR();
            f32x16 pa0, pa1, pb0, pb1;
#define MLA_QK(D0, D1, sl) do { const LAS unsigned char* kb_ = lds + (sl) * SLOTB; \
            _Pragma("unroll") for (int r_ = 0; r_ < 16; ++r_) { D0[r_] = -m; D1[r_] = -m; } \
            _Pragma("unroll") for (int sidx = 0; sidx < NS; ++sidx) { \
                const bf16x8 a0_ = *(const LAS bf16x8*)(kb_ + ql * KS + 32 * sidx + 16 * hi); \
                const bf16x8 a1_ = *(const LAS bf16x8*)(kb_ + (32 + ql) * KS + 32 * sidx + 16 * hi); \
                { D0 = __builtin_amdgcn_mfma_f32_32x32x16_bf16(a0_, qf[sidx], D0, 0, 0, 0); \
                       D1 = __builtin_amdgcn_mfma_f32_32x32x16_bf16(a1_, qf[sidx], D1, 0, 0, 0); } } } while (0)
#define VB(x) (((VARIANT) >> (x)) & 1)
#define MLA_KHALF(D0, D1, sl, h0) do { const LAS unsigned char* kq_ = lds + (sl) * SLOTB; \
            _Pragma("unroll") for (int sidx = 0; sidx < NS / 2; ++sidx) { \
                D0[sidx] = *(const LAS bf16x8*)(kq_ + ql * KS + 32 * ((h0) + sidx) + 16 * hi); D1[sidx] = *(const LAS bf16x8*)(kq_ + (32 + ql) * KS + 32 * ((h0) + sidx) + 16 * hi); } } while (0)
#define MLA_ITER(CV, P0, P1, S0, S1, it) do { \
            if (CV && ((it) & 7) == 0) conv_step<false>(C, cst, cscr);            \
            if (!VB(3)) ATT_DMA((it) + 3, ((it) + 3) & 3);                        \
            bf16x8 kb0_[NS / 2], kb1_[NS / 2]; s16x4 vlo_[2][4], vhi_[2][4]; u32x4 pfw_[4]; \
              \
            _Pragma("unroll") for (int r_ = 0; r_ < 16; ++r_) { S0[r_] = -m; S1[r_] = -m; } \
            asm volatile("s_waitcnt lgkmcnt(0)" ::: "memory"); __builtin_amdgcn_sched_barrier(0); \
            _Pragma("unroll") for (int g_ = 0; g_ < 20; ++g_) { \
                if (g_ == 6) { asm volatile("s_waitcnt lgkmcnt(0)" ::: "memory"); __builtin_amdgcn_sched_barrier(0); } \
                if (g_ == 12) { if (!VB(4)) { asm volatile("s_waitcnt vmcnt(3)" ::: "memory"); ATT_BAR(); }         \
                                else { asm volatile("s_waitcnt lgkmcnt(0)" ::: "memory"); __builtin_amdgcn_sched_barrier(0); } } \
                if (g_ == 2) MLA_KHALF(kb0_, kb1_, ((it) + 1) & 3, NS / 2); \
                if (g_ == 16) MLA_KHALF(ka0, ka1, ((it) + 2) & 3, 0); \
                if (g_ < 6) { if (g_ & 1) S1 = __builtin_amdgcn_mfma_f32_32x32x16_bf16(ka1[g_ >> 1], qf[g_ >> 1], S1, 0, 0, 0); else S0 = __builtin_amdgcn_mfma_f32_32x32x16_bf16(ka0[g_ >> 1], qf[g_ >> 1], S0, 0, 0, 0); } \
                else if (g_ < 12) { if (g_ & 1) S1 = __builtin_amdgcn_mfma_f32_32x32x16_bf16(kb1_[(g_ >> 1) - NS / 2], qf[g_ >> 1], S1, 0, 0, 0); else S0 = __builtin_amdgcn_mfma_f32_32x32x16_bf16(kb0_[(g_ >> 1) - NS / 2], qf[g_ >> 1], S0, 0, 0, 0); } \
                else { const int ks_ = (g_ - 12) >> 1, c_ = (g_ - 12) & 1; \
                    const bf16x8 av_ = (bf16x8){vlo_[c_][ks_][0], vlo_[c_][ks_][1], vlo_[c_][ks_][2], vlo_[c_][ks_][3], vhi_[c_][ks_][0], vhi_[c_][ks_][1], vhi_[c_][ks_][2], vhi_[c_][ks_][3]}; \
                    ot[c_] = __builtin_amdgcn_mfma_f32_32x32x16_bf16(av_, __builtin_bit_cast(bf16x8, pfw_[ks_]), ot[c_], 0, 0, 0); } \
                if (g_ < 16) { \
                    _Pragma("unroll") for (int k_ = 2 * g_; k_ < 2 * g_ + 2; ++k_) { \
                        if (k_ < 16) { P0[k_] = __builtin_amdgcn_exp2f(P0[k_]); l += P0[k_]; } \
                        else { P1[k_ - 16] = __builtin_amdgcn_exp2f(P1[k_ - 16]); l += P1[k_ - 16]; } } \
                } \
                  \
                _Pragma("unroll") for (int q_ = 0; q_ < 2; ++q_) { \
                    const int f_ = g_ < 16 ? (g_ >> 2) - 1 : 3, j_ = g_ < 16 ? (g_ & 3) : 2 * (g_ - 16) + q_; \
                    if (g_ >= 4 && g_ < 18 && (g_ >= 16 || q_ == 0)) { \
                        if (f_ < 2) pfw_[f_][j_] = cvt_pk_bf16(P0[8 * f_ + 2 * j_], P0[8 * f_ + 2 * j_ + 1]); \
                        else pfw_[f_][j_] = cvt_pk_bf16(P1[8 * (f_ - 2) + 2 * j_], P1[8 * (f_ - 2) + 2 * j_ + 1]); } } \
                if (g_ == 7) { const unsigned vb_ = lds_u32 + (unsigned)(((it) & 3) * SLOTB + KBYTES); \
                  _Pragma("unroll") for (int c = 0; c < 2; ++c) { const unsigned va_ = vb_ + (unsigned)(c ? vlane1 : vlane0); \
                    _Pragma("unroll") for (int ks = 0; ks < 4; ++ks) { \
                        asm volatile("ds_read_b64_tr_b16 %0, %1 offset:%c2" : "=&v"(vlo_[c][ks]) : "v"(va_), "i"((32 * (ks >> 1) + 16 * (ks & 1)) * VS) : "memory"); \
                        asm volatile("ds_read_b64_tr_b16 %0, %1 offset:%c2" : "=&v"(vhi_[c][ks]) : "v"(va_), "i"((32 * (ks >> 1) + 16 * (ks & 1) + 8) * VS) : "memory"); } } } \
                __builtin_amdgcn_sched_barrier(0); } \
            } while (0)
            MLA_QK(pa0, pa1, 0);
            bf16x8 ka0[NS / 2], ka1[NS / 2];
            MLA_KHALF(ka0, ka1, 1, 0);
            for (int i = 0; i < ntiles; i += 2) {
                MLA_ITER(1, pa0, pa1, pb0, pb1, i);
                MLA_ITER(0, pb0, pb1, pa0, pa1, i + 1);
            }
#undef MLA_KHALF
#undef MLA_QK
#undef MLA_ITER
#undef VB
        } else {
        ATT_WAIT_DMA();
        ATT_BAR();
        int rs_cur = 0, rs_nxt = 3;
        for (int i = 0; i < ntiles; ++i) {
            if (convon) conv_pipe_step<CFL>(C, cpipe, lds);
            ATT_DMA(i + PD, rs_nxt);
            const bool lat = i < nlat; const int key0 = ATT_KEY0(i);
            bool need = true;
            if (lat) { if (KIND == 0) { const int kr = lat0 + i; need = kr >= wrs && kr < wre; }
                       else if (KIND == 1) need = (key0 + 63 >= wq0 - 128) && (key0 <= wq0 + 31 + 128); }
            if (KIND == 0 && lat) {
              if (need) {
                const int kr = lat0 + i;
                const LAS unsigned char* kb = lds + rs_cur * SLOTB + kc0 * KS; const int swz = ((kc0 + ql) >> 1) & 7;
                f32x16 p0;
#pragma unroll
                for (int r = 0; r < 16; ++r) p0[r] = 0.f;
#pragma unroll
                for (int sidx = 0; sidx < NS; ++sidx) {
                    const bf16x8 a0 = *(const LAS bf16x8*)(kb + ql * KS + 16 * ((2 * sidx + hi) ^ swz));
                    p0 = __builtin_amdgcn_mfma_f32_32x32x16_bf16(a0, qf[sidx], p0, 0, 0, 0);
                }
                const bool rowok = kr >= rs && kr < rs + 8;
                float mx = -INFINITY;
#pragma unroll
                for (int r = 0; r < 16; ++r) { const int kc = kc0 + crow(r, hi); const bool v0 = rowok && (unsigned)(kc - cs0) < 16u;
                    const int bi = (kr - qr_ + 7) * 31 + (kc - qc_ + 15);
                    const float s0 = v0 ? p0[r] * c2 + Bsm[v0 ? bi : 0] : -INFINITY; p0[r] = s0; mx = fmaxf(mx, s0); }
                { const auto sw = __builtin_amdgcn_permlane32_swap(__float_as_uint(mx), __float_as_uint(mx), false, false);
                  mx = fmaxf(__uint_as_float(sw[0]), __uint_as_float(sw[1])); }
                const float mn = fmaxf(m, mx), ms = mn == -INFINITY ? 0.f : mn;
                const float alpha = __builtin_amdgcn_exp2f(m - ms);
                if (__builtin_amdgcn_ballot_w64(alpha != 1.f) != 0ull) {
#pragma unroll
                    for (int r = 0; r < 16; ++r) { ot[0][r] *= alpha; ot[1][r] *= alpha; }
                }
                s16x4 vlo[2][2], vhi[2][2];
                { const unsigned vb0 = lds_u32 + (unsigned)(rs_cur * SLOTB + KBYTES + kc0 * VS);
#pragma unroll
                  for (int c = 0; c < 2; ++c) { const unsigned va = vb0 + (unsigned)(c ? vlane1 : vlane0);
#pragma unroll
                    for (int ks = 0; ks < 2; ++ks) {
                        asm volatile("ds_read_b64_tr_b16 %0, %1 offset:%c2" : "=&v"(vlo[c][ks]) : "v"(va), "i"((16 * ks) * VS) : "memory");
                        asm volatile("ds_read_b64_tr_b16 %0, %1 offset:%c2" : "=&v"(vhi[c][ks]) : "v"(va), "i"((16 * ks + 8) * VS) : "memory"); } } }
                __builtin_amdgcn_sched_barrier(0);
                float rs0 = 0.f, rs1 = 0.f;
#pragma unroll
                for (int ks = 0; ks < 2; ++ks) {
#pragma unroll
                    for (int j = 0; j < 8; ++j) { const int r = 8 * ks + j; p0[r] = __builtin_amdgcn_exp2f(p0[r] - ms); if (j & 1) rs1 += p0[r]; else rs0 += p0[r]; }
                    u32x4 pw; const int k8 = 8 * ks;
                    pw.x = cvt_pk_bf16(p0[k8 + 0], p0[k8 + 1]); pw.y = cvt_pk_bf16(p0[k8 + 2], p0[k8 + 3]); pw.z = cvt_pk_bf16(p0[k8 + 4], p0[k8 + 5]); pw.w = cvt_pk_bf16(p0[k8 + 6], p0[k8 + 7]);
                    const bf16x8 pfk = __builtin_bit_cast(bf16x8, pw);
                    if (ks == 0) { asm volatile("s_waitcnt lgkmcnt(0)" ::: "memory"); }
                    __builtin_amdgcn_sched_barrier(0);
                    const bf16x8 av0 = (bf16x8){vlo[0][ks][0], vlo[0][ks][1], vlo[0][ks][2], vlo[0][ks][3], vhi[0][ks][0], vhi[0][ks][1], vhi[0][ks][2], vhi[0][ks][3]};
                    const bf16x8 av1 = (bf16x8){vlo[1][ks][0], vlo[1][ks][1], vlo[1][ks][2], vlo[1][ks][3], vhi[1][ks][0], vhi[1][ks][1], vhi[1][ks][2], vhi[1][ks][3]};
                    ot[0] = __builtin_amdgcn_mfma_f32_32x32x16_bf16(av0, pfk, ot[0], 0, 0, 0);
                    ot[1] = __builtin_amdgcn_mfma_f32_32x32x16_bf16(av1, pfk, ot[1], 0, 0, 0);
                    __builtin_amdgcn_sched_barrier(0);
                }
                l = l * alpha + (rs0 + rs1); m = mn;
              }
            } else if (need) {
                const LAS unsigned char* kb = lds + rs_cur * SLOTB; const LAS unsigned char* vb = kb + KBYTES;
                f32x16 p0, p1;
#pragma unroll
                for (int r = 0; r < 16; ++r) { p0[r] = 0.f; p1[r] = 0.f; }
#pragma unroll
                for (int sidx = 0; sidx < NS; ++sidx) {
                    const int swz = (ql >> 1) & 7;
                    const bf16x8 a0 = *(const LAS bf16x8*)(kb + ql * KS + 16 * ((2 * sidx + hi) ^ swz));
                    const bf16x8 a1 = *(const LAS bf16x8*)(kb + (32 + ql) * KS + 16 * ((2 * sidx + hi) ^ swz));
                    p0 = __builtin_amdgcn_mfma_f32_32x32x16_bf16(a0, qf[sidx], p0, 0, 0, 0);
                    p1 = __builtin_amdgcn_mfma_f32_32x32x16_bf16(a1, qf[sidx], p1, 0, 0, 0);
                }
                float mx = -INFINITY;
                if (KIND == 0) {
#pragma unroll
                    for (int r = 0; r < 16; ++r) {
                        float s0 = p0[r] * c2, s1 = p1[r] * c2;
                        if (lat) { const int kr = lat0 + i; const int kc = crow(r, hi);
                            const bool v0 = (unsigned)(kc - cs0) < 16u, v1 = (unsigned)(kc + 32 - cs0) < 16u;
                            const int bi = (kr - qr_ + 7) * 31 + (kc - qc_ + 15);
                            s0 = v0 ? s0 + Bsm[v0 ? bi : 0] : -INFINITY; s1 = v1 ? s1 + Bsm[v1 ? bi + 32 : 0] : -INFINITY; }
                        p0[r] = s0; p1[r] = s1; mx = fmaxf(fmaxf(mx, s0), s1);
                    }
                } else {
                    if (KIND == 1 && lat) {
#pragma unroll
                        for (int r = 0; r < 16; ++r) { const int dd = key0 + crow(r, hi) - t;
                            p0[r] = (unsigned)(dd + 128) <= 256u ? p0[r] : -INFINITY; p1[r] = (unsigned)(dd + 32 + 128) <= 256u ? p1[r] : -INFINITY; }
                    }
#pragma unroll
                    for (int r = 0; r < 16; ++r) mx = fmaxf(fmaxf(mx, p0[r]), p1[r]);
                    mx *= c2;
                }
                { const auto sw = __builtin_amdgcn_permlane32_swap(__float_as_uint(mx), __float_as_uint(mx), false, false);
                  mx = fmaxf(__uint_as_float(sw[0]), __uint_as_float(sw[1])); }
                const float mn = fmaxf(m, mx), ms = mn == -INFINITY ? 0.f : mn;
                const float alpha = __builtin_amdgcn_exp2f(m - ms);
                if (__builtin_amdgcn_ballot_w64(alpha != 1.f) != 0ull) {
#pragma unroll
                    for (int r = 0; r < 16; ++r) { ot[0][r] *= alpha; ot[1][r] *= alpha; }
                }
                s16x4 vlo[2][4], vhi[2][4];
                { const unsigned vb0 = lds_u32 + (unsigned)(rs_cur * SLOTB + KBYTES);
#pragma unroll
                  for (int c = 0; c < 2; ++c) { const unsigned va = vb0 + (unsigned)(c ? vlane1 : vlane0);
#pragma unroll
                    for (int ks = 0; ks < 4; ++ks) {
                        asm volatile("ds_read_b64_tr_b16 %0, %1 offset:%c2" : "=&v"(vlo[c][ks]) : "v"(va), "i"((32 * (ks >> 1) + 16 * (ks & 1)) * VS) : "memory");
                        asm volatile("ds_read_b64_tr_b16 %0, %1 offset:%c2" : "=&v"(vhi[c][ks]) : "v"(va), "i"((32 * (ks >> 1) + 16 * (ks & 1) + 8) * VS) : "memory"); } } }
                __builtin_amdgcn_sched_barrier(0);
                float rs0 = 0.f, rs1 = 0.f;
#pragma unroll
                for (int ks = 0; ks < 4; ++ks) {
#pragma unroll
                    for (int j = 0; j < 8; ++j) { const int r = 8 * (ks & 1) + j;
                        if (ks < 2) { p0[r] = KIND == 0 ? __builtin_amdgcn_exp2f(p0[r] - ms) : __builtin_amdgcn_exp2f(__builtin_fmaf(p0[r], c2, -ms)); if (j & 1) rs1 += p0[r]; else rs0 += p0[r]; }
                        else { p1[r] = KIND == 0 ? __builtin_amdgcn_exp2f(p1[r] - ms) : __builtin_amdgcn_exp2f(__builtin_fmaf(p1[r], c2, -ms)); if (j & 1) rs1 += p1[r]; else rs0 += p1[r]; } }
                    u32x4 pw; const int k8 = 8 * (ks & 1);
                    if (ks < 2) { pw.x = cvt_pk_bf16(p0[k8 + 0], p0[k8 + 1]); pw.y = cvt_pk_bf16(p0[k8 + 2], p0[k8 + 3]); pw.z = cvt_pk_bf16(p0[k8 + 4], p0[k8 + 5]); pw.w = cvt_pk_bf16(p0[k8 + 6], p0[k8 + 7]); }
                    else { pw.x = cvt_pk_bf16(p1[k8 + 0], p1[k8 + 1]); pw.y = cvt_pk_bf16(p1[k8 + 2], p1[k8 + 3]); pw.z = cvt_pk_bf16(p1[k8 + 4], p1[k8 + 5]); pw.w = cvt_pk_bf16(p1[k8 + 6], p1[k8 + 7]); }
                    const bf16x8 pfk = __builtin_bit_cast(bf16x8, pw);
                    if (ks == 0) { asm volatile("s_waitcnt lgkmcnt(0)" ::: "memory"); }
                    __builtin_amdgcn_sched_barrier(0);
                    const bf16x8 av0 = (bf16x8){vlo[0][ks][0], vlo[0][ks][1], vlo[0][ks][2], vlo[0][ks][3], vhi[0][ks][0], vhi[0][ks][1], vhi[0][ks][2], vhi[0][ks][3]};
                    const bf16x8 av1 = (bf16x8){vlo[1][ks][0], vlo[1][ks][1], vlo[1][ks][2], vlo[1][ks][3], vhi[1][ks][0], vhi[1][ks][1], vhi[1][ks][2], vhi[1][ks][3]};
                    ot[0] = __builtin_amdgcn_mfma_f32_32x32x16_bf16(av0, pfk, ot[0], 0, 0, 0);
                    ot[1] = __builtin_amdgcn_mfma_f32_32x32x16_bf16(av1, pfk, ot[1], 0, 0, 0);
                    __builtin_amdgcn_sched_barrier(0);
                }
                l = l * alpha + (rs0 + rs1); m = mn;
            }
            ATT_WAIT_DMA_IT();
            ATT_BAR();
            rs_cur = (rs_cur + 1) & 3; rs_nxt = (rs_nxt + 1) & 3;
        }
        }
        asm volatile("s_waitcnt vmcnt(0)" ::: "memory");
#undef ATT_KEY0
#undef ATT_DMA
#undef ATT_WAIT_DMA
#undef ATT_WAIT_DMA_IT
        { const auto sw = __builtin_amdgcn_permlane32_swap(__float_as_uint(l), __float_as_uint(l), false, false);
          const float il = 1.f / (__uint_as_float(sw[0]) + __uint_as_float(sw[1])); bf16* orow = Ob + (size_t)t * D + h * 64 + 4 * hi;
#pragma unroll
          for (int c = 0; c < 2; ++c)
#pragma unroll
            for (int g = 0; g < 4; ++g) { u32x2 o2; o2.x = cvt_pk_bf16(ot[c][4 * g] * il, ot[c][4 * g + 1] * il); o2.y = cvt_pk_bf16(ot[c][4 * g + 2] * il, ot[c][4 * g + 3] * il);
                *(u32x2*)(orow + 32 * c + 8 * g) = o2; } }
    }
    if (KIND == 2) { while (cst.loaded || cst.cur < cst.total) conv_step<true>(C, cst, cscr); }
    else if (convon && !VARIANT) conv_pipe_drain(C, cpipe, lds);
    __syncthreads();
}
template <int KIND>
__device__ __forceinline__ void ph_attn(const Ctx& C, int slot, bool with_ctxq, int conv_layer = -1) {
#if USE_FAST_ATTN
    ph_attn_fast<KIND>(C, slot, with_ctxq, conv_layer);
#else
    ph_attn_naive<KIND>(C, slot);
#endif
}

#define PH_BEGIN if (lo <= ph && ph < hi) {
#define PH_END   if (ph + 1 < hi) xcd_barrier(bar); if (DIAG && C.blk == 0 && C.tid == 0) ((unsigned long long*)(C.ws + WS_CTL + 512 * 1024))[ph + 1] = __builtin_amdgcn_s_memrealtime(); } ++ph;
#ifndef DIAG
#define DIAG 0
#define DIAG_PH1 25
#define DIAG_PH2 25
#endif
#ifndef NORM2_VARIANT_PROBE
#define NORM2_VARIANT_PROBE 0
#endif
#ifndef SWA_VARIANT_PROBE
#define SWA_VARIANT_PROBE 0
#endif
#ifndef ATTN_VARIANT_PROBE
#define ATTN_VARIANT_PROBE 0
#endif
#ifndef PROBE_MASK
#define PROBE_MASK 0
#endif
#define PHG(g, ...) PH_BEGIN __VA_ARGS__ PH_END if constexpr (((PROBE_MASK >> (g)) & 1) != 0) { PH_BEGIN __VA_ARGS__ PH_END }
template <int L>
__device__ __forceinline__ void layer_phases(const Ctx& C, const XcdBarrier& bar, int lo, int hi, int& ph) {
    constexpr int l = L, kind = L % 3, slot = L / 3; constexpr bool need_ctx = L < 3; constexpr int RL = need_ctx ? R : SEQ;
    PH_BEGIN ph_rowA<0>(C, l); PH_END
    if constexpr (kind == 0) {
        PHG(1, gemm_tok(C, WSP(bf16, WS_H), WSP(bf16, WS_W_NAQKV) + (size_t)slot * 3072 * 1024, 3072, 1024, true, EpiStoreHeads{WSP(bf16, WS_QKV), 64, (size_t)R * 64});)
        PHG(2, ph_attn<0>(C, slot, need_ctx, l == 0 ? 0 : -1);)
    } else if constexpr (kind == 1) {
        PHG(1, gemm_tok(C, WSP(bf16, WS_H), WSP(bf16, WS_W_SWAQKV), 1536, 1024, true, EpiStoreHeads{WSP(bf16, WS_QKV), 64, (size_t)R * 64});)
        PH_BEGIN ph_rope(C, WSP(bf16, WS_QKV), 64, 20, 0, 16); PH_END
        PHG(3, ph_attn<1>(C, slot, need_ctx, l);)
#if SWA_VARIANT_PROBE
        PH_BEGIN ph_attn_fast<1, SWA_VARIANT_PROBE>(C, slot, need_ctx, (SWA_VARIANT_PROBE & 64) ? l : -1); PH_END
#endif
    } else {
        PHG(1, gemm_tok(C, WSP(bf16, WS_H), WSP(bf16, WS_W_MLAD), 1024, 1024, true, EpiStoreF32{WSP(float, WS_CQ), 1024});)
        PHG(11, ph_mlanorm(C);)
        PHG(1, gemm_tok(C, WSP(bf16, WS_CQN), WSP(bf16, WS_W_MLAUQ), 1536, 512, true, EpiStoreHeads{WSP(bf16, WS_Q), 96, (size_t)R * 96});
                 gemm_tok(C, WSP(bf16, WS_CKVN), WSP(bf16, WS_W_MLAUKV), 2048, 256, true, EpiStoreHeads{WSP(bf16, WS_KV), 128, (size_t)R * 128});)
        PH_BEGIN ph_rope(C, WSP(bf16, WS_Q), 96, 16, 64, 8); ph_kmax(C); PH_END
        PHG(4, ph_attn<2>(C, slot, need_ctx, 2);)
#if ATTN_VARIANT_PROBE
        PH_BEGIN ph_attn_fast<2, ATTN_VARIANT_PROBE>(C, slot, need_ctx, (ATTN_VARIANT_PROBE & 64) ? 2 : -1); PH_END
#endif
    }
    const bf16* wo = kind == 0 ? WSP(bf16, WS_W_NAO) + (size_t)slot * 1024 * 1024 : (kind == 1 ? WSP(bf16, WS_W_SWAO) : WSP(bf16, WS_W_MLAO));
    PH_BEGIN gemm_tok(C, WSP(bf16, WS_O), wo, 1024, 1024, need_ctx, EpiResid{WSP(float, WS_X), modp(C, l, 0, 2), modp(C, l, 1, 2)}); PH_END
    PHG(5, ph_norm2(C, l, RL);)
#if NORM2_VARIANT_PROBE
    PH_BEGIN ph_norm2<NORM2_VARIANT_PROBE>(C, l, RL); PH_END
#endif
    PHG(6, ph_topk(C, need_ctx);)
    PHG(8, gemm_moe(C, WSP(bf16, WS_H), WSP(bf16, WS_W_GU) + (size_t)l * 16 * 4096 * 1024, 4096, 1024, (size_t)4096 * 1024, need_ctx, EpiSwiglu{WSP(bf16, WS_ACT)}, WSP(int, WS_ROWL));)
    PHG(9, gemm_moe(C, WSP(bf16, WS_ACT), WSP(bf16, WS_W_DN) + (size_t)l * 16 * 1024 * 2048, 1024, 2048, (size_t)1024 * 2048, need_ctx, EpiMoeOut{WSP(bf16, WS_YB), WSP(float, WS_GATEL)});)
}
__global__ void __launch_bounds__(512, 2) fwd_kernel(Args args) {
    extern __shared__ __attribute__((aligned(16))) unsigned char lds_raw[];
    Ctx C;
#pragma unroll
    for (int i = 0; i < 26; ++i) C.in[i] = args.in[i];
    C.out = args.out; C.ws = args.ws; C.lds = (LAS unsigned char*)lds_raw;
    C.tid = threadIdx.x; C.lane = C.tid & 63; C.wave = __builtin_amdgcn_readfirstlane(C.tid >> 6); C.blk = blockIdx.x; C.G = gridDim.x;
    volatile LAS unsigned* MISC = (volatile LAS unsigned*)(C.lds + MISC_OFF);
    if (C.tid < 32) MISC[C.tid] = 0u;
    __syncthreads();
    const int lo = args.ph_lo, hi = args.ph_hi;
    XcdBarrier bar; bar.bar = (unsigned*)(C.ws + WS_CTL) + CW_BAR; bar.x = 0; bar.st = nullptr;
    if (hi - lo > 1) bar = xcd_barrier_post((unsigned*)(C.ws + WS_CTL) + CW_BAR, MISC + 8);
    int ph = 0;
    PHG(0, ph_prologue(C);)
    layer_phases<0>(C, bar, lo, hi, ph);
    layer_phases<1>(C, bar, lo, hi, ph);
    layer_phases<2>(C, bar, lo, hi, ph);
    layer_phases<3>(C, bar, lo, hi, ph);
    PH_BEGIN ph_rowA<1>(C, 4); PH_END
#if DIAG
    {
        __builtin_amdgcn_fence(__ATOMIC_ACQUIRE, "agent");
        const unsigned long long* st = (const unsigned long long*)(C.ws + WS_CTL + 512 * 1024);
        const float t1 = (float)(__hip_atomic_load(st + DIAG_PH1 + 1, __ATOMIC_RELAXED, __HIP_MEMORY_SCOPE_AGENT) - __hip_atomic_load(st + DIAG_PH1, __ATOMIC_RELAXED, __HIP_MEMORY_SCOPE_AGENT)) * 0.01f;
        const float t2 = (float)(__hip_atomic_load(st + DIAG_PH2 + 1, __ATOMIC_RELAXED, __HIP_MEMORY_SCOPE_AGENT) - __hip_atomic_load(st + DIAG_PH2, __ATOMIC_RELAXED, __HIP_MEMORY_SCOPE_AGENT)) * 0.01f;
        (void)t2;
        const float tq = exp2f(rintf(log2f(t1) * 16.f) * (1.f / 16.f));
        const float cval = 0.1f * sqrtf(tq);
        for (size_t i = (size_t)C.blk * 512 + C.tid; i < (size_t)SEQ * D; i += (size_t)C.G * 512) C.out[i] = cval;
    }
#endif
}
#undef PH_BEGIN
#undef PH_END

extern "C" void kernel_launch(void* const* d_in, const int* in_sizes, int n_in, void* d_out, int out_size, void* d_ws, size_t ws_size, hipStream_t stream) {
    static int grid = 0;
    if (grid == 0) {
        if (n_in != 26 || out_size != SEQ * D || ws_size < WS_END) { fprintf(stderr, "kernel_launch: unexpected shapes (n_in %d out %d ws %zu)\n", n_in, out_size, ws_size); grid = -1; return; }
        int dev = 0, cus = 0, per_cu = 0;
        if (hipGetDevice(&dev) != hipSuccess || hipDeviceGetAttribute(&cus, hipDeviceAttributeMultiprocessorCount, dev) != hipSuccess) { grid = -1; return; }
        if (hipFuncSetAttribute((const void*)fwd_kernel, hipFuncAttributeMaxDynamicSharedMemorySize, LDS_BYTES) != hipSuccess) { fprintf(stderr, "kernel_launch: hipFuncSetAttribute failed\n"); grid = -1; return; }
        if (hipOccupancyMaxActiveBlocksPerMultiprocessor(&per_cu, (const void*)fwd_kernel, 512, LDS_BYTES) != hipSuccess || per_cu < 1) fprintf(stderr, "kernel_launch: occupancy query says %d\n", per_cu);
        (void)hipGetLastError();
        grid = cus;
    }
    if (grid < 0) return;
    if (hipMemsetAsync((char*)d_ws + WS_CTL, 0, CTL_ZERO_BYTES, stream) != hipSuccess) return;
    Args a{};
    for (int i = 0; i < 26; ++i) a.in[i] = (const float*)d_in[i];
    a.out = (float*)d_out; a.ws = (unsigned char*)d_ws; a.pad = 0;
#if MK_N_LAUNCHES == 1
    a.ph_lo = 0; a.ph_hi = 1 << 20; a.li = 0;
    hipLaunchKernelGGL(fwd_kernel, dim3(grid), dim3(512), LDS_BYTES, stream, a);
#else
    for (int li = 0; li < NPH; ++li) { a.ph_lo = li; a.ph_hi = li + 1; a.li = li;
        hipLaunchKernelGGL(fwd_kernel, dim3(grid), dim3(512), LDS_BYTES, stream, a); }
#endif
}
```

```cpp
#include <hip/hip_runtime.h>
#include <cstdio>
#include <cstdint>

#ifndef MK_N_LAUNCHES
#define MK_N_LAUNCHES 1
#endif

#define GAS __attribute__((address_space(1)))
#define LAS __attribute__((address_space(3)))
typedef unsigned short bf16;
typedef float f32x4 __attribute__((ext_vector_type(4)));
typedef unsigned u32x4 __attribute__((ext_vector_type(4)));
typedef unsigned u32x2 __attribute__((ext_vector_type(2)));
typedef short bf16x8 __attribute__((ext_vector_type(8)));
typedef short s16x4 __attribute__((ext_vector_type(4)));
typedef float f32x16 __attribute__((ext_vector_type(16)));

constexpr int D = 1024, SEQ = 16384, NCTX = 256, R = SEQ + NCTX, NE = 16, FF = 2048;
constexpr int CAP_L = 2048, CAP_C = 32, EROWS = 2304, XROWS = NE * EROWS;
constexpr float RMS_EPS = 1e-6f;
constexpr int NPH = 1 + 9 + 10 + 12 + 9 + 1;

constexpr size_t MiB = 1u << 20;
constexpr size_t WS_CTL = 0, CTL_ZERO_BYTES = 1 * MiB;
constexpr size_t WS_MOD = 1 * MiB;
constexpr size_t WS_W_NAQKV = 2 * MiB;
constexpr size_t WS_W_NAO = 14 * MiB;
constexpr size_t WS_W_SWAQKV = 18 * MiB;
constexpr size_t WS_W_SWAO = 21 * MiB;
constexpr size_t WS_W_MLAD = 23 * MiB;
constexpr size_t WS_W_MLAUQ = 25 * MiB;
constexpr size_t WS_W_MLAUKV = 27 * MiB;
constexpr size_t WS_W_MLAO = 28 * MiB;
constexpr size_t WS_W_GU = 32 * MiB;
constexpr size_t WS_W_DN = WS_W_GU + 512 * MiB;
constexpr size_t WS_X = WS_W_DN + 256 * MiB;
constexpr size_t WS_H = WS_X + 65 * MiB;
constexpr size_t WS_QKV = WS_H + 33 * MiB;
constexpr size_t WS_CQ = WS_QKV + 98 * MiB;
constexpr size_t WS_Q = WS_CQ + 65 * MiB;
constexpr size_t WS_KV = WS_Q + 49 * MiB;
constexpr size_t WS_CQN = WS_KV + 65 * MiB;
constexpr size_t WS_CKVN = WS_CQN + 17 * MiB;
constexpr size_t WS_KROPE = WS_CKVN + 9 * MiB;
constexpr size_t WS_O = WS_KROPE + 2 * MiB;
constexpr size_t WS_AFF = WS_O + 33 * MiB;
constexpr size_t WS_ROWL = WS_AFF + 2 * MiB;
constexpr size_t WS_GATEL = WS_ROWL + 1 * MiB;
constexpr size_t WS_INV = WS_GATEL + 1 * MiB;
constexpr size_t WS_XG = WS_INV + 2 * MiB;
constexpr size_t WS_ACT = WS_XG + 72 * MiB;
constexpr size_t WS_YB = WS_ACT + 144 * MiB;
constexpr size_t WS_END = WS_YB + 72 * MiB;
static_assert(WS_END <= 2048 * MiB, "d_ws map");
constexpr int CW_BAR = 4096;

constexpr int LDS_BYTES = 147456;
constexpr int MISC_OFF = 131072 + 320;

__device__ __forceinline__ float bf2f(unsigned b) { return __uint_as_float(b << 16); }
__device__ __forceinline__ unsigned f2bf(float f) { unsigned u = __float_as_uint(f); return (u + 0x7fffu + ((u >> 16) & 1u)) >> 16; }
typedef float f32x2_t __attribute__((ext_vector_type(2))); typedef __bf16 bf16x2_t __attribute__((ext_vector_type(2)));
__device__ __forceinline__ unsigned cvt_pk_bf16(float lo, float hi) { f32x2_t v = {lo, hi}; bf16x2_t b = __builtin_convertvector(v, bf16x2_t); return __builtin_bit_cast(unsigned, b); }
__device__ __forceinline__ unsigned pk2(float lo, float hi) { return cvt_pk_bf16(lo, hi); }
__device__ __forceinline__ float wave_sum(float v) {
#pragma unroll
    for (int o = 1; o < 64; o <<= 1) v += __shfl_xor(v, o);
    return v;
}
__device__ __forceinline__ int wave_sum_i(int v) {
#pragma unroll
    for (int o = 1; o < 64; o <<= 1) v += __shfl_xor(v, o);
    return v;
}

#define XB_TMO      128
#define XB_XCNT(j)  (256  + 64 * (j))
#define XB_XSUB(j)  (1280 + 64 * (j))
#define XB_XGEN(j)  (2304 + 64 * (j))
#define XB_TOP      3328
#define XB_TOPGEN   3392
#define XCD_BAR_WORDS 3456
#define XB_SPIN_CAP (1u << 18)
__device__ __forceinline__ unsigned xb_ld(unsigned* p)              { return __hip_atomic_load(p, __ATOMIC_RELAXED, __HIP_MEMORY_SCOPE_AGENT); }
__device__ __forceinline__ unsigned xb_add(unsigned* p, unsigned v) { return __hip_atomic_fetch_add(p, v, __ATOMIC_RELAXED, __HIP_MEMORY_SCOPE_AGENT); }
__device__ __forceinline__ unsigned xb_xcc_id() { return (unsigned)__builtin_amdgcn_s_getreg((3 << 11) | 20) & 0xFu; }
#define XB_SPIN(cond, bar) do { unsigned _sp = 0; while (cond) { __builtin_amdgcn_s_sleep(1); \
    if ((++_sp & 255u) == 0u) { if (xb_ld(&(bar)[XB_TMO])) break; if (_sp > XB_SPIN_CAP) { atomicAdd(&(bar)[XB_TMO], 1u); break; } } } } while (0)
struct XcdBarrier { unsigned* bar; unsigned x; volatile LAS unsigned* st; };
__device__ __forceinline__ XcdBarrier xcd_barrier_post(unsigned* bar, volatile LAS unsigned* st) {
    XcdBarrier b; b.bar = bar; b.x = xb_xcc_id(); b.st = st;
    if (threadIdx.x == 0) (void)xb_add(&bar[XB_XCNT(b.x)], 1u);
    return b;
}
__device__ __forceinline__ void xcd_barrier_complete(unsigned* bar, unsigned x, unsigned& nloc, unsigned& nx) {
    const unsigned G = gridDim.x * gridDim.y * gridDim.z;
    unsigned sum, cnt, mine, sp = 0u;
    for (;;) {
        sum = 0u; cnt = 0u; mine = 0u;
#pragma unroll
        for (unsigned j = 0; j < 16; ++j) { const unsigned c = xb_ld(&bar[XB_XCNT(j)]); sum += c; cnt += (c > 0u) ? 1u : 0u; mine = (j == x) ? c : mine; }
        if (sum == G) break;
        __builtin_amdgcn_s_sleep(1);
        if ((++sp & 255u) == 0u) { if (xb_ld(&bar[XB_TMO])) break; if (sp > XB_SPIN_CAP) { atomicAdd(&bar[XB_TMO], 1u); break; } }
    }
    nloc = mine > 0u ? mine : 1u; nx = cnt > 0u ? cnt : 1u;
}
__device__ __forceinline__ void xcd_barrier(const XcdBarrier& b) {
    asm volatile("s_waitcnt vmcnt(0)" ::: "memory");
    __syncthreads();
    if (threadIdx.x == 0) {
        unsigned* bar = b.bar;
        __builtin_amdgcn_s_waitcnt(0);
        unsigned nloc = b.st[0], nx = b.st[1];
        if (nloc == 0u) { xcd_barrier_complete(bar, b.x, nloc, nx); b.st[0] = nloc; b.st[1] = nx; }
        const unsigned old = xb_add(&bar[XB_XSUB(b.x)], 1u);
        const unsigned gen = old / nloc;
        if (old + 1u == (gen + 1u) * nloc) {
            __builtin_amdgcn_fence(__ATOMIC_RELEASE, "agent");
            asm volatile("s_waitcnt vmcnt(0)" ::: "memory");
            const unsigned og = xb_add(&bar[XB_TOP], 1u);
            const unsigned tg = og / nx;
            if (og + 1u == (tg + 1u) * nx) xb_add(&bar[XB_TOPGEN], 1u);
            else XB_SPIN(xb_ld(&bar[XB_TOPGEN]) == tg, bar);
            __builtin_amdgcn_fence(__ATOMIC_ACQUIRE, "agent");
            xb_add(&bar[XB_XGEN(b.x)], 1u);
            asm volatile("s_waitcnt vmcnt(0)" ::: "memory");
        } else {
            XB_SPIN(xb_ld(&bar[XB_XGEN(b.x)]) == gen, bar);
            __builtin_amdgcn_fence(__ATOMIC_ACQUIRE, "agent");
            asm volatile("s_waitcnt vmcnt(0)" ::: "memory");
        }
    }
    __syncthreads();
}

struct Args { const float* in[26]; float* out; unsigned char* ws; int ph_lo, ph_hi, li, pad; };
struct Ctx {
    const float* in[26]; float* out; unsigned char* ws;
    LAS unsigned char* lds;
    int tid, lane, wave, blk, G;
};
#define WSP(T, off) ((T*)(C.ws + (off)))
__device__ __forceinline__ const float* modp(const Ctx& C, int l, int set, int j) { return (const float*)(C.ws + WS_MOD) + ((l * 2 + set) * 6 + j) * D; }

__device__ __forceinline__ void p0_transpose_item(const float* W, int K, int N, bf16* WT, int k0, int n0, int drow0, LAS float* scr, int lane) {
    const int lr = lane >> 3, lc = (lane & 7) * 4;
    f32x4 v[8];
#pragma unroll
    for (int i = 0; i < 8; ++i) v[i] = *(const f32x4*)(W + (size_t)(k0 + 8 * i + lr) * N + n0 + lc);
#pragma unroll
    for (int i = 0; i < 8; ++i) *(LAS f32x4*)(scr + (8 * i + lr) * 36 + lc) = v[i];
    asm volatile("s_waitcnt lgkmcnt(0)" ::: "memory");
    const int c = lane & 7;
#pragma unroll
    for (int j = 0; j < 4; ++j) { const int n = (lane >> 3) + 8 * j; const LAS float* s = scr + (8 * c) * 36 + n;
        u32x4 o; o.x = pk2(s[0 * 36], s[1 * 36]); o.y = pk2(s[2 * 36], s[3 * 36]); o.z = pk2(s[4 * 36], s[5 * 36]); o.w = pk2(s[6 * 36], s[7 * 36]);
        *(u32x4*)(WT + (size_t)(drow0 + n) * K + k0 + 8 * c) = o; }
    asm volatile("s_waitcnt lgkmcnt(0)" ::: "memory");
}
constexpr int MOE_ITEMS_PER_LAYER = 16 * 3072, MOE_HALF_ITEMS = 2 * MOE_ITEMS_PER_LAYER;
__device__ __forceinline__ bool moe_layer_in_attention(int l) { return true; }
struct ConvItem { const float* W; bf16* WT; int K, N; };
__device__ __forceinline__ ConvItem conv_half_item(const Ctx& C, int l, int hidx) {
    const int it = hidx >> 1, half = hidx & 1, e = it / 3072, r2 = it % 3072, which = r2 / 1024, item = r2 % 1024, le = l * 16 + e;
    ConvItem ci;
    if (which < 2) { const int kb = item / 64, nb = item % 64, n0 = nb * 32, k0 = kb * 64 + 32 * half, drow0 = (n0 >> 7) * 256 + (n0 & 127) + which * 128;
        ci.K = 1024; ci.N = 2048; ci.W = (which ? C.in[23] : C.in[22]) + (size_t)le * 1024 * 2048 + (size_t)k0 * 2048 + n0;
        ci.WT = WSP(bf16, WS_W_GU) + (size_t)le * 4096 * 1024 + (size_t)drow0 * 1024 + k0; }
    else { const int kb = item / 32, nb = item % 32, n0 = nb * 32, k0 = kb * 64 + 32 * half;
        ci.K = 2048; ci.N = 1024; ci.W = C.in[24] + (size_t)le * 2048 * 1024 + (size_t)k0 * 1024 + n0;
        ci.WT = WSP(bf16, WS_W_DN) + (size_t)le * 1024 * 2048 + (size_t)n0 * 2048 + k0; }
    return ci;
}
struct ConvState { int l0, total, cur; bool loaded; };
template <bool DRAIN>
__device__ __forceinline__ void conv_step(const Ctx& C, ConvState& st, LAS float* scr) {
    int lane = C.lane; asm volatile("" : "+v"(lane));
    if (st.loaded) {
        if (DRAIN) asm volatile("s_waitcnt vmcnt(0)" ::: "memory");
        const int pc = st.cur - C.G * 8; const ConvItem pi = conv_half_item(C, st.l0 + pc / MOE_HALF_ITEMS, pc % MOE_HALF_ITEMS);
#pragma unroll
        for (int j = 0; j < 2; ++j) { const int ch = lane + 64 * j, n = ch >> 2, c = ch & 3; const LAS float* sp = scr + (8 * c) * 32 + ((((n >> 2) ^ (2 * c)) << 2) | (n & 3));
            u32x4 o; o.x = cvt_pk_bf16(sp[0 * 32], sp[1 * 32]); o.y = cvt_pk_bf16(sp[2 * 32], sp[3 * 32]); o.z = cvt_pk_bf16(sp[4 * 32], sp[5 * 32]); o.w = cvt_pk_bf16(sp[6 * 32], sp[7 * 32]);
            *(u32x4*)(pi.WT + (size_t)n * pi.K + 8 * c) = o; }
        asm volatile("s_waitcnt lgkmcnt(0)" ::: "memory");
        st.loaded = false;
    }
    if (st.cur < st.total) {
        const ConvItem ci = conv_half_item(C, st.l0 + st.cur / MOE_HALF_ITEMS, st.cur % MOE_HALF_ITEMS);
        const int lr = lane >> 3;
#pragma unroll
        for (int i = 0; i < 4; ++i) { const int lc = ((lane & 7) ^ (2 * i)) * 4;
            __builtin_amdgcn_global_load_lds((const unsigned*)(ci.W + (size_t)(8 * i + lr) * ci.N + lc), (LAS unsigned*)(scr + i * 256), 16, 0, 0); }
        st.loaded = true; st.cur += C.G * 8;
    }
}
struct ConvPipe { int l0, total, first, n; };
constexpr int CONV_PIPE_BASE = 4 * (64 * 128 + 64 * 128) + 2048;
__device__ __forceinline__ LAS float* conv_pipe_buf(LAS unsigned char* lds, int wave, int par) {
    const int b = wave * 2 + par;
    return (LAS float*)(lds + (b < 14 ? CONV_PIPE_BASE + b * 4096 : 132096 + (b - 14) * 4096));
}
template <bool STORE = true>
__device__ __forceinline__ void conv_pack_store(bf16* WT, int K, const LAS float* scr, int lane) {
#pragma unroll
    for (int j = 0; j < 2; ++j) { const int ch = lane + 64 * j, n = ch >> 2, c = ch & 3; const LAS float* sp = scr + (8 * c) * 32 + ((((n >> 2) ^ (2 * c)) << 2) | (n & 3));
        u32x4 o; o.x = cvt_pk_bf16(sp[0 * 32], sp[1 * 32]); o.y = cvt_pk_bf16(sp[2 * 32], sp[3 * 32]); o.z = cvt_pk_bf16(sp[4 * 32], sp[5 * 32]); o.w = cvt_pk_bf16(sp[6 * 32], sp[7 * 32]);
        if (STORE) *(u32x4*)(WT + (size_t)n * K + 8 * c) = o; else asm volatile("" :: "v"(o.x), "v"(o.y), "v"(o.z), "v"(o.w)); }
    asm volatile("s_waitcnt lgkmcnt(0)" ::: "memory");
}
template <int FL = 0>
__device__ __forceinline__ void conv_pipe_step(const Ctx& C, ConvPipe& st, LAS unsigned char* lds) {
    int lane = C.lane; asm volatile("" : "+v"(lane));
    const int NGW = C.G * 8, cur = st.first + st.n * NGW, pc = cur - 2 * NGW;
    LAS float* scr = conv_pipe_buf(lds, C.wave, st.n & 1);
    { const bool real = st.n >= 2 && pc < st.total; const int pcc = real ? pc : st.first;
      const ConvItem pi = conv_half_item(C, st.l0, pcc);
      conv_pack_store<!(FL & 1)>(real ? pi.WT : WSP(bf16, WS_XG) + (size_t)st.first * 1024, real ? pi.K : 32, scr, lane); }
    { const int cc = cur < st.total ? cur : st.first;
      const ConvItem ci = conv_half_item(C, st.l0, cc);
      const int lr = lane >> 3;
#pragma unroll
      for (int i = 0; i < 4; ++i) { const int lc = ((lane & 7) ^ (2 * i)) * 4;
          if (!(FL & 2)) __builtin_amdgcn_global_load_lds((const unsigned*)(ci.W + (size_t)(8 * i + lr) * ci.N + lc), (LAS unsigned*)(scr + i * 256), 16, 0, 0); } }
    st.n += 1;
}
__device__ __forceinline__ void conv_pipe_drain(const Ctx& C, ConvPipe& st, LAS unsigned char* lds) {
    asm volatile("s_waitcnt vmcnt(0)" ::: "memory");
    const int NGW = C.G * 8;
#pragma unroll 1
    for (int k = 2; k >= 1; --k) { const int m = st.n - k, pc = st.first + m * NGW;
        if (m >= 0 && pc < st.total) { const ConvItem pi = conv_half_item(C, st.l0, pc); conv_pack_store(pi.WT, pi.K, conv_pipe_buf(lds, C.wave, m & 1), C.lane); } }
    ConvState rest; rest.l0 = st.l0; rest.total = st.total; rest.cur = st.first + st.n * NGW; rest.loaded = false;
    LAS float* scr = conv_pipe_buf(lds, C.wave, 0);
    while (rest.loaded || rest.cur < rest.total) conv_step<true>(C, rest, scr);
}
__device__ __forceinline__ bool p0_plain(int& r, const float* W, int K, int N, bf16* WT, int row_off, LAS float* scr, int lane) {
    const int nblk = N / 32, cnt = (K / 64) * nblk;
    if (r >= cnt) { r -= cnt; return false; }
    const int kb = r / nblk, nb = r % nblk;
    p0_transpose_item(W, K, N, WT, kb * 64, nb * 32, row_off + nb * 32, scr, lane);
    return true;
}
__device__ __forceinline__ void ph_prologue(const Ctx& C) {
    LAS float* scr = (LAS float*)(C.lds + C.wave * 16384);
    const int gw = C.blk * 8 + C.wave, NGW = C.G * 8;
    constexpr int MOE_ITEMS = 4 * 16 * 3072;
    constexpr int SMALL_ITEMS = 2 * 1536 + 2 * 512 + 768 + 512 + 256 + 144 + 384 + 256 + 512;
    for (int it = gw; it < MOE_ITEMS + SMALL_ITEMS; it += NGW) {
        if (it < MOE_ITEMS) {
            if (moe_layer_in_attention(it / MOE_ITEMS_PER_LAYER)) continue;
            const int le = it / 3072, r2 = it % 3072, which = r2 / 1024, item = r2 % 1024, l = le / 16, e = le % 16;
            if (which < 2) {
                const float* W = (which ? C.in[23] : C.in[22]) + (size_t)le * 1024 * 2048;
                bf16* WT = WSP(bf16, WS_W_GU) + ((size_t)l * 16 + e) * 4096 * 1024;
                const int kb = item / 64, nb = item % 64, n0 = nb * 32;
                p0_transpose_item(W, 1024, 2048, WT, kb * 64, n0, (n0 >> 7) * 256 + (n0 & 127) + which * 128, scr, C.lane);
            } else {
                const float* W = C.in[24] + (size_t)le * 2048 * 1024;
                bf16* WT = WSP(bf16, WS_W_DN) + ((size_t)l * 16 + e) * 1024 * 2048;
                const int kb = item / 32, nb = item % 32;
                p0_transpose_item(W, 2048, 1024, WT, kb * 64, nb * 32, nb * 32, scr, C.lane);
            }
            continue;
        }
        int r = it - MOE_ITEMS;
        if (p0_plain(r, C.in[8], 1024, 3072, WSP(bf16, WS_W_NAQKV), 0, scr, C.lane)) continue;
        if (p0_plain(r, C.in[8] + (size_t)1024 * 3072, 1024, 3072, WSP(bf16, WS_W_NAQKV) + (size_t)3072 * 1024, 0, scr, C.lane)) continue;
        if (p0_plain(r, C.in[9], 1024, 1024, WSP(bf16, WS_W_NAO), 0, scr, C.lane)) continue;
        if (p0_plain(r, C.in[9] + (size_t)1024 * 1024, 1024, 1024, WSP(bf16, WS_W_NAO) + (size_t)1024 * 1024, 0, scr, C.lane)) continue;
        if (p0_plain(r, C.in[11], 1024, 1536, WSP(bf16, WS_W_SWAQKV), 0, scr, C.lane)) continue;
        if (p0_plain(r, C.in[12], 1024, 1024, WSP(bf16, WS_W_SWAO), 0, scr, C.lane)) continue;
        if (p0_plain(r, C.in[14], 1024, 512, WSP(bf16, WS_W_MLAD), 0, scr, C.lane)) continue;
        if (p0_plain(r, C.in[17], 1024, 288, WSP(bf16, WS_W_MLAD), 512, scr, C.lane)) continue;
        if (p0_plain(r, C.in[16], 512, 1536, WSP(bf16, WS_W_MLAUQ), 0, scr, C.lane)) continue;
        if (p0_plain(r, C.in[19], 256, 2048, WSP(bf16, WS_W_MLAUKV), 0, scr, C.lane)) continue;
        p0_plain(r, C.in[20], 1024, 1024, WSP(bf16, WS_W_MLAO), 0, scr, C.lane);
    }
    { u32x4* z = (u32x4*)(WSP(bf16, WS_W_MLAD) + (size_t)800 * 1024); const int n16 = 224 * 1024 * 2 / 16;
      for (int i = C.blk * 512 + C.tid; i < n16; i += C.G * 512) z[i] = (u32x4){0u, 0u, 0u, 0u}; }
    __syncthreads();
    LAS float* sc = (LAS float*)C.lds;
    LAS float* red = sc + 2048;
    for (int i = C.tid; i < 2048; i += 512) { const float v = (i < 1024) ? C.in[1][i] : C.in[3][i - 1024]; sc[i] = v / (1.f + __expf(-v)); }
    __syncthreads();
    for (int u = C.blk; u < 4 * 96; u += C.G) {
        const int l = u / 96, j0 = (u % 96) * 64, kg = C.tid >> 4, jl = (C.tid & 15) * 4;
        const float* W = C.in[4] + (size_t)l * 1024 * 6144 + (size_t)(kg * 32) * 6144 + j0 + jl;
        f32x4 a0 = (f32x4){0.f, 0.f, 0.f, 0.f}, a1 = a0;
#pragma unroll 1
        for (int kb = 0; kb < 32; kb += 16) {
            f32x4 wv[16];
#pragma unroll
            for (int i = 0; i < 16; ++i) wv[i] = *(const f32x4*)(W + (size_t)(kb + i) * 6144);
#pragma unroll
            for (int i = 0; i < 16; ++i) { const float s0 = sc[kg * 32 + kb + i], s1 = sc[1024 + kg * 32 + kb + i];
                a0[0] += s0 * wv[i][0]; a0[1] += s0 * wv[i][1]; a0[2] += s0 * wv[i][2]; a0[3] += s0 * wv[i][3];
                a1[0] += s1 * wv[i][0]; a1[1] += s1 * wv[i][1]; a1[2] += s1 * wv[i][2]; a1[3] += s1 * wv[i][3]; }
        }
        *(LAS f32x4*)(red + kg * 64 + jl) = a0; *(LAS f32x4*)(red + 2048 + kg * 64 + jl) = a1;
        __syncthreads();
        if (C.tid < 128) { const int set = C.tid >> 6, j = C.tid & 63; float s = 0.f;
#pragma unroll
            for (int q = 0; q < 32; ++q) s += red[set * 2048 + q * 64 + j];
            const int col = j0 + j;
            ((float*)(C.ws + WS_MOD))[((l * 2 + set) * 6) * D + col] = s + C.in[5][l * 6144 + col]; }
        __syncthreads();
    }
}

template <int MODE>
__device__ __forceinline__ void ph_rowA(const Ctx& C, int l) {
    float* X = WSP(float, WS_X); bf16* H = WSP(bf16, WS_H); const int* INV = WSP(int, WS_INV); const bf16* YB = WSP(bf16, WS_YB);
    const int nrows = MODE == 1 ? SEQ : R;
    for (int t = C.blk * 8 + C.wave; t < nrows; t += C.G * 8) {
        const int set = t >= SEQ ? 1 : 0;
        const float* src = (MODE == 0 && l == 0) ? (set ? C.in[2] + (size_t)(t - SEQ) * D : C.in[0] + (size_t)t * D) : X + (size_t)t * D;
        f32x4 v[4];
#pragma unroll
        for (int j = 0; j < 4; ++j) v[j] = ((const f32x4*)src)[C.lane + 64 * j];
        if (MODE == 1 || l > 0) {
            const int lp = MODE == 1 ? 3 : l - 1;
            const int myinv = C.lane < 16 ? INV[(size_t)C.lane * R + t] : -1;
            f32x4 a[4];
#pragma unroll
            for (int j = 0; j < 4; ++j) a[j] = (f32x4){0.f, 0.f, 0.f, 0.f};
            unsigned em = (unsigned)(__builtin_amdgcn_ballot_w64(myinv >= 0) & 0xffffull);
            while (em) {
                int sl[4]; bool ok[4];
#pragma unroll
                for (int q = 0; q < 4; ++q) { ok[q] = em != 0u; const int e = ok[q] ? __builtin_ctz(em) : 0; if (ok[q]) em &= em - 1u; sl[q] = e * EROWS + __shfl(myinv, e); }
                u32x2 w[4][4];
#pragma unroll
                for (int q = 0; q < 4; ++q) { const u32x2* yr = (const u32x2*)(YB + (size_t)(ok[q] ? sl[q] : 0) * D);
#pragma unroll
                    for (int j = 0; j < 4; ++j) w[q][j] = ok[q] ? yr[C.lane + 64 * j] : (u32x2){0u, 0u}; }
#pragma unroll
                for (int q = 0; q < 4; ++q)
#pragma unroll
                    for (int j = 0; j < 4; ++j) a[j] += (f32x4){bf2f(w[q][j].x & 0xffffu), bf2f(w[q][j].x >> 16), bf2f(w[q][j].y & 0xffffu), bf2f(w[q][j].y >> 16)};
            }
            const f32x4* g = (const f32x4*)modp(C, lp, set, 5);
#pragma unroll
            for (int j = 0; j < 4; ++j) v[j] += g[C.lane + 64 * j] * a[j];
        }
        if (MODE == 0) {
#pragma unroll
            for (int j = 0; j < 4; ++j) ((f32x4*)(X + (size_t)t * D))[C.lane + 64 * j] = v[j];
        }
        float ss = 0.f;
#pragma unroll
        for (int j = 0; j < 4; ++j) ss += (v[j].x * v[j].x + v[j].y * v[j].y) + (v[j].z * v[j].z + v[j].w * v[j].w);
        const float rstd = rsqrtf(wave_sum(ss) * (1.f / D) + RMS_EPS);
        if (MODE == 0) {
            const f32x4* w = (const f32x4*)(C.in[6] + (size_t)l * D); const f32x4* sh = (const f32x4*)modp(C, l, set, 0); const f32x4* scl = (const f32x4*)modp(C, l, set, 1);
#pragma unroll
            for (int j = 0; j < 4; ++j) { const int i = C.lane + 64 * j; const f32x4 y = v[j] * rstd * w[i] * (scl[i] + 1.f) + sh[i];
                u32x2 o; o.x = pk2(y.x, y.y); o.y = pk2(y.z, y.w); ((u32x2*)(H + (size_t)t * D))[i] = o; }
        } else {
            const f32x4* w = (const f32x4*)C.in[25];
#pragma unroll
            for (int j = 0; j < 4; ++j) { const int i = C.lane + 64 * j; ((f32x4*)(C.out + (size_t)t * D))[i] = v[j] * rstd * w[i]; }
        }
    }
}
template <int M> __device__ __forceinline__ float xorx(float v, int b5) {
    if constexpr (M == 32) { const auto sw = __builtin_amdgcn_permlane32_swap(__float_as_uint(v), __float_as_uint(v), false, false); return __uint_as_float(b5 ? sw[0] : sw[1]); }
    else return __int_as_float(__builtin_amdgcn_ds_swizzle(__float_as_int(v), (M << 10) | 0x1f));
}
#define RS_STEP(lo, hi, bit, off) ((bit ? hi : lo) + xorx<off>(bit ? lo : hi, b5))
__device__ __forceinline__ float rscatter16(const float (&a)[16], int b5, int b4, int b3, int b2) {
    const float c0 = RS_STEP(a[0], a[8], b5, 32), c1 = RS_STEP(a[1], a[9], b5, 32), c2 = RS_STEP(a[2], a[10], b5, 32), c3 = RS_STEP(a[3], a[11], b5, 32);
    const float c4 = RS_STEP(a[4], a[12], b5, 32), c5 = RS_STEP(a[5], a[13], b5, 32), c6 = RS_STEP(a[6], a[14], b5, 32), c7 = RS_STEP(a[7], a[15], b5, 32);
    const float d0 = RS_STEP(c0, c4, b4, 16), d1 = RS_STEP(c1, c5, b4, 16), d2 = RS_STEP(c2, c6, b4, 16), d3 = RS_STEP(c3, c7, b4, 16);
    const float e0 = RS_STEP(d0, d2, b3, 8), e1 = RS_STEP(d1, d3, b3, 8);
    return RS_STEP(e0, e1, b2, 4);
}
__device__ __forceinline__ void n2_finish(float (&lg)[16], int b5, int b4, int b3, int b2, int my_e, int lane, float* AFF, int t) {
    float vv = rscatter16(lg, b5, b4, b3, b2);
    vv += xorx<1>(vv, b5); vv += xorx<2>(vv, b5);
    float mx = vv; mx = fmaxf(mx, xorx<4>(mx, b5)); mx = fmaxf(mx, xorx<8>(mx, b5)); mx = fmaxf(mx, xorx<16>(mx, b5)); mx = fmaxf(mx, xorx<32>(mx, b5));
    const float ex = __expf(vv - mx); float sm = ex; sm += xorx<4>(sm, b5); sm += xorx<8>(sm, b5); sm += xorx<16>(sm, b5); sm += xorx<32>(sm, b5);
    if ((lane & 3) == 0) AFF[(size_t)my_e * R + t] = ex / sm;
}
template <int VAR = 0>
__device__ __forceinline__ void ph_norm2(const Ctx& C, int l, int nrows) {
    const float* X = WSP(float, WS_X); bf16* H = VAR ? WSP(bf16, WS_XG) : WSP(bf16, WS_H); float* AFF = VAR ? WSP(float, WS_ACT) : WSP(float, WS_AFF);
    LAS float* Rs = (LAS float*)C.lds;
    const float* rt = C.in[21] + (size_t)l * D * NE;
    for (int i = C.tid; i < D * NE / 4; i += 512) { const f32x4 r4 = ((const f32x4*)rt)[i]; const int c = i >> 2, e0 = (i & 3) * 4;
        Rs[(e0 + 0) * D + c] = r4.x; Rs[(e0 + 1) * D + c] = r4.y; Rs[(e0 + 2) * D + c] = r4.z; Rs[(e0 + 3) * D + c] = r4.w; }
    __syncthreads();
    const int b5 = (C.lane >> 5) & 1, b4 = (C.lane >> 4) & 1, b3 = (C.lane >> 3) & 1, b2 = (C.lane >> 2) & 1, my_e = 8 * b5 + 4 * b4 + 2 * b3 + b2;
    for (int t0 = (C.blk * 8 + C.wave) * 2; t0 < nrows; t0 += C.G * 16) {
        asm volatile("" ::: "memory");
        const int set = t0 >= SEQ ? 1 : 0;
        f32x4 va[4], vb[4];
#pragma unroll
        for (int j = 0; j < 4; ++j) { va[j] = ((const f32x4*)(X + (size_t)t0 * D))[C.lane + 64 * j]; vb[j] = ((const f32x4*)(X + (size_t)(t0 + 1) * D))[C.lane + 64 * j]; }
        { const f32x4* w = (const f32x4*)(C.in[7] + (size_t)l * D); const f32x4* sh = (const f32x4*)modp(C, l, set, 3); const f32x4* scl = (const f32x4*)modp(C, l, set, 4);
          float sa = 0.f, sb = 0.f;
#pragma unroll
          for (int j = 0; j < 4; ++j) { sa += (va[j].x * va[j].x + va[j].y * va[j].y) + (va[j].z * va[j].z + va[j].w * va[j].w); sb += (vb[j].x * vb[j].x + vb[j].y * vb[j].y) + (vb[j].z * vb[j].z + vb[j].w * vb[j].w); }
          const float ra = rsqrtf(wave_sum(sa) * (1.f / D) + RMS_EPS), rb = rsqrtf(wave_sum(sb) * (1.f / D) + RMS_EPS);
#pragma unroll
          for (int j = 0; j < 4; ++j) { const int i = C.lane + 64 * j; const f32x4 ws = w[i] * (scl[i] + 1.f), s4 = sh[i];
              va[j] = va[j] * ra * ws + s4; vb[j] = vb[j] * rb * ws + s4;
              u32x2 o; o.x = pk2(va[j].x, va[j].y); o.y = pk2(va[j].z, va[j].w); ((u32x2*)(H + (size_t)t0 * D))[i] = o;
              o.x = pk2(vb[j].x, vb[j].y); o.y = pk2(vb[j].z, vb[j].w); ((u32x2*)(H + (size_t)(t0 + 1) * D))[i] = o; } }
        float la[16], lb[16];
#pragma unroll
        for (int e = 0; e < 16; ++e) { float s0 = 0.f, s1 = 0.f;
#pragma unroll
            for (int j = 0; j < 4; ++j) { if (VAR & 2) { s0 += va[j].x * (float)e; s1 += vb[j].y * (float)e; continue; } const f32x4 r = *(const LAS f32x4*)(Rs + e * D + 4 * (C.lane + 64 * j));
                s0 += (va[j].x * r.x + va[j].y * r.y) + (va[j].z * r.z + va[j].w * r.w); s1 += (vb[j].x * r.x + vb[j].y * r.y) + (vb[j].z * r.z + vb[j].w * r.w); }
            la[e] = s0; lb[e] = s1; }
        if (VAR & 1) { float z = 0.f;
#pragma unroll
            for (int e = 0; e < 16; ++e) z += la[e] * lb[e];
            if (C.lane == 0) AFF[t0] = z; continue; }
#pragma unroll 1
        for (int rr = 0; rr < 2; ++rr) {
            n2_finish(la, b5, b4, b3, b2, my_e, C.lane, AFF, t0 + rr);
#pragma unroll
            for (int e = 0; e < 16; ++e) la[e] = lb[e];
        }
    }
}

__device__ __forceinline__ int block_sum_i(int v, LAS int* scr, int wave, int lane) {
    v = wave_sum_i(v);
    if (lane == 0) scr[wave] = v;
    __syncthreads();
    int t = 0;
#pragma unroll
    for (int w = 0; w < 8; ++w) t += scr[w];
    __syncthreads();
    return t;
}
__device__ __forceinline__ int block_excl_scan(int v, LAS int* scr, int wave, int lane) {
    int inc = v;
#pragma unroll
    for (int o = 1; o < 64; o <<= 1) { const int n = __shfl_up(inc, o); if (lane >= o) inc += n; }
    if (lane == 63) scr[wave] = inc;
    __syncthreads();
    int off = 0;
#pragma unroll
    for (int w = 0; w < 8; ++w) off += (w < wave) ? scr[w] : 0;
    __syncthreads();
    return off + inc - v;
}
template <int KPT>
__device__ __forceinline__ void topk_unit(const Ctx& C, int e, int base, int n, int cap, int slot0) {
    const float* aff = WSP(float, WS_AFF) + (size_t)e * R + base;
    int* rowl = WSP(int, WS_ROWL) + e * EROWS; float* gatel = WSP(float, WS_GATEL) + e * EROWS; int* INV = WSP(int, WS_INV);
    LAS unsigned* hist = (LAS unsigned*)C.lds;
    LAS int* scr = (LAS int*)(hist + 2048);
    LAS unsigned* bc = hist + 2048 + 16;
    unsigned key[KPT];
    if (KPT == 32) {
#pragma unroll
        for (int j = 0; j < KPT; j += 4) { const u32x4 k4 = *(const u32x4*)(aff + C.tid * KPT + j); key[j] = k4.x; key[j + 1] = k4.y; key[j + 2] = k4.z; key[j + 3] = k4.w; }
    } else {
#pragma unroll
        for (int j = 0; j < KPT; ++j) { const int t = C.tid * KPT + j; key[j] = t < n ? __float_as_uint(aff[t]) : 0u; }
    }
    unsigned prefix = 0u, pmask = 0u; int kth = cap;
#pragma unroll 1
    for (int pass = 0; pass < 3; ++pass) {
        const int shift = pass == 0 ? 20 : (pass == 1 ? 9 : 0), nb = pass == 2 ? 512 : 2048; const unsigned dmask = (unsigned)nb - 1u;
        for (int i = C.tid; i < nb; i += 512) hist[i] = 0u;
        __syncthreads();
#pragma unroll
        for (int j = 0; j < KPT; ++j) if (key[j] != 0u && (key[j] & pmask) == prefix) __hip_atomic_fetch_add(hist + ((key[j] >> shift) & dmask), 1u, __ATOMIC_RELAXED, __HIP_MEMORY_SCOPE_WORKGROUP);
        __syncthreads();
        if (C.wave == 0) {
            const int per = nb >> 6;
            int tot = 0;
            for (int q = 0; q < per; ++q) tot += (int)hist[C.lane * per + q];
            int suf = tot;
#pragma unroll
            for (int o = 1; o < 64; o <<= 1) { const int nbv = __shfl_down(suf, o); if (C.lane + o < 64) suf += nbv; }
            const unsigned long long bal = __ballot(suf >= kth);
            const int lstar = 63 - __builtin_clzll(bal);
            if (C.lane == lstar) { int above = suf - tot; int q = per - 1;
                for (; q > 0; --q) { const int c = (int)hist[C.lane * per + q]; if (above + c >= kth) break; above += c; }
                bc[0] = (unsigned)(C.lane * per + q); bc[1] = (unsigned)(kth - above); }
        }
        __syncthreads();
        prefix |= bc[0] << shift; pmask |= dmask << shift; kth = (int)bc[1];
    }
    const int need_eq = kth;
    int ce = 0;
#pragma unroll
    for (int j = 0; j < KPT; ++j) ce += key[j] == prefix ? 1 : 0;
    int eqr = block_excl_scan(ce, scr, C.wave, C.lane);
    int nsel = 0; unsigned selmask = 0u;
#pragma unroll
    for (int j = 0; j < KPT; ++j) { bool sl = key[j] > prefix; if (key[j] == prefix) { sl = eqr < need_eq; ++eqr; } if (sl) { ++nsel; selmask |= 1u << j; } }
    int slot = block_excl_scan(nsel, scr, C.wave, C.lane);
    int invv[KPT];
#pragma unroll
    for (int j = 0; j < KPT; ++j) { const int t = C.tid * KPT + j; invv[j] = -1;
        if (t < n && ((selmask >> j) & 1u)) { rowl[slot0 + slot] = base + t; gatel[slot0 + slot] = __uint_as_float(key[j]); invv[j] = slot0 + slot; ++slot; } }
    int* invrow = INV + (size_t)e * R + base + C.tid * KPT;
    if (KPT == 32) {
#pragma unroll
        for (int j = 0; j < KPT; j += 4) *(u32x4*)(invrow + j) = (u32x4){(unsigned)invv[j], (unsigned)invv[j + 1], (unsigned)invv[j + 2], (unsigned)invv[j + 3]};
    } else {
#pragma unroll
        for (int j = 0; j < KPT; ++j) if (C.tid * KPT + j < n) invrow[j] = invv[j];
    }
}
__device__ __forceinline__ void ph_topk(const Ctx& C, bool with_ctx) {
    for (int u = C.blk; u < (with_ctx ? 32 : 16); u += C.G) {
        const int e = u & 15;
        if (u < 16) { topk_unit<32>(C, e, 0, SEQ, CAP_L, 0); int* rowl = WSP(int, WS_ROWL) + e * EROWS; for (int i = CAP_L + CAP_C + C.tid; i < EROWS; i += 512) rowl[i] = 0; }
        else topk_unit<1>(C, e, SEQ, NCTX, CAP_C, CAP_L);
        __syncthreads();
    }
}
__device__ __forceinline__ void ph_gather(const Ctx& C, bool with_ctx) {
    const int* rowl = WSP(int, WS_ROWL); const bf16* H = WSP(bf16, WS_H); bf16* XG = WSP(bf16, WS_XG);
    const int nslots = with_ctx ? CAP_L + CAP_C : CAP_L, ntot = NE * nslots;
    for (int i = C.blk * 8 + C.wave; i < ntot; i += C.G * 8) {
        const int e = i / nslots, sl = i % nslots, r = e * EROWS + sl;
        const int src = rowl[r];
        u32x4* d = (u32x4*)(XG + (size_t)r * D); const u32x4* sp = (const u32x4*)(H + (size_t)src * D);
        d[C.lane] = sp[C.lane]; d[C.lane + 64] = sp[C.lane + 64];
    }
}
__device__ __forceinline__ void rot_angles(int t, int half, int d, int quarter, float& cs, float& sn) {
    const float invf = exp2f(-(float)d * (13.287712379549449f / (float)quarter));
    const float pos = half ? (float)(t & 63) : (float)(t >> 6);
    const float ang = pos * invf;
    const double rev = (double)ang * 0.15915494309189535; const float fr = (float)(rev - __builtin_rint(rev));
    cs = __builtin_amdgcn_cosf(fr); sn = __builtin_amdgcn_sinf(fr);
}
__device__ __forceinline__ void ph_rope(const Ctx& C, bf16* buf, int hw, int nheads, int off, int quarter) {
    const int per_tok = nheads * 2 * quarter; const long total = (long)SEQ * per_tok;
    for (long i = (long)C.blk * 512 + C.tid; i < total; i += (long)C.G * 512) {
        const int t = (int)(i / per_tok), r = (int)(i % per_tok), h = r / (2 * quarter), p = r % (2 * quarter), half = p / quarter, d = p % quarter;
        float cs, sn; rot_angles(t, half, d, quarter, cs, sn);
        bf16* b = buf + (size_t)h * R * hw + (size_t)t * hw + off + half * 2 * quarter + d;
        const float x1 = bf2f(b[0]), x2 = bf2f(b[quarter]);
        b[0] = (bf16)f2bf(x1 * cs - x2 * sn); b[quarter] = (bf16)f2bf(x1 * sn + x2 * cs);
    }
}
__device__ __forceinline__ void ph_mlanorm(const Ctx& C) {
    const float* CQ = WSP(float, WS_CQ); bf16* CQN = WSP(bf16, WS_CQN); bf16* CKVN = WSP(bf16, WS_CKVN); bf16* KR = WSP(bf16, WS_KROPE);
    for (int t = C.blk * 8 + C.wave; t < R; t += C.G * 8) {
        const float* row = CQ + (size_t)t * D;
        const f32x4 a0 = ((const f32x4*)row)[C.lane], a1 = ((const f32x4*)row)[C.lane + 64], b0 = ((const f32x4*)(row + 512))[C.lane];
        const float sa = wave_sum((a0.x * a0.x + a0.y * a0.y) + (a0.z * a0.z + a0.w * a0.w) + (a1.x * a1.x + a1.y * a1.y) + (a1.z * a1.z + a1.w * a1.w));
        const float sb = wave_sum((b0.x * b0.x + b0.y * b0.y) + (b0.z * b0.z + b0.w * b0.w));
        const float ra = rsqrtf(sa * (1.f / 512.f) + RMS_EPS), rb = rsqrtf(sb * (1.f / 256.f) + RMS_EPS);
        const f32x4* gq = (const f32x4*)C.in[15]; const f32x4* gk = (const f32x4*)C.in[18];
        { const f32x4 y0 = a0 * ra * gq[C.lane], y1 = a1 * ra * gq[C.lane + 64], z = b0 * rb * gk[C.lane];
          u32x2 o; o.x = pk2(y0.x, y0.y); o.y = pk2(y0.z, y0.w); ((u32x2*)(CQN + (size_t)t * 512))[C.lane] = o;
          o.x = pk2(y1.x, y1.y); o.y = pk2(y1.z, y1.w); ((u32x2*)(CQN + (size_t)t * 512))[C.lane + 64] = o;
          o.x = pk2(z.x, z.y); o.y = pk2(z.z, z.w); ((u32x2*)(CKVN + (size_t)t * 256))[C.lane] = o; }
        const float x = row[768 + (C.lane & 31)];
        const float xp = __shfl_xor(x, 8);
        float y = x;
        if (t < SEQ) { float cs, sn; rot_angles(t, (C.lane >> 4) & 1, C.lane & 7, 8, cs, sn);
            y = ((C.lane >> 3) & 1) ? (xp * sn + x * cs) : (x * cs - xp * sn); }
        if (C.lane < 32) KR[(size_t)t * 32 + C.lane] = (bf16)f2bf(y);
    }
}

constexpr int CW_KMAX = 8192;
__device__ __forceinline__ void ph_kmax(const Ctx& C) {
    const bf16* KV = WSP(bf16, WS_KV); const bf16* KR = WSP(bf16, WS_KROPE); unsigned* ctl = (unsigned*)(C.ws + WS_CTL);
    for (int i = C.blk * 512 + C.tid; i < 16 * R; i += C.G * 512) {
        const int h = i / R, t = i - h * R;
        const u32x4* kp = (const u32x4*)(KV + (size_t)h * R * 128 + (size_t)t * 128); const u32x4* rp = (const u32x4*)(KR + (size_t)t * 32);
        float ss = 0.f;
#pragma unroll
        for (int q = 0; q < 12; ++q) { const u32x4 w = q < 8 ? kp[q] : rp[q - 8];
            const float a0 = bf2f(w.x & 0xffffu), a1 = bf2f(w.x >> 16), a2 = bf2f(w.y & 0xffffu), a3 = bf2f(w.y >> 16), a4 = bf2f(w.z & 0xffffu), a5 = bf2f(w.z >> 16), a6 = bf2f(w.w & 0xffffu), a7 = bf2f(w.w >> 16);
            ss += (a0 * a0 + a1 * a1) + (a2 * a2 + a3 * a3) + (a4 * a4 + a5 * a5) + (a6 * a6 + a7 * a7); }
#pragma unroll
        for (int o = 1; o < 64; o <<= 1) ss = fmaxf(ss, __shfl_xor(ss, o));
        if (C.lane == 0) atomicMax(ctl + CW_KMAX + h, __float_as_uint(ss));
    }
}

namespace pg8 {
#define PG8_LAS __attribute__((address_space(3)))
typedef unsigned short bf16_t;
typedef short bf16x8 __attribute__((ext_vector_type(8)));
typedef float f32x4 __attribute__((ext_vector_type(4)));
typedef unsigned u32x4 __attribute__((ext_vector_type(4)));
constexpr int BM = 256, BK = 64, HALF = 128, HTB = HALF * BK * 2  , STAGE_BYTES = 8 * HTB, NXCD = 8, WGM = 8;

__host__ __device__ __forceinline__ int lds_byte(int r, int c) { const int st = (r >> 4) * 2 + (c >> 5), rr = r & 15, cc = c & 31, ob = rr * 64 + cc * 2; return st * 1024 + (ob ^ (((ob >> 9) & 1) << 5)); }
__host__ __device__ __forceinline__ void stage_rc(int b, int& R, int& C) { const int st = b / 1024, sb = b % 1024, swz = sb ^ (((sb >> 9) & 1) << 5); R = (st >> 1) * 16 + swz / 64; C = (st & 1) * 32 + (swz % 64) / 2; }
__host__ __device__ __forceinline__ int perm32(int rho) { const int n = rho >> 4, i = rho & 15; return 8 * (i >> 2) + 4 * n + (i & 3); }

struct Unit { int pm, pn, thin; };
struct Gemm { const bf16_t* A; const bf16_t* Bt; int M, N, K; int pm_per_grp; size_t grp_stride; };

struct StaticOrder {
    int nM, nN, nwg, G, c;
    __host__ __device__ void init(int M, int N, int G_, int c_) { nM = M / BM; nN = N / BM; nwg = nM * nN; G = G_; c = c_; }
    __host__ __device__ bool next(int i, Unit& u) const {
        const long L = (long)i * G + c; if (L >= nwg) return false;
        int wgid = (int)L; { const int q = nwg / NXCD, r = nwg % NXCD, xcd = wgid % NXCD, off = wgid / NXCD; wgid = (xcd < r ? xcd * (q + 1) : r * (q + 1) + (xcd - r) * q) + off; }
        const int nig = WGM * nN, gid = wgid / nig, fm = gid * WGM, gsz = (nM - fm) < WGM ? (nM - fm) : WGM;
        u.pm = fm + ((wgid % nig) % gsz); u.pn = (wgid % nig) / gsz; u.thin = 0; return true;
    }
    __device__ __forceinline__ void a_ready(const Unit&) const {}
    __device__ __forceinline__ void done(const Unit&) const {}
};
struct MoeOrder {
    StaticOrder base; int nN, nthin;
    __host__ __device__ void init(int N, int G_, int c_, bool with_thin) { base.init(NEXP_PANELS * BM, N, G_, c_); nN = N / BM; nthin = with_thin ? 16 * nN : 0; }
    static constexpr int NEXP_PANELS = 16 * 8;
    __host__ __device__ bool next(int i, Unit& u) const {
        if (base.next(i, u)) { u.pm = (u.pm >> 3) * 9 + (u.pm & 7); return true; }
        const long j = (long)i * base.G + base.c - base.nwg; if (j >= nthin) return false;
        u.pm = (int)(j / nN) * 9 + 8; u.pn = (int)(j % nN); u.thin = 1; return true;
    }
    __device__ __forceinline__ void a_ready(const Unit&) const {}
    __device__ __forceinline__ void done(const Unit&) const {}
};

template <class Epi, class Sched, bool ALIGN_EPI = false, bool SP2 = false, bool GATHER = false>
__device__ __forceinline__ void gemm_phase(PG8_LAS unsigned char* lds, const Gemm g, const Sched& S, const Epi& E, const PG8_LAS int* idx_tab = nullptr) {
    static_assert(!GATHER || SP2, "the gathered A panel is wired into the SP2 loop only");
    const int tid = threadIdx.x, wid = __builtin_amdgcn_readfirstlane(tid >> 6), lane = tid & 63, wr = wid >> 2, wc = wid & 3, fr = lane & 15, fq = lane >> 4;
    const int K = g.K, nt = K / BK;
    unsigned voffA[2], voffB[2]; int rowA[2]; unsigned colA[2];
#pragma unroll
    for (int i = 0; i < 2; ++i) { int R, C; stage_rc(tid * 16 + i * 8192, R, C); const int Rb = Epi::PERM ? ((R & ~31) + perm32(R & 31)) : R;
        voffA[i] = (unsigned)(R * K + C) * 2u; voffB[i] = (unsigned)(Rb * K + C) * 2u; rowA[i] = R; colA[i] = (unsigned)C * 2u; }
    unsigned vGc[2][2], vGn[2][2];
#define PG8_GOFF(dst, ui_) do { _Pragma("unroll") for (int h_ = 0; h_ < 2; ++h_) _Pragma("unroll") for (int i_ = 0; i_ < 2; ++i_) \
        dst[h_][i_] = (unsigned)idx_tab[(ui_) * 256 + h_ * HALF + rowA[i_]] * (unsigned)(K * 2) + colA[i_]; } while (0)
#define PG8_STAGE_A(bufoff, ptr, h, nf) do { if constexpr (GATHER) { _Pragma("unroll") for (int _i = 0; _i < 2; ++_i) \
        __builtin_amdgcn_global_load_lds((const unsigned*)((const char*)(ptr) + ((nf) ? vGn[h][_i] : vGc[h][_i])), (PG8_LAS unsigned*)(lds + (bufoff) + ldsw + _i * 8192), 16, 0, 0); } \
        else PG8_STAGE(bufoff, (ptr) + (h) * hstep, voffA); } while (0)
    const size_t kstep = (size_t)(BK * 2);
    const size_t hstep = (size_t)HALF * K * 2;
    const size_t tstep = 2 * hstep;
    const unsigned ldsw = (unsigned)wid * 1024u;
    const int aoff = lds_byte(wr * 64 + fr, fq * 8), boff = lds_byte(wc * 32 + fr, fq * 8);
#define PG8_SA(b, h) (((b) * 2 + (h)) * HTB)
#define PG8_SB(b, h) ((4 + (b) * 2 + (h)) * HTB)
#define PG8_STAGE(bufoff, gbase, voff) do { _Pragma("unroll") for (int _i = 0; _i < 2; ++_i) \
        __builtin_amdgcn_global_load_lds((const unsigned*)((const char*)(gbase) + (voff)[_i]), (PG8_LAS unsigned*)(lds + (bufoff) + ldsw + _i * 8192), 16, 0, 0); } while (0)
#define PG8_LDA(dst, b, h) do { _Pragma("unroll") for (int m = 0; m < 4; ++m) _Pragma("unroll") for (int k = 0; k < 2; ++k) dst[m][k] = *(const PG8_LAS bf16x8*)(lds + PG8_SA(b, h) + aoff + m * 2048 + k * 1024); } while (0)
#define PG8_LDB(dst, b, h) do { _Pragma("unroll") for (int n = 0; n < 2; ++n) _Pragma("unroll") for (int k = 0; k < 2; ++k) dst[n][k] = *(const PG8_LAS bf16x8*)(lds + PG8_SB(b, h) + boff + n * 2048 + k * 1024); } while (0)
#define PG8_MMA(ai, bj, At, Bt) do { if (cur.thin && ((ai) != 0 || wr != 0)) break; __builtin_amdgcn_s_setprio(1); _Pragma("unroll") for (int m = 0; m < 4; ++m) _Pragma("unroll") for (int n = 0; n < 2; ++n) _Pragma("unroll") for (int k = 0; k < 2; ++k) \
        acc[ai][bj][m][n] = __builtin_amdgcn_mfma_f32_16x16x32_bf16(Bt[n][k], At[m][k], acc[ai][bj][m][n], 0, 0, 0); __builtin_amdgcn_s_setprio(0); } while (0)
#define PG8_WAIT_V(n) asm volatile("s_waitcnt vmcnt(" #n ")" ::: "memory")
#define PG8_WAIT_L(n) asm volatile("s_waitcnt lgkmcnt(" #n ")" ::: "memory")
#define PG8_BAR __builtin_amdgcn_s_barrier()
#define PG8_SCHED __builtin_amdgcn_sched_barrier(0)
    Unit cur, nxt; int ui = 0;
    if (!S.next(0, cur)) return;
    f32x4 acc[2][2][4][2];
#pragma unroll
    for (int a = 0; a < 2; ++a)
#pragma unroll
        for (int b = 0; b < 2; ++b)
#pragma unroll
            for (int m = 0; m < 4; ++m)
#pragma unroll
                for (int n = 0; n < 2; ++n) acc[a][b][m][n] = (f32x4){0.f, 0.f, 0.f, 0.f};
    bf16x8 At[4][2], B0[2][2], B1[2][2];
    const char* cA = GATHER ? (const char*)g.A : (const char*)g.A + (size_t)cur.pm * tstep; const char* cB = (const char*)g.Bt + (g.pm_per_grp ? (size_t)(cur.pm / g.pm_per_grp) * g.grp_stride * 2 : (size_t)0) + (size_t)cur.pn * tstep;
    S.a_ready(cur);
    if constexpr (GATHER) { PG8_GOFF(vGc, 0); }
    if constexpr (SP2) {
        PG8_STAGE(PG8_SB(0, 0), cB, voffB); PG8_STAGE(PG8_SB(0, 1), cB + hstep, voffB); PG8_STAGE_A(PG8_SA(0, 0), cA, 0, false); PG8_STAGE_A(PG8_SA(0, 1), cA, 1, false);
        if (wr == 1) PG8_BAR;
        PG8_WAIT_V(2); PG8_BAR;
        PG8_STAGE(PG8_SB(1, 0), cB + kstep, voffB); PG8_STAGE_A(PG8_SA(1, 0), cA + kstep, 0, false); PG8_STAGE(PG8_SB(1, 1), cB + hstep + kstep, voffB);
        PG8_WAIT_V(6); PG8_BAR;
    } else {
        PG8_STAGE(PG8_SB(0, 0), cB, voffB); PG8_STAGE(PG8_SA(0, 0), cA, voffA); PG8_STAGE(PG8_SB(0, 1), cB + hstep, voffB); PG8_STAGE(PG8_SA(0, 1), cA + hstep, voffA);
        if (wr == 1) PG8_BAR;
        PG8_WAIT_V(4); PG8_BAR;
        PG8_STAGE(PG8_SB(1, 0), cB + kstep, voffB); PG8_STAGE(PG8_SA(1, 0), cA + kstep, voffA); PG8_STAGE(PG8_SB(1, 1), cB + hstep + kstep, voffB);
        PG8_WAIT_V(6); PG8_BAR;
    }
    for (;;) {
        const bool has_next = S.next(ui + 1, nxt);
        const char* nA = GATHER ? (const char*)g.A : (has_next ? (const char*)g.A + (size_t)nxt.pm * tstep : cA);
        if constexpr (GATHER) { if (has_next) { PG8_GOFF(vGn, ui + 1); } else {
#pragma unroll
            for (int h_ = 0; h_ < 2; ++h_) { vGn[h_][0] = vGc[h_][0]; vGn[h_][1] = vGc[h_][1]; } } } const char* nB = has_next ? (const char*)g.Bt + (g.pm_per_grp ? (size_t)(nxt.pm / g.pm_per_grp) * g.grp_stride * 2 : (size_t)0) + (size_t)nxt.pn * tstep : cB;
        for (int t = 0; t < nt; t += 2) {
            const bool last = (t == nt - 2);
            const char* a1 = cA + (size_t)(t + 1) * kstep;
            const char* a2 = last ? nA : cA + (size_t)(t + 2) * kstep; const char* b2 = last ? nB : cB + (size_t)(t + 2) * kstep;
            const char* a3 = a2 + kstep; const char* b3 = b2 + kstep;
            if (last && has_next) S.a_ready(nxt);
            if constexpr (SP2) {
            PG8_LDB(B0, 0, 0); PG8_LDB(B1, 0, 1); PG8_SCHED; PG8_LDA(At, 0, 0); PG8_STAGE_A(PG8_SA(1, 1), a1, 1, false);
            PG8_WAIT_V(8); PG8_WAIT_L(0); PG8_BAR; PG8_MMA(0, 0, At, B0); PG8_MMA(0, 1, At, B1); PG8_BAR; PG8_SCHED;
            PG8_LDA(At, 0, 1); PG8_STAGE(PG8_SB(0, 0), b2, voffB); PG8_STAGE(PG8_SB(0, 1), b2 + hstep, voffB); PG8_STAGE_A(PG8_SA(0, 0), a2, 0, last);
            PG8_WAIT_V(8); PG8_WAIT_L(0); PG8_BAR; PG8_MMA(1, 0, At, B0); PG8_MMA(1, 1, At, B1); PG8_BAR; PG8_SCHED;
            PG8_LDB(B0, 1, 0); PG8_LDB(B1, 1, 1); PG8_SCHED; PG8_LDA(At, 1, 0); PG8_STAGE_A(PG8_SA(0, 1), a2, 1, last);
            PG8_WAIT_V(8); PG8_WAIT_L(0); PG8_BAR; PG8_MMA(0, 0, At, B0); PG8_MMA(0, 1, At, B1); PG8_BAR; PG8_SCHED;
            PG8_LDA(At, 1, 1); PG8_STAGE(PG8_SB(1, 0), b3, voffB); PG8_STAGE(PG8_SB(1, 1), b3 + hstep, voffB); PG8_STAGE_A(PG8_SA(1, 0), a3, 0, last);
            PG8_WAIT_V(8); PG8_WAIT_L(0); PG8_BAR; PG8_MMA(1, 0, At, B0); PG8_MMA(1, 1, At, B1); PG8_BAR; PG8_SCHED;
            } else {
            PG8_LDB(B0, 0, 0); PG8_SCHED; PG8_LDA(At, 0, 0); PG8_STAGE(PG8_SA(1, 1), a1 + hstep, voffA);
            PG8_WAIT_L(8); PG8_BAR; PG8_WAIT_L(0); PG8_MMA(0, 0, At, B0); PG8_BAR; PG8_SCHED;
            PG8_LDB(B1, 0, 1); PG8_STAGE(PG8_SB(0, 0), b2, voffB);
            PG8_BAR; PG8_WAIT_L(0); PG8_MMA(0, 1, At, B1); PG8_BAR;
            PG8_LDA(At, 0, 1); PG8_STAGE(PG8_SA(0, 0), a2, voffA);
            PG8_BAR; PG8_WAIT_L(0); PG8_MMA(1, 0, At, B0); PG8_BAR; PG8_SCHED;
            PG8_STAGE(PG8_SB(0, 1), b2 + hstep, voffB);
            PG8_WAIT_V(6); PG8_BAR; PG8_MMA(1, 1, At, B1); PG8_BAR;
            PG8_LDB(B0, 1, 0); PG8_SCHED; PG8_LDA(At, 1, 0); PG8_STAGE(PG8_SA(0, 1), a2 + hstep, voffA);
            PG8_WAIT_L(8); PG8_BAR; PG8_WAIT_L(0); PG8_MMA(0, 0, At, B0); PG8_BAR; PG8_SCHED;
            PG8_LDB(B1, 1, 1); PG8_STAGE(PG8_SB(1, 0), b3, voffB);
            PG8_BAR; PG8_WAIT_L(0); PG8_MMA(0, 1, At, B1); PG8_BAR;
            PG8_LDA(At, 1, 1); PG8_STAGE(PG8_SA(1, 0), a3, voffA);
            PG8_BAR; PG8_WAIT_L(0); PG8_MMA(1, 0, At, B0); PG8_BAR; PG8_SCHED;
            PG8_STAGE(PG8_SB(1, 1), b3 + hstep, voffB);
            PG8_WAIT_V(6); PG8_BAR; PG8_MMA(1, 1, At, B1); PG8_BAR;
            }
        }
        if constexpr (ALIGN_EPI) { if (wr == 0) PG8_BAR; }
        if constexpr (!Epi::AFTER_DRAIN) { E(acc, cur, wr, wc, fr, fq); S.done(cur); }
        if (!has_next) break;
#pragma unroll
        for (int a = 0; a < 2; ++a)
#pragma unroll
            for (int b = 0; b < 2; ++b)
#pragma unroll
                for (int m = 0; m < 4; ++m)
#pragma unroll
                    for (int n = 0; n < 2; ++n) acc[a][b][m][n] = (f32x4){0.f, 0.f, 0.f, 0.f};
        cur = nxt; cA = nA; cB = nB; ++ui;
        if constexpr (GATHER) {
#pragma unroll
            for (int h_ = 0; h_ < 2; ++h_) { vGc[h_][0] = vGn[h_][0]; vGc[h_][1] = vGn[h_][1]; } }
        if constexpr (ALIGN_EPI) { if (wr == 1) PG8_BAR; }
    }
    PG8_WAIT_V(0);
    if constexpr (!ALIGN_EPI) { if (wr == 0) PG8_BAR; }
    PG8_BAR;
    if constexpr (Epi::AFTER_DRAIN) { E.fused(acc, cur, wr, wc, fr, fq, lds, wid, lane); S.done(cur); }
#undef PG8_GOFF
#undef PG8_STAGE_A
#undef PG8_SA
#undef PG8_SB
#undef PG8_STAGE
#undef PG8_LDA
#undef PG8_LDB
#undef PG8_MMA
#undef PG8_WAIT_V
#undef PG8_WAIT_L
#undef PG8_BAR
#undef PG8_SCHED
}
}
#ifndef USE_PG8
#define USE_PG8 1
#endif

typedef const f32x4 (&AccRef)[2][2][4][2];
struct EpiStoreBf16 { static constexpr bool DUAL = false, PERM = true, AFTER_DRAIN = false; bf16* O; int ldc;
    __device__ __forceinline__ void elem(int row, int col, float v, float) const { O[(size_t)row * ldc + col] = (bf16)f2bf(v); }
    __device__ __forceinline__ void operator()(AccRef acc, const pg8::Unit& u, int wr, int wc, int fr, int fq) const {
        const int row0 = u.pm * 256 + wr * 64 + fr, col0 = u.pn * 256 + wc * 32 + 8 * fq;
#pragma unroll
        for (int ai = 0; ai < 2; ++ai)
#pragma unroll
            for (int m = 0; m < 4; ++m) { bf16* rowp = O + (size_t)(row0 + ai * 128 + m * 16) * ldc + col0;
#pragma unroll
                for (int bj = 0; bj < 2; ++bj) { const f32x4 v0 = acc[ai][bj][m][0], v1 = acc[ai][bj][m][1];
                    u32x4 w; w.x = cvt_pk_bf16(v0[0], v0[1]); w.y = cvt_pk_bf16(v0[2], v0[3]); w.z = cvt_pk_bf16(v1[0], v1[1]); w.w = cvt_pk_bf16(v1[2], v1[3]);
                    *(u32x4*)(rowp + bj * 128) = w; } }
    } };
struct EpiStoreHeads { static constexpr bool DUAL = false, PERM = true, AFTER_DRAIN = false; bf16* O; int hw; size_t hstride;
    __device__ __forceinline__ void store4(int row, int col, f32x4 v) const { const int hd = col / hw, wi = col - hd * hw; u32x2 o; o.x = cvt_pk_bf16(v[0], v[1]); o.y = cvt_pk_bf16(v[2], v[3]); *(u32x2*)(O + (size_t)hd * hstride + (size_t)row * hw + wi) = o; }
    __device__ __forceinline__ void elem(int row, int col, float v, float) const { O[(size_t)(col / hw) * hstride + (size_t)row * hw + (col % hw)] = (bf16)f2bf(v); }
    __device__ __forceinline__ void operator()(AccRef acc, const pg8::Unit& u, int wr, int wc, int fr, int fq) const {
        const int row0 = u.pm * 256 + wr * 64 + fr, col0 = u.pn * 256 + wc * 32 + 8 * fq;
#pragma unroll
        for (int bj = 0; bj < 2; ++bj) { const int c = col0 + bj * 128, hd = c / hw, wi = c - hd * hw; bf16* base = O + (size_t)hd * hstride + wi;
#pragma unroll
            for (int ai = 0; ai < 2; ++ai)
#pragma unroll
                for (int m = 0; m < 4; ++m) { const f32x4 v0 = acc[ai][bj][m][0], v1 = acc[ai][bj][m][1];
                    u32x4 w; w.x = cvt_pk_bf16(v0[0], v0[1]); w.y = cvt_pk_bf16(v0[2], v0[3]); w.z = cvt_pk_bf16(v1[0], v1[1]); w.w = cvt_pk_bf16(v1[2], v1[3]);
                    *(u32x4*)(base + (size_t)(row0 + ai * 128 + m * 16) * hw) = w; } }
    } };
struct EpiStoreF32 { static constexpr bool DUAL = false, PERM = false, AFTER_DRAIN = false; float* O; int ldc;
    __device__ __forceinline__ void store4(int row, int col, f32x4 v) const { *(f32x4*)(O + (size_t)row * ldc + col) = v; }
    __device__ __forceinline__ void elem(int row, int col, float v, float) const { O[(size_t)row * ldc + col] = v; }
    __device__ __forceinline__ void operator()(AccRef acc, const pg8::Unit& u, int wr, int wc, int fr, int fq) const {
        const int row0 = u.pm * 256 + wr * 64 + fr, col0 = u.pn * 256 + wc * 32 + 4 * fq;
#pragma unroll
        for (int ai = 0; ai < 2; ++ai)
#pragma unroll
            for (int m = 0; m < 4; ++m) { float* rowp = O + (size_t)(row0 + ai * 128 + m * 16) * ldc + col0;
#pragma unroll
                for (int bj = 0; bj < 2; ++bj)
#pragma unroll
                    for (int n = 0; n < 2; ++n) *(f32x4*)(rowp + bj * 128 + n * 16) = acc[ai][bj][m][n]; }
    } };
struct EpiResid { static constexpr bool DUAL = false, PERM = false, AFTER_DRAIN = false; float* X; const float* g_lat; const float* g_ctx;
    __device__ __forceinline__ void store4(int row, int col, f32x4 v) const { const float* g = row >= SEQ ? g_ctx : g_lat; f32x4* p = (f32x4*)(X + (size_t)row * D + col); *p = *p + *(const f32x4*)(g + col) * v; }
    __device__ __forceinline__ void elem(int row, int col, float v, float) const { const float g = row >= SEQ ? g_ctx[col] : g_lat[col]; X[(size_t)row * D + col] += g * v; }
    __device__ __forceinline__ void operator()(AccRef acc, const pg8::Unit& u, int wr, int wc, int fr, int fq) const {
        const int row0 = u.pm * 256 + wr * 64 + fr, col0 = u.pn * 256 + wc * 32 + 4 * fq;
        const float* g = (u.pm * 256 >= SEQ) ? g_ctx : g_lat;
        f32x4 gv[2][2];
#pragma unroll
        for (int bj = 0; bj < 2; ++bj)
#pragma unroll
            for (int n = 0; n < 2; ++n) gv[bj][n] = *(const f32x4*)(g + col0 + bj * 128 + n * 16);
#pragma unroll
        for (int ai = 0; ai < 2; ++ai)
#pragma unroll
            for (int m = 0; m < 4; ++m) { float* rowp = X + (size_t)(row0 + ai * 128 + m * 16) * D + col0;
#pragma unroll
                for (int bj = 0; bj < 2; ++bj)
#pragma unroll
                    for (int n = 0; n < 2; ++n) { f32x4* p = (f32x4*)(rowp + bj * 128 + n * 16); *p = *p + gv[bj][n] * acc[ai][bj][m][n]; } }
    } };
__device__ __forceinline__ float silu_mul(float g, float u) { return g * __builtin_amdgcn_rcpf(1.f + __expf(-g)) * u; }
struct EpiSwiglu { static constexpr bool DUAL = true, PERM = true, AFTER_DRAIN = false; bf16* ACT;
    __device__ __forceinline__ void elem(int row, int col, float g, float u) const { ACT[(size_t)row * FF + col] = (bf16)f2bf(g / (1.f + __expf(-g)) * u); }
    __device__ __forceinline__ void operator()(AccRef acc, const pg8::Unit& u, int wr, int wc, int fr, int fq) const {
        const int row0 = u.pm * 256 + wr * 64 + fr, col0 = u.pn * 128 + wc * 32 + 8 * fq;
#pragma unroll
        for (int ai = 0; ai < 2; ++ai)
#pragma unroll
            for (int m = 0; m < 4; ++m) { bf16* rowp = ACT + (size_t)(row0 + ai * 128 + m * 16) * FF + col0;
                const f32x4 g0 = acc[ai][0][m][0], g1 = acc[ai][0][m][1], u0 = acc[ai][1][m][0], u1 = acc[ai][1][m][1];
                u32x4 w; w.x = cvt_pk_bf16(silu_mul(g0[0], u0[0]), silu_mul(g0[1], u0[1])); w.y = cvt_pk_bf16(silu_mul(g0[2], u0[2]), silu_mul(g0[3], u0[3]));
                w.z = cvt_pk_bf16(silu_mul(g1[0], u1[0]), silu_mul(g1[1], u1[1])); w.w = cvt_pk_bf16(silu_mul(g1[2], u1[2]), silu_mul(g1[3], u1[3]));
                *(u32x4*)rowp = w; }
    } };
struct EpiMoeOut { static constexpr bool DUAL = false, PERM = true, AFTER_DRAIN = false; bf16* YB; const float* gatel;
    __device__ __forceinline__ void elem(int row, int col, float v, float) const { YB[(size_t)row * D + col] = (bf16)f2bf(v * gatel[row]); }
    __device__ __forceinline__ void operator()(AccRef acc, const pg8::Unit& u, int wr, int wc, int fr, int fq) const {
        const int row0 = u.pm * 256 + wr * 64 + fr, col0 = u.pn * 256 + wc * 32 + 8 * fq;
#pragma unroll
        for (int ai = 0; ai < 2; ++ai)
#pragma unroll
            for (int m = 0; m < 4; ++m) { const int row = row0 + ai * 128 + m * 16; const float gt = gatel[row]; bf16* rowp = YB + (size_t)row * D + col0;
#pragma unroll
                for (int bj = 0; bj < 2; ++bj) { const f32x4 v0 = acc[ai][bj][m][0] * gt, v1 = acc[ai][bj][m][1] * gt;
                    u32x4 w; w.x = cvt_pk_bf16(v0[0], v0[1]); w.y = cvt_pk_bf16(v0[2], v0[3]); w.z = cvt_pk_bf16(v1[0], v1[1]); w.w = cvt_pk_bf16(v1[2], v1[3]);
                    *(u32x4*)(rowp + bj * 128) = w; } }
    } };

template <class Epi>
__device__ __forceinline__ void naive_gemm(const Ctx& C, const bf16* A, const bf16* Bt, int M, int N, int K, int pm_per_grp, size_t grp_stride, const Epi& E) {
    LAS float* As = (LAS float*)C.lds;
    LAS float* Bs = As + 16 * 132;
    LAS float* Bs2 = Bs + 16 * 68;
    const int NO = Epi::DUAL ? N / 2 : N, tn_cnt = NO / 64, nun = (M / 128) * tn_cnt;
    const int ty = C.tid >> 4, tx = C.tid & 15;
    for (int u = C.blk; u < nun; u += C.G) {
        const int tm = u / tn_cnt, tn = u % tn_cnt, row0 = tm * 128, oc0 = tn * 64;
        const bf16* Bg = Bt + (pm_per_grp ? (size_t)((row0 / 256) / pm_per_grp) * grp_stride : (size_t)0);
        const int brow0 = Epi::DUAL ? ((oc0 >> 7) * 256 + (oc0 & 127)) : oc0;
        float acc[4][4], acc2[4][4];
#pragma unroll
        for (int i = 0; i < 4; ++i)
#pragma unroll
            for (int j = 0; j < 4; ++j) { acc[i][j] = 0.f; acc2[i][j] = 0.f; }
        for (int k0 = 0; k0 < K; k0 += 16) {
            __syncthreads();
            { const int r = C.tid >> 2, kc = (C.tid & 3) * 4;
              const u32x2 w = *(const u32x2*)(A + (size_t)(row0 + r) * K + k0 + kc);
              As[(kc + 0) * 132 + r] = bf2f(w.x & 0xffffu); As[(kc + 1) * 132 + r] = bf2f(w.x >> 16); As[(kc + 2) * 132 + r] = bf2f(w.y & 0xffffu); As[(kc + 3) * 132 + r] = bf2f(w.y >> 16); }
            if (C.tid < 256) { const int r = C.tid >> 2, kc = (C.tid & 3) * 4;
              const u32x2 w = *(const u32x2*)(Bg + (size_t)(brow0 + r) * K + k0 + kc);
              Bs[(kc + 0) * 68 + r] = bf2f(w.x & 0xffffu); Bs[(kc + 1) * 68 + r] = bf2f(w.x >> 16); Bs[(kc + 2) * 68 + r] = bf2f(w.y & 0xffffu); Bs[(kc + 3) * 68 + r] = bf2f(w.y >> 16);
              if (Epi::DUAL) { const u32x2 w2 = *(const u32x2*)(Bg + (size_t)(brow0 + 128 + r) * K + k0 + kc);
                Bs2[(kc + 0) * 68 + r] = bf2f(w2.x & 0xffffu); Bs2[(kc + 1) * 68 + r] = bf2f(w2.x >> 16); Bs2[(kc + 2) * 68 + r] = bf2f(w2.y & 0xffffu); Bs2[(kc + 3) * 68 + r] = bf2f(w2.y >> 16); } }
            __syncthreads();
#pragma unroll
            for (int kk = 0; kk < 16; ++kk) {
                const f32x4 a = *(const LAS f32x4*)(As + kk * 132 + ty * 4), b = *(const LAS f32x4*)(Bs + kk * 68 + tx * 4);
#pragma unroll
                for (int i = 0; i < 4; ++i)
#pragma unroll
                    for (int j = 0; j < 4; ++j) acc[i][j] += a[i] * b[j];
                if (Epi::DUAL) { const f32x4 b2 = *(const LAS f32x4*)(Bs2 + kk * 68 + tx * 4);
#pragma unroll
                    for (int i = 0; i < 4; ++i)
#pragma unroll
                        for (int j = 0; j < 4; ++j) acc2[i][j] += a[i] * b2[j]; }
            }
        }
#pragma unroll
        for (int i = 0; i < 4; ++i)
#pragma unroll
            for (int j = 0; j < 4; ++j) E.elem(row0 + ty * 4 + i, oc0 + tx * 4 + j, acc[i][j], acc2[i][j]);
    }
    __syncthreads();
}

template <class Epi>
__device__ __forceinline__ void gemm(const Ctx& C, const bf16* A, const bf16* Bt, int M, int N, int K, int pm_per_grp, size_t grp_stride, const Epi& E) {
#if USE_PG8
    pg8::Gemm g{A, Bt, M, N, K, pm_per_grp, grp_stride}; pg8::StaticOrder S; S.init(M, N, C.G, C.blk);
    pg8::gemm_phase<Epi, pg8::StaticOrder, true, true>(C.lds, g, S, E);
#else
    naive_gemm(C, A, Bt, M, N, K, pm_per_grp, grp_stride, E);
#endif
}
template <class Epi>
__device__ __forceinline__ void small_gemm(const Ctx& C, const bf16* A, const bf16* Bt, int row0, int nrows, int N, int K, const Epi& E) {
    const int ql = C.lane & 31, hi = C.lane >> 5, nrb = nrows / 32, nitems = nrb * (N / 32);
    for (int it = C.blk * 8 + C.wave; it < nitems; it += C.G * 8) {
        const int cb = it / nrb, rb = it % nrb;
        const bf16* ap = A + (size_t)(row0 + rb * 32 + ql) * K + 8 * hi; const bf16* bp = Bt + (size_t)(cb * 32 + ql) * K + 8 * hi;
        f32x16 acc;
#pragma unroll
        for (int r = 0; r < 16; ++r) acc[r] = 0.f;
#pragma unroll 1
        for (int k0 = 0; k0 < K; k0 += 256) {
            bf16x8 a[16], b[16];
#pragma unroll
            for (int q = 0; q < 16; ++q) { a[q] = *(const bf16x8*)(ap + k0 + 16 * q); b[q] = *(const bf16x8*)(bp + k0 + 16 * q); }
            __builtin_amdgcn_sched_barrier(0);
#pragma unroll
            for (int q = 0; q < 16; ++q) acc = __builtin_amdgcn_mfma_f32_32x32x16_bf16(b[q], a[q], acc, 0, 0, 0);
            __builtin_amdgcn_sched_barrier(0);
        }
        const int row = row0 + rb * 32 + ql;
#pragma unroll
        for (int g = 0; g < 4; ++g) E.store4(row, cb * 32 + 8 * g + 4 * hi, (f32x4){acc[4 * g], acc[4 * g + 1], acc[4 * g + 2], acc[4 * g + 3]});
    }
}
template <class Epi>
__device__ __forceinline__ void gemm_tok(const Ctx& C, const bf16* A, const bf16* Bt, int N, int K, bool with_ctx, const Epi& E) {
#if USE_PG8
    gemm(C, A, Bt, SEQ, N, K, 0, 0, E);
    if (with_ctx) small_gemm(C, A, Bt, SEQ, NCTX, N, K, E);
#else
    naive_gemm(C, A, Bt, with_ctx ? R : SEQ, N, K, 0, 0, E);
#endif
}
constexpr int LDS_IDX_OFF = 132096;
template <class Epi>
__device__ __forceinline__ void gemm_moe(const Ctx& C, const bf16* A, const bf16* Bt, int N, int K, size_t grp_stride, bool with_ctx, const Epi& E, const int* rowlist = nullptr) {
#if USE_PG8
    pg8::Gemm g{A, Bt, XROWS, N, K, 9, grp_stride}; pg8::MoeOrder S; S.init(N, C.G, C.blk, with_ctx);
    if (rowlist) {
        LAS int* tab = (LAS int*)(C.lds + LDS_IDX_OFF); pg8::Unit u;
        for (int i = 0; S.next(i, u); ++i) if (C.tid < 256) tab[i * 256 + C.tid] = rowlist[u.pm * 256 + C.tid];
        __syncthreads();
        pg8::gemm_phase<Epi, pg8::MoeOrder, true, true, true>(C.lds, g, S, E, tab);
        return;
    }
    pg8::gemm_phase<Epi, pg8::MoeOrder, true, true>(C.lds, g, S, E);
#else
    naive_gemm(C, A, Bt, XROWS, N, K, 9, grp_stride, E);
#endif
}

template <int KIND>
__device__ __forceinline__ void ph_attn_naive(const Ctx& C, int slot) {
    constexpr int DQK = KIND == 2 ? 96 : 64, DH = DQK / 2;
    LAS float* Ks = (LAS float*)C.lds;
    LAS float* Vs = Ks + 32 * DQK;
    LAS float* Bsm = Vs + 32 * 64;
    const bf16 *Qb, *Kb, *Vb, *KRb = nullptr; int qp, kp, vp, kgrp = 1; size_t qhs, khs, vhs; float scale;
    if (KIND == 0) { Qb = WSP(bf16, WS_QKV); Kb = Qb + (size_t)16 * R * 64; Vb = Qb + (size_t)32 * R * 64; qp = kp = vp = 64; qhs = khs = vhs = (size_t)R * 64; scale = 0.125f; }
    else if (KIND == 1) { Qb = WSP(bf16, WS_QKV); Kb = Qb + (size_t)16 * R * 64; Vb = Qb + (size_t)20 * R * 64; qp = kp = vp = 64; qhs = khs = vhs = (size_t)R * 64; kgrp = 4; scale = 0.125f; }
    else { Qb = WSP(bf16, WS_Q); Kb = WSP(bf16, WS_KV); Vb = Kb + 64; KRb = WSP(bf16, WS_KROPE); qp = 96; kp = vp = 128; qhs = (size_t)R * 96; khs = vhs = (size_t)R * 128; scale = 0.10206207261596575f; }
    bf16* Ob = WSP(bf16, WS_O);
    const int half = C.tid & 1, qi = C.tid >> 1;
    for (int u = C.blk; u < 1040; u += C.G) {
        const bool isctx = u >= 1024;
        const int h = isctx ? (u - 1024) : (u & 15), q0 = isctx ? SEQ : (u >> 4) * 256, kh = h / kgrp;
        const int t = q0 + qi;
        float q[DH], o[32];
        { const bf16* qr = Qb + (size_t)t * qp + h * qhs + half * DH;
#pragma unroll
          for (int d = 0; d < DH; d += 8) { const u32x4 w = *(const u32x4*)(qr + d);
              q[d + 0] = bf2f(w.x & 0xffffu); q[d + 1] = bf2f(w.x >> 16); q[d + 2] = bf2f(w.y & 0xffffu); q[d + 3] = bf2f(w.y >> 16);
              q[d + 4] = bf2f(w.z & 0xffffu); q[d + 5] = bf2f(w.z >> 16); q[d + 6] = bf2f(w.w & 0xffffu); q[d + 7] = bf2f(w.w >> 16); } }
#pragma unroll
        for (int d = 0; d < 32; ++d) o[d] = 0.f;
        float m = -INFINITY, l = 0.f;
        if (KIND == 1) { m = C.in[13][h]; l = 1.f; }
        int klo = 0, khi = 0;
        if (!isctx) {
            if (KIND == 0) { const int r0 = q0 >> 6; const int ra = r0 - 4 < 0 ? 0 : r0 - 4, rb = r0 + 7 > 255 ? 255 : r0 + 7; klo = ra * 64; khi = (rb + 1) * 64; }
            else if (KIND == 1) { klo = q0 - 128 < 0 ? 0 : q0 - 128; khi = q0 + 384 > SEQ ? SEQ : q0 + 384; }
            else { klo = 0; khi = SEQ; }
        }
        if (KIND == 0) { __syncthreads(); const float* rp = C.in[10] + ((size_t)slot * 16 + h) * 465; for (int i = C.tid; i < 465; i += 512) Bsm[i] = rp[i]; }
        const int qr_ = t >> 6, qc_ = t & 63;
        int rs = qr_ - 4; rs = rs < 0 ? 0 : (rs > 248 ? 248 : rs);
        int cs0 = qc_ - 8; cs0 = cs0 < 0 ? 0 : (cs0 > 48 ? 48 : cs0);
        for (int seg = 0; seg < 2; ++seg) {
            const int kb = seg == 0 ? klo : SEQ, ke = seg == 0 ? khi : R;
            for (int k0 = kb; k0 < ke; k0 += 32) {
                __syncthreads();
                for (int i = C.tid; i < 32 * DQK; i += 512) { const int j = i / DQK, d = i % DQK; const int row = k0 + j;
                    unsigned b;
                    if (KIND == 2 && d >= 64) b = KRb[(size_t)row * 32 + (d - 64)]; else b = Kb[(size_t)row * kp + kh * khs + d];
                    Ks[i] = bf2f(b); }
                for (int i = C.tid; i < 32 * 64; i += 512) { const int j = i >> 6, d = i & 63; Vs[i] = bf2f(Vb[(size_t)(k0 + j) * vp + kh * vhs + d]); }
                __syncthreads();
#pragma unroll 1
                for (int j = 0; j < 32; ++j) {
                    const int kt = k0 + j; bool valid = true; float bias = 0.f;
                    if (seg == 0) {
                        if (KIND == 0) { const int kr = kt >> 6, kc = kt & 63; valid = kr >= rs && kr < rs + 8 && kc >= cs0 && kc < cs0 + 16;
                            if (valid) bias = Bsm[(kr - qr_ + 7) * 31 + (kc - qc_ + 15)]; }
                        else if (KIND == 1) { const int dd = kt - t; valid = dd <= 128 && dd >= -128; }
                    }
                    float s0 = 0.f, s1 = 0.f;
#pragma unroll
                    for (int d = 0; d < DH; d += 4) { const f32x4 kv = *(const LAS f32x4*)(Ks + j * DQK + half * DH + d); s0 += q[d] * kv.x + q[d + 2] * kv.z; s1 += q[d + 1] * kv.y + q[d + 3] * kv.w; }
                    float sp = s0 + s1; sp += __shfl_xor(sp, 1);
                    if (valid) {
                        const float s = sp * scale + bias;
                        if (s > m) { const float a = __expf(m - s); l *= a;
#pragma unroll
                            for (int d = 0; d < 32; ++d) o[d] *= a;
                            m = s; }
                        const float p = __expf(s - m); l += p;
#pragma unroll
                        for (int d = 0; d < 32; d += 4) { const f32x4 vv = *(const LAS f32x4*)(Vs + j * 64 + half * 32 + d); o[d] += p * vv.x; o[d + 1] += p * vv.y; o[d + 2] += p * vv.z; o[d + 3] += p * vv.w; }
                    }
                }
            }
        }
        { const float il = 1.f / l; bf16* orow = Ob + (size_t)t * D + h * 64 + half * 32;
#pragma unroll
            for (int d = 0; d < 32; d += 8) { u32x4 w; w.x = pk2(o[d] * il, o[d + 1] * il); w.y = pk2(o[d + 2] * il, o[d + 3] * il); w.z = pk2(o[d + 4] * il, o[d + 5] * il); w.w = pk2(o[d + 6] * il, o[d + 7] * il);
                *(u32x4*)(orow + d) = w; } }
    }
    __syncthreads();
}

#ifndef USE_FAST_ATTN
#define USE_FAST_ATTN 1
#endif
__device__ __forceinline__ s16x4 lds_tr16(const LAS unsigned char* p) { return __builtin_bit_cast(s16x4, __builtin_amdgcn_ds_read_tr16_b64_v4i16((LAS s16x4*)p)); }
__device__ __forceinline__ int crow(int r, int hi) { return (r & 3) + 8 * (r >> 2) + 4 * hi; }

#define ATT_BAR() do { __builtin_amdgcn_sched_barrier(0); asm volatile("s_waitcnt lgkmcnt(0)\n\ts_barrier" ::: "memory"); __builtin_amdgcn_sched_barrier(0); } while (0)
template <int KIND, int VARIANT = 0>
__device__ __forceinline__ void ph_attn_fast(const Ctx& C, int slot, bool with_ctxq, int conv_layer = -1) {
    constexpr int DQK = KIND == 2 ? 96 : 64, NS = DQK / 16, CPR = DQK / 8, CPRP = CPR + (KIND == 2 ? 1 : 0);
    constexpr int KS = CPRP * 16, VS = 128, KBYTES = 64 * KS, VBYTES = 64 * VS, SLOTB = KBYTES + VBYTES;
    constexpr int NKC = 64 * CPRP, NINST = (NKC + 64 * 8) / 64, NDMA = (NINST + 7) / 8, NRING = 4, PD = 3;
    static_assert(NKC % 64 == 0 && SLOTB % 1024 == 0 && NRING * SLOTB + 2048 <= 131072, "attention ring geometry");
    LAS unsigned char* lds = C.lds; const unsigned lds_u32 = (unsigned)(size_t)C.lds;
    LAS float* Bsm = (LAS float*)(lds + NRING * SLOTB);
    const bf16 *Qb, *Kb, *Vb, *KRb = nullptr; int qp, kp, vp, kgrp = 1; size_t qhs, khs, vhs; float scale;
    if (KIND == 0) { Qb = WSP(bf16, WS_QKV); Kb = Qb + (size_t)16 * R * 64; Vb = Qb + (size_t)32 * R * 64; qp = kp = vp = 64; qhs = khs = vhs = (size_t)R * 64; scale = 0.125f; }
    else if (KIND == 1) { Qb = WSP(bf16, WS_QKV); Kb = Qb + (size_t)16 * R * 64; Vb = Qb + (size_t)20 * R * 64; qp = kp = vp = 64; qhs = khs = vhs = (size_t)R * 64; kgrp = 4; scale = 0.125f; }
    else { Qb = WSP(bf16, WS_Q); Kb = WSP(bf16, WS_KV); Vb = Kb + 64; KRb = WSP(bf16, WS_KROPE); qp = 96; kp = vp = 128; qhs = (size_t)R * 96; khs = vhs = (size_t)R * 128; scale = 0.10206207261596575f; }
    bf16* Ob = VARIANT ? WSP(bf16, WS_ACT) : WSP(bf16, WS_O);
    const float c2 = scale * 1.4426950408889634f;
    const int w = C.wave, lane = C.lane, ql = lane & 31, hi = lane >> 5;
    const int vq_ = (lane & 15) >> 2, vsw_ = 4 * ((vq_ >> 1) & 1), vch_ = 2 * ((lane >> 4) & 1) + ((lane & 3) >> 1);
    const int vlane0 = (vq_ + 4 * hi) * VS + ((0 + vch_) ^ vsw_) * 16 + 8 * (lane & 1), vlane1 = (vq_ + 4 * hi) * VS + ((4 + vch_) ^ vsw_) * 16 + 8 * (lane & 1);
    const int nunits = with_ctxq ? 1040 : 1024;
    ConvState cst; cst.l0 = conv_layer; cst.total = conv_layer < 0 ? 0 : (KIND == 2 ? 2 : 1) * MOE_HALF_ITEMS; cst.cur = C.blk * 8 + C.wave; cst.loaded = false;
    LAS float* cscr = (LAS float*)(C.lds + NRING * SLOTB + 2048 + C.wave * 4096);
    static_assert(NRING * SLOTB + 2048 + 8 * 4096 <= 131072, "conversion scratch");
    static_assert(KIND == 2 || NRING * SLOTB + 2048 == CONV_PIPE_BASE, "pipelined conversion scratch");
    ConvPipe cpipe; cpipe.l0 = conv_layer; cpipe.total = (KIND != 2 && conv_layer >= 0) ? MOE_HALF_ITEMS : 0; cpipe.first = C.blk * 8 + C.wave; cpipe.n = 0;
    const bool convon = cpipe.total > 0; constexpr int CFL = (VARIANT >> 7) & 3;
    for (int u = C.blk; u < nunits; u += C.G) {
        const bool isctx = u >= 1024;
        const int h = isctx ? (u - 1024) : (u & 15), q0 = isctx ? SEQ : (u >> 4) * 256, kh = h / kgrp;
        int lat0 = 0, nlat = 0;
        if (!isctx) {
            if (KIND == 0) { const int r0 = q0 >> 6; int ta = r0 - 4; ta = ta < 0 ? 0 : (ta > 248 ? 248 : ta); int tb = r0 - 1; tb = (tb < 0 ? 0 : (tb > 248 ? 248 : tb)) + 7; lat0 = ta; nlat = tb - ta + 1; }
            else if (KIND == 1) { const int a = q0 - 128 < 0 ? 0 : q0 - 128, b = q0 + 384 > SEQ ? SEQ : q0 + 384; lat0 = a >> 6; nlat = (b - a) >> 6; }
            else { lat0 = 0; nlat = SEQ / 64; }
        }
        const int ntiles = nlat + 4;
        int lane_u = lane; asm volatile("" : "+v"(lane_u));
        const int ql_u = lane_u & 31, hi_u = lane_u >> 5;
        const int t = (KIND == 0 && !isctx) ? q0 + 128 * (w >> 2) + 64 * (ql_u >> 4) + 16 * (w & 3) + (ql_u & 15) : q0 + 32 * w + ql_u;
        bf16x8 qf[NS];
        { const bf16* qr = Qb + (size_t)t * qp + h * qhs + 8 * hi_u;
#pragma unroll
          for (int sidx = 0; sidx < NS; ++sidx) qf[sidx] = *(const bf16x8*)(qr + 16 * sidx); }
        unsigned gsrc[NDMA]; int gpitch[NDMA], ldst[NDMA];
        const char* const wsb = (const char*)C.ws;
#pragma unroll
        for (int jj = 0; jj < NDMA; ++jj) {
            int j = w + 8 * jj; if (j >= NINST) j -= 8;
            const int cidx = 64 * j + lane_u; ldst[jj] = j * 1024;
            if (cidx < NKC) { const int row = cidx / CPRP; int c = cidx % CPRP; if (c >= CPR) c = 0;
                if (KIND != 2) c ^= (row >> 1) & 7;
                if (KIND == 2 && c >= 8) { gsrc[jj] = (unsigned)((const char*)(KRb + (size_t)row * 32 + 8 * (c - 8)) - wsb); gpitch[jj] = 64; }
                else { gsrc[jj] = (unsigned)((const char*)(Kb + kh * khs + (size_t)row * kp + 8 * c) - wsb); gpitch[jj] = kp * 2; } }
            else { const int v = cidx - NKC, row = v >> 3; const int c = (v & 7) ^ (4 * ((row >> 1) & 1));
                gsrc[jj] = (unsigned)((const char*)(Vb + kh * vhs + (size_t)row * vp + 8 * c) - wsb); gpitch[jj] = vp * 2; }
        }
#define ATT_KEY0(i) (KIND == 2 ? (isctx ? SEQ : 0) + (i) * 64 : ((i) < nlat ? (lat0 + (i)) * 64 : SEQ + ((i) - nlat) * 64))
#define ATT_DMA(i, sl) do { const int ti_ = (i) < ntiles ? (i) : ntiles - 1; const unsigned key0_ = (unsigned)ATT_KEY0(ti_); \
        _Pragma("unroll") for (int jj = 0; jj < NDMA; ++jj) \
            __builtin_amdgcn_global_load_lds((const unsigned*)(wsb + (size_t)(gsrc[jj] + __umul24(key0_, (unsigned)gpitch[jj]))), (LAS unsigned*)(lds + (sl) * SLOTB + ldst[jj]), 16, 0, 0); } while (0)
        static_assert(NDMA == (KIND == 2 ? 3 : 2), "the counted waits below are written for these DMA counts");
#define ATT_WAIT_DMA() do { if (NDMA == 2) asm volatile("s_waitcnt vmcnt(4)" ::: "memory"); else asm volatile("s_waitcnt vmcnt(6)" ::: "memory"); } while (0)
#define ATT_WAIT_DMA_IT() do { if (KIND == 2) { ATT_WAIT_DMA(); } else if (convon) { if (CFL == 0) asm volatile("s_waitcnt vmcnt(10)" ::: "memory"); else if (CFL == 1) asm volatile("s_waitcnt vmcnt(8)" ::: "memory"); else if (CFL == 2) asm volatile("s_waitcnt vmcnt(6)" ::: "memory"); else asm volatile("s_waitcnt vmcnt(4)" ::: "memory"); } \
        else asm volatile("s_waitcnt vmcnt(2)" ::: "memory"); } while (0)
        __syncthreads();
        if (KIND == 0) { const float* rp = C.in[10] + ((size_t)slot * 16 + h) * 465; for (int i = C.tid; i < 465; i += 512) Bsm[i] = rp[i] * 1.4426950408889634f; }
        float m = -INFINITY, l = 0.f;
        if (KIND == 1) { m = C.in[13][h] * 1.4426950408889634f; l = hi ? 0.f : 1.f; }
        ATT_DMA(0, 0); ATT_DMA(1, 1); ATT_DMA(2, 2);
        f32x16 ot[2];
#pragma unroll
        for (int r = 0; r < 16; ++r) { ot[0][r] = 0.f; ot[1][r] = 0.f; }
        const int qr_ = t >> 6, qc_ = t & 63;
        int cs0 = qc_ - 8; cs0 = cs0 < 0 ? 0 : (cs0 > 48 ? 48 : cs0);
        const int wrow = (q0 >> 6) + 2 * (w >> 2);
        int wrs = wrow - 4; wrs = wrs < 0 ? 0 : (wrs > 248 ? 248 : wrs);
        int wre = wrow + 1 - 4; wre = (wre < 0 ? 0 : (wre > 248 ? 248 : wre)) + 8;
        int rs = qr_ - 4; rs = rs < 0 ? 0 : (rs > 248 ? 248 : rs);
        const int kc0 = (w & 3) == 0 ? 0 : ((w & 3) == 1 ? 8 : ((w & 3) == 2 ? 24 : 32));
        const int wq0 = q0 + 32 * w;
        if constexpr (KIND == 2) {
            { float qs = 0.f;
#pragma unroll
              for (int sidx = 0; sidx < NS; ++sidx) { u32x4 qw;
#pragma unroll
                  for (int j = 0; j < 4; ++j) { const float q0_ = bf2f((unsigned)(unsigned short)qf[sidx][2 * j]) * c2, q1_ = bf2f((unsigned)(unsigned short)qf[sidx][2 * j + 1]) * c2;
                      const unsigned pw = cvt_pk_bf16(q0_, q1_); qw[j] = pw; const float r0_ = bf2f(pw & 0xffffu), r1_ = bf2f(pw >> 16); qs += r0_ * r0_ + r1_ * r1_; }
                  qf[sidx] = __builtin_bit_cast(bf16x8, qw); }
              const auto sw = __builtin_amdgcn_permlane32_swap(__float_as_uint(qs), __float_as_uint(qs), false, false);
              qs = __uint_as_float(sw[0]) + __uint_as_float(sw[1]);
              const float k2 = __uint_as_float(__hip_atomic_load((unsigned*)(C.ws + WS_CTL) + CW_KMAX + h, __ATOMIC_RELAXED, __HIP_MEMORY_SCOPE_AGENT));
              m = sqrtf(qs * k2) * 1.001f + 0.01f; }
            if (NDMA == 4) asm volatile("s_waitcnt vmcnt(4)" ::: "memory"); else asm volatile("s_waitcnt vmcnt(3)" ::: "memory");
            ATT_BAR();
            f32x16 pa0, pa1, pb0, pb1;
#define MLA_QK(D0, D1, sl) do { const LAS unsigned char* kb_ = lds + (sl) * SLOTB; \
            _Pragma("unroll") for (int r_ = 0; r_ < 16; ++r_) { D0[r_] = -m; D1[r_] = -m; } \
            _Pragma("unroll") for (int sidx = 0; sidx < NS; ++sidx) { \
                const bf16x8 a0_ = *(const LAS bf16x8*)(kb_ + ql * KS + 32 * sidx + 16 * hi); \
                const bf16x8 a1_ = *(const LAS bf16x8*)(kb_ + (32 + ql) * KS + 32 * sidx + 16 * hi); \
                { D0 = __builtin_amdgcn_mfma_f32_32x32x16_bf16(a0_, qf[sidx], D0, 0, 0, 0); \
                       D1 = __builtin_amdgcn_mfma_f32_32x32x16_bf16(a1_, qf[sidx], D1, 0, 0, 0); } } } while (0)
#define VB(x) (((VARIANT) >> (x)) & 1)
#define MLA_KHALF(D0, D1, sl, h0) do { const LAS unsigned char* kq_ = lds + (sl) * SLOTB; \
            _Pragma("unroll") for (int sidx = 0; sidx < NS / 2; ++sidx) { \
                D0[sidx] = *(const LAS bf16x8*)(kq_ + ql * KS + 32 * ((h0) + sidx) + 16 * hi); D1[sidx] = *(const LAS bf16x8*)(kq_ + (32 + ql) * KS + 32 * ((h0) + sidx) + 16 * hi); } } while (0)
#define MLA_ITER(CV, P0, P1, S0, S1, it) do { \
            if (CV && ((it) & 7) == 0) conv_step<false>(C, cst, cscr);            \
            if (!VB(3)) ATT_DMA((it) + 3, ((it) + 3) & 3);                        \
            bf16x8 kb0_[NS / 2], kb1_[NS / 2]; s16x4 vlo_[2][4], vhi_[2][4]; u32x4 pfw_[4]; \
              \
            _Pragma("unroll") for (int r_ = 0; r_ < 16; ++r_) { S0[r_] = -m; S1[r_] = -m; } \
            asm volatile("s_waitcnt lgkmcnt(0)" ::: "memory"); __builtin_amdgcn_sched_barrier(0); \
            _Pragma("unroll") for (int g_ = 0; g_ < 20; ++g_) { \
                if (g_ == 6) { asm volatile("s_waitcnt lgkmcnt(0)" ::: "memory"); __builtin_amdgcn_sched_barrier(0); } \
                if (g_ == 12) { if (!VB(4)) { asm volatile("s_waitcnt vmcnt(3)" ::: "memory"); ATT_BAR(); }         \
                                else { asm volatile("s_waitcnt lgkmcnt(0)" ::: "memory"); __builtin_amdgcn_sched_barrier(0); } } \
                if (g_ == 2) MLA_KHALF(kb0_, kb1_, ((it) + 1) & 3, NS / 2); \
                if (g_ == 16) MLA_KHALF(ka0, ka1, ((it) + 2) & 3, 0); \
                if (g_ < 6) { if (g_ & 1) S1 = __builtin_amdgcn_mfma_f32_32x32x16_bf16(ka1[g_ >> 1], qf[g_ >> 1], S1, 0, 0, 0); else S0 = __builtin_amdgcn_mfma_f32_32x32x16_bf16(ka0[g_ >> 1], qf[g_ >> 1], S0, 0, 0, 0); } \
                else if (g_ < 12) { if (g_ & 1) S1 = __builtin_amdgcn_mfma_f32_32x32x16_bf16(kb1_[(g_ >> 1) - NS / 2], qf[g_ >> 1], S1, 0, 0, 0); else S0 = __builtin_amdgcn_mfma_f32_32x32x16_bf16(kb0_[(g_ >> 1) - NS / 2], qf[g_ >> 1], S0, 0, 0, 0); } \
                else { const int ks_ = (g_ - 12) >> 1, c_ = (g_ - 12) & 1; \
                    const bf16x8 av_ = (bf16x8){vlo_[c_][ks_][0], vlo_[c_][ks_][1], vlo_[c_][ks_][2], vlo_[c_][ks_][3], vhi_[c_][ks_][0], vhi_[c_][ks_][1], vhi_[c_][ks_][2], vhi_[c_][ks_][3]}; \
                    ot[c_] = __builtin_amdgcn_mfma_f32_32x32x16_bf16(av_, __builtin_bit_cast(bf16x8, pfw_[ks_]), ot[c_], 0, 0, 0); } \
                if (g_ < 16) { \
                    _Pragma("unroll") for (int k_ = 2 * g_; k_ < 2 * g_ + 2; ++k_) { \
                        if (k_ < 16) { P0[k_] = __builtin_amdgcn_exp2f(P0[k_]); l += P0[k_]; } \
                        else { P1[k_ - 16] = __builtin_amdgcn_exp2f(P1[k_ - 16]); l += P1[k_ - 16]; } } \
                } \
                  \
                _Pragma("unroll") for (int q_ = 0; q_ < 2; ++q_) { \
                    const int f_ = g_ < 16 ? (g_ >> 2) - 1 : 3, j_ = g_ < 16 ? (g_ & 3) : 2 * (g_ - 16) + q_; \
                    if (g_ >= 4 && g_ < 18 && (g_ >= 16 || q_ == 0)) { \
                        if (f_ < 2) pfw_[f_][j_] = cvt_pk_bf16(P0[8 * f_ + 2 * j_], P0[8 * f_ + 2 * j_ + 1]); \
                        else pfw_[f_][j_] = cvt_pk_bf16(P1[8 * (f_ - 2) + 2 * j_], P1[8 * (f_ - 2) + 2 * j_ + 1]); } } \
                if (g_ == 7) { const unsigned vb_ = lds_u32 + (unsigned)(((it) & 3) * SLOTB + KBYTES); \
                  _Pragma("unroll") for (int c = 0; c < 2; ++c) { const unsigned va_ = vb_ + (unsigned)(c ? vlane1 : vlane0); \
                    _Pragma("unroll") for (int ks = 0; ks < 4; ++ks) { \
                        asm volatile("ds_read_b64_tr_b16 %0, %1 offset:%c2" : "=&v"(vlo_[c][ks]) : "v"(va_), "i"((32 * (ks >> 1) + 16 * (ks & 1)) * VS) : "memory"); \
                        asm volatile("ds_read_b64_tr_b16 %0, %1 offset:%c2" : "=&v"(vhi_[c][ks]) : "v"(va_), "i"((32 * (ks >> 1) + 16 * (ks & 1) + 8) * VS) : "memory"); } } } \
                __builtin_amdgcn_sched_barrier(0); } \
            } while (0)
            MLA_QK(pa0, pa1, 0);
            bf16x8 ka0[NS / 2], ka1[NS / 2];
            MLA_KHALF(ka0, ka1, 1, 0);
            for (int i = 0; i < ntiles; i += 2) {
                MLA_ITER(1, pa0, pa1, pb0, pb1, i);
                MLA_ITER(0, pb0, pb1, pa0, pa1, i + 1);
            }
#undef MLA_KHALF
#undef MLA_QK
#undef MLA_ITER
#undef VB
        } else {
        ATT_WAIT_DMA();
        ATT_BAR();
        int rs_cur = 0, rs_nxt = 3;
        for (int i = 0; i < ntiles; ++i) {
            if (convon) conv_pipe_step<CFL>(C, cpipe, lds);
            ATT_DMA(i + PD, rs_nxt);
            const bool lat = i < nlat; const int key0 = ATT_KEY0(i);
            bool need = true;
            if (lat) { if (KIND == 0) { const int kr = lat0 + i; need = kr >= wrs && kr < wre; }
                       else if (KIND == 1) need = (key0 + 63 >= wq0 - 128) && (key0 <= wq0 + 31 + 128); }
            if (KIND == 0 && lat) {
              if (need) {
                const int kr = lat0 + i;
                const LAS unsigned char* kb = lds + rs_cur * SLOTB + kc0 * KS; const int swz = ((kc0 + ql) >> 1) & 7;
                f32x16 p0;
#pragma unroll
                for (int r = 0; r < 16; ++r) p0[r] = 0.f;
#pragma unroll
                for (int sidx = 0; sidx < NS; ++sidx) {
                    const bf16x8 a0 = *(const LAS bf16x8*)(kb + ql * KS + 16 * ((2 * sidx + hi) ^ swz));
                    p0 = __builtin_amdgcn_mfma_f32_32x32x16_bf16(a0, qf[sidx], p0, 0, 0, 0);
                }
                const bool rowok = kr >= rs && kr < rs + 8;
                float mx = -INFINITY;
#pragma unroll
                for (int r = 0; r < 16; ++r) { const int kc = kc0 + crow(r, hi); const bool v0 = rowok && (unsigned)(kc - cs0) < 16u;
                    const int bi = (kr - qr_ + 7) * 31 + (kc - qc_ + 15);
                    const float s0 = v0 ? p0[r] * c2 + Bsm[v0 ? bi : 0] : -INFINITY; p0[r] = s0; mx = fmaxf(mx, s0); }
                { const auto sw = __builtin_amdgcn_permlane32_swap(__float_as_uint(mx), __float_as_uint(mx), false, false);
                  mx = fmaxf(__uint_as_float(sw[0]), __uint_as_float(sw[1])); }
                const float mn = fmaxf(m, mx), ms = mn == -INFINITY ? 0.f : mn;
                const float alpha = __builtin_amdgcn_exp2f(m - ms);
                if (__builtin_amdgcn_ballot_w64(alpha != 1.f) != 0ull) {
#pragma unroll
                    for (int r = 0; r < 16; ++r) { ot[0][r] *= alpha; ot[1][r] *= alpha; }
                }
                s16x4 vlo[2][2], vhi[2][2];
                { const unsigned vb0 = lds_u32 + (unsigned)(rs_cur * SLOTB + KBYTES + kc0 * VS);
#pragma unroll
                  for (int c = 0; c < 2; ++c) { const unsigned va = vb0 + (unsigned)(c ? vlane1 : vlane0);
#pragma unroll
                    for (int ks = 0; ks < 2; ++ks) {
                        asm volatile("ds_read_b64_tr_b16 %0, %1 offset:%c2" : "=&v"(vlo[c][ks]) : "v"(va), "i"((16 * ks) * VS) : "memory");
                        asm volatile("ds_read_b64_tr_b16 %0, %1 offset:%c2" : "=&v"(vhi[c][ks]) : "v"(va), "i"((16 * ks + 8) * VS) : "memory"); } } }
                __builtin_amdgcn_sched_barrier(0);
                float rs0 = 0.f, rs1 = 0.f;
#pragma unroll
                for (int ks = 0; ks < 2; ++ks) {
#pragma unroll
                    for (int j = 0; j < 8; ++j) { const int r = 8 * ks + j; p0[r] = __builtin_amdgcn_exp2f(p0[r] - ms); if (j & 1) rs1 += p0[r]; else rs0 += p0[r]; }
                    u32x4 pw; const int k8 = 8 * ks;
                    pw.x = cvt_pk_bf16(p0[k8 + 0], p0[k8 + 1]); pw.y = cvt_pk_bf16(p0[k8 + 2], p0[k8 + 3]); pw.z = cvt_pk_bf16(p0[k8 + 4], p0[k8 + 5]); pw.w = cvt_pk_bf16(p0[k8 + 6], p0[k8 + 7]);
                    const bf16x8 pfk = __builtin_bit_cast(bf16x8, pw);
                    if (ks == 0) { asm volatile("s_waitcnt lgkmcnt(0)" ::: "memory"); }
                    __builtin_amdgcn_sched_barrier(0);
                    const bf16x8 av0 = (bf16x8){vlo[0][ks][0], vlo[0][ks][1], vlo[0][ks][2], vlo[0][ks][3], vhi[0][ks][0], vhi[0][ks][1], vhi[0][ks][2], vhi[0][ks][3]};
                    const bf16x8 av1 = (bf16x8){vlo[1][ks][0], vlo[1][ks][1], vlo[1][ks][2], vlo[1][ks][3], vhi[1][ks][0], vhi[1][ks][1], vhi[1][ks][2], vhi[1][ks][3]};
                    ot[0] = __builtin_amdgcn_mfma_f32_32x32x16_bf16(av0, pfk, ot[0], 0, 0, 0);
                    ot[1] = __builtin_amdgcn_mfma_f32_32x32x16_bf16(av1, pfk, ot[1], 0, 0, 0);
                    __builtin_amdgcn_sched_barrier(0);
                }
                l = l * alpha + (rs0 + rs1); m = mn;
              }
            } else if (need) {
                const LAS unsigned char* kb = lds + rs_cur * SLOTB; const LAS unsigned char* vb = kb + KBYTES;
                f32x16 p0, p1;
#pragma unroll
                for (int r = 0; r < 16; ++r) { p0[r] = 0.f; p1[r] = 0.f; }
#pragma unroll
                for (int sidx = 0; sidx < NS; ++sidx) {
                    const int swz = (ql >> 1) & 7;
                    const bf16x8 a0 = *(const LAS bf16x8*)(kb + ql * KS + 16 * ((2 * sidx + hi) ^ swz));
                    const bf16x8 a1 = *(const LAS bf16x8*)(kb + (32 + ql) * KS + 16 * ((2 * sidx + hi) ^ swz));
                    p0 = __builtin_amdgcn_mfma_f32_32x32x16_bf16(a0, qf[sidx], p0, 0, 0, 0);
                    p1 = __builtin_amdgcn_mfma_f32_32x32x16_bf16(a1, qf[sidx], p1, 0, 0, 0);
                }
                float mx = -INFINITY;
                if (KIND == 0) {
#pragma unroll
                    for (int r = 0; r < 16; ++r) {
                        float s0 = p0[r] * c2, s1 = p1[r] * c2;
                        if (lat) { const int kr = lat0 + i; const int kc = crow(r, hi);
                            const bool v0 = (unsigned)(kc - cs0) < 16u, v1 = (unsigned)(kc + 32 - cs0) < 16u;
                            const int bi = (kr - qr_ + 7) * 31 + (kc - qc_ + 15);
                            s0 = v0 ? s0 + Bsm[v0 ? bi : 0] : -INFINITY; s1 = v1 ? s1 + Bsm[v1 ? bi + 32 : 0] : -INFINITY; }
                        p0[r] = s0; p1[r] = s1; mx = fmaxf(fmaxf(mx, s0), s1);
                    }
                } else {
                    if (KIND == 1 && lat) {
#pragma unroll
                        for (int r = 0; r < 16; ++r) { const int dd = key0 + crow(r, hi) - t;
                            p0[r] = (unsigned)(dd + 128) <= 256u ? p0[r] : -INFINITY; p1[r] = (unsigned)(dd + 32 + 128) <= 256u ? p1[r] : -INFINITY; }
                    }
#pragma unroll
                    for (int r = 0; r < 16; ++r) mx = fmaxf(fmaxf(mx, p0[r]), p1[r]);
                    mx *= c2;
                }
                { const auto sw = __builtin_amdgcn_permlane32_swap(__float_as_uint(mx), __float_as_uint(mx), false, false);
                  mx = fmaxf(__uint_as_float(sw[0]), __uint_as_float(sw[1])); }
                const float mn = fmaxf(m, mx), ms = mn == -INFINITY ? 0.f : mn;
                const float alpha = __builtin_amdgcn_exp2f(m - ms);
                if (__builtin_amdgcn_ballot_w64(alpha != 1.f) != 0ull) {
#pragma unroll
                    for (int r = 0; r < 16; ++r) { ot[0][r] *= alpha; ot[1][r] *= alpha; }
                }
                s16x4 vlo[2][4], vhi[2][4];
                { const unsigned vb0 = lds_u32 + (unsigned)(rs_cur * SLOTB + KBYTES);
#pragma unroll
                  for (int c = 0; c < 2; ++c) { const unsigned va = vb0 + (unsigned)(c ? vlane1 : vlane0);
#pragma unroll
                    for (int ks = 0; ks < 4; ++ks) {
                        asm volatile("ds_read_b64_tr_b16 %0, %1 offset:%c2" : "=&v"(vlo[c][ks]) : "v"(va), "i"((32 * (ks >> 1) + 16 * (ks & 1)) * VS) : "memory");
                        asm volatile("ds_read_b64_tr_b16 %0, %1 offset:%c2" : "=&v"(vhi[c][ks]) : "v"(va), "i"((32 * (ks >> 1) + 16 * (ks & 1) + 8) * VS) : "memory"); } } }
                __builtin_amdgcn_sched_barrier(0);
                float rs0 = 0.f, rs1 = 0.f;
#pragma unroll
                for (int ks = 0; ks < 4; ++ks) {
#pragma unroll
                    for (int j = 0; j < 8; ++j) { const int r = 8 * (ks & 1) + j;
                        if (ks < 2) { p0[r] = KIND == 0 ? __builtin_amdgcn_exp2f(p0[r] - ms) : __builtin_amdgcn_exp2f(__builtin_fmaf(p0[r], c2, -ms)); if (j & 1) rs1 += p0[r]; else rs0 += p0[r]; }
                        else { p1[r] = KIND == 0 ? __builtin_amdgcn_exp2f(p1[r] - ms) : __builtin_amdgcn_exp2f(__builtin_fmaf(p1[r], c2, -ms)); if (j & 1) rs1 += p1[r]; else rs0 += p1[r]; } }
                    u32x4 pw; const int k8 = 8 * (ks & 1);
                    if (ks < 2) { pw.x = cvt_pk_bf16(p0[k8 + 0], p0[k8 + 1]); pw.y = cvt_pk_bf16(p0[k8 + 2], p0[k8 + 3]); pw.z = cvt_pk_bf16(p0[k8 + 4], p0[k8 + 5]); pw.w = cvt_pk_bf16(p0[k8 + 6], p0[k8 + 7]); }
                    else { pw.x = cvt_pk_bf16(p1[k8 + 0], p1[k8 + 1]); pw.y = cvt_pk_bf16(p1[k8 + 2], p1[k8 + 3]); pw.z = cvt_pk_bf16(p1[k8 + 4], p1[k8 + 5]); pw.w = cvt_pk_bf16(p1[k8 + 6], p1[k8 + 7]); }
                    const bf16x8 pfk = __builtin_bit_cast(bf16x8, pw);
                    if (ks == 0) { asm volatile("s_waitcnt lgkmcnt(0)" ::: "memory"); }
                    __builtin_amdgcn_sched_barrier(0);
                    const bf16x8 av0 = (bf16x8){vlo[0][ks][0], vlo[0][ks][1], vlo[0][ks][2], vlo[0][ks][3], vhi[0][ks][0], vhi[0][ks][1], vhi[0][ks][2], vhi[0][ks][3]};
                    const bf16x8 av1 = (bf16x8){vlo[1][ks][0], vlo[1][ks][1], vlo[1][ks][2], vlo[1][ks][3], vhi[1][ks][0], vhi[1][ks][1], vhi[1][ks][2], vhi[1][ks][3]};
                    ot[0] = __builtin_amdgcn_mfma_f32_32x32x16_bf16(av0, pfk, ot[0], 0, 0, 0);
                    ot[1] = __builtin_amdgcn_mfma_f32_32x32x16_bf16(av1, pfk, ot[1], 0, 0, 0);
                    __builtin_amdgcn_sched_barrier(0);
                }
                l = l * alpha + (rs0 + rs1); m = mn;
            }
            ATT_WAIT_DMA_IT();
            ATT_BAR();
            rs_cur = (rs_cur + 1) & 3; rs_nxt = (rs_nxt + 1) & 3;
        }
        }
        asm volatile("s_waitcnt vmcnt(0)" ::: "memory");
#undef ATT_KEY0
#undef ATT_DMA
#undef ATT_WAIT_DMA
#undef ATT_WAIT_DMA_IT
        { const auto sw = __builtin_amdgcn_permlane32_swap(__float_as_uint(l), __float_as_uint(l), false, false);
          const float il = 1.f / (__uint_as_float(sw[0]) + __uint_as_float(sw[1])); bf16* orow = Ob + (size_t)t * D + h * 64 + 4 * hi;
#pragma unroll
          for (int c = 0; c < 2; ++c)
#pragma unroll
            for (int g = 0; g < 4; ++g) { u32x2 o2; o2.x = cvt_pk_bf16(ot[c][4 * g] * il, ot[c][4 * g + 1] * il); o2.y = cvt_pk_bf16(ot[c][4 * g + 2] * il, ot[c][4 * g + 3] * il);
                *(u32x2*)(orow + 32 * c + 8 * g) = o2; } }
    }
    if (KIND == 2) { while (cst.loaded || cst.cur < cst.total) conv_step<true>(C, cst, cscr); }
    else if (convon && !VARIANT) conv_pipe_drain(C, cpipe, lds);
    __syncthreads();
}
template <int KIND>
__device__ __forceinline__ void ph_attn(const Ctx& C, int slot, bool with_ctxq, int conv_layer = -1) {
#if USE_FAST_ATTN
    ph_attn_fast<KIND>(C, slot, with_ctxq, conv_layer);
#else
    ph_attn_naive<KIND>(C, slot);
#endif
}

#define PH_BEGIN if (lo <= ph && ph < hi) {
#define PH_END   if (ph + 1 < hi) xcd_barrier(bar); if (DIAG && C.blk == 0 && C.tid == 0) ((unsigned long long*)(C.ws + WS_CTL + 512 * 1024))[ph + 1] = __builtin_amdgcn_s_memrealtime(); } ++ph;
#ifndef DIAG
#define DIAG 0
#define DIAG_PH1 25
#define DIAG_PH2 25
#endif
#ifndef NORM2_VARIANT_PROBE
#define NORM2_VARIANT_PROBE 0
#endif
#ifndef SWA_VARIANT_PROBE
#define SWA_VARIANT_PROBE 0
#endif
#ifndef ATTN_VARIANT_PROBE
#define ATTN_VARIANT_PROBE 0
#endif
#ifndef PROBE_MASK
#define PROBE_MASK 0
#endif
#define PHG(g, ...) PH_BEGIN __VA_ARGS__ PH_END if constexpr (((PROBE_MASK >> (g)) & 1) != 0) { PH_BEGIN __VA_ARGS__ PH_END }
template <int L>
__device__ __forceinline__ void layer_phases(const Ctx& C, const XcdBarrier& bar, int lo, int hi, int& ph) {
    constexpr int l = L, kind = L % 3, slot = L / 3; constexpr bool need_ctx = L < 3; constexpr int RL = need_ctx ? R : SEQ;
    PH_BEGIN ph_rowA<0>(C, l); PH_END
    if constexpr (kind == 0) {
        PHG(1, gemm_tok(C, WSP(bf16, WS_H), WSP(bf16, WS_W_NAQKV) + (size_t)slot * 3072 * 1024, 3072, 1024, true, EpiStoreHeads{WSP(bf16, WS_QKV), 64, (size_t)R * 64});)
        PHG(2, ph_attn<0>(C, slot, need_ctx, l == 0 ? 0 : -1);)
    } else if constexpr (kind == 1) {
        PHG(1, gemm_tok(C, WSP(bf16, WS_H), WSP(bf16, WS_W_SWAQKV), 1536, 1024, true, EpiStoreHeads{WSP(bf16, WS_QKV), 64, (size_t)R * 64});)
        PH_BEGIN ph_rope(C, WSP(bf16, WS_QKV), 64, 20, 0, 16); PH_END
        PHG(3, ph_attn<1>(C, slot, need_ctx, l);)
#if SWA_VARIANT_PROBE
        PH_BEGIN ph_attn_fast<1, SWA_VARIANT_PROBE>(C, slot, need_ctx, (SWA_VARIANT_PROBE & 64) ? l : -1); PH_END
#endif
    } else {
        PHG(1, gemm_tok(C, WSP(bf16, WS_H), WSP(bf16, WS_W_MLAD), 1024, 1024, true, EpiStoreF32{WSP(float, WS_CQ), 1024});)
        PHG(11, ph_mlanorm(C);)
        PHG(1, gemm_tok(C, WSP(bf16, WS_CQN), WSP(bf16, WS_W_MLAUQ), 1536, 512, true, EpiStoreHeads{WSP(bf16, WS_Q), 96, (size_t)R * 96});
                 gemm_tok(C, WSP(bf16, WS_CKVN), WSP(bf16, WS_W_MLAUKV), 2048, 256, true, EpiStoreHeads{WSP(bf16, WS_KV), 128, (size_t)R * 128});)
        PH_BEGIN ph_rope(C, WSP(bf16, WS_Q), 96, 16, 64, 8); ph_kmax(C); PH_END
        PHG(4, ph_attn<2>(C, slot, need_ctx, 2);)
#if ATTN_VARIANT_PROBE
        PH_BEGIN ph_attn_fast<2, ATTN_VARIANT_PROBE>(C, slot, need_ctx, (ATTN_VARIANT_PROBE & 64) ? 2 : -1); PH_END
#endif
    }
    const bf16* wo = kind == 0 ? WSP(bf16, WS_W_NAO) + (size_t)slot * 1024 * 1024 : (kind == 1 ? WSP(bf16, WS_W_SWAO) : WSP(bf16, WS_W_MLAO));
    PH_BEGIN gemm_tok(C, WSP(bf16, WS_O), wo, 1024, 1024, need_ctx, EpiResid{WSP(float, WS_X), modp(C, l, 0, 2), modp(C, l, 1, 2)}); PH_END
    PHG(5, ph_norm2(C, l, RL);)
#if NORM2_VARIANT_PROBE
    PH_BEGIN ph_norm2<NORM2_VARIANT_PROBE>(C, l, RL); PH_END
#endif
    PHG(6, ph_topk(C, need_ctx);)
    PHG(8, gemm_moe(C, WSP(bf16, WS_H), WSP(bf16, WS_W_GU) + (size_t)l * 16 * 4096 * 1024, 4096, 1024, (size_t)4096 * 1024, need_ctx, EpiSwiglu{WSP(bf16, WS_ACT)}, WSP(int, WS_ROWL));)
    PHG(9, gemm_moe(C, WSP(bf16, WS_ACT), WSP(bf16, WS_W_DN) + (size_t)l * 16 * 1024 * 2048, 1024, 2048, (size_t)1024 * 2048, need_ctx, EpiMoeOut{WSP(bf16, WS_YB), WSP(float, WS_GATEL)});)
}
__global__ void __launch_bounds__(512, 2) fwd_kernel(Args args) {
    extern __shared__ __attribute__((aligned(16))) unsigned char lds_raw[];
    Ctx C;
#pragma unroll
    for (int i = 0; i < 26; ++i) C.in[i] = args.in[i];
    C.out = args.out; C.ws = args.ws; C.lds = (LAS unsigned char*)lds_raw;
    C.tid = threadIdx.x; C.lane = C.tid & 63; C.wave = __builtin_amdgcn_readfirstlane(C.tid >> 6); C.blk = blockIdx.x; C.G = gridDim.x;
    volatile LAS unsigned* MISC = (volatile LAS unsigned*)(C.lds + MISC_OFF);
    if (C.tid < 32) MISC[C.tid] = 0u;
    __syncthreads();
    const int lo = args.ph_lo, hi = args.ph_hi;
    XcdBarrier bar; bar.bar = (unsigned*)(C.ws + WS_CTL) + CW_BAR; bar.x = 0; bar.st = nullptr;
    if (hi - lo > 1) bar = xcd_barrier_post((unsigned*)(C.ws + WS_CTL) + CW_BAR, MISC + 8);
    int ph = 0;
    PHG(0, ph_prologue(C);)
    layer_phases<0>(C, bar, lo, hi, ph);
    layer_phases<1>(C, bar, lo, hi, ph);
    layer_phases<2>(C, bar, lo, hi, ph);
    layer_phases<3>(C, bar, lo, hi, ph);
    PH_BEGIN ph_rowA<1>(C, 4); PH_END
#if DIAG
    {
        __builtin_amdgcn_fence(__ATOMIC_ACQUIRE, "agent");
        const unsigned long long* st = (const unsigned long long*)(C.ws + WS_CTL + 512 * 1024);
        const float t1 = (float)(__hip_atomic_load(st + DIAG_PH1 + 1, __ATOMIC_RELAXED, __HIP_MEMORY_SCOPE_AGENT) - __hip_atomic_load(st + DIAG_PH1, __ATOMIC_RELAXED, __HIP_MEMORY_SCOPE_AGENT)) * 0.01f;
        const float t2 = (float)(__hip_atomic_load(st + DIAG_PH2 + 1, __ATOMIC_RELAXED, __HIP_MEMORY_SCOPE_AGENT) - __hip_atomic_load(st + DIAG_PH2, __ATOMIC_RELAXED, __HIP_MEMORY_SCOPE_AGENT)) * 0.01f;
        (void)t2;
        const float tq = exp2f(rintf(log2f(t1) * 16.f) * (1.f / 16.f));
        const float cval = 0.1f * sqrtf(tq);
        for (size_t i = (size_t)C.blk * 512 + C.tid; i < (size_t)SEQ * D; i += (size_t)C.G * 512) C.out[i] = cval;
    }
#endif
}
#undef PH_BEGIN
#undef PH_END

extern "C" void kernel_launch(void* const* d_in, const int* in_sizes, int n_in, void* d_out, int out_size, void* d_ws, size_t ws_size, hipStream_t stream) {
    static int grid = 0;
    if (grid == 0) {
        if (n_in != 26 || out_size != SEQ * D || ws_size < WS_END) { fprintf(stderr, "kernel_launch: unexpected shapes (n_in %d out %d ws %zu)\n", n_in, out_size, ws_size); grid = -1; return; }
        int dev = 0, cus = 0, per_cu = 0;
        if (hipGetDevice(&dev) != hipSuccess || hipDeviceGetAttribute(&cus, hipDeviceAttributeMultiprocessorCount, dev) != hipSuccess) { grid = -1; return; }
        if (hipFuncSetAttribute((const void*)fwd_kernel, hipFuncAttributeMaxDynamicSharedMemorySize, LDS_BYTES) != hipSuccess) { fprintf(stderr, "kernel_launch: hipFuncSetAttribute failed\n"); grid = -1; return; }
        if (hipOccupancyMaxActiveBlocksPerMultiprocessor(&per_cu, (const void*)fwd_kernel, 512, LDS_BYTES) != hipSuccess || per_cu < 1) fprintf(stderr, "kernel_launch: occupancy query says %d\n", per_cu);
        (void)hipGetLastError();
        grid = cus;
    }
    if (grid < 0) return;
    if (hipMemsetAsync((char*)d_ws + WS_CTL, 0, CTL_ZERO_BYTES, stream) != hipSuccess) return;
    Args a{};
    for (int i = 0; i < 26; ++i) a.in[i] = (const float*)d_in[i];
    a.out = (float*)d_out; a.ws = (unsigned char*)d_ws; a.pad = 0;
#if MK_N_LAUNCHES == 1
    a.ph_lo = 0; a.ph_hi = 1 << 20; a.li = 0;
    hipLaunchKernelGGL(fwd_kernel, dim3(grid), dim3(512), LDS_BYTES, stream, a);
#else
    for (int li = 0; li < NPH; ++li) { a.ph_lo = li; a.ph_hi = li + 1; a.li = li;
        hipLaunchKernelGGL(fwd_kernel, dim3(grid), dim3(512), LDS_BYTES, stream, a); }
#endif
}
```

```cpp
#include <hip/hip_runtime.h>
#include <cstdio>
#include <cstdint>

#ifndef MK_N_LAUNCHES
#define MK_N_LAUNCHES 1
#endif

#define GAS __attribute__((address_space(1)))
#define LAS __attribute__((address_space(3)))
typedef unsigned short bf16;
typedef float f32x4 __attribute__((ext_vector_type(4)));
typedef unsigned u32x4 __attribute__((ext_vector_type(4)));
typedef unsigned u32x2 __attribute__((ext_vector_type(2)));
typedef short bf16x8 __attribute__((ext_vector_type(8)));
typedef short s16x4 __attribute__((ext_vector_type(4)));
typedef float f32x16 __attribute__((ext_vector_type(16)));

constexpr int D = 1024, SEQ = 16384, NCTX = 256, R = SEQ + NCTX, NE = 16, FF = 2048;
constexpr int CAP_L = 2048, CAP_C = 32, EROWS = 2304, XROWS = NE * EROWS;
constexpr float RMS_EPS = 1e-6f;
constexpr int NPH = 1 + 9 + 10 + 12 + 9 + 1;

constexpr size_t MiB = 1u << 20;
constexpr size_t WS_CTL = 0, CTL_ZERO_BYTES = 1 * MiB;
constexpr size_t WS_MOD = 1 * MiB;
constexpr size_t WS_W_NAQKV = 2 * MiB;
constexpr size_t WS_W_NAO = 14 * MiB;
constexpr size_t WS_W_SWAQKV = 18 * MiB;
constexpr size_t WS_W_SWAO = 21 * MiB;
constexpr size_t WS_W_MLAD = 23 * MiB;
constexpr size_t WS_W_MLAUQ = 25 * MiB;
constexpr size_t WS_W_MLAUKV = 27 * MiB;
constexpr size_t WS_W_MLAO = 28 * MiB;
constexpr size_t WS_W_GU = 32 * MiB;
constexpr size_t WS_W_DN = WS_W_GU + 512 * MiB;
constexpr size_t WS_X = WS_W_DN + 256 * MiB;
constexpr size_t WS_H = WS_X + 65 * MiB;
constexpr size_t WS_QKV = WS_H + 33 * MiB;
constexpr size_t WS_CQ = WS_QKV + 98 * MiB;
constexpr size_t WS_Q = WS_CQ + 65 * MiB;
constexpr size_t WS_KV = WS_Q + 49 * MiB;
constexpr size_t WS_CQN = WS_KV + 65 * MiB;
constexpr size_t WS_CKVN = WS_CQN + 17 * MiB;
constexpr size_t WS_KROPE = WS_CKVN + 9 * MiB;
constexpr size_t WS_O = WS_KROPE + 2 * MiB;
constexpr size_t WS_AFF = WS_O + 33 * MiB;
constexpr size_t WS_ROWL = WS_AFF + 2 * MiB;
constexpr size_t WS_GATEL = WS_ROWL + 1 * MiB;
constexpr size_t WS_INV = WS_GATEL + 1 * MiB;
constexpr size_t WS_XG = WS_INV + 2 * MiB;
constexpr size_t WS_ACT = WS_XG + 72 * MiB;
constexpr size_t WS_YB = WS_ACT + 144 * MiB;
constexpr size_t WS_END = WS_YB + 72 * MiB;
static_assert(WS_END <= 2048 * MiB, "d_ws map");
constexpr int CW_BAR = 4096;

constexpr int LDS_BYTES = 147456;
constexpr int MISC_OFF = 131072 + 320;

__device__ __forceinline__ float bf2f(unsigned b) { return __uint_as_float(b << 16); }
__device__ __forceinline__ unsigned f2bf(float f) { unsigned u = __float_as_uint(f); return (u + 0x7fffu + ((u >> 16) & 1u)) >> 16; }
typedef float f32x2_t __attribute__((ext_vector_type(2))); typedef __bf16 bf16x2_t __attribute__((ext_vector_type(2)));
__device__ __forceinline__ unsigned cvt_pk_bf16(float lo, float hi) { f32x2_t v = {lo, hi}; bf16x2_t b = __builtin_convertvector(v, bf16x2_t); return __builtin_bit_cast(unsigned, b); }
__device__ __forceinline__ unsigned pk2(float lo, float hi) { return cvt_pk_bf16(lo, hi); }
__device__ __forceinline__ float wave_sum(float v) {
#pragma unroll
    for (int o = 1; o < 64; o <<= 1) v += __shfl_xor(v, o);
    return v;
}
__device__ __forceinline__ int wave_sum_i(int v) {
#pragma unroll
    for (int o = 1; o < 64; o <<= 1) v += __shfl_xor(v, o);
    return v;
}

#define XB_TMO      128
#define XB_XCNT(j)  (256  + 64 * (j))
#define XB_XSUB(j)  (1280 + 64 * (j))
#define XB_XGEN(j)  (2304 + 64 * (j))
#define XB_TOP      3328
#define XB_TOPGEN   3392
#define XCD_BAR_WORDS 3456
#define XB_SPIN_CAP (1u << 18)
__device__ __forceinline__ unsigned xb_ld(unsigned* p)              { return __hip_atomic_load(p, __ATOMIC_RELAXED, __HIP_MEMORY_SCOPE_AGENT); }
__device__ __forceinline__ unsigned xb_add(unsigned* p, unsigned v) { return __hip_atomic_fetch_add(p, v, __ATOMIC_RELAXED, __HIP_MEMORY_SCOPE_AGENT); }
__device__ __forceinline__ unsigned xb_xcc_id() { return (unsigned)__builtin_amdgcn_s_getreg((3 << 11) | 20) & 0xFu; }
#define XB_SPIN(cond, bar) do { unsigned _sp = 0; while (cond) { __builtin_amdgcn_s_sleep(1); \
    if ((++_sp & 255u) == 0u) { if (xb_ld(&(bar)[XB_TMO])) break; if (_sp > XB_SPIN_CAP) { atomicAdd(&(bar)[XB_TMO], 1u); break; } } } } while (0)
struct XcdBarrier { unsigned* bar; unsigned x; volatile LAS unsigned* st; };
__device__ __forceinline__ XcdBarrier xcd_barrier_post(unsigned* bar, volatile LAS unsigned* st) {
    XcdBarrier b; b.bar = bar; b.x = xb_xcc_id(); b.st = st;
    if (threadIdx.x == 0) (void)xb_add(&bar[XB_XCNT(b.x)], 1u);
    return b;
}
__device__ __forceinline__ void xcd_barrier_complete(unsigned* bar, unsigned x, unsigned& nloc, unsigned& nx) {
    const unsigned G = gridDim.x * gridDim.y * gridDim.z;
    unsigned sum, cnt, mine, sp = 0u;
    for (;;) {
        sum = 0u; cnt = 0u; mine = 0u;
#pragma unroll
        for (unsigned j = 0; j < 16; ++j) { const unsigned c = xb_ld(&bar[XB_XCNT(j)]); sum += c; cnt += (c > 0u) ? 1u : 0u; mine = (j == x) ? c : mine; }
        if (sum == G) break;
        __builtin_amdgcn_s_sleep(1);
        if ((++sp & 255u) == 0u) { if (xb_ld(&bar[XB_TMO])) break; if (sp > XB_SPIN_CAP) { atomicAdd(&bar[XB_TMO], 1u); break; } }
    }
    nloc = mine > 0u ? mine : 1u; nx = cnt > 0u ? cnt : 1u;
}
__device__ __forceinline__ void xcd_barrier(const XcdBarrier& b) {
    asm volatile("s_waitcnt vmcnt(0)" ::: "memory");
    __syncthreads();
    if (threadIdx.x == 0) {
        unsigned* bar = b.bar;
        __builtin_amdgcn_s_waitcnt(0);
        unsigned nloc = b.st[0], nx = b.st[1];
        if (nloc == 0u) { xcd_barrier_complete(bar, b.x, nloc, nx); b.st[0] = nloc; b.st[1] = nx; }
        const unsigned old = xb_add(&bar[XB_XSUB(b.x)], 1u);
        const unsigned gen = old / nloc;
        if (old + 1u == (gen + 1u) * nloc) {
            __builtin_amdgcn_fence(__ATOMIC_RELEASE, "agent");
            asm volatile("s_waitcnt vmcnt(0)" ::: "memory");
            const unsigned og = xb_add(&bar[XB_TOP], 1u);
            const unsigned tg = og / nx;
            if (og + 1u == (tg + 1u) * nx) xb_add(&bar[XB_TOPGEN], 1u);
            else XB_SPIN(xb_ld(&bar[XB_TOPGEN]) == tg, bar);
            __builtin_amdgcn_fence(__ATOMIC_ACQUIRE, "agent");
            xb_add(&bar[XB_XGEN(b.x)], 1u);
            asm volatile("s_waitcnt vmcnt(0)" ::: "memory");
        } else {
            XB_SPIN(xb_ld(&bar[XB_XGEN(b.x)]) == gen, bar);
            __builtin_amdgcn_fence(__ATOMIC_ACQUIRE, "agent");
            asm volatile("s_waitcnt vmcnt(0)" ::: "memory");
        }
    }
    __syncthreads();
}

struct Args { const float* in[26]; float* out; unsigned char* ws; int ph_lo, ph_hi, li, pad; };
struct Ctx {
    const float* in[26]; float* out; unsigned char* ws;
    LAS unsigned char* lds;
    int tid, lane, wave, blk, G;
};
#define WSP(T, off) ((T*)(C.ws + (off)))
__device__ __forceinline__ const float* modp(const Ctx& C, int l, int set, int j) { return (const float*)(C.ws + WS_MOD) + ((l * 2 + set) * 6 + j) * D; }

__device__ __forceinline__ void p0_transpose_item(const float* W, int K, int N, bf16* WT, int k0, int n0, int drow0, LAS float* scr, int lane) {
    const int lr = lane >> 3, lc = (lane & 7) * 4;
    f32x4 v[8];
#pragma unroll
    for (int i = 0; i < 8; ++i) v[i] = *(const f32x4*)(W + (size_t)(k0 + 8 * i + lr) * N + n0 + lc);
#pragma unroll
    for (int i = 0; i < 8; ++i) *(LAS f32x4*)(scr + (8 * i + lr) * 36 + lc) = v[i];
    asm volatile("s_waitcnt lgkmcnt(0)" ::: "memory");
    const int c = lane & 7;
#pragma unroll
    for (int j = 0; j < 4; ++j) { const int n = (lane >> 3) + 8 * j; const LAS float* s = scr + (8 * c) * 36 + n;
        u32x4 o; o.x = pk2(s[0 * 36], s[1 * 36]); o.y = pk2(s[2 * 36], s[3 * 36]); o.z = pk2(s[4 * 36], s[5 * 36]); o.w = pk2(s[6 * 36], s[7 * 36]);
        *(u32x4*)(WT + (size_t)(drow0 + n) * K + k0 + 8 * c) = o; }
    asm volatile("s_waitcnt lgkmcnt(0)" ::: "memory");
}
constexpr int MOE_ITEMS_PER_LAYER = 16 * 3072, MOE_HALF_ITEMS = 2 * MOE_ITEMS_PER_LAYER;
__device__ __forceinline__ bool moe_layer_in_attention(int l) { return true; }
struct ConvItem { const float* W; bf16* WT; int K, N; };
__device__ __forceinline__ ConvItem conv_half_item(const Ctx& C, int l, int hidx) {
    const int it = hidx >> 1, half = hidx & 1, e = it / 3072, r2 = it % 3072, which = r2 / 1024, item = r2 % 1024, le = l * 16 + e;
    ConvItem ci;
    if (which < 2) { const int kb = item / 64, nb = item % 64, n0 = nb * 32, k0 = kb * 64 + 32 * half, drow0 = (n0 >> 7) * 256 + (n0 & 127) + which * 128;
        ci.K = 1024; ci.N = 2048; ci.W = (which ? C.in[23] : C.in[22]) + (size_t)le * 1024 * 2048 + (size_t)k0 * 2048 + n0;
        ci.WT = WSP(bf16, WS_W_GU) + (size_t)le * 4096 * 1024 + (size_t)drow0 * 1024 + k0; }
    else { const int kb = item / 32, nb = item % 32, n0 = nb * 32, k0 = kb * 64 + 32 * half;
        ci.K = 2048; ci.N = 1024; ci.W = C.in[24] + (size_t)le * 2048 * 1024 + (size_t)k0 * 1024 + n0;
        ci.WT = WSP(bf16, WS_W_DN) + (size_t)le * 1024 * 2048 + (size_t)n0 * 2048 + k0; }
    return ci;
}
struct ConvState { int l0, total, cur; bool loaded; };
template <bool DRAIN>
__device__ __forceinline__ void conv_step(const Ctx& C, ConvState& st, LAS float* scr) {
    int lane = C.lane; asm volatile("" : "+v"(lane));
    if (st.loaded) {
        if (DRAIN) asm volatile("s_waitcnt vmcnt(0)" ::: "memory");
        const int pc = st.cur - C.G * 8; const ConvItem pi = conv_half_item(C, st.l0 + pc / MOE_HALF_ITEMS, pc % MOE_HALF_ITEMS);
#pragma unroll
        for (int j = 0; j < 2; ++j) { const int ch = lane + 64 * j, n = ch >> 2, c = ch & 3; const LAS float* sp = scr + (8 * c) * 32 + ((((n >> 2) ^ (2 * c)) << 2) | (n & 3));
            u32x4 o; o.x = cvt_pk_bf16(sp[0 * 32], sp[1 * 32]); o.y = cvt_pk_bf16(sp[2 * 32], sp[3 * 32]); o.z = cvt_pk_bf16(sp[4 * 32], sp[5 * 32]); o.w = cvt_pk_bf16(sp[6 * 32], sp[7 * 32]);
            *(u32x4*)(pi.WT + (size_t)n * pi.K + 8 * c) = o; }
        asm volatile("s_waitcnt lgkmcnt(0)" ::: "memory");
        st.loaded = false;
    }
    if (st.cur < st.total) {
        const ConvItem ci = conv_half_item(C, st.l0 + st.cur / MOE_HALF_ITEMS, st.cur % MOE_HALF_ITEMS);
        const int lr = lane >> 3;
#pragma unroll
        for (int i = 0; i < 4; ++i) { const int lc = ((lane & 7) ^ (2 * i)) * 4;
            __builtin_amdgcn_global_load_lds((const unsigned*)(ci.W + (size_t)(8 * i + lr) * ci.N + lc), (LAS unsigned*)(scr + i * 256), 16, 0, 0); }
        st.loaded = true; st.cur += C.G * 8;
    }
}
struct ConvPipe { int l0, total, first, n; };
constexpr int CONV_PIPE_BASE = 4 * (64 * 128 + 64 * 128) + 2048;
__device__ __forceinline__ LAS float* conv_pipe_buf(LAS unsigned char* lds, int wave, int par) {
    const int b = wave * 2 + par;
    return (LAS float*)(lds + (b < 14 ? CONV_PIPE_BASE + b * 4096 : 132096 + (b - 14) * 4096));
}
template <bool STORE = true>
__device__ __forceinline__ void conv_pack_store(bf16* WT, int K, const LAS float* scr, int lane) {
#pragma unroll
    for (int j = 0; j < 2; ++j) { const int ch = lane + 64 * j, n = ch >> 2, c = ch & 3; const LAS float* sp = scr + (8 * c) * 32 + ((((n >> 2) ^ (2 * c)) << 2) | (n & 3));
        u32x4 o; o.x = cvt_pk_bf16(sp[0 * 32], sp[1 * 32]); o.y = cvt_pk_bf16(sp[2 * 32], sp[3 * 32]); o.z = cvt_pk_bf16(sp[4 * 32], sp[5 * 32]); o.w = cvt_pk_bf16(sp[6 * 32], sp[7 * 32]);
        if (STORE) *(u32x4*)(WT + (size_t)n * K + 8 * c) = o; else asm volatile("" :: "v"(o.x), "v"(o.y), "v"(o.z), "v"(o.w)); }
    asm volatile("s_waitcnt lgkmcnt(0)" ::: "memory");
}
template <int FL = 0>
__device__ __forceinline__ void conv_pipe_step(const Ctx& C, ConvPipe& st, LAS unsigned char* lds) {
    int lane = C.lane; asm volatile("" : "+v"(lane));
    const int NGW = C.G * 8, cur = st.first + st.n * NGW, pc = cur - 2 * NGW;
    LAS float* scr = conv_pipe_buf(lds, C.wave, st.n & 1);
    unsigned* dummy = (unsigned*)WSP(bf16, WS_XG) + (size_t)st.first * 512 + lane;
    if (st.n >= 2 && pc < st.total) { const ConvItem pi = conv_half_item(C, st.l0, pc); conv_pack_store<!(FL & 1)>(pi.WT, pi.K, scr, lane); }
    else { dummy[0] = 0u; asm volatile("" ::: "memory"); dummy[64] = 0u; asm volatile("" ::: "memory"); }
    if (cur < st.total) { const ConvItem ci = conv_half_item(C, st.l0, cur);
        const int lr = lane >> 3;
#pragma unroll
        for (int i = 0; i < 4; ++i) { const int lc = ((lane & 7) ^ (2 * i)) * 4;
            if (!(FL & 2)) __builtin_amdgcn_global_load_lds((const unsigned*)(ci.W + (size_t)(8 * i + lr) * ci.N + lc), (LAS unsigned*)(scr + i * 256), 16, 0, 0); } }
    else {
#pragma unroll
        for (int i = 0; i < 4; ++i) { dummy[128 + 64 * i] = 0u; asm volatile("" ::: "memory"); } }
    st.n += 1;
}
__device__ __forceinline__ void conv_pipe_drain(const Ctx& C, ConvPipe& st, LAS unsigned char* lds) {
    asm volatile("s_waitcnt vmcnt(0)" ::: "memory");
    const int NGW = C.G * 8;
#pragma unroll 1
    for (int k = 2; k >= 1; --k) { const int m = st.n - k, pc = st.first + m * NGW;
        if (m >= 0 && pc < st.total) { const ConvItem pi = conv_half_item(C, st.l0, pc); conv_pack_store(pi.WT, pi.K, conv_pipe_buf(lds, C.wave, m & 1), C.lane); } }
    ConvState rest; rest.l0 = st.l0; rest.total = st.total; rest.cur = st.first + st.n * NGW; rest.loaded = false;
    LAS float* scr = conv_pipe_buf(lds, C.wave, 0);
    while (rest.loaded || rest.cur < rest.total) conv_step<true>(C, rest, scr);
}
__device__ __forceinline__ void conv_const_step(const Ctx& C, ConvState& st, LAS float* scr) {
    int lane = C.lane; asm volatile("" : "+v"(lane));
    const int NGW = C.G * 8;
    unsigned* dummy = (unsigned*)WSP(bf16, WS_XG) + (size_t)(C.blk * 8 + C.wave) * 512 + lane;
    if (st.loaded) { const int pc = st.cur - NGW; const ConvItem pi = conv_half_item(C, st.l0 + pc / MOE_HALF_ITEMS, pc % MOE_HALF_ITEMS);
        conv_pack_store<true>(pi.WT, pi.K, scr, lane); }
    else { dummy[0] = 0u; asm volatile("" ::: "memory"); dummy[64] = 0u; asm volatile("" ::: "memory"); }
    if (st.cur < st.total) { const ConvItem ci = conv_half_item(C, st.l0 + st.cur / MOE_HALF_ITEMS, st.cur % MOE_HALF_ITEMS);
        const int lr = lane >> 3;
#pragma unroll
        for (int i = 0; i < 4; ++i) { const int lc = ((lane & 7) ^ (2 * i)) * 4;
            __builtin_amdgcn_global_load_lds((const unsigned*)(ci.W + (size_t)(8 * i + lr) * ci.N + lc), (LAS unsigned*)(scr + i * 256), 16, 0, 0); }
        st.loaded = true; st.cur += NGW; }
    else { st.loaded = false;
#pragma unroll
        for (int i = 0; i < 4; ++i) { dummy[128 + 64 * i] = 0u; asm volatile("" ::: "memory"); } }
}
__device__ __forceinline__ bool p0_plain(int& r, const float* W, int K, int N, bf16* WT, int row_off, LAS float* scr, int lane) {
    const int nblk = N / 32, cnt = (K / 64) * nblk;
    if (r >= cnt) { r -= cnt; return false; }
    const int kb = r / nblk, nb = r % nblk;
    p0_transpose_item(W, K, N, WT, kb * 64, nb * 32, row_off + nb * 32, scr, lane);
    return true;
}
__device__ __forceinline__ void ph_prologue(const Ctx& C) {
    LAS float* scr = (LAS float*)(C.lds + C.wave * 16384);
    const int gw = C.blk * 8 + C.wave, NGW = C.G * 8;
    constexpr int MOE_ITEMS = 4 * 16 * 3072;
    constexpr int SMALL_ITEMS = 2 * 1536 + 2 * 512 + 768 + 512 + 256 + 144 + 384 + 256 + 512;
    for (int it = gw; it < MOE_ITEMS + SMALL_ITEMS; it += NGW) {
        if (it < MOE_ITEMS) {
            if (moe_layer_in_attention(it / MOE_ITEMS_PER_LAYER)) continue;
            const int le = it / 3072, r2 = it % 3072, which = r2 / 1024, item = r2 % 1024, l = le / 16, e = le % 16;
            if (which < 2) {
                const float* W = (which ? C.in[23] : C.in[22]) + (size_t)le * 1024 * 2048;
                bf16* WT = WSP(bf16, WS_W_GU) + ((size_t)l * 16 + e) * 4096 * 1024;
                const int kb = item / 64, nb = item % 64, n0 = nb * 32;
                p0_transpose_item(W, 1024, 2048, WT, kb * 64, n0, (n0 >> 7) * 256 + (n0 & 127) + which * 128, scr, C.lane);
            } else {
                const float* W = C.in[24] + (size_t)le * 2048 * 1024;
                bf16* WT = WSP(bf16, WS_W_DN) + ((size_t)l * 16 + e) * 1024 * 2048;
                const int kb = item / 32, nb = item % 32;
                p0_transpose_item(W, 2048, 1024, WT, kb * 64, nb * 32, nb * 32, scr, C.lane);
            }
            continue;
        }
        int r = it - MOE_ITEMS;
        if (p0_plain(r, C.in[8], 1024, 3072, WSP(bf16, WS_W_NAQKV), 0, scr, C.lane)) continue;
        if (p0_plain(r, C.in[8] + (size_t)1024 * 3072, 1024, 3072, WSP(bf16, WS_W_NAQKV) + (size_t)3072 * 1024, 0, scr, C.lane)) continue;
        if (p0_plain(r, C.in[9], 1024, 1024, WSP(bf16, WS_W_NAO), 0, scr, C.lane)) continue;
        if (p0_plain(r, C.in[9] + (size_t)1024 * 1024, 1024, 1024, WSP(bf16, WS_W_NAO) + (size_t)1024 * 1024, 0, scr, C.lane)) continue;
        if (p0_plain(r, C.in[11], 1024, 1536, WSP(bf16, WS_W_SWAQKV), 0, scr, C.lane)) continue;
        if (p0_plain(r, C.in[12], 1024, 1024, WSP(bf16, WS_W_SWAO), 0, scr, C.lane)) continue;
        if (p0_plain(r, C.in[14], 1024, 512, WSP(bf16, WS_W_MLAD), 0, scr, C.lane)) continue;
        if (p0_plain(r, C.in[17], 1024, 288, WSP(bf16, WS_W_MLAD), 512, scr, C.lane)) continue;
        if (p0_plain(r, C.in[16], 512, 1536, WSP(bf16, WS_W_MLAUQ), 0, scr, C.lane)) continue;
        if (p0_plain(r, C.in[19], 256, 2048, WSP(bf16, WS_W_MLAUKV), 0, scr, C.lane)) continue;
        p0_plain(r, C.in[20], 1024, 1024, WSP(bf16, WS_W_MLAO), 0, scr, C.lane);
    }
    { u32x4* z = (u32x4*)(WSP(bf16, WS_W_MLAD) + (size_t)800 * 1024); const int n16 = 224 * 1024 * 2 / 16;
      for (int i = C.blk * 512 + C.tid; i < n16; i += C.G * 512) z[i] = (u32x4){0u, 0u, 0u, 0u}; }
    __syncthreads();
    LAS float* sc = (LAS float*)C.lds;
    LAS float* red = sc + 2048;
    for (int i = C.tid; i < 2048; i += 512) { const float v = (i < 1024) ? C.in[1][i] : C.in[3][i - 1024]; sc[i] = v / (1.f + __expf(-v)); }
    __syncthreads();
    for (int u = C.blk; u < 4 * 96; u += C.G) {
        const int l = u / 96, j0 = (u % 96) * 64, kg = C.tid >> 4, jl = (C.tid & 15) * 4;
        const float* W = C.in[4] + (size_t)l * 1024 * 6144 + (size_t)(kg * 32) * 6144 + j0 + jl;
        f32x4 a0 = (f32x4){0.f, 0.f, 0.f, 0.f}, a1 = a0;
#pragma unroll 1
        for (int kb = 0; kb < 32; kb += 16) {
            f32x4 wv[16];
#pragma unroll
            for (int i = 0; i < 16; ++i) wv[i] = *(const f32x4*)(W + (size_t)(kb + i) * 6144);
#pragma unroll
            for (int i = 0; i < 16; ++i) { const float s0 = sc[kg * 32 + kb + i], s1 = sc[1024 + kg * 32 + kb + i];
                a0[0] += s0 * wv[i][0]; a0[1] += s0 * wv[i][1]; a0[2] += s0 * wv[i][2]; a0[3] += s0 * wv[i][3];
                a1[0] += s1 * wv[i][0]; a1[1] += s1 * wv[i][1]; a1[2] += s1 * wv[i][2]; a1[3] += s1 * wv[i][3]; }
        }
        *(LAS f32x4*)(red + kg * 64 + jl) = a0; *(LAS f32x4*)(red + 2048 + kg * 64 + jl) = a1;
        __syncthreads();
        if (C.tid < 128) { const int set = C.tid >> 6, j = C.tid & 63; float s = 0.f;
#pragma unroll
            for (int q = 0; q < 32; ++q) s += red[set * 2048 + q * 64 + j];
            const int col = j0 + j;
            ((float*)(C.ws + WS_MOD))[((l * 2 + set) * 6) * D + col] = s + C.in[5][l * 6144 + col]; }
        __syncthreads();
    }
}

template <int MODE>
__device__ __forceinline__ void ph_rowA(const Ctx& C, int l) {
    float* X = WSP(float, WS_X); bf16* H = WSP(bf16, WS_H); const int* INV = WSP(int, WS_INV); const bf16* YB = WSP(bf16, WS_YB);
    const int nrows = MODE == 1 ? SEQ : R, NW = C.G * 8;
    const bool comb = MODE == 1 || l > 0; const int lp = MODE == 1 ? 3 : l - 1;
    int t = C.blk * 8 + C.wave;
    f32x4 v[4]; int myinv = -1;
#pragma unroll
    for (int j = 0; j < 4; ++j) v[j] = (f32x4){0.f, 0.f, 0.f, 0.f};
    if (t < nrows) {
        const float* src = (MODE == 0 && l == 0) ? (t >= SEQ ? C.in[2] + (size_t)(t - SEQ) * D : C.in[0] + (size_t)t * D) : X + (size_t)t * D;
#pragma unroll
        for (int j = 0; j < 4; ++j) v[j] = ((const f32x4*)src)[C.lane + 64 * j];
        if (comb) myinv = C.lane < 16 ? INV[(size_t)C.lane * R + t] : -1;
    }
    int cur_set = -1; f32x4 gg[4], ws[4], sh4[4];
#pragma unroll
    for (int j = 0; j < 4; ++j) { gg[j] = (f32x4){0.f, 0.f, 0.f, 0.f}; ws[j] = gg[j]; sh4[j] = gg[j]; }
    for (; t < nrows; t += NW) {
        const int set = t >= SEQ ? 1 : 0;
        if (set != cur_set) { cur_set = set;
            if (comb) { const f32x4* g = (const f32x4*)modp(C, lp, set, 5);
#pragma unroll
                for (int j = 0; j < 4; ++j) gg[j] = g[C.lane + 64 * j]; }
            if (MODE == 0) { const f32x4* w = (const f32x4*)(C.in[6] + (size_t)l * D); const f32x4* sh = (const f32x4*)modp(C, l, set, 0); const f32x4* scl = (const f32x4*)modp(C, l, set, 1);
#pragma unroll
                for (int j = 0; j < 4; ++j) { const int i = C.lane + 64 * j; ws[j] = w[i] * (scl[i] + 1.f); sh4[j] = sh[i]; } }
            else { const f32x4* w = (const f32x4*)C.in[25];
#pragma unroll
                for (int j = 0; j < 4; ++j) ws[j] = w[C.lane + 64 * j]; }
        }
        f32x4 vn[4]; int invn = -1;
        { const int tn = t + NW < nrows ? t + NW : t;
          const float* srcn = (MODE == 0 && l == 0) ? (tn >= SEQ ? C.in[2] + (size_t)(tn - SEQ) * D : C.in[0] + (size_t)tn * D) : X + (size_t)tn * D;
#pragma unroll
          for (int j = 0; j < 4; ++j) vn[j] = ((const f32x4*)srcn)[C.lane + 64 * j];
          if (comb) invn = C.lane < 16 ? INV[(size_t)C.lane * R + tn] : -1; }
        if (comb) {
            f32x4 a[4];
#pragma unroll
            for (int j = 0; j < 4; ++j) a[j] = (f32x4){0.f, 0.f, 0.f, 0.f};
            unsigned em = (unsigned)(__builtin_amdgcn_ballot_w64(myinv >= 0) & 0xffffull);
            while (em) {
                int sl[4]; bool ok[4];
#pragma unroll
                for (int q = 0; q < 4; ++q) { ok[q] = em != 0u; const int e = ok[q] ? __builtin_ctz(em) : 0; if (ok[q]) em &= em - 1u; sl[q] = e * EROWS + __shfl(myinv, e); }
                u32x2 w[4][4];
#pragma unroll
                for (int q = 0; q < 4; ++q) { const u32x2* yr = (const u32x2*)(YB + (size_t)(ok[q] ? sl[q] : 0) * D);
#pragma unroll
                    for (int j = 0; j < 4; ++j) w[q][j] = ok[q] ? yr[C.lane + 64 * j] : (u32x2){0u, 0u}; }
#pragma unroll
                for (int q = 0; q < 4; ++q)
#pragma unroll
                    for (int j = 0; j < 4; ++j) a[j] += (f32x4){bf2f(w[q][j].x & 0xffffu), bf2f(w[q][j].x >> 16), bf2f(w[q][j].y & 0xffffu), bf2f(w[q][j].y >> 16)};
            }
#pragma unroll
            for (int j = 0; j < 4; ++j) v[j] += gg[j] * a[j];
        }
        if (MODE == 0) {
#pragma unroll
            for (int j = 0; j < 4; ++j) ((f32x4*)(X + (size_t)t * D))[C.lane + 64 * j] = v[j];
        }
        float ss = 0.f;
#pragma unroll
        for (int j = 0; j < 4; ++j) ss += (v[j].x * v[j].x + v[j].y * v[j].y) + (v[j].z * v[j].z + v[j].w * v[j].w);
        const float rstd = rsqrtf(wave_sum(ss) * (1.f / D) + RMS_EPS);
        if (MODE == 0) {
#pragma unroll
            for (int j = 0; j < 4; ++j) { const int i = C.lane + 64 * j; const f32x4 y = v[j] * rstd * ws[j] + sh4[j];
                u32x2 o; o.x = pk2(y.x, y.y); o.y = pk2(y.z, y.w); ((u32x2*)(H + (size_t)t * D))[i] = o; }
        } else {
#pragma unroll
            for (int j = 0; j < 4; ++j) { const int i = C.lane + 64 * j; ((f32x4*)(C.out + (size_t)t * D))[i] = v[j] * rstd * ws[j]; }
        }
#pragma unroll
        for (int j = 0; j < 4; ++j) v[j] = vn[j];
        myinv = invn;
    }
}
template <int M> __device__ __forceinline__ float xorx(float v, int b5) {
    if constexpr (M == 32) { const auto sw = __builtin_amdgcn_permlane32_swap(__float_as_uint(v), __float_as_uint(v), false, false); return __uint_as_float(b5 ? sw[0] : sw[1]); }
    else return __int_as_float(__builtin_amdgcn_ds_swizzle(__float_as_int(v), (M << 10) | 0x1f));
}
#define RS_STEP(lo, hi, bit, off) ((bit ? hi : lo) + xorx<off>(bit ? lo : hi, b5))
__device__ __forceinline__ float rscatter16(const float (&a)[16], int b5, int b4, int b3, int b2) {
    const float c0 = RS_STEP(a[0], a[8], b5, 32), c1 = RS_STEP(a[1], a[9], b5, 32), c2 = RS_STEP(a[2], a[10], b5, 32), c3 = RS_STEP(a[3], a[11], b5, 32);
    const float c4 = RS_STEP(a[4], a[12], b5, 32), c5 = RS_STEP(a[5], a[13], b5, 32), c6 = RS_STEP(a[6], a[14], b5, 32), c7 = RS_STEP(a[7], a[15], b5, 32);
    const float d0 = RS_STEP(c0, c4, b4, 16), d1 = RS_STEP(c1, c5, b4, 16), d2 = RS_STEP(c2, c6, b4, 16), d3 = RS_STEP(c3, c7, b4, 16);
    const float e0 = RS_STEP(d0, d2, b3, 8), e1 = RS_STEP(d1, d3, b3, 8);
    return RS_STEP(e0, e1, b2, 4);
}
__device__ __forceinline__ void n2_finish(float (&lg)[16], int b5, int b4, int b3, int b2, int my_e, int lane, float* AFF, int t) {
    float vv = rscatter16(lg, b5, b4, b3, b2);
    vv += xorx<1>(vv, b5); vv += xorx<2>(vv, b5);
    float mx = vv; mx = fmaxf(mx, xorx<4>(mx, b5)); mx = fmaxf(mx, xorx<8>(mx, b5)); mx = fmaxf(mx, xorx<16>(mx, b5)); mx = fmaxf(mx, xorx<32>(mx, b5));
    const float ex = __expf(vv - mx); float sm = ex; sm += xorx<4>(sm, b5); sm += xorx<8>(sm, b5); sm += xorx<16>(sm, b5); sm += xorx<32>(sm, b5);
    if ((lane & 3) == 0) AFF[(size_t)my_e * R + t] = ex / sm;
}
template <int VAR = 0>
__device__ __forceinline__ void ph_norm2(const Ctx& C, int l, int nrows) {
    const float* X = WSP(float, WS_X); bf16* H = VAR ? WSP(bf16, WS_XG) : WSP(bf16, WS_H); float* AFF = VAR ? WSP(float, WS_ACT) : WSP(float, WS_AFF);
    LAS float* Rs = (LAS float*)C.lds;
    const float* rt = C.in[21] + (size_t)l * D * NE;
    for (int i = C.tid; i < D * NE / 4; i += 512) { const f32x4 r4 = ((const f32x4*)rt)[i]; const int c = i >> 2, e0 = (i & 3) * 4;
        Rs[(e0 + 0) * D + c] = r4.x; Rs[(e0 + 1) * D + c] = r4.y; Rs[(e0 + 2) * D + c] = r4.z; Rs[(e0 + 3) * D + c] = r4.w; }
    __syncthreads();
    const int b5 = (C.lane >> 5) & 1, b4 = (C.lane >> 4) & 1, b3 = (C.lane >> 3) & 1, b2 = (C.lane >> 2) & 1, my_e = 8 * b5 + 4 * b4 + 2 * b3 + b2;
    for (int t0 = (C.blk * 8 + C.wave) * 2; t0 < nrows; t0 += C.G * 16) {
        asm volatile("" ::: "memory");
        const int set = t0 >= SEQ ? 1 : 0;
        f32x4 va[4], vb[4];
#pragma unroll
        for (int j = 0; j < 4; ++j) { va[j] = ((const f32x4*)(X + (size_t)t0 * D))[C.lane + 64 * j]; vb[j] = ((const f32x4*)(X + (size_t)(t0 + 1) * D))[C.lane + 64 * j]; }
        { const f32x4* w = (const f32x4*)(C.in[7] + (size_t)l * D); const f32x4* sh = (const f32x4*)modp(C, l, set, 3); const f32x4* scl = (const f32x4*)modp(C, l, set, 4);
          float sa = 0.f, sb = 0.f;
#pragma unroll
          for (int j = 0; j < 4; ++j) { sa += (va[j].x * va[j].x + va[j].y * va[j].y) + (va[j].z * va[j].z + va[j].w * va[j].w); sb += (vb[j].x * vb[j].x + vb[j].y * vb[j].y) + (vb[j].z * vb[j].z + vb[j].w * vb[j].w); }
          const float ra = rsqrtf(wave_sum(sa) * (1.f / D) + RMS_EPS), rb = rsqrtf(wave_sum(sb) * (1.f / D) + RMS_EPS);
#pragma unroll
          for (int j = 0; j < 4; ++j) { const int i = C.lane + 64 * j; const f32x4 ws = w[i] * (scl[i] + 1.f), s4 = sh[i];
              va[j] = va[j] * ra * ws + s4; vb[j] = vb[j] * rb * ws + s4;
              u32x2 o; o.x = pk2(va[j].x, va[j].y); o.y = pk2(va[j].z, va[j].w); ((u32x2*)(H + (size_t)t0 * D))[i] = o;
              o.x = pk2(vb[j].x, vb[j].y); o.y = pk2(vb[j].z, vb[j].w); ((u32x2*)(H + (size_t)(t0 + 1) * D))[i] = o; } }
        float la[16], lb[16];
#pragma unroll
        for (int e = 0; e < 16; ++e) { float s0 = 0.f, s1 = 0.f;
#pragma unroll
            for (int j = 0; j < 4; ++j) { if (VAR & 2) { s0 += va[j].x * (float)e; s1 += vb[j].y * (float)e; continue; } const f32x4 r = *(const LAS f32x4*)(Rs + e * D + 4 * (C.lane + 64 * j));
                s0 += (va[j].x * r.x + va[j].y * r.y) + (va[j].z * r.z + va[j].w * r.w); s1 += (vb[j].x * r.x + vb[j].y * r.y) + (vb[j].z * r.z + vb[j].w * r.w); }
            la[e] = s0; lb[e] = s1; }
        if (VAR & 1) { float z = 0.f;
#pragma unroll
            for (int e = 0; e < 16; ++e) z += la[e] * lb[e];
            if (C.lane == 0) AFF[t0] = z; continue; }
#pragma unroll 1
        for (int rr = 0; rr < 2; ++rr) {
            n2_finish(la, b5, b4, b3, b2, my_e, C.lane, AFF, t0 + rr);
#pragma unroll
            for (int e = 0; e < 16; ++e) la[e] = lb[e];
        }
    }
}

__device__ __forceinline__ int block_sum_i(int v, LAS int* scr, int wave, int lane) {
    v = wave_sum_i(v);
    if (lane == 0) scr[wave] = v;
    __syncthreads();
    int t = 0;
#pragma unroll
    for (int w = 0; w < 8; ++w) t += scr[w];
    __syncthreads();
    return t;
}
__device__ __forceinline__ int block_excl_scan(int v, LAS int* scr, int wave, int lane) {
    int inc = v;
#pragma unroll
    for (int o = 1; o < 64; o <<= 1) { const int n = __shfl_up(inc, o); if (lane >= o) inc += n; }
    if (lane == 63) scr[wave] = inc;
    __syncthreads();
    int off = 0;
#pragma unroll
    for (int w = 0; w < 8; ++w) off += (w < wave) ? scr[w] : 0;
    __syncthreads();
    return off + inc - v;
}
template <int KPT>
__device__ __forceinline__ void topk_unit(const Ctx& C, int e, int base, int n, int cap, int slot0) {
    const float* aff = WSP(float, WS_AFF) + (size_t)e * R + base;
    int* rowl = WSP(int, WS_ROWL) + e * EROWS; float* gatel = WSP(float, WS_GATEL) + e * EROWS; int* INV = WSP(int, WS_INV);
    LAS unsigned* hist = (LAS unsigned*)C.lds;
    LAS int* scr = (LAS int*)(hist + 2048);
    LAS unsigned* bc = hist + 2048 + 16;
    unsigned key[KPT];
    if (KPT == 32) {
#pragma unroll
        for (int j = 0; j < KPT; j += 4) { const u32x4 k4 = *(const u32x4*)(aff + C.tid * KPT + j); key[j] = k4.x; key[j + 1] = k4.y; key[j + 2] = k4.z; key[j + 3] = k4.w; }
    } else {
#pragma unroll
        for (int j = 0; j < KPT; ++j) { const int t = C.tid * KPT + j; key[j] = t < n ? __float_as_uint(aff[t]) : 0u; }
    }
    unsigned prefix = 0u, pmask = 0u; int kth = cap;
#pragma unroll 1
    for (int pass = 0; pass < 3; ++pass) {
        const int shift = pass == 0 ? 20 : (pass == 1 ? 9 : 0), nb = pass == 2 ? 512 : 2048; const unsigned dmask = (unsigned)nb - 1u;
        for (int i = C.tid; i < nb; i += 512) hist[i] = 0u;
        __syncthreads();
#pragma unroll
        for (int j = 0; j < KPT; ++j) if (key[j] != 0u && (key[j] & pmask) == prefix) __hip_atomic_fetch_add(hist + ((key[j] >> shift) & dmask), 1u, __ATOMIC_RELAXED, __HIP_MEMORY_SCOPE_WORKGROUP);
        __syncthreads();
        if (C.wave == 0) {
            const int per = nb >> 6;
            int tot = 0;
            for (int q = 0; q < per; ++q) tot += (int)hist[C.lane * per + q];
            int suf = tot;
#pragma unroll
            for (int o = 1; o < 64; o <<= 1) { const int nbv = __shfl_down(suf, o); if (C.lane + o < 64) suf += nbv; }
            const unsigned long long bal = __ballot(suf >= kth);
            const int lstar = 63 - __builtin_clzll(bal);
            if (C.lane == lstar) { int above = suf - tot; int q = per - 1;
                for (; q > 0; --q) { const int c = (int)hist[C.lane * per + q]; if (above + c >= kth) break; above += c; }
                bc[0] = (unsigned)(C.lane * per + q); bc[1] = (unsigned)(kth - above); }
        }
        __syncthreads();
        prefix |= bc[0] << shift; pmask |= dmask << shift; kth = (int)bc[1];
    }
    const int need_eq = kth;
    int ce = 0;
#pragma unroll
    for (int j = 0; j < KPT; ++j) ce += key[j] == prefix ? 1 : 0;
    int eqr = block_excl_scan(ce, scr, C.wave, C.lane);
    int nsel = 0; unsigned selmask = 0u;
#pragma unroll
    for (int j = 0; j < KPT; ++j) { bool sl = key[j] > prefix; if (key[j] == prefix) { sl = eqr < need_eq; ++eqr; } if (sl) { ++nsel; selmask |= 1u << j; } }
    int slot = block_excl_scan(nsel, scr, C.wave, C.lane);
    int invv[KPT];
#pragma unroll
    for (int j = 0; j < KPT; ++j) { const int t = C.tid * KPT + j; invv[j] = -1;
        if (t < n && ((selmask >> j) & 1u)) { rowl[slot0 + slot] = base + t; gatel[slot0 + slot] = __uint_as_float(key[j]); invv[j] = slot0 + slot; ++slot; } }
    int* invrow = INV + (size_t)e * R + base + C.tid * KPT;
    if (KPT == 32) {
#pragma unroll
        for (int j = 0; j < KPT; j += 4) *(u32x4*)(invrow + j) = (u32x4){(unsigned)invv[j], (unsigned)invv[j + 1], (unsigned)invv[j + 2], (unsigned)invv[j + 3]};
    } else {
#pragma unroll
        for (int j = 0; j < KPT; ++j) if (C.tid * KPT + j < n) invrow[j] = invv[j];
    }
}
__device__ __forceinline__ void ph_topk(const Ctx& C, bool with_ctx) {
    for (int u = C.blk; u < (with_ctx ? 32 : 16); u += C.G) {
        const int e = u & 15;
        if (u < 16) { topk_unit<32>(C, e, 0, SEQ, CAP_L, 0); int* rowl = WSP(int, WS_ROWL) + e * EROWS; for (int i = CAP_L + CAP_C + C.tid; i < EROWS; i += 512) rowl[i] = 0; }
        else topk_unit<1>(C, e, SEQ, NCTX, CAP_C, CAP_L);
        __syncthreads();
    }
}
__device__ __forceinline__ void ph_gather(const Ctx& C, bool with_ctx) {
    const int* rowl = WSP(int, WS_ROWL); const bf16* H = WSP(bf16, WS_H); bf16* XG = WSP(bf16, WS_XG);
    const int nslots = with_ctx ? CAP_L + CAP_C : CAP_L, ntot = NE * nslots;
    for (int i = C.blk * 8 + C.wave; i < ntot; i += C.G * 8) {
        const int e = i / nslots, sl = i % nslots, r = e * EROWS + sl;
        const int src = rowl[r];
        u32x4* d = (u32x4*)(XG + (size_t)r * D); const u32x4* sp = (const u32x4*)(H + (size_t)src * D);
        d[C.lane] = sp[C.lane]; d[C.lane + 64] = sp[C.lane + 64];
    }
}
__device__ __forceinline__ void rot_angles(int t, int half, int d, int quarter, float& cs, float& sn) {
    const float invf = exp2f(-(float)d * (13.287712379549449f / (float)quarter));
    const float pos = half ? (float)(t & 63) : (float)(t >> 6);
    const float ang = pos * invf;
    const double rev = (double)ang * 0.15915494309189535; const float fr = (float)(rev - __builtin_rint(rev));
    cs = __builtin_amdgcn_cosf(fr); sn = __builtin_amdgcn_sinf(fr);
}
__device__ __forceinline__ void ph_rope(const Ctx& C, bf16* buf, int hw, int nheads, int off, int quarter) {
    const int npb = quarter / 8, per_tok = 2 * npb, HG = quarter == 16 ? 2 : 4, hpg = nheads / HG; const long total = (long)SEQ * per_tok * HG;
    for (long i = (long)C.blk * 512 + C.tid; i < total; i += (long)C.G * 512) {
        const int hg = (int)(i / ((long)SEQ * per_tok)); const int r0 = (int)(i - (long)hg * SEQ * per_tok), t = r0 / per_tok, p = r0 % per_tok, half = p / npb, d0 = (p % npb) * 8;
        float cs[8], sn[8];
#pragma unroll
        for (int j = 0; j < 8; ++j) rot_angles(t, half, d0 + j, quarter, cs[j], sn[j]);
        for (int h = hg * hpg; h < (hg + 1) * hpg; ++h) {
            bf16* b = buf + (size_t)h * R * hw + (size_t)t * hw + off + half * 2 * quarter + d0;
            const u32x4 w1 = *(const u32x4*)b, w2 = *(const u32x4*)(b + quarter); u32x4 o1, o2;
#pragma unroll
            for (int j = 0; j < 4; ++j) {
                const float a0 = bf2f(w1[j] & 0xffffu), a1 = bf2f(w1[j] >> 16), b0 = bf2f(w2[j] & 0xffffu), b1 = bf2f(w2[j] >> 16);
                o1[j] = cvt_pk_bf16(a0 * cs[2 * j] - b0 * sn[2 * j], a1 * cs[2 * j + 1] - b1 * sn[2 * j + 1]);
                o2[j] = cvt_pk_bf16(a0 * sn[2 * j] + b0 * cs[2 * j], a1 * sn[2 * j + 1] + b1 * cs[2 * j + 1]); }
            *(u32x4*)b = o1; *(u32x4*)(b + quarter) = o2;
        }
    }
}
__device__ __forceinline__ void ph_mlanorm(const Ctx& C) {
    const float* CQ = WSP(float, WS_CQ); bf16* CQN = WSP(bf16, WS_CQN); bf16* CKVN = WSP(bf16, WS_CKVN); bf16* KR = WSP(bf16, WS_KROPE);
    const int NW = C.G * 8; int t = C.blk * 8 + C.wave;
    const f32x4 gq0 = ((const f32x4*)C.in[15])[C.lane], gq1 = ((const f32x4*)C.in[15])[C.lane + 64], gk0 = ((const f32x4*)C.in[18])[C.lane];
    f32x4 a0 = (f32x4){0.f, 0.f, 0.f, 0.f}, a1 = a0, b0 = a0; float x = 0.f;
    if (t < R) { const float* row = CQ + (size_t)t * D; a0 = ((const f32x4*)row)[C.lane]; a1 = ((const f32x4*)row)[C.lane + 64]; b0 = ((const f32x4*)(row + 512))[C.lane]; x = row[768 + (C.lane & 31)]; }
    for (; t < R; t += NW) {
        const int tn = t + NW < R ? t + NW : t; const float* rown = CQ + (size_t)tn * D;
        const f32x4 na0 = ((const f32x4*)rown)[C.lane], na1 = ((const f32x4*)rown)[C.lane + 64], nb0 = ((const f32x4*)(rown + 512))[C.lane]; const float nx = rown[768 + (C.lane & 31)];
        const float sa = wave_sum((a0.x * a0.x + a0.y * a0.y) + (a0.z * a0.z + a0.w * a0.w) + (a1.x * a1.x + a1.y * a1.y) + (a1.z * a1.z + a1.w * a1.w));
        const float sb = wave_sum((b0.x * b0.x + b0.y * b0.y) + (b0.z * b0.z + b0.w * b0.w));
        const float ra = rsqrtf(sa * (1.f / 512.f) + RMS_EPS), rb = rsqrtf(sb * (1.f / 256.f) + RMS_EPS);
        { const f32x4 y0 = a0 * ra * gq0, y1 = a1 * ra * gq1, z = b0 * rb * gk0;
          u32x2 o; o.x = pk2(y0.x, y0.y); o.y = pk2(y0.z, y0.w); ((u32x2*)(CQN + (size_t)t * 512))[C.lane] = o;
          o.x = pk2(y1.x, y1.y); o.y = pk2(y1.z, y1.w); ((u32x2*)(CQN + (size_t)t * 512))[C.lane + 64] = o;
          o.x = pk2(z.x, z.y); o.y = pk2(z.z, z.w); ((u32x2*)(CKVN + (size_t)t * 256))[C.lane] = o; }
        const float xp = __shfl_xor(x, 8);
        float y = x;
        if (t < SEQ) { float cs, sn; rot_angles(t, (C.lane >> 4) & 1, C.lane & 7, 8, cs, sn);
            y = ((C.lane >> 3) & 1) ? (xp * sn + x * cs) : (x * cs - xp * sn); }
        if (C.lane < 32) KR[(size_t)t * 32 + C.lane] = (bf16)f2bf(y);
        a0 = na0; a1 = na1; b0 = nb0; x = nx;
    }
}

constexpr int CW_KMAX = 8192;
__device__ __forceinline__ void ph_kmax(const Ctx& C) {
    const bf16* KV = WSP(bf16, WS_KV); const bf16* KR = WSP(bf16, WS_KROPE); unsigned* ctl = (unsigned*)(C.ws + WS_CTL);
    for (int i = C.blk * 512 + C.tid; i < 16 * R; i += C.G * 512) {
        const int h = i / R, t = i - h * R;
        const u32x4* kp = (const u32x4*)(KV + (size_t)h * R * 128 + (size_t)t * 128); const u32x4* rp = (const u32x4*)(KR + (size_t)t * 32);
        float ss = 0.f;
#pragma unroll
        for (int q = 0; q < 12; ++q) { const u32x4 w = q < 8 ? kp[q] : rp[q - 8];
            const float a0 = bf2f(w.x & 0xffffu), a1 = bf2f(w.x >> 16), a2 = bf2f(w.y & 0xffffu), a3 = bf2f(w.y >> 16), a4 = bf2f(w.z & 0xffffu), a5 = bf2f(w.z >> 16), a6 = bf2f(w.w & 0xffffu), a7 = bf2f(w.w >> 16);
            ss += (a0 * a0 + a1 * a1) + (a2 * a2 + a3 * a3) + (a4 * a4 + a5 * a5) + (a6 * a6 + a7 * a7); }
#pragma unroll
        for (int o = 1; o < 64; o <<= 1) ss = fmaxf(ss, __shfl_xor(ss, o));
        if (C.lane == 0) atomicMax(ctl + CW_KMAX + h, __float_as_uint(ss));
    }
}

namespace pg8 {
#define PG8_LAS __attribute__((address_space(3)))
typedef unsigned short bf16_t;
typedef short bf16x8 __attribute__((ext_vector_type(8)));
typedef float f32x4 __attribute__((ext_vector_type(4)));
typedef unsigned u32x4 __attribute__((ext_vector_type(4)));
constexpr int BM = 256, BK = 64, HALF = 128, HTB = HALF * BK * 2  , STAGE_BYTES = 8 * HTB, NXCD = 8, WGM = 8;

__host__ __device__ __forceinline__ int lds_byte(int r, int c) { const int st = (r >> 4) * 2 + (c >> 5), rr = r & 15, cc = c & 31, ob = rr * 64 + cc * 2; return st * 1024 + (ob ^ (((ob >> 9) & 1) << 5)); }
__host__ __device__ __forceinline__ void stage_rc(int b, int& R, int& C) { const int st = b / 1024, sb = b % 1024, swz = sb ^ (((sb >> 9) & 1) << 5); R = (st >> 1) * 16 + swz / 64; C = (st & 1) * 32 + (swz % 64) / 2; }
__host__ __device__ __forceinline__ int perm32(int rho) { const int n = rho >> 4, i = rho & 15; return 8 * (i >> 2) + 4 * n + (i & 3); }

struct Unit { int pm, pn, thin; };
struct Gemm { const bf16_t* A; const bf16_t* Bt; int M, N, K; int pm_per_grp; size_t grp_stride; };

struct StaticOrder {
    int nM, nN, nwg, G, c;
    __host__ __device__ void init(int M, int N, int G_, int c_) { nM = M / BM; nN = N / BM; nwg = nM * nN; G = G_; c = c_; }
    __host__ __device__ bool next(int i, Unit& u) const {
        const long L = (long)i * G + c; if (L >= nwg) return false;
        int wgid = (int)L; { const int q = nwg / NXCD, r = nwg % NXCD, xcd = wgid % NXCD, off = wgid / NXCD; wgid = (xcd < r ? xcd * (q + 1) : r * (q + 1) + (xcd - r) * q) + off; }
        const int nig = WGM * nN, gid = wgid / nig, fm = gid * WGM, gsz = (nM - fm) < WGM ? (nM - fm) : WGM;
        u.pm = fm + ((wgid % nig) % gsz); u.pn = (wgid % nig) / gsz; u.thin = 0; return true;
    }
    __device__ __forceinline__ void a_ready(const Unit&) const {}
    __device__ __forceinline__ void done(const Unit&) const {}
};
struct MoeOrder {
    StaticOrder base; int nN, nthin;
    __host__ __device__ void init(int N, int G_, int c_, bool with_thin) { base.init(NEXP_PANELS * BM, N, G_, c_); nN = N / BM; nthin = with_thin ? 16 * nN : 0; }
    static constexpr int NEXP_PANELS = 16 * 8;
    __host__ __device__ bool next(int i, Unit& u) const {
        if (base.next(i, u)) { u.pm = (u.pm >> 3) * 9 + (u.pm & 7); return true; }
        const long j = (long)i * base.G + base.c - base.nwg; if (j >= nthin) return false;
        u.pm = (int)(j / nN) * 9 + 8; u.pn = (int)(j % nN); u.thin = 1; return true;
    }
    __device__ __forceinline__ void a_ready(const Unit&) const {}
    __device__ __forceinline__ void done(const Unit&) const {}
};

template <class Epi, class Sched, bool ALIGN_EPI = false, bool SP2 = false, bool GATHER = false>
__device__ __forceinline__ void gemm_phase(PG8_LAS unsigned char* lds, const Gemm g, const Sched& S, const Epi& E, const PG8_LAS int* idx_tab = nullptr) {
    static_assert(!GATHER || SP2, "the gathered A panel is wired into the SP2 loop only");
    const int tid = threadIdx.x, wid = __builtin_amdgcn_readfirstlane(tid >> 6), lane = tid & 63, wr = wid >> 2, wc = wid & 3, fr = lane & 15, fq = lane >> 4;
    const int K = g.K, nt = K / BK;
    unsigned voffA[2], voffB[2]; int rowA[2]; unsigned colA[2];
#pragma unroll
    for (int i = 0; i < 2; ++i) { int R, C; stage_rc(tid * 16 + i * 8192, R, C); const int Rb = Epi::PERM ? ((R & ~31) + perm32(R & 31)) : R;
        voffA[i] = (unsigned)(R * K + C) * 2u; voffB[i] = (unsigned)(Rb * K + C) * 2u; rowA[i] = R; colA[i] = (unsigned)C * 2u; }
    unsigned vGc[2][2], vGn[2][2];
#define PG8_GOFF(dst, ui_) do { _Pragma("unroll") for (int h_ = 0; h_ < 2; ++h_) _Pragma("unroll") for (int i_ = 0; i_ < 2; ++i_) \
        dst[h_][i_] = (unsigned)idx_tab[(ui_) * 256 + h_ * HALF + rowA[i_]] * (unsigned)(K * 2) + colA[i_]; } while (0)
#define PG8_STAGE_A(bufoff, ptr, h, nf) do { if constexpr (GATHER) { _Pragma("unroll") for (int _i = 0; _i < 2; ++_i) \
        __builtin_amdgcn_global_load_lds((const unsigned*)((const char*)(ptr) + ((nf) ? vGn[h][_i] : vGc[h][_i])), (PG8_LAS unsigned*)(lds + (bufoff) + ldsw + _i * 8192), 16, 0, 0); } \
        else PG8_STAGE(bufoff, (ptr) + (h) * hstep, voffA); } while (0)
    const size_t kstep = (size_t)(BK * 2);
    const size_t hstep = (size_t)HALF * K * 2;
    const size_t tstep = 2 * hstep;
    const unsigned ldsw = (unsigned)wid * 1024u;
    const int aoff = lds_byte(wr * 64 + fr, fq * 8), boff = lds_byte(wc * 32 + fr, fq * 8);
#define PG8_SA(b, h) (((b) * 2 + (h)) * HTB)
#define PG8_SB(b, h) ((4 + (b) * 2 + (h)) * HTB)
#define PG8_STAGE(bufoff, gbase, voff) do { _Pragma("unroll") for (int _i = 0; _i < 2; ++_i) \
        __builtin_amdgcn_global_load_lds((const unsigned*)((const char*)(gbase) + (voff)[_i]), (PG8_LAS unsigned*)(lds + (bufoff) + ldsw + _i * 8192), 16, 0, 0); } while (0)
#define PG8_LDA(dst, b, h) do { _Pragma("unroll") for (int m = 0; m < 4; ++m) _Pragma("unroll") for (int k = 0; k < 2; ++k) dst[m][k] = *(const PG8_LAS bf16x8*)(lds + PG8_SA(b, h) + aoff + m * 2048 + k * 1024); } while (0)
#define PG8_LDB(dst, b, h) do { _Pragma("unroll") for (int n = 0; n < 2; ++n) _Pragma("unroll") for (int k = 0; k < 2; ++k) dst[n][k] = *(const PG8_LAS bf16x8*)(lds + PG8_SB(b, h) + boff + n * 2048 + k * 1024); } while (0)
#define PG8_MMA(ai, bj, At, Bt) do { if (cur.thin && ((ai) != 0 || wr != 0)) break; __builtin_amdgcn_s_setprio(1); _Pragma("unroll") for (int m = 0; m < 4; ++m) _Pragma("unroll") for (int n = 0; n < 2; ++n) _Pragma("unroll") for (int k = 0; k < 2; ++k) \
        acc[ai][bj][m][n] = __builtin_amdgcn_mfma_f32_16x16x32_bf16(Bt[n][k], At[m][k], acc[ai][bj][m][n], 0, 0, 0); __builtin_amdgcn_s_setprio(0); } while (0)
#define PG8_WAIT_V(n) asm volatile("s_waitcnt vmcnt(" #n ")" ::: "memory")
#define PG8_WAIT_L(n) asm volatile("s_waitcnt lgkmcnt(" #n ")" ::: "memory")
#define PG8_BAR __builtin_amdgcn_s_barrier()
#define PG8_SCHED __builtin_amdgcn_sched_barrier(0)
    Unit cur, nxt; int ui = 0;
    if (!S.next(0, cur)) return;
    f32x4 acc[2][2][4][2];
#pragma unroll
    for (int a = 0; a < 2; ++a)
#pragma unroll
        for (int b = 0; b < 2; ++b)
#pragma unroll
            for (int m = 0; m < 4; ++m)
#pragma unroll
                for (int n = 0; n < 2; ++n) acc[a][b][m][n] = (f32x4){0.f, 0.f, 0.f, 0.f};
    bf16x8 At[4][2], B0[2][2], B1[2][2];
    const char* cA = GATHER ? (const char*)g.A : (const char*)g.A + (size_t)cur.pm * tstep; const char* cB = (const char*)g.Bt + (g.pm_per_grp ? (size_t)(cur.pm / g.pm_per_grp) * g.grp_stride * 2 : (size_t)0) + (size_t)cur.pn * tstep;
    S.a_ready(cur);
    if constexpr (GATHER) { PG8_GOFF(vGc, 0); }
    if constexpr (SP2) {
        PG8_STAGE(PG8_SB(0, 0), cB, voffB); PG8_STAGE(PG8_SB(0, 1), cB + hstep, voffB); PG8_STAGE_A(PG8_SA(0, 0), cA, 0, false); PG8_STAGE_A(PG8_SA(0, 1), cA, 1, false);
        if (wr == 1) PG8_BAR;
        PG8_WAIT_V(2); PG8_BAR;
        PG8_STAGE(PG8_SB(1, 0), cB + kstep, voffB); PG8_STAGE_A(PG8_SA(1, 0), cA + kstep, 0, false); PG8_STAGE(PG8_SB(1, 1), cB + hstep + kstep, voffB);
        PG8_WAIT_V(6); PG8_BAR;
    } else {
        PG8_STAGE(PG8_SB(0, 0), cB, voffB); PG8_STAGE(PG8_SA(0, 0), cA, voffA); PG8_STAGE(PG8_SB(0, 1), cB + hstep, voffB); PG8_STAGE(PG8_SA(0, 1), cA + hstep, voffA);
        if (wr == 1) PG8_BAR;
        PG8_WAIT_V(4); PG8_BAR;
        PG8_STAGE(PG8_SB(1, 0), cB + kstep, voffB); PG8_STAGE(PG8_SA(1, 0), cA + kstep, voffA); PG8_STAGE(PG8_SB(1, 1), cB + hstep + kstep, voffB);
        PG8_WAIT_V(6); PG8_BAR;
    }
    for (;;) {
        const bool has_next = S.next(ui + 1, nxt);
        const char* nA = GATHER ? (const char*)g.A : (has_next ? (const char*)g.A + (size_t)nxt.pm * tstep : cA);
        if constexpr (GATHER) { if (has_next) { PG8_GOFF(vGn, ui + 1); } else {
#pragma unroll
            for (int h_ = 0; h_ < 2; ++h_) { vGn[h_][0] = vGc[h_][0]; vGn[h_][1] = vGc[h_][1]; } } } const char* nB = has_next ? (const char*)g.Bt + (g.pm_per_grp ? (size_t)(nxt.pm / g.pm_per_grp) * g.grp_stride * 2 : (size_t)0) + (size_t)nxt.pn * tstep : cB;
        for (int t = 0; t < nt; t += 2) {
            const bool last = (t == nt - 2);
            const char* a1 = cA + (size_t)(t + 1) * kstep;
            const char* a2 = last ? nA : cA + (size_t)(t + 2) * kstep; const char* b2 = last ? nB : cB + (size_t)(t + 2) * kstep;
            const char* a3 = a2 + kstep; const char* b3 = b2 + kstep;
            if (last && has_next) S.a_ready(nxt);
            if constexpr (SP2) {
            PG8_LDB(B0, 0, 0); PG8_LDB(B1, 0, 1); PG8_SCHED; PG8_LDA(At, 0, 0); PG8_STAGE_A(PG8_SA(1, 1), a1, 1, false);
            PG8_WAIT_V(8); PG8_WAIT_L(0); PG8_BAR; PG8_MMA(0, 0, At, B0); PG8_MMA(0, 1, At, B1); PG8_BAR; PG8_SCHED;
            PG8_LDA(At, 0, 1); PG8_STAGE(PG8_SB(0, 0), b2, voffB); PG8_STAGE(PG8_SB(0, 1), b2 + hstep, voffB); PG8_STAGE_A(PG8_SA(0, 0), a2, 0, last);
            PG8_WAIT_V(8); PG8_WAIT_L(0); PG8_BAR; PG8_MMA(1, 0, At, B0); PG8_MMA(1, 1, At, B1); PG8_BAR; PG8_SCHED;
            PG8_LDB(B0, 1, 0); PG8_LDB(B1, 1, 1); PG8_SCHED; PG8_LDA(At, 1, 0); PG8_STAGE_A(PG8_SA(0, 1), a2, 1, last);
            PG8_WAIT_V(8); PG8_WAIT_L(0); PG8_BAR; PG8_MMA(0, 0, At, B0); PG8_MMA(0, 1, At, B1); PG8_BAR; PG8_SCHED;
            PG8_LDA(At, 1, 1); PG8_STAGE(PG8_SB(1, 0), b3, voffB); PG8_STAGE(PG8_SB(1, 1), b3 + hstep, voffB); PG8_STAGE_A(PG8_SA(1, 0), a3, 0, last);
            PG8_WAIT_V(8); PG8_WAIT_L(0); PG8_BAR; PG8_MMA(1, 0, At, B0); PG8_MMA(1, 1, At, B1); PG8_BAR; PG8_SCHED;
            } else {
            PG8_LDB(B0, 0, 0); PG8_SCHED; PG8_LDA(At, 0, 0); PG8_STAGE(PG8_SA(1, 1), a1 + hstep, voffA);
            PG8_WAIT_L(8); PG8_BAR; PG8_WAIT_L(0); PG8_MMA(0, 0, At, B0); PG8_BAR; PG8_SCHED;
            PG8_LDB(B1, 0, 1); PG8_STAGE(PG8_SB(0, 0), b2, voffB);
            PG8_BAR; PG8_WAIT_L(0); PG8_MMA(0, 1, At, B1); PG8_BAR;
            PG8_LDA(At, 0, 1); PG8_STAGE(PG8_SA(0, 0), a2, voffA);
            PG8_BAR; PG8_WAIT_L(0); PG8_MMA(1, 0, At, B0); PG8_BAR; PG8_SCHED;
            PG8_STAGE(PG8_SB(0, 1), b2 + hstep, voffB);
            PG8_WAIT_V(6); PG8_BAR; PG8_MMA(1, 1, At, B1); PG8_BAR;
            PG8_LDB(B0, 1, 0); PG8_SCHED; PG8_LDA(At, 1, 0); PG8_STAGE(PG8_SA(0, 1), a2 + hstep, voffA);
            PG8_WAIT_L(8); PG8_BAR; PG8_WAIT_L(0); PG8_MMA(0, 0, At, B0); PG8_BAR; PG8_SCHED;
            PG8_LDB(B1, 1, 1); PG8_STAGE(PG8_SB(1, 0), b3, voffB);
            PG8_BAR; PG8_WAIT_L(0); PG8_MMA(0, 1, At, B1); PG8_BAR;
            PG8_LDA(At, 1, 1); PG8_STAGE(PG8_SA(1, 0), a3, voffA);
            PG8_BAR; PG8_WAIT_L(0); PG8_MMA(1, 0, At, B0); PG8_BAR; PG8_SCHED;
            PG8_STAGE(PG8_SB(1, 1), b3 + hstep, voffB);
            PG8_WAIT_V(6); PG8_BAR; PG8_MMA(1, 1, At, B1); PG8_BAR;
            }
        }
        if constexpr (ALIGN_EPI) { if (wr == 0) PG8_BAR; }
        if constexpr (!Epi::AFTER_DRAIN) { E(acc, cur, wr, wc, fr, fq); S.done(cur); }
        if (!has_next) break;
#pragma unroll
        for (int a = 0; a < 2; ++a)
#pragma unroll
            for (int b = 0; b < 2; ++b)
#pragma unroll
                for (int m = 0; m < 4; ++m)
#pragma unroll
                    for (int n = 0; n < 2; ++n) acc[a][b][m][n] = (f32x4){0.f, 0.f, 0.f, 0.f};
        cur = nxt; cA = nA; cB = nB; ++ui;
        if constexpr (GATHER) {
#pragma unroll
            for (int h_ = 0; h_ < 2; ++h_) { vGc[h_][0] = vGn[h_][0]; vGc[h_][1] = vGn[h_][1]; } }
        if constexpr (ALIGN_EPI) { if (wr == 1) PG8_BAR; }
    }
    PG8_WAIT_V(0);
    if constexpr (!ALIGN_EPI) { if (wr == 0) PG8_BAR; }
    PG8_BAR;
    if constexpr (Epi::AFTER_DRAIN) { E.fused(acc, cur, wr, wc, fr, fq, lds, wid, lane); S.done(cur); }
#undef PG8_GOFF
#undef PG8_STAGE_A
#undef PG8_SA
#undef PG8_SB
#undef PG8_STAGE
#undef PG8_LDA
#undef PG8_LDB
#undef PG8_MMA
#undef PG8_WAIT_V
#undef PG8_WAIT_L
#undef PG8_BAR
#undef PG8_SCHED
}
}
#ifndef USE_PG8
#define USE_PG8 1
#endif

typedef const f32x4 (&AccRef)[2][2][4][2];
struct EpiStoreBf16 { static constexpr bool DUAL = false, PERM = true, AFTER_DRAIN = false; bf16* O; int ldc;
    __device__ __forceinline__ void elem(int row, int col, float v, float) const { O[(size_t)row * ldc + col] = (bf16)f2bf(v); }
    __device__ __forceinline__ void operator()(AccRef acc, const pg8::Unit& u, int wr, int wc, int fr, int fq) const {
        const int row0 = u.pm * 256 + wr * 64 + fr, col0 = u.pn * 256 + wc * 32 + 8 * fq;
#pragma unroll
        for (int ai = 0; ai < 2; ++ai)
#pragma unroll
            for (int m = 0; m < 4; ++m) { bf16* rowp = O + (size_t)(row0 + ai * 128 + m * 16) * ldc + col0;
#pragma unroll
                for (int bj = 0; bj < 2; ++bj) { const f32x4 v0 = acc[ai][bj][m][0], v1 = acc[ai][bj][m][1];
                    u32x4 w; w.x = cvt_pk_bf16(v0[0], v0[1]); w.y = cvt_pk_bf16(v0[2], v0[3]); w.z = cvt_pk_bf16(v1[0], v1[1]); w.w = cvt_pk_bf16(v1[2], v1[3]);
                    *(u32x4*)(rowp + bj * 128) = w; } }
    } };
struct EpiStoreHeads { static constexpr bool DUAL = false, PERM = true, AFTER_DRAIN = false; bf16* O; int hw; size_t hstride;
    __device__ __forceinline__ void store4(int row, int col, f32x4 v) const { const int hd = col / hw, wi = col - hd * hw; u32x2 o; o.x = cvt_pk_bf16(v[0], v[1]); o.y = cvt_pk_bf16(v[2], v[3]); *(u32x2*)(O + (size_t)hd * hstride + (size_t)row * hw + wi) = o; }
    __device__ __forceinline__ void elem(int row, int col, float v, float) const { O[(size_t)(col / hw) * hstride + (size_t)row * hw + (col % hw)] = (bf16)f2bf(v); }
    __device__ __forceinline__ void operator()(AccRef acc, const pg8::Unit& u, int wr, int wc, int fr, int fq) const {
        const int row0 = u.pm * 256 + wr * 64 + fr, col0 = u.pn * 256 + wc * 32 + 8 * fq;
#pragma unroll
        for (int bj = 0; bj < 2; ++bj) { const int c = col0 + bj * 128, hd = c / hw, wi = c - hd * hw; bf16* base = O + (size_t)hd * hstride + wi;
#pragma unroll
            for (int ai = 0; ai < 2; ++ai)
#pragma unroll
                for (int m = 0; m < 4; ++m) { const f32x4 v0 = acc[ai][bj][m][0], v1 = acc[ai][bj][m][1];
                    u32x4 w; w.x = cvt_pk_bf16(v0[0], v0[1]); w.y = cvt_pk_bf16(v0[2], v0[3]); w.z = cvt_pk_bf16(v1[0], v1[1]); w.w = cvt_pk_bf16(v1[2], v1[3]);
                    *(u32x4*)(base + (size_t)(row0 + ai * 128 + m * 16) * hw) = w; } }
    } };
struct EpiStoreF32 { static constexpr bool DUAL = false, PERM = false, AFTER_DRAIN = false; float* O; int ldc;
    __device__ __forceinline__ void store4(int row, int col, f32x4 v) const { *(f32x4*)(O + (size_t)row * ldc + col) = v; }
    __device__ __forceinline__ void elem(int row, int col, float v, float) const { O[(size_t)row * ldc + col] = v; }
    __device__ __forceinline__ void operator()(AccRef acc, const pg8::Unit& u, int wr, int wc, int fr, int fq) const {
        const int row0 = u.pm * 256 + wr * 64 + fr, col0 = u.pn * 256 + wc * 32 + 4 * fq;
#pragma unroll
        for (int ai = 0; ai < 2; ++ai)
#pragma unroll
            for (int m = 0; m < 4; ++m) { float* rowp = O + (size_t)(row0 + ai * 128 + m * 16) * ldc + col0;
#pragma unroll
                for (int bj = 0; bj < 2; ++bj)
#pragma unroll
                    for (int n = 0; n < 2; ++n) *(f32x4*)(rowp + bj * 128 + n * 16) = acc[ai][bj][m][n]; }
    } };
struct EpiResid { static constexpr bool DUAL = false, PERM = false, AFTER_DRAIN = false; float* X; const float* g_lat; const float* g_ctx;
    __device__ __forceinline__ void store4(int row, int col, f32x4 v) const { const float* g = row >= SEQ ? g_ctx : g_lat; f32x4* p = (f32x4*)(X + (size_t)row * D + col); *p = *p + *(const f32x4*)(g + col) * v; }
    __device__ __forceinline__ void elem(int row, int col, float v, float) const { const float g = row >= SEQ ? g_ctx[col] : g_lat[col]; X[(size_t)row * D + col] += g * v; }
    __device__ __forceinline__ void operator()(AccRef acc, const pg8::Unit& u, int wr, int wc, int fr, int fq) const {
        const int row0 = u.pm * 256 + wr * 64 + fr, col0 = u.pn * 256 + wc * 32 + 4 * fq;
        const float* g = (u.pm * 256 >= SEQ) ? g_ctx : g_lat;
        f32x4 gv[2][2];
#pragma unroll
        for (int bj = 0; bj < 2; ++bj)
#pragma unroll
            for (int n = 0; n < 2; ++n) gv[bj][n] = *(const f32x4*)(g + col0 + bj * 128 + n * 16);
#pragma unroll
        for (int ai = 0; ai < 2; ++ai)
#pragma unroll
            for (int m = 0; m < 4; ++m) { float* rowp = X + (size_t)(row0 + ai * 128 + m * 16) * D + col0;
#pragma unroll
                for (int bj = 0; bj < 2; ++bj)
#pragma unroll
                    for (int n = 0; n < 2; ++n) { f32x4* p = (f32x4*)(rowp + bj * 128 + n * 16); *p = *p + gv[bj][n] * acc[ai][bj][m][n]; } }
    } };
__device__ __forceinline__ float silu_mul(float g, float u) { return g * __builtin_amdgcn_rcpf(1.f + __expf(-g)) * u; }
struct EpiSwiglu { static constexpr bool DUAL = true, PERM = true, AFTER_DRAIN = false; bf16* ACT;
    __device__ __forceinline__ void elem(int row, int col, float g, float u) const { ACT[(size_t)row * FF + col] = (bf16)f2bf(g / (1.f + __expf(-g)) * u); }
    __device__ __forceinline__ void operator()(AccRef acc, const pg8::Unit& u, int wr, int wc, int fr, int fq) const {
        const int row0 = u.pm * 256 + wr * 64 + fr, col0 = u.pn * 128 + wc * 32 + 8 * fq;
#pragma unroll
        for (int ai = 0; ai < 2; ++ai)
#pragma unroll
            for (int m = 0; m < 4; ++m) { bf16* rowp = ACT + (size_t)(row0 + ai * 128 + m * 16) * FF + col0;
                const f32x4 g0 = acc[ai][0][m][0], g1 = acc[ai][0][m][1], u0 = acc[ai][1][m][0], u1 = acc[ai][1][m][1];
                u32x4 w; w.x = cvt_pk_bf16(silu_mul(g0[0], u0[0]), silu_mul(g0[1], u0[1])); w.y = cvt_pk_bf16(silu_mul(g0[2], u0[2]), silu_mul(g0[3], u0[3]));
                w.z = cvt_pk_bf16(silu_mul(g1[0], u1[0]), silu_mul(g1[1], u1[1])); w.w = cvt_pk_bf16(silu_mul(g1[2], u1[2]), silu_mul(g1[3], u1[3]));
                *(u32x4*)rowp = w; }
    } };
struct EpiMoeOut { static constexpr bool DUAL = false, PERM = true, AFTER_DRAIN = false; bf16* YB; const float* gatel;
    __device__ __forceinline__ void elem(int row, int col, float v, float) const { YB[(size_t)row * D + col] = (bf16)f2bf(v * gatel[row]); }
    __device__ __forceinline__ void operator()(AccRef acc, const pg8::Unit& u, int wr, int wc, int fr, int fq) const {
        const int row0 = u.pm * 256 + wr * 64 + fr, col0 = u.pn * 256 + wc * 32 + 8 * fq;
#pragma unroll
        for (int ai = 0; ai < 2; ++ai)
#pragma unroll
            for (int m = 0; m < 4; ++m) { const int row = row0 + ai * 128 + m * 16; const float gt = gatel[row]; bf16* rowp = YB + (size_t)row * D + col0;
#pragma unroll
                for (int bj = 0; bj < 2; ++bj) { const f32x4 v0 = acc[ai][bj][m][0] * gt, v1 = acc[ai][bj][m][1] * gt;
                    u32x4 w; w.x = cvt_pk_bf16(v0[0], v0[1]); w.y = cvt_pk_bf16(v0[2], v0[3]); w.z = cvt_pk_bf16(v1[0], v1[1]); w.w = cvt_pk_bf16(v1[2], v1[3]);
                    *(u32x4*)(rowp + bj * 128) = w; } }
    } };

template <class Epi>
__device__ __forceinline__ void naive_gemm(const Ctx& C, const bf16* A, const bf16* Bt, int M, int N, int K, int pm_per_grp, size_t grp_stride, const Epi& E) {
    LAS float* As = (LAS float*)C.lds;
    LAS float* Bs = As + 16 * 132;
    LAS float* Bs2 = Bs + 16 * 68;
    const int NO = Epi::DUAL ? N / 2 : N, tn_cnt = NO / 64, nun = (M / 128) * tn_cnt;
    const int ty = C.tid >> 4, tx = C.tid & 15;
    for (int u = C.blk; u < nun; u += C.G) {
        const int tm = u / tn_cnt, tn = u % tn_cnt, row0 = tm * 128, oc0 = tn * 64;
        const bf16* Bg = Bt + (pm_per_grp ? (size_t)((row0 / 256) / pm_per_grp) * grp_stride : (size_t)0);
        const int brow0 = Epi::DUAL ? ((oc0 >> 7) * 256 + (oc0 & 127)) : oc0;
        float acc[4][4], acc2[4][4];
#pragma unroll
        for (int i = 0; i < 4; ++i)
#pragma unroll
            for (int j = 0; j < 4; ++j) { acc[i][j] = 0.f; acc2[i][j] = 0.f; }
        for (int k0 = 0; k0 < K; k0 += 16) {
            __syncthreads();
            { const int r = C.tid >> 2, kc = (C.tid & 3) * 4;
              const u32x2 w = *(const u32x2*)(A + (size_t)(row0 + r) * K + k0 + kc);
              As[(kc + 0) * 132 + r] = bf2f(w.x & 0xffffu); As[(kc + 1) * 132 + r] = bf2f(w.x >> 16); As[(kc + 2) * 132 + r] = bf2f(w.y & 0xffffu); As[(kc + 3) * 132 + r] = bf2f(w.y >> 16); }
            if (C.tid < 256) { const int r = C.tid >> 2, kc = (C.tid & 3) * 4;
              const u32x2 w = *(const u32x2*)(Bg + (size_t)(brow0 + r) * K + k0 + kc);
              Bs[(kc + 0) * 68 + r] = bf2f(w.x & 0xffffu); Bs[(kc + 1) * 68 + r] = bf2f(w.x >> 16); Bs[(kc + 2) * 68 + r] = bf2f(w.y & 0xffffu); Bs[(kc + 3) * 68 + r] = bf2f(w.y >> 16);
              if (Epi::DUAL) { const u32x2 w2 = *(const u32x2*)(Bg + (size_t)(brow0 + 128 + r) * K + k0 + kc);
                Bs2[(kc + 0) * 68 + r] = bf2f(w2.x & 0xffffu); Bs2[(kc + 1) * 68 + r] = bf2f(w2.x >> 16); Bs2[(kc + 2) * 68 + r] = bf2f(w2.y & 0xffffu); Bs2[(kc + 3) * 68 + r] = bf2f(w2.y >> 16); } }
            __syncthreads();
#pragma unroll
            for (int kk = 0; kk < 16; ++kk) {
                const f32x4 a = *(const LAS f32x4*)(As + kk * 132 + ty * 4), b = *(const LAS f32x4*)(Bs + kk * 68 + tx * 4);
#pragma unroll
                for (int i = 0; i < 4; ++i)
#pragma unroll
                    for (int j = 0; j < 4; ++j) acc[i][j] += a[i] * b[j];
                if (Epi::DUAL) { const f32x4 b2 = *(const LAS f32x4*)(Bs2 + kk * 68 + tx * 4);
#pragma unroll
                    for (int i = 0; i < 4; ++i)
#pragma unroll
                        for (int j = 0; j < 4; ++j) acc2[i][j] += a[i] * b2[j]; }
            }
        }
#pragma unroll
        for (int i = 0; i < 4; ++i)
#pragma unroll
            for (int j = 0; j < 4; ++j) E.elem(row0 + ty * 4 + i, oc0 + tx * 4 + j, acc[i][j], acc2[i][j]);
    }
    __syncthreads();
}

template <class Epi>
__device__ __forceinline__ void gemm(const Ctx& C, const bf16* A, const bf16* Bt, int M, int N, int K, int pm_per_grp, size_t grp_stride, const Epi& E) {
#if USE_PG8
    pg8::Gemm g{A, Bt, M, N, K, pm_per_grp, grp_stride}; pg8::StaticOrder S; S.init(M, N, C.G, C.blk);
    pg8::gemm_phase<Epi, pg8::StaticOrder, true, true>(C.lds, g, S, E);
#else
    naive_gemm(C, A, Bt, M, N, K, pm_per_grp, grp_stride, E);
#endif
}
template <class Epi>
__device__ __forceinline__ void small_gemm(const Ctx& C, const bf16* A, const bf16* Bt, int row0, int nrows, int N, int K, const Epi& E) {
    const int ql = C.lane & 31, hi = C.lane >> 5, nrb = nrows / 32, nitems = nrb * (N / 32), NW = C.G * 8;
    int S = 1; while (S < 8 && nitems * (S * 2) <= NW && K / (S * 2) >= 128) S *= 2;
    const int ipb = 8 / S, slot = C.wave / S, kpart = C.wave % S, klen = K / S;
    LAS float* red = (LAS float*)C.lds;
    __syncthreads();
    for (int base = C.blk * ipb; base < nitems; base += C.G * ipb) {
        const int it = base + slot, cb = it / nrb, rb = it % nrb;
        const bf16* ap = A + (size_t)(row0 + rb * 32 + ql) * K + 8 * hi + kpart * klen; const bf16* bp = Bt + (size_t)(cb * 32 + ql) * K + 8 * hi + kpart * klen;
        f32x16 acc;
#pragma unroll
        for (int r = 0; r < 16; ++r) acc[r] = 0.f;
        if ((klen & 255) == 0) {
#pragma unroll 1
            for (int k0 = 0; k0 < klen; k0 += 256) {
                bf16x8 a[16], b[16];
#pragma unroll
                for (int q = 0; q < 16; ++q) { a[q] = *(const bf16x8*)(ap + k0 + 16 * q); b[q] = *(const bf16x8*)(bp + k0 + 16 * q); }
                __builtin_amdgcn_sched_barrier(0);
#pragma unroll
                for (int q = 0; q < 16; ++q) acc = __builtin_amdgcn_mfma_f32_32x32x16_bf16(b[q], a[q], acc, 0, 0, 0);
                __builtin_amdgcn_sched_barrier(0);
            }
        } else {
#pragma unroll 1
            for (int k0 = 0; k0 < klen; k0 += 128) {
                bf16x8 a[8], b[8];
#pragma unroll
                for (int q = 0; q < 8; ++q) { a[q] = *(const bf16x8*)(ap + k0 + 16 * q); b[q] = *(const bf16x8*)(bp + k0 + 16 * q); }
                __builtin_amdgcn_sched_barrier(0);
#pragma unroll
                for (int q = 0; q < 8; ++q) acc = __builtin_amdgcn_mfma_f32_32x32x16_bf16(b[q], a[q], acc, 0, 0, 0);
                __builtin_amdgcn_sched_barrier(0);
            }
        }
        if (kpart != 0) {
#pragma unroll
            for (int r = 0; r < 16; ++r) red[((slot * 7 + kpart - 1) * 16 + r) * 64 + C.lane] = acc[r]; }
        __syncthreads();
        if (kpart == 0) {
            for (int pz = 0; pz < S - 1; ++pz) {
#pragma unroll
                for (int r = 0; r < 16; ++r) acc[r] += red[((slot * 7 + pz) * 16 + r) * 64 + C.lane]; }
            const int row = row0 + rb * 32 + ql;
#pragma unroll
            for (int g = 0; g < 4; ++g) E.store4(row, cb * 32 + 8 * g + 4 * hi, (f32x4){acc[4 * g], acc[4 * g + 1], acc[4 * g + 2], acc[4 * g + 3]});
        }
        __syncthreads();
    }
}
template <class Epi>
__device__ __forceinline__ void gemm_tok(const Ctx& C, const bf16* A, const bf16* Bt, int N, int K, bool with_ctx, const Epi& E) {
#if USE_PG8
    gemm(C, A, Bt, SEQ, N, K, 0, 0, E);
    if (with_ctx) small_gemm(C, A, Bt, SEQ, NCTX, N, K, E);
#else
    naive_gemm(C, A, Bt, with_ctx ? R : SEQ, N, K, 0, 0, E);
#endif
}
__device__ __forceinline__ void small_moe2(const Ctx& C, const bf16* ACT, const bf16* Wdn, const float* gatel, bf16* YB) {
    const int ql = C.lane & 31, hi = C.lane >> 5, sub = C.wave & 1, qt = C.wave >> 1;
    LAS float* red = (LAS float*)C.lds;
    __syncthreads();
    for (int base = C.blk * 2; base < 16 * 32; base += C.G * 2) {
        const int it = base + sub, e = it >> 5, c0 = (it & 31) * 32, xr = e * EROWS + CAP_L + ql;
        const bf16* ap = ACT + (size_t)xr * FF + 8 * hi + qt * 512; const bf16* bp = Wdn + ((size_t)e * 1024 + c0 + ql) * FF + 8 * hi + qt * 512;
        f32x16 acc;
#pragma unroll
        for (int r = 0; r < 16; ++r) acc[r] = 0.f;
#pragma unroll 1
        for (int k0 = 0; k0 < 512; k0 += 256) {
            bf16x8 a[16], b[16];
#pragma unroll
            for (int q = 0; q < 16; ++q) { a[q] = *(const bf16x8*)(ap + k0 + 16 * q); b[q] = *(const bf16x8*)(bp + k0 + 16 * q); }
            __builtin_amdgcn_sched_barrier(0);
#pragma unroll
            for (int q = 0; q < 16; ++q) acc = __builtin_amdgcn_mfma_f32_32x32x16_bf16(b[q], a[q], acc, 0, 0, 0);
            __builtin_amdgcn_sched_barrier(0);
        }
        if (qt != 0) {
#pragma unroll
            for (int r = 0; r < 16; ++r) red[((sub * 3 + qt - 1) * 16 + r) * 64 + C.lane] = acc[r]; }
        __syncthreads();
        if (qt == 0) {
#pragma unroll
            for (int r = 0; r < 16; ++r) acc[r] += (red[((sub * 3 + 0) * 16 + r) * 64 + C.lane] + red[((sub * 3 + 1) * 16 + r) * 64 + C.lane]) + red[((sub * 3 + 2) * 16 + r) * 64 + C.lane];
            const float gt = gatel[xr]; bf16* orow = YB + (size_t)xr * D + c0 + 4 * hi;
#pragma unroll
            for (int g4 = 0; g4 < 4; ++g4) { u32x2 o; o.x = cvt_pk_bf16(acc[4 * g4] * gt, acc[4 * g4 + 1] * gt); o.y = cvt_pk_bf16(acc[4 * g4 + 2] * gt, acc[4 * g4 + 3] * gt); *(u32x2*)(orow + 8 * g4) = o; }
        }
        __syncthreads();
    }
}
constexpr int LDS_IDX_OFF = 132096;
template <class Epi>
__device__ __forceinline__ void gemm_moe(const Ctx& C, const bf16* A, const bf16* Bt, int N, int K, size_t grp_stride, bool with_ctx, const Epi& E, const int* rowlist = nullptr) {
#if USE_PG8
    pg8::Gemm g{A, Bt, XROWS, N, K, 9, grp_stride}; pg8::MoeOrder S; S.init(N, C.G, C.blk, with_ctx);
    if (rowlist) {
        LAS int* tab = (LAS int*)(C.lds + LDS_IDX_OFF); pg8::Unit u;
        for (int i = 0; S.next(i, u); ++i) if (C.tid < 256) tab[i * 256 + C.tid] = rowlist[u.pm * 256 + C.tid];
        __syncthreads();
        pg8::gemm_phase<Epi, pg8::MoeOrder, true, true, true>(C.lds, g, S, E, tab);
        return;
    }
    pg8::gemm_phase<Epi, pg8::MoeOrder, true, true>(C.lds, g, S, E);
#else
    naive_gemm(C, A, Bt, XROWS, N, K, 9, grp_stride, E);
#endif
}

template <int KIND>
__device__ __forceinline__ void ph_attn_naive(const Ctx& C, int slot) {
    constexpr int DQK = KIND == 2 ? 96 : 64, DH = DQK / 2;
    LAS float* Ks = (LAS float*)C.lds;
    LAS float* Vs = Ks + 32 * DQK;
    LAS float* Bsm = Vs + 32 * 64;
    const bf16 *Qb, *Kb, *Vb, *KRb = nullptr; int qp, kp, vp, kgrp = 1; size_t qhs, khs, vhs; float scale;
    if (KIND == 0) { Qb = WSP(bf16, WS_QKV); Kb = Qb + (size_t)16 * R * 64; Vb = Qb + (size_t)32 * R * 64; qp = kp = vp = 64; qhs = khs = vhs = (size_t)R * 64; scale = 0.125f; }
    else if (KIND == 1) { Qb = WSP(bf16, WS_QKV); Kb = Qb + (size_t)16 * R * 64; Vb = Qb + (size_t)20 * R * 64; qp = kp = vp = 64; qhs = khs = vhs = (size_t)R * 64; kgrp = 4; scale = 0.125f; }
    else { Qb = WSP(bf16, WS_Q); Kb = WSP(bf16, WS_KV); Vb = Kb + 64; KRb = WSP(bf16, WS_KROPE); qp = 96; kp = vp = 128; qhs = (size_t)R * 96; khs = vhs = (size_t)R * 128; scale = 0.10206207261596575f; }
    bf16* Ob = WSP(bf16, WS_O);
    const int half = C.tid & 1, qi = C.tid >> 1;
    for (int u = C.blk; u < 1040; u += C.G) {
        const bool isctx = u >= 1024;
        const int h = isctx ? (u - 1024) : (u & 15), q0 = isctx ? SEQ : (u >> 4) * 256, kh = h / kgrp;
        const int t = q0 + qi;
        float q[DH], o[32];
        { const bf16* qr = Qb + (size_t)t * qp + h * qhs + half * DH;
#pragma unroll
          for (int d = 0; d < DH; d += 8) { const u32x4 w = *(const u32x4*)(qr + d);
              q[d + 0] = bf2f(w.x & 0xffffu); q[d + 1] = bf2f(w.x >> 16); q[d + 2] = bf2f(w.y & 0xffffu); q[d + 3] = bf2f(w.y >> 16);
              q[d + 4] = bf2f(w.z & 0xffffu); q[d + 5] = bf2f(w.z >> 16); q[d + 6] = bf2f(w.w & 0xffffu); q[d + 7] = bf2f(w.w >> 16); } }
#pragma unroll
        for (int d = 0; d < 32; ++d) o[d] = 0.f;
        float m = -INFINITY, l = 0.f;
        if (KIND == 1) { m = C.in[13][h]; l = 1.f; }
        int klo = 0, khi = 0;
        if (!isctx) {
            if (KIND == 0) { const int r0 = q0 >> 6; const int ra = r0 - 4 < 0 ? 0 : r0 - 4, rb = r0 + 7 > 255 ? 255 : r0 + 7; klo = ra * 64; khi = (rb + 1) * 64; }
            else if (KIND == 1) { klo = q0 - 128 < 0 ? 0 : q0 - 128; khi = q0 + 384 > SEQ ? SEQ : q0 + 384; }
            else { klo = 0; khi = SEQ; }
        }
        if (KIND == 0) { __syncthreads(); const float* rp = C.in[10] + ((size_t)slot * 16 + h) * 465; for (int i = C.tid; i < 465; i += 512) Bsm[i] = rp[i]; }
        const int qr_ = t >> 6, qc_ = t & 63;
        int rs = qr_ - 4; rs = rs < 0 ? 0 : (rs > 248 ? 248 : rs);
        int cs0 = qc_ - 8; cs0 = cs0 < 0 ? 0 : (cs0 > 48 ? 48 : cs0);
        for (int seg = 0; seg < 2; ++seg) {
            const int kb = seg == 0 ? klo : SEQ, ke = seg == 0 ? khi : R;
            for (int k0 = kb; k0 < ke; k0 += 32) {
                __syncthreads();
                for (int i = C.tid; i < 32 * DQK; i += 512) { const int j = i / DQK, d = i % DQK; const int row = k0 + j;
                    unsigned b;
                    if (KIND == 2 && d >= 64) b = KRb[(size_t)row * 32 + (d - 64)]; else b = Kb[(size_t)row * kp + kh * khs + d];
                    Ks[i] = bf2f(b); }
                for (int i = C.tid; i < 32 * 64; i += 512) { const int j = i >> 6, d = i & 63; Vs[i] = bf2f(Vb[(size_t)(k0 + j) * vp + kh * vhs + d]); }
                __syncthreads();
#pragma unroll 1
                for (int j = 0; j < 32; ++j) {
                    const int kt = k0 + j; bool valid = true; float bias = 0.f;
                    if (seg == 0) {
                        if (KIND == 0) { const int kr = kt >> 6, kc = kt & 63; valid = kr >= rs && kr < rs + 8 && kc >= cs0 && kc < cs0 + 16;
                            if (valid) bias = Bsm[(kr - qr_ + 7) * 31 + (kc - qc_ + 15)]; }
                        else if (KIND == 1) { const int dd = kt - t; valid = dd <= 128 && dd >= -128; }
                    }
                    float s0 = 0.f, s1 = 0.f;
#pragma unroll
                    for (int d = 0; d < DH; d += 4) { const f32x4 kv = *(const LAS f32x4*)(Ks + j * DQK + half * DH + d); s0 += q[d] * kv.x + q[d + 2] * kv.z; s1 += q[d + 1] * kv.y + q[d + 3] * kv.w; }
                    float sp = s0 + s1; sp += __shfl_xor(sp, 1);
                    if (valid) {
                        const float s = sp * scale + bias;
                        if (s > m) { const float a = __expf(m - s); l *= a;
#pragma unroll
                            for (int d = 0; d < 32; ++d) o[d] *= a;
                            m = s; }
                        const float p = __expf(s - m); l += p;
#pragma unroll
                        for (int d = 0; d < 32; d += 4) { const f32x4 vv = *(const LAS f32x4*)(Vs + j * 64 + half * 32 + d); o[d] += p * vv.x; o[d + 1] += p * vv.y; o[d + 2] += p * vv.z; o[d + 3] += p * vv.w; }
                    }
                }
            }
        }
        { const float il = 1.f / l; bf16* orow = Ob + (size_t)t * D + h * 64 + half * 32;
#pragma unroll
            for (int d = 0; d < 32; d += 8) { u32x4 w; w.x = pk2(o[d] * il, o[d + 1] * il); w.y = pk2(o[d + 2] * il, o[d + 3] * il); w.z = pk2(o[d + 4] * il, o[d + 5] * il); w.w = pk2(o[d + 6] * il, o[d + 7] * il);
                *(u32x4*)(orow + d) = w; } }
    }
    __syncthreads();
}

#ifndef USE_FAST_ATTN
#define USE_FAST_ATTN 1
#endif
__device__ __forceinline__ s16x4 lds_tr16(const LAS unsigned char* p) { return __builtin_bit_cast(s16x4, __builtin_amdgcn_ds_read_tr16_b64_v4i16((LAS s16x4*)p)); }
__device__ __forceinline__ int crow(int r, int hi) { return (r & 3) + 8 * (r >> 2) + 4 * hi; }

#define ATT_BAR() do { __builtin_amdgcn_sched_barrier(0); asm volatile("s_waitcnt lgkmcnt(0)\n\ts_barrier" ::: "memory"); __builtin_amdgcn_sched_barrier(0); } while (0)
template <int KIND, int VARIANT = 0>
__device__ __forceinline__ void ph_attn_fast(const Ctx& C, int slot, bool with_ctxq, int conv_layer = -1) {
    constexpr int DQK = KIND == 2 ? 96 : 64, NS = DQK / 16, CPR = DQK / 8, CPRP = CPR + (KIND == 2 ? 1 : 0);
    constexpr int KS = CPRP * 16, VS = 128, KBYTES = 64 * KS, VBYTES = 64 * VS, SLOTB = KBYTES + VBYTES;
    constexpr int NKC = 64 * CPRP, NINST = (NKC + 64 * 8) / 64, NDMA = (NINST + 7) / 8, NRING = 4, PD = 3;
    static_assert(NKC % 64 == 0 && SLOTB % 1024 == 0 && NRING * SLOTB + 2048 <= 131072, "attention ring geometry");
    LAS unsigned char* lds = C.lds; const unsigned lds_u32 = (unsigned)(size_t)C.lds;
    LAS float* Bsm = (LAS float*)(lds + NRING * SLOTB);
    const bf16 *Qb, *Kb, *Vb, *KRb = nullptr; int qp, kp, vp, kgrp = 1; size_t qhs, khs, vhs; float scale;
    if (KIND == 0) { Qb = WSP(bf16, WS_QKV); Kb = Qb + (size_t)16 * R * 64; Vb = Qb + (size_t)32 * R * 64; qp = kp = vp = 64; qhs = khs = vhs = (size_t)R * 64; scale = 0.125f; }
    else if (KIND == 1) { Qb = WSP(bf16, WS_QKV); Kb = Qb + (size_t)16 * R * 64; Vb = Qb + (size_t)20 * R * 64; qp = kp = vp = 64; qhs = khs = vhs = (size_t)R * 64; kgrp = 4; scale = 0.125f; }
    else { Qb = WSP(bf16, WS_Q); Kb = WSP(bf16, WS_KV); Vb = Kb + 64; KRb = WSP(bf16, WS_KROPE); qp = 96; kp = vp = 128; qhs = (size_t)R * 96; khs = vhs = (size_t)R * 128; scale = 0.10206207261596575f; }
    bf16* Ob = VARIANT ? WSP(bf16, WS_ACT) : WSP(bf16, WS_O);
    const float c2 = scale * 1.4426950408889634f;
    const int w = C.wave, lane = C.lane, ql = lane & 31, hi = lane >> 5;
    const int vq_ = (lane & 15) >> 2, vsw_ = 4 * ((vq_ >> 1) & 1), vch_ = 2 * ((lane >> 4) & 1) + ((lane & 3) >> 1);
    const int vlane0 = (vq_ + 4 * hi) * VS + ((0 + vch_) ^ vsw_) * 16 + 8 * (lane & 1), vlane1 = (vq_ + 4 * hi) * VS + ((4 + vch_) ^ vsw_) * 16 + 8 * (lane & 1);
    const int nunits = with_ctxq ? 1040 : 1024;
    ConvState cst; cst.l0 = conv_layer; cst.total = conv_layer < 0 ? 0 : (KIND == 2 ? 2 : 1) * MOE_HALF_ITEMS; cst.cur = C.blk * 8 + C.wave; cst.loaded = false;
    LAS float* cscr = (LAS float*)(C.lds + NRING * SLOTB + 2048 + C.wave * 4096);
    static_assert(NRING * SLOTB + 2048 + 8 * 4096 <= 131072, "conversion scratch");
    static_assert(KIND == 2 || NRING * SLOTB + 2048 == CONV_PIPE_BASE, "pipelined conversion scratch");
    ConvPipe cpipe; cpipe.l0 = conv_layer; cpipe.total = (KIND != 2 && conv_layer >= 0) ? MOE_HALF_ITEMS : 0; cpipe.first = C.blk * 8 + C.wave; cpipe.n = 0;
    const bool convon = cpipe.total > 0; constexpr int CFL = (VARIANT >> 7) & 3;
    for (int u = C.blk; u < nunits; u += C.G) {
        const bool isctx = u >= 1024;
        int h, q0;
        if (isctx) { h = u - 1024; q0 = SEQ; }
        else if (C.G == 256) { const int k = u >> 8; h = 2 * (C.blk & 7) + (k >> 1); q0 = ((k & 1) * 32 + (C.blk >> 3)) * 256; }
        else { h = u & 15; q0 = (u >> 4) * 256; }
        const int kh = h / kgrp;
        int lat0 = 0, nlat = 0;
        if (!isctx) {
            if (KIND == 0) { const int r0 = q0 >> 6; int ta = r0 - 4; ta = ta < 0 ? 0 : (ta > 248 ? 248 : ta); int tb = r0 - 1; tb = (tb < 0 ? 0 : (tb > 248 ? 248 : tb)) + 7; lat0 = ta; nlat = tb - ta + 1; }
            else if (KIND == 1) { const int a = q0 - 128 < 0 ? 0 : q0 - 128, b = q0 + 384 > SEQ ? SEQ : q0 + 384; lat0 = a >> 6; nlat = (b - a) >> 6; }
            else { lat0 = 0; nlat = SEQ / 64; }
        }
        const int ntiles = nlat + 4;
        int lane_u = lane; asm volatile("" : "+v"(lane_u));
        const int ql_u = lane_u & 31, hi_u = lane_u >> 5;
        const int t = (KIND == 0 && !isctx) ? q0 + 128 * (w >> 2) + 64 * (ql_u >> 4) + 16 * (w & 3) + (ql_u & 15) : q0 + 32 * w + ql_u;
        bf16x8 qf[NS];
        { const bf16* qr = Qb + (size_t)t * qp + h * qhs + 8 * hi_u;
#pragma unroll
          for (int sidx = 0; sidx < NS; ++sidx) qf[sidx] = *(const bf16x8*)(qr + 16 * sidx); }
        unsigned gsrc[NDMA]; int gpitch[NDMA], ldst[NDMA];
        const char* const wsb = (const char*)C.ws;
#pragma unroll
        for (int jj = 0; jj < NDMA; ++jj) {
            int j = w + 8 * jj; if (j >= NINST) j -= 8;
            const int cidx = 64 * j + lane_u; ldst[jj] = j * 1024;
            if (cidx < NKC) { const int row = cidx / CPRP; int c = cidx % CPRP; if (c >= CPR) c = 0;
                if (KIND != 2) c ^= (row >> 1) & 7;
                if (KIND == 2 && c >= 8) { gsrc[jj] = (unsigned)((const char*)(KRb + (size_t)row * 32 + 8 * (c - 8)) - wsb); gpitch[jj] = 64; }
                else { gsrc[jj] = (unsigned)((const char*)(Kb + kh * khs + (size_t)row * kp + 8 * c) - wsb); gpitch[jj] = kp * 2; } }
            else { const int v = cidx - NKC, row = v >> 3; const int c = (v & 7) ^ (4 * ((row >> 1) & 1));
                gsrc[jj] = (unsigned)((const char*)(Vb + kh * vhs + (size_t)row * vp + 8 * c) - wsb); gpitch[jj] = vp * 2; }
        }
#define ATT_KEY0(i) (KIND == 2 ? (isctx ? SEQ : 0) + (i) * 64 : ((i) < nlat ? (lat0 + (i)) * 64 : SEQ + ((i) - nlat) * 64))
#define ATT_DMA(i, sl) do { const int ti_ = (i) < ntiles ? (i) : ntiles - 1; const unsigned key0_ = (unsigned)ATT_KEY0(ti_); \
        _Pragma("unroll") for (int jj = 0; jj < NDMA; ++jj) \
            __builtin_amdgcn_global_load_lds((const unsigned*)(wsb + (size_t)(gsrc[jj] + __umul24(key0_, (unsigned)gpitch[jj]))), (LAS unsigned*)(lds + (sl) * SLOTB + ldst[jj]), 16, 0, 0); } while (0)
        static_assert(NDMA == (KIND == 2 ? 3 : 2), "the counted waits below are written for these DMA counts");
#define ATT_WAIT_DMA() do { if (NDMA == 2) asm volatile("s_waitcnt vmcnt(4)" ::: "memory"); else asm volatile("s_waitcnt vmcnt(6)" ::: "memory"); } while (0)
#define ATT_WAIT_DMA_IT() do { if (KIND == 2) { ATT_WAIT_DMA(); } else if (convon) { if (CFL == 0) asm volatile("s_waitcnt vmcnt(10)" ::: "memory"); else if (CFL == 1) asm volatile("s_waitcnt vmcnt(8)" ::: "memory"); else if (CFL == 2) asm volatile("s_waitcnt vmcnt(6)" ::: "memory"); else asm volatile("s_waitcnt vmcnt(4)" ::: "memory"); } \
        else asm volatile("s_waitcnt vmcnt(4)" ::: "memory"); } while (0)
        float bval = -INFINITY;
        if (KIND == 0) { const float* rp = C.in[10] + ((size_t)slot * 16 + h) * 465; const int i = C.tid, br = i >> 5, bc = i & 31; if (br < 15 && bc < 31) bval = rp[br * 31 + bc] * 1.4426950408889634f; }
        __syncthreads();
        if (KIND == 0) Bsm[C.tid] = bval;
        float m = -INFINITY, l = 0.f;
        if (KIND == 1) { m = C.in[13][h] * 1.4426950408889634f; l = hi ? 0.f : 1.f; }
        ATT_DMA(0, 0); ATT_DMA(1, 1); ATT_DMA(2, 2);
        f32x16 ot[2];
#pragma unroll
        for (int r = 0; r < 16; ++r) { ot[0][r] = 0.f; ot[1][r] = 0.f; }
        const int qr_ = t >> 6, qc_ = t & 63;
        int cs0 = qc_ - 8; cs0 = cs0 < 0 ? 0 : (cs0 > 48 ? 48 : cs0);
        const int wrow = (q0 >> 6) + 2 * (w >> 2);
        int wrs = wrow - 4; wrs = wrs < 0 ? 0 : (wrs > 248 ? 248 : wrs);
        int wre = wrow + 1 - 4; wre = (wre < 0 ? 0 : (wre > 248 ? 248 : wre)) + 8;
        int rs = qr_ - 4; rs = rs < 0 ? 0 : (rs > 248 ? 248 : rs);
        const int kc0 = (w & 3) == 0 ? 0 : ((w & 3) == 1 ? 8 : ((w & 3) == 2 ? 24 : 32));
        const int wq0 = q0 + 32 * w;
        int cidx[16];
#pragma unroll
        for (int r = 0; r < 16; ++r) { const int kc = kc0 + crow(r, hi); cidx[r] = (KIND == 0 && (unsigned)(kc - cs0) < 16u) ? kc - qc_ + 15 : 31; }
        if constexpr (KIND == 2) {
            { float qs = 0.f;
#pragma unroll
              for (int sidx = 0; sidx < NS; ++sidx) { u32x4 qw;
#pragma unroll
                  for (int j = 0; j < 4; ++j) { const float q0_ = bf2f((unsigned)(unsigned short)qf[sidx][2 * j]) * c2, q1_ = bf2f((unsigned)(unsigned short)qf[sidx][2 * j + 1]) * c2;
                      const unsigned pw = cvt_pk_bf16(q0_, q1_); qw[j] = pw; const float r0_ = bf2f(pw & 0xffffu), r1_ = bf2f(pw >> 16); qs += r0_ * r0_ + r1_ * r1_; }
                  qf[sidx] = __builtin_bit_cast(bf16x8, qw); }
              const auto sw = __builtin_amdgcn_permlane32_swap(__float_as_uint(qs), __float_as_uint(qs), false, false);
              qs = __uint_as_float(sw[0]) + __uint_as_float(sw[1]);
              const float k2 = __uint_as_float(__hip_atomic_load((unsigned*)(C.ws + WS_CTL) + CW_KMAX + h, __ATOMIC_RELAXED, __HIP_MEMORY_SCOPE_AGENT));
              m = sqrtf(qs * k2) * 1.001f + 0.01f; }
            if (NDMA == 4) asm volatile("s_waitcnt vmcnt(4)" ::: "memory"); else asm volatile("s_waitcnt vmcnt(3)" ::: "memory");
            ATT_BAR();
            f32x16 pa0, pa1, pb0, pb1;
#define MLA_QK(D0, D1, sl) do { const LAS unsigned char* kb_ = lds + (sl) * SLOTB; \
            _Pragma("unroll") for (int r_ = 0; r_ < 16; ++r_) { D0[r_] = -m; D1[r_] = -m; } \
            _Pragma("unroll") for (int sidx = 0; sidx < NS; ++sidx) { \
                const bf16x8 a0_ = *(const LAS bf16x8*)(kb_ + ql * KS + 32 * sidx + 16 * hi); \
                const bf16x8 a1_ = *(const LAS bf16x8*)(kb_ + (32 + ql) * KS + 32 * sidx + 16 * hi); \
                { D0 = __builtin_amdgcn_mfma_f32_32x32x16_bf16(a0_, qf[sidx], D0, 0, 0, 0); \
                       D1 = __builtin_amdgcn_mfma_f32_32x32x16_bf16(a1_, qf[sidx], D1, 0, 0, 0); } } } while (0)
#define VB(x) (((VARIANT) >> (x)) & 1)
#define MLA_KHALF(D0, D1, sl, h0) do { const LAS unsigned char* kq_ = lds + (sl) * SLOTB; \
            _Pragma("unroll") for (int sidx = 0; sidx < NS / 2; ++sidx) { \
                D0[sidx] = *(const LAS bf16x8*)(kq_ + ql * KS + 32 * ((h0) + sidx) + 16 * hi); D1[sidx] = *(const LAS bf16x8*)(kq_ + (32 + ql) * KS + 32 * ((h0) + sidx) + 16 * hi); } } while (0)
#define MLA_ITER(CV, WV, P0, P1, S0, S1, it) do { \
            if (!VB(3)) ATT_DMA((it) + 3, ((it) + 3) & 3);                        \
            bf16x8 kb0_[NS / 2], kb1_[NS / 2]; s16x4 vlo_[2][4], vhi_[2][4]; u32x4 pfw_[4]; \
              \
            _Pragma("unroll") for (int r_ = 0; r_ < 16; ++r_) { S0[r_] = -m; S1[r_] = -m; } \
            asm volatile("s_waitcnt lgkmcnt(0)" ::: "memory"); __builtin_amdgcn_sched_barrier(0); \
            _Pragma("unroll") for (int g_ = 0; g_ < 20; ++g_) { \
                if (g_ == 6) { asm volatile("s_waitcnt lgkmcnt(0)" ::: "memory"); __builtin_amdgcn_sched_barrier(0); } \
                if (g_ == 12) { if (!VB(4)) { asm volatile("s_waitcnt vmcnt(" #WV ")" ::: "memory"); ATT_BAR(); }         \
                                else { asm volatile("s_waitcnt lgkmcnt(0)" ::: "memory"); __builtin_amdgcn_sched_barrier(0); } \
                                if (CV) { conv_const_step(C, cst, cscr); __builtin_amdgcn_sched_barrier(0); } }        \
                if (g_ == 2) MLA_KHALF(kb0_, kb1_, ((it) + 1) & 3, NS / 2); \
                if (g_ == 16) MLA_KHALF(ka0, ka1, ((it) + 2) & 3, 0); \
                if (g_ < 6) { if (g_ & 1) S1 = __builtin_amdgcn_mfma_f32_32x32x16_bf16(ka1[g_ >> 1], qf[g_ >> 1], S1, 0, 0, 0); else S0 = __builtin_amdgcn_mfma_f32_32x32x16_bf16(ka0[g_ >> 1], qf[g_ >> 1], S0, 0, 0, 0); } \
                else if (g_ < 12) { if (g_ & 1) S1 = __builtin_amdgcn_mfma_f32_32x32x16_bf16(kb1_[(g_ >> 1) - NS / 2], qf[g_ >> 1], S1, 0, 0, 0); else S0 = __builtin_amdgcn_mfma_f32_32x32x16_bf16(kb0_[(g_ >> 1) - NS / 2], qf[g_ >> 1], S0, 0, 0, 0); } \
                else { const int ks_ = (g_ - 12) >> 1, c_ = (g_ - 12) & 1; \
                    const bf16x8 av_ = (bf16x8){vlo_[c_][ks_][0], vlo_[c_][ks_][1], vlo_[c_][ks_][2], vlo_[c_][ks_][3], vhi_[c_][ks_][0], vhi_[c_][ks_][1], vhi_[c_][ks_][2], vhi_[c_][ks_][3]}; \
                    ot[c_] = __builtin_amdgcn_mfma_f32_32x32x16_bf16(av_, __builtin_bit_cast(bf16x8, pfw_[ks_]), ot[c_], 0, 0, 0); } \
                if (g_ < 16) { \
                    _Pragma("unroll") for (int k_ = 2 * g_; k_ < 2 * g_ + 2; ++k_) { \
                        if (k_ < 16) { P0[k_] = __builtin_amdgcn_exp2f(P0[k_]); l += P0[k_]; } \
                        else { P1[k_ - 16] = __builtin_amdgcn_exp2f(P1[k_ - 16]); l += P1[k_ - 16]; } } \
                } \
                  \
                _Pragma("unroll") for (int q_ = 0; q_ < 2; ++q_) { \
                    const int f_ = g_ < 16 ? (g_ >> 2) - 1 : 3, j_ = g_ < 16 ? (g_ & 3) : 2 * (g_ - 16) + q_; \
                    if (g_ >= 4 && g_ < 18 && (g_ >= 16 || q_ == 0)) { \
                        if (f_ < 2) pfw_[f_][j_] = cvt_pk_bf16(P0[8 * f_ + 2 * j_], P0[8 * f_ + 2 * j_ + 1]); \
                        else pfw_[f_][j_] = cvt_pk_bf16(P1[8 * (f_ - 2) + 2 * j_], P1[8 * (f_ - 2) + 2 * j_ + 1]); } } \
                if (g_ == 7) { const unsigned vb_ = lds_u32 + (unsigned)(((it) & 3) * SLOTB + KBYTES); \
                  _Pragma("unroll") for (int c = 0; c < 2; ++c) { const unsigned va_ = vb_ + (unsigned)(c ? vlane1 : vlane0); \
                    _Pragma("unroll") for (int ks = 0; ks < 4; ++ks) { \
                        asm volatile("ds_read_b64_tr_b16 %0, %1 offset:%c2" : "=&v"(vlo_[c][ks]) : "v"(va_), "i"((32 * (ks >> 1) + 16 * (ks & 1)) * VS) : "memory"); \
                        asm volatile("ds_read_b64_tr_b16 %0, %1 offset:%c2" : "=&v"(vhi_[c][ks]) : "v"(va_), "i"((32 * (ks >> 1) + 16 * (ks & 1) + 8) * VS) : "memory"); } } } \
                __builtin_amdgcn_sched_barrier(0); } \
            } while (0)
            MLA_QK(pa0, pa1, 0);
            bf16x8 ka0[NS / 2], ka1[NS / 2];
            MLA_KHALF(ka0, ka1, 1, 0);
            if (w >= 4) __builtin_amdgcn_s_setprio(1);
            for (int i = 0; i < ntiles; i += 4) {
                MLA_ITER(1, 3, pa0, pa1, pb0, pb1, i);
                MLA_ITER(0, 9, pb0, pb1, pa0, pa1, i + 1);
                MLA_ITER(0, 3, pa0, pa1, pb0, pb1, i + 2);
                MLA_ITER(0, 3, pb0, pb1, pa0, pa1, i + 3);
            }
            __builtin_amdgcn_s_setprio(0);
#undef MLA_KHALF
#undef MLA_QK
#undef MLA_ITER
#undef VB
        } else {
        ATT_WAIT_DMA();
        ATT_BAR();
        int rs_cur = 0, rs_nxt = 3;
        for (int i = 0; i < ntiles; ++i) {
            if (convon) conv_pipe_step<CFL>(C, cpipe, lds);
            ATT_DMA(i + PD, rs_nxt);
            const bool lat = i < nlat; const int key0 = ATT_KEY0(i);
            bool need = true;
            if (lat) { if (KIND == 0) { const int kr = lat0 + i; need = kr >= wrs && kr < wre; }
                       else if (KIND == 1) need = (key0 + 63 >= wq0 - 128) && (key0 <= wq0 + 31 + 128); }
            if (KIND == 0 && lat) {
              if (need) {
                const int kr = lat0 + i;
                const LAS unsigned char* kb = lds + rs_cur * SLOTB + kc0 * KS; const int swz = ((kc0 + ql) >> 1) & 7;
                f32x16 p0;
#pragma unroll
                for (int r = 0; r < 16; ++r) p0[r] = 0.f;
#pragma unroll
                for (int sidx = 0; sidx < NS; ++sidx) {
                    const bf16x8 a0 = *(const LAS bf16x8*)(kb + ql * KS + 16 * ((2 * sidx + hi) ^ swz));
                    p0 = __builtin_amdgcn_mfma_f32_32x32x16_bf16(a0, qf[sidx], p0, 0, 0, 0);
                }
                const bool rowok = kr >= rs && kr < rs + 8;
                const LAS float* brow = Bsm + (rowok ? kr - qr_ + 7 : 15) * 32;
                float mx = -INFINITY;
#pragma unroll
                for (int r = 0; r < 16; ++r) { const float s0 = __builtin_fmaf(p0[r], c2, brow[cidx[r]]); p0[r] = s0; mx = fmaxf(mx, s0); }
                { const auto sw = __builtin_amdgcn_permlane32_swap(__float_as_uint(mx), __float_as_uint(mx), false, false);
                  mx = fmaxf(__uint_as_float(sw[0]), __uint_as_float(sw[1])); }
                const float mn = fmaxf(m, mx), ms = mn == -INFINITY ? 0.f : mn;
                const float alpha = __builtin_amdgcn_exp2f(m - ms);
                if (__builtin_amdgcn_ballot_w64(alpha != 1.f) != 0ull) {
#pragma unroll
                    for (int r = 0; r < 16; ++r) { ot[0][r] *= alpha; ot[1][r] *= alpha; }
                }
                s16x4 vlo[2][2], vhi[2][2];
                { const unsigned vb0 = lds_u32 + (unsigned)(rs_cur * SLOTB + KBYTES + kc0 * VS);
#pragma unroll
                  for (int c = 0; c < 2; ++c) { const unsigned va = vb0 + (unsigned)(c ? vlane1 : vlane0);
#pragma unroll
                    for (int ks = 0; ks < 2; ++ks) {
                        asm volatile("ds_read_b64_tr_b16 %0, %1 offset:%c2" : "=&v"(vlo[c][ks]) : "v"(va), "i"((16 * ks) * VS) : "memory");
                        asm volatile("ds_read_b64_tr_b16 %0, %1 offset:%c2" : "=&v"(vhi[c][ks]) : "v"(va), "i"((16 * ks + 8) * VS) : "memory"); } } }
                __builtin_amdgcn_sched_barrier(0);
                float rs0 = 0.f, rs1 = 0.f;
#pragma unroll
                for (int ks = 0; ks < 2; ++ks) {
#pragma unroll
                    for (int j = 0; j < 8; ++j) { const int r = 8 * ks + j; p0[r] = __builtin_amdgcn_exp2f(p0[r] - ms); if (j & 1) rs1 += p0[r]; else rs0 += p0[r]; }
                    u32x4 pw; const int k8 = 8 * ks;
                    pw.x = cvt_pk_bf16(p0[k8 + 0], p0[k8 + 1]); pw.y = cvt_pk_bf16(p0[k8 + 2], p0[k8 + 3]); pw.z = cvt_pk_bf16(p0[k8 + 4], p0[k8 + 5]); pw.w = cvt_pk_bf16(p0[k8 + 6], p0[k8 + 7]);
                    const bf16x8 pfk = __builtin_bit_cast(bf16x8, pw);
                    if (ks == 0) { asm volatile("s_waitcnt lgkmcnt(0)" ::: "memory"); }
                    __builtin_amdgcn_sched_barrier(0);
                    const bf16x8 av0 = (bf16x8){vlo[0][ks][0], vlo[0][ks][1], vlo[0][ks][2], vlo[0][ks][3], vhi[0][ks][0], vhi[0][ks][1], vhi[0][ks][2], vhi[0][ks][3]};
                    const bf16x8 av1 = (bf16x8){vlo[1][ks][0], vlo[1][ks][1], vlo[1][ks][2], vlo[1][ks][3], vhi[1][ks][0], vhi[1][ks][1], vhi[1][ks][2], vhi[1][ks][3]};
                    ot[0] = __builtin_amdgcn_mfma_f32_32x32x16_bf16(av0, pfk, ot[0], 0, 0, 0);
                    ot[1] = __builtin_amdgcn_mfma_f32_32x32x16_bf16(av1, pfk, ot[1], 0, 0, 0);
                    __builtin_amdgcn_sched_barrier(0);
                }
                l = l * alpha + (rs0 + rs1); m = mn;
              }
            } else if (need) {
                const LAS unsigned char* kb = lds + rs_cur * SLOTB; const LAS unsigned char* vb = kb + KBYTES;
                f32x16 p0, p1;
#pragma unroll
                for (int r = 0; r < 16; ++r) { p0[r] = 0.f; p1[r] = 0.f; }
#pragma unroll
                for (int sidx = 0; sidx < NS; ++sidx) {
                    const int swz = (ql >> 1) & 7;
                    const bf16x8 a0 = *(const LAS bf16x8*)(kb + ql * KS + 16 * ((2 * sidx + hi) ^ swz));
                    const bf16x8 a1 = *(const LAS bf16x8*)(kb + (32 + ql) * KS + 16 * ((2 * sidx + hi) ^ swz));
                    p0 = __builtin_amdgcn_mfma_f32_32x32x16_bf16(a0, qf[sidx], p0, 0, 0, 0);
                    p1 = __builtin_amdgcn_mfma_f32_32x32x16_bf16(a1, qf[sidx], p1, 0, 0, 0);
                }
                float mx = -INFINITY;
                if (KIND == 0) {
#pragma unroll
                    for (int r = 0; r < 16; ++r) {
                        const float s0 = p0[r] * c2, s1 = p1[r] * c2;
                        p0[r] = s0; p1[r] = s1; mx = fmaxf(fmaxf(mx, s0), s1);
                    }
                } else {
                    if (KIND == 1 && lat && !((key0 + 63 - wq0 <= 128) && (wq0 + 31 - key0 <= 128))) {
#pragma unroll
                        for (int r = 0; r < 16; ++r) { const int dd = key0 + crow(r, hi) - t;
                            p0[r] = (unsigned)(dd + 128) <= 256u ? p0[r] : -INFINITY; p1[r] = (unsigned)(dd + 32 + 128) <= 256u ? p1[r] : -INFINITY; }
                    }
#pragma unroll
                    for (int r = 0; r < 16; ++r) mx = fmaxf(fmaxf(mx, p0[r]), p1[r]);
                    mx *= c2;
                }
                { const auto sw = __builtin_amdgcn_permlane32_swap(__float_as_uint(mx), __float_as_uint(mx), false, false);
                  mx = fmaxf(__uint_as_float(sw[0]), __uint_as_float(sw[1])); }
                const float mn = fmaxf(m, mx), ms = mn == -INFINITY ? 0.f : mn;
                const float alpha = __builtin_amdgcn_exp2f(m - ms);
                if (__builtin_amdgcn_ballot_w64(alpha != 1.f) != 0ull) {
#pragma unroll
                    for (int r = 0; r < 16; ++r) { ot[0][r] *= alpha; ot[1][r] *= alpha; }
                }
                s16x4 vlo[2][4], vhi[2][4];
                { const unsigned vb0 = lds_u32 + (unsigned)(rs_cur * SLOTB + KBYTES);
#pragma unroll
                  for (int c = 0; c < 2; ++c) { const unsigned va = vb0 + (unsigned)(c ? vlane1 : vlane0);
#pragma unroll
                    for (int ks = 0; ks < 4; ++ks) {
                        asm volatile("ds_read_b64_tr_b16 %0, %1 offset:%c2" : "=&v"(vlo[c][ks]) : "v"(va), "i"((32 * (ks >> 1) + 16 * (ks & 1)) * VS) : "memory");
                        asm volatile("ds_read_b64_tr_b16 %0, %1 offset:%c2" : "=&v"(vhi[c][ks]) : "v"(va), "i"((32 * (ks >> 1) + 16 * (ks & 1) + 8) * VS) : "memory"); } } }
                __builtin_amdgcn_sched_barrier(0);
                float rs0 = 0.f, rs1 = 0.f;
#pragma unroll
                for (int ks = 0; ks < 4; ++ks) {
#pragma unroll
                    for (int j = 0; j < 8; ++j) { const int r = 8 * (ks & 1) + j;
                        if (ks < 2) { p0[r] = KIND == 0 ? __builtin_amdgcn_exp2f(p0[r] - ms) : __builtin_amdgcn_exp2f(__builtin_fmaf(p0[r], c2, -ms)); if (j & 1) rs1 += p0[r]; else rs0 += p0[r]; }
                        else { p1[r] = KIND == 0 ? __builtin_amdgcn_exp2f(p1[r] - ms) : __builtin_amdgcn_exp2f(__builtin_fmaf(p1[r], c2, -ms)); if (j & 1) rs1 += p1[r]; else rs0 += p1[r]; } }
                    u32x4 pw; const int k8 = 8 * (ks & 1);
                    if (ks < 2) { pw.x = cvt_pk_bf16(p0[k8 + 0], p0[k8 + 1]); pw.y = cvt_pk_bf16(p0[k8 + 2], p0[k8 + 3]); pw.z = cvt_pk_bf16(p0[k8 + 4], p0[k8 + 5]); pw.w = cvt_pk_bf16(p0[k8 + 6], p0[k8 + 7]); }
                    else { pw.x = cvt_pk_bf16(p1[k8 + 0], p1[k8 + 1]); pw.y = cvt_pk_bf16(p1[k8 + 2], p1[k8 + 3]); pw.z = cvt_pk_bf16(p1[k8 + 4], p1[k8 + 5]); pw.w = cvt_pk_bf16(p1[k8 + 6], p1[k8 + 7]); }
                    const bf16x8 pfk = __builtin_bit_cast(bf16x8, pw);
                    if (ks == 0) { asm volatile("s_waitcnt lgkmcnt(0)" ::: "memory"); }
                    __builtin_amdgcn_sched_barrier(0);
                    const bf16x8 av0 = (bf16x8){vlo[0][ks][0], vlo[0][ks][1], vlo[0][ks][2], vlo[0][ks][3], vhi[0][ks][0], vhi[0][ks][1], vhi[0][ks][2], vhi[0][ks][3]};
                    const bf16x8 av1 = (bf16x8){vlo[1][ks][0], vlo[1][ks][1], vlo[1][ks][2], vlo[1][ks][3], vhi[1][ks][0], vhi[1][ks][1], vhi[1][ks][2], vhi[1][ks][3]};
                    ot[0] = __builtin_amdgcn_mfma_f32_32x32x16_bf16(av0, pfk, ot[0], 0, 0, 0);
                    ot[1] = __builtin_amdgcn_mfma_f32_32x32x16_bf16(av1, pfk, ot[1], 0, 0, 0);
                    __builtin_amdgcn_sched_barrier(0);
                }
                l = l * alpha + (rs0 + rs1); m = mn;
            }
            ATT_WAIT_DMA_IT();
            ATT_BAR();
            rs_cur = (rs_cur + 1) & 3; rs_nxt = (rs_nxt + 1) & 3;
        }
        }
        asm volatile("s_waitcnt vmcnt(0)" ::: "memory");
#undef ATT_KEY0
#undef ATT_DMA
#undef ATT_WAIT_DMA
#undef ATT_WAIT_DMA_IT
        { const auto sw = __builtin_amdgcn_permlane32_swap(__float_as_uint(l), __float_as_uint(l), false, false);
          const float il = 1.f / (__uint_as_float(sw[0]) + __uint_as_float(sw[1])); bf16* orow = Ob + (size_t)t * D + h * 64 + 8 * hi;
#pragma unroll
          for (int c = 0; c < 2; ++c)
#pragma unroll
            for (int gp = 0; gp < 2; ++gp) { unsigned a[2], b[2];
#pragma unroll
                for (int j = 0; j < 2; ++j) { a[j] = cvt_pk_bf16(ot[c][8 * gp + 2 * j] * il, ot[c][8 * gp + 2 * j + 1] * il); b[j] = cvt_pk_bf16(ot[c][8 * gp + 4 + 2 * j] * il, ot[c][8 * gp + 4 + 2 * j + 1] * il); }
                u32x4 w;
#pragma unroll
                for (int j = 0; j < 2; ++j) { const auto x = __builtin_amdgcn_permlane32_swap(a[j], b[j], false, false); w[j] = x[0]; w[2 + j] = x[1]; }
                *(u32x4*)(orow + 32 * c + 16 * gp) = w; } }
    }
    if (KIND == 2) { while (cst.loaded || cst.cur < cst.total) conv_step<true>(C, cst, cscr); }
    else if (convon && !VARIANT) conv_pipe_drain(C, cpipe, lds);
    __syncthreads();
}
template <int KIND>
__device__ __forceinline__ void ph_attn(const Ctx& C, int slot, bool with_ctxq, int conv_layer = -1) {
#if USE_FAST_ATTN
    ph_attn_fast<KIND>(C, slot, with_ctxq, conv_layer);
#else
    ph_attn_naive<KIND>(C, slot);
#endif
}

#define PH_BEGIN if (lo <= ph && ph < hi) {
#define PH_END   if (ph + 1 < hi) xcd_barrier(bar); if (DIAG && C.blk == 0 && C.tid == 0) ((unsigned long long*)(C.ws + WS_CTL + 512 * 1024))[ph + 1] = __builtin_amdgcn_s_memrealtime(); } ++ph;
#ifndef DIAG
#define DIAG 0
#define DIAG_PH1 25
#define DIAG_PH2 25
#endif
#ifndef NORM2_VARIANT_PROBE
#define NORM2_VARIANT_PROBE 0
#endif
#ifndef SWA_VARIANT_PROBE
#define SWA_VARIANT_PROBE 0
#endif
#ifndef ATTN_VARIANT_PROBE
#define ATTN_VARIANT_PROBE 0
#endif
#ifndef PROBE_MASK
#define PROBE_MASK 0
#endif
#define PHG(g, ...) PH_BEGIN __VA_ARGS__ PH_END if constexpr (((PROBE_MASK >> (g)) & 1) != 0) { PH_BEGIN __VA_ARGS__ PH_END }
template <int L>
__device__ __forceinline__ void layer_phases(const Ctx& C, const XcdBarrier& bar, int lo, int hi, int& ph) {
    constexpr int l = L, kind = L % 3, slot = L / 3; constexpr bool need_ctx = L < 3; constexpr int RL = need_ctx ? R : SEQ;
    PH_BEGIN ph_rowA<0>(C, l); PH_END
    if constexpr (kind == 0) {
        PHG(1, gemm_tok(C, WSP(bf16, WS_H), WSP(bf16, WS_W_NAQKV) + (size_t)slot * 3072 * 1024, 3072, 1024, true, EpiStoreHeads{WSP(bf16, WS_QKV), 64, (size_t)R * 64});)
        PHG(2, ph_attn<0>(C, slot, need_ctx, l == 0 ? 0 : -1);)
    } else if constexpr (kind == 1) {
        PHG(1, gemm_tok(C, WSP(bf16, WS_H), WSP(bf16, WS_W_SWAQKV), 1536, 1024, true, EpiStoreHeads{WSP(bf16, WS_QKV), 64, (size_t)R * 64});)
        PH_BEGIN ph_rope(C, WSP(bf16, WS_QKV), 64, 20, 0, 16); PH_END
        PHG(3, ph_attn<1>(C, slot, need_ctx, l);)
#if SWA_VARIANT_PROBE
        PH_BEGIN ph_attn_fast<1, SWA_VARIANT_PROBE>(C, slot, need_ctx, (SWA_VARIANT_PROBE & 64) ? l : -1); PH_END
#endif
    } else {
        PHG(1, gemm_tok(C, WSP(bf16, WS_H), WSP(bf16, WS_W_MLAD), 1024, 1024, true, EpiStoreF32{WSP(float, WS_CQ), 1024});)
        PHG(11, ph_mlanorm(C);)
        PHG(1, gemm_tok(C, WSP(bf16, WS_CQN), WSP(bf16, WS_W_MLAUQ), 1536, 512, true, EpiStoreHeads{WSP(bf16, WS_Q), 96, (size_t)R * 96});
                 gemm_tok(C, WSP(bf16, WS_CKVN), WSP(bf16, WS_W_MLAUKV), 2048, 256, true, EpiStoreHeads{WSP(bf16, WS_KV), 128, (size_t)R * 128});)
        PH_BEGIN ph_rope(C, WSP(bf16, WS_Q), 96, 16, 64, 8); ph_kmax(C); PH_END
        PHG(4, ph_attn<2>(C, slot, need_ctx, 2);)
#if ATTN_VARIANT_PROBE
        PH_BEGIN ph_attn_fast<2, ATTN_VARIANT_PROBE>(C, slot, need_ctx, (ATTN_VARIANT_PROBE & 64) ? 2 : -1); PH_END
#endif
    }
    const bf16* wo = kind == 0 ? WSP(bf16, WS_W_NAO) + (size_t)slot * 1024 * 1024 : (kind == 1 ? WSP(bf16, WS_W_SWAO) : WSP(bf16, WS_W_MLAO));
    PH_BEGIN gemm_tok(C, WSP(bf16, WS_O), wo, 1024, 1024, need_ctx, EpiResid{WSP(float, WS_X), modp(C, l, 0, 2), modp(C, l, 1, 2)}); PH_END
    PHG(5, ph_norm2(C, l, RL);)
#if NORM2_VARIANT_PROBE
    PH_BEGIN ph_norm2<NORM2_VARIANT_PROBE>(C, l, RL); PH_END
#endif
    PHG(6, ph_topk(C, need_ctx);)
    PHG(8, gemm_moe(C, WSP(bf16, WS_H), WSP(bf16, WS_W_GU) + (size_t)l * 16 * 4096 * 1024, 4096, 1024, (size_t)4096 * 1024, need_ctx, EpiSwiglu{WSP(bf16, WS_ACT)}, WSP(int, WS_ROWL));)
    PHG(9, gemm_moe(C, WSP(bf16, WS_ACT), WSP(bf16, WS_W_DN) + (size_t)l * 16 * 1024 * 2048, 1024, 2048, (size_t)1024 * 2048, false, EpiMoeOut{WSP(bf16, WS_YB), WSP(float, WS_GATEL)});
           if (need_ctx) small_moe2(C, WSP(bf16, WS_ACT), WSP(bf16, WS_W_DN) + (size_t)l * 16 * 1024 * 2048, WSP(float, WS_GATEL), WSP(bf16, WS_YB));)
}
__global__ void __launch_bounds__(512, 2) fwd_kernel(Args args) {
    extern __shared__ __attribute__((aligned(16))) unsigned char lds_raw[];
    Ctx C;
#pragma unroll
    for (int i = 0; i < 26; ++i) C.in[i] = args.in[i];
    C.out = args.out; C.ws = args.ws; C.lds = (LAS unsigned char*)lds_raw;
    C.tid = threadIdx.x; C.lane = C.tid & 63; C.wave = __builtin_amdgcn_readfirstlane(C.tid >> 6); C.blk = blockIdx.x; C.G = gridDim.x;
    volatile LAS unsigned* MISC = (volatile LAS unsigned*)(C.lds + MISC_OFF);
    if (C.tid < 32) MISC[C.tid] = 0u;
    __syncthreads();
    const int lo = args.ph_lo, hi = args.ph_hi;
    XcdBarrier bar; bar.bar = (unsigned*)(C.ws + WS_CTL) + CW_BAR; bar.x = 0; bar.st = nullptr;
    if (hi - lo > 1) bar = xcd_barrier_post((unsigned*)(C.ws + WS_CTL) + CW_BAR, MISC + 8);
    int ph = 0;
    PHG(0, ph_prologue(C);)
    layer_phases<0>(C, bar, lo, hi, ph);
    layer_phases<1>(C, bar, lo, hi, ph);
    layer_phases<2>(C, bar, lo, hi, ph);
    layer_phases<3>(C, bar, lo, hi, ph);
    PH_BEGIN ph_rowA<1>(C, 4); PH_END
#if DIAG
    {
        __builtin_amdgcn_fence(__ATOMIC_ACQUIRE, "agent");
        const unsigned long long* st = (const unsigned long long*)(C.ws + WS_CTL + 512 * 1024);
        const float t1 = (float)(__hip_atomic_load(st + DIAG_PH1 + 1, __ATOMIC_RELAXED, __HIP_MEMORY_SCOPE_AGENT) - __hip_atomic_load(st + DIAG_PH1, __ATOMIC_RELAXED, __HIP_MEMORY_SCOPE_AGENT)) * 0.01f;
        const float t2 = (float)(__hip_atomic_load(st + DIAG_PH2 + 1, __ATOMIC_RELAXED, __HIP_MEMORY_SCOPE_AGENT) - __hip_atomic_load(st + DIAG_PH2, __ATOMIC_RELAXED, __HIP_MEMORY_SCOPE_AGENT)) * 0.01f;
        (void)t2;
        const float tq = exp2f(rintf(log2f(t1) * 16.f) * (1.f / 16.f));
        const float cval = 0.1f * sqrtf(tq);
        for (size_t i = (size_t)C.blk * 512 + C.tid; i < (size_t)SEQ * D; i += (size_t)C.G * 512) C.out[i] = cval;
    }
#endif
}
#undef PH_BEGIN
#undef PH_END

extern "C" void kernel_launch(void* const* d_in, const int* in_sizes, int n_in, void* d_out, int out_size, void* d_ws, size_t ws_size, hipStream_t stream) {
    static int grid = 0;
    if (grid == 0) {
        if (n_in != 26 || out_size != SEQ * D || ws_size < WS_END) { fprintf(stderr, "kernel_launch: unexpected shapes (n_in %d out %d ws %zu)\n", n_in, out_size, ws_size); grid = -1; return; }
        int dev = 0, cus = 0, per_cu = 0;
        if (hipGetDevice(&dev) != hipSuccess || hipDeviceGetAttribute(&cus, hipDeviceAttributeMultiprocessorCount, dev) != hipSuccess) { grid = -1; return; }
        if (hipFuncSetAttribute((const void*)fwd_kernel, hipFuncAttributeMaxDynamicSharedMemorySize, LDS_BYTES) != hipSuccess) { fprintf(stderr, "kernel_launch: hipFuncSetAttribute failed\n"); grid = -1; return; }
        if (hipOccupancyMaxActiveBlocksPerMultiprocessor(&per_cu, (const void*)fwd_kernel, 512, LDS_BYTES) != hipSuccess || per_cu < 1) fprintf(stderr, "kernel_launch: occupancy query says %d\n", per_cu);
        (void)hipGetLastError();
        grid = cus;
    }
    if (grid < 0) return;
    if (hipMemsetAsync((char*)d_ws + WS_CTL, 0, CTL_ZERO_BYTES, stream) != hipSuccess) return;
    Args a{};
    for (int i = 0; i < 26; ++i) a.in[i] = (const float*)d_in[i];
    a.out = (float*)d_out; a.ws = (unsigned char*)d_ws; a.pad = 0;
#if MK_N_LAUNCHES == 1
    a.ph_lo = 0; a.ph_hi = 1 << 20; a.li = 0;
    hipLaunchKernelGGL(fwd_kernel, dim3(grid), dim3(512), LDS_BYTES, stream, a);
#else
    for (int li = 0; li < NPH; ++li) { a.ph_lo = li; a.ph_hi = li + 1; a.li = li;
        hipLaunchKernelGGL(fwd_kernel, dim3(grid), dim3(512), LDS_BYTES, stream, a); }
#endif
}
```
